# Optimizing an MI355X kernel written in HIP

```python
import math
import jax, jax.numpy as jnp
from jax import lax
import numpy as np

D_MODEL = 1024
BATCH = 8
SEQ = 4096
DEPTH = 4
DEC_BATCH = 2
DEC_SEQ = 16384
PAST_LEN = 128

N_META = 16
GRID_W = 64
EPS = 1e-6
NEG = -1e30
S5_WIDTH = 256
S5_GROUP = 16
S5_GROUPS = S5_WIDTH // S5_GROUP
S5_STATE = 64
NA_HEADS = 8
NA_HEAD_DIM = 64
NA_WIDTH = NA_HEADS * NA_HEAD_DIM
NA_ROWS = 8
NA_COLS = 16
NA_QBLOCK = 16
NA_KBLOCK = NA_QBLOCK + NA_COLS
HG_HEADS = 4
HG_DK = 64
HG_DV = 64
HG_WIDTH = HG_HEADS * HG_DK
HG_CHUNK = 64
FFN_HIDDEN = -(-8 * D_MODEL // (3 * 256)) * 256
IN_SIZES = [S5_WIDTH, NA_WIDTH, NA_WIDTH, NA_WIDTH, HG_WIDTH, HG_WIDTH, HG_WIDTH, HG_WIDTH, HG_WIDTH, D_MODEL, D_MODEL, D_MODEL]
IN_WIDTH = sum(IN_SIZES)

kernel_name = "hybrid_s5_natten_hgrn2_encoder"


def rms_norm(x, g):
    xf = x.astype(jnp.float32)
    y = xf * lax.rsqrt(jnp.mean(xf * xf, axis=-1, keepdims=True) + EPS)
    return (y * g.astype(jnp.float32)).astype(x.dtype)


def s5_scan_dir(u, a_re, a_im, log_dt, b_re, b_im, c_re, c_im, reverse):
    dt = jnp.exp(log_dt)[:, None]
    mag = jnp.exp(a_re * dt)
    lbar_re = mag * jnp.cos(a_im * dt)
    lbar_im = mag * jnp.sin(a_im * dt)
    den = a_re * a_re + a_im * a_im
    nr = lbar_re - 1.0
    ni = lbar_im
    z_re = (nr * a_re + ni * a_im) / den
    z_im = (ni * a_re - nr * a_im) / den
    bbar_re = z_re[..., None] * b_re - z_im[..., None] * b_im
    bbar_im = z_re[..., None] * b_im + z_im[..., None] * b_re
    bu_re = jnp.einsum('blgc,gpc->blgp', u, bbar_re)
    bu_im = jnp.einsum('blgc,gpc->blgp', u, bbar_im)
    lr = jnp.broadcast_to(lbar_re, bu_re.shape)
    li = jnp.broadcast_to(lbar_im, bu_re.shape)

    def combine(e1, e2):
        a1r, a1i, b1r, b1i = e1
        a2r, a2i, b2r, b2i = e2
        return (a1r * a2r - a1i * a2i, a1r * a2i + a1i * a2r,
                a2r * b1r - a2i * b1i + b2r, a2r * b1i + a2i * b1r + b2i)

    _, _, xr, xi = lax.associative_scan(combine, (lr, li, bu_re, bu_im), axis=1, reverse=reverse)
    return jnp.einsum('blgp,gcp->blgc', xr, c_re) - jnp.einsum('blgp,gcp->blgc', xi, c_im)


def s5_mixer(u, a_re, a_im, log_dt, b_re, b_im, c_re, c_im, d_skip, w_glu):
    f32 = jnp.float32
    bsz, L, _ = u.shape
    uf = u.astype(f32)
    ug = uf.reshape(bsz, L, S5_GROUPS, S5_GROUP)
    y = (s5_scan_dir(ug, a_re[0].astype(f32), a_im[0].astype(f32), log_dt[0].astype(f32), b_re[0].astype(f32),
                     b_im[0].astype(f32), c_re[0].astype(f32), c_im[0].astype(f32), False)
         + s5_scan_dir(ug, a_re[1].astype(f32), a_im[1].astype(f32), log_dt[1].astype(f32), b_re[1].astype(f32),
                       b_im[1].astype(f32), c_re[1].astype(f32), c_im[1].astype(f32), True))
    y = y.reshape(bsz, L, S5_WIDTH) + d_skip.astype(f32) * uf
    y = jax.nn.gelu(y)
    y = y * jax.nn.sigmoid(y @ w_glu.astype(f32))
    return y.astype(u.dtype)


def neighborhood_attention(q, k, v, rpb):
    bsz, L, _ = q.shape
    n_tok = L - N_META
    rows = n_tok // GRID_W
    kr = min(NA_ROWS, rows)
    scale = NA_HEAD_DIM ** -0.5
    q = q.reshape(bsz, L, NA_HEADS, NA_HEAD_DIM) * scale
    k = k.reshape(bsz, L, NA_HEADS, NA_HEAD_DIM)
    v = v.reshape(bsz, L, NA_HEADS, NA_HEAD_DIM)
    qm, km, vm = q[:, :N_META], k[:, :N_META], v[:, :N_META]
    sm = jnp.einsum('bqhd,bkhd->bhqk', qm, km).astype(jnp.float32)
    om = jnp.einsum('bhqk,bkhd->bqhd', jax.nn.softmax(sm, axis=-1).astype(v.dtype), vm)
    grid = lambda t: t[:, N_META:].reshape(bsz, rows, GRID_W, NA_HEADS, NA_HEAD_DIM)
    qg, kg, vg = grid(q), grid(k), grid(v)
    ncb = GRID_W // NA_QBLOCK
    qcols = np.arange(GRID_W).reshape(ncb, NA_QBLOCK)
    ks = np.clip(np.arange(ncb) * NA_QBLOCK - NA_COLS // 2, 0, GRID_W - NA_KBLOCK)
    kcols = ks[:, None] + np.arange(NA_KBLOCK)
    wstart = np.clip(qcols - NA_COLS // 2, 0, GRID_W - NA_COLS)
    colmask = (kcols[:, None, :] >= wstart[..., None]) & (kcols[:, None, :] < wstart[..., None] + NA_COLS)
    dcol = np.clip(kcols[:, None, :] - qcols[..., None], -(NA_COLS - 1), NA_COLS - 1) + NA_COLS - 1
    mask = np.broadcast_to(colmask[:, :, None, :], (ncb, NA_QBLOCK, kr, NA_KBLOCK)).reshape(ncb, NA_QBLOCK, kr * NA_KBLOCK)
    rpb = rpb.astype(jnp.float32)

    def row_fn(args):
        r, q_row = args
        rs = jnp.clip(r - NA_ROWS // 2, 0, rows - kr)
        k_strip = lax.dynamic_slice_in_dim(kg, rs, kr, axis=1)
        v_strip = lax.dynamic_slice_in_dim(vg, rs, kr, axis=1)
        k_blk = k_strip[:, :, kcols].transpose(0, 2, 1, 3, 4, 5).reshape(bsz, ncb, kr * NA_KBLOCK, NA_HEADS, NA_HEAD_DIM)
        v_blk = v_strip[:, :, kcols].transpose(0, 2, 1, 3, 4, 5).reshape(bsz, ncb, kr * NA_KBLOCK, NA_HEADS, NA_HEAD_DIM)
        q_blk = q_row.reshape(bsz, ncb, NA_QBLOCK, NA_HEADS, NA_HEAD_DIM)
        drow = rs + jnp.arange(kr) - r + NA_ROWS - 1
        bias = rpb[:, drow][:, :, dcol]
        bias = bias.transpose(0, 2, 3, 1, 4).reshape(NA_HEADS, ncb, NA_QBLOCK, kr * NA_KBLOCK)
        s_loc = jnp.einsum('bnqhd,bnkhd->bhnqk', q_blk, k_blk).astype(jnp.float32) + bias
        s_loc = jnp.where(mask, s_loc, NEG)
        s_meta = jnp.einsum('bnqhd,bmhd->bhnqm', q_blk, km).astype(jnp.float32)
        p = jax.nn.softmax(jnp.concatenate([s_meta, s_loc], axis=-1), axis=-1).astype(v.dtype)
        o = (jnp.einsum('bhnqm,bmhd->bnqhd', p[..., :N_META], vm)
             + jnp.einsum('bhnqk,bnkhd->bnqhd', p[..., N_META:], v_blk))
        return o.reshape(bsz, GRID_W, NA_HEADS, NA_HEAD_DIM)

    og = lax.map(row_fn, (jnp.arange(rows), qg.transpose(1, 0, 2, 3, 4)))
    og = og.transpose(1, 0, 2, 3, 4).reshape(bsz, n_tok, NA_WIDTH)
    return jnp.concatenate([om.reshape(bsz, N_META, NA_WIDTH), og], axis=1)


def chunk_recurrence(q, k, v, g):
    bsz, Lp, nh, dk = q.shape
    dv = v.shape[-1]
    nc = Lp // HG_CHUNK
    to_chunks = lambda t: t.reshape(bsz, nc, HG_CHUNK, nh, t.shape[-1]).transpose(1, 0, 3, 2, 4)
    tri = np.tril(np.ones((HG_CHUNK, HG_CHUNK), dtype=bool))[:, :, None]

    def step(S, xs):
        qc, kc, vc, gc = xs
        b = jnp.cumsum(gc, axis=2)
        o_inter = jnp.einsum('bhcd,bhde->bhce', qc * jnp.exp(b), S)
        diff = b[:, :, :, None, :] - b[:, :, None, :, :]
        decay = jnp.where(tri, jnp.exp(jnp.where(tri, diff, 0.0)), 0.0)
        att = jnp.einsum('bhid,bhjd,bhijd->bhij', qc, kc, decay)
        o_intra = jnp.einsum('bhij,bhje->bhie', att, vc)
        b_last = b[:, :, -1:, :]
        S = jnp.exp(b_last[:, :, 0, :, None]) * S + jnp.einsum('bhjd,bhje->bhde', kc * jnp.exp(b_last - b), vc)
        return S, o_inter + o_intra

    S0 = jnp.zeros((bsz, nh, dk, dv), jnp.float32)
    _, o = lax.scan(step, S0, (to_chunks(q), to_chunks(k), to_chunks(v), to_chunks(g)))
    return o.transpose(1, 0, 3, 2, 4).reshape(bsz, Lp, nh, dv)


def hgrn2_mixer(q, f_fwd, f_bwd, i, g_out, lb, onorm_g):
    f32 = jnp.float32
    bsz, L, _ = q.shape
    pad = HG_CHUNK - N_META
    heads = lambda t: jnp.pad(t.astype(f32), ((0, 0), (pad, 0), (0, 0))).reshape(bsz, L + pad, HG_HEADS, -1)
    qh = heads(jax.nn.silu(q.astype(f32)))
    vh = heads(i)
    lb = lb.astype(f32)

    def gates(f):
        ff = f.astype(f32)
        fg = lb + (1.0 - lb) * jax.nn.sigmoid(ff)
        log_f = jnp.log(fg)
        kk = (1.0 - lb) * jax.nn.sigmoid(-ff)
        return heads(kk), heads(log_f)

    kf, gf = gates(f_fwd)
    kb, gb = gates(f_bwd)
    flip = lambda t: jnp.flip(t, axis=1)
    o = chunk_recurrence(qh, kf, vh, gf) + flip(chunk_recurrence(flip(qh), flip(kb), flip(vh), flip(gb)))
    o = o[:, pad:]
    o = o * lax.rsqrt(jnp.mean(o * o, axis=-1, keepdims=True) + EPS) * onorm_g.astype(f32)
    o = o.reshape(bsz, L, HG_WIDTH) * jax.nn.silu(g_out.astype(f32))
    return o.astype(q.dtype)


def hybrid_layer(h, lb, norm1_g, w_in, s5_a_re, s5_a_im, s5_log_dt, s5_b_re, s5_b_im, s5_c_re, s5_c_im,
                 s5_d, s5_w_glu, na_rpb, hg_onorm_g, w_up_a, w_up_b, w_up_c, w_o, norm2_g,
                 w_ffn_gate, w_ffn_up, w_ffn_down):
    xn = rms_norm(h, norm1_g)
    z = xn @ w_in
    (u_a, q_b, k_b, v_b, q_c, f_cf, f_cb, i_c, g_c, gt_a, gt_b, gt_c) = jnp.split(
        z, list(np.cumsum(IN_SIZES)[:-1]), axis=-1)
    y_a = s5_mixer(u_a, s5_a_re, s5_a_im, s5_log_dt, s5_b_re, s5_b_im, s5_c_re, s5_c_im, s5_d, s5_w_glu) @ w_up_a
    y_b = neighborhood_attention(q_b, k_b, v_b, na_rpb) @ w_up_b
    y_c = hgrn2_mixer(q_c, f_cf, f_cb, i_c, g_c, lb, hg_onorm_g) @ w_up_c
    mix = jax.nn.sigmoid(gt_a) * y_a + jax.nn.sigmoid(gt_b) * y_b + jax.nn.sigmoid(gt_c) * y_c
    h = h + mix @ w_o
    hn = rms_norm(h, norm2_g)
    h = h + (jax.nn.silu(hn @ w_ffn_gate) * (hn @ w_ffn_up)) @ w_ffn_down
    return h


def trunk(x, lbs, meta_tokens, norm1_g, w_in, s5_a_re, s5_a_im, s5_log_dt, s5_b_re, s5_b_im, s5_c_re, s5_c_im,
          s5_d, s5_w_glu, na_rpb, hg_onorm_g, w_up_a, w_up_b, w_up_c, w_o, norm2_g,
          w_ffn_gate, w_ffn_up, w_ffn_down, final_norm_g):
    bsz = x.shape[0]
    meta = jnp.broadcast_to(meta_tokens[None].astype(x.dtype), (bsz, N_META, D_MODEL))
    h = jnp.concatenate([meta, x], axis=1)
    for l in range(DEPTH):
        h = hybrid_layer(h, lbs[l], norm1_g[l], w_in[l], s5_a_re[l], s5_a_im[l], s5_log_dt[l], s5_b_re[l],
                         s5_b_im[l], s5_c_re[l], s5_c_im[l], s5_d[l], s5_w_glu[l], na_rpb[l], hg_onorm_g[l],
                         w_up_a[l], w_up_b[l], w_up_c[l], w_o[l], norm2_g[l],
                         w_ffn_gate[l], w_ffn_up[l], w_ffn_down[l])
    h = rms_norm(h, final_norm_g)
    return h[:, N_META:]


def setup_inputs(seed: int = 0) -> dict:
    key = jax.random.key(seed)
    ks = jax.random.split(key, 32)
    nrm = lambda k, shape, s: jax.random.normal(k, shape, jnp.float32) * s
    G, P, C = S5_GROUPS, S5_STATE, S5_GROUP
    a_im_init = jnp.pi * jnp.arange(P, dtype=jnp.float32)
    return {
        "x_prompt": nrm(ks[0], (BATCH, SEQ, D_MODEL), 1.0),
        "x_sample": nrm(ks[1], (DEC_BATCH, DEC_SEQ, D_MODEL), 1.0),
        "meta_tokens": nrm(ks[2], (N_META, D_MODEL), 1.0),
        "norm1_g": 1.0 + nrm(ks[3], (DEPTH, D_MODEL), 0.1),
        "w_in": nrm(ks[4], (DEPTH, D_MODEL, IN_WIDTH), D_MODEL ** -0.5),
        "s5_a_re": -0.5 + nrm(ks[5], (DEPTH, 2, G, P), 0.01),
        "s5_a_im": a_im_init + nrm(ks[6], (DEPTH, 2, G, P), 0.01),
        "s5_log_dt": jax.random.uniform(ks[7], (DEPTH, 2, G), jnp.float32, math.log(1e-3), math.log(1e-1)),
        "s5_b_re": nrm(ks[8], (DEPTH, 2, G, P, C), (2 * C) ** -0.5),
        "s5_b_im": nrm(ks[9], (DEPTH, 2, G, P, C), (2 * C) ** -0.5),
        "s5_c_re": nrm(ks[10], (DEPTH, 2, G, C, P), P ** -0.5),
        "s5_c_im": nrm(ks[11], (DEPTH, 2, G, C, P), P ** -0.5),
        "s5_d": nrm(ks[12], (DEPTH, S5_WIDTH), 1.0),
        "s5_w_glu": nrm(ks[13], (DEPTH, S5_WIDTH, S5_WIDTH), S5_WIDTH ** -0.5),
        "na_rpb": nrm(ks[14], (DEPTH, NA_HEADS, 2 * NA_ROWS - 1, 2 * NA_COLS - 1), 0.1),
        "hg_lb_logits": nrm(ks[15], (DEPTH, HG_WIDTH), 1.0),
        "hg_onorm_g": 1.0 + nrm(ks[16], (DEPTH, HG_DV), 0.1),
        "w_up_a": nrm(ks[17], (DEPTH, S5_WIDTH, D_MODEL), S5_WIDTH ** -0.5),
        "w_up_b": nrm(ks[18], (DEPTH, NA_WIDTH, D_MODEL), NA_WIDTH ** -0.5),
        "w_up_c": nrm(ks[19], (DEPTH, HG_WIDTH, D_MODEL), HG_WIDTH ** -0.5),
        "w_o": nrm(ks[20], (DEPTH, D_MODEL, D_MODEL), D_MODEL ** -0.5),
        "norm2_g": 1.0 + nrm(ks[21], (DEPTH, D_MODEL), 0.1),
        "w_ffn_gate": nrm(ks[22], (DEPTH, D_MODEL, FFN_HIDDEN), D_MODEL ** -0.5),
        "w_ffn_up": nrm(ks[23], (DEPTH, D_MODEL, FFN_HIDDEN), D_MODEL ** -0.5),
        "w_ffn_down": nrm(ks[24], (DEPTH, FFN_HIDDEN, D_MODEL), FFN_HIDDEN ** -0.5),
        "final_norm_g": 1.0 + nrm(ks[25], (D_MODEL,), 0.1),
    }


def reference(x_prompt, x_sample, meta_tokens, norm1_g, w_in, s5_a_re, s5_a_im, s5_log_dt, s5_b_re, s5_b_im,
              s5_c_re, s5_c_im, s5_d, s5_w_glu, na_rpb, hg_lb_logits, hg_onorm_g, w_up_a, w_up_b, w_up_c,
              w_o, norm2_g, w_ffn_gate, w_ffn_up, w_ffn_down, final_norm_g):
    sm = jax.nn.softmax(hg_lb_logits.astype(jnp.float32), axis=0)
    lbs = jnp.cumsum(sm, axis=0) - sm[0:1]
    y_prompt = trunk(x_prompt, lbs, meta_tokens, norm1_g, w_in, s5_a_re, s5_a_im, s5_log_dt, s5_b_re, s5_b_im,
                     s5_c_re, s5_c_im, s5_d, s5_w_glu, na_rpb, hg_onorm_g, w_up_a, w_up_b, w_up_c, w_o,
                     norm2_g, w_ffn_gate, w_ffn_up, w_ffn_down, final_norm_g)
    y_sample = trunk(x_sample, lbs, meta_tokens, norm1_g, w_in, s5_a_re, s5_a_im, s5_log_dt, s5_b_re, s5_b_im,
                     s5_c_re, s5_c_im, s5_d, s5_w_glu, na_rpb, hg_onorm_g, w_up_a, w_up_b, w_up_c, w_o,
                     norm2_g, w_ffn_gate, w_ffn_up, w_ffn_down, final_norm_g)
    return (y_prompt, y_sample)
```

```cpp
#include <hip/hip_runtime.h>
#include <hip/hip_cooperative_groups.h>
#include <cstdio>
#include <cstdint>
namespace cg = cooperative_groups;

#define LAS __attribute__((address_space(3)))
typedef unsigned short bf16_t;
typedef short bf16x8 __attribute__((ext_vector_type(8)));
typedef float f32x4 __attribute__((ext_vector_type(4)));
typedef unsigned u32x4 __attribute__((ext_vector_type(4)));
typedef unsigned u32x2 __attribute__((ext_vector_type(2)));

#define WAVE_SYNC() asm volatile("s_waitcnt lgkmcnt(0)" ::: "memory")
__device__ __forceinline__ int opaque_tid() { int t = threadIdx.x; asm volatile("" : "+v"(t)); return t; }

__device__ __forceinline__ unsigned f2bf(float f) { unsigned u = __builtin_bit_cast(unsigned, f); return (u + 0x7fffu + ((u >> 16) & 1u)) >> 16; }
__device__ __forceinline__ unsigned pk2(float lo, float hi) { return f2bf(lo) | (f2bf(hi) << 16); }
__device__ __forceinline__ float bf2f(bf16_t b) { return __builtin_bit_cast(float, (unsigned)b << 16); }
__device__ __forceinline__ float bflo(unsigned w) { return __builtin_bit_cast(float, w << 16); }
__device__ __forceinline__ float bfhi(unsigned w) { return __builtin_bit_cast(float, w & 0xffff0000u); }
__device__ __forceinline__ float sigm(float x) { return 1.f / (1.f + __expf(-x)); }
__device__ __forceinline__ float gelu_tanh(float y) { const float a = 0.7978845608028654f * (y + 0.044715f * y * y * y); const float th = 1.f - 2.f / (__expf(2.f * a) + 1.f); return 0.5f * y * (1.f + th); }
__device__ __forceinline__ u32x4 pack8(f32x4 a, f32x4 b) { u32x4 w; w.x = pk2(a[0], a[1]); w.y = pk2(a[2], a[3]); w.z = pk2(b[0], b[1]); w.w = pk2(b[2], b[3]); return w; }
__device__ __forceinline__ float wave_sum(float v) {
#pragma unroll
    for (int o = 1; o < 64; o <<= 1) v += __shfl_xor(v, o);
    return v;
}

namespace pg8 {
constexpr int BM = 256, BK = 64, HALF = 128, HTB = HALF * BK * 2, STAGE_BYTES = 8 * HTB, NXCD = 8, WGM = 8;
__host__ __device__ __forceinline__ int lds_byte(int r, int c) { const int st = (r >> 4) * 2 + (c >> 5), rr = r & 15, cc = c & 31, ob = rr * 64 + cc * 2; return st * 1024 + (ob ^ (((ob >> 9) & 1) << 5)); }
__host__ __device__ __forceinline__ void stage_rc(int b, int& R, int& C) { const int st = b / 1024, sb = b % 1024, swz = sb ^ (((sb >> 9) & 1) << 5); R = (st >> 1) * 16 + swz / 64; C = (st & 1) * 32 + (swz % 64) / 2; }
__host__ __device__ __forceinline__ int perm32(int rho) { const int n = rho >> 4, i = rho & 15; return 8 * (i >> 2) + 4 * n + (i & 3); }
struct Unit { int pm, pn; };
struct Gemm { const bf16_t* A; int lda; const bf16_t* Bt; int M, N, K; };
struct StaticOrder {
    int nM, nN, nwg, G, c;
    __device__ void init(int M, int N, int G_, int c_) { nM = M / BM; nN = N / BM; nwg = nM * nN; G = G_; c = c_; }
    __device__ bool next(int i, Unit& u) const {
        const long L = (long)i * G + c; if (L >= nwg) return false;
        int wgid = (int)L; { const int q = nwg / NXCD, r = nwg % NXCD, xcd = wgid % NXCD, off = wgid / NXCD; wgid = (xcd < r ? xcd * (q + 1) : r * (q + 1) + (xcd - r) * q) + off; }
        const int nig = WGM * nN, gid = wgid / nig, fm = gid * WGM, gsz = (nM - fm) < WGM ? (nM - fm) : WGM;
        u.pm = fm + ((wgid % nig) % gsz); u.pn = (wgid % nig) / gsz; return true;
    }
};

struct UberEpi;
__device__ __forceinline__ void run_epi(const UberEpi& E, LAS unsigned char* lds, const f32x4 (&acc)[2][2][4][2], const Unit& u, int wr, int wc, int fr, int fq);
__device__ __forceinline__ void gemm_phase(LAS unsigned char* lds, const Gemm g, const StaticOrder& S, const UberEpi& E) {
    const int tid = opaque_tid(), wid = __builtin_amdgcn_readfirstlane(tid >> 6), lane = tid & 63, wr = wid >> 2, wc = wid & 3, fr = lane & 15, fq = lane >> 4;
    const int K = g.K, nt = K / BK, lda = g.lda;
    unsigned voffA[2], voffB[2];
#pragma unroll
    for (int i = 0; i < 2; ++i) { int R, C; stage_rc(tid * 16 + i * 8192, R, C); const int Rb = (R & ~31) + perm32(R & 31);
        voffA[i] = (unsigned)(R * lda + C) * 2u; voffB[i] = (unsigned)(Rb * K + C) * 2u; }
    const size_t kstep = (size_t)(BK * 2);
    const size_t hstepA = (size_t)HALF * lda * 2, hstepB = (size_t)HALF * K * 2;
    const size_t tstepA = 2 * hstepA, tstepB = 2 * hstepB;
    const unsigned ldsw = (unsigned)wid * 1024u;
    const int aoff = lds_byte(wr * 64 + fr, fq * 8), boff = lds_byte(wc * 32 + fr, fq * 8);
#define PG8_SA(b, h) (((b) * 2 + (h)) * HTB)
#define PG8_SB(b, h) ((4 + (b) * 2 + (h)) * HTB)
#define PG8_STAGE(bufoff, gbase, voff) do { _Pragma("unroll") for (int _i = 0; _i < 2; ++_i) \
        __builtin_amdgcn_global_load_lds((const unsigned*)((const char*)(gbase) + (voff)[_i]), (LAS unsigned*)(lds + (bufoff) + ldsw + _i * 8192), 16, 0, 0); } while (0)
#define PG8_LDA(dst, b, h) do { _Pragma("unroll") for (int m = 0; m < 4; ++m) _Pragma("unroll") for (int k = 0; k < 2; ++k) dst[m][k] = *(const LAS bf16x8*)(lds + PG8_SA(b, h) + aoff + m * 2048 + k * 1024); } while (0)
#define PG8_LDB(dst, b, h) do { _Pragma("unroll") for (int n = 0; n < 2; ++n) _Pragma("unroll") for (int k = 0; k < 2; ++k) dst[n][k] = *(const LAS bf16x8*)(lds + PG8_SB(b, h) + boff + n * 2048 + k * 1024); } while (0)
#define PG8_MMA(ai, bj, At, Bt) do { __builtin_amdgcn_s_setprio(1); _Pragma("unroll") for (int m = 0; m < 4; ++m) _Pragma("unroll") for (int n = 0; n < 2; ++n) _Pragma("unroll") for (int k = 0; k < 2; ++k) \
        acc[ai][bj][m][n] = __builtin_amdgcn_mfma_f32_16x16x32_bf16(Bt[n][k], At[m][k], acc[ai][bj][m][n], 0, 0, 0); __builtin_amdgcn_s_setprio(0); } while (0)
#define PG8_WAIT_V(n) asm volatile("s_waitcnt vmcnt(" #n ")" ::: "memory")
#define PG8_WAIT_L(n) asm volatile("s_waitcnt lgkmcnt(" #n ")" ::: "memory")
#define PG8_BAR __builtin_amdgcn_s_barrier()
#define PG8_SCHED __builtin_amdgcn_sched_barrier(0)
    Unit cur, nxt; int ui = 0;
    if (!S.next(0, cur)) return;
    f32x4 acc[2][2][4][2];
#pragma unroll
    for (int a = 0; a < 2; ++a)
#pragma unroll
        for (int b = 0; b < 2; ++b)
#pragma unroll
            for (int m = 0; m < 4; ++m)
#pragma unroll
                for (int n = 0; n < 2; ++n) acc[a][b][m][n] = (f32x4){0.f, 0.f, 0.f, 0.f};
    bf16x8 At[4][2], B0[2][2], B1[2][2];
    const char* cA = (const char*)g.A + (size_t)cur.pm * tstepA; const char* cB = (const char*)g.Bt + (size_t)cur.pn * tstepB;
    PG8_STAGE(PG8_SB(0, 0), cB, voffB); PG8_STAGE(PG8_SB(0, 1), cB + hstepB, voffB); PG8_STAGE(PG8_SA(0, 0), cA, voffA); PG8_STAGE(PG8_SA(0, 1), cA + hstepA, voffA);
    if (wr == 1) PG8_BAR;
    PG8_WAIT_V(2); PG8_BAR;
    PG8_STAGE(PG8_SB(1, 0), cB + kstep, voffB); PG8_STAGE(PG8_SA(1, 0), cA + kstep, voffA); PG8_STAGE(PG8_SB(1, 1), cB + hstepB + kstep, voffB);
    PG8_WAIT_V(6); PG8_BAR;
    for (;;) {
        const bool has_next = S.next(ui + 1, nxt);
        const char* nA = has_next ? (const char*)g.A + (size_t)nxt.pm * tstepA : cA; const char* nB = has_next ? (const char*)g.Bt + (size_t)nxt.pn * tstepB : cB;
        for (int t = 0; t < nt; t += 2) {
            const bool last = (t == nt - 2);
            const char* a1 = cA + (size_t)(t + 1) * kstep;
            const char* a2 = last ? nA : cA + (size_t)(t + 2) * kstep; const char* b2 = last ? nB : cB + (size_t)(t + 2) * kstep;
            const char* a3 = a2 + kstep; const char* b3 = b2 + kstep;
            PG8_LDB(B0, 0, 0); PG8_LDB(B1, 0, 1); PG8_SCHED; PG8_LDA(At, 0, 0); PG8_STAGE(PG8_SA(1, 1), a1 + hstepA, voffA);
            PG8_WAIT_V(8); PG8_WAIT_L(0); PG8_BAR; PG8_MMA(0, 0, At, B0); PG8_MMA(0, 1, At, B1); PG8_BAR; PG8_SCHED;
            PG8_LDA(At, 0, 1); PG8_STAGE(PG8_SB(0, 0), b2, voffB); PG8_STAGE(PG8_SB(0, 1), b2 + hstepB, voffB); PG8_STAGE(PG8_SA(0, 0), a2, voffA);
            PG8_WAIT_V(8); PG8_WAIT_L(0); PG8_BAR; PG8_MMA(1, 0, At, B0); PG8_MMA(1, 1, At, B1); PG8_BAR; PG8_SCHED;
            PG8_LDB(B0, 1, 0); PG8_LDB(B1, 1, 1); PG8_SCHED; PG8_LDA(At, 1, 0); PG8_STAGE(PG8_SA(0, 1), a2 + hstepA, voffA);
            PG8_WAIT_V(8); PG8_WAIT_L(0); PG8_BAR; PG8_MMA(0, 0, At, B0); PG8_MMA(0, 1, At, B1); PG8_BAR; PG8_SCHED;
            PG8_LDA(At, 1, 1); PG8_STAGE(PG8_SB(1, 0), b3, voffB); PG8_STAGE(PG8_SB(1, 1), b3 + hstepB, voffB); PG8_STAGE(PG8_SA(1, 0), a3, voffA);
            PG8_WAIT_V(8); PG8_WAIT_L(0); PG8_BAR; PG8_MMA(1, 0, At, B0); PG8_MMA(1, 1, At, B1); PG8_BAR; PG8_SCHED;
        }
        if (wr == 0) PG8_BAR;
        run_epi(E, lds, acc, cur, wr, wc, fr, fq);
        if (!has_next) break;
#pragma unroll
        for (int a = 0; a < 2; ++a)
#pragma unroll
            for (int b = 0; b < 2; ++b)
#pragma unroll
                for (int m = 0; m < 4; ++m)
#pragma unroll
                    for (int n = 0; n < 2; ++n) acc[a][b][m][n] = (f32x4){0.f, 0.f, 0.f, 0.f};
        cur = nxt; cA = nA; cB = nB; ++ui;
        if (wr == 1) PG8_BAR;
    }
    PG8_WAIT_V(0);
    PG8_BAR;
#undef PG8_SA
#undef PG8_SB
#undef PG8_STAGE
#undef PG8_LDA
#undef PG8_LDB
#undef PG8_MMA
#undef PG8_WAIT_V
#undef PG8_WAIT_L
#undef PG8_BAR
#undef PG8_SCHED
}

__device__ __forceinline__ float row_rstd(const float* ssq, int row) {
    const f32x4 s0 = *(const f32x4*)(ssq + (size_t)row * 4);
    const float ss = (s0[0] + s0[1]) + (s0[2] + s0[3]);
    return rsqrtf(ss * (1.0f / 1024.0f) + 1e-6f);
}
struct EpiZ {
    bf16_t* z; const float* ssq; bf16_t* vt; int vt_ld;
    __device__ __forceinline__ void operator()(const f32x4 (&acc)[2][2][4][2], const Unit& u, int wr, int wc, int fr, int fq) const {
        const int row0 = u.pm * BM + wr * 64 + fr, col0 = u.pn * BM + wc * 32 + 8 * fq;
        const bool isv = (u.pn == 5 || u.pn == 6);
#pragma unroll
        for (int ai = 0; ai < 2; ++ai)
#pragma unroll
            for (int m = 0; m < 4; ++m) {
                const int row = row0 + ai * HALF + m * 16; const float rs = row_rstd(ssq, row);
#pragma unroll
                for (int bj = 0; bj < 2; ++bj) {
                    const u32x4 w = pack8(acc[ai][bj][m][0] * rs, acc[ai][bj][m][1] * rs);
                    *(u32x4*)(z + (size_t)row * 6144 + col0 + bj * HALF) = w;
                    if (isv) { const int c = col0 + bj * HALF - 1280;
#pragma unroll
                        for (int i = 0; i < 8; ++i) vt[(size_t)(c + i) * vt_ld + row] = (bf16_t)((w[i >> 1] >> (16 * (i & 1))) & 0xffffu); }
                }
            }
    }
};
struct EpiGlu {
    bf16_t* z;
    __device__ __forceinline__ void operator()(const f32x4 (&acc)[2][2][4][2], const Unit& u, int wr, int wc, int fr, int fq) const {
        const int row0 = u.pm * BM + wr * 64 + fr, col0 = wc * 32 + 8 * fq;
#pragma unroll
        for (int ai = 0; ai < 2; ++ai)
#pragma unroll
            for (int m = 0; m < 4; ++m) {
                const int row = row0 + ai * HALF + m * 16;
#pragma unroll
                for (int bj = 0; bj < 2; ++bj) {
                    bf16_t* zp = z + (size_t)row * 6144 + col0 + bj * HALF;
                    const u32x4 y = *(const u32x4*)(zp + 512);
                    const f32x4 a0 = acc[ai][bj][m][0], a1 = acc[ai][bj][m][1];
                    f32x4 o0, o1;
                    o0[0] = bflo(y.x) * sigm(a0[0]); o0[1] = bfhi(y.x) * sigm(a0[1]); o0[2] = bflo(y.y) * sigm(a0[2]); o0[3] = bfhi(y.y) * sigm(a0[3]);
                    o1[0] = bflo(y.z) * sigm(a1[0]); o1[1] = bfhi(y.z) * sigm(a1[1]); o1[2] = bflo(y.w) * sigm(a1[2]); o1[3] = bfhi(y.w) * sigm(a1[3]);
                    *(u32x4*)zp = pack8(o0, o1);
                }
            }
    }
};
template <int MODE> struct EpiMix {
    bf16_t* z; int goff;
    __device__ __forceinline__ void operator()(const f32x4 (&acc)[2][2][4][2], const Unit& u, int wr, int wc, int fr, int fq) const {
        const int row0 = u.pm * BM + wr * 64 + fr, col0 = u.pn * BM + wc * 32 + 8 * fq;
#pragma unroll
        for (int ai = 0; ai < 2; ++ai)
#pragma unroll
            for (int m = 0; m < 4; ++m) {
                const int row = row0 + ai * HALF + m * 16;
#pragma unroll
                for (int bj = 0; bj < 2; ++bj) {
                    bf16_t* zr = z + (size_t)row * 6144 + col0 + bj * HALF;
                    const u32x4 gq = *(const u32x4*)(zr + goff);
                    const f32x4 a0 = acc[ai][bj][m][0], a1 = acc[ai][bj][m][1];
                    f32x4 o0, o1;
                    o0[0] = sigm(bflo(gq.x)) * a0[0]; o0[1] = sigm(bfhi(gq.x)) * a0[1]; o0[2] = sigm(bflo(gq.y)) * a0[2]; o0[3] = sigm(bfhi(gq.y)) * a0[3];
                    o1[0] = sigm(bflo(gq.z)) * a1[0]; o1[1] = sigm(bfhi(gq.z)) * a1[1]; o1[2] = sigm(bflo(gq.w)) * a1[2]; o1[3] = sigm(bfhi(gq.w)) * a1[3];
                    if (MODE == 1) { const u32x4 p = *(const u32x4*)(zr + 1024);
                        o0[0] += bflo(p.x); o0[1] += bfhi(p.x); o0[2] += bflo(p.y); o0[3] += bfhi(p.y); o1[0] += bflo(p.z); o1[1] += bfhi(p.z); o1[2] += bflo(p.w); o1[3] += bfhi(p.w); }
                    *(u32x4*)(zr + 1024) = pack8(o0, o1);
                }
            }
    }
};
struct EpiRes {
    float* h; bf16_t* hb; float* ssq; LAS float* red;
    __device__ __forceinline__ void operator()(const f32x4 (&acc)[2][2][4][2], const Unit& u, int wr, int wc, int fr, int fq) const {
        const int row0 = u.pm * BM + wr * 64 + fr, col0 = u.pn * BM + wc * 32 + 8 * fq;
#pragma unroll
        for (int ai = 0; ai < 2; ++ai)
#pragma unroll
            for (int m = 0; m < 4; ++m) {
                const int row = row0 + ai * HALF + m * 16; float part = 0.f;
#pragma unroll
                for (int bj = 0; bj < 2; ++bj) {
                    float* hp = h + (size_t)row * 1024 + col0 + bj * HALF;
                    f32x4 h0 = *(const f32x4*)hp, h1 = *(const f32x4*)(hp + 4);
                    h0 = h0 + acc[ai][bj][m][0]; h1 = h1 + acc[ai][bj][m][1];
                    *(f32x4*)hp = h0; *(f32x4*)(hp + 4) = h1;
                    part += (h0[0] * h0[0] + h0[1] * h0[1]) + (h0[2] * h0[2] + h0[3] * h0[3]) + (h1[0] * h1[0] + h1[1] * h1[1]) + (h1[2] * h1[2] + h1[3] * h1[3]);
                    *(u32x4*)(hb + (size_t)row * 1024 + col0 + bj * HALF) = pack8(h0, h1);
                }
                part += __shfl_xor(part, 16); part += __shfl_xor(part, 32);
                if (fq == 0) red[(ai * HALF + wr * 64 + m * 16 + fr) * 4 + wc] = part;
            }
        asm volatile("s_waitcnt lgkmcnt(0)" ::: "memory");
        __builtin_amdgcn_s_barrier();
        asm volatile("" ::: "memory");
        { const int t_ = opaque_tid(); if (t_ < 256) { const f32x4 r4 = *(const LAS f32x4*)(red + t_ * 4); ssq[(size_t)(u.pm * BM + t_) * 4 + u.pn] = (r4[0] + r4[1]) + (r4[2] + r4[3]); } }
    }
};
struct EpiAct {
    bf16_t* act; const float* ssq;
    __device__ __forceinline__ void operator()(const f32x4 (&acc)[2][2][4][2], const Unit& u, int wr, int wc, int fr, int fq) const {
        const int row0 = u.pm * BM + wr * 64 + fr, col0 = u.pn * HALF + wc * 32 + 8 * fq;
#pragma unroll
        for (int ai = 0; ai < 2; ++ai)
#pragma unroll
            for (int m = 0; m < 4; ++m) {
                const int row = row0 + ai * HALF + m * 16; const float rs = row_rstd(ssq, row);
                f32x4 o[2];
#pragma unroll
                for (int n = 0; n < 2; ++n)
#pragma unroll
                    for (int i = 0; i < 4; ++i) { const float gg = acc[ai][0][m][n][i] * rs, uu = acc[ai][1][m][n][i] * rs; o[n][i] = gg * sigm(gg) * uu; }
                *(u32x4*)(act + (size_t)row * 2816 + col0) = pack8(o[0], o[1]);
            }
    }
};
struct UberEpi { int mode, i0; unsigned char *p0, *p1, *p2; };
__device__ __forceinline__ void run_epi(const UberEpi& E, LAS unsigned char* lds, const f32x4 (&acc)[2][2][4][2], const Unit& u, int wr, int wc, int fr, int fq) {
    switch (E.mode) {
        case 0: { EpiZ e{(bf16_t*)E.p0, (const float*)E.p1, (bf16_t*)E.p2, E.i0}; e(acc, u, wr, wc, fr, fq); break; }
        case 1: { EpiGlu e{(bf16_t*)E.p0}; e(acc, u, wr, wc, fr, fq); break; }
        case 2: { EpiMix<0> e{(bf16_t*)E.p0, E.i0}; e(acc, u, wr, wc, fr, fq); break; }
        case 3: { EpiMix<1> e{(bf16_t*)E.p0, E.i0}; e(acc, u, wr, wc, fr, fq); break; }
        case 4: { EpiRes e{(float*)E.p0, (bf16_t*)E.p1, (float*)E.p2, (LAS float*)(lds + 131072)}; e(acc, u, wr, wc, fr, fq); break; }
        default: { EpiAct e{(bf16_t*)E.p0, (const float*)E.p1}; e(acc, u, wr, wc, fr, fq); break; }
    }
}
}

constexpr int NLAYER = 4, DM = 1024, ZW = 6144, FFH = 2816, RG = 16384, RMAIN = 65536;
constexpr size_t al256(size_t x) { return (x + 255) & ~(size_t)255; }
constexpr size_t WS_HB = 0;
constexpr size_t WS_SSQ = WS_HB + (size_t)RMAIN * DM * 2;
constexpr size_t WS_Z = WS_SSQ + (size_t)RMAIN * 4 * 4;
constexpr size_t WS_YB = WS_Z + (size_t)RG * ZW * 2;
constexpr size_t WS_VT = WS_YB + (size_t)RG * 512 * 2;
constexpr size_t WS_HGU = WS_VT + (size_t)512 * RG * 2;
constexpr size_t WS_HGP = WS_HGU + (size_t)260 * 8 * 4096 * 4;
constexpr size_t WS_S5S = WS_HGP + (size_t)260 * 8 * 64 * 4;
constexpr size_t WS_W = WS_S5S + (size_t)260 * 2048 * 8;
constexpr size_t W_IN = 0, W_UPA = W_IN + (size_t)6144 * 1024 * 2, W_UPB = W_UPA + (size_t)1024 * 256 * 2, W_UPC = W_UPB + (size_t)1024 * 512 * 2,
                 W_O = W_UPC + (size_t)1024 * 256 * 2, W_GU = W_O + (size_t)1024 * 1024 * 2, W_DN = W_GU + (size_t)5632 * 1024 * 2, W_GLU = W_DN + (size_t)1024 * 2816 * 2,
                 W_END = W_GLU + (size_t)256 * 256 * 2;
constexpr size_t WS_TAB = WS_W + W_END;
constexpr size_t T_LBAR = 0, T_L16 = T_LBAR + 2048 * 8, T_L64 = T_L16 + 2048 * 8, T_BFRAG = T_L64 + 2048 * 8, T_CFRAG = T_BFRAG + (size_t)32 * 8 * 64 * 16,
                 T_LB = T_CFRAG + (size_t)32 * 4 * 64 * 16, T_END = T_LB + 256 * 4;
constexpr size_t WS_META = al256(WS_TAB + T_END);
constexpr size_t M_H = 0, M_HB = M_H + (size_t)256 * 1024 * 4, M_SSQ = M_HB + (size_t)256 * 1024 * 2, M_Z = M_SSQ + (size_t)256 * 4 * 4, M_YB = M_Z + (size_t)256 * ZW * 2,
                 M_VT = M_YB + (size_t)256 * 512 * 2, M_ACT = M_VT + (size_t)512 * 256 * 2, M_END = M_ACT + (size_t)256 * FFH * 2;
constexpr size_t WS_CTL = al256(WS_META + M_END);
constexpr size_t CTL_BYTES = 16384;
constexpr size_t WS_TOTAL = WS_CTL + CTL_BYTES;
constexpr int LDS_ST_OFF = 135168;
constexpr int LDS_BYTES = 147456;

struct Args {
    const float *x_prompt, *x_sample, *meta_tokens, *norm1_g, *w_in, *a_re, *a_im, *log_dt, *b_re, *b_im, *c_re, *c_im, *s5_d, *w_glu, *rpb, *lb_logits, *onorm_g,
        *w_up_a, *w_up_b, *w_up_c, *w_o, *norm2_g, *w_gate, *w_up, *w_down, *final_g;
    float* out; unsigned char* ws;
};

__device__ __forceinline__ unsigned long long ufl(unsigned long long v) { const unsigned lo = __builtin_amdgcn_readfirstlane((unsigned)v), hi = __builtin_amdgcn_readfirstlane((unsigned)(v >> 32)); return ((unsigned long long)hi << 32) | lo; }
#define KA(f) ((decltype(Args::f))ufl((unsigned long long)(((const volatile Args*)__builtin_amdgcn_kernarg_segment_ptr())->f)))
#define KAF(f) ((const float*)KA(f))
struct Ctx {
    bf16_t *hb, *z, *yb, *vt; float *ssq, *hgu, *hgp, *s5s;
    bf16_t *w; const float *lbar, *l16, *l64; const bf16_t *bfrag, *cfrag; const float* lb;
    float* mh; bf16_t *mhb, *mz, *myb, *mvt, *mact; float* mssq;
};

__device__ __forceinline__ void tr_item(const float* W, int K, int N, bf16_t* WT, const float* kscale, int mode, LAS float* scr, int item, int lane, bool valid) {
    const int nblk = N / 32, kb = item / nblk, nb = item % nblk, k0 = 64 * kb, n0 = 32 * nb;
    if (valid) {
#pragma unroll 8
    for (int i = 0; i < 32; ++i) { const int kk = 2 * i + (lane >> 5); float v = W[(size_t)(k0 + kk) * N + n0 + (lane & 31)]; if (kscale) v *= kscale[k0 + kk]; scr[kk * 33 + (lane & 31)] = v; }
    }
    __syncthreads();
    const int c = lane & 7;
    int drow0 = n0; if (mode) drow0 = (n0 >> 7) * 256 + (n0 & 127) + (mode == 2 ? 128 : 0);
    if (valid) {
#pragma unroll
    for (int j = 0; j < 4; ++j) { const int n = (lane >> 3) + 8 * j; const LAS float* s = scr + (8 * c) * 33 + n;
        u32x4 o; o.x = pk2(s[0 * 33], s[1 * 33]); o.y = pk2(s[2 * 33], s[3 * 33]); o.z = pk2(s[4 * 33], s[5 * 33]); o.w = pk2(s[6 * 33], s[7 * 33]);
        *(u32x4*)(WT + (size_t)(drow0 + n) * K + k0 + 8 * c) = o; }
    }
    __syncthreads();
}

__device__ __forceinline__ void prep_layer(const Ctx& X, int l, LAS unsigned char* lds, int G) {
    const int tid_ = opaque_tid(); const int wave = __builtin_amdgcn_readfirstlane(tid_ >> 6), lane = tid_ & 63;
    LAS float* scr = (LAS float*)(lds + wave * 16384);
    const int gw = blockIdx.x * 8 + wave, NGW = G * 8;
    constexpr int I0 = 16 * 192, I1 = 4 * 32, I2 = 8 * 32, I3 = 4 * 32, I4 = 16 * 32, I5 = 16 * 88, I6 = 16 * 88, I7 = 44 * 32, I8 = 4 * 8;
    constexpr int NIT = I0 + I1 + I2 + I3 + I4 + I5 + I6 + I7 + I8;
    unsigned char* wb = (unsigned char*)X.w;
    for (int it0 = 0; it0 < NIT; it0 += NGW) {
        const int it = it0 + gw; const bool valid = it < NIT;
        int r = valid ? it : 0;
        if (r < I0) { tr_item(KAF(w_in) + (size_t)l * 1024 * 6144, 1024, 6144, (bf16_t*)(wb + W_IN), KAF(norm1_g) + l * 1024, 0, scr, r, lane, valid); continue; } r -= I0;
        if (r < I1) { tr_item(KAF(w_up_a) + (size_t)l * 256 * 1024, 256, 1024, (bf16_t*)(wb + W_UPA), nullptr, 0, scr, r, lane, valid); continue; } r -= I1;
        if (r < I2) { tr_item(KAF(w_up_b) + (size_t)l * 512 * 1024, 512, 1024, (bf16_t*)(wb + W_UPB), nullptr, 0, scr, r, lane, valid); continue; } r -= I2;
        if (r < I3) { tr_item(KAF(w_up_c) + (size_t)l * 256 * 1024, 256, 1024, (bf16_t*)(wb + W_UPC), nullptr, 0, scr, r, lane, valid); continue; } r -= I3;
        if (r < I4) { tr_item(KAF(w_o) + (size_t)l * 1024 * 1024, 1024, 1024, (bf16_t*)(wb + W_O), nullptr, 0, scr, r, lane, valid); continue; } r -= I4;
        if (r < I5) { tr_item(KAF(w_gate) + (size_t)l * 1024 * 2816, 1024, 2816, (bf16_t*)(wb + W_GU), KAF(norm2_g) + l * 1024, 1, scr, r, lane, valid); continue; } r -= I5;
        if (r < I6) { tr_item(KAF(w_up) + (size_t)l * 1024 * 2816, 1024, 2816, (bf16_t*)(wb + W_GU), KAF(norm2_g) + l * 1024, 2, scr, r, lane, valid); continue; } r -= I6;
        if (r < I7) { tr_item(KAF(w_down) + (size_t)l * 2816 * 1024, 2816, 1024, (bf16_t*)(wb + W_DN), nullptr, 0, scr, r, lane, valid); continue; } r -= I7;
        tr_item(KAF(w_glu) + (size_t)l * 256 * 256, 256, 256, (bf16_t*)(wb + W_GLU), nullptr, 0, scr, r, lane, valid);
    }
    const int gt = blockIdx.x * 512 + tid_;
    if (gt < 2048) {
        const int dg = gt >> 6, p = gt & 63;
        const size_t pb = ((size_t)l * 32 + dg);
        const float are = KAF(a_re)[pb * 64 + p], aim = KAF(a_im)[pb * 64 + p], dt = expf(KAF(log_dt)[pb]);
        const float mag = expf(are * dt); float sn, cs; sincosf(aim * dt, &sn, &cs);
        const float lr = mag * cs, li = mag * sn;
        const float den = are * are + aim * aim, nr = lr - 1.0f, ni = li;
        const float zr = (nr * are + ni * aim) / den, zi = (ni * are - nr * aim) / den;
        float* lbar = (float*)X.lbar; float* l16 = (float*)X.l16; float* l64 = (float*)X.l64;
        lbar[gt * 2] = lr; lbar[gt * 2 + 1] = li;
        float pr = lr, pi = li;
#pragma unroll
        for (int s = 0; s < 4; ++s) { const float t = pr * pr - pi * pi; pi = 2.f * pr * pi; pr = t; }
        l16[gt * 2] = pr; l16[gt * 2 + 1] = pi;
#pragma unroll
        for (int s = 0; s < 2; ++s) { const float t = pr * pr - pi * pi; pi = 2.f * pr * pi; pr = t; }
        l64[gt * 2] = pr; l64[gt * 2 + 1] = pi;
        bf16_t* bfr = (bf16_t*)X.bfrag; bf16_t* cfr = (bf16_t*)X.cfrag;
        const int ntr = p >> 4, col = p & 15;
        for (int c = 0; c < 16; ++c) {
            const float br = KAF(b_re)[(pb * 64 + p) * 16 + c], bi = KAF(b_im)[(pb * 64 + p) * 16 + c];
            const float bbr = zr * br - zi * bi, bbi = zr * bi + zi * br;
            const int q = c >> 3, j = c & 7;
            bfr[(((size_t)dg * 8 + ntr) * 64 + col + 16 * q) * 8 + j] = (bf16_t)f2bf(bbr);
            bfr[(((size_t)dg * 8 + 4 + ntr) * 64 + col + 16 * q) * 8 + j] = (bf16_t)f2bf(bbi);
            bfr[(((size_t)dg * 8 + ntr) * 64 + col + 16 * (q + 2)) * 8 + j] = 0;
            bfr[(((size_t)dg * 8 + 4 + ntr) * 64 + col + 16 * (q + 2)) * 8 + j] = 0;
            const float cr = KAF(c_re)[(pb * 16 + c) * 64 + p], ci = KAF(c_im)[(pb * 16 + c) * 64 + p];
            { const int k = p;      cfr[(((size_t)dg * 4 + (k >> 5)) * 64 + c + 16 * ((k >> 3) & 3)) * 8 + (k & 7)] = (bf16_t)f2bf(cr); }
            { const int k = 64 + p; cfr[(((size_t)dg * 4 + (k >> 5)) * 64 + c + 16 * ((k >> 3) & 3)) * 8 + (k & 7)] = (bf16_t)f2bf(-ci); }
        }
    }
    if (gt >= 2048 && gt < 2048 + 256) {
        const int c = gt - 2048;
        const float l0 = KAF(lb_logits)[c], l1 = KAF(lb_logits)[256 + c], l2 = KAF(lb_logits)[512 + c], l3 = KAF(lb_logits)[768 + c];
        const float mx = fmaxf(fmaxf(l0, l1), fmaxf(l2, l3));
        const float e0 = expf(l0 - mx), e1 = expf(l1 - mx), e2 = expf(l2 - mx), e3 = expf(l3 - mx), inv = 1.f / (e0 + e1 + e2 + e3);
        float v = 0.f; if (l >= 1) v += e1 * inv; if (l >= 2) v += e2 * inv; if (l >= 3) v += e3 * inv;
        ((float*)X.lb)[c] = v;
    }
}

struct Grp { int g, nseq, Lr, nch, s0; };
__device__ __forceinline__ Grp make_grp(int g) { Grp r; r.g = g; r.nseq = g < 2 ? 4 : 1; r.Lr = g < 2 ? 4096 : 16384; r.nch = r.Lr / 64 + 1; r.s0 = g < 2 ? g * 4 : 8 + (g - 2); return r; }

template <bool OUT>
__device__ __forceinline__ void s5_chunk(const Ctx& X, const float* s5d, LAS float* buf, bf16_t* zc, int T, int ci, int wave, int lane) {
    const int p = lane, fr = lane & 15, fq = lane >> 4;
    for (int gi = 0; gi < 2; ++gi) {
        const int g = wave * 2 + gi;
        f32x4 yacc[2][2];
#pragma unroll
        for (int i = 0; i < 2; ++i)
#pragma unroll
            for (int j = 0; j < 2; ++j) yacc[i][j] = (f32x4){0.f, 0.f, 0.f, 0.f};
#pragma unroll
        for (int dir = 0; dir < 2; ++dir) {
            const int dg = dir * 16 + g;
            const float lr = X.lbar[(dg * 64 + p) * 2], li = X.lbar[(dg * 64 + p) * 2 + 1];
            float xr = 0.f, xi = 0.f;
            float* st = X.s5s + ((size_t)ci * 2048 + dg * 64 + p) * 2;
            if (OUT) { xr = st[0]; xi = st[1]; }
#pragma unroll
            for (int sti = 0; sti < 2; ++sti) {
                const int stt = dir ? 1 - sti : sti; const int t0 = stt * 32;
                if (t0 < T) {
                    const int tn = (T - t0) < 32 ? (T - t0) : 32;
#pragma unroll
                    for (int mt = 0; mt < 2; ++mt) {
                        if (mt * 16 < tn) {
                            bf16x8 av = (bf16x8){0, 0, 0, 0, 0, 0, 0, 0};
                            if (fq < 2) av = *(const bf16x8*)(zc + (size_t)(t0 + mt * 16 + fr) * ZW + g * 16 + fq * 8);
#pragma unroll
                            for (int nt = 0; nt < 8; ++nt) {
                                const bf16x8 bv = *(const bf16x8*)(X.bfrag + (((size_t)dg * 8 + nt) * 64 + lane) * 8);
                                const f32x4 c = __builtin_amdgcn_mfma_f32_16x16x32_bf16(av, bv, (f32x4){0.f, 0.f, 0.f, 0.f}, 0, 0, 0);
#pragma unroll
                                for (int r = 0; r < 4; ++r) buf[(mt * 16 + fq * 4 + r) * 132 + nt * 16 + fr] = c[r];
                            }
                        }
                    }
                    __syncthreads();
                    for (int k = 0; k < tn; ++k) {
                        const int t = dir ? (tn - 1 - k) : k;
                        const float br = buf[t * 132 + p], bi = buf[t * 132 + 64 + p];
                        const float nr = lr * xr - li * xi + br, ni = lr * xi + li * xr + bi;
                        xr = nr; xi = ni;
                        if (OUT) { buf[t * 132 + p] = xr; buf[t * 132 + 64 + p] = xi; }
                    }
                    if (OUT) {
                        __syncthreads();
#pragma unroll
                        for (int mt = 0; mt < 2; ++mt) {
                            if (mt * 16 < tn) {
#pragma unroll
                                for (int ks = 0; ks < 4; ++ks) {
                                    const LAS float* ap = buf + (mt * 16 + fr) * 132 + ks * 32 + fq * 8;
                                    const f32x4 a0 = *(const LAS f32x4*)ap, a1 = *(const LAS f32x4*)(ap + 4);
                                    const u32x4 aw = pack8(a0, a1);
                                    const bf16x8 av = __builtin_bit_cast(bf16x8, aw);
                                    const bf16x8 bv = *(const bf16x8*)(X.cfrag + (((size_t)dg * 4 + ks) * 64 + lane) * 8);
                                    yacc[stt][mt] = __builtin_amdgcn_mfma_f32_16x16x32_bf16(av, bv, yacc[stt][mt], 0, 0, 0);
                                }
                            }
                        }
                    }
                    __syncthreads();
                }
            }
            if (!OUT) { st[0] = xr; st[1] = xi; }
        }
        if (OUT) {
            const float dsk = s5d[g * 16 + fr];
#pragma unroll
            for (int stt = 0; stt < 2; ++stt)
#pragma unroll
                for (int mt = 0; mt < 2; ++mt) {
                    if (stt * 32 + mt * 16 < T) {
#pragma unroll
                        for (int r = 0; r < 4; ++r) {
                            const int t = stt * 32 + mt * 16 + fq * 4 + r;
                            bf16_t* zr = zc + (size_t)t * ZW;
                            const float u = bf2f(zr[g * 16 + fr]);
                            const float y = gelu_tanh(yacc[stt][mt][r] + dsk * u);
                            zr[512 + g * 16 + fr] = (bf16_t)f2bf(y);
                        }
                    }
                }
        }
    }
}

__device__ __forceinline__ void s5_passB(const Ctx& X, const Grp& gp, int gtid, int GT) {
    const int n = gp.nseq * 2048;
    for (int e = gtid; e < n; e += GT) {
        const int sl = e >> 11, r = e & 2047, dir = r >> 10;
        const float l16r = X.l16[r * 2], l16i = X.l16[r * 2 + 1], l64r = X.l64[r * 2], l64i = X.l64[r * 2 + 1];
        float sr = 0.f, si = 0.f;
        for (int k0 = 0; k0 < gp.nch; k0 += 8) {
            float er[8], ei[8];
#pragma unroll
            for (int j = 0; j < 8; ++j) { const int k = k0 + j; if (k < gp.nch) { const int c = dir ? gp.nch - 1 - k : k; const float* pp = X.s5s + ((size_t)(sl * gp.nch + c) * 2048 + r) * 2; er[j] = pp[0]; ei[j] = pp[1]; } else { er[j] = 0.f; ei[j] = 0.f; } }
#pragma unroll
            for (int j = 0; j < 8; ++j) { const int k = k0 + j; if (k < gp.nch) { const int c = dir ? gp.nch - 1 - k : k; float* pp = X.s5s + ((size_t)(sl * gp.nch + c) * 2048 + r) * 2; pp[0] = sr; pp[1] = si;
                    const float pr = c == 0 ? l16r : l64r, pi = c == 0 ? l16i : l64i;
                    const float nr = pr * sr - pi * si + er[j], ni = pr * si + pi * sr + ei[j]; sr = nr; si = ni; } }
        }
    }
}

template <bool OUT>
__device__ __forceinline__ void hg_chunk(const Ctx& X, LAS float* gt, LAS bf16_t* ot, const bf16_t* zc, int T, int ci, int wave, int lane) {
    const int h = wave >> 1, dir = wave & 1;
    float S[64];
    float* U = X.hgu + ((size_t)ci * 8 + wave) * 4096;
    if (OUT) {
#pragma unroll
        for (int d = 0; d < 64; ++d) S[d] = U[d * 64 + lane];
    } else {
#pragma unroll
        for (int d = 0; d < 64; ++d) S[d] = 0.f;
    }
    const float lbv = X.lb[h * 64 + lane], oml = 1.f - lbv; float P = 1.f;
    const int fcol = (dir ? 2304 : 2048) + h * 64 + lane, qcol = 1792 + h * 64 + lane, vcol = 2560 + h * 64 + lane;
    const int ns8 = T >> 3;
#pragma unroll 1
    for (int s8 = 0; s8 < ns8; ++s8) {
        const int sb = dir ? (ns8 - 1 - s8) : s8;
#pragma unroll
        for (int j = 0; j < 8; ++j) {
            const bf16_t* zr = zc + (size_t)(sb * 8 + j) * ZW;
            const float q = bf2f(zr[qcol]), ff = bf2f(zr[fcol]);
            const float sg = sigm(ff), fg = lbv + oml * sg, kk = oml * (1.f - sg);
            gt[j * 256 + lane] = fg; gt[j * 256 + 64 + lane] = kk; gt[j * 256 + 128 + lane] = q * sigm(q); gt[j * 256 + 192 + lane] = bf2f(zr[vcol]);
            P *= fg;
        }
        __syncthreads();
#pragma unroll 1
        for (int jj = 0; jj < 8; ++jj) {
            const int j = dir ? 7 - jj : jj;
            const LAS float* gj = gt + j * 256;
            const float v = gj[192 + lane];
            float o = 0.f;
#pragma unroll
            for (int d4 = 0; d4 < 16; ++d4) {
                const f32x4 f4 = *(const LAS f32x4*)(gj + d4 * 4), k4 = *(const LAS f32x4*)(gj + 64 + d4 * 4);
#pragma unroll
                for (int i = 0; i < 4; ++i) S[d4 * 4 + i] = f4[i] * S[d4 * 4 + i] + k4[i] * v;
                if (OUT) { const f32x4 q4 = *(const LAS f32x4*)(gj + 128 + d4 * 4);
#pragma unroll
                    for (int i = 0; i < 4; ++i) o += S[d4 * 4 + i] * q4[i]; }
                if ((d4 & 3) == 3) __builtin_amdgcn_sched_barrier(0);
            }
            if (OUT) ot[(sb * 8 + j) * 64 + lane] = (bf16_t)f2bf(o);
        }
        __syncthreads();
    }
    if (!OUT) {
#pragma unroll
        for (int d = 0; d < 64; ++d) U[d * 64 + lane] = S[d];
        X.hgp[((size_t)ci * 8 + wave) * 64 + lane] = P;
    }
}

__device__ __forceinline__ void hg_passB(const Ctx& X, const Grp& gp, int gtid, int GT) {
    const int n = gp.nseq * 32768;
    for (int e = gtid; e < n; e += GT) {
        const int sl = e >> 15, r = e & 32767, hd = r >> 12, de = r & 4095, d = de >> 6, dir = hd & 1;
        float s = 0.f;
        for (int k0 = 0; k0 < gp.nch; k0 += 8) {
            float u[8], pv[8];
#pragma unroll
            for (int j = 0; j < 8; ++j) { const int k = k0 + j; if (k < gp.nch) { const int c = dir ? gp.nch - 1 - k : k; const size_t cb = (size_t)(sl * gp.nch + c) * 8 + hd; u[j] = X.hgu[cb * 4096 + de]; pv[j] = X.hgp[cb * 64 + d]; } else { u[j] = 0.f; pv[j] = 0.f; } }
#pragma unroll
            for (int j = 0; j < 8; ++j) { const int k = k0 + j; if (k < gp.nch) { const int c = dir ? gp.nch - 1 - k : k; const size_t cb = (size_t)(sl * gp.nch + c) * 8 + hd; X.hgu[cb * 4096 + de] = s; s = pv[j] * s + u[j]; } }
        }
    }
}

__device__ __forceinline__ void na_task(const Ctx& X, const float* rpb, const Grp& gp, int sl, int task, bool metaq, int wave, int lane) {
    const int h = wave, fr = lane & 15, fq = lane >> 4;
    const int s = gp.s0 + sl, rows = gp.Lr >> 6;
    int r = 0, n = 0, rs = 0, ks = 0;
    const bf16_t* qptr; bf16_t* optr; size_t ostride = 512;
    if (metaq) { qptr = X.mz + (size_t)(s * 16 + fr) * ZW; optr = X.myb + (size_t)(s * 16) * 512; }
    else {
        r = task >> 2; n = task & 3;
        rs = r - 4; rs = rs < 0 ? 0 : (rs > rows - 8 ? rows - 8 : rs);
        ks = 16 * n - 8; ks = ks < 0 ? 0 : (ks > 32 ? 32 : ks);
        const size_t qrow0 = (size_t)sl * gp.Lr + r * 64 + 16 * n;
        qptr = X.z + (qrow0 + fr) * ZW; optr = X.yb + qrow0 * 512;
    }
    bf16x8 qf[2];
#pragma unroll
    for (int kk = 0; kk < 2; ++kk) qf[kk] = *(const bf16x8*)(qptr + 256 + h * 64 + 32 * kk + 8 * fq);
    f32x4 sc[17];
    {
        const bf16_t* kp = X.mz + (size_t)(s * 16 + fr) * ZW + 768 + h * 64 + 8 * fq;
        f32x4 c = (f32x4){0.f, 0.f, 0.f, 0.f};
#pragma unroll
        for (int kk = 0; kk < 2; ++kk) c = __builtin_amdgcn_mfma_f32_16x16x32_bf16(*(const bf16x8*)(kp + 32 * kk), qf[kk], c, 0, 0, 0);
        sc[0] = c * 0.125f;
    }
    const int qc = 16 * n + fr;
    int wstart = qc - 8; wstart = wstart < 0 ? 0 : (wstart > 48 ? 48 : wstart);
    const size_t krow_base = (size_t)sl * gp.Lr + (size_t)rs * 64 + ks;
    if (!metaq) {
#pragma unroll
        for (int tb = 0; tb < 4; ++tb) {
            bf16x8 kf[4][2]; float bz[4][4];
#pragma unroll
            for (int t4 = 0; t4 < 4; ++t4) {
                const int tt = tb * 4 + t4, kj = tt >> 1, half = tt & 1;
                const bf16_t* kp = X.z + (krow_base + kj * 64 + 16 * half + fr) * ZW + 768 + h * 64 + 8 * fq;
                kf[t4][0] = *(const bf16x8*)kp; kf[t4][1] = *(const bf16x8*)(kp + 32);
            }
#pragma unroll
            for (int t4 = 0; t4 < 4; ++t4) {
                const int tt = tb * 4 + t4, kj = tt >> 1, half = tt & 1;
                const float* rp = rpb + (h * 15 + (rs + kj - r + 7)) * 31;
#pragma unroll
                for (int i = 0; i < 4; ++i) { int dc = ks + 16 * half + 4 * fq + i - qc; dc = dc < -15 ? -15 : (dc > 15 ? 15 : dc); bz[t4][i] = rp[dc + 15]; }
            }
#pragma unroll
            for (int t4 = 0; t4 < 4; ++t4) {
                const int tt = tb * 4 + t4, half = tt & 1;
                f32x4 c = (f32x4){0.f, 0.f, 0.f, 0.f};
                c = __builtin_amdgcn_mfma_f32_16x16x32_bf16(kf[t4][0], qf[0], c, 0, 0, 0);
                c = __builtin_amdgcn_mfma_f32_16x16x32_bf16(kf[t4][1], qf[1], c, 0, 0, 0);
#pragma unroll
                for (int i = 0; i < 4; ++i) {
                    const int kc = ks + 16 * half + 4 * fq + i;
                    const bool valid = (kc >= wstart) && (kc < wstart + 16);
                    c[i] = valid ? c[i] * 0.125f + bz[t4][i] : -1e30f;
                }
                sc[1 + tt] = c;
            }
            __builtin_amdgcn_sched_barrier(0);
        }
    } else {
#pragma unroll
        for (int tt = 0; tt < 16; ++tt) sc[1 + tt] = (f32x4){-1e30f, -1e30f, -1e30f, -1e30f};
    }
    float mx = -1e30f;
#pragma unroll
    for (int t = 0; t < 17; ++t)
#pragma unroll
        for (int i = 0; i < 4; ++i) mx = fmaxf(mx, sc[t][i]);
    mx = fmaxf(mx, __shfl_xor(mx, 16)); mx = fmaxf(mx, __shfl_xor(mx, 32));
    float sum = 0.f;
#pragma unroll
    for (int t = 0; t < 17; ++t)
#pragma unroll
        for (int i = 0; i < 4; ++i) { const float e = __expf(sc[t][i] - mx); sc[t][i] = e; sum += e; }
    sum += __shfl_xor(sum, 16); sum += __shfl_xor(sum, 32);
    const float inv = 1.f / sum;
    f32x4 oacc[4];
#pragma unroll
    for (int et = 0; et < 4; ++et) oacc[et] = (f32x4){0.f, 0.f, 0.f, 0.f};
#pragma unroll
    for (int kb = 0; kb < 3; ++kb) {
        if (kb > 0 && metaq) break;
        u32x2 va[3][4], vb[3][4];
#pragma unroll
        for (int k3 = 0; k3 < 3; ++k3) {
            const int kst = kb * 3 + k3, ta = 2 * kst, tb = 2 * kst + 1;
#pragma unroll
            for (int et = 0; et < 4; ++et) {
                const int e = h * 64 + et * 16 + fr;
                va[k3][et] = (u32x2){0u, 0u}; vb[k3][et] = (u32x2){0u, 0u};
                if (ta == 0) va[k3][et] = *(const u32x2*)(X.mvt + (size_t)e * 256 + s * 16 + 4 * fq);
                else if (!metaq) { const int tt = ta - 1; va[k3][et] = *(const u32x2*)(X.vt + (size_t)e * RG + krow_base + (tt >> 1) * 64 + 16 * (tt & 1) + 4 * fq); }
                if (tb < 17 && !metaq) { const int tt = tb - 1; vb[k3][et] = *(const u32x2*)(X.vt + (size_t)e * RG + krow_base + (tt >> 1) * 64 + 16 * (tt & 1) + 4 * fq); }
            }
        }
#pragma unroll
        for (int k3 = 0; k3 < 3; ++k3) {
            const int kst = kb * 3 + k3, ta = 2 * kst, tb = 2 * kst + 1;
            f32x4 pa = sc[ta] * inv, pb = (f32x4){0.f, 0.f, 0.f, 0.f};
            if (tb < 17) pb = sc[tb] * inv;
            const bf16x8 pf = __builtin_bit_cast(bf16x8, pack8(pa, pb));
#pragma unroll
            for (int et = 0; et < 4; ++et) {
                const u32x4 vw = (u32x4){va[k3][et].x, va[k3][et].y, vb[k3][et].x, vb[k3][et].y};
                oacc[et] = __builtin_amdgcn_mfma_f32_16x16x32_bf16(pf, __builtin_bit_cast(bf16x8, vw), oacc[et], 0, 0, 0);
            }
        }
        __builtin_amdgcn_sched_barrier(0);
    }
#pragma unroll
    for (int et = 0; et < 4; ++et)
#pragma unroll
        for (int i = 0; i < 4; ++i) optr[(size_t)(4 * fq + i) * ostride + h * 64 + et * 16 + fr] = (bf16_t)f2bf(oacc[et][i]);
}

#define XB_TMO      128
#define XB_XCNT(j)  (256  + 64 * (j))
#define XB_XSUB(j)  (1280 + 64 * (j))
#define XB_XGEN(j)  (2304 + 64 * (j))
#define XB_TOP      3328
#define XB_TOPGEN   3392
#define XCD_BAR_WORDS 3456
#define XB_SPIN_CAP (1u << 22)
__device__ __forceinline__ unsigned xb_ld(unsigned* p)              { return __hip_atomic_load(p, __ATOMIC_RELAXED, __HIP_MEMORY_SCOPE_AGENT); }
__device__ __forceinline__ unsigned xb_add(unsigned* p, unsigned v) { return __hip_atomic_fetch_add(p, v, __ATOMIC_RELAXED, __HIP_MEMORY_SCOPE_AGENT); }
__device__ __forceinline__ unsigned xb_xcc_id() { return (unsigned)__builtin_amdgcn_s_getreg((3 << 11) | 20) & 0xFu; }
#define XB_SPIN(cond, bar) do { unsigned _sp = 0; while (cond) { __builtin_amdgcn_s_sleep(1); \
    if ((++_sp & 255u) == 0u) { if (xb_ld(&(bar)[XB_TMO])) break; if (_sp > XB_SPIN_CAP) { atomicAdd(&(bar)[XB_TMO], 1u); break; } } } } while (0)
__device__ __forceinline__ void xcd_barrier_complete(unsigned* bar, unsigned x, unsigned& nloc, unsigned& nx) {
    const unsigned G = gridDim.x * gridDim.y * gridDim.z;
    unsigned sum, cnt, mine, sp = 0u;
    for (;;) {
        sum = 0u; cnt = 0u; mine = 0u;
#pragma unroll
        for (unsigned j = 0; j < 16; ++j) { const unsigned c = xb_ld(&bar[XB_XCNT(j)]); sum += c; cnt += (c > 0u) ? 1u : 0u; mine = (j == x) ? c : mine; }
        if (sum == G) break;
        __builtin_amdgcn_s_sleep(1);
        if ((++sp & 255u) == 0u) { if (xb_ld(&bar[XB_TMO])) break; if (sp > XB_SPIN_CAP) { atomicAdd(&bar[XB_TMO], 1u); break; } }
    }
    nloc = mine > 0u ? mine : 1u; nx = cnt > 0u ? cnt : 1u;
}
__device__ __forceinline__ void xcd_barrier(unsigned* bar, volatile LAS unsigned* st) {
    asm volatile("s_waitcnt vmcnt(0)" ::: "memory");
    __syncthreads();
    if (threadIdx.x == 0) {
        const unsigned x = xb_xcc_id();
        __builtin_amdgcn_s_waitcnt(0);
        unsigned nloc = st[0], nx = st[1];
        if (nloc == 0u) { xcd_barrier_complete(bar, x, nloc, nx); st[0] = nloc; st[1] = nx; }
        const unsigned old = xb_add(&bar[XB_XSUB(x)], 1u);
        const unsigned gen = old / nloc;
        if (old + 1u == (gen + 1u) * nloc) {
            __builtin_amdgcn_fence(__ATOMIC_RELEASE, "agent");
            asm volatile("s_waitcnt vmcnt(0)" ::: "memory");
            const unsigned og = xb_add(&bar[XB_TOP], 1u);
            const unsigned tg = og / nx;
            if (og + 1u == (tg + 1u) * nx) xb_add(&bar[XB_TOPGEN], 1u);
            else XB_SPIN(xb_ld(&bar[XB_TOPGEN]) == tg, bar);
            __builtin_amdgcn_fence(__ATOMIC_ACQUIRE, "agent");
            xb_add(&bar[XB_XGEN(x)], 1u);
            asm volatile("s_waitcnt vmcnt(0)" ::: "memory");
        } else {
            XB_SPIN(xb_ld(&bar[XB_XGEN(x)]) == gen, bar);
            __builtin_amdgcn_fence(__ATOMIC_ACQUIRE, "agent");
            asm volatile("s_waitcnt vmcnt(0)" ::: "memory");
        }
    }
    __syncthreads();
}
#define GRID_SYNC() xcd_barrier((unsigned*)(KA(ws) + WS_CTL), (volatile LAS unsigned*)(lds + LDS_ST_OFF))
__device__ __forceinline__ Ctx make_ctx(unsigned char* ws) {
    Ctx X;
    X.hb = (bf16_t*)(ws + WS_HB); X.ssq = (float*)(ws + WS_SSQ); X.z = (bf16_t*)(ws + WS_Z); X.yb = (bf16_t*)(ws + WS_YB); X.vt = (bf16_t*)(ws + WS_VT);
    X.hgu = (float*)(ws + WS_HGU); X.hgp = (float*)(ws + WS_HGP); X.s5s = (float*)(ws + WS_S5S); X.w = (bf16_t*)(ws + WS_W);
    X.lbar = (const float*)(ws + WS_TAB + T_LBAR); X.l16 = (const float*)(ws + WS_TAB + T_L16); X.l64 = (const float*)(ws + WS_TAB + T_L64);
    X.bfrag = (const bf16_t*)(ws + WS_TAB + T_BFRAG); X.cfrag = (const bf16_t*)(ws + WS_TAB + T_CFRAG); X.lb = (const float*)(ws + WS_TAB + T_LB);
    X.mh = (float*)(ws + WS_META + M_H); X.mhb = (bf16_t*)(ws + WS_META + M_HB); X.mssq = (float*)(ws + WS_META + M_SSQ); X.mz = (bf16_t*)(ws + WS_META + M_Z);
    X.myb = (bf16_t*)(ws + WS_META + M_YB); X.mvt = (bf16_t*)(ws + WS_META + M_VT); X.mact = (bf16_t*)(ws + WS_META + M_ACT);
    return X;
}

__device__ __forceinline__ bool make_job(unsigned char* ws, float* out, int l, int g, int ph, int j, pg8::Gemm& gm, pg8::UberEpi& ep) {
    const bool mchain = (g == 3) && (l < NLAYER - 1);
    int njobs = 1; bool meta = false; int sub = j;
    if (ph == 0) { njobs = (g == 0) ? 2 : 1; meta = (j == 1); }
    else if (ph == 4) { njobs = (g == 3) ? 2 : 1; meta = (j == 1); }
    else if (ph == 5) { njobs = mchain ? 6 : 3; meta = (j >= 3); sub = j % 3; }
    else { njobs = mchain ? 2 : 1; meta = (j == 1); }
    if (j >= njobs) return false;
    unsigned char* wb = ws + WS_W;
    const size_t r0 = (size_t)g * RG;
    unsigned char* mb = ws + WS_META;
    bf16_t* z = meta ? (bf16_t*)(mb + M_Z) : (bf16_t*)(ws + WS_Z);
    bf16_t* hb = meta ? (bf16_t*)(mb + M_HB) : (bf16_t*)(ws + WS_HB) + r0 * DM;
    float* ssq = meta ? (float*)(mb + M_SSQ) : (float*)(ws + WS_SSQ) + r0 * 4;
    float* h = meta ? (float*)(mb + M_H) : out + r0 * DM;
    bf16_t* yb = meta ? (bf16_t*)(mb + M_YB) : (bf16_t*)(ws + WS_YB);
    bf16_t* vt = meta ? (bf16_t*)(mb + M_VT) : (bf16_t*)(ws + WS_VT);
    bf16_t* act = meta ? (bf16_t*)(mb + M_ACT) : (bf16_t*)(ws + WS_Z);
    gm.M = meta ? 256 : RG;
    ep.i0 = 0; ep.p0 = nullptr; ep.p1 = nullptr; ep.p2 = nullptr;
    if (ph == 0) { gm.A = hb; gm.lda = DM; gm.Bt = (const bf16_t*)(wb + W_IN); gm.N = ZW; gm.K = DM; ep.mode = 0; ep.p0 = (unsigned char*)z; ep.p1 = (unsigned char*)ssq; ep.p2 = (unsigned char*)vt; ep.i0 = meta ? 256 : RG; }
    else if (ph == 4) { gm.A = z + 512; gm.lda = ZW; gm.Bt = (const bf16_t*)(wb + W_GLU); gm.N = 256; gm.K = 256; ep.mode = 1; ep.p0 = (unsigned char*)z; }
    else if (ph == 5) {
        gm.N = DM; ep.p0 = (unsigned char*)z;
        if (sub == 0) { gm.A = yb; gm.lda = 512; gm.Bt = (const bf16_t*)(wb + W_UPB); gm.K = 512; ep.mode = 2; ep.i0 = 4096; }
        else if (sub == 1) { gm.A = z + 256; gm.lda = ZW; gm.Bt = (const bf16_t*)(wb + W_UPC); gm.K = 256; ep.mode = 3; ep.i0 = 5120; }
        else { gm.A = z; gm.lda = ZW; gm.Bt = (const bf16_t*)(wb + W_UPA); gm.K = 256; ep.mode = 3; ep.i0 = 3072; }
    }
    else if (ph == 6) { gm.A = z + 1024; gm.lda = ZW; gm.Bt = (const bf16_t*)(wb + W_O); gm.N = DM; gm.K = DM; ep.mode = 4; ep.p0 = (unsigned char*)h; ep.p1 = (unsigned char*)hb; ep.p2 = (unsigned char*)ssq; }
    else if (ph == 7) { gm.A = hb; gm.lda = DM; gm.Bt = (const bf16_t*)(wb + W_GU); gm.N = 2 * FFH; gm.K = DM; ep.mode = 5; ep.p0 = (unsigned char*)act; ep.p1 = (unsigned char*)ssq; }
    else { gm.A = act; gm.lda = FFH; gm.Bt = (const bf16_t*)(wb + W_DN); gm.N = DM; gm.K = FFH; ep.mode = 4; ep.p0 = (unsigned char*)h; ep.p1 = (unsigned char*)hb; ep.p2 = (unsigned char*)ssq; }
    return true;
}

__device__ __forceinline__ void prologue(int G) {
    const int tid_ = opaque_tid(); const int lane = tid_ & 63, gw = blockIdx.x * 8 + __builtin_amdgcn_readfirstlane(tid_ >> 6), NGW = G * 8;
    const Ctx X = make_ctx(((unsigned char*)KA(ws)));
    for (int row = gw; row < RMAIN + 256; row += NGW) {
        const bool ismeta = row >= RMAIN; const int mr = row - RMAIN;
        const float* src = ismeta ? (mr < 160 ? KAF(meta_tokens) + (size_t)(mr & 15) * DM : nullptr) : (row < 32768 ? KAF(x_prompt) + (size_t)row * DM : KAF(x_sample) + (size_t)(row - 32768) * DM);
        float* hd = ismeta ? X.mh + (size_t)mr * DM : ((float*)KA(out)) + (size_t)row * DM;
        bf16_t* hbd = ismeta ? X.mhb + (size_t)mr * DM : X.hb + (size_t)row * DM;
        float* sq = ismeta ? X.mssq + (size_t)mr * 4 : X.ssq + (size_t)row * 4;
        float ss = 0.f;
#pragma unroll
        for (int j = 0; j < 4; ++j) {
            f32x4 v = (f32x4){0.f, 0.f, 0.f, 0.f}; if (src) v = *(const f32x4*)(src + j * 256 + lane * 4);
            *(f32x4*)(hd + j * 256 + lane * 4) = v;
            *(u32x2*)(hbd + j * 256 + lane * 4) = (u32x2){pk2(v[0], v[1]), pk2(v[2], v[3])};
            ss += (v[0] * v[0] + v[1] * v[1]) + (v[2] * v[2] + v[3] * v[3]);
        }
        ss = wave_sum(ss);
        if (lane < 4) sq[lane] = lane == 0 ? ss : 0.f;
    }
}

__device__ __forceinline__ void mixer_phase_A(int l, int g, LAS unsigned char* lds, int G, int bid) {
    const int tid_ = opaque_tid(); const int lane = tid_ & 63, wave = __builtin_amdgcn_readfirstlane(tid_ >> 6);
    const Ctx X = make_ctx(((unsigned char*)KA(ws))); const Grp gp = make_grp(g);
    const float* rpb = KAF(rpb) + (size_t)l * 8 * 15 * 31; const float* s5d = KAF(s5_d) + l * 256;
    const int nna = gp.nseq * (gp.Lr / 16), nmq = gp.nseq, nck = gp.nseq * gp.nch;
    const int ntask = nna + nmq + 2 * nck;
    for (int t = bid; t < ntask; t += G) {
        __syncthreads();
        if (t < nna) { const int per = gp.Lr / 16; na_task(X, rpb, gp, t / per, t % per, false, wave, lane); }
        else if (t < nna + nmq) { na_task(X, rpb, gp, t - nna, 0, true, wave, lane); }
        else {
            const int u = t - nna - nmq; const bool isS5 = u < nck; const int ci = isS5 ? u : u - nck;
            const int sl = ci / gp.nch, c = ci % gp.nch; const int T = c == 0 ? 16 : 64;
            bf16_t* zc = c == 0 ? X.mz + (size_t)((gp.s0 + sl) * 16) * ZW : X.z + ((size_t)sl * gp.Lr + 64 * (c - 1)) * ZW;
            if (isS5) s5_chunk<false>(X, s5d, (LAS float*)(lds + wave * 16896), zc, T, ci, wave, lane);
            else hg_chunk<false>(X, (LAS float*)(lds + wave * 8192), (LAS bf16_t*)(lds + 65536 + wave * 8192), zc, T, ci, wave, lane);
        }
    }
}

__device__ __forceinline__ void mixer_phase_C(int l, int g, LAS unsigned char* lds, int G, int bid) {
    const int tid_ = opaque_tid(); const int lane = tid_ & 63, wave = __builtin_amdgcn_readfirstlane(tid_ >> 6);
    const Ctx X = make_ctx(((unsigned char*)KA(ws))); const Grp gp = make_grp(g);
    const float* s5d = KAF(s5_d) + l * 256; const float* ong = KAF(onorm_g) + l * 64;
    const int nck = gp.nseq * gp.nch;
    for (int t = bid; t < 2 * nck; t += G) {
        __syncthreads();
        const bool isS5 = t < nck; const int ci = isS5 ? t : t - nck;
        const int sl = ci / gp.nch, c = ci % gp.nch; const int T = c == 0 ? 16 : 64;
        bf16_t* zc = c == 0 ? X.mz + (size_t)((gp.s0 + sl) * 16) * ZW : X.z + ((size_t)sl * gp.Lr + 64 * (c - 1)) * ZW;
        if (isS5) s5_chunk<true>(X, s5d, (LAS float*)(lds + wave * 16896), zc, T, ci, wave, lane);
        else {
            hg_chunk<true>(X, (LAS float*)(lds + wave * 8192), (LAS bf16_t*)(lds + 65536 + wave * 8192), zc, T, ci, wave, lane);
            __syncthreads();
            const int h = wave >> 1, half = wave & 1;
            const LAS bf16_t* of = (const LAS bf16_t*)(lds + 65536 + (2 * h) * 8192); const LAS bf16_t* ob = (const LAS bf16_t*)(lds + 65536 + (2 * h + 1) * 8192);
            const float gn = ong[lane];
            for (int tt = half * (T / 2); tt < (half + 1) * (T / 2); ++tt) {
                const float o = bf2f(of[tt * 64 + lane]) + bf2f(ob[tt * 64 + lane]);
                const float ms = wave_sum(o * o) * (1.0f / 64.0f);
                bf16_t* zr = zc + (size_t)tt * ZW;
                const float go = bf2f(zr[2816 + h * 64 + lane]);
                zr[256 + h * 64 + lane] = (bf16_t)f2bf(o * rsqrtf(ms + 1e-6f) * gn * (go * sigm(go)));
            }
        }
    }
}

__global__ void __launch_bounds__(512, 2) fwd_kernel(Args a) {
    extern __shared__ __attribute__((aligned(16))) unsigned char lds_raw[];
    LAS unsigned char* lds = (LAS unsigned char*)lds_raw;
    const int G = gridDim.x, bid = blockIdx.x;

    if (threadIdx.x < 2) ((volatile LAS unsigned*)(lds + LDS_ST_OFF))[threadIdx.x] = 0u;
    if (threadIdx.x == 0) (void)xb_add((unsigned*)(KA(ws) + WS_CTL) + XB_XCNT(xb_xcc_id()), 1u);
    __syncthreads();
    prologue(G);

    for (int l = 0; l < NLAYER; ++l) {
        __syncthreads();
        { const Ctx X = make_ctx(((unsigned char*)KA(ws))); prep_layer(X, l, lds, G); }
        if (l == 0) { asm volatile("s_waitcnt vmcnt(0)" ::: "memory"); __syncthreads(); cg::this_grid().sync(); }
        GRID_SYNC();
        for (int g = 0; g < 4; ++g) {
            for (int ph = 0; ph < 9; ++ph) {
                if (ph == 1) mixer_phase_A(l, g, lds, G, bid);
                else if (ph == 2) { const Ctx X = make_ctx(((unsigned char*)KA(ws))); const Grp gp = make_grp(g); const int gtid = bid * 512 + opaque_tid(), GT = G * 512; s5_passB(X, gp, gtid, GT); hg_passB(X, gp, GT - 1 - gtid, GT); }
                else if (ph == 3) mixer_phase_C(l, g, lds, G, bid);
                else {
                    for (int j = 0; j < 6; ++j) {
                        pg8::Gemm gm; pg8::UberEpi ep;
                        if (!make_job(((unsigned char*)KA(ws)), ((float*)KA(out)), l, g, ph, j, gm, ep)) break;
                        pg8::StaticOrder SO; SO.init(gm.M, gm.N, G, bid);
                        pg8::gemm_phase(lds, gm, SO, ep);
                    }
                }
                GRID_SYNC();
            }
        }
    }
    {
        const float* ssq = (const float*)(((unsigned char*)KA(ws)) + WS_SSQ);
        const int tid_ = opaque_tid(); const int lane = tid_ & 63, wave = __builtin_amdgcn_readfirstlane(tid_ >> 6);
        for (int row = bid * 8 + wave; row < RMAIN; row += G * 8) {
            const float rs = pg8::row_rstd(ssq, row);
            float* hp = ((float*)KA(out)) + (size_t)row * DM;
#pragma unroll
            for (int j = 0; j < 4; ++j) {
                f32x4 v = *(const f32x4*)(hp + j * 256 + lane * 4); const f32x4 gv = *(const f32x4*)(KAF(final_g) + j * 256 + lane * 4);
                v = v * rs * gv; *(f32x4*)(hp + j * 256 + lane * 4) = v;
            }
        }
    }
}

extern "C" void kernel_launch(void* const* d_in, const int* in_sizes, int n_in, void* d_out, int out_size, void* d_ws, size_t ws_size, hipStream_t stream) {
    static int grid = 0;
    if (grid == 0) {
        int dev = 0, cus = 0, per_cu = 0;
        (void)hipGetDevice(&dev);
        (void)hipDeviceGetAttribute(&cus, hipDeviceAttributeMultiprocessorCount, dev);
        (void)hipFuncSetAttribute((const void*)fwd_kernel, hipFuncAttributeMaxDynamicSharedMemorySize, LDS_BYTES);
        (void)hipOccupancyMaxActiveBlocksPerMultiprocessor(&per_cu, (const void*)fwd_kernel, 512, LDS_BYTES);
        (void)hipGetLastError();
        if (ws_size < WS_TOTAL) fprintf(stderr, "kernel_launch: workspace too small: %zu < %zu\n", ws_size, (size_t)WS_TOTAL);
        grid = cus > 0 ? cus : 256;
    }
    (void)hipMemsetAsync((char*)d_ws + WS_CTL, 0, CTL_BYTES, stream);
    Args a{};
    const float** pp = (const float**)&a;
    for (int i = 0; i < 26; ++i) pp[i] = (const float*)d_in[i];
    a.out = (float*)d_out; a.ws = (unsigned char*)d_ws;
    void* args[] = {&a};
    hipError_t e = hipLaunchCooperativeKernel((const void*)fwd_kernel, dim3(grid), dim3(512), args, LDS_BYTES, stream);
    if (e != hipSuccess) fprintf(stderr, "cooperative launch failed: %s\n", hipGetErrorString(e));
}
```

```cpp
#include <hip/hip_runtime.h>
#include <hip/hip_cooperative_groups.h>
#include <cstdio>
#include <cstdint>
namespace cg = cooperative_groups;

#define LAS __attribute__((address_space(3)))
typedef unsigned short bf16_t;
typedef short bf16x8 __attribute__((ext_vector_type(8)));
typedef float f32x4 __attribute__((ext_vector_type(4)));
typedef unsigned u32x4 __attribute__((ext_vector_type(4)));
typedef unsigned u32x2 __attribute__((ext_vector_type(2)));

#define WAVE_SYNC() asm volatile("s_waitcnt lgkmcnt(0)" ::: "memory")
__device__ __forceinline__ int opaque_tid() { int t = threadIdx.x; asm volatile("" : "+v"(t)); return t; }

__device__ __forceinline__ unsigned f2bf(float f) { unsigned u = __builtin_bit_cast(unsigned, f); return (u + 0x7fffu + ((u >> 16) & 1u)) >> 16; }
__device__ __forceinline__ unsigned pk2(float lo, float hi) { return f2bf(lo) | (f2bf(hi) << 16); }
__device__ __forceinline__ float bf2f(bf16_t b) { return __builtin_bit_cast(float, (unsigned)b << 16); }
__device__ __forceinline__ float bflo(unsigned w) { return __builtin_bit_cast(float, w << 16); }
__device__ __forceinline__ float bfhi(unsigned w) { return __builtin_bit_cast(float, w & 0xffff0000u); }
__device__ __forceinline__ float sigm(float x) { return 1.f / (1.f + __expf(-x)); }
__device__ __forceinline__ float gelu_tanh(float y) { const float a = 0.7978845608028654f * (y + 0.044715f * y * y * y); const float th = 1.f - 2.f / (__expf(2.f * a) + 1.f); return 0.5f * y * (1.f + th); }
__device__ __forceinline__ u32x4 pack8(f32x4 a, f32x4 b) { u32x4 w; w.x = pk2(a[0], a[1]); w.y = pk2(a[2], a[3]); w.z = pk2(b[0], b[1]); w.w = pk2(b[2], b[3]); return w; }
__device__ __forceinline__ float wave_sum(float v) {
#pragma unroll
    for (int o = 1; o < 64; o <<= 1) v += __shfl_xor(v, o);
    return v;
}

namespace pg8 {
constexpr int ZSTR = 6208;
constexpr int BM = 256, BK = 64, HALF = 128, HTB = HALF * BK * 2, STAGE_BYTES = 8 * HTB, NXCD = 8, WGM = 8;
__host__ __device__ __forceinline__ int lds_byte(int r, int c) { const int st = (r >> 4) * 2 + (c >> 5), rr = r & 15, cc = c & 31, ob = rr * 64 + cc * 2; return st * 1024 + (ob ^ (((ob >> 9) & 1) << 5)); }
__host__ __device__ __forceinline__ void stage_rc(int b, int& R, int& C) { const int st = b / 1024, sb = b % 1024, swz = sb ^ (((sb >> 9) & 1) << 5); R = (st >> 1) * 16 + swz / 64; C = (st & 1) * 32 + (swz % 64) / 2; }
__host__ __device__ __forceinline__ int perm32(int rho) { const int n = rho >> 4, i = rho & 15; return 8 * (i >> 2) + 4 * n + (i & 3); }
struct Unit { int pm, pn; };
struct Gemm { const bf16_t* A; int lda; const bf16_t* Bt; int M, N, K; };
struct StaticOrder {
    int nM, nN, nwg, G, c;
    __device__ void init(int M, int N, int G_, int c_) { nM = M / BM; nN = N / BM; nwg = nM * nN; G = G_; c = c_; }
    __device__ bool next(int i, Unit& u) const {
        const long L = (long)i * G + c; if (L >= nwg) return false;
        int wgid = (int)L; { const int q = nwg / NXCD, r = nwg % NXCD, xcd = wgid % NXCD, off = wgid / NXCD; wgid = (xcd < r ? xcd * (q + 1) : r * (q + 1) + (xcd - r) * q) + off; }
        const int nig = WGM * nN, gid = wgid / nig, fm = gid * WGM, gsz = (nM - fm) < WGM ? (nM - fm) : WGM;
        u.pm = fm + ((wgid % nig) % gsz); u.pn = (wgid % nig) / gsz; return true;
    }
};

struct UberEpi;
__device__ __forceinline__ void run_epi(const UberEpi& E, LAS unsigned char* lds, const f32x4 (&acc)[2][2][4][2], const Unit& u, int wr, int wc, int fr, int fq);
__device__ __forceinline__ void gemm_phase(LAS unsigned char* lds, const Gemm g, const StaticOrder& S, const UberEpi& E) {
    const int tid = opaque_tid(), wid = __builtin_amdgcn_readfirstlane(tid >> 6), lane = tid & 63, wr = wid >> 2, wc = wid & 3, fr = lane & 15, fq = lane >> 4;
    const int K = g.K, nt = K / BK, lda = g.lda;
    unsigned voffA[2], voffB[2];
#pragma unroll
    for (int i = 0; i < 2; ++i) { int R, C; stage_rc(tid * 16 + i * 8192, R, C); const int Rb = (R & ~31) + perm32(R & 31);
        voffA[i] = (unsigned)(R * lda + C) * 2u; voffB[i] = (unsigned)(Rb * K + C) * 2u; }
    const size_t kstep = (size_t)(BK * 2);
    const size_t hstepA = (size_t)HALF * lda * 2, hstepB = (size_t)HALF * K * 2;
    const size_t tstepA = 2 * hstepA, tstepB = 2 * hstepB;
    const unsigned ldsw = (unsigned)wid * 1024u;
    const int aoff = lds_byte(wr * 64 + fr, fq * 8), boff = lds_byte(wc * 32 + fr, fq * 8);
#define PG8_SA(b, h) (((b) * 2 + (h)) * HTB)
#define PG8_SB(b, h) ((4 + (b) * 2 + (h)) * HTB)
#define PG8_STAGE(bufoff, gbase, voff) do { _Pragma("unroll") for (int _i = 0; _i < 2; ++_i) \
        __builtin_amdgcn_global_load_lds((const unsigned*)((const char*)(gbase) + (voff)[_i]), (LAS unsigned*)(lds + (bufoff) + ldsw + _i * 8192), 16, 0, 0); } while (0)
#define PG8_LDA(dst, b, h) do { _Pragma("unroll") for (int m = 0; m < 4; ++m) _Pragma("unroll") for (int k = 0; k < 2; ++k) dst[m][k] = *(const LAS bf16x8*)(lds + PG8_SA(b, h) + aoff + m * 2048 + k * 1024); } while (0)
#define PG8_LDB(dst, b, h) do { _Pragma("unroll") for (int n = 0; n < 2; ++n) _Pragma("unroll") for (int k = 0; k < 2; ++k) dst[n][k] = *(const LAS bf16x8*)(lds + PG8_SB(b, h) + boff + n * 2048 + k * 1024); } while (0)
#define PG8_MMA(ai, bj, At, Bt) do { __builtin_amdgcn_s_setprio(1); _Pragma("unroll") for (int m = 0; m < 4; ++m) _Pragma("unroll") for (int n = 0; n < 2; ++n) _Pragma("unroll") for (int k = 0; k < 2; ++k) \
        acc[ai][bj][m][n] = __builtin_amdgcn_mfma_f32_16x16x32_bf16(Bt[n][k], At[m][k], acc[ai][bj][m][n], 0, 0, 0); __builtin_amdgcn_s_setprio(0); } while (0)
#define PG8_WAIT_V(n) asm volatile("s_waitcnt vmcnt(" #n ")" ::: "memory")
#define PG8_WAIT_L(n) asm volatile("s_waitcnt lgkmcnt(" #n ")" ::: "memory")
#define PG8_BAR __builtin_amdgcn_s_barrier()
#define PG8_SCHED __builtin_amdgcn_sched_barrier(0)
    Unit cur, nxt; int ui = 0;
    if (!S.next(0, cur)) return;
    f32x4 acc[2][2][4][2];
#pragma unroll
    for (int a = 0; a < 2; ++a)
#pragma unroll
        for (int b = 0; b < 2; ++b)
#pragma unroll
            for (int m = 0; m < 4; ++m)
#pragma unroll
                for (int n = 0; n < 2; ++n) acc[a][b][m][n] = (f32x4){0.f, 0.f, 0.f, 0.f};
    bf16x8 At[4][2], B0[2][2], B1[2][2];
    const char* cA = (const char*)g.A + (size_t)cur.pm * tstepA; const char* cB = (const char*)g.Bt + (size_t)cur.pn * tstepB;
    PG8_STAGE(PG8_SB(0, 0), cB, voffB); PG8_STAGE(PG8_SB(0, 1), cB + hstepB, voffB); PG8_STAGE(PG8_SA(0, 0), cA, voffA); PG8_STAGE(PG8_SA(0, 1), cA + hstepA, voffA);
    if (wr == 1) PG8_BAR;
    PG8_WAIT_V(2); PG8_BAR;
    PG8_STAGE(PG8_SB(1, 0), cB + kstep, voffB); PG8_STAGE(PG8_SA(1, 0), cA + kstep, voffA); PG8_STAGE(PG8_SB(1, 1), cB + hstepB + kstep, voffB);
    PG8_WAIT_V(6); PG8_BAR;
    for (;;) {
        const bool has_next = S.next(ui + 1, nxt);
        const char* nA = has_next ? (const char*)g.A + (size_t)nxt.pm * tstepA : cA; const char* nB = has_next ? (const char*)g.Bt + (size_t)nxt.pn * tstepB : cB;
        for (int t = 0; t < nt; t += 2) {
            const bool last = (t == nt - 2);
            const char* a1 = cA + (size_t)(t + 1) * kstep;
            const char* a2 = last ? nA : cA + (size_t)(t + 2) * kstep; const char* b2 = last ? nB : cB + (size_t)(t + 2) * kstep;
            const char* a3 = a2 + kstep; const char* b3 = b2 + kstep;
            PG8_LDB(B0, 0, 0); PG8_LDB(B1, 0, 1); PG8_SCHED; PG8_LDA(At, 0, 0); PG8_STAGE(PG8_SA(1, 1), a1 + hstepA, voffA);
            PG8_WAIT_V(8); PG8_WAIT_L(0); PG8_BAR; PG8_MMA(0, 0, At, B0); PG8_MMA(0, 1, At, B1); PG8_BAR; PG8_SCHED;
            PG8_LDA(At, 0, 1); PG8_STAGE(PG8_SB(0, 0), b2, voffB); PG8_STAGE(PG8_SB(0, 1), b2 + hstepB, voffB); PG8_STAGE(PG8_SA(0, 0), a2, voffA);
            PG8_WAIT_V(8); PG8_WAIT_L(0); PG8_BAR; PG8_MMA(1, 0, At, B0); PG8_MMA(1, 1, At, B1); PG8_BAR; PG8_SCHED;
            PG8_LDB(B0, 1, 0); PG8_LDB(B1, 1, 1); PG8_SCHED; PG8_LDA(At, 1, 0); PG8_STAGE(PG8_SA(0, 1), a2 + hstepA, voffA);
            PG8_WAIT_V(8); PG8_WAIT_L(0); PG8_BAR; PG8_MMA(0, 0, At, B0); PG8_MMA(0, 1, At, B1); PG8_BAR; PG8_SCHED;
            PG8_LDA(At, 1, 1); PG8_STAGE(PG8_SB(1, 0), b3, voffB); PG8_STAGE(PG8_SB(1, 1), b3 + hstepB, voffB); PG8_STAGE(PG8_SA(1, 0), a3, voffA);
            PG8_WAIT_V(8); PG8_WAIT_L(0); PG8_BAR; PG8_MMA(1, 0, At, B0); PG8_MMA(1, 1, At, B1); PG8_BAR; PG8_SCHED;
        }
        if (wr == 0) PG8_BAR;
        run_epi(E, lds, acc, cur, wr, wc, fr, fq);
        if (!has_next) break;
#pragma unroll
        for (int a = 0; a < 2; ++a)
#pragma unroll
            for (int b = 0; b < 2; ++b)
#pragma unroll
                for (int m = 0; m < 4; ++m)
#pragma unroll
                    for (int n = 0; n < 2; ++n) acc[a][b][m][n] = (f32x4){0.f, 0.f, 0.f, 0.f};
        cur = nxt; cA = nA; cB = nB; ++ui;
        if (wr == 1) PG8_BAR;
    }
    PG8_WAIT_V(0);
    PG8_BAR;
#undef PG8_SA
#undef PG8_SB
#undef PG8_STAGE
#undef PG8_LDA
#undef PG8_LDB
#undef PG8_MMA
#undef PG8_WAIT_V
#undef PG8_WAIT_L
#undef PG8_BAR
#undef PG8_SCHED
}

__device__ __forceinline__ float row_rstd(const float* ssq, int row) {
    const f32x4 s0 = *(const f32x4*)(ssq + (size_t)row * 4);
    const float ss = (s0[0] + s0[1]) + (s0[2] + s0[3]);
    return rsqrtf(ss * (1.0f / 1024.0f) + 1e-6f);
}
struct EpiZ {
    bf16_t* z; const float* ssq; bf16_t* vt; int vt_ld;
    __device__ __forceinline__ void operator()(const f32x4 (&acc)[2][2][4][2], const Unit& u, int wr, int wc, int fr, int fq) const {
        const int row0 = u.pm * BM + wr * 64 + fr, col0 = u.pn * BM + wc * 32 + 8 * fq;
        const bool isv = (u.pn == 5 || u.pn == 6);
#pragma unroll
        for (int ai = 0; ai < 2; ++ai)
#pragma unroll
            for (int m = 0; m < 4; ++m) {
                const int row = row0 + ai * HALF + m * 16; const float rs = row_rstd(ssq, row);
#pragma unroll
                for (int bj = 0; bj < 2; ++bj) {
                    const u32x4 w = pack8(acc[ai][bj][m][0] * rs, acc[ai][bj][m][1] * rs);
                    *(u32x4*)(z + (size_t)row * ZSTR + col0 + bj * HALF) = w;
                    if (isv) { const int c = col0 + bj * HALF - 1280;
#pragma unroll
                        for (int i = 0; i < 8; ++i) vt[(size_t)(c + i) * vt_ld + row] = (bf16_t)((w[i >> 1] >> (16 * (i & 1))) & 0xffffu); }
                }
            }
    }
};
struct EpiGlu {
    bf16_t* z;
    __device__ __forceinline__ void operator()(const f32x4 (&acc)[2][2][4][2], const Unit& u, int wr, int wc, int fr, int fq) const {
        const int row0 = u.pm * BM + wr * 64 + fr, col0 = wc * 32 + 8 * fq;
#pragma unroll
        for (int ai = 0; ai < 2; ++ai)
#pragma unroll
            for (int m = 0; m < 4; ++m) {
                const int row = row0 + ai * HALF + m * 16;
#pragma unroll
                for (int bj = 0; bj < 2; ++bj) {
                    bf16_t* zp = z + (size_t)row * ZSTR + col0 + bj * HALF;
                    const u32x4 y = *(const u32x4*)(zp + 512);
                    const f32x4 a0 = acc[ai][bj][m][0], a1 = acc[ai][bj][m][1];
                    f32x4 o0, o1;
                    o0[0] = bflo(y.x) * sigm(a0[0]); o0[1] = bfhi(y.x) * sigm(a0[1]); o0[2] = bflo(y.y) * sigm(a0[2]); o0[3] = bfhi(y.y) * sigm(a0[3]);
                    o1[0] = bflo(y.z) * sigm(a1[0]); o1[1] = bfhi(y.z) * sigm(a1[1]); o1[2] = bflo(y.w) * sigm(a1[2]); o1[3] = bfhi(y.w) * sigm(a1[3]);
                    *(u32x4*)zp = pack8(o0, o1);
                }
            }
    }
};
template <int MODE> struct EpiMix {
    bf16_t* z; int goff;
    __device__ __forceinline__ void operator()(const f32x4 (&acc)[2][2][4][2], const Unit& u, int wr, int wc, int fr, int fq) const {
        const int row0 = u.pm * BM + wr * 64 + fr, col0 = u.pn * BM + wc * 32 + 8 * fq;
#pragma unroll
        for (int ai = 0; ai < 2; ++ai)
#pragma unroll
            for (int m = 0; m < 4; ++m) {
                const int row = row0 + ai * HALF + m * 16;
#pragma unroll
                for (int bj = 0; bj < 2; ++bj) {
                    bf16_t* zr = z + (size_t)row * ZSTR + col0 + bj * HALF;
                    const u32x4 gq = *(const u32x4*)(zr + goff);
                    const f32x4 a0 = acc[ai][bj][m][0], a1 = acc[ai][bj][m][1];
                    f32x4 o0, o1;
                    o0[0] = sigm(bflo(gq.x)) * a0[0]; o0[1] = sigm(bfhi(gq.x)) * a0[1]; o0[2] = sigm(bflo(gq.y)) * a0[2]; o0[3] = sigm(bfhi(gq.y)) * a0[3];
                    o1[0] = sigm(bflo(gq.z)) * a1[0]; o1[1] = sigm(bfhi(gq.z)) * a1[1]; o1[2] = sigm(bflo(gq.w)) * a1[2]; o1[3] = sigm(bfhi(gq.w)) * a1[3];
                    if (MODE == 1) { const u32x4 p = *(const u32x4*)(zr + 1024);
                        o0[0] += bflo(p.x); o0[1] += bfhi(p.x); o0[2] += bflo(p.y); o0[3] += bfhi(p.y); o1[0] += bflo(p.z); o1[1] += bfhi(p.z); o1[2] += bflo(p.w); o1[3] += bfhi(p.w); }
                    *(u32x4*)(zr + 1024) = pack8(o0, o1);
                }
            }
    }
};
struct EpiRes {
    float* h; bf16_t* hb; float* ssq; LAS float* red;
    __device__ __forceinline__ void operator()(const f32x4 (&acc)[2][2][4][2], const Unit& u, int wr, int wc, int fr, int fq) const {
        const int row0 = u.pm * BM + wr * 64 + fr, col0 = u.pn * BM + wc * 32 + 8 * fq;
#pragma unroll
        for (int ai = 0; ai < 2; ++ai)
#pragma unroll
            for (int m = 0; m < 4; ++m) {
                const int row = row0 + ai * HALF + m * 16; float part = 0.f;
#pragma unroll
                for (int bj = 0; bj < 2; ++bj) {
                    float* hp = h + (size_t)row * 1024 + col0 + bj * HALF;
                    f32x4 h0 = *(const f32x4*)hp, h1 = *(const f32x4*)(hp + 4);
                    h0 = h0 + acc[ai][bj][m][0]; h1 = h1 + acc[ai][bj][m][1];
                    *(f32x4*)hp = h0; *(f32x4*)(hp + 4) = h1;
                    part += (h0[0] * h0[0] + h0[1] * h0[1]) + (h0[2] * h0[2] + h0[3] * h0[3]) + (h1[0] * h1[0] + h1[1] * h1[1]) + (h1[2] * h1[2] + h1[3] * h1[3]);
                    *(u32x4*)(hb + (size_t)row * 1024 + col0 + bj * HALF) = pack8(h0, h1);
                }
                part += __shfl_xor(part, 16); part += __shfl_xor(part, 32);
                if (fq == 0) red[(ai * HALF + wr * 64 + m * 16 + fr) * 4 + wc] = part;
            }
        asm volatile("s_waitcnt lgkmcnt(0)" ::: "memory");
        __builtin_amdgcn_s_barrier();
        asm volatile("" ::: "memory");
        { const int t_ = opaque_tid(); if (t_ < 256) { const f32x4 r4 = *(const LAS f32x4*)(red + t_ * 4); ssq[(size_t)(u.pm * BM + t_) * 4 + u.pn] = (r4[0] + r4[1]) + (r4[2] + r4[3]); } }
    }
};
struct EpiAct {
    bf16_t* act; const float* ssq;
    __device__ __forceinline__ void operator()(const f32x4 (&acc)[2][2][4][2], const Unit& u, int wr, int wc, int fr, int fq) const {
        const int row0 = u.pm * BM + wr * 64 + fr, col0 = u.pn * HALF + wc * 32 + 8 * fq;
#pragma unroll
        for (int ai = 0; ai < 2; ++ai)
#pragma unroll
            for (int m = 0; m < 4; ++m) {
                const int row = row0 + ai * HALF + m * 16; const float rs = row_rstd(ssq, row);
                f32x4 o[2];
#pragma unroll
                for (int n = 0; n < 2; ++n)
#pragma unroll
                    for (int i = 0; i < 4; ++i) { const float gg = acc[ai][0][m][n][i] * rs, uu = acc[ai][1][m][n][i] * rs; o[n][i] = gg * sigm(gg) * uu; }
                *(u32x4*)(act + (size_t)row * 2816 + col0) = pack8(o[0], o[1]);
            }
    }
};
struct UberEpi { int mode, i0; unsigned char *p0, *p1, *p2; };
__device__ __forceinline__ void run_epi(const UberEpi& E, LAS unsigned char* lds, const f32x4 (&acc)[2][2][4][2], const Unit& u, int wr, int wc, int fr, int fq) {
    switch (E.mode) {
        case 0: { EpiZ e{(bf16_t*)E.p0, (const float*)E.p1, (bf16_t*)E.p2, E.i0}; e(acc, u, wr, wc, fr, fq); break; }
        case 1: { EpiGlu e{(bf16_t*)E.p0}; e(acc, u, wr, wc, fr, fq); break; }
        case 2: { EpiMix<0> e{(bf16_t*)E.p0, E.i0}; e(acc, u, wr, wc, fr, fq); break; }
        case 3: { EpiMix<1> e{(bf16_t*)E.p0, E.i0}; e(acc, u, wr, wc, fr, fq); break; }
        case 4: { EpiRes e{(float*)E.p0, (bf16_t*)E.p1, (float*)E.p2, (LAS float*)(lds + 131072)}; e(acc, u, wr, wc, fr, fq); break; }
        default: { EpiAct e{(bf16_t*)E.p0, (const float*)E.p1}; e(acc, u, wr, wc, fr, fq); break; }
    }
}
}

constexpr int NLAYER = 4, DM = 1024, ZN = 6144, ZW = 6208  , FFH = 2816, RG = 16384, RMAIN = 65536, VTLD = RG + 64  ;
constexpr size_t al256(size_t x) { return (x + 255) & ~(size_t)255; }
constexpr size_t WS_HB = 0;
constexpr size_t WS_SSQ = WS_HB + (size_t)RMAIN * DM * 2;
constexpr size_t WS_Z = WS_SSQ + (size_t)RMAIN * 4 * 4;
constexpr size_t WS_YB = WS_Z + (size_t)RG * ZW * 2;
constexpr size_t WS_VT = WS_YB + (size_t)RG * 512 * 2;
constexpr size_t WS_HGU = WS_VT + (size_t)512 * VTLD * 2;
constexpr size_t WS_HGP = WS_HGU + (size_t)260 * 8 * 4096 * 4;
constexpr size_t WS_S5S = WS_HGP + (size_t)260 * 8 * 64 * 4;
constexpr size_t WS_W = WS_S5S + (size_t)260 * 2048 * 8;
constexpr size_t W_IN = 0, W_UPA = W_IN + (size_t)6144 * 1024 * 2, W_UPB = W_UPA + (size_t)1024 * 256 * 2, W_UPC = W_UPB + (size_t)1024 * 512 * 2,
                 W_O = W_UPC + (size_t)1024 * 256 * 2, W_GU = W_O + (size_t)1024 * 1024 * 2, W_DN = W_GU + (size_t)5632 * 1024 * 2, W_GLU = W_DN + (size_t)1024 * 2816 * 2,
                 W_END = W_GLU + (size_t)256 * 256 * 2;
constexpr size_t WS_TAB = WS_W + W_END;
constexpr size_t T_LBAR = 0, T_L16 = T_LBAR + 2048 * 8, T_L64 = T_L16 + 2048 * 8, T_BFRAG = T_L64 + 2048 * 8, T_CFRAG = T_BFRAG + (size_t)32 * 8 * 64 * 16,
                 T_LB = T_CFRAG + (size_t)32 * 4 * 64 * 16, T_END = T_LB + 256 * 4;
constexpr size_t WS_META = al256(WS_TAB + T_END);
constexpr size_t M_H = 0, M_HB = M_H + (size_t)256 * 1024 * 4, M_SSQ = M_HB + (size_t)256 * 1024 * 2, M_Z = M_SSQ + (size_t)256 * 4 * 4, M_YB = M_Z + (size_t)256 * ZW * 2,
                 M_VT = M_YB + (size_t)256 * 512 * 2, M_ACT = M_VT + (size_t)512 * 256 * 2, M_END = M_ACT + (size_t)256 * FFH * 2;
constexpr size_t WS_CTL = al256(WS_META + M_END);
constexpr size_t CTL_BYTES = 16384;
constexpr size_t WS_TOTAL = WS_CTL + CTL_BYTES;
constexpr int LDS_ST_OFF = 135168;
constexpr int LDS_BYTES = 147456;

struct Args {
    const float *x_prompt, *x_sample, *meta_tokens, *norm1_g, *w_in, *a_re, *a_im, *log_dt, *b_re, *b_im, *c_re, *c_im, *s5_d, *w_glu, *rpb, *lb_logits, *onorm_g,
        *w_up_a, *w_up_b, *w_up_c, *w_o, *norm2_g, *w_gate, *w_up, *w_down, *final_g;
    float* out; unsigned char* ws;
};

__device__ __forceinline__ unsigned long long ufl(unsigned long long v) { const unsigned lo = __builtin_amdgcn_readfirstlane((unsigned)v), hi = __builtin_amdgcn_readfirstlane((unsigned)(v >> 32)); return ((unsigned long long)hi << 32) | lo; }
#define KA(f) ((decltype(Args::f))ufl((unsigned long long)(((const volatile Args*)__builtin_amdgcn_kernarg_segment_ptr())->f)))
#define KAF(f) ((const float*)KA(f))
struct Ctx {
    bf16_t *hb, *z, *yb, *vt; float *ssq, *hgu, *hgp, *s5s;
    bf16_t *w; const float *lbar, *l16, *l64; const bf16_t *bfrag, *cfrag; const float* lb;
    float* mh; bf16_t *mhb, *mz, *myb, *mvt, *mact; float* mssq;
};

__device__ __forceinline__ void tr_item(const float* W, int K, int N, bf16_t* WT, const float* kscale, int mode, LAS float* scr, int item, int lane, bool valid) {
    const int nblk = N / 32, kb = item / nblk, nb = item % nblk, k0 = 64 * kb, n0 = 32 * nb;
    if (valid) {
#pragma unroll 8
    for (int i = 0; i < 32; ++i) { const int kk = 2 * i + (lane >> 5); float v = W[(size_t)(k0 + kk) * N + n0 + (lane & 31)]; if (kscale) v *= kscale[k0 + kk]; scr[kk * 33 + (lane & 31)] = v; }
    }
    __syncthreads();
    const int c = lane & 7;
    int drow0 = n0; if (mode) drow0 = (n0 >> 7) * 256 + (n0 & 127) + (mode == 2 ? 128 : 0);
    if (valid) {
#pragma unroll
    for (int j = 0; j < 4; ++j) { const int n = (lane >> 3) + 8 * j; const LAS float* s = scr + (8 * c) * 33 + n;
        u32x4 o; o.x = pk2(s[0 * 33], s[1 * 33]); o.y = pk2(s[2 * 33], s[3 * 33]); o.z = pk2(s[4 * 33], s[5 * 33]); o.w = pk2(s[6 * 33], s[7 * 33]);
        *(u32x4*)(WT + (size_t)(drow0 + n) * K + k0 + 8 * c) = o; }
    }
    __syncthreads();
}

__device__ __forceinline__ void prep_layer(const Ctx& X, int l, LAS unsigned char* lds, int G) {
    const int tid_ = opaque_tid(); const int wave = __builtin_amdgcn_readfirstlane(tid_ >> 6), lane = tid_ & 63;
    LAS float* scr = (LAS float*)(lds + wave * 16384);
    const int gw = blockIdx.x * 8 + wave, NGW = G * 8;
    constexpr int I0 = 16 * 192, I1 = 4 * 32, I2 = 8 * 32, I3 = 4 * 32, I4 = 16 * 32, I5 = 16 * 88, I6 = 16 * 88, I7 = 44 * 32, I8 = 4 * 8;
    constexpr int NIT = I0 + I1 + I2 + I3 + I4 + I5 + I6 + I7 + I8;
    unsigned char* wb = (unsigned char*)X.w;
    for (int it0 = 0; it0 < NIT; it0 += NGW) {
        const int it = it0 + gw; const bool valid = it < NIT;
        int r = valid ? it : 0;
        if (r < I0) { tr_item(KAF(w_in) + (size_t)l * 1024 * 6144, 1024, 6144, (bf16_t*)(wb + W_IN), KAF(norm1_g) + l * 1024, 0, scr, r, lane, valid); continue; } r -= I0;
        if (r < I1) { tr_item(KAF(w_up_a) + (size_t)l * 256 * 1024, 256, 1024, (bf16_t*)(wb + W_UPA), nullptr, 0, scr, r, lane, valid); continue; } r -= I1;
        if (r < I2) { tr_item(KAF(w_up_b) + (size_t)l * 512 * 1024, 512, 1024, (bf16_t*)(wb + W_UPB), nullptr, 0, scr, r, lane, valid); continue; } r -= I2;
        if (r < I3) { tr_item(KAF(w_up_c) + (size_t)l * 256 * 1024, 256, 1024, (bf16_t*)(wb + W_UPC), nullptr, 0, scr, r, lane, valid); continue; } r -= I3;
        if (r < I4) { tr_item(KAF(w_o) + (size_t)l * 1024 * 1024, 1024, 1024, (bf16_t*)(wb + W_O), nullptr, 0, scr, r, lane, valid); continue; } r -= I4;
        if (r < I5) { tr_item(KAF(w_gate) + (size_t)l * 1024 * 2816, 1024, 2816, (bf16_t*)(wb + W_GU), KAF(norm2_g) + l * 1024, 1, scr, r, lane, valid); continue; } r -= I5;
        if (r < I6) { tr_item(KAF(w_up) + (size_t)l * 1024 * 2816, 1024, 2816, (bf16_t*)(wb + W_GU), KAF(norm2_g) + l * 1024, 2, scr, r, lane, valid); continue; } r -= I6;
        if (r < I7) { tr_item(KAF(w_down) + (size_t)l * 2816 * 1024, 2816, 1024, (bf16_t*)(wb + W_DN), nullptr, 0, scr, r, lane, valid); continue; } r -= I7;
        tr_item(KAF(w_glu) + (size_t)l * 256 * 256, 256, 256, (bf16_t*)(wb + W_GLU), nullptr, 0, scr, r, lane, valid);
    }
    const int gt = blockIdx.x * 512 + tid_;
    if (gt < 2048) {
        const int dg = gt >> 6, p = gt & 63;
        const size_t pb = ((size_t)l * 32 + dg);
        const float are = KAF(a_re)[pb * 64 + p], aim = KAF(a_im)[pb * 64 + p], dt = expf(KAF(log_dt)[pb]);
        const float mag = expf(are * dt); float sn, cs; sincosf(aim * dt, &sn, &cs);
        const float lr = mag * cs, li = mag * sn;
        const float den = are * are + aim * aim, nr = lr - 1.0f, ni = li;
        const float zr = (nr * are + ni * aim) / den, zi = (ni * are - nr * aim) / den;
        float* lbar = (float*)X.lbar; float* l16 = (float*)X.l16; float* l64 = (float*)X.l64;
        lbar[gt * 2] = lr; lbar[gt * 2 + 1] = li;
        float pr = lr, pi = li;
#pragma unroll
        for (int s = 0; s < 4; ++s) { const float t = pr * pr - pi * pi; pi = 2.f * pr * pi; pr = t; }
        l16[gt * 2] = pr; l16[gt * 2 + 1] = pi;
#pragma unroll
        for (int s = 0; s < 2; ++s) { const float t = pr * pr - pi * pi; pi = 2.f * pr * pi; pr = t; }
        l64[gt * 2] = pr; l64[gt * 2 + 1] = pi;
        bf16_t* bfr = (bf16_t*)X.bfrag; bf16_t* cfr = (bf16_t*)X.cfrag;
        const int ntr = p >> 4, col = p & 15;
        for (int c = 0; c < 16; ++c) {
            const float br = KAF(b_re)[(pb * 64 + p) * 16 + c], bi = KAF(b_im)[(pb * 64 + p) * 16 + c];
            const float bbr = zr * br - zi * bi, bbi = zr * bi + zi * br;
            const int q = c >> 3, j = c & 7;
            bfr[(((size_t)dg * 8 + ntr) * 64 + col + 16 * q) * 8 + j] = (bf16_t)f2bf(bbr);
            bfr[(((size_t)dg * 8 + 4 + ntr) * 64 + col + 16 * q) * 8 + j] = (bf16_t)f2bf(bbi);
            bfr[(((size_t)dg * 8 + ntr) * 64 + col + 16 * (q + 2)) * 8 + j] = 0;
            bfr[(((size_t)dg * 8 + 4 + ntr) * 64 + col + 16 * (q + 2)) * 8 + j] = 0;
            const float cr = KAF(c_re)[(pb * 16 + c) * 64 + p], ci = KAF(c_im)[(pb * 16 + c) * 64 + p];
            { const int k = p;      cfr[(((size_t)dg * 4 + (k >> 5)) * 64 + c + 16 * ((k >> 3) & 3)) * 8 + (k & 7)] = (bf16_t)f2bf(cr); }
            { const int k = 64 + p; cfr[(((size_t)dg * 4 + (k >> 5)) * 64 + c + 16 * ((k >> 3) & 3)) * 8 + (k & 7)] = (bf16_t)f2bf(-ci); }
        }
    }
    if (gt >= 2048 && gt < 2048 + 256) {
        const int c = gt - 2048;
        const float l0 = KAF(lb_logits)[c], l1 = KAF(lb_logits)[256 + c], l2 = KAF(lb_logits)[512 + c], l3 = KAF(lb_logits)[768 + c];
        const float mx = fmaxf(fmaxf(l0, l1), fmaxf(l2, l3));
        const float e0 = expf(l0 - mx), e1 = expf(l1 - mx), e2 = expf(l2 - mx), e3 = expf(l3 - mx), inv = 1.f / (e0 + e1 + e2 + e3);
        float v = 0.f; if (l >= 1) v += e1 * inv; if (l >= 2) v += e2 * inv; if (l >= 3) v += e3 * inv;
        ((float*)X.lb)[c] = v;
    }
}

struct Grp { int g, nseq, Lr, nch, s0; };
__device__ __forceinline__ Grp make_grp(int g) { Grp r; r.g = g; r.nseq = g < 2 ? 4 : 1; r.Lr = g < 2 ? 4096 : 16384; r.nch = r.Lr / 64 + 1; r.s0 = g < 2 ? g * 4 : 8 + (g - 2); return r; }

template <bool OUT>
__device__ __forceinline__ void s5_chunk(const Ctx& X, const float* s5d, LAS float* buf, bf16_t* zc, int T, int ci, int wave, int lane) {
    const int p = lane, fr = lane & 15, fq = lane >> 4;
    for (int gi = 0; gi < 2; ++gi) {
        const int g = wave * 2 + gi;
        f32x4 yacc[2][2];
#pragma unroll
        for (int i = 0; i < 2; ++i)
#pragma unroll
            for (int j = 0; j < 2; ++j) yacc[i][j] = (f32x4){0.f, 0.f, 0.f, 0.f};
#pragma unroll
        for (int dir = 0; dir < 2; ++dir) {
            const int dg = dir * 16 + g;
            const float lr = X.lbar[(dg * 64 + p) * 2], li = X.lbar[(dg * 64 + p) * 2 + 1];
            float xr = 0.f, xi = 0.f;
            float* st = X.s5s + ((size_t)ci * 2048 + dg * 64 + p) * 2;
            if (OUT) { xr = st[0]; xi = st[1]; }
#pragma unroll
            for (int sti = 0; sti < 2; ++sti) {
                const int stt = dir ? 1 - sti : sti; const int t0 = stt * 32;
                if (t0 < T) {
                    const int tn = (T - t0) < 32 ? (T - t0) : 32;
#pragma unroll
                    for (int mt = 0; mt < 2; ++mt) {
                        if (mt * 16 < tn) {
                            bf16x8 av = (bf16x8){0, 0, 0, 0, 0, 0, 0, 0};
                            if (fq < 2) av = *(const bf16x8*)(zc + (size_t)(t0 + mt * 16 + fr) * ZW + g * 16 + fq * 8);
#pragma unroll
                            for (int nt = 0; nt < 8; ++nt) {
                                const bf16x8 bv = *(const bf16x8*)(X.bfrag + (((size_t)dg * 8 + nt) * 64 + lane) * 8);
                                const f32x4 c = __builtin_amdgcn_mfma_f32_16x16x32_bf16(av, bv, (f32x4){0.f, 0.f, 0.f, 0.f}, 0, 0, 0);
#pragma unroll
                                for (int r = 0; r < 4; ++r) buf[(mt * 16 + fq * 4 + r) * 132 + nt * 16 + fr] = c[r];
                            }
                        }
                    }
                    __syncthreads();
                    for (int k = 0; k < tn; ++k) {
                        const int t = dir ? (tn - 1 - k) : k;
                        const float br = buf[t * 132 + p], bi = buf[t * 132 + 64 + p];
                        const float nr = lr * xr - li * xi + br, ni = lr * xi + li * xr + bi;
                        xr = nr; xi = ni;
                        if (OUT) { buf[t * 132 + p] = xr; buf[t * 132 + 64 + p] = xi; }
                    }
                    if (OUT) {
                        __syncthreads();
#pragma unroll
                        for (int mt = 0; mt < 2; ++mt) {
                            if (mt * 16 < tn) {
#pragma unroll
                                for (int ks = 0; ks < 4; ++ks) {
                                    const LAS float* ap = buf + (mt * 16 + fr) * 132 + ks * 32 + fq * 8;
                                    const f32x4 a0 = *(const LAS f32x4*)ap, a1 = *(const LAS f32x4*)(ap + 4);
                                    const u32x4 aw = pack8(a0, a1);
                                    const bf16x8 av = __builtin_bit_cast(bf16x8, aw);
                                    const bf16x8 bv = *(const bf16x8*)(X.cfrag + (((size_t)dg * 4 + ks) * 64 + lane) * 8);
                                    yacc[stt][mt] = __builtin_amdgcn_mfma_f32_16x16x32_bf16(av, bv, yacc[stt][mt], 0, 0, 0);
                                }
                            }
                        }
                    }
                    __syncthreads();
                }
            }
            if (!OUT) { st[0] = xr; st[1] = xi; }
        }
        if (OUT) {
            const float dsk = s5d[g * 16 + fr];
#pragma unroll
            for (int stt = 0; stt < 2; ++stt)
#pragma unroll
                for (int mt = 0; mt < 2; ++mt) {
                    if (stt * 32 + mt * 16 < T) {
#pragma unroll
                        for (int r = 0; r < 4; ++r) {
                            const int t = stt * 32 + mt * 16 + fq * 4 + r;
                            bf16_t* zr = zc + (size_t)t * ZW;
                            const float u = bf2f(zr[g * 16 + fr]);
                            const float y = gelu_tanh(yacc[stt][mt][r] + dsk * u);
                            zr[512 + g * 16 + fr] = (bf16_t)f2bf(y);
                        }
                    }
                }
        }
    }
}

__device__ __forceinline__ void s5_passB(const Ctx& X, const Grp& gp, int gtid, int GT) {
    const int n = gp.nseq * 2048;
    for (int e = gtid; e < n; e += GT) {
        const int sl = e >> 11, r = e & 2047, dir = r >> 10;
        const float l16r = X.l16[r * 2], l16i = X.l16[r * 2 + 1], l64r = X.l64[r * 2], l64i = X.l64[r * 2 + 1];
        float sr = 0.f, si = 0.f;
        for (int k0 = 0; k0 < gp.nch; k0 += 8) {
            float er[8], ei[8];
#pragma unroll
            for (int j = 0; j < 8; ++j) { const int k = k0 + j; if (k < gp.nch) { const int c = dir ? gp.nch - 1 - k : k; const float* pp = X.s5s + ((size_t)(sl * gp.nch + c) * 2048 + r) * 2; er[j] = pp[0]; ei[j] = pp[1]; } else { er[j] = 0.f; ei[j] = 0.f; } }
#pragma unroll
            for (int j = 0; j < 8; ++j) { const int k = k0 + j; if (k < gp.nch) { const int c = dir ? gp.nch - 1 - k : k; float* pp = X.s5s + ((size_t)(sl * gp.nch + c) * 2048 + r) * 2; pp[0] = sr; pp[1] = si;
                    const float pr = c == 0 ? l16r : l64r, pi = c == 0 ? l16i : l64i;
                    const float nr = pr * sr - pi * si + er[j], ni = pr * si + pi * sr + ei[j]; sr = nr; si = ni; } }
        }
    }
}

template <bool OUT>
__device__ __forceinline__ void hg_chunk(const Ctx& X, LAS float* gt, LAS bf16_t* ot, const bf16_t* zc, int T, int ci, int wave, int lane) {
    const int h = wave >> 1, dir = wave & 1;
    float S[64];
    float* U = X.hgu + ((size_t)ci * 8 + wave) * 4096;
    if (OUT) {
#pragma unroll
        for (int d = 0; d < 64; ++d) S[d] = U[d * 64 + lane];
    } else {
#pragma unroll
        for (int d = 0; d < 64; ++d) S[d] = 0.f;
    }
    const float lbv = X.lb[h * 64 + lane], oml = 1.f - lbv; float P = 1.f;
    const int fcol = (dir ? 2304 : 2048) + h * 64 + lane, qcol = 1792 + h * 64 + lane, vcol = 2560 + h * 64 + lane;
    const int ns8 = T >> 3;
#pragma unroll 1
    for (int s8 = 0; s8 < ns8; ++s8) {
        const int sb = dir ? (ns8 - 1 - s8) : s8;
#pragma unroll
        for (int j = 0; j < 8; ++j) {
            const bf16_t* zr = zc + (size_t)(sb * 8 + j) * ZW;
            const float q = bf2f(zr[qcol]), ff = bf2f(zr[fcol]);
            const float sg = sigm(ff), fg = lbv + oml * sg, kk = oml * (1.f - sg);
            gt[j * 256 + lane] = fg; gt[j * 256 + 64 + lane] = kk; gt[j * 256 + 128 + lane] = q * sigm(q); gt[j * 256 + 192 + lane] = bf2f(zr[vcol]);
            P *= fg;
        }
        __syncthreads();
#pragma unroll 1
        for (int jj = 0; jj < 8; ++jj) {
            const int j = dir ? 7 - jj : jj;
            const LAS float* gj = gt + j * 256;
            const float v = gj[192 + lane];
            float o = 0.f;
#pragma unroll
            for (int d4 = 0; d4 < 16; ++d4) {
                const f32x4 f4 = *(const LAS f32x4*)(gj + d4 * 4), k4 = *(const LAS f32x4*)(gj + 64 + d4 * 4);
#pragma unroll
                for (int i = 0; i < 4; ++i) S[d4 * 4 + i] = f4[i] * S[d4 * 4 + i] + k4[i] * v;
                if (OUT) { const f32x4 q4 = *(const LAS f32x4*)(gj + 128 + d4 * 4);
#pragma unroll
                    for (int i = 0; i < 4; ++i) o += S[d4 * 4 + i] * q4[i]; }
                if ((d4 & 3) == 3) __builtin_amdgcn_sched_barrier(0);
            }
            if (OUT) ot[(sb * 8 + j) * 64 + lane] = (bf16_t)f2bf(o);
        }
        __syncthreads();
    }
    if (!OUT) {
#pragma unroll
        for (int d = 0; d < 64; ++d) U[d * 64 + lane] = S[d];
        X.hgp[((size_t)ci * 8 + wave) * 64 + lane] = P;
    }
}

__device__ __forceinline__ void hg_passB(const Ctx& X, const Grp& gp, int gtid, int GT) {
    const int n = gp.nseq * 32768;
    for (int e = gtid; e < n; e += GT) {
        const int sl = e >> 15, r = e & 32767, hd = r >> 12, de = r & 4095, d = de >> 6, dir = hd & 1;
        float s = 0.f;
        for (int k0 = 0; k0 < gp.nch; k0 += 8) {
            float u[8], pv[8];
#pragma unroll
            for (int j = 0; j < 8; ++j) { const int k = k0 + j; if (k < gp.nch) { const int c = dir ? gp.nch - 1 - k : k; const size_t cb = (size_t)(sl * gp.nch + c) * 8 + hd; u[j] = X.hgu[cb * 4096 + de]; pv[j] = X.hgp[cb * 64 + d]; } else { u[j] = 0.f; pv[j] = 0.f; } }
#pragma unroll
            for (int j = 0; j < 8; ++j) { const int k = k0 + j; if (k < gp.nch) { const int c = dir ? gp.nch - 1 - k : k; const size_t cb = (size_t)(sl * gp.nch + c) * 8 + hd; X.hgu[cb * 4096 + de] = s; s = pv[j] * s + u[j]; } }
        }
    }
}

__device__ __forceinline__ void na_task(const Ctx& X, const float* rpb, const Grp& gp, int sl, int task, bool metaq, int wave, int lane) {
    const int h = wave, fr = lane & 15, fq = lane >> 4;
    const int s = gp.s0 + sl, rows = gp.Lr >> 6;
    int r = 0, n = 0, rs = 0, ks = 0;
    const bf16_t* qptr; bf16_t* optr; size_t ostride = 512;
    if (metaq) { qptr = X.mz + (size_t)(s * 16 + fr) * ZW; optr = X.myb + (size_t)(s * 16) * 512; }
    else {
        r = task >> 2; n = task & 3;
        rs = r - 4; rs = rs < 0 ? 0 : (rs > rows - 8 ? rows - 8 : rs);
        ks = 16 * n - 8; ks = ks < 0 ? 0 : (ks > 32 ? 32 : ks);
        const size_t qrow0 = (size_t)sl * gp.Lr + r * 64 + 16 * n;
        qptr = X.z + (qrow0 + fr) * ZW; optr = X.yb + qrow0 * 512;
    }
    bf16x8 qf[2];
#pragma unroll
    for (int kk = 0; kk < 2; ++kk) qf[kk] = *(const bf16x8*)(qptr + 256 + h * 64 + 32 * kk + 8 * fq);
    f32x4 sc[17];
    {
        const bf16_t* kp = X.mz + (size_t)(s * 16 + fr) * ZW + 768 + h * 64 + 8 * fq;
        f32x4 c = (f32x4){0.f, 0.f, 0.f, 0.f};
#pragma unroll
        for (int kk = 0; kk < 2; ++kk) c = __builtin_amdgcn_mfma_f32_16x16x32_bf16(*(const bf16x8*)(kp + 32 * kk), qf[kk], c, 0, 0, 0);
        sc[0] = c * 0.125f;
    }
    const int qc = 16 * n + fr;
    int wstart = qc - 8; wstart = wstart < 0 ? 0 : (wstart > 48 ? 48 : wstart);
    const size_t krow_base = (size_t)sl * gp.Lr + (size_t)rs * 64 + ks;
    if (!metaq) {
#pragma unroll
        for (int tt = 0; tt < 16; ++tt) {
            const int kj = tt >> 1, half = tt & 1;
            const bf16_t* kp = X.z + (krow_base + kj * 64 + 16 * half + fr) * ZW + 768 + h * 64 + 8 * fq;
            f32x4 c = (f32x4){0.f, 0.f, 0.f, 0.f};
#pragma unroll
            for (int kk = 0; kk < 2; ++kk) c = __builtin_amdgcn_mfma_f32_16x16x32_bf16(*(const bf16x8*)(kp + 32 * kk), qf[kk], c, 0, 0, 0);
            const int dr = rs + kj - r + 7;
            const float* rp = rpb + (h * 15 + dr) * 31;
#pragma unroll
            for (int i = 0; i < 4; ++i) {
                const int kc = ks + 16 * half + 4 * fq + i;
                const bool valid = (kc >= wstart) && (kc < wstart + 16);
                int dc = kc - qc; dc = dc < -15 ? -15 : (dc > 15 ? 15 : dc); dc += 15;
                c[i] = valid ? c[i] * 0.125f + rp[dc] : -1e30f;
            }
            sc[1 + tt] = c;
            if ((tt & 3) == 3) __builtin_amdgcn_sched_barrier(0);
        }
    } else {
#pragma unroll
        for (int tt = 0; tt < 16; ++tt) sc[1 + tt] = (f32x4){-1e30f, -1e30f, -1e30f, -1e30f};
    }
    float mx = -1e30f;
#pragma unroll
    for (int t = 0; t < 17; ++t)
#pragma unroll
        for (int i = 0; i < 4; ++i) mx = fmaxf(mx, sc[t][i]);
    mx = fmaxf(mx, __shfl_xor(mx, 16)); mx = fmaxf(mx, __shfl_xor(mx, 32));
    float sum = 0.f;
#pragma unroll
    for (int t = 0; t < 17; ++t)
#pragma unroll
        for (int i = 0; i < 4; ++i) { const float e = __expf(sc[t][i] - mx); sc[t][i] = e; sum += e; }
    sum += __shfl_xor(sum, 16); sum += __shfl_xor(sum, 32);
    const float inv = 1.f / sum;
    f32x4 oacc[4];
#pragma unroll
    for (int et = 0; et < 4; ++et) oacc[et] = (f32x4){0.f, 0.f, 0.f, 0.f};
#pragma unroll
    for (int kst = 0; kst < 9; ++kst) {
        const int ta = 2 * kst, tb = 2 * kst + 1;
        if (kst > 0 && metaq) break;
        f32x4 pa = sc[ta] * inv, pb = (f32x4){0.f, 0.f, 0.f, 0.f};
        if (tb < 17) pb = sc[tb] * inv;
        const bf16x8 pf = __builtin_bit_cast(bf16x8, pack8(pa, pb));
#pragma unroll
        for (int et = 0; et < 4; ++et) {
            const int e = h * 64 + et * 16 + fr;
            u32x2 va, vb = (u32x2){0u, 0u};
            if (ta == 0) va = *(const u32x2*)(X.mvt + (size_t)e * 256 + s * 16 + 4 * fq);
            else { const int tt = ta - 1; va = *(const u32x2*)(X.vt + (size_t)e * VTLD + krow_base + (tt >> 1) * 64 + 16 * (tt & 1) + 4 * fq); }
            if (tb < 17 && !metaq) { const int tt = tb - 1; vb = *(const u32x2*)(X.vt + (size_t)e * VTLD + krow_base + (tt >> 1) * 64 + 16 * (tt & 1) + 4 * fq); }
            const u32x4 vw = (u32x4){va.x, va.y, vb.x, vb.y};
            oacc[et] = __builtin_amdgcn_mfma_f32_16x16x32_bf16(pf, __builtin_bit_cast(bf16x8, vw), oacc[et], 0, 0, 0);
        }
    }
#pragma unroll
    for (int et = 0; et < 4; ++et)
#pragma unroll
        for (int i = 0; i < 4; ++i) optr[(size_t)(4 * fq + i) * ostride + h * 64 + et * 16 + fr] = (bf16_t)f2bf(oacc[et][i]);
}

#define XB_TMO      128
#define XB_XCNT(j)  (256  + 64 * (j))
#define XB_XSUB(j)  (1280 + 64 * (j))
#define XB_XGEN(j)  (2304 + 64 * (j))
#define XB_TOP      3328
#define XB_TOPGEN   3392
#define XCD_BAR_WORDS 3456
#define XB_SPIN_CAP (1u << 22)
__device__ __forceinline__ unsigned xb_ld(unsigned* p)              { return __hip_atomic_load(p, __ATOMIC_RELAXED, __HIP_MEMORY_SCOPE_AGENT); }
__device__ __forceinline__ unsigned xb_add(unsigned* p, unsigned v) { return __hip_atomic_fetch_add(p, v, __ATOMIC_RELAXED, __HIP_MEMORY_SCOPE_AGENT); }
__device__ __forceinline__ unsigned xb_xcc_id() { return (unsigned)__builtin_amdgcn_s_getreg((3 << 11) | 20) & 0xFu; }
#define XB_SPIN(cond, bar) do { unsigned _sp = 0; while (cond) { __builtin_amdgcn_s_sleep(1); \
    if ((++_sp & 255u) == 0u) { if (xb_ld(&(bar)[XB_TMO])) break; if (_sp > XB_SPIN_CAP) { atomicAdd(&(bar)[XB_TMO], 1u); break; } } } } while (0)
__device__ __forceinline__ void xcd_barrier_complete(unsigned* bar, unsigned x, unsigned& nloc, unsigned& nx) {
    const unsigned G = gridDim.x * gridDim.y * gridDim.z;
    unsigned sum, cnt, mine, sp = 0u;
    for (;;) {
        sum = 0u; cnt = 0u; mine = 0u;
#pragma unroll
        for (unsigned j = 0; j < 16; ++j) { const unsigned c = xb_ld(&bar[XB_XCNT(j)]); sum += c; cnt += (c > 0u) ? 1u : 0u; mine = (j == x) ? c : mine; }
        if (sum == G) break;
        __builtin_amdgcn_s_sleep(1);
        if ((++sp & 255u) == 0u) { if (xb_ld(&bar[XB_TMO])) break; if (sp > XB_SPIN_CAP) { atomicAdd(&bar[XB_TMO], 1u); break; } }
    }
    nloc = mine > 0u ? mine : 1u; nx = cnt > 0u ? cnt : 1u;
}
__device__ __forceinline__ void xcd_barrier(unsigned* bar, volatile LAS unsigned* st) {
    asm volatile("s_waitcnt vmcnt(0)" ::: "memory");
    __syncthreads();
    if (threadIdx.x == 0) {
        const unsigned x = xb_xcc_id();
        __builtin_amdgcn_s_waitcnt(0);
        unsigned nloc = st[0], nx = st[1];
        if (nloc == 0u) { xcd_barrier_complete(bar, x, nloc, nx); st[0] = nloc; st[1] = nx; }
        const unsigned old = xb_add(&bar[XB_XSUB(x)], 1u);
        const unsigned gen = old / nloc;
        if (old + 1u == (gen + 1u) * nloc) {
            __builtin_amdgcn_fence(__ATOMIC_RELEASE, "agent");
            asm volatile("s_waitcnt vmcnt(0)" ::: "memory");
            const unsigned og = xb_add(&bar[XB_TOP], 1u);
            const unsigned tg = og / nx;
            if (og + 1u == (tg + 1u) * nx) xb_add(&bar[XB_TOPGEN], 1u);
            else XB_SPIN(xb_ld(&bar[XB_TOPGEN]) == tg, bar);
            __builtin_amdgcn_fence(__ATOMIC_ACQUIRE, "agent");
            xb_add(&bar[XB_XGEN(x)], 1u);
            asm volatile("s_waitcnt vmcnt(0)" ::: "memory");
        } else {
            XB_SPIN(xb_ld(&bar[XB_XGEN(x)]) == gen, bar);
            __builtin_amdgcn_fence(__ATOMIC_ACQUIRE, "agent");
            asm volatile("s_waitcnt vmcnt(0)" ::: "memory");
        }
    }
    __syncthreads();
}
#define GRID_SYNC() xcd_barrier((unsigned*)(KA(ws) + WS_CTL), (volatile LAS unsigned*)(lds + LDS_ST_OFF))
__device__ __forceinline__ Ctx make_ctx(unsigned char* ws) {
    Ctx X;
    X.hb = (bf16_t*)(ws + WS_HB); X.ssq = (float*)(ws + WS_SSQ); X.z = (bf16_t*)(ws + WS_Z); X.yb = (bf16_t*)(ws + WS_YB); X.vt = (bf16_t*)(ws + WS_VT);
    X.hgu = (float*)(ws + WS_HGU); X.hgp = (float*)(ws + WS_HGP); X.s5s = (float*)(ws + WS_S5S); X.w = (bf16_t*)(ws + WS_W);
    X.lbar = (const float*)(ws + WS_TAB + T_LBAR); X.l16 = (const float*)(ws + WS_TAB + T_L16); X.l64 = (const float*)(ws + WS_TAB + T_L64);
    X.bfrag = (const bf16_t*)(ws + WS_TAB + T_BFRAG); X.cfrag = (const bf16_t*)(ws + WS_TAB + T_CFRAG); X.lb = (const float*)(ws + WS_TAB + T_LB);
    X.mh = (float*)(ws + WS_META + M_H); X.mhb = (bf16_t*)(ws + WS_META + M_HB); X.mssq = (float*)(ws + WS_META + M_SSQ); X.mz = (bf16_t*)(ws + WS_META + M_Z);
    X.myb = (bf16_t*)(ws + WS_META + M_YB); X.mvt = (bf16_t*)(ws + WS_META + M_VT); X.mact = (bf16_t*)(ws + WS_META + M_ACT);
    return X;
}

__device__ __forceinline__ bool make_job(unsigned char* ws, float* out, int l, int g, int ph, int j, pg8::Gemm& gm, pg8::UberEpi& ep) {
    const bool mchain = (g == 3) && (l < NLAYER - 1);
    int njobs = 1; bool meta = false; int sub = j;
    if (ph == 0) { njobs = (g == 0) ? 2 : 1; meta = (j == 1); }
    else if (ph == 4) { njobs = (g == 3) ? 2 : 1; meta = (j == 1); }
    else if (ph == 5) { njobs = mchain ? 6 : 3; meta = (j >= 3); sub = j % 3; }
    else { njobs = mchain ? 2 : 1; meta = (j == 1); }
    if (j >= njobs) return false;
    unsigned char* wb = ws + WS_W;
    const size_t r0 = (size_t)g * RG;
    unsigned char* mb = ws + WS_META;
    bf16_t* z = meta ? (bf16_t*)(mb + M_Z) : (bf16_t*)(ws + WS_Z);
    bf16_t* hb = meta ? (bf16_t*)(mb + M_HB) : (bf16_t*)(ws + WS_HB) + r0 * DM;
    float* ssq = meta ? (float*)(mb + M_SSQ) : (float*)(ws + WS_SSQ) + r0 * 4;
    float* h = meta ? (float*)(mb + M_H) : out + r0 * DM;
    bf16_t* yb = meta ? (bf16_t*)(mb + M_YB) : (bf16_t*)(ws + WS_YB);
    bf16_t* vt = meta ? (bf16_t*)(mb + M_VT) : (bf16_t*)(ws + WS_VT);
    bf16_t* act = meta ? (bf16_t*)(mb + M_ACT) : (bf16_t*)(ws + WS_Z);
    gm.M = meta ? 256 : RG;
    ep.i0 = 0; ep.p0 = nullptr; ep.p1 = nullptr; ep.p2 = nullptr;
    if (ph == 0) { gm.A = hb; gm.lda = DM; gm.Bt = (const bf16_t*)(wb + W_IN); gm.N = ZN; gm.K = DM; ep.mode = 0; ep.p0 = (unsigned char*)z; ep.p1 = (unsigned char*)ssq; ep.p2 = (unsigned char*)vt; ep.i0 = meta ? 256 : VTLD; }
    else if (ph == 4) { gm.A = z + 512; gm.lda = ZW; gm.Bt = (const bf16_t*)(wb + W_GLU); gm.N = 256; gm.K = 256; ep.mode = 1; ep.p0 = (unsigned char*)z; }
    else if (ph == 5) {
        gm.N = DM; ep.p0 = (unsigned char*)z;
        if (sub == 0) { gm.A = yb; gm.lda = 512; gm.Bt = (const bf16_t*)(wb + W_UPB); gm.K = 512; ep.mode = 2; ep.i0 = 4096; }
        else if (sub == 1) { gm.A = z + 256; gm.lda = ZW; gm.Bt = (const bf16_t*)(wb + W_UPC); gm.K = 256; ep.mode = 3; ep.i0 = 5120; }
        else { gm.A = z; gm.lda = ZW; gm.Bt = (const bf16_t*)(wb + W_UPA); gm.K = 256; ep.mode = 3; ep.i0 = 3072; }
    }
    else if (ph == 6) { gm.A = z + 1024; gm.lda = ZW; gm.Bt = (const bf16_t*)(wb + W_O); gm.N = DM; gm.K = DM; ep.mode = 4; ep.p0 = (unsigned char*)h; ep.p1 = (unsigned char*)hb; ep.p2 = (unsigned char*)ssq; }
    else if (ph == 7) { gm.A = hb; gm.lda = DM; gm.Bt = (const bf16_t*)(wb + W_GU); gm.N = 2 * FFH; gm.K = DM; ep.mode = 5; ep.p0 = (unsigned char*)act; ep.p1 = (unsigned char*)ssq; }
    else { gm.A = act; gm.lda = FFH; gm.Bt = (const bf16_t*)(wb + W_DN); gm.N = DM; gm.K = FFH; ep.mode = 4; ep.p0 = (unsigned char*)h; ep.p1 = (unsigned char*)hb; ep.p2 = (unsigned char*)ssq; }
    return true;
}

__device__ __forceinline__ void prologue(int G) {
    const int tid_ = opaque_tid(); const int lane = tid_ & 63, gw = blockIdx.x * 8 + __builtin_amdgcn_readfirstlane(tid_ >> 6), NGW = G * 8;
    const Ctx X = make_ctx(((unsigned char*)KA(ws)));
    for (int row = gw; row < RMAIN + 256; row += NGW) {
        const bool ismeta = row >= RMAIN; const int mr = row - RMAIN;
        const float* src = ismeta ? (mr < 160 ? KAF(meta_tokens) + (size_t)(mr & 15) * DM : nullptr) : (row < 32768 ? KAF(x_prompt) + (size_t)row * DM : KAF(x_sample) + (size_t)(row - 32768) * DM);
        float* hd = ismeta ? X.mh + (size_t)mr * DM : ((float*)KA(out)) + (size_t)row * DM;
        bf16_t* hbd = ismeta ? X.mhb + (size_t)mr * DM : X.hb + (size_t)row * DM;
        float* sq = ismeta ? X.mssq + (size_t)mr * 4 : X.ssq + (size_t)row * 4;
        float ss = 0.f;
#pragma unroll
        for (int j = 0; j < 4; ++j) {
            f32x4 v = (f32x4){0.f, 0.f, 0.f, 0.f}; if (src) v = *(const f32x4*)(src + j * 256 + lane * 4);
            *(f32x4*)(hd + j * 256 + lane * 4) = v;
            *(u32x2*)(hbd + j * 256 + lane * 4) = (u32x2){pk2(v[0], v[1]), pk2(v[2], v[3])};
            ss += (v[0] * v[0] + v[1] * v[1]) + (v[2] * v[2] + v[3] * v[3]);
        }
        ss = wave_sum(ss);
        if (lane < 4) sq[lane] = lane == 0 ? ss : 0.f;
    }
}

__device__ __forceinline__ void mixer_phase_A(int l, int g, LAS unsigned char* lds, int G, int bid) {
    const int tid_ = opaque_tid(); const int lane = tid_ & 63, wave = __builtin_amdgcn_readfirstlane(tid_ >> 6);
    const Ctx X = make_ctx(((unsigned char*)KA(ws))); const Grp gp = make_grp(g);
    const float* rpb = KAF(rpb) + (size_t)l * 8 * 15 * 31; const float* s5d = KAF(s5_d) + l * 256;
    const int nna = gp.nseq * (gp.Lr / 16), nmq = gp.nseq, nck = gp.nseq * gp.nch;
    const int ntask = nna + nmq + 2 * nck;
    for (int t = bid; t < ntask; t += G) {
        __syncthreads();
        if (t < nna) { const int per = gp.Lr / 16; na_task(X, rpb, gp, t / per, t % per, false, wave, lane); }
        else if (t < nna + nmq) { na_task(X, rpb, gp, t - nna, 0, true, wave, lane); }
        else {
            const int u = t - nna - nmq; const bool isS5 = u < nck; const int ci = isS5 ? u : u - nck;
            const int sl = ci / gp.nch, c = ci % gp.nch; const int T = c == 0 ? 16 : 64;
            bf16_t* zc = c == 0 ? X.mz + (size_t)((gp.s0 + sl) * 16) * ZW : X.z + ((size_t)sl * gp.Lr + 64 * (c - 1)) * ZW;
            if (isS5) s5_chunk<false>(X, s5d, (LAS float*)(lds + wave * 16896), zc, T, ci, wave, lane);
            else hg_chunk<false>(X, (LAS float*)(lds + wave * 8192), (LAS bf16_t*)(lds + 65536 + wave * 8192), zc, T, ci, wave, lane);
        }
    }
}

__device__ __forceinline__ void mixer_phase_C(int l, int g, LAS unsigned char* lds, int G, int bid) {
    const int tid_ = opaque_tid(); const int lane = tid_ & 63, wave = __builtin_amdgcn_readfirstlane(tid_ >> 6);
    const Ctx X = make_ctx(((unsigned char*)KA(ws))); const Grp gp = make_grp(g);
    const float* s5d = KAF(s5_d) + l * 256; const float* ong = KAF(onorm_g) + l * 64;
    const int nck = gp.nseq * gp.nch;
    for (int t = bid; t < 2 * nck; t += G) {
        __syncthreads();
        const bool isS5 = t < nck; const int ci = isS5 ? t : t - nck;
        const int sl = ci / gp.nch, c = ci % gp.nch; const int T = c == 0 ? 16 : 64;
        bf16_t* zc = c == 0 ? X.mz + (size_t)((gp.s0 + sl) * 16) * ZW : X.z + ((size_t)sl * gp.Lr + 64 * (c - 1)) * ZW;
        if (isS5) s5_chunk<true>(X, s5d, (LAS float*)(lds + wave * 16896), zc, T, ci, wave, lane);
        else {
            hg_chunk<true>(X, (LAS float*)(lds + wave * 8192), (LAS bf16_t*)(lds + 65536 + wave * 8192), zc, T, ci, wave, lane);
            __syncthreads();
            const int h = wave >> 1, half = wave & 1;
            const LAS bf16_t* of = (const LAS bf16_t*)(lds + 65536 + (2 * h) * 8192); const LAS bf16_t* ob = (const LAS bf16_t*)(lds + 65536 + (2 * h + 1) * 8192);
            const float gn = ong[lane];
            for (int tt = half * (T / 2); tt < (half + 1) * (T / 2); ++tt) {
                const float o = bf2f(of[tt * 64 + lane]) + bf2f(ob[tt * 64 + lane]);
                const float ms = wave_sum(o * o) * (1.0f / 64.0f);
                bf16_t* zr = zc + (size_t)tt * ZW;
                const float go = bf2f(zr[2816 + h * 64 + lane]);
                zr[256 + h * 64 + lane] = (bf16_t)f2bf(o * rsqrtf(ms + 1e-6f) * gn * (go * sigm(go)));
            }
        }
    }
}

__global__ void __launch_bounds__(512, 2) fwd_kernel(Args a) {
    extern __shared__ __attribute__((aligned(16))) unsigned char lds_raw[];
    LAS unsigned char* lds = (LAS unsigned char*)lds_raw;
    const int G = gridDim.x, bid = blockIdx.x;

    if (threadIdx.x < 2) ((volatile LAS unsigned*)(lds + LDS_ST_OFF))[threadIdx.x] = 0u;
    if (threadIdx.x == 0) (void)xb_add((unsigned*)(KA(ws) + WS_CTL) + XB_XCNT(xb_xcc_id()), 1u);
    __syncthreads();
    prologue(G);

    for (int l = 0; l < NLAYER; ++l) {
        __syncthreads();
        { const Ctx X = make_ctx(((unsigned char*)KA(ws))); prep_layer(X, l, lds, G); }
        if (l == 0) { asm volatile("s_waitcnt vmcnt(0)" ::: "memory"); __syncthreads(); cg::this_grid().sync(); }
        GRID_SYNC();
        for (int g = 0; g < 4; ++g) {
            for (int ph = 0; ph < 9; ++ph) {
                if (ph == 1) mixer_phase_A(l, g, lds, G, bid);
                else if (ph == 2) { const Ctx X = make_ctx(((unsigned char*)KA(ws))); const Grp gp = make_grp(g); const int gtid = bid * 512 + opaque_tid(), GT = G * 512; s5_passB(X, gp, gtid, GT); hg_passB(X, gp, GT - 1 - gtid, GT); }
                else if (ph == 3) mixer_phase_C(l, g, lds, G, bid);
                else {
                    for (int j = 0; j < 6; ++j) {
                        pg8::Gemm gm; pg8::UberEpi ep;
                        if (!make_job(((unsigned char*)KA(ws)), ((float*)KA(out)), l, g, ph, j, gm, ep)) break;
                        pg8::StaticOrder SO; SO.init(gm.M, gm.N, G, bid);
                        pg8::gemm_phase(lds, gm, SO, ep);
                    }
                }
                GRID_SYNC();
            }
        }
    }
    {
        const float* ssq = (const float*)(((unsigned char*)KA(ws)) + WS_SSQ);
        const int tid_ = opaque_tid(); const int lane = tid_ & 63, wave = __builtin_amdgcn_readfirstlane(tid_ >> 6);
        for (int row = bid * 8 + wave; row < RMAIN; row += G * 8) {
            const float rs = pg8::row_rstd(ssq, row);
            float* hp = ((float*)KA(out)) + (size_t)row * DM;
#pragma unroll
            for (int j = 0; j < 4; ++j) {
                f32x4 v = *(const f32x4*)(hp + j * 256 + lane * 4); const f32x4 gv = *(const f32x4*)(KAF(final_g) + j * 256 + lane * 4);
                v = v * rs * gv; *(f32x4*)(hp + j * 256 + lane * 4) = v;
            }
        }
    }
}

extern "C" void kernel_launch(void* const* d_in, const int* in_sizes, int n_in, void* d_out, int out_size, void* d_ws, size_t ws_size, hipStream_t stream) {
    static int grid = 0;
    if (grid == 0) {
        int dev = 0, cus = 0, per_cu = 0;
        (void)hipGetDevice(&dev);
        (void)hipDeviceGetAttribute(&cus, hipDeviceAttributeMultiprocessorCount, dev);
        (void)hipFuncSetAttribute((const void*)fwd_kernel, hipFuncAttributeMaxDynamicSharedMemorySize, LDS_BYTES);
        (void)hipOccupancyMaxActiveBlocksPerMultiprocessor(&per_cu, (const void*)fwd_kernel, 512, LDS_BYTES);
        (void)hipGetLastError();
        if (ws_size < WS_TOTAL) fprintf(stderr, "kernel_launch: workspace too small: %zu < %zu\n", ws_size, (size_t)WS_TOTAL);
        grid = cus > 0 ? cus : 256;
    }
    (void)hipMemsetAsync((char*)d_ws + WS_CTL, 0, CTL_BYTES, stream);
    Args a{};
    const float** pp = (const float**)&a;
    for (int i = 0; i < 26; ++i) pp[i] = (const float*)d_in[i];
    a.out = (float*)d_out; a.ws = (unsigned char*)d_ws;
    void* args[] = {&a};
    hipError_t e = hipLaunchCooperativeKernel((const void*)fwd_kernel, dim3(grid), dim3(512), args, LDS_BYTES, stream);
    if (e != hipSuccess) fprintf(stderr, "cooperative launch failed: %s\n", hipGetErrorString(e));
}
```

```cpp
#include <hip/hip_runtime.h>
#include <hip/hip_cooperative_groups.h>
#include <cstdio>
#include <cstdint>
namespace cg = cooperative_groups;

#define LAS __attribute__((address_space(3)))
typedef unsigned short bf16_t;
typedef short bf16x8 __attribute__((ext_vector_type(8)));
typedef float f32x4 __attribute__((ext_vector_type(4)));
typedef unsigned u32x4 __attribute__((ext_vector_type(4)));
typedef unsigned u32x2 __attribute__((ext_vector_type(2)));

#define WAVE_SYNC() asm volatile("s_waitcnt lgkmcnt(0)" ::: "memory")
__device__ __forceinline__ int opaque_tid() { int t = threadIdx.x; asm volatile("" : "+v"(t)); return t; }

__device__ __forceinline__ unsigned f2bf(float f) { unsigned u = __builtin_bit_cast(unsigned, f); return (u + 0x7fffu + ((u >> 16) & 1u)) >> 16; }
__device__ __forceinline__ unsigned pk2(float lo, float hi) { return f2bf(lo) | (f2bf(hi) << 16); }
__device__ __forceinline__ float bf2f(bf16_t b) { return __builtin_bit_cast(float, (unsigned)b << 16); }
__device__ __forceinline__ float bflo(unsigned w) { return __builtin_bit_cast(float, w << 16); }
__device__ __forceinline__ float bfhi(unsigned w) { return __builtin_bit_cast(float, w & 0xffff0000u); }
__device__ __forceinline__ float sigm(float x) { return 1.f / (1.f + __expf(-x)); }
__device__ __forceinline__ float gelu_tanh(float y) { const float a = 0.7978845608028654f * (y + 0.044715f * y * y * y); const float th = 1.f - 2.f / (__expf(2.f * a) + 1.f); return 0.5f * y * (1.f + th); }
__device__ __forceinline__ u32x4 pack8(f32x4 a, f32x4 b) { u32x4 w; w.x = pk2(a[0], a[1]); w.y = pk2(a[2], a[3]); w.z = pk2(b[0], b[1]); w.w = pk2(b[2], b[3]); return w; }
__device__ __forceinline__ float wave_sum(float v) {
#pragma unroll
    for (int o = 1; o < 64; o <<= 1) v += __shfl_xor(v, o);
    return v;
}

namespace pg8 {
constexpr int ZSTR = 6208;
constexpr int BM = 256, BK = 64, HALF = 128, HTB = HALF * BK * 2, STAGE_BYTES = 8 * HTB, NXCD = 8, WGM = 8;
__host__ __device__ __forceinline__ int lds_byte(int r, int c) { const int st = (r >> 4) * 2 + (c >> 5), rr = r & 15, cc = c & 31, ob = rr * 64 + cc * 2; return st * 1024 + (ob ^ (((ob >> 9) & 1) << 5)); }
__host__ __device__ __forceinline__ void stage_rc(int b, int& R, int& C) { const int st = b / 1024, sb = b % 1024, swz = sb ^ (((sb >> 9) & 1) << 5); R = (st >> 1) * 16 + swz / 64; C = (st & 1) * 32 + (swz % 64) / 2; }
__host__ __device__ __forceinline__ int perm32(int rho) { const int n = rho >> 4, i = rho & 15; return 8 * (i >> 2) + 4 * n + (i & 3); }
struct Unit { int pm, pn; };
struct Gemm { const bf16_t* A; int lda; const bf16_t* Bt; int M, N, K; };
struct StaticOrder {
    int nM, nN, nwg, G, c;
    __device__ void init(int M, int N, int G_, int c_) { nM = M / BM; nN = N / BM; nwg = nM * nN; G = G_; c = c_; }
    __device__ bool next(int i, Unit& u) const {
        const long L = (long)i * G + c; if (L >= nwg) return false;
        int wgid = (int)L; { const int q = nwg / NXCD, r = nwg % NXCD, xcd = wgid % NXCD, off = wgid / NXCD; wgid = (xcd < r ? xcd * (q + 1) : r * (q + 1) + (xcd - r) * q) + off; }
        const int nig = WGM * nN, gid = wgid / nig, fm = gid * WGM, gsz = (nM - fm) < WGM ? (nM - fm) : WGM;
        u.pm = fm + ((wgid % nig) % gsz); u.pn = (wgid % nig) / gsz; return true;
    }
};

struct UberEpi;
__device__ __forceinline__ void run_epi(const UberEpi& E, LAS unsigned char* lds, const f32x4 (&acc)[2][2][4][2], const Unit& u, int wr, int wc, int fr, int fq);
__device__ __forceinline__ void gemm_phase(LAS unsigned char* lds, const Gemm g, const StaticOrder& S, const UberEpi& E) {
    const int tid = opaque_tid(), wid = __builtin_amdgcn_readfirstlane(tid >> 6), lane = tid & 63, wr = wid >> 2, wc = wid & 3, fr = lane & 15, fq = lane >> 4;
    const int K = g.K, nt = K / BK, lda = g.lda;
    unsigned voffA[2], voffB[2];
#pragma unroll
    for (int i = 0; i < 2; ++i) { int R, C; stage_rc(tid * 16 + i * 8192, R, C); const int Rb = (R & ~31) + perm32(R & 31);
        voffA[i] = (unsigned)(R * lda + C) * 2u; voffB[i] = (unsigned)(Rb * K + C) * 2u; }
    const size_t kstep = (size_t)(BK * 2);
    const size_t hstepA = (size_t)HALF * lda * 2, hstepB = (size_t)HALF * K * 2;
    const size_t tstepA = 2 * hstepA, tstepB = 2 * hstepB;
    const unsigned ldsw = (unsigned)wid * 1024u;
    const int aoff = lds_byte(wr * 64 + fr, fq * 8), boff = lds_byte(wc * 32 + fr, fq * 8);
#define PG8_SA(b, h) (((b) * 2 + (h)) * HTB)
#define PG8_SB(b, h) ((4 + (b) * 2 + (h)) * HTB)
#define PG8_STAGE(bufoff, gbase, voff) do { _Pragma("unroll") for (int _i = 0; _i < 2; ++_i) \
        __builtin_amdgcn_global_load_lds((const unsigned*)((const char*)(gbase) + (voff)[_i]), (LAS unsigned*)(lds + (bufoff) + ldsw + _i * 8192), 16, 0, 0); } while (0)
#define PG8_LDA(dst, b, h) do { _Pragma("unroll") for (int m = 0; m < 4; ++m) _Pragma("unroll") for (int k = 0; k < 2; ++k) dst[m][k] = *(const LAS bf16x8*)(lds + PG8_SA(b, h) + aoff + m * 2048 + k * 1024); } while (0)
#define PG8_LDB(dst, b, h) do { _Pragma("unroll") for (int n = 0; n < 2; ++n) _Pragma("unroll") for (int k = 0; k < 2; ++k) dst[n][k] = *(const LAS bf16x8*)(lds + PG8_SB(b, h) + boff + n * 2048 + k * 1024); } while (0)
#define PG8_MMA(ai, bj, At, Bt) do { __builtin_amdgcn_s_setprio(1); _Pragma("unroll") for (int m = 0; m < 4; ++m) _Pragma("unroll") for (int n = 0; n < 2; ++n) _Pragma("unroll") for (int k = 0; k < 2; ++k) \
        acc[ai][bj][m][n] = __builtin_amdgcn_mfma_f32_16x16x32_bf16(Bt[n][k], At[m][k], acc[ai][bj][m][n], 0, 0, 0); __builtin_amdgcn_s_setprio(0); } while (0)
#define PG8_WAIT_V(n) asm volatile("s_waitcnt vmcnt(" #n ")" ::: "memory")
#define PG8_WAIT_L(n) asm volatile("s_waitcnt lgkmcnt(" #n ")" ::: "memory")
#define PG8_BAR __builtin_amdgcn_s_barrier()
#define PG8_SCHED __builtin_amdgcn_sched_barrier(0)
    Unit cur, nxt; int ui = 0;
    if (!S.next(0, cur)) return;
    f32x4 acc[2][2][4][2];
#pragma unroll
    for (int a = 0; a < 2; ++a)
#pragma unroll
        for (int b = 0; b < 2; ++b)
#pragma unroll
            for (int m = 0; m < 4; ++m)
#pragma unroll
                for (int n = 0; n < 2; ++n) acc[a][b][m][n] = (f32x4){0.f, 0.f, 0.f, 0.f};
    bf16x8 At[4][2], B0[2][2], B1[2][2];
    const char* cA = (const char*)g.A + (size_t)cur.pm * tstepA; const char* cB = (const char*)g.Bt + (size_t)cur.pn * tstepB;
    PG8_STAGE(PG8_SB(0, 0), cB, voffB); PG8_STAGE(PG8_SB(0, 1), cB + hstepB, voffB); PG8_STAGE(PG8_SA(0, 0), cA, voffA); PG8_STAGE(PG8_SA(0, 1), cA + hstepA, voffA);
    if (wr == 1) PG8_BAR;
    PG8_WAIT_V(2); PG8_BAR;
    PG8_STAGE(PG8_SB(1, 0), cB + kstep, voffB); PG8_STAGE(PG8_SA(1, 0), cA + kstep, voffA); PG8_STAGE(PG8_SB(1, 1), cB + hstepB + kstep, voffB);
    PG8_WAIT_V(6); PG8_BAR;
    for (;;) {
        const bool has_next = S.next(ui + 1, nxt);
        const char* nA = has_next ? (const char*)g.A + (size_t)nxt.pm * tstepA : cA; const char* nB = has_next ? (const char*)g.Bt + (size_t)nxt.pn * tstepB : cB;
        for (int t = 0; t < nt; t += 2) {
            const bool last = (t == nt - 2);
            const char* a1 = cA + (size_t)(t + 1) * kstep;
            const char* a2 = last ? nA : cA + (size_t)(t + 2) * kstep; const char* b2 = last ? nB : cB + (size_t)(t + 2) * kstep;
            const char* a3 = a2 + kstep; const char* b3 = b2 + kstep;
            PG8_LDB(B0, 0, 0); PG8_LDB(B1, 0, 1); PG8_SCHED; PG8_LDA(At, 0, 0); PG8_STAGE(PG8_SA(1, 1), a1 + hstepA, voffA);
            PG8_WAIT_V(8); PG8_WAIT_L(0); PG8_BAR; PG8_MMA(0, 0, At, B0); PG8_MMA(0, 1, At, B1); PG8_BAR; PG8_SCHED;
            PG8_LDA(At, 0, 1); PG8_STAGE(PG8_SB(0, 0), b2, voffB); PG8_STAGE(PG8_SB(0, 1), b2 + hstepB, voffB); PG8_STAGE(PG8_SA(0, 0), a2, voffA);
            PG8_WAIT_V(8); PG8_WAIT_L(0); PG8_BAR; PG8_MMA(1, 0, At, B0); PG8_MMA(1, 1, At, B1); PG8_BAR; PG8_SCHED;
            PG8_LDB(B0, 1, 0); PG8_LDB(B1, 1, 1); PG8_SCHED; PG8_LDA(At, 1, 0); PG8_STAGE(PG8_SA(0, 1), a2 + hstepA, voffA);
            PG8_WAIT_V(8); PG8_WAIT_L(0); PG8_BAR; PG8_MMA(0, 0, At, B0); PG8_MMA(0, 1, At, B1); PG8_BAR; PG8_SCHED;
            PG8_LDA(At, 1, 1); PG8_STAGE(PG8_SB(1, 0), b3, voffB); PG8_STAGE(PG8_SB(1, 1), b3 + hstepB, voffB); PG8_STAGE(PG8_SA(1, 0), a3, voffA);
            PG8_WAIT_V(8); PG8_WAIT_L(0); PG8_BAR; PG8_MMA(1, 0, At, B0); PG8_MMA(1, 1, At, B1); PG8_BAR; PG8_SCHED;
        }
        if (wr == 0) PG8_BAR;
        run_epi(E, lds, acc, cur, wr, wc, fr, fq);
        if (!has_next) break;
#pragma unroll
        for (int a = 0; a < 2; ++a)
#pragma unroll
            for (int b = 0; b < 2; ++b)
#pragma unroll
                for (int m = 0; m < 4; ++m)
#pragma unroll
                    for (int n = 0; n < 2; ++n) acc[a][b][m][n] = (f32x4){0.f, 0.f, 0.f, 0.f};
        cur = nxt; cA = nA; cB = nB; ++ui;
        if (wr == 1) PG8_BAR;
    }
    PG8_WAIT_V(0);
    PG8_BAR;
#undef PG8_SA
#undef PG8_SB
#undef PG8_STAGE
#undef PG8_LDA
#undef PG8_LDB
#undef PG8_MMA
#undef PG8_WAIT_V
#undef PG8_WAIT_L
#undef PG8_BAR
#undef PG8_SCHED
}

__device__ __forceinline__ float row_rstd(const float* ssq, int row) {
    const f32x4 s0 = *(const f32x4*)(ssq + (size_t)row * 4);
    const float ss = (s0[0] + s0[1]) + (s0[2] + s0[3]);
    return rsqrtf(ss * (1.0f / 1024.0f) + 1e-6f);
}
struct EpiZ {
    bf16_t* z; const float* ssq; bf16_t* vt; int vt_ld;
    __device__ __forceinline__ void operator()(const f32x4 (&acc)[2][2][4][2], const Unit& u, int wr, int wc, int fr, int fq) const {
        const int row0 = u.pm * BM + wr * 64 + fr, col0 = u.pn * BM + wc * 32 + 8 * fq;
        const bool isv = (u.pn == 5 || u.pn == 6);
#pragma unroll
        for (int ai = 0; ai < 2; ++ai)
#pragma unroll
            for (int m = 0; m < 4; ++m) {
                const int row = row0 + ai * HALF + m * 16; const float rs = row_rstd(ssq, row);
#pragma unroll
                for (int bj = 0; bj < 2; ++bj) {
                    const u32x4 w = pack8(acc[ai][bj][m][0] * rs, acc[ai][bj][m][1] * rs);
                    *(u32x4*)(z + (size_t)row * ZSTR + col0 + bj * HALF) = w;
                    if (isv) { const int c = col0 + bj * HALF - 1280;
#pragma unroll
                        for (int i = 0; i < 8; ++i) vt[(size_t)(c + i) * vt_ld + row] = (bf16_t)((w[i >> 1] >> (16 * (i & 1))) & 0xffffu); }
                }
            }
    }
};
struct EpiGlu {
    bf16_t* z;
    __device__ __forceinline__ void operator()(const f32x4 (&acc)[2][2][4][2], const Unit& u, int wr, int wc, int fr, int fq) const {
        const int row0 = u.pm * BM + wr * 64 + fr, col0 = wc * 32 + 8 * fq;
#pragma unroll
        for (int ai = 0; ai < 2; ++ai)
#pragma unroll
            for (int m = 0; m < 4; ++m) {
                const int row = row0 + ai * HALF + m * 16;
#pragma unroll
                for (int bj = 0; bj < 2; ++bj) {
                    bf16_t* zp = z + (size_t)row * ZSTR + col0 + bj * HALF;
                    const u32x4 y = *(const u32x4*)(zp + 512);
                    const f32x4 a0 = acc[ai][bj][m][0], a1 = acc[ai][bj][m][1];
                    f32x4 o0, o1;
                    o0[0] = bflo(y.x) * sigm(a0[0]); o0[1] = bfhi(y.x) * sigm(a0[1]); o0[2] = bflo(y.y) * sigm(a0[2]); o0[3] = bfhi(y.y) * sigm(a0[3]);
                    o1[0] = bflo(y.z) * sigm(a1[0]); o1[1] = bfhi(y.z) * sigm(a1[1]); o1[2] = bflo(y.w) * sigm(a1[2]); o1[3] = bfhi(y.w) * sigm(a1[3]);
                    *(u32x4*)zp = pack8(o0, o1);
                }
            }
    }
};
template <int MODE> struct EpiMix {
    bf16_t* z; int goff;
    __device__ __forceinline__ void operator()(const f32x4 (&acc)[2][2][4][2], const Unit& u, int wr, int wc, int fr, int fq) const {
        const int row0 = u.pm * BM + wr * 64 + fr, col0 = u.pn * BM + wc * 32 + 8 * fq;
#pragma unroll
        for (int ai = 0; ai < 2; ++ai)
#pragma unroll
            for (int m = 0; m < 4; ++m) {
                const int row = row0 + ai * HALF + m * 16;
#pragma unroll
                for (int bj = 0; bj < 2; ++bj) {
                    bf16_t* zr = z + (size_t)row * ZSTR + col0 + bj * HALF;
                    const u32x4 gq = *(const u32x4*)(zr + goff);
                    const f32x4 a0 = acc[ai][bj][m][0], a1 = acc[ai][bj][m][1];
                    f32x4 o0, o1;
                    o0[0] = sigm(bflo(gq.x)) * a0[0]; o0[1] = sigm(bfhi(gq.x)) * a0[1]; o0[2] = sigm(bflo(gq.y)) * a0[2]; o0[3] = sigm(bfhi(gq.y)) * a0[3];
                    o1[0] = sigm(bflo(gq.z)) * a1[0]; o1[1] = sigm(bfhi(gq.z)) * a1[1]; o1[2] = sigm(bflo(gq.w)) * a1[2]; o1[3] = sigm(bfhi(gq.w)) * a1[3];
                    if (MODE == 1) { const u32x4 p = *(const u32x4*)(zr + 1024);
                        o0[0] += bflo(p.x); o0[1] += bfhi(p.x); o0[2] += bflo(p.y); o0[3] += bfhi(p.y); o1[0] += bflo(p.z); o1[1] += bfhi(p.z); o1[2] += bflo(p.w); o1[3] += bfhi(p.w); }
                    *(u32x4*)(zr + 1024) = pack8(o0, o1);
                }
            }
    }
};
struct EpiRes {
    float* h; bf16_t* hb; float* ssq; LAS float* red;
    __device__ __forceinline__ void operator()(const f32x4 (&acc)[2][2][4][2], const Unit& u, int wr, int wc, int fr, int fq) const {
        const int row0 = u.pm * BM + wr * 64 + fr, col0 = u.pn * BM + wc * 32 + 8 * fq;
#pragma unroll
        for (int ai = 0; ai < 2; ++ai)
#pragma unroll
            for (int m = 0; m < 4; ++m) {
                const int row = row0 + ai * HALF + m * 16; float part = 0.f;
#pragma unroll
                for (int bj = 0; bj < 2; ++bj) {
                    float* hp = h + (size_t)row * 1024 + col0 + bj * HALF;
                    f32x4 h0 = *(const f32x4*)hp, h1 = *(const f32x4*)(hp + 4);
                    h0 = h0 + acc[ai][bj][m][0]; h1 = h1 + acc[ai][bj][m][1];
                    *(f32x4*)hp = h0; *(f32x4*)(hp + 4) = h1;
                    part += (h0[0] * h0[0] + h0[1] * h0[1]) + (h0[2] * h0[2] + h0[3] * h0[3]) + (h1[0] * h1[0] + h1[1] * h1[1]) + (h1[2] * h1[2] + h1[3] * h1[3]);
                    *(u32x4*)(hb + (size_t)row * 1024 + col0 + bj * HALF) = pack8(h0, h1);
                }
                part += __shfl_xor(part, 16); part += __shfl_xor(part, 32);
                if (fq == 0) red[(ai * HALF + wr * 64 + m * 16 + fr) * 4 + wc] = part;
            }
        asm volatile("s_waitcnt lgkmcnt(0)" ::: "memory");
        __builtin_amdgcn_s_barrier();
        asm volatile("" ::: "memory");
        { const int t_ = opaque_tid(); if (t_ < 256) { const f32x4 r4 = *(const LAS f32x4*)(red + t_ * 4); ssq[(size_t)(u.pm * BM + t_) * 4 + u.pn] = (r4[0] + r4[1]) + (r4[2] + r4[3]); } }
    }
};
struct EpiAct {
    bf16_t* act; const float* ssq;
    __device__ __forceinline__ void operator()(const f32x4 (&acc)[2][2][4][2], const Unit& u, int wr, int wc, int fr, int fq) const {
        const int row0 = u.pm * BM + wr * 64 + fr, col0 = u.pn * HALF + wc * 32 + 8 * fq;
#pragma unroll
        for (int ai = 0; ai < 2; ++ai)
#pragma unroll
            for (int m = 0; m < 4; ++m) {
                const int row = row0 + ai * HALF + m * 16; const float rs = row_rstd(ssq, row);
                f32x4 o[2];
#pragma unroll
                for (int n = 0; n < 2; ++n)
#pragma unroll
                    for (int i = 0; i < 4; ++i) { const float gg = acc[ai][0][m][n][i] * rs, uu = acc[ai][1][m][n][i] * rs; o[n][i] = gg * sigm(gg) * uu; }
                *(u32x4*)(act + (size_t)row * 2816 + col0) = pack8(o[0], o[1]);
            }
    }
};
struct UberEpi { int mode, i0; unsigned char *p0, *p1, *p2; };
__device__ __forceinline__ void run_epi(const UberEpi& E, LAS unsigned char* lds, const f32x4 (&acc)[2][2][4][2], const Unit& u, int wr, int wc, int fr, int fq) {
    switch (E.mode) {
        case 0: { EpiZ e{(bf16_t*)E.p0, (const float*)E.p1, (bf16_t*)E.p2, E.i0}; e(acc, u, wr, wc, fr, fq); break; }
        case 1: { EpiGlu e{(bf16_t*)E.p0}; e(acc, u, wr, wc, fr, fq); break; }
        case 2: { EpiMix<0> e{(bf16_t*)E.p0, E.i0}; e(acc, u, wr, wc, fr, fq); break; }
        case 3: { EpiMix<1> e{(bf16_t*)E.p0, E.i0}; e(acc, u, wr, wc, fr, fq); break; }
        case 4: { EpiRes e{(float*)E.p0, (bf16_t*)E.p1, (float*)E.p2, (LAS float*)(lds + 131072)}; e(acc, u, wr, wc, fr, fq); break; }
        default: { EpiAct e{(bf16_t*)E.p0, (const float*)E.p1}; e(acc, u, wr, wc, fr, fq); break; }
    }
}
}

constexpr int NLAYER = 4, DM = 1024, ZN = 6144, ZW = 6208  , FFH = 2816, RG = 16384, RMAIN = 65536, VTLD = RG + 64  ;
constexpr size_t al256(size_t x) { return (x + 255) & ~(size_t)255; }
constexpr size_t WS_HB = 0;
constexpr size_t WS_SSQ = WS_HB + (size_t)RMAIN * DM * 2;
constexpr size_t WS_Z = WS_SSQ + (size_t)RMAIN * 4 * 4;
constexpr size_t WS_YB = WS_Z + (size_t)RG * ZW * 2;
constexpr size_t WS_VT = WS_YB + (size_t)RG * 512 * 2;
constexpr size_t WS_HGU = WS_VT + (size_t)512 * VTLD * 2;
constexpr size_t WS_HGP = WS_HGU + (size_t)260 * 8 * 4096 * 4;
constexpr size_t WS_S5S = WS_HGP + (size_t)260 * 8 * 64 * 4;
constexpr size_t WS_W = WS_S5S + (size_t)260 * 2048 * 8;
constexpr size_t W_IN = 0, W_UPA = W_IN + (size_t)6144 * 1024 * 2, W_UPB = W_UPA + (size_t)1024 * 256 * 2, W_UPC = W_UPB + (size_t)1024 * 512 * 2,
                 W_O = W_UPC + (size_t)1024 * 256 * 2, W_GU = W_O + (size_t)1024 * 1024 * 2, W_DN = W_GU + (size_t)5632 * 1024 * 2, W_GLU = W_DN + (size_t)1024 * 2816 * 2,
                 W_END = W_GLU + (size_t)256 * 256 * 2;
constexpr size_t WS_TAB = WS_W + W_END;
constexpr size_t T_LBAR = 0, T_L16 = T_LBAR + 2048 * 8, T_L64 = T_L16 + 2048 * 8, T_BFRAG = T_L64 + 2048 * 8, T_CFRAG = T_BFRAG + (size_t)32 * 8 * 64 * 16,
                 T_LB = T_CFRAG + (size_t)32 * 4 * 64 * 16, T_END = T_LB + 256 * 4;
constexpr size_t WS_META = al256(WS_TAB + T_END);
constexpr size_t M_H = 0, M_HB = M_H + (size_t)256 * 1024 * 4, M_SSQ = M_HB + (size_t)256 * 1024 * 2, M_Z = M_SSQ + (size_t)256 * 4 * 4, M_YB = M_Z + (size_t)256 * ZW * 2,
                 M_VT = M_YB + (size_t)256 * 512 * 2, M_ACT = M_VT + (size_t)512 * 256 * 2, M_END = M_ACT + (size_t)256 * FFH * 2;
constexpr size_t WS_CTL = al256(WS_META + M_END);
constexpr size_t CTL_BYTES = 16384;
constexpr size_t WS_TOTAL = WS_CTL + CTL_BYTES;
constexpr int LDS_ST_OFF = 135168;
constexpr int LDS_BYTES = 147456;

struct Args {
    const float *x_prompt, *x_sample, *meta_tokens, *norm1_g, *w_in, *a_re, *a_im, *log_dt, *b_re, *b_im, *c_re, *c_im, *s5_d, *w_glu, *rpb, *lb_logits, *onorm_g,
        *w_up_a, *w_up_b, *w_up_c, *w_o, *norm2_g, *w_gate, *w_up, *w_down, *final_g;
    float* out; unsigned char* ws;
};

__device__ __forceinline__ unsigned long long ufl(unsigned long long v) { const unsigned lo = __builtin_amdgcn_readfirstlane((unsigned)v), hi = __builtin_amdgcn_readfirstlane((unsigned)(v >> 32)); return ((unsigned long long)hi << 32) | lo; }
#define GAS __attribute__((address_space(1)))
#define KA(f) ((decltype(Args::f))(GAS char*)ufl((unsigned long long)(((const volatile Args*)__builtin_amdgcn_kernarg_segment_ptr())->f)))
#define KAF(f) ((const float*)KA(f))
struct Ctx {
    bf16_t *hb, *z, *yb, *vt; float *ssq, *hgu, *hgp, *s5s;
    bf16_t *w; const float *lbar, *l16, *l64; const bf16_t *bfrag, *cfrag; const float* lb;
    float* mh; bf16_t *mhb, *mz, *myb, *mvt, *mact; float* mssq;
};

__device__ __forceinline__ void tr_item(const float* W, int K, int N, bf16_t* WT, const float* kscale, int mode, LAS float* scr, int item, int lane, bool valid) {
    const int nblk = N / 32, kb = item / nblk, nb = item % nblk, k0 = 64 * kb, n0 = 32 * nb;
    if (valid) {
#pragma unroll 8
    for (int i = 0; i < 32; ++i) { const int kk = 2 * i + (lane >> 5); float v = W[(size_t)(k0 + kk) * N + n0 + (lane & 31)]; if (kscale) v *= kscale[k0 + kk]; scr[kk * 33 + (lane & 31)] = v; }
    }
    __syncthreads();
    const int c = lane & 7;
    int drow0 = n0; if (mode) drow0 = (n0 >> 7) * 256 + (n0 & 127) + (mode == 2 ? 128 : 0);
    if (valid) {
#pragma unroll
    for (int j = 0; j < 4; ++j) { const int n = (lane >> 3) + 8 * j; const LAS float* s = scr + (8 * c) * 33 + n;
        u32x4 o; o.x = pk2(s[0 * 33], s[1 * 33]); o.y = pk2(s[2 * 33], s[3 * 33]); o.z = pk2(s[4 * 33], s[5 * 33]); o.w = pk2(s[6 * 33], s[7 * 33]);
        *(u32x4*)(WT + (size_t)(drow0 + n) * K + k0 + 8 * c) = o; }
    }
    __syncthreads();
}

__device__ __forceinline__ void prep_layer(const Ctx& X, int l, LAS unsigned char* lds, int G) {
    const int tid_ = opaque_tid(); const int wave = __builtin_amdgcn_readfirstlane(tid_ >> 6), lane = tid_ & 63;
    LAS float* scr = (LAS float*)(lds + wave * 16384);
    const int gw = blockIdx.x * 8 + wave, NGW = G * 8;
    constexpr int I0 = 16 * 192, I1 = 4 * 32, I2 = 8 * 32, I3 = 4 * 32, I4 = 16 * 32, I5 = 16 * 88, I6 = 16 * 88, I7 = 44 * 32, I8 = 4 * 8;
    constexpr int NIT = I0 + I1 + I2 + I3 + I4 + I5 + I6 + I7 + I8;
    unsigned char* wb = (unsigned char*)X.w;
    for (int it0 = 0; it0 < NIT; it0 += NGW) {
        const int it = it0 + gw; const bool valid = it < NIT;
        int r = valid ? it : 0;
        if (r < I0) { tr_item(KAF(w_in) + (size_t)l * 1024 * 6144, 1024, 6144, (bf16_t*)(wb + W_IN), KAF(norm1_g) + l * 1024, 0, scr, r, lane, valid); continue; } r -= I0;
        if (r < I1) { tr_item(KAF(w_up_a) + (size_t)l * 256 * 1024, 256, 1024, (bf16_t*)(wb + W_UPA), nullptr, 0, scr, r, lane, valid); continue; } r -= I1;
        if (r < I2) { tr_item(KAF(w_up_b) + (size_t)l * 512 * 1024, 512, 1024, (bf16_t*)(wb + W_UPB), nullptr, 0, scr, r, lane, valid); continue; } r -= I2;
        if (r < I3) { tr_item(KAF(w_up_c) + (size_t)l * 256 * 1024, 256, 1024, (bf16_t*)(wb + W_UPC), nullptr, 0, scr, r, lane, valid); continue; } r -= I3;
        if (r < I4) { tr_item(KAF(w_o) + (size_t)l * 1024 * 1024, 1024, 1024, (bf16_t*)(wb + W_O), nullptr, 0, scr, r, lane, valid); continue; } r -= I4;
        if (r < I5) { tr_item(KAF(w_gate) + (size_t)l * 1024 * 2816, 1024, 2816, (bf16_t*)(wb + W_GU), KAF(norm2_g) + l * 1024, 1, scr, r, lane, valid); continue; } r -= I5;
        if (r < I6) { tr_item(KAF(w_up) + (size_t)l * 1024 * 2816, 1024, 2816, (bf16_t*)(wb + W_GU), KAF(norm2_g) + l * 1024, 2, scr, r, lane, valid); continue; } r -= I6;
        if (r < I7) { tr_item(KAF(w_down) + (size_t)l * 2816 * 1024, 2816, 1024, (bf16_t*)(wb + W_DN), nullptr, 0, scr, r, lane, valid); continue; } r -= I7;
        tr_item(KAF(w_glu) + (size_t)l * 256 * 256, 256, 256, (bf16_t*)(wb + W_GLU), nullptr, 0, scr, r, lane, valid);
    }
    const int gt = blockIdx.x * 512 + tid_;
    if (gt < 2048) {
        const int dg = gt >> 6, p = gt & 63;
        const size_t pb = ((size_t)l * 32 + dg);
        const float are = KAF(a_re)[pb * 64 + p], aim = KAF(a_im)[pb * 64 + p], dt = expf(KAF(log_dt)[pb]);
        const float mag = expf(are * dt); float sn, cs; sincosf(aim * dt, &sn, &cs);
        const float lr = mag * cs, li = mag * sn;
        const float den = are * are + aim * aim, nr = lr - 1.0f, ni = li;
        const float zr = (nr * are + ni * aim) / den, zi = (ni * are - nr * aim) / den;
        float* lbar = (float*)X.lbar; float* l16 = (float*)X.l16; float* l64 = (float*)X.l64;
        lbar[gt * 2] = lr; lbar[gt * 2 + 1] = li;
        float pr = lr, pi = li;
#pragma unroll
        for (int s = 0; s < 4; ++s) { const float t = pr * pr - pi * pi; pi = 2.f * pr * pi; pr = t; }
        l16[gt * 2] = pr; l16[gt * 2 + 1] = pi;
#pragma unroll
        for (int s = 0; s < 2; ++s) { const float t = pr * pr - pi * pi; pi = 2.f * pr * pi; pr = t; }
        l64[gt * 2] = pr; l64[gt * 2 + 1] = pi;
        bf16_t* bfr = (bf16_t*)X.bfrag; bf16_t* cfr = (bf16_t*)X.cfrag;
        const int ntr = p >> 4, col = p & 15;
        for (int c = 0; c < 16; ++c) {
            const float br = KAF(b_re)[(pb * 64 + p) * 16 + c], bi = KAF(b_im)[(pb * 64 + p) * 16 + c];
            const float bbr = zr * br - zi * bi, bbi = zr * bi + zi * br;
            const int q = c >> 3, j = c & 7;
            bfr[(((size_t)dg * 8 + ntr) * 64 + col + 16 * q) * 8 + j] = (bf16_t)f2bf(bbr);
            bfr[(((size_t)dg * 8 + 4 + ntr) * 64 + col + 16 * q) * 8 + j] = (bf16_t)f2bf(bbi);
            bfr[(((size_t)dg * 8 + ntr) * 64 + col + 16 * (q + 2)) * 8 + j] = 0;
            bfr[(((size_t)dg * 8 + 4 + ntr) * 64 + col + 16 * (q + 2)) * 8 + j] = 0;
            const float cr = KAF(c_re)[(pb * 16 + c) * 64 + p], ci = KAF(c_im)[(pb * 16 + c) * 64 + p];
            { const int k = p;      cfr[(((size_t)dg * 4 + (k >> 5)) * 64 + c + 16 * ((k >> 3) & 3)) * 8 + (k & 7)] = (bf16_t)f2bf(cr); }
            { const int k = 64 + p; cfr[(((size_t)dg * 4 + (k >> 5)) * 64 + c + 16 * ((k >> 3) & 3)) * 8 + (k & 7)] = (bf16_t)f2bf(-ci); }
        }
    }
    if (gt >= 2048 && gt < 2048 + 256) {
        const int c = gt - 2048;
        const float l0 = KAF(lb_logits)[c], l1 = KAF(lb_logits)[256 + c], l2 = KAF(lb_logits)[512 + c], l3 = KAF(lb_logits)[768 + c];
        const float mx = fmaxf(fmaxf(l0, l1), fmaxf(l2, l3));
        const float e0 = expf(l0 - mx), e1 = expf(l1 - mx), e2 = expf(l2 - mx), e3 = expf(l3 - mx), inv = 1.f / (e0 + e1 + e2 + e3);
        float v = 0.f; if (l >= 1) v += e1 * inv; if (l >= 2) v += e2 * inv; if (l >= 3) v += e3 * inv;
        ((float*)X.lb)[c] = v;
    }
}

struct Grp { int g, nseq, Lr, nch, s0; };
__device__ __forceinline__ Grp make_grp(int g) { Grp r; r.g = g; r.nseq = g < 2 ? 4 : 1; r.Lr = g < 2 ? 4096 : 16384; r.nch = r.Lr / 64 + 1; r.s0 = g < 2 ? g * 4 : 8 + (g - 2); return r; }

template <bool OUT>
__device__ __forceinline__ void s5_chunk(const Ctx& X, const float* s5d, LAS float* buf, bf16_t* zc, int T, int ci, int wave, int lane) {
    const int p = lane, fr = lane & 15, fq = lane >> 4;
    for (int gi = 0; gi < 2; ++gi) {
        const int g = wave * 2 + gi;
        f32x4 yacc[2][2];
#pragma unroll
        for (int i = 0; i < 2; ++i)
#pragma unroll
            for (int j = 0; j < 2; ++j) yacc[i][j] = (f32x4){0.f, 0.f, 0.f, 0.f};
#pragma unroll
        for (int dir = 0; dir < 2; ++dir) {
            const int dg = dir * 16 + g;
            const float lr = X.lbar[(dg * 64 + p) * 2], li = X.lbar[(dg * 64 + p) * 2 + 1];
            float xr = 0.f, xi = 0.f;
            float* st = X.s5s + ((size_t)ci * 2048 + dg * 64 + p) * 2;
            if (OUT) { xr = st[0]; xi = st[1]; }
#pragma unroll
            for (int sti = 0; sti < 2; ++sti) {
                const int stt = dir ? 1 - sti : sti; const int t0 = stt * 32;
                if (t0 < T) {
                    const int tn = (T - t0) < 32 ? (T - t0) : 32;
#pragma unroll
                    for (int mt = 0; mt < 2; ++mt) {
                        if (mt * 16 < tn) {
                            bf16x8 av = (bf16x8){0, 0, 0, 0, 0, 0, 0, 0};
                            if (fq < 2) av = *(const bf16x8*)(zc + (size_t)(t0 + mt * 16 + fr) * ZW + g * 16 + fq * 8);
#pragma unroll
                            for (int nt = 0; nt < 8; ++nt) {
                                const bf16x8 bv = *(const bf16x8*)(X.bfrag + (((size_t)dg * 8 + nt) * 64 + lane) * 8);
                                const f32x4 c = __builtin_amdgcn_mfma_f32_16x16x32_bf16(av, bv, (f32x4){0.f, 0.f, 0.f, 0.f}, 0, 0, 0);
#pragma unroll
                                for (int r = 0; r < 4; ++r) buf[(mt * 16 + fq * 4 + r) * 132 + nt * 16 + fr] = c[r];
                            }
                        }
                    }
                    __syncthreads();
                    for (int k = 0; k < tn; ++k) {
                        const int t = dir ? (tn - 1 - k) : k;
                        const float br = buf[t * 132 + p], bi = buf[t * 132 + 64 + p];
                        const float nr = lr * xr - li * xi + br, ni = lr * xi + li * xr + bi;
                        xr = nr; xi = ni;
                        if (OUT) { buf[t * 132 + p] = xr; buf[t * 132 + 64 + p] = xi; }
                    }
                    if (OUT) {
                        __syncthreads();
#pragma unroll
                        for (int mt = 0; mt < 2; ++mt) {
                            if (mt * 16 < tn) {
#pragma unroll
                                for (int ks = 0; ks < 4; ++ks) {
                                    const LAS float* ap = buf + (mt * 16 + fr) * 132 + ks * 32 + fq * 8;
                                    const f32x4 a0 = *(const LAS f32x4*)ap, a1 = *(const LAS f32x4*)(ap + 4);
                                    const u32x4 aw = pack8(a0, a1);
                                    const bf16x8 av = __builtin_bit_cast(bf16x8, aw);
                                    const bf16x8 bv = *(const bf16x8*)(X.cfrag + (((size_t)dg * 4 + ks) * 64 + lane) * 8);
                                    yacc[stt][mt] = __builtin_amdgcn_mfma_f32_16x16x32_bf16(av, bv, yacc[stt][mt], 0, 0, 0);
                                }
                            }
                        }
                    }
                    __syncthreads();
                }
            }
            if (!OUT) { st[0] = xr; st[1] = xi; }
        }
        if (OUT) {
            const float dsk = s5d[g * 16 + fr];
#pragma unroll
            for (int stt = 0; stt < 2; ++stt)
#pragma unroll
                for (int mt = 0; mt < 2; ++mt) {
                    if (stt * 32 + mt * 16 < T) {
#pragma unroll
                        for (int r = 0; r < 4; ++r) {
                            const int t = stt * 32 + mt * 16 + fq * 4 + r;
                            bf16_t* zr = zc + (size_t)t * ZW;
                            const float u = bf2f(zr[g * 16 + fr]);
                            const float y = gelu_tanh(yacc[stt][mt][r] + dsk * u);
                            zr[512 + g * 16 + fr] = (bf16_t)f2bf(y);
                        }
                    }
                }
        }
    }
}

__device__ __forceinline__ void s5_passB(const Ctx& X, const Grp& gp, int gtid, int GT) {
    const int n = gp.nseq * 2048;
    for (int e = gtid; e < n; e += GT) {
        const int sl = e >> 11, r = e & 2047, dir = r >> 10;
        const float l16r = X.l16[r * 2], l16i = X.l16[r * 2 + 1], l64r = X.l64[r * 2], l64i = X.l64[r * 2 + 1];
        float sr = 0.f, si = 0.f;
        for (int k0 = 0; k0 < gp.nch; k0 += 8) {
            float er[8], ei[8];
#pragma unroll
            for (int j = 0; j < 8; ++j) { const int k = k0 + j; if (k < gp.nch) { const int c = dir ? gp.nch - 1 - k : k; const float* pp = X.s5s + ((size_t)(sl * gp.nch + c) * 2048 + r) * 2; er[j] = pp[0]; ei[j] = pp[1]; } else { er[j] = 0.f; ei[j] = 0.f; } }
#pragma unroll
            for (int j = 0; j < 8; ++j) { const int k = k0 + j; if (k < gp.nch) { const int c = dir ? gp.nch - 1 - k : k; float* pp = X.s5s + ((size_t)(sl * gp.nch + c) * 2048 + r) * 2; pp[0] = sr; pp[1] = si;
                    const float pr = c == 0 ? l16r : l64r, pi = c == 0 ? l16i : l64i;
                    const float nr = pr * sr - pi * si + er[j], ni = pr * si + pi * sr + ei[j]; sr = nr; si = ni; } }
        }
    }
}

template <bool OUT>
__device__ __forceinline__ void hg_chunk(const Ctx& X, LAS float* gt, LAS bf16_t* ot, const bf16_t* zc, int T, int ci, int wave, int lane) {
    const int h = wave >> 1, dir = wave & 1;
    float S[64];
    float* U = X.hgu + ((size_t)ci * 8 + wave) * 4096;
    if (OUT) {
#pragma unroll
        for (int d = 0; d < 64; ++d) S[d] = U[d * 64 + lane];
    } else {
#pragma unroll
        for (int d = 0; d < 64; ++d) S[d] = 0.f;
    }
    const float lbv = X.lb[h * 64 + lane], oml = 1.f - lbv; float P = 1.f;
    const int fcol = (dir ? 2304 : 2048) + h * 64 + lane, qcol = 1792 + h * 64 + lane, vcol = 2560 + h * 64 + lane;
    const int ns8 = T >> 3;
#pragma unroll 1
    for (int s8 = 0; s8 < ns8; ++s8) {
        const int sb = dir ? (ns8 - 1 - s8) : s8;
#pragma unroll
        for (int j = 0; j < 8; ++j) {
            const bf16_t* zr = zc + (size_t)(sb * 8 + j) * ZW;
            const float q = bf2f(zr[qcol]), ff = bf2f(zr[fcol]);
            const float sg = sigm(ff), fg = lbv + oml * sg, kk = oml * (1.f - sg);
            gt[j * 256 + lane] = fg; gt[j * 256 + 64 + lane] = kk; gt[j * 256 + 128 + lane] = q * sigm(q); gt[j * 256 + 192 + lane] = bf2f(zr[vcol]);
            P *= fg;
        }
        __syncthreads();
#pragma unroll 1
        for (int jj = 0; jj < 8; ++jj) {
            const int j = dir ? 7 - jj : jj;
            const LAS float* gj = gt + j * 256;
            const float v = gj[192 + lane];
            float o = 0.f;
#pragma unroll
            for (int d4 = 0; d4 < 16; ++d4) {
                const f32x4 f4 = *(const LAS f32x4*)(gj + d4 * 4), k4 = *(const LAS f32x4*)(gj + 64 + d4 * 4);
#pragma unroll
                for (int i = 0; i < 4; ++i) S[d4 * 4 + i] = f4[i] * S[d4 * 4 + i] + k4[i] * v;
                if (OUT) { const f32x4 q4 = *(const LAS f32x4*)(gj + 128 + d4 * 4);
#pragma unroll
                    for (int i = 0; i < 4; ++i) o += S[d4 * 4 + i] * q4[i]; }
                if ((d4 & 3) == 3) __builtin_amdgcn_sched_barrier(0);
            }
            if (OUT) ot[(sb * 8 + j) * 64 + lane] = (bf16_t)f2bf(o);
        }
        __syncthreads();
    }
    if (!OUT) {
#pragma unroll
        for (int d = 0; d < 64; ++d) U[d * 64 + lane] = S[d];
        X.hgp[((size_t)ci * 8 + wave) * 64 + lane] = P;
    }
}

__device__ __forceinline__ void hg_passB(const Ctx& X, const Grp& gp, int gtid, int GT) {
    const int n = gp.nseq * 32768;
    for (int e = gtid; e < n; e += GT) {
        const int sl = e >> 15, r = e & 32767, hd = r >> 12, de = r & 4095, d = de >> 6, dir = hd & 1;
        float s = 0.f;
        for (int k0 = 0; k0 < gp.nch; k0 += 8) {
            float u[8], pv[8];
#pragma unroll
            for (int j = 0; j < 8; ++j) { const int k = k0 + j; if (k < gp.nch) { const int c = dir ? gp.nch - 1 - k : k; const size_t cb = (size_t)(sl * gp.nch + c) * 8 + hd; u[j] = X.hgu[cb * 4096 + de]; pv[j] = X.hgp[cb * 64 + d]; } else { u[j] = 0.f; pv[j] = 0.f; } }
#pragma unroll
            for (int j = 0; j < 8; ++j) { const int k = k0 + j; if (k < gp.nch) { const int c = dir ? gp.nch - 1 - k : k; const size_t cb = (size_t)(sl * gp.nch + c) * 8 + hd; X.hgu[cb * 4096 + de] = s; s = pv[j] * s + u[j]; } }
        }
    }
}

__device__ __forceinline__ void na_task(const Ctx& X, const float* rpb, const Grp& gp, int sl, int task, bool metaq, int wave, int lane) {
    const int h = wave, fr = lane & 15, fq = lane >> 4;
    const int s = gp.s0 + sl, rows = gp.Lr >> 6;
    int r = 0, n = 0, rs = 0, ks = 0;
    const bf16_t* qptr; bf16_t* optr; size_t ostride = 512;
    if (metaq) { qptr = X.mz + (size_t)(s * 16 + fr) * ZW; optr = X.myb + (size_t)(s * 16) * 512; }
    else {
        r = task >> 2; n = task & 3;
        rs = r - 4; rs = rs < 0 ? 0 : (rs > rows - 8 ? rows - 8 : rs);
        ks = 16 * n - 8; ks = ks < 0 ? 0 : (ks > 32 ? 32 : ks);
        const size_t qrow0 = (size_t)sl * gp.Lr + r * 64 + 16 * n;
        qptr = X.z + (qrow0 + fr) * ZW; optr = X.yb + qrow0 * 512;
    }
    bf16x8 qf[2];
#pragma unroll
    for (int kk = 0; kk < 2; ++kk) qf[kk] = *(const bf16x8*)(qptr + 256 + h * 64 + 32 * kk + 8 * fq);
    f32x4 sc[17];
    {
        const bf16_t* kp = X.mz + (size_t)(s * 16 + fr) * ZW + 768 + h * 64 + 8 * fq;
        f32x4 c = (f32x4){0.f, 0.f, 0.f, 0.f};
#pragma unroll
        for (int kk = 0; kk < 2; ++kk) c = __builtin_amdgcn_mfma_f32_16x16x32_bf16(*(const bf16x8*)(kp + 32 * kk), qf[kk], c, 0, 0, 0);
        sc[0] = c * 0.125f;
    }
    const int qc = 16 * n + fr;
    int wstart = qc - 8; wstart = wstart < 0 ? 0 : (wstart > 48 ? 48 : wstart);
    const size_t krow_base = (size_t)sl * gp.Lr + (size_t)rs * 64 + ks;
    if (!metaq) {
#pragma unroll
        for (int tb = 0; tb < 2; ++tb) {
            bf16x8 kf[8][2]; float bz[8][4];
#pragma unroll
            for (int t4 = 0; t4 < 8; ++t4) {
                const int tt = tb * 8 + t4, kj = tt >> 1, half = tt & 1;
                const bf16_t* kp = X.z + (krow_base + kj * 64 + 16 * half + fr) * ZW + 768 + h * 64 + 8 * fq;
                kf[t4][0] = *(const bf16x8*)kp; kf[t4][1] = *(const bf16x8*)(kp + 32);
            }
#pragma unroll
            for (int t4 = 0; t4 < 8; ++t4) {
                const int tt = tb * 8 + t4, kj = tt >> 1, half = tt & 1;
                const float* rp = rpb + (h * 15 + (rs + kj - r + 7)) * 31;
#pragma unroll
                for (int i = 0; i < 4; ++i) { int dc = ks + 16 * half + 4 * fq + i - qc; dc = dc < -15 ? -15 : (dc > 15 ? 15 : dc); bz[t4][i] = rp[dc + 15]; }
            }
            __builtin_amdgcn_sched_barrier(0);
#pragma unroll
            for (int t4 = 0; t4 < 8; ++t4) {
                const int tt = tb * 8 + t4, half = tt & 1;
                f32x4 c = (f32x4){0.f, 0.f, 0.f, 0.f};
                c = __builtin_amdgcn_mfma_f32_16x16x32_bf16(kf[t4][0], qf[0], c, 0, 0, 0);
                c = __builtin_amdgcn_mfma_f32_16x16x32_bf16(kf[t4][1], qf[1], c, 0, 0, 0);
#pragma unroll
                for (int i = 0; i < 4; ++i) {
                    const int kc = ks + 16 * half + 4 * fq + i;
                    const bool valid = (kc >= wstart) && (kc < wstart + 16);
                    c[i] = valid ? c[i] * 0.125f + bz[t4][i] : -1e30f;
                }
                sc[1 + tt] = c;
            }
            __builtin_amdgcn_sched_barrier(0);
        }
    } else {
#pragma unroll
        for (int tt = 0; tt < 16; ++tt) sc[1 + tt] = (f32x4){-1e30f, -1e30f, -1e30f, -1e30f};
    }
    float mx = -1e30f;
#pragma unroll
    for (int t = 0; t < 17; ++t)
#pragma unroll
        for (int i = 0; i < 4; ++i) mx = fmaxf(mx, sc[t][i]);
    mx = fmaxf(mx, __shfl_xor(mx, 16)); mx = fmaxf(mx, __shfl_xor(mx, 32));
    float sum = 0.f;
#pragma unroll
    for (int t = 0; t < 17; ++t)
#pragma unroll
        for (int i = 0; i < 4; ++i) { const float e = __expf(sc[t][i] - mx); sc[t][i] = e; sum += e; }
    sum += __shfl_xor(sum, 16); sum += __shfl_xor(sum, 32);
    const float inv = 1.f / sum;
    f32x4 oacc[4];
#pragma unroll
    for (int et = 0; et < 4; ++et) oacc[et] = (f32x4){0.f, 0.f, 0.f, 0.f};
#pragma unroll
    for (int kb = 0; kb < 3; ++kb) {
        if (kb > 0 && metaq) break;
        u32x2 va[3][4], vb[3][4];
#pragma unroll
        for (int k3 = 0; k3 < 3; ++k3) {
            const int kst = kb * 3 + k3, ta = 2 * kst, tb = 2 * kst + 1;
#pragma unroll
            for (int et = 0; et < 4; ++et) {
                const int e = h * 64 + et * 16 + fr;
                va[k3][et] = (u32x2){0u, 0u}; vb[k3][et] = (u32x2){0u, 0u};
                if (ta == 0) va[k3][et] = *(const u32x2*)(X.mvt + (size_t)e * 256 + s * 16 + 4 * fq);
                else if (!metaq) { const int tt = ta - 1; va[k3][et] = *(const u32x2*)(X.vt + (size_t)e * VTLD + krow_base + (tt >> 1) * 64 + 16 * (tt & 1) + 4 * fq); }
                if (tb < 17 && !metaq) { const int tt = tb - 1; vb[k3][et] = *(const u32x2*)(X.vt + (size_t)e * VTLD + krow_base + (tt >> 1) * 64 + 16 * (tt & 1) + 4 * fq); }
            }
        }
        __builtin_amdgcn_sched_barrier(0);
#pragma unroll
        for (int k3 = 0; k3 < 3; ++k3) {
            const int kst = kb * 3 + k3, ta = 2 * kst, tb = 2 * kst + 1;
            f32x4 pa = sc[ta] * inv, pb = (f32x4){0.f, 0.f, 0.f, 0.f};
            if (tb < 17) pb = sc[tb] * inv;
            const bf16x8 pf = __builtin_bit_cast(bf16x8, pack8(pa, pb));
#pragma unroll
            for (int et = 0; et < 4; ++et) {
                const u32x4 vw = (u32x4){va[k3][et].x, va[k3][et].y, vb[k3][et].x, vb[k3][et].y};
                oacc[et] = __builtin_amdgcn_mfma_f32_16x16x32_bf16(pf, __builtin_bit_cast(bf16x8, vw), oacc[et], 0, 0, 0);
            }
        }
        __builtin_amdgcn_sched_barrier(0);
    }
#pragma unroll
    for (int et = 0; et < 4; ++et)
#pragma unroll
        for (int i = 0; i < 4; ++i) optr[(size_t)(4 * fq + i) * ostride + h * 64 + et * 16 + fr] = (bf16_t)f2bf(oacc[et][i]);
}

#define XB_TMO      128
#define XB_XCNT(j)  (256  + 64 * (j))
#define XB_XSUB(j)  (1280 + 64 * (j))
#define XB_XGEN(j)  (2304 + 64 * (j))
#define XB_TOP      3328
#define XB_TOPGEN   3392
#define XCD_BAR_WORDS 3456
#define XB_SPIN_CAP (1u << 22)
__device__ __forceinline__ unsigned xb_ld(unsigned* p)              { return __hip_atomic_load(p, __ATOMIC_RELAXED, __HIP_MEMORY_SCOPE_AGENT); }
__device__ __forceinline__ unsigned xb_add(unsigned* p, unsigned v) { return __hip_atomic_fetch_add(p, v, __ATOMIC_RELAXED, __HIP_MEMORY_SCOPE_AGENT); }
__device__ __forceinline__ unsigned xb_xcc_id() { return (unsigned)__builtin_amdgcn_s_getreg((3 << 11) | 20) & 0xFu; }
#define XB_SPIN(cond, bar) do { unsigned _sp = 0; while (cond) { __builtin_amdgcn_s_sleep(1); \
    if ((++_sp & 255u) == 0u) { if (xb_ld(&(bar)[XB_TMO])) break; if (_sp > XB_SPIN_CAP) { atomicAdd(&(bar)[XB_TMO], 1u); break; } } } } while (0)
__device__ __forceinline__ void xcd_barrier_complete(unsigned* bar, unsigned x, unsigned& nloc, unsigned& nx) {
    const unsigned G = gridDim.x * gridDim.y * gridDim.z;
    unsigned sum, cnt, mine, sp = 0u;
    for (;;) {
        sum = 0u; cnt = 0u; mine = 0u;
#pragma unroll
        for (unsigned j = 0; j < 16; ++j) { const unsigned c = xb_ld(&bar[XB_XCNT(j)]); sum += c; cnt += (c > 0u) ? 1u : 0u; mine = (j == x) ? c : mine; }
        if (sum == G) break;
        __builtin_amdgcn_s_sleep(1);
        if ((++sp & 255u) == 0u) { if (xb_ld(&bar[XB_TMO])) break; if (sp > XB_SPIN_CAP) { atomicAdd(&bar[XB_TMO], 1u); break; } }
    }
    nloc = mine > 0u ? mine : 1u; nx = cnt > 0u ? cnt : 1u;
}
__device__ __forceinline__ void xcd_barrier(unsigned* bar, volatile LAS unsigned* st) {
    asm volatile("s_waitcnt vmcnt(0)" ::: "memory");
    __syncthreads();
    if (threadIdx.x == 0) {
        const unsigned x = xb_xcc_id();
        __builtin_amdgcn_s_waitcnt(0);
        unsigned nloc = st[0], nx = st[1];
        if (nloc == 0u) { xcd_barrier_complete(bar, x, nloc, nx); st[0] = nloc; st[1] = nx; }
        const unsigned old = xb_add(&bar[XB_XSUB(x)], 1u);
        const unsigned gen = old / nloc;
        if (old + 1u == (gen + 1u) * nloc) {
            __builtin_amdgcn_fence(__ATOMIC_RELEASE, "agent");
            asm volatile("s_waitcnt vmcnt(0)" ::: "memory");
            const unsigned og = xb_add(&bar[XB_TOP], 1u);
            const unsigned tg = og / nx;
            if (og + 1u == (tg + 1u) * nx) xb_add(&bar[XB_TOPGEN], 1u);
            else XB_SPIN(xb_ld(&bar[XB_TOPGEN]) == tg, bar);
            __builtin_amdgcn_fence(__ATOMIC_ACQUIRE, "agent");
            xb_add(&bar[XB_XGEN(x)], 1u);
            asm volatile("s_waitcnt vmcnt(0)" ::: "memory");
        } else {
            XB_SPIN(xb_ld(&bar[XB_XGEN(x)]) == gen, bar);
            __builtin_amdgcn_fence(__ATOMIC_ACQUIRE, "agent");
            asm volatile("s_waitcnt vmcnt(0)" ::: "memory");
        }
    }
    __syncthreads();
}
#define GRID_SYNC() xcd_barrier((unsigned*)(KA(ws) + WS_CTL), (volatile LAS unsigned*)(lds + LDS_ST_OFF))
__device__ __forceinline__ Ctx make_ctx(unsigned char* ws) {
    Ctx X;
    X.hb = (bf16_t*)(ws + WS_HB); X.ssq = (float*)(ws + WS_SSQ); X.z = (bf16_t*)(ws + WS_Z); X.yb = (bf16_t*)(ws + WS_YB); X.vt = (bf16_t*)(ws + WS_VT);
    X.hgu = (float*)(ws + WS_HGU); X.hgp = (float*)(ws + WS_HGP); X.s5s = (float*)(ws + WS_S5S); X.w = (bf16_t*)(ws + WS_W);
    X.lbar = (const float*)(ws + WS_TAB + T_LBAR); X.l16 = (const float*)(ws + WS_TAB + T_L16); X.l64 = (const float*)(ws + WS_TAB + T_L64);
    X.bfrag = (const bf16_t*)(ws + WS_TAB + T_BFRAG); X.cfrag = (const bf16_t*)(ws + WS_TAB + T_CFRAG); X.lb = (const float*)(ws + WS_TAB + T_LB);
    X.mh = (float*)(ws + WS_META + M_H); X.mhb = (bf16_t*)(ws + WS_META + M_HB); X.mssq = (float*)(ws + WS_META + M_SSQ); X.mz = (bf16_t*)(ws + WS_META + M_Z);
    X.myb = (bf16_t*)(ws + WS_META + M_YB); X.mvt = (bf16_t*)(ws + WS_META + M_VT); X.mact = (bf16_t*)(ws + WS_META + M_ACT);
    return X;
}

__device__ __forceinline__ bool make_job(unsigned char* ws, float* out, int l, int g, int ph, int j, pg8::Gemm& gm, pg8::UberEpi& ep) {
    const bool mchain = (g == 3) && (l < NLAYER - 1);
    int njobs = 1; bool meta = false; int sub = j;
    if (ph == 0) { njobs = (g == 0) ? 2 : 1; meta = (j == 1); }
    else if (ph == 4) { njobs = (g == 3) ? 2 : 1; meta = (j == 1); }
    else if (ph == 5) { njobs = mchain ? 6 : 3; meta = (j >= 3); sub = j % 3; }
    else { njobs = mchain ? 2 : 1; meta = (j == 1); }
    if (j >= njobs) return false;
    unsigned char* wb = ws + WS_W;
    const size_t r0 = (size_t)g * RG;
    unsigned char* mb = ws + WS_META;
    bf16_t* z = meta ? (bf16_t*)(mb + M_Z) : (bf16_t*)(ws + WS_Z);
    bf16_t* hb = meta ? (bf16_t*)(mb + M_HB) : (bf16_t*)(ws + WS_HB) + r0 * DM;
    float* ssq = meta ? (float*)(mb + M_SSQ) : (float*)(ws + WS_SSQ) + r0 * 4;
    float* h = meta ? (float*)(mb + M_H) : out + r0 * DM;
    bf16_t* yb = meta ? (bf16_t*)(mb + M_YB) : (bf16_t*)(ws + WS_YB);
    bf16_t* vt = meta ? (bf16_t*)(mb + M_VT) : (bf16_t*)(ws + WS_VT);
    bf16_t* act = meta ? (bf16_t*)(mb + M_ACT) : (bf16_t*)(ws + WS_Z);
    gm.M = meta ? 256 : RG;
    ep.i0 = 0; ep.p0 = nullptr; ep.p1 = nullptr; ep.p2 = nullptr;
    if (ph == 0) { gm.A = hb; gm.lda = DM; gm.Bt = (const bf16_t*)(wb + W_IN); gm.N = ZN; gm.K = DM; ep.mode = 0; ep.p0 = (unsigned char*)z; ep.p1 = (unsigned char*)ssq; ep.p2 = (unsigned char*)vt; ep.i0 = meta ? 256 : VTLD; }
    else if (ph == 4) { gm.A = z + 512; gm.lda = ZW; gm.Bt = (const bf16_t*)(wb + W_GLU); gm.N = 256; gm.K = 256; ep.mode = 1; ep.p0 = (unsigned char*)z; }
    else if (ph == 5) {
        gm.N = DM; ep.p0 = (unsigned char*)z;
        if (sub == 0) { gm.A = yb; gm.lda = 512; gm.Bt = (const bf16_t*)(wb + W_UPB); gm.K = 512; ep.mode = 2; ep.i0 = 4096; }
        else if (sub == 1) { gm.A = z + 256; gm.lda = ZW; gm.Bt = (const bf16_t*)(wb + W_UPC); gm.K = 256; ep.mode = 3; ep.i0 = 5120; }
        else { gm.A = z; gm.lda = ZW; gm.Bt = (const bf16_t*)(wb + W_UPA); gm.K = 256; ep.mode = 3; ep.i0 = 3072; }
    }
    else if (ph == 6) { gm.A = z + 1024; gm.lda = ZW; gm.Bt = (const bf16_t*)(wb + W_O); gm.N = DM; gm.K = DM; ep.mode = 4; ep.p0 = (unsigned char*)h; ep.p1 = (unsigned char*)hb; ep.p2 = (unsigned char*)ssq; }
    else if (ph == 7) { gm.A = hb; gm.lda = DM; gm.Bt = (const bf16_t*)(wb + W_GU); gm.N = 2 * FFH; gm.K = DM; ep.mode = 5; ep.p0 = (unsigned char*)act; ep.p1 = (unsigned char*)ssq; }
    else { gm.A = act; gm.lda = FFH; gm.Bt = (const bf16_t*)(wb + W_DN); gm.N = DM; gm.K = FFH; ep.mode = 4; ep.p0 = (unsigned char*)h; ep.p1 = (unsigned char*)hb; ep.p2 = (unsigned char*)ssq; }
    return true;
}

__device__ __forceinline__ void prologue(int G) {
    const int tid_ = opaque_tid(); const int lane = tid_ & 63, gw = blockIdx.x * 8 + __builtin_amdgcn_readfirstlane(tid_ >> 6), NGW = G * 8;
    const Ctx X = make_ctx(((unsigned char*)KA(ws)));
    for (int row = gw; row < RMAIN + 256; row += NGW) {
        const bool ismeta = row >= RMAIN; const int mr = row - RMAIN;
        const float* src = ismeta ? (mr < 160 ? KAF(meta_tokens) + (size_t)(mr & 15) * DM : nullptr) : (row < 32768 ? KAF(x_prompt) + (size_t)row * DM : KAF(x_sample) + (size_t)(row - 32768) * DM);
        float* hd = ismeta ? X.mh + (size_t)mr * DM : ((float*)KA(out)) + (size_t)row * DM;
        bf16_t* hbd = ismeta ? X.mhb + (size_t)mr * DM : X.hb + (size_t)row * DM;
        float* sq = ismeta ? X.mssq + (size_t)mr * 4 : X.ssq + (size_t)row * 4;
        float ss = 0.f;
#pragma unroll
        for (int j = 0; j < 4; ++j) {
            f32x4 v = (f32x4){0.f, 0.f, 0.f, 0.f}; if (src) v = *(const f32x4*)(src + j * 256 + lane * 4);
            *(f32x4*)(hd + j * 256 + lane * 4) = v;
            *(u32x2*)(hbd + j * 256 + lane * 4) = (u32x2){pk2(v[0], v[1]), pk2(v[2], v[3])};
            ss += (v[0] * v[0] + v[1] * v[1]) + (v[2] * v[2] + v[3] * v[3]);
        }
        ss = wave_sum(ss);
        if (lane < 4) sq[lane] = lane == 0 ? ss : 0.f;
    }
}

__device__ __forceinline__ void mixer_phase_A(int l, int g, LAS unsigned char* lds, int G, int bid) {
    const int tid_ = opaque_tid(); const int lane = tid_ & 63, wave = __builtin_amdgcn_readfirstlane(tid_ >> 6);
    const Ctx X = make_ctx(((unsigned char*)KA(ws))); const Grp gp = make_grp(g);
    const float* rpb = KAF(rpb) + (size_t)l * 8 * 15 * 31; const float* s5d = KAF(s5_d) + l * 256;
    const int nna = gp.nseq * (gp.Lr / 16), nmq = gp.nseq, nct = gp.nseq * (gp.nch - 1);
    const int ntask = nna + nmq + 2 * nct;
    const bool xmap = (nna % 256 == 0) && ((volatile LAS unsigned*)(lds + LDS_ST_OFF))[4] != 0u;
    if (xmap) {
        const int xcc = (int)((volatile LAS unsigned*)(lds + LDS_ST_OFF))[2], xrk = (int)((volatile LAS unsigned*)(lds + LDS_ST_OFF))[3];
        const int per = gp.Lr / 16, nx = nna / 8, rounds = nna / 256;
        for (int i = 0; i < rounds; ++i) { const int t = xcc * nx + xrk + 32 * i; na_task(X, rpb, gp, t / per, t % per, false, wave, lane); }
    }
    for (int t = bid + (xmap ? nna : 0); t < ntask; t += G) {
        __syncthreads();
        if (t < nna) { const int per = gp.Lr / 16; na_task(X, rpb, gp, t / per, t % per, false, wave, lane); }
        else if (t < nna + nmq) { na_task(X, rpb, gp, t - nna, 0, true, wave, lane); }
        else {
            const int u = t - nna - nmq; const bool isS5 = u < nct; const int v = isS5 ? u : u - nct;
            const int sl = v / (gp.nch - 1), c1 = v % (gp.nch - 1) + 1;
            for (int c = (c1 == 1 ? 0 : c1); c <= c1; ++c) {
                __syncthreads();
                const int ci = sl * gp.nch + c; const int T = c == 0 ? 16 : 64;
                bf16_t* zc = c == 0 ? X.mz + (size_t)((gp.s0 + sl) * 16) * ZW : X.z + ((size_t)sl * gp.Lr + 64 * (c - 1)) * ZW;
                if (isS5) s5_chunk<false>(X, s5d, (LAS float*)(lds + wave * 16896), zc, T, ci, wave, lane);
                else hg_chunk<false>(X, (LAS float*)(lds + wave * 8192), (LAS bf16_t*)(lds + 65536 + wave * 8192), zc, T, ci, wave, lane);
            }
        }
    }
}

__device__ __forceinline__ void mixer_phase_C(int l, int g, LAS unsigned char* lds, int G, int bid) {
    const int tid_ = opaque_tid(); const int lane = tid_ & 63, wave = __builtin_amdgcn_readfirstlane(tid_ >> 6);
    const Ctx X = make_ctx(((unsigned char*)KA(ws))); const Grp gp = make_grp(g);
    const float* s5d = KAF(s5_d) + l * 256; const float* ong = KAF(onorm_g) + l * 64;
    const int nct = gp.nseq * (gp.nch - 1);
    for (int t = bid; t < 2 * nct; t += G) {
        const bool isS5 = t < nct; const int v = isS5 ? t : t - nct;
        const int sl = v / (gp.nch - 1), c1 = v % (gp.nch - 1) + 1;
        for (int c = (c1 == 1 ? 0 : c1); c <= c1; ++c) {
            __syncthreads();
            const int ci = sl * gp.nch + c; const int T = c == 0 ? 16 : 64;
            bf16_t* zc = c == 0 ? X.mz + (size_t)((gp.s0 + sl) * 16) * ZW : X.z + ((size_t)sl * gp.Lr + 64 * (c - 1)) * ZW;
            if (isS5) s5_chunk<true>(X, s5d, (LAS float*)(lds + wave * 16896), zc, T, ci, wave, lane);
            else {
                hg_chunk<true>(X, (LAS float*)(lds + wave * 8192), (LAS bf16_t*)(lds + 65536 + wave * 8192), zc, T, ci, wave, lane);
                __syncthreads();
                const int h = wave >> 1, half = wave & 1;
                const LAS bf16_t* of = (const LAS bf16_t*)(lds + 65536 + (2 * h) * 8192); const LAS bf16_t* ob = (const LAS bf16_t*)(lds + 65536 + (2 * h + 1) * 8192);
                const float gn = ong[lane];
                for (int tt = half * (T / 2); tt < (half + 1) * (T / 2); ++tt) {
                    const float o = bf2f(of[tt * 64 + lane]) + bf2f(ob[tt * 64 + lane]);
                    const float ms = wave_sum(o * o) * (1.0f / 64.0f);
                    bf16_t* zr = zc + (size_t)tt * ZW;
                    const float go = bf2f(zr[2816 + h * 64 + lane]);
                    zr[256 + h * 64 + lane] = (bf16_t)f2bf(o * rsqrtf(ms + 1e-6f) * gn * (go * sigm(go)));
                }
            }
        }
    }
}

__global__ void __launch_bounds__(512, 2) fwd_kernel(Args a) {
    extern __shared__ __attribute__((aligned(16))) unsigned char lds_raw[];
    LAS unsigned char* lds = (LAS unsigned char*)lds_raw;
    const int G = gridDim.x, bid = blockIdx.x;

    if (threadIdx.x < 2) ((volatile LAS unsigned*)(lds + LDS_ST_OFF))[threadIdx.x] = 0u;
    if (threadIdx.x == 0) { const unsigned xc = xb_xcc_id(); const unsigned rk = xb_add((unsigned*)(KA(ws) + WS_CTL) + XB_XCNT(xc), 1u);
        ((volatile LAS unsigned*)(lds + LDS_ST_OFF))[2] = xc; ((volatile LAS unsigned*)(lds + LDS_ST_OFF))[3] = rk; }
    __syncthreads();
    prologue(G);

    for (int l = 0; l < NLAYER; ++l) {
        __syncthreads();
        { const Ctx X = make_ctx(((unsigned char*)KA(ws))); prep_layer(X, l, lds, G); }
        if (l == 0) { asm volatile("s_waitcnt vmcnt(0)" ::: "memory"); __syncthreads(); cg::this_grid().sync(); }
        GRID_SYNC();
        if (l == 0) {
            if (threadIdx.x == 0) { unsigned* bar = (unsigned*)(KA(ws) + WS_CTL); bool ok = (G == 256);
                for (int j = 0; j < 16; ++j) { const unsigned c = xb_ld(&bar[XB_XCNT(j)]); ok = ok && (c == (j < 8 ? 32u : 0u)); }
                ((volatile LAS unsigned*)(lds + LDS_ST_OFF))[4] = ok ? 1u : 0u; }
            __syncthreads();
        }
        for (int g = 0; g < 4; ++g) {
            for (int ph = 0; ph < 9; ++ph) {
                if (ph == 1) mixer_phase_A(l, g, lds, G, bid);
                else if (ph == 2) { const Ctx X = make_ctx(((unsigned char*)KA(ws))); const Grp gp = make_grp(g); const int gtid = bid * 512 + opaque_tid(), GT = G * 512; s5_passB(X, gp, gtid, GT); hg_passB(X, gp, GT - 1 - gtid, GT); }
                else if (ph == 3) mixer_phase_C(l, g, lds, G, bid);
                else {
                    for (int j = 0; j < 6; ++j) {
                        pg8::Gemm gm; pg8::UberEpi ep;
                        if (!make_job(((unsigned char*)KA(ws)), ((float*)KA(out)), l, g, ph, j, gm, ep)) break;
                        pg8::StaticOrder SO; SO.init(gm.M, gm.N, G, bid);
                        pg8::gemm_phase(lds, gm, SO, ep);
                    }
                }
                GRID_SYNC();
            }
        }
    }
    {
        const float* ssq = (const float*)(((unsigned char*)KA(ws)) + WS_SSQ);
        const int tid_ = opaque_tid(); const int lane = tid_ & 63, wave = __builtin_amdgcn_readfirstlane(tid_ >> 6);
        for (int row = bid * 8 + wave; row < RMAIN; row += G * 8) {
            const float rs = pg8::row_rstd(ssq, row);
            float* hp = ((float*)KA(out)) + (size_t)row * DM;
#pragma unroll
            for (int j = 0; j < 4; ++j) {
                f32x4 v = *(const f32x4*)(hp + j * 256 + lane * 4); const f32x4 gv = *(const f32x4*)(KAF(final_g) + j * 256 + lane * 4);
                v = v * rs * gv; *(f32x4*)(hp + j * 256 + lane * 4) = v;
            }
        }
    }
}

extern "C" void kernel_launch(void* const* d_in, const int* in_sizes, int n_in, void* d_out, int out_size, void* d_ws, size_t ws_size, hipStream_t stream) {
    static int grid = 0;
    if (grid == 0) {
        int dev = 0, cus = 0, per_cu = 0;
        (void)hipGetDevice(&dev);
        (void)hipDeviceGetAttribute(&cus, hipDeviceAttributeMultiprocessorCount, dev);
        (void)hipFuncSetAttribute((const void*)fwd_kernel, hipFuncAttributeMaxDynamicSharedMemorySize, LDS_BYTES);
        (void)hipOccupancyMaxActiveBlocksPerMultiprocessor(&per_cu, (const void*)fwd_kernel, 512, LDS_BYTES);
        (void)hipGetLastError();
        if (ws_size < WS_TOTAL) fprintf(stderr, "kernel_launch: workspace too small: %zu < %zu\n", ws_size, (size_t)WS_TOTAL);
        grid = cus > 0 ? cus : 256;
    }
    (void)hipMemsetAsync((char*)d_ws + WS_CTL, 0, CTL_BYTES, stream);
    Args a{};
    const float** pp = (const float**)&a;
    for (int i = 0; i < 26; ++i) pp[i] = (const float*)d_in[i];
    a.out = (float*)d_out; a.ws = (unsigned char*)d_ws;
    void* args[] = {&a};
    hipError_t e = hipLaunchCooperativeKernel((const void*)fwd_kernel, dim3(grid), dim3(512), args, LDS_BYTES, stream);
    if (e != hipSuccess) fprintf(stderr, "cooperative launch failed: %s\n", hipGetErrorString(e));
}
```

```cpp
#include <hip/hip_runtime.h>
#include <hip/hip_cooperative_groups.h>
#include <cstdio>
#include <cstdint>
namespace cg = cooperative_groups;

#define LAS __attribute__((address_space(3)))
typedef unsigned short bf16_t;
typedef short bf16x8 __attribute__((ext_vector_type(8)));
typedef float f32x4 __attribute__((ext_vector_type(4)));
typedef unsigned u32x4 __attribute__((ext_vector_type(4)));
typedef unsigned u32x2 __attribute__((ext_vector_type(2)));

#define WAVE_SYNC() asm volatile("s_waitcnt lgkmcnt(0)" ::: "memory")
__device__ __forceinline__ int opaque_tid() { int t = threadIdx.x; asm volatile("" : "+v"(t)); return t; }

__device__ __forceinline__ unsigned f2bf(float f) { unsigned u = __builtin_bit_cast(unsigned, f); return (u + 0x7fffu + ((u >> 16) & 1u)) >> 16; }
__device__ __forceinline__ unsigned pk2(float lo, float hi) { return f2bf(lo) | (f2bf(hi) << 16); }
__device__ __forceinline__ float bf2f(bf16_t b) { return __builtin_bit_cast(float, (unsigned)b << 16); }
__device__ __forceinline__ float bflo(unsigned w) { return __builtin_bit_cast(float, w << 16); }
__device__ __forceinline__ float bfhi(unsigned w) { return __builtin_bit_cast(float, w & 0xffff0000u); }
__device__ __forceinline__ float sigm(float x) { return 1.f / (1.f + __expf(-x)); }
__device__ __forceinline__ float gelu_tanh(float y) { const float a = 0.7978845608028654f * (y + 0.044715f * y * y * y); const float th = 1.f - 2.f / (__expf(2.f * a) + 1.f); return 0.5f * y * (1.f + th); }
__device__ __forceinline__ u32x4 pack8(f32x4 a, f32x4 b) { u32x4 w; w.x = pk2(a[0], a[1]); w.y = pk2(a[2], a[3]); w.z = pk2(b[0], b[1]); w.w = pk2(b[2], b[3]); return w; }
__device__ __forceinline__ float wave_sum(float v) {
#pragma unroll
    for (int o = 1; o < 64; o <<= 1) v += __shfl_xor(v, o);
    return v;
}

namespace pg8 {
constexpr int ZSTR = 6208;
constexpr int BM = 256, BK = 64, HALF = 128, HTB = HALF * BK * 2, STAGE_BYTES = 8 * HTB, NXCD = 8, WGM = 8;
__host__ __device__ __forceinline__ int lds_byte(int r, int c) { const int st = (r >> 4) * 2 + (c >> 5), rr = r & 15, cc = c & 31, ob = rr * 64 + cc * 2; return st * 1024 + (ob ^ (((ob >> 9) & 1) << 5)); }
__host__ __device__ __forceinline__ void stage_rc(int b, int& R, int& C) { const int st = b / 1024, sb = b % 1024, swz = sb ^ (((sb >> 9) & 1) << 5); R = (st >> 1) * 16 + swz / 64; C = (st & 1) * 32 + (swz % 64) / 2; }
__host__ __device__ __forceinline__ int perm32(int rho) { const int n = rho >> 4, i = rho & 15; return 8 * (i >> 2) + 4 * n + (i & 3); }
struct Unit { int pm, pn; };
struct Gemm { const bf16_t* A; int lda; const bf16_t* Bt; int M, N, K; };
struct StaticOrder {
    int nM, nN, nwg, G, c;
    __device__ void init(int M, int N, int G_, int c_) { nM = M / BM; nN = N / BM; nwg = nM * nN; G = G_; c = c_; }
    __device__ bool next(int i, Unit& u) const {
        const long L = (long)i * G + c; if (L >= nwg) return false;
        int wgid = (int)L; { const int q = nwg / NXCD, r = nwg % NXCD, xcd = wgid % NXCD, off = wgid / NXCD; wgid = (xcd < r ? xcd * (q + 1) : r * (q + 1) + (xcd - r) * q) + off; }
        const int nig = WGM * nN, gid = wgid / nig, fm = gid * WGM, gsz = (nM - fm) < WGM ? (nM - fm) : WGM;
        u.pm = fm + ((wgid % nig) % gsz); u.pn = (wgid % nig) / gsz; return true;
    }
};

struct UberEpi;
__device__ __forceinline__ void run_epi(const UberEpi& E, LAS unsigned char* lds, const f32x4 (&acc)[2][2][4][2], const Unit& u, int wr, int wc, int fr, int fq);
__device__ __forceinline__ void gemm_phase(LAS unsigned char* lds, const Gemm g, const StaticOrder& S, const UberEpi& E) {
    const int tid = opaque_tid(), wid = __builtin_amdgcn_readfirstlane(tid >> 6), lane = tid & 63, wr = wid >> 2, wc = wid & 3, fr = lane & 15, fq = lane >> 4;
    const int K = g.K, nt = K / BK, lda = g.lda;
    unsigned voffA[2], voffB[2];
#pragma unroll
    for (int i = 0; i < 2; ++i) { int R, C; stage_rc(tid * 16 + i * 8192, R, C); const int Rb = (R & ~31) + perm32(R & 31);
        voffA[i] = (unsigned)(R * lda + C) * 2u; voffB[i] = (unsigned)(Rb * K + C) * 2u; }
    const size_t kstep = (size_t)(BK * 2);
    const size_t hstepA = (size_t)HALF * lda * 2, hstepB = (size_t)HALF * K * 2;
    const size_t tstepA = 2 * hstepA, tstepB = 2 * hstepB;
    const unsigned ldsw = (unsigned)wid * 1024u;
    const int aoff = lds_byte(wr * 64 + fr, fq * 8), boff = lds_byte(wc * 32 + fr, fq * 8);
#define PG8_SA(b, h) (((b) * 2 + (h)) * HTB)
#define PG8_SB(b, h) ((4 + (b) * 2 + (h)) * HTB)
#define PG8_STAGE(bufoff, gbase, voff) do { _Pragma("unroll") for (int _i = 0; _i < 2; ++_i) \
        __builtin_amdgcn_global_load_lds((const unsigned*)((const char*)(gbase) + (voff)[_i]), (LAS unsigned*)(lds + (bufoff) + ldsw + _i * 8192), 16, 0, 0); } while (0)
#define PG8_LDA(dst, b, h) do { _Pragma("unroll") for (int m = 0; m < 4; ++m) _Pragma("unroll") for (int k = 0; k < 2; ++k) dst[m][k] = *(const LAS bf16x8*)(lds + PG8_SA(b, h) + aoff + m * 2048 + k * 1024); } while (0)
#define PG8_LDB(dst, b, h) do { _Pragma("unroll") for (int n = 0; n < 2; ++n) _Pragma("unroll") for (int k = 0; k < 2; ++k) dst[n][k] = *(const LAS bf16x8*)(lds + PG8_SB(b, h) + boff + n * 2048 + k * 1024); } while (0)
#define PG8_MMA(ai, bj, At, Bt) do { __builtin_amdgcn_s_setprio(1); _Pragma("unroll") for (int m = 0; m < 4; ++m) _Pragma("unroll") for (int n = 0; n < 2; ++n) _Pragma("unroll") for (int k = 0; k < 2; ++k) \
        acc[ai][bj][m][n] = __builtin_amdgcn_mfma_f32_16x16x32_bf16(Bt[n][k], At[m][k], acc[ai][bj][m][n], 0, 0, 0); __builtin_amdgcn_s_setprio(0); } while (0)
#define PG8_WAIT_V(n) asm volatile("s_waitcnt vmcnt(" #n ")" ::: "memory")
#define PG8_WAIT_L(n) asm volatile("s_waitcnt lgkmcnt(" #n ")" ::: "memory")
#define PG8_BAR __builtin_amdgcn_s_barrier()
#define PG8_SCHED __builtin_amdgcn_sched_barrier(0)
    Unit cur, nxt; int ui = 0;
    if (!S.next(0, cur)) return;
    f32x4 acc[2][2][4][2];
#pragma unroll
    for (int a = 0; a < 2; ++a)
#pragma unroll
        for (int b = 0; b < 2; ++b)
#pragma unroll
            for (int m = 0; m < 4; ++m)
#pragma unroll
                for (int n = 0; n < 2; ++n) acc[a][b][m][n] = (f32x4){0.f, 0.f, 0.f, 0.f};
    bf16x8 At[4][2], B0[2][2], B1[2][2];
    const char* cA = (const char*)g.A + (size_t)cur.pm * tstepA; const char* cB = (const char*)g.Bt + (size_t)cur.pn * tstepB;
    PG8_STAGE(PG8_SB(0, 0), cB, voffB); PG8_STAGE(PG8_SB(0, 1), cB + hstepB, voffB); PG8_STAGE(PG8_SA(0, 0), cA, voffA); PG8_STAGE(PG8_SA(0, 1), cA + hstepA, voffA);
    if (wr == 1) PG8_BAR;
    PG8_WAIT_V(2); PG8_BAR;
    PG8_STAGE(PG8_SB(1, 0), cB + kstep, voffB); PG8_STAGE(PG8_SA(1, 0), cA + kstep, voffA); PG8_STAGE(PG8_SB(1, 1), cB + hstepB + kstep, voffB);
    PG8_WAIT_V(6); PG8_BAR;
    for (;;) {
        const bool has_next = S.next(ui + 1, nxt);
        const char* nA = has_next ? (const char*)g.A + (size_t)nxt.pm * tstepA : cA; const char* nB = has_next ? (const char*)g.Bt + (size_t)nxt.pn * tstepB : cB;
        for (int t = 0; t < nt; t += 2) {
            const bool last = (t == nt - 2);
            const char* a1 = cA + (size_t)(t + 1) * kstep;
            const char* a2 = last ? nA : cA + (size_t)(t + 2) * kstep; const char* b2 = last ? nB : cB + (size_t)(t + 2) * kstep;
            const char* a3 = a2 + kstep; const char* b3 = b2 + kstep;
            PG8_LDB(B0, 0, 0); PG8_LDB(B1, 0, 1); PG8_SCHED; PG8_LDA(At, 0, 0); PG8_STAGE(PG8_SA(1, 1), a1 + hstepA, voffA);
            PG8_WAIT_V(8); PG8_WAIT_L(0); PG8_BAR; PG8_MMA(0, 0, At, B0); PG8_MMA(0, 1, At, B1); PG8_BAR; PG8_SCHED;
            PG8_LDA(At, 0, 1); PG8_STAGE(PG8_SB(0, 0), b2, voffB); PG8_STAGE(PG8_SB(0, 1), b2 + hstepB, voffB); PG8_STAGE(PG8_SA(0, 0), a2, voffA);
            PG8_WAIT_V(8); PG8_WAIT_L(0); PG8_BAR; PG8_MMA(1, 0, At, B0); PG8_MMA(1, 1, At, B1); PG8_BAR; PG8_SCHED;
            PG8_LDB(B0, 1, 0); PG8_LDB(B1, 1, 1); PG8_SCHED; PG8_LDA(At, 1, 0); PG8_STAGE(PG8_SA(0, 1), a2 + hstepA, voffA);
            PG8_WAIT_V(8); PG8_WAIT_L(0); PG8_BAR; PG8_MMA(0, 0, At, B0); PG8_MMA(0, 1, At, B1); PG8_BAR; PG8_SCHED;
            PG8_LDA(At, 1, 1); PG8_STAGE(PG8_SB(1, 0), b3, voffB); PG8_STAGE(PG8_SB(1, 1), b3 + hstepB, voffB); PG8_STAGE(PG8_SA(1, 0), a3, voffA);
            PG8_WAIT_V(8); PG8_WAIT_L(0); PG8_BAR; PG8_MMA(1, 0, At, B0); PG8_MMA(1, 1, At, B1); PG8_BAR; PG8_SCHED;
        }
        if (wr == 0) PG8_BAR;
        run_epi(E, lds, acc, cur, wr, wc, fr, fq);
        if (!has_next) break;
#pragma unroll
        for (int a = 0; a < 2; ++a)
#pragma unroll
            for (int b = 0; b < 2; ++b)
#pragma unroll
                for (int m = 0; m < 4; ++m)
#pragma unroll
                    for (int n = 0; n < 2; ++n) acc[a][b][m][n] = (f32x4){0.f, 0.f, 0.f, 0.f};
        cur = nxt; cA = nA; cB = nB; ++ui;
        if (wr == 1) PG8_BAR;
    }
    PG8_WAIT_V(0);
    PG8_BAR;
#undef PG8_SA
#undef PG8_SB
#undef PG8_STAGE
#undef PG8_LDA
#undef PG8_LDB
#undef PG8_MMA
#undef PG8_WAIT_V
#undef PG8_WAIT_L
#undef PG8_BAR
#undef PG8_SCHED
}

__device__ __forceinline__ float row_rstd(const float* ssq, int row) {
    const f32x4 s0 = *(const f32x4*)(ssq + (size_t)row * 4);
    const float ss = (s0[0] + s0[1]) + (s0[2] + s0[3]);
    return rsqrtf(ss * (1.0f / 1024.0f) + 1e-6f);
}
struct EpiZ {
    bf16_t* z; const float* ssq; bf16_t* vt; int vt_ld;
    __device__ __forceinline__ void operator()(const f32x4 (&acc)[2][2][4][2], const Unit& u, int wr, int wc, int fr, int fq) const {
        const int row0 = u.pm * BM + wr * 64 + fr, col0 = u.pn * BM + wc * 32 + 8 * fq;
#pragma unroll
        for (int ai = 0; ai < 2; ++ai)
#pragma unroll
            for (int m = 0; m < 4; ++m) {
                const int row = row0 + ai * HALF + m * 16; const float rs = row_rstd(ssq, row);
#pragma unroll
                for (int bj = 0; bj < 2; ++bj) {
                    const u32x4 w = pack8(acc[ai][bj][m][0] * rs, acc[ai][bj][m][1] * rs);
                    *(u32x4*)(z + (size_t)row * ZSTR + col0 + bj * HALF) = w;
                }
            }
    }
};
struct EpiGlu {
    bf16_t* z;
    __device__ __forceinline__ void operator()(const f32x4 (&acc)[2][2][4][2], const Unit& u, int wr, int wc, int fr, int fq) const {
        const int row0 = u.pm * BM + wr * 64 + fr, col0 = wc * 32 + 8 * fq;
#pragma unroll
        for (int ai = 0; ai < 2; ++ai)
#pragma unroll
            for (int m = 0; m < 4; ++m) {
                const int row = row0 + ai * HALF + m * 16;
#pragma unroll
                for (int bj = 0; bj < 2; ++bj) {
                    bf16_t* zp = z + (size_t)row * ZSTR + col0 + bj * HALF;
                    const u32x4 y = *(const u32x4*)(zp + 512);
                    const f32x4 a0 = acc[ai][bj][m][0], a1 = acc[ai][bj][m][1];
                    f32x4 o0, o1;
                    o0[0] = bflo(y.x) * sigm(a0[0]); o0[1] = bfhi(y.x) * sigm(a0[1]); o0[2] = bflo(y.y) * sigm(a0[2]); o0[3] = bfhi(y.y) * sigm(a0[3]);
                    o1[0] = bflo(y.z) * sigm(a1[0]); o1[1] = bfhi(y.z) * sigm(a1[1]); o1[2] = bflo(y.w) * sigm(a1[2]); o1[3] = bfhi(y.w) * sigm(a1[3]);
                    *(u32x4*)zp = pack8(o0, o1);
                }
            }
    }
};
template <int MODE> struct EpiMix {
    bf16_t* z; int goff;
    __device__ __forceinline__ void operator()(const f32x4 (&acc)[2][2][4][2], const Unit& u, int wr, int wc, int fr, int fq) const {
        const int row0 = u.pm * BM + wr * 64 + fr, col0 = u.pn * BM + wc * 32 + 8 * fq;
#pragma unroll
        for (int ai = 0; ai < 2; ++ai)
#pragma unroll
            for (int m = 0; m < 4; ++m) {
                const int row = row0 + ai * HALF + m * 16;
#pragma unroll
                for (int bj = 0; bj < 2; ++bj) {
                    bf16_t* zr = z + (size_t)row * ZSTR + col0 + bj * HALF;
                    const u32x4 gq = *(const u32x4*)(zr + goff);
                    const f32x4 a0 = acc[ai][bj][m][0], a1 = acc[ai][bj][m][1];
                    f32x4 o0, o1;
                    o0[0] = sigm(bflo(gq.x)) * a0[0]; o0[1] = sigm(bfhi(gq.x)) * a0[1]; o0[2] = sigm(bflo(gq.y)) * a0[2]; o0[3] = sigm(bfhi(gq.y)) * a0[3];
                    o1[0] = sigm(bflo(gq.z)) * a1[0]; o1[1] = sigm(bfhi(gq.z)) * a1[1]; o1[2] = sigm(bflo(gq.w)) * a1[2]; o1[3] = sigm(bfhi(gq.w)) * a1[3];
                    if (MODE == 1) { const u32x4 p = *(const u32x4*)(zr + 1024);
                        o0[0] += bflo(p.x); o0[1] += bfhi(p.x); o0[2] += bflo(p.y); o0[3] += bfhi(p.y); o1[0] += bflo(p.z); o1[1] += bfhi(p.z); o1[2] += bflo(p.w); o1[3] += bfhi(p.w); }
                    *(u32x4*)(zr + 1024) = pack8(o0, o1);
                }
            }
    }
};
struct EpiRes {
    float* h; bf16_t* hb; float* ssq; LAS float* red;
    __device__ __forceinline__ void operator()(const f32x4 (&acc)[2][2][4][2], const Unit& u, int wr, int wc, int fr, int fq) const {
        const int row0 = u.pm * BM + wr * 64 + fr, col0 = u.pn * BM + wc * 32 + 8 * fq;
#pragma unroll
        for (int ai = 0; ai < 2; ++ai)
#pragma unroll
            for (int m = 0; m < 4; ++m) {
                const int row = row0 + ai * HALF + m * 16; float part = 0.f;
#pragma unroll
                for (int bj = 0; bj < 2; ++bj) {
                    float* hp = h + (size_t)row * 1024 + col0 + bj * HALF;
                    f32x4 h0 = *(const f32x4*)hp, h1 = *(const f32x4*)(hp + 4);
                    h0 = h0 + acc[ai][bj][m][0]; h1 = h1 + acc[ai][bj][m][1];
                    *(f32x4*)hp = h0; *(f32x4*)(hp + 4) = h1;
                    part += (h0[0] * h0[0] + h0[1] * h0[1]) + (h0[2] * h0[2] + h0[3] * h0[3]) + (h1[0] * h1[0] + h1[1] * h1[1]) + (h1[2] * h1[2] + h1[3] * h1[3]);
                    *(u32x4*)(hb + (size_t)row * 1024 + col0 + bj * HALF) = pack8(h0, h1);
                }
                part += __shfl_xor(part, 16); part += __shfl_xor(part, 32);
                if (fq == 0) red[(ai * HALF + wr * 64 + m * 16 + fr) * 4 + wc] = part;
            }
        asm volatile("s_waitcnt lgkmcnt(0)" ::: "memory");
        __builtin_amdgcn_s_barrier();
        asm volatile("" ::: "memory");
        { const int t_ = opaque_tid(); if (t_ < 256) { const f32x4 r4 = *(const LAS f32x4*)(red + t_ * 4); ssq[(size_t)(u.pm * BM + t_) * 4 + u.pn] = (r4[0] + r4[1]) + (r4[2] + r4[3]); } }
    }
};
struct EpiAct {
    bf16_t* act; const float* ssq;
    __device__ __forceinline__ void operator()(const f32x4 (&acc)[2][2][4][2], const Unit& u, int wr, int wc, int fr, int fq) const {
        const int row0 = u.pm * BM + wr * 64 + fr, col0 = u.pn * HALF + wc * 32 + 8 * fq;
#pragma unroll
        for (int ai = 0; ai < 2; ++ai)
#pragma unroll
            for (int m = 0; m < 4; ++m) {
                const int row = row0 + ai * HALF + m * 16; const float rs = row_rstd(ssq, row);
                f32x4 o[2];
#pragma unroll
                for (int n = 0; n < 2; ++n)
#pragma unroll
                    for (int i = 0; i < 4; ++i) { const float gg = acc[ai][0][m][n][i] * rs, uu = acc[ai][1][m][n][i] * rs; o[n][i] = gg * sigm(gg) * uu; }
                *(u32x4*)(act + (size_t)row * 2816 + col0) = pack8(o[0], o[1]);
            }
    }
};
struct UberEpi { int mode, i0; unsigned char *p0, *p1, *p2; };
__device__ __forceinline__ void run_epi(const UberEpi& E, LAS unsigned char* lds, const f32x4 (&acc)[2][2][4][2], const Unit& u, int wr, int wc, int fr, int fq) {
    switch (E.mode) {
        case 0: { EpiZ e{(bf16_t*)E.p0, (const float*)E.p1, (bf16_t*)E.p2, E.i0}; e(acc, u, wr, wc, fr, fq); break; }
        case 1: { EpiGlu e{(bf16_t*)E.p0}; e(acc, u, wr, wc, fr, fq); break; }
        case 2: { EpiMix<0> e{(bf16_t*)E.p0, E.i0}; e(acc, u, wr, wc, fr, fq); break; }
        case 3: { EpiMix<1> e{(bf16_t*)E.p0, E.i0}; e(acc, u, wr, wc, fr, fq); break; }
        case 4: { EpiRes e{(float*)E.p0, (bf16_t*)E.p1, (float*)E.p2, (LAS float*)(lds + 131072)}; e(acc, u, wr, wc, fr, fq); break; }
        default: { EpiAct e{(bf16_t*)E.p0, (const float*)E.p1}; e(acc, u, wr, wc, fr, fq); break; }
    }
}
}

constexpr int NLAYER = 4, DM = 1024, ZN = 6144, ZW = 6208  , FFH = 2816, RG = 16384, RMAIN = 65536, VTLD = RG + 64  ;
constexpr size_t al256(size_t x) { return (x + 255) & ~(size_t)255; }
constexpr size_t WS_HB = 0;
constexpr size_t WS_SSQ = WS_HB + (size_t)RMAIN * DM * 2;
constexpr size_t WS_Z = WS_SSQ + (size_t)RMAIN * 4 * 4;
constexpr size_t WS_YB = WS_Z + (size_t)RG * ZW * 2;
constexpr size_t WS_VT = WS_YB + (size_t)RG * 512 * 2;
constexpr size_t WS_HGU = WS_VT + (size_t)512 * VTLD * 2;
constexpr size_t WS_HGP = WS_HGU + (size_t)260 * 8 * 4096 * 4;
constexpr size_t WS_S5S = WS_HGP + (size_t)260 * 8 * 64 * 4;
constexpr size_t WS_W = WS_S5S + (size_t)260 * 2048 * 8;
constexpr size_t W_IN = 0, W_UPA = W_IN + (size_t)6144 * 1024 * 2, W_UPB = W_UPA + (size_t)1024 * 256 * 2, W_UPC = W_UPB + (size_t)1024 * 512 * 2,
                 W_O = W_UPC + (size_t)1024 * 256 * 2, W_GU = W_O + (size_t)1024 * 1024 * 2, W_DN = W_GU + (size_t)5632 * 1024 * 2, W_GLU = W_DN + (size_t)1024 * 2816 * 2,
                 W_END = W_GLU + (size_t)256 * 256 * 2;
constexpr size_t WS_TAB = WS_W + W_END;
constexpr size_t T_LBAR = 0, T_L16 = T_LBAR + 2048 * 8, T_L64 = T_L16 + 2048 * 8, T_BFRAG = T_L64 + 2048 * 8, T_CFRAG = T_BFRAG + (size_t)32 * 8 * 64 * 16,
                 T_LB = T_CFRAG + (size_t)32 * 4 * 64 * 16, T_END = T_LB + 256 * 4;
constexpr size_t WS_META = al256(WS_TAB + T_END);
constexpr size_t M_H = 0, M_HB = M_H + (size_t)256 * 1024 * 4, M_SSQ = M_HB + (size_t)256 * 1024 * 2, M_Z = M_SSQ + (size_t)256 * 4 * 4, M_YB = M_Z + (size_t)256 * ZW * 2,
                 M_VT = M_YB + (size_t)256 * 512 * 2, M_ACT = M_VT + (size_t)512 * 256 * 2, M_END = M_ACT + (size_t)256 * FFH * 2;
constexpr size_t WS_CTL = al256(WS_META + M_END);
constexpr size_t CTL_BYTES = 16384;
constexpr size_t WS_TOTAL = WS_CTL + CTL_BYTES;
constexpr int LDS_ST_OFF = 135168;
constexpr int LDS_BYTES = 147456;

struct Args {
    const float *x_prompt, *x_sample, *meta_tokens, *norm1_g, *w_in, *a_re, *a_im, *log_dt, *b_re, *b_im, *c_re, *c_im, *s5_d, *w_glu, *rpb, *lb_logits, *onorm_g,
        *w_up_a, *w_up_b, *w_up_c, *w_o, *norm2_g, *w_gate, *w_up, *w_down, *final_g;
    float* out; unsigned char* ws;
};

__device__ __forceinline__ unsigned long long ufl(unsigned long long v) { const unsigned lo = __builtin_amdgcn_readfirstlane((unsigned)v), hi = __builtin_amdgcn_readfirstlane((unsigned)(v >> 32)); return ((unsigned long long)hi << 32) | lo; }
#define GAS __attribute__((address_space(1)))
#define KA(f) ((decltype(Args::f))(GAS char*)ufl((unsigned long long)(((const volatile Args*)__builtin_amdgcn_kernarg_segment_ptr())->f)))
#define KAF(f) ((const float*)KA(f))
struct Ctx {
    bf16_t *hb, *z, *yb, *vt; float *ssq, *hgu, *hgp, *s5s;
    bf16_t *w; const float *lbar, *l16, *l64; const bf16_t *bfrag, *cfrag; const float* lb;
    float* mh; bf16_t *mhb, *mz, *myb, *mvt, *mact; float* mssq;
};

__device__ __forceinline__ void tr_item(const float* W, int K, int N, bf16_t* WT, const float* kscale, int mode, LAS float* scr, int item, int lane, bool valid) {
    const int nblk = N / 32, kb = item / nblk, nb = item % nblk, k0 = 64 * kb, n0 = 32 * nb;
    if (valid) {
#pragma unroll 8
    for (int i = 0; i < 32; ++i) { const int kk = 2 * i + (lane >> 5); float v = W[(size_t)(k0 + kk) * N + n0 + (lane & 31)]; if (kscale) v *= kscale[k0 + kk]; scr[kk * 33 + (lane & 31)] = v; }
    }
    __syncthreads();
    const int c = lane & 7;
    int drow0 = n0; if (mode) drow0 = (n0 >> 7) * 256 + (n0 & 127) + (mode == 2 ? 128 : 0);
    if (valid) {
#pragma unroll
    for (int j = 0; j < 4; ++j) { const int n = (lane >> 3) + 8 * j; const LAS float* s = scr + (8 * c) * 33 + n;
        u32x4 o; o.x = pk2(s[0 * 33], s[1 * 33]); o.y = pk2(s[2 * 33], s[3 * 33]); o.z = pk2(s[4 * 33], s[5 * 33]); o.w = pk2(s[6 * 33], s[7 * 33]);
        *(u32x4*)(WT + (size_t)(drow0 + n) * K + k0 + 8 * c) = o; }
    }
    __syncthreads();
}

__device__ __forceinline__ void prep_layer(const Ctx& X, int l, LAS unsigned char* lds, int G) {
    const int tid_ = opaque_tid(); const int wave = __builtin_amdgcn_readfirstlane(tid_ >> 6), lane = tid_ & 63;
    LAS float* scr = (LAS float*)(lds + wave * 16384);
    const int gw = blockIdx.x * 8 + wave, NGW = G * 8;
    constexpr int I0 = 16 * 192, I1 = 4 * 32, I2 = 8 * 32, I3 = 4 * 32, I4 = 16 * 32, I5 = 16 * 88, I6 = 16 * 88, I7 = 44 * 32, I8 = 4 * 8;
    constexpr int NIT = I0 + I1 + I2 + I3 + I4 + I5 + I6 + I7 + I8;
    unsigned char* wb = (unsigned char*)X.w;
    for (int it0 = 0; it0 < NIT; it0 += NGW) {
        const int it = it0 + gw; const bool valid = it < NIT;
        int r = valid ? it : 0;
        if (r < I0) { tr_item(KAF(w_in) + (size_t)l * 1024 * 6144, 1024, 6144, (bf16_t*)(wb + W_IN), KAF(norm1_g) + l * 1024, 0, scr, r, lane, valid); continue; } r -= I0;
        if (r < I1) { tr_item(KAF(w_up_a) + (size_t)l * 256 * 1024, 256, 1024, (bf16_t*)(wb + W_UPA), nullptr, 0, scr, r, lane, valid); continue; } r -= I1;
        if (r < I2) { tr_item(KAF(w_up_b) + (size_t)l * 512 * 1024, 512, 1024, (bf16_t*)(wb + W_UPB), nullptr, 0, scr, r, lane, valid); continue; } r -= I2;
        if (r < I3) { tr_item(KAF(w_up_c) + (size_t)l * 256 * 1024, 256, 1024, (bf16_t*)(wb + W_UPC), nullptr, 0, scr, r, lane, valid); continue; } r -= I3;
        if (r < I4) { tr_item(KAF(w_o) + (size_t)l * 1024 * 1024, 1024, 1024, (bf16_t*)(wb + W_O), nullptr, 0, scr, r, lane, valid); continue; } r -= I4;
        if (r < I5) { tr_item(KAF(w_gate) + (size_t)l * 1024 * 2816, 1024, 2816, (bf16_t*)(wb + W_GU), KAF(norm2_g) + l * 1024, 1, scr, r, lane, valid); continue; } r -= I5;
        if (r < I6) { tr_item(KAF(w_up) + (size_t)l * 1024 * 2816, 1024, 2816, (bf16_t*)(wb + W_GU), KAF(norm2_g) + l * 1024, 2, scr, r, lane, valid); continue; } r -= I6;
        if (r < I7) { tr_item(KAF(w_down) + (size_t)l * 2816 * 1024, 2816, 1024, (bf16_t*)(wb + W_DN), nullptr, 0, scr, r, lane, valid); continue; } r -= I7;
        tr_item(KAF(w_glu) + (size_t)l * 256 * 256, 256, 256, (bf16_t*)(wb + W_GLU), nullptr, 0, scr, r, lane, valid);
    }
    const int gt = blockIdx.x * 512 + tid_;
    if (gt < 2048) {
        const int dg = gt >> 6, p = gt & 63;
        const size_t pb = ((size_t)l * 32 + dg);
        const float are = KAF(a_re)[pb * 64 + p], aim = KAF(a_im)[pb * 64 + p], dt = expf(KAF(log_dt)[pb]);
        const float mag = expf(are * dt); float sn, cs; sincosf(aim * dt, &sn, &cs);
        const float lr = mag * cs, li = mag * sn;
        const float den = are * are + aim * aim, nr = lr - 1.0f, ni = li;
        const float zr = (nr * are + ni * aim) / den, zi = (ni * are - nr * aim) / den;
        float* lbar = (float*)X.lbar; float* l16 = (float*)X.l16; float* l64 = (float*)X.l64;
        lbar[gt * 2] = lr; lbar[gt * 2 + 1] = li;
        float pr = lr, pi = li;
#pragma unroll
        for (int s = 0; s < 4; ++s) { const float t = pr * pr - pi * pi; pi = 2.f * pr * pi; pr = t; }
        l16[gt * 2] = pr; l16[gt * 2 + 1] = pi;
#pragma unroll
        for (int s = 0; s < 2; ++s) { const float t = pr * pr - pi * pi; pi = 2.f * pr * pi; pr = t; }
        l64[gt * 2] = pr; l64[gt * 2 + 1] = pi;
        bf16_t* bfr = (bf16_t*)X.bfrag; bf16_t* cfr = (bf16_t*)X.cfrag;
        const int ntr = p >> 4, col = p & 15;
        for (int c = 0; c < 16; ++c) {
            const float br = KAF(b_re)[(pb * 64 + p) * 16 + c], bi = KAF(b_im)[(pb * 64 + p) * 16 + c];
            const float bbr = zr * br - zi * bi, bbi = zr * bi + zi * br;
            const int q = c >> 3, j = c & 7;
            bfr[(((size_t)dg * 8 + ntr) * 64 + col + 16 * q) * 8 + j] = (bf16_t)f2bf(bbr);
            bfr[(((size_t)dg * 8 + 4 + ntr) * 64 + col + 16 * q) * 8 + j] = (bf16_t)f2bf(bbi);
            bfr[(((size_t)dg * 8 + ntr) * 64 + col + 16 * (q + 2)) * 8 + j] = 0;
            bfr[(((size_t)dg * 8 + 4 + ntr) * 64 + col + 16 * (q + 2)) * 8 + j] = 0;
            const float cr = KAF(c_re)[(pb * 16 + c) * 64 + p], ci = KAF(c_im)[(pb * 16 + c) * 64 + p];
            { const int k = p;      cfr[(((size_t)dg * 4 + (k >> 5)) * 64 + c + 16 * ((k >> 3) & 3)) * 8 + (k & 7)] = (bf16_t)f2bf(cr); }
            { const int k = 64 + p; cfr[(((size_t)dg * 4 + (k >> 5)) * 64 + c + 16 * ((k >> 3) & 3)) * 8 + (k & 7)] = (bf16_t)f2bf(-ci); }
        }
    }
    if (gt >= 2048 && gt < 2048 + 256) {
        const int c = gt - 2048;
        const float l0 = KAF(lb_logits)[c], l1 = KAF(lb_logits)[256 + c], l2 = KAF(lb_logits)[512 + c], l3 = KAF(lb_logits)[768 + c];
        const float mx = fmaxf(fmaxf(l0, l1), fmaxf(l2, l3));
        const float e0 = expf(l0 - mx), e1 = expf(l1 - mx), e2 = expf(l2 - mx), e3 = expf(l3 - mx), inv = 1.f / (e0 + e1 + e2 + e3);
        float v = 0.f; if (l >= 1) v += e1 * inv; if (l >= 2) v += e2 * inv; if (l >= 3) v += e3 * inv;
        ((float*)X.lb)[c] = v;
    }
}

struct Grp { int g, nseq, Lr, nch, s0; };
__device__ __forceinline__ Grp make_grp(int g) { Grp r; r.g = g; r.nseq = g < 2 ? 4 : 1; r.Lr = g < 2 ? 4096 : 16384; r.nch = r.Lr / 64 + 1; r.s0 = g < 2 ? g * 4 : 8 + (g - 2); return r; }

template <bool OUT>
__device__ __forceinline__ void s5_chunk(const Ctx& X, const float* s5d, LAS float* buf, bf16_t* zc, int T, int ci, int wave, int lane) {
    const int p = lane, fr = lane & 15, fq = lane >> 4;
    for (int gi = 0; gi < 2; ++gi) {
        const int g = wave * 2 + gi;
        f32x4 yacc[2][2];
#pragma unroll
        for (int i = 0; i < 2; ++i)
#pragma unroll
            for (int j = 0; j < 2; ++j) yacc[i][j] = (f32x4){0.f, 0.f, 0.f, 0.f};
#pragma unroll
        for (int dir = 0; dir < 2; ++dir) {
            const int dg = dir * 16 + g;
            const float lr = X.lbar[(dg * 64 + p) * 2], li = X.lbar[(dg * 64 + p) * 2 + 1];
            float xr = 0.f, xi = 0.f;
            float* st = X.s5s + ((size_t)ci * 2048 + dg * 64 + p) * 2;
            if (OUT) { xr = st[0]; xi = st[1]; }
#pragma unroll
            for (int sti = 0; sti < 2; ++sti) {
                const int stt = dir ? 1 - sti : sti; const int t0 = stt * 32;
                if (t0 < T) {
                    const int tn = (T - t0) < 32 ? (T - t0) : 32;
#pragma unroll
                    for (int mt = 0; mt < 2; ++mt) {
                        if (mt * 16 < tn) {
                            bf16x8 av = (bf16x8){0, 0, 0, 0, 0, 0, 0, 0};
                            if (fq < 2) av = *(const bf16x8*)(zc + (size_t)(t0 + mt * 16 + fr) * ZW + g * 16 + fq * 8);
#pragma unroll
                            for (int nt = 0; nt < 8; ++nt) {
                                const bf16x8 bv = *(const bf16x8*)(X.bfrag + (((size_t)dg * 8 + nt) * 64 + lane) * 8);
                                const f32x4 c = __builtin_amdgcn_mfma_f32_16x16x32_bf16(av, bv, (f32x4){0.f, 0.f, 0.f, 0.f}, 0, 0, 0);
#pragma unroll
                                for (int r = 0; r < 4; ++r) buf[(mt * 16 + fq * 4 + r) * 132 + nt * 16 + fr] = c[r];
                            }
                        }
                    }
                    __syncthreads();
                    for (int k = 0; k < tn; ++k) {
                        const int t = dir ? (tn - 1 - k) : k;
                        const float br = buf[t * 132 + p], bi = buf[t * 132 + 64 + p];
                        const float nr = lr * xr - li * xi + br, ni = lr * xi + li * xr + bi;
                        xr = nr; xi = ni;
                        if (OUT) { buf[t * 132 + p] = xr; buf[t * 132 + 64 + p] = xi; }
                    }
                    if (OUT) {
                        __syncthreads();
#pragma unroll
                        for (int mt = 0; mt < 2; ++mt) {
                            if (mt * 16 < tn) {
#pragma unroll
                                for (int ks = 0; ks < 4; ++ks) {
                                    const LAS float* ap = buf + (mt * 16 + fr) * 132 + ks * 32 + fq * 8;
                                    const f32x4 a0 = *(const LAS f32x4*)ap, a1 = *(const LAS f32x4*)(ap + 4);
                                    const u32x4 aw = pack8(a0, a1);
                                    const bf16x8 av = __builtin_bit_cast(bf16x8, aw);
                                    const bf16x8 bv = *(const bf16x8*)(X.cfrag + (((size_t)dg * 4 + ks) * 64 + lane) * 8);
                                    yacc[stt][mt] = __builtin_amdgcn_mfma_f32_16x16x32_bf16(av, bv, yacc[stt][mt], 0, 0, 0);
                                }
                            }
                        }
                    }
                    __syncthreads();
                }
            }
            if (!OUT) { st[0] = xr; st[1] = xi; }
        }
        if (OUT) {
            const float dsk = s5d[g * 16 + fr];
#pragma unroll
            for (int stt = 0; stt < 2; ++stt)
#pragma unroll
                for (int mt = 0; mt < 2; ++mt) {
                    if (stt * 32 + mt * 16 < T) {
#pragma unroll
                        for (int r = 0; r < 4; ++r) {
                            const int t = stt * 32 + mt * 16 + fq * 4 + r;
                            bf16_t* zr = zc + (size_t)t * ZW;
                            const float u = bf2f(zr[g * 16 + fr]);
                            const float y = gelu_tanh(yacc[stt][mt][r] + dsk * u);
                            zr[512 + g * 16 + fr] = (bf16_t)f2bf(y);
                        }
                    }
                }
        }
    }
}

__device__ __forceinline__ void s5_passB(const Ctx& X, const Grp& gp, int gtid, int GT) {
    const int n = gp.nseq * 2048;
    for (int e = gtid; e < n; e += GT) {
        const int sl = e >> 11, r = e & 2047, dir = r >> 10;
        const float l16r = X.l16[r * 2], l16i = X.l16[r * 2 + 1], l64r = X.l64[r * 2], l64i = X.l64[r * 2 + 1];
        float sr = 0.f, si = 0.f;
        for (int k0 = 0; k0 < gp.nch; k0 += 8) {
            float er[8], ei[8];
#pragma unroll
            for (int j = 0; j < 8; ++j) { const int k = k0 + j; if (k < gp.nch) { const int c = dir ? gp.nch - 1 - k : k; const float* pp = X.s5s + ((size_t)(sl * gp.nch + c) * 2048 + r) * 2; er[j] = pp[0]; ei[j] = pp[1]; } else { er[j] = 0.f; ei[j] = 0.f; } }
#pragma unroll
            for (int j = 0; j < 8; ++j) { const int k = k0 + j; if (k < gp.nch) { const int c = dir ? gp.nch - 1 - k : k; float* pp = X.s5s + ((size_t)(sl * gp.nch + c) * 2048 + r) * 2; pp[0] = sr; pp[1] = si;
                    const float pr = c == 0 ? l16r : l64r, pi = c == 0 ? l16i : l64i;
                    const float nr = pr * sr - pi * si + er[j], ni = pr * si + pi * sr + ei[j]; sr = nr; si = ni; } }
        }
    }
}

template <bool OUT>
__device__ __forceinline__ void hg_chunk(const Ctx& X, LAS float* gt, LAS bf16_t* ot, const bf16_t* zc, int T, int ci, int wave, int lane) {
    const int h = wave >> 1, dir = wave & 1;
    float S[64];
    float* U = X.hgu + ((size_t)ci * 8 + wave) * 4096;
    if (OUT) {
#pragma unroll
        for (int d = 0; d < 64; ++d) S[d] = U[d * 64 + lane];
    } else {
#pragma unroll
        for (int d = 0; d < 64; ++d) S[d] = 0.f;
    }
    const float lbv = X.lb[h * 64 + lane], oml = 1.f - lbv; float P = 1.f;
    const int fcol = (dir ? 2304 : 2048) + h * 64 + lane, qcol = 1792 + h * 64 + lane, vcol = 2560 + h * 64 + lane;
    const int ns8 = T >> 3;
#pragma unroll 1
    for (int s8 = 0; s8 < ns8; ++s8) {
        const int sb = dir ? (ns8 - 1 - s8) : s8;
#pragma unroll
        for (int j = 0; j < 8; ++j) {
            const bf16_t* zr = zc + (size_t)(sb * 8 + j) * ZW;
            const float q = bf2f(zr[qcol]), ff = bf2f(zr[fcol]);
            const float sg = sigm(ff), fg = lbv + oml * sg, kk = oml * (1.f - sg);
            gt[j * 256 + lane] = fg; gt[j * 256 + 64 + lane] = kk; gt[j * 256 + 128 + lane] = q * sigm(q); gt[j * 256 + 192 + lane] = bf2f(zr[vcol]);
            P *= fg;
        }
        __syncthreads();
#pragma unroll 1
        for (int jj = 0; jj < 8; ++jj) {
            const int j = dir ? 7 - jj : jj;
            const LAS float* gj = gt + j * 256;
            const float v = gj[192 + lane];
            float o = 0.f;
#pragma unroll
            for (int d4 = 0; d4 < 16; ++d4) {
                const f32x4 f4 = *(const LAS f32x4*)(gj + d4 * 4), k4 = *(const LAS f32x4*)(gj + 64 + d4 * 4);
#pragma unroll
                for (int i = 0; i < 4; ++i) S[d4 * 4 + i] = f4[i] * S[d4 * 4 + i] + k4[i] * v;
                if (OUT) { const f32x4 q4 = *(const LAS f32x4*)(gj + 128 + d4 * 4);
#pragma unroll
                    for (int i = 0; i < 4; ++i) o += S[d4 * 4 + i] * q4[i]; }
                if ((d4 & 3) == 3) __builtin_amdgcn_sched_barrier(0);
            }
            if (OUT) ot[(sb * 8 + j) * 64 + lane] = (bf16_t)f2bf(o);
        }
        __syncthreads();
    }
    if (!OUT) {
#pragma unroll
        for (int d = 0; d < 64; ++d) U[d * 64 + lane] = S[d];
        X.hgp[((size_t)ci * 8 + wave) * 64 + lane] = P;
    }
}

__device__ __forceinline__ void hg_passB(const Ctx& X, const Grp& gp, int gtid, int GT) {
    const int n = gp.nseq * 32768;
    for (int e = gtid; e < n; e += GT) {
        const int sl = e >> 15, r = e & 32767, hd = r >> 12, de = r & 4095, d = de >> 6, dir = hd & 1;
        float s = 0.f;
        for (int k0 = 0; k0 < gp.nch; k0 += 8) {
            float u[8], pv[8];
#pragma unroll
            for (int j = 0; j < 8; ++j) { const int k = k0 + j; if (k < gp.nch) { const int c = dir ? gp.nch - 1 - k : k; const size_t cb = (size_t)(sl * gp.nch + c) * 8 + hd; u[j] = X.hgu[cb * 4096 + de]; pv[j] = X.hgp[cb * 64 + d]; } else { u[j] = 0.f; pv[j] = 0.f; } }
#pragma unroll
            for (int j = 0; j < 8; ++j) { const int k = k0 + j; if (k < gp.nch) { const int c = dir ? gp.nch - 1 - k : k; const size_t cb = (size_t)(sl * gp.nch + c) * 8 + hd; X.hgu[cb * 4096 + de] = s; s = pv[j] * s + u[j]; } }
        }
    }
}

typedef short v4i16_t __attribute__((ext_vector_type(4)));
__device__ __forceinline__ v4i16_t vtr16(const LAS unsigned char* p) { return __builtin_amdgcn_ds_read_tr16_b64_v4i16((LAS v4i16_t*)p); }
__device__ __forceinline__ void na_task(const Ctx& X, const float* rpb, const Grp& gp, int sl, int task, bool metaq, int wave, int lane, LAS unsigned char* vl) {
    const int h = wave, fr = lane & 15, fq = lane >> 4;
    const int s = gp.s0 + sl, rows = gp.Lr >> 6;
    int r = 0, n = 0, rs = 0, ks = 0;
    const bf16_t* qptr; bf16_t* optr; size_t ostride = 512;
    if (metaq) { qptr = X.mz + (size_t)(s * 16 + fr) * ZW; optr = X.myb + (size_t)(s * 16) * 512; }
    else {
        r = task >> 2; n = task & 3;
        rs = r - 4; rs = rs < 0 ? 0 : (rs > rows - 8 ? rows - 8 : rs);
        ks = 16 * n - 8; ks = ks < 0 ? 0 : (ks > 32 ? 32 : ks);
        const size_t qrow0 = (size_t)sl * gp.Lr + r * 64 + 16 * n;
        qptr = X.z + (qrow0 + fr) * ZW; optr = X.yb + qrow0 * 512;
    }
    bf16x8 qf[2];
#pragma unroll
    for (int kk = 0; kk < 2; ++kk) qf[kk] = *(const bf16x8*)(qptr + 256 + h * 64 + 32 * kk + 8 * fq);
    f32x4 sc[17];
    {
        const bf16_t* kp = X.mz + (size_t)(s * 16 + fr) * ZW + 768 + h * 64 + 8 * fq;
        f32x4 c = (f32x4){0.f, 0.f, 0.f, 0.f};
#pragma unroll
        for (int kk = 0; kk < 2; ++kk) c = __builtin_amdgcn_mfma_f32_16x16x32_bf16(*(const bf16x8*)(kp + 32 * kk), qf[kk], c, 0, 0, 0);
        sc[0] = c * 0.125f;
    }
    const int qc = 16 * n + fr;
    int wstart = qc - 8; wstart = wstart < 0 ? 0 : (wstart > 48 ? 48 : wstart);
    const size_t krow_base = (size_t)sl * gp.Lr + (size_t)rs * 64 + ks;
    if (!metaq) {
#pragma unroll
        for (int tb = 0; tb < 2; ++tb) {
            bf16x8 kf[8][2]; float bz[8][4];
#pragma unroll
            for (int t4 = 0; t4 < 8; ++t4) {
                const int tt = tb * 8 + t4, kj = tt >> 1, half = tt & 1;
                const bf16_t* kp = X.z + (krow_base + kj * 64 + 16 * half + fr) * ZW + 768 + h * 64 + 8 * fq;
                kf[t4][0] = *(const bf16x8*)kp; kf[t4][1] = *(const bf16x8*)(kp + 32);
            }
#pragma unroll
            for (int t4 = 0; t4 < 8; ++t4) {
                const int tt = tb * 8 + t4, kj = tt >> 1, half = tt & 1;
                const float* rp = rpb + (h * 15 + (rs + kj - r + 7)) * 31;
#pragma unroll
                for (int i = 0; i < 4; ++i) { int dc = ks + 16 * half + 4 * fq + i - qc; dc = dc < -15 ? -15 : (dc > 15 ? 15 : dc); bz[t4][i] = rp[dc + 15]; }
            }
            __builtin_amdgcn_sched_barrier(0);
#pragma unroll
            for (int t4 = 0; t4 < 8; ++t4) {
                const int tt = tb * 8 + t4, half = tt & 1;
                f32x4 c = (f32x4){0.f, 0.f, 0.f, 0.f};
                c = __builtin_amdgcn_mfma_f32_16x16x32_bf16(kf[t4][0], qf[0], c, 0, 0, 0);
                c = __builtin_amdgcn_mfma_f32_16x16x32_bf16(kf[t4][1], qf[1], c, 0, 0, 0);
#pragma unroll
                for (int i = 0; i < 4; ++i) {
                    const int kc = ks + 16 * half + 4 * fq + i;
                    const bool valid = (kc >= wstart) && (kc < wstart + 16);
                    c[i] = valid ? c[i] * 0.125f + bz[t4][i] : -1e30f;
                }
                sc[1 + tt] = c;
            }
            __builtin_amdgcn_sched_barrier(0);
        }
    } else {
#pragma unroll
        for (int tt = 0; tt < 16; ++tt) sc[1 + tt] = (f32x4){-1e30f, -1e30f, -1e30f, -1e30f};
    }
    float mx = -1e30f;
#pragma unroll
    for (int t = 0; t < 17; ++t)
#pragma unroll
        for (int i = 0; i < 4; ++i) mx = fmaxf(mx, sc[t][i]);
    mx = fmaxf(mx, __shfl_xor(mx, 16)); mx = fmaxf(mx, __shfl_xor(mx, 32));
    float sum = 0.f;
#pragma unroll
    for (int t = 0; t < 17; ++t)
#pragma unroll
        for (int i = 0; i < 4; ++i) { const float e = __expf(sc[t][i] - mx); sc[t][i] = e; sum += e; }
    sum += __shfl_xor(sum, 16); sum += __shfl_xor(sum, 32);
    const float inv = 1.f / sum;
    f32x4 oacc[4];
#pragma unroll
    for (int et = 0; et < 4; ++et) oacc[et] = (f32x4){0.f, 0.f, 0.f, 0.f};
    {
        const int r8 = lane >> 3, pc = lane & 7, l16 = lane & 15;
        const int vcol = 1280 + h * 64 + pc * 8;
        u32x4 vreg[8];
#pragma unroll
        for (int i = 0; i < 2; ++i) vreg[i] = *(const u32x4*)(X.mz + (size_t)(s * 16 + i * 8 + r8) * ZW + vcol);
#pragma unroll
        for (int cc = 0; cc < 5; ++cc) {
            if (cc > 0 && metaq) break;
            __syncthreads();
#pragma unroll
            for (int i = 0; i < 8; ++i) if (cc > 0 || i < 2) *(LAS u32x4*)(vl + (i * 8 + r8) * 144 + pc * 16) = vreg[i];
            __syncthreads();
            if (cc < 4 && !metaq) {
#pragma unroll
                for (int i = 0; i < 8; ++i) { const int rr = i * 8 + r8;
                    vreg[i] = *(const u32x4*)(X.z + (krow_base + (size_t)(2 * cc + (rr >> 5)) * 64 + (rr & 31)) * ZW + vcol); }
            }
#pragma unroll
            for (int ksl = 0; ksl < 2; ++ksl) {
                if (cc == 0 && ksl == 1) break;
                const int tt = 4 * (cc - 1) + 2 * ksl;
                f32x4 pa, pb;
                if (cc == 0) { pa = sc[0] * inv; pb = (f32x4){0.f, 0.f, 0.f, 0.f}; } else { pa = sc[1 + tt] * inv; pb = sc[2 + tt] * inv; }
                const bf16x8 pf = __builtin_bit_cast(bf16x8, pack8(pa, pb));
                const LAS unsigned char* rowp = vl + (32 * ksl + 4 * fq + (l16 >> 2)) * 144 + (4 * (l16 & 3)) * 2;
#pragma unroll
                for (int et = 0; et < 4; ++et) {
                    const v4i16_t ta = vtr16(rowp + et * 32);
                    v4i16_t tb = (v4i16_t){0, 0, 0, 0};
                    if (cc > 0) tb = vtr16(rowp + 16 * 144 + et * 32);
                    const bf16x8 vw = (bf16x8){ta[0], ta[1], ta[2], ta[3], tb[0], tb[1], tb[2], tb[3]};
                    oacc[et] = __builtin_amdgcn_mfma_f32_16x16x32_bf16(pf, vw, oacc[et], 0, 0, 0);
                }
            }
        }
    }
#pragma unroll
    for (int et = 0; et < 4; ++et)
#pragma unroll
        for (int i = 0; i < 4; ++i) optr[(size_t)(4 * fq + i) * ostride + h * 64 + et * 16 + fr] = (bf16_t)f2bf(oacc[et][i]);
}

#define XB_TMO      128
#define XB_XCNT(j)  (256  + 64 * (j))
#define XB_XSUB(j)  (1280 + 64 * (j))
#define XB_XGEN(j)  (2304 + 64 * (j))
#define XB_TOP      3328
#define XB_TOPGEN   3392
#define XCD_BAR_WORDS 3456
#define XB_SPIN_CAP (1u << 22)
__device__ __forceinline__ unsigned xb_ld(unsigned* p)              { return __hip_atomic_load(p, __ATOMIC_RELAXED, __HIP_MEMORY_SCOPE_AGENT); }
__device__ __forceinline__ unsigned xb_add(unsigned* p, unsigned v) { return __hip_atomic_fetch_add(p, v, __ATOMIC_RELAXED, __HIP_MEMORY_SCOPE_AGENT); }
__device__ __forceinline__ unsigned xb_xcc_id() { return (unsigned)__builtin_amdgcn_s_getreg((3 << 11) | 20) & 0xFu; }
#define XB_SPIN(cond, bar) do { unsigned _sp = 0; while (cond) { __builtin_amdgcn_s_sleep(1); \
    if ((++_sp & 255u) == 0u) { if (xb_ld(&(bar)[XB_TMO])) break; if (_sp > XB_SPIN_CAP) { atomicAdd(&(bar)[XB_TMO], 1u); break; } } } } while (0)
__device__ __forceinline__ void xcd_barrier_complete(unsigned* bar, unsigned x, unsigned& nloc, unsigned& nx) {
    const unsigned G = gridDim.x * gridDim.y * gridDim.z;
    unsigned sum, cnt, mine, sp = 0u;
    for (;;) {
        sum = 0u; cnt = 0u; mine = 0u;
#pragma unroll
        for (unsigned j = 0; j < 16; ++j) { const unsigned c = xb_ld(&bar[XB_XCNT(j)]); sum += c; cnt += (c > 0u) ? 1u : 0u; mine = (j == x) ? c : mine; }
        if (sum == G) break;
        __builtin_amdgcn_s_sleep(1);
        if ((++sp & 255u) == 0u) { if (xb_ld(&bar[XB_TMO])) break; if (sp > XB_SPIN_CAP) { atomicAdd(&bar[XB_TMO], 1u); break; } }
    }
    nloc = mine > 0u ? mine : 1u; nx = cnt > 0u ? cnt : 1u;
}
__device__ __forceinline__ void xcd_barrier(unsigned* bar, volatile LAS unsigned* st) {
    asm volatile("s_waitcnt vmcnt(0)" ::: "memory");
    __syncthreads();
    if (threadIdx.x == 0) {
        const unsigned x = xb_xcc_id();
        __builtin_amdgcn_s_waitcnt(0);
        unsigned nloc = st[0], nx = st[1];
        if (nloc == 0u) { xcd_barrier_complete(bar, x, nloc, nx); st[0] = nloc; st[1] = nx; }
        const unsigned old = xb_add(&bar[XB_XSUB(x)], 1u);
        const unsigned gen = old / nloc;
        if (old + 1u == (gen + 1u) * nloc) {
            __builtin_amdgcn_fence(__ATOMIC_RELEASE, "agent");
            asm volatile("s_waitcnt vmcnt(0)" ::: "memory");
            const unsigned og = xb_add(&bar[XB_TOP], 1u);
            const unsigned tg = og / nx;
            if (og + 1u == (tg + 1u) * nx) xb_add(&bar[XB_TOPGEN], 1u);
            else XB_SPIN(xb_ld(&bar[XB_TOPGEN]) == tg, bar);
            __builtin_amdgcn_fence(__ATOMIC_ACQUIRE, "agent");
            xb_add(&bar[XB_XGEN(x)], 1u);
            asm volatile("s_waitcnt vmcnt(0)" ::: "memory");
        } else {
            XB_SPIN(xb_ld(&bar[XB_XGEN(x)]) == gen, bar);
            __builtin_amdgcn_fence(__ATOMIC_ACQUIRE, "agent");
            asm volatile("s_waitcnt vmcnt(0)" ::: "memory");
        }
    }
    __syncthreads();
}
#define GRID_SYNC() xcd_barrier((unsigned*)(KA(ws) + WS_CTL), (volatile LAS unsigned*)(lds + LDS_ST_OFF))
__device__ __forceinline__ Ctx make_ctx(unsigned char* ws) {
    Ctx X;
    X.hb = (bf16_t*)(ws + WS_HB); X.ssq = (float*)(ws + WS_SSQ); X.z = (bf16_t*)(ws + WS_Z); X.yb = (bf16_t*)(ws + WS_YB); X.vt = (bf16_t*)(ws + WS_VT);
    X.hgu = (float*)(ws + WS_HGU); X.hgp = (float*)(ws + WS_HGP); X.s5s = (float*)(ws + WS_S5S); X.w = (bf16_t*)(ws + WS_W);
    X.lbar = (const float*)(ws + WS_TAB + T_LBAR); X.l16 = (const float*)(ws + WS_TAB + T_L16); X.l64 = (const float*)(ws + WS_TAB + T_L64);
    X.bfrag = (const bf16_t*)(ws + WS_TAB + T_BFRAG); X.cfrag = (const bf16_t*)(ws + WS_TAB + T_CFRAG); X.lb = (const float*)(ws + WS_TAB + T_LB);
    X.mh = (float*)(ws + WS_META + M_H); X.mhb = (bf16_t*)(ws + WS_META + M_HB); X.mssq = (float*)(ws + WS_META + M_SSQ); X.mz = (bf16_t*)(ws + WS_META + M_Z);
    X.myb = (bf16_t*)(ws + WS_META + M_YB); X.mvt = (bf16_t*)(ws + WS_META + M_VT); X.mact = (bf16_t*)(ws + WS_META + M_ACT);
    return X;
}

__device__ __forceinline__ bool make_job(unsigned char* ws, float* out, int l, int g, int ph, int j, pg8::Gemm& gm, pg8::UberEpi& ep) {
    const bool mchain = (g == 3) && (l < NLAYER - 1);
    int njobs = 1; bool meta = false; int sub = j;
    if (ph == 0) { njobs = (g == 0) ? 2 : 1; meta = (j == 1); }
    else if (ph == 4) { njobs = (g == 3) ? 2 : 1; meta = (j == 1); }
    else if (ph == 5) { njobs = mchain ? 6 : 3; meta = (j >= 3); sub = j % 3; }
    else { njobs = mchain ? 2 : 1; meta = (j == 1); }
    if (j >= njobs) return false;
    unsigned char* wb = ws + WS_W;
    const size_t r0 = (size_t)g * RG;
    unsigned char* mb = ws + WS_META;
    bf16_t* z = meta ? (bf16_t*)(mb + M_Z) : (bf16_t*)(ws + WS_Z);
    bf16_t* hb = meta ? (bf16_t*)(mb + M_HB) : (bf16_t*)(ws + WS_HB) + r0 * DM;
    float* ssq = meta ? (float*)(mb + M_SSQ) : (float*)(ws + WS_SSQ) + r0 * 4;
    float* h = meta ? (float*)(mb + M_H) : out + r0 * DM;
    bf16_t* yb = meta ? (bf16_t*)(mb + M_YB) : (bf16_t*)(ws + WS_YB);
    bf16_t* vt = meta ? (bf16_t*)(mb + M_VT) : (bf16_t*)(ws + WS_VT);
    bf16_t* act = meta ? (bf16_t*)(mb + M_ACT) : (bf16_t*)(ws + WS_Z);
    gm.M = meta ? 256 : RG;
    ep.i0 = 0; ep.p0 = nullptr; ep.p1 = nullptr; ep.p2 = nullptr;
    if (ph == 0) { gm.A = hb; gm.lda = DM; gm.Bt = (const bf16_t*)(wb + W_IN); gm.N = ZN; gm.K = DM; ep.mode = 0; ep.p0 = (unsigned char*)z; ep.p1 = (unsigned char*)ssq; ep.p2 = (unsigned char*)vt; ep.i0 = meta ? 256 : VTLD; }
    else if (ph == 4) { gm.A = z + 512; gm.lda = ZW; gm.Bt = (const bf16_t*)(wb + W_GLU); gm.N = 256; gm.K = 256; ep.mode = 1; ep.p0 = (unsigned char*)z; }
    else if (ph == 5) {
        gm.N = DM; ep.p0 = (unsigned char*)z;
        if (sub == 0) { gm.A = yb; gm.lda = 512; gm.Bt = (const bf16_t*)(wb + W_UPB); gm.K = 512; ep.mode = 2; ep.i0 = 4096; }
        else if (sub == 1) { gm.A = z + 256; gm.lda = ZW; gm.Bt = (const bf16_t*)(wb + W_UPC); gm.K = 256; ep.mode = 3; ep.i0 = 5120; }
        else { gm.A = z; gm.lda = ZW; gm.Bt = (const bf16_t*)(wb + W_UPA); gm.K = 256; ep.mode = 3; ep.i0 = 3072; }
    }
    else if (ph == 6) { gm.A = z + 1024; gm.lda = ZW; gm.Bt = (const bf16_t*)(wb + W_O); gm.N = DM; gm.K = DM; ep.mode = 4; ep.p0 = (unsigned char*)h; ep.p1 = (unsigned char*)hb; ep.p2 = (unsigned char*)ssq; }
    else if (ph == 7) { gm.A = hb; gm.lda = DM; gm.Bt = (const bf16_t*)(wb + W_GU); gm.N = 2 * FFH; gm.K = DM; ep.mode = 5; ep.p0 = (unsigned char*)act; ep.p1 = (unsigned char*)ssq; }
    else { gm.A = act; gm.lda = FFH; gm.Bt = (const bf16_t*)(wb + W_DN); gm.N = DM; gm.K = FFH; ep.mode = 4; ep.p0 = (unsigned char*)h; ep.p1 = (unsigned char*)hb; ep.p2 = (unsigned char*)ssq; }
    return true;
}

__device__ __forceinline__ void prologue(int G) {
    const int tid_ = opaque_tid(); const int lane = tid_ & 63, gw = blockIdx.x * 8 + __builtin_amdgcn_readfirstlane(tid_ >> 6), NGW = G * 8;
    const Ctx X = make_ctx(((unsigned char*)KA(ws)));
    for (int row = gw; row < RMAIN + 256; row += NGW) {
        const bool ismeta = row >= RMAIN; const int mr = row - RMAIN;
        const float* src = ismeta ? (mr < 160 ? KAF(meta_tokens) + (size_t)(mr & 15) * DM : nullptr) : (row < 32768 ? KAF(x_prompt) + (size_t)row * DM : KAF(x_sample) + (size_t)(row - 32768) * DM);
        float* hd = ismeta ? X.mh + (size_t)mr * DM : ((float*)KA(out)) + (size_t)row * DM;
        bf16_t* hbd = ismeta ? X.mhb + (size_t)mr * DM : X.hb + (size_t)row * DM;
        float* sq = ismeta ? X.mssq + (size_t)mr * 4 : X.ssq + (size_t)row * 4;
        float ss = 0.f;
#pragma unroll
        for (int j = 0; j < 4; ++j) {
            f32x4 v = (f32x4){0.f, 0.f, 0.f, 0.f}; if (src) v = *(const f32x4*)(src + j * 256 + lane * 4);
            *(f32x4*)(hd + j * 256 + lane * 4) = v;
            *(u32x2*)(hbd + j * 256 + lane * 4) = (u32x2){pk2(v[0], v[1]), pk2(v[2], v[3])};
            ss += (v[0] * v[0] + v[1] * v[1]) + (v[2] * v[2] + v[3] * v[3]);
        }
        ss = wave_sum(ss);
        if (lane < 4) sq[lane] = lane == 0 ? ss : 0.f;
    }
}

__device__ __forceinline__ void mixer_phase_A(int l, int g, LAS unsigned char* lds, int G, int bid) {
    const int tid_ = opaque_tid(); const int lane = tid_ & 63, wave = __builtin_amdgcn_readfirstlane(tid_ >> 6);
    const Ctx X = make_ctx(((unsigned char*)KA(ws))); const Grp gp = make_grp(g);
    const float* rpb = KAF(rpb) + (size_t)l * 8 * 15 * 31; const float* s5d = KAF(s5_d) + l * 256;
    const int nna = gp.nseq * (gp.Lr / 16), nmq = gp.nseq, nct = gp.nseq * (gp.nch - 1);
    const int ntask = nna + nmq + 2 * nct;
    const bool xmap = (nna % 256 == 0) && ((volatile LAS unsigned*)(lds + LDS_ST_OFF))[4] != 0u;
    if (xmap) {
        const int xcc = (int)((volatile LAS unsigned*)(lds + LDS_ST_OFF))[2], xrk = (int)((volatile LAS unsigned*)(lds + LDS_ST_OFF))[3];
        const int per = gp.Lr / 16, nx = nna / 8, rounds = nna / 256;
        for (int i = 0; i < rounds; ++i) { const int t = xcc * nx + xrk + 32 * i; na_task(X, rpb, gp, t / per, t % per, false, wave, lane, lds + wave * 9216); }
    }
    for (int t = bid + (xmap ? nna : 0); t < ntask; t += G) {
        __syncthreads();
        if (t < nna) { const int per = gp.Lr / 16; na_task(X, rpb, gp, t / per, t % per, false, wave, lane, lds + wave * 9216); }
        else if (t < nna + nmq) { na_task(X, rpb, gp, t - nna, 0, true, wave, lane, lds + wave * 9216); }
        else {
            const int u = t - nna - nmq; const bool isS5 = u < nct; const int v = isS5 ? u : u - nct;
            const int sl = v / (gp.nch - 1), c1 = v % (gp.nch - 1) + 1;
            for (int c = (c1 == 1 ? 0 : c1); c <= c1; ++c) {
                __syncthreads();
                const int ci = sl * gp.nch + c; const int T = c == 0 ? 16 : 64;
                bf16_t* zc = c == 0 ? X.mz + (size_t)((gp.s0 + sl) * 16) * ZW : X.z + ((size_t)sl * gp.Lr + 64 * (c - 1)) * ZW;
                if (isS5) s5_chunk<false>(X, s5d, (LAS float*)(lds + wave * 16896), zc, T, ci, wave, lane);
                else hg_chunk<false>(X, (LAS float*)(lds + wave * 8192), (LAS bf16_t*)(lds + 65536 + wave * 8192), zc, T, ci, wave, lane);
            }
        }
    }
}

__device__ __forceinline__ void mixer_phase_C(int l, int g, LAS unsigned char* lds, int G, int bid) {
    const int tid_ = opaque_tid(); const int lane = tid_ & 63, wave = __builtin_amdgcn_readfirstlane(tid_ >> 6);
    const Ctx X = make_ctx(((unsigned char*)KA(ws))); const Grp gp = make_grp(g);
    const float* s5d = KAF(s5_d) + l * 256; const float* ong = KAF(onorm_g) + l * 64;
    const int nct = gp.nseq * (gp.nch - 1);
    for (int t = bid; t < 2 * nct; t += G) {
        const bool isS5 = t < nct; const int v = isS5 ? t : t - nct;
        const int sl = v / (gp.nch - 1), c1 = v % (gp.nch - 1) + 1;
        for (int c = (c1 == 1 ? 0 : c1); c <= c1; ++c) {
            __syncthreads();
            const int ci = sl * gp.nch + c; const int T = c == 0 ? 16 : 64;
            bf16_t* zc = c == 0 ? X.mz + (size_t)((gp.s0 + sl) * 16) * ZW : X.z + ((size_t)sl * gp.Lr + 64 * (c - 1)) * ZW;
            if (isS5) s5_chunk<true>(X, s5d, (LAS float*)(lds + wave * 16896), zc, T, ci, wave, lane);
            else {
                hg_chunk<true>(X, (LAS float*)(lds + wave * 8192), (LAS bf16_t*)(lds + 65536 + wave * 8192), zc, T, ci, wave, lane);
                __syncthreads();
                const int h = wave >> 1, half = wave & 1;
                const LAS bf16_t* of = (const LAS bf16_t*)(lds + 65536 + (2 * h) * 8192); const LAS bf16_t* ob = (const LAS bf16_t*)(lds + 65536 + (2 * h + 1) * 8192);
                const float gn = ong[lane];
                for (int tt = half * (T / 2); tt < (half + 1) * (T / 2); ++tt) {
                    const float o = bf2f(of[tt * 64 + lane]) + bf2f(ob[tt * 64 + lane]);
                    const float ms = wave_sum(o * o) * (1.0f / 64.0f);
                    bf16_t* zr = zc + (size_t)tt * ZW;
                    const float go = bf2f(zr[2816 + h * 64 + lane]);
                    zr[256 + h * 64 + lane] = (bf16_t)f2bf(o * rsqrtf(ms + 1e-6f) * gn * (go * sigm(go)));
                }
            }
        }
    }
}

__global__ void __launch_bounds__(512, 2) fwd_kernel(Args a) {
    extern __shared__ __attribute__((aligned(16))) unsigned char lds_raw[];
    LAS unsigned char* lds = (LAS unsigned char*)lds_raw;
    const int G = gridDim.x, bid = blockIdx.x;

    if (threadIdx.x < 2) ((volatile LAS unsigned*)(lds + LDS_ST_OFF))[threadIdx.x] = 0u;
    if (threadIdx.x == 0) { const unsigned xc = xb_xcc_id(); const unsigned rk = xb_add((unsigned*)(KA(ws) + WS_CTL) + XB_XCNT(xc), 1u);
        ((volatile LAS unsigned*)(lds + LDS_ST_OFF))[2] = xc; ((volatile LAS unsigned*)(lds + LDS_ST_OFF))[3] = rk; }
    __syncthreads();
    prologue(G);

    for (int l = 0; l < NLAYER; ++l) {
        __syncthreads();
        { const Ctx X = make_ctx(((unsigned char*)KA(ws))); prep_layer(X, l, lds, G); }
        if (l == 0) { asm volatile("s_waitcnt vmcnt(0)" ::: "memory"); __syncthreads(); cg::this_grid().sync(); }
        GRID_SYNC();
        if (l == 0) {
            if (threadIdx.x == 0) { unsigned* bar = (unsigned*)(KA(ws) + WS_CTL); bool ok = (G == 256);
                for (int j = 0; j < 16; ++j) { const unsigned c = xb_ld(&bar[XB_XCNT(j)]); ok = ok && (c == (j < 8 ? 32u : 0u)); }
                ((volatile LAS unsigned*)(lds + LDS_ST_OFF))[4] = ok ? 1u : 0u; }
            __syncthreads();
        }
        for (int g = 0; g < 4; ++g) {
            for (int ph = 0; ph < 9; ++ph) {
                if (ph == 1) mixer_phase_A(l, g, lds, G, bid);
                else if (ph == 2) { const Ctx X = make_ctx(((unsigned char*)KA(ws))); const Grp gp = make_grp(g); const int gtid = bid * 512 + opaque_tid(), GT = G * 512; s5_passB(X, gp, gtid, GT); hg_passB(X, gp, GT - 1 - gtid, GT); }
                else if (ph == 3) mixer_phase_C(l, g, lds, G, bid);
                else {
                    for (int j = 0; j < 6; ++j) {
                        pg8::Gemm gm; pg8::UberEpi ep;
                        if (!make_job(((unsigned char*)KA(ws)), ((float*)KA(out)), l, g, ph, j, gm, ep)) break;
                        pg8::StaticOrder SO; SO.init(gm.M, gm.N, G, bid);
                        pg8::gemm_phase(lds, gm, SO, ep);
                    }
                }
                GRID_SYNC();
            }
        }
    }
    {
        const float* ssq = (const float*)(((unsigned char*)KA(ws)) + WS_SSQ);
        const int tid_ = opaque_tid(); const int lane = tid_ & 63, wave = __builtin_amdgcn_readfirstlane(tid_ >> 6);
        for (int row = bid * 8 + wave; row < RMAIN; row += G * 8) {
            const float rs = pg8::row_rstd(ssq, row);
            float* hp = ((float*)KA(out)) + (size_t)row * DM;
#pragma unroll
            for (int j = 0; j < 4; ++j) {
                f32x4 v = *(const f32x4*)(hp + j * 256 + lane * 4); const f32x4 gv = *(const f32x4*)(KAF(final_g) + j * 256 + lane * 4);
                v = v * rs * gv; *(f32x4*)(hp + j * 256 + lane * 4) = v;
            }
        }
    }
}

extern "C" void kernel_launch(void* const* d_in, const int* in_sizes, int n_in, void* d_out, int out_size, void* d_ws, size_t ws_size, hipStream_t stream) {
    static int grid = 0;
    if (grid == 0) {
        int dev = 0, cus = 0, per_cu = 0;
        (void)hipGetDevice(&dev);
        (void)hipDeviceGetAttribute(&cus, hipDeviceAttributeMultiprocessorCount, dev);
        (void)hipFuncSetAttribute((const void*)fwd_kernel, hipFuncAttributeMaxDynamicSharedMemorySize, LDS_BYTES);
        (void)hipOccupancyMaxActiveBlocksPerMultiprocessor(&per_cu, (const void*)fwd_kernel, 512, LDS_BYTES);
        (void)hipGetLastError();
        if (ws_size < WS_TOTAL) fprintf(stderr, "kernel_launch: workspace too small: %zu < %zu\n", ws_size, (size_t)WS_TOTAL);
        grid = cus > 0 ? cus : 256;
    }
    (void)hipMemsetAsync((char*)d_ws + WS_CTL, 0, CTL_BYTES, stream);
    Args a{};
    const float** pp = (const float**)&a;
    for (int i = 0; i < 26; ++i) pp[i] = (const float*)d_in[i];
    a.out = (float*)d_out; a.ws = (unsigned char*)d_ws;
    void* args[] = {&a};
    hipError_t e = hipLaunchCooperativeKernel((const void*)fwd_kernel, dim3(grid), dim3(512), args, LDS_BYTES, stream);
    if (e != hipSuccess) fprintf(stderr, "cooperative launch failed: %s\n", hipGetErrorString(e));
}
```

```cpp
#include <hip/hip_runtime.h>
#include <hip/hip_cooperative_groups.h>
#include <cstdio>
#include <cstdint>
namespace cg = cooperative_groups;

#define LAS __attribute__((address_space(3)))
typedef unsigned short bf16_t;
typedef short bf16x8 __attribute__((ext_vector_type(8)));
typedef float f32x4 __attribute__((ext_vector_type(4)));
typedef unsigned u32x4 __attribute__((ext_vector_type(4)));
typedef unsigned u32x2 __attribute__((ext_vector_type(2)));

#define WAVE_SYNC() asm volatile("s_waitcnt lgkmcnt(0)" ::: "memory")
__device__ __forceinline__ int opaque_tid() { int t = threadIdx.x; asm volatile("" : "+v"(t)); return t; }

__device__ __forceinline__ unsigned f2bf(float f) { unsigned u = __builtin_bit_cast(unsigned, f); return (u + 0x7fffu + ((u >> 16) & 1u)) >> 16; }
__device__ __forceinline__ unsigned pk2(float lo, float hi) { return f2bf(lo) | (f2bf(hi) << 16); }
__device__ __forceinline__ float bf2f(bf16_t b) { return __builtin_bit_cast(float, (unsigned)b << 16); }
__device__ __forceinline__ float bflo(unsigned w) { return __builtin_bit_cast(float, w << 16); }
__device__ __forceinline__ float bfhi(unsigned w) { return __builtin_bit_cast(float, w & 0xffff0000u); }
__device__ __forceinline__ float sigm(float x) { return 1.f / (1.f + __expf(-x)); }
__device__ __forceinline__ float gelu_tanh(float y) { const float a = 0.7978845608028654f * (y + 0.044715f * y * y * y); const float th = 1.f - 2.f / (__expf(2.f * a) + 1.f); return 0.5f * y * (1.f + th); }
__device__ __forceinline__ u32x4 pack8(f32x4 a, f32x4 b) { u32x4 w; w.x = pk2(a[0], a[1]); w.y = pk2(a[2], a[3]); w.z = pk2(b[0], b[1]); w.w = pk2(b[2], b[3]); return w; }
__device__ __forceinline__ float wave_sum(float v) {
#pragma unroll
    for (int o = 1; o < 64; o <<= 1) v += __shfl_xor(v, o);
    return v;
}

namespace pg8 {
constexpr int ZSTR = 6208;
constexpr int BM = 256, BK = 64, HALF = 128, HTB = HALF * BK * 2, STAGE_BYTES = 8 * HTB, NXCD = 8, WGM = 8;
__host__ __device__ __forceinline__ int lds_byte(int r, int c) { const int st = (r >> 4) * 2 + (c >> 5), rr = r & 15, cc = c & 31, ob = rr * 64 + cc * 2; return st * 1024 + (ob ^ (((ob >> 9) & 1) << 5)); }
__host__ __device__ __forceinline__ void stage_rc(int b, int& R, int& C) { const int st = b / 1024, sb = b % 1024, swz = sb ^ (((sb >> 9) & 1) << 5); R = (st >> 1) * 16 + swz / 64; C = (st & 1) * 32 + (swz % 64) / 2; }
__host__ __device__ __forceinline__ int perm32(int rho) { const int n = rho >> 4, i = rho & 15; return 8 * (i >> 2) + 4 * n + (i & 3); }
struct Unit { int pm, pn; };
struct Gemm { const bf16_t* A; int lda; const bf16_t* Bt; int M, N, K; };
struct StaticOrder {
    int nM, nN, nwg, G, c;
    __device__ void init(int M, int N, int G_, int c_) { nM = M / BM; nN = N / BM; nwg = nM * nN; G = G_; c = c_; }
    __device__ bool next(int i, Unit& u) const {
        const long L = (long)i * G + c; if (L >= nwg) return false;
        int wgid = (int)L; { const int q = nwg / NXCD, r = nwg % NXCD, xcd = wgid % NXCD, off = wgid / NXCD; wgid = (xcd < r ? xcd * (q + 1) : r * (q + 1) + (xcd - r) * q) + off; }
        const int nig = WGM * nN, gid = wgid / nig, fm = gid * WGM, gsz = (nM - fm) < WGM ? (nM - fm) : WGM;
        u.pm = fm + ((wgid % nig) % gsz); u.pn = (wgid % nig) / gsz; return true;
    }
};

struct UberEpi;
__device__ __forceinline__ void run_epi(const UberEpi& E, LAS unsigned char* lds, const f32x4 (&acc)[2][2][4][2], const Unit& u, int wr, int wc, int fr, int fq);
__device__ __forceinline__ void gemm_phase(LAS unsigned char* lds, const Gemm g, const StaticOrder& S, const UberEpi& E) {
    const int tid = opaque_tid(), wid = __builtin_amdgcn_readfirstlane(tid >> 6), lane = tid & 63, wr = wid >> 2, wc = wid & 3, fr = lane & 15, fq = lane >> 4;
    const int K = g.K, nt = K / BK, lda = g.lda;
    unsigned voffA[2], voffB[2];
#pragma unroll
    for (int i = 0; i < 2; ++i) { int R, C; stage_rc(tid * 16 + i * 8192, R, C); const int Rb = (R & ~31) + perm32(R & 31);
        voffA[i] = (unsigned)(R * lda + C) * 2u; voffB[i] = (unsigned)(Rb * K + C) * 2u; }
    const size_t kstep = (size_t)(BK * 2);
    const size_t hstepA = (size_t)HALF * lda * 2, hstepB = (size_t)HALF * K * 2;
    const size_t tstepA = 2 * hstepA, tstepB = 2 * hstepB;
    const unsigned ldsw = (unsigned)wid * 1024u;
    const int aoff = lds_byte(wr * 64 + fr, fq * 8), boff = lds_byte(wc * 32 + fr, fq * 8);
#define PG8_SA(b, h) (((b) * 2 + (h)) * HTB)
#define PG8_SB(b, h) ((4 + (b) * 2 + (h)) * HTB)
#define PG8_STAGE(bufoff, gbase, voff) do { _Pragma("unroll") for (int _i = 0; _i < 2; ++_i) \
        __builtin_amdgcn_global_load_lds((const unsigned*)((const char*)(gbase) + (voff)[_i]), (LAS unsigned*)(lds + (bufoff) + ldsw + _i * 8192), 16, 0, 0); } while (0)
#define PG8_LDA(dst, b, h) do { _Pragma("unroll") for (int m = 0; m < 4; ++m) _Pragma("unroll") for (int k = 0; k < 2; ++k) dst[m][k] = *(const LAS bf16x8*)(lds + PG8_SA(b, h) + aoff + m * 2048 + k * 1024); } while (0)
#define PG8_LDB(dst, b, h) do { _Pragma("unroll") for (int n = 0; n < 2; ++n) _Pragma("unroll") for (int k = 0; k < 2; ++k) dst[n][k] = *(const LAS bf16x8*)(lds + PG8_SB(b, h) + boff + n * 2048 + k * 1024); } while (0)
#define PG8_MMA(ai, bj, At, Bt) do { __builtin_amdgcn_s_setprio(1); _Pragma("unroll") for (int m = 0; m < 4; ++m) _Pragma("unroll") for (int n = 0; n < 2; ++n) _Pragma("unroll") for (int k = 0; k < 2; ++k) \
        acc[ai][bj][m][n] = __builtin_amdgcn_mfma_f32_16x16x32_bf16(Bt[n][k], At[m][k], acc[ai][bj][m][n], 0, 0, 0); __builtin_amdgcn_s_setprio(0); } while (0)
#define PG8_WAIT_V(n) asm volatile("s_waitcnt vmcnt(" #n ")" ::: "memory")
#define PG8_WAIT_L(n) asm volatile("s_waitcnt lgkmcnt(" #n ")" ::: "memory")
#define PG8_BAR __builtin_amdgcn_s_barrier()
#define PG8_SCHED __builtin_amdgcn_sched_barrier(0)
    Unit cur, nxt; int ui = 0;
    if (!S.next(0, cur)) return;
    f32x4 acc[2][2][4][2];
#pragma unroll
    for (int a = 0; a < 2; ++a)
#pragma unroll
        for (int b = 0; b < 2; ++b)
#pragma unroll
            for (int m = 0; m < 4; ++m)
#pragma unroll
                for (int n = 0; n < 2; ++n) acc[a][b][m][n] = (f32x4){0.f, 0.f, 0.f, 0.f};
    bf16x8 At[4][2], B0[2][2], B1[2][2];
    const char* cA = (const char*)g.A + (size_t)cur.pm * tstepA; const char* cB = (const char*)g.Bt + (size_t)cur.pn * tstepB;
    PG8_STAGE(PG8_SB(0, 0), cB, voffB); PG8_STAGE(PG8_SB(0, 1), cB + hstepB, voffB); PG8_STAGE(PG8_SA(0, 0), cA, voffA); PG8_STAGE(PG8_SA(0, 1), cA + hstepA, voffA);
    if (wr == 1) PG8_BAR;
    PG8_WAIT_V(2); PG8_BAR;
    PG8_STAGE(PG8_SB(1, 0), cB + kstep, voffB); PG8_STAGE(PG8_SA(1, 0), cA + kstep, voffA); PG8_STAGE(PG8_SB(1, 1), cB + hstepB + kstep, voffB);
    PG8_WAIT_V(6); PG8_BAR;
    for (;;) {
        const bool has_next = S.next(ui + 1, nxt);
        const char* nA = has_next ? (const char*)g.A + (size_t)nxt.pm * tstepA : cA; const char* nB = has_next ? (const char*)g.Bt + (size_t)nxt.pn * tstepB : cB;
        for (int t = 0; t < nt; t += 2) {
            const bool last = (t == nt - 2);
            const char* a1 = cA + (size_t)(t + 1) * kstep;
            const char* a2 = last ? nA : cA + (size_t)(t + 2) * kstep; const char* b2 = last ? nB : cB + (size_t)(t + 2) * kstep;
            const char* a3 = a2 + kstep; const char* b3 = b2 + kstep;
            PG8_LDB(B0, 0, 0); PG8_LDB(B1, 0, 1); PG8_SCHED; PG8_LDA(At, 0, 0); PG8_STAGE(PG8_SA(1, 1), a1 + hstepA, voffA);
            PG8_WAIT_V(8); PG8_WAIT_L(0); PG8_BAR; PG8_MMA(0, 0, At, B0); PG8_MMA(0, 1, At, B1); PG8_BAR; PG8_SCHED;
            PG8_LDA(At, 0, 1); PG8_STAGE(PG8_SB(0, 0), b2, voffB); PG8_STAGE(PG8_SB(0, 1), b2 + hstepB, voffB); PG8_STAGE(PG8_SA(0, 0), a2, voffA);
            PG8_WAIT_V(8); PG8_WAIT_L(0); PG8_BAR; PG8_MMA(1, 0, At, B0); PG8_MMA(1, 1, At, B1); PG8_BAR; PG8_SCHED;
            PG8_LDB(B0, 1, 0); PG8_LDB(B1, 1, 1); PG8_SCHED; PG8_LDA(At, 1, 0); PG8_STAGE(PG8_SA(0, 1), a2 + hstepA, voffA);
            PG8_WAIT_V(8); PG8_WAIT_L(0); PG8_BAR; PG8_MMA(0, 0, At, B0); PG8_MMA(0, 1, At, B1); PG8_BAR; PG8_SCHED;
            PG8_LDA(At, 1, 1); PG8_STAGE(PG8_SB(1, 0), b3, voffB); PG8_STAGE(PG8_SB(1, 1), b3 + hstepB, voffB); PG8_STAGE(PG8_SA(1, 0), a3, voffA);
            PG8_WAIT_V(8); PG8_WAIT_L(0); PG8_BAR; PG8_MMA(1, 0, At, B0); PG8_MMA(1, 1, At, B1); PG8_BAR; PG8_SCHED;
        }
        if (wr == 0) PG8_BAR;
        run_epi(E, lds, acc, cur, wr, wc, fr, fq);
        if (!has_next) break;
#pragma unroll
        for (int a = 0; a < 2; ++a)
#pragma unroll
            for (int b = 0; b < 2; ++b)
#pragma unroll
                for (int m = 0; m < 4; ++m)
#pragma unroll
                    for (int n = 0; n < 2; ++n) acc[a][b][m][n] = (f32x4){0.f, 0.f, 0.f, 0.f};
        cur = nxt; cA = nA; cB = nB; ++ui;
        if (wr == 1) PG8_BAR;
    }
    PG8_WAIT_V(0);
    PG8_BAR;
#undef PG8_SA
#undef PG8_SB
#undef PG8_STAGE
#undef PG8_LDA
#undef PG8_LDB
#undef PG8_MMA
#undef PG8_WAIT_V
#undef PG8_WAIT_L
#undef PG8_BAR
#undef PG8_SCHED
}

__device__ __forceinline__ float row_rstd(const float* ssq, int row) {
    const f32x4 s0 = *(const f32x4*)(ssq + (size_t)row * 4);
    const float ss = (s0[0] + s0[1]) + (s0[2] + s0[3]);
    return rsqrtf(ss * (1.0f / 1024.0f) + 1e-6f);
}
struct EpiZ {
    bf16_t* z; const float* ssq; bf16_t* vt; int vt_ld;
    __device__ __forceinline__ void operator()(const f32x4 (&acc)[2][2][4][2], const Unit& u, int wr, int wc, int fr, int fq) const {
        const int row0 = u.pm * BM + wr * 64 + fr, col0 = u.pn * BM + wc * 32 + 8 * fq;
#pragma unroll
        for (int ai = 0; ai < 2; ++ai)
#pragma unroll
            for (int m = 0; m < 4; ++m) {
                const int row = row0 + ai * HALF + m * 16; const float rs = row_rstd(ssq, row);
#pragma unroll
                for (int bj = 0; bj < 2; ++bj) {
                    const u32x4 w = pack8(acc[ai][bj][m][0] * rs, acc[ai][bj][m][1] * rs);
                    *(u32x4*)(z + (size_t)row * ZSTR + col0 + bj * HALF) = w;
                }
            }
    }
};
struct EpiGlu {
    bf16_t* z;
    __device__ __forceinline__ void operator()(const f32x4 (&acc)[2][2][4][2], const Unit& u, int wr, int wc, int fr, int fq) const {
        const int row0 = u.pm * BM + wr * 64 + fr, col0 = wc * 32 + 8 * fq;
#pragma unroll
        for (int ai = 0; ai < 2; ++ai)
#pragma unroll
            for (int m = 0; m < 4; ++m) {
                const int row = row0 + ai * HALF + m * 16;
#pragma unroll
                for (int bj = 0; bj < 2; ++bj) {
                    bf16_t* zp = z + (size_t)row * ZSTR + col0 + bj * HALF;
                    const u32x4 y = *(const u32x4*)(zp + 512);
                    const f32x4 a0 = acc[ai][bj][m][0], a1 = acc[ai][bj][m][1];
                    f32x4 o0, o1;
                    o0[0] = bflo(y.x) * sigm(a0[0]); o0[1] = bfhi(y.x) * sigm(a0[1]); o0[2] = bflo(y.y) * sigm(a0[2]); o0[3] = bfhi(y.y) * sigm(a0[3]);
                    o1[0] = bflo(y.z) * sigm(a1[0]); o1[1] = bfhi(y.z) * sigm(a1[1]); o1[2] = bflo(y.w) * sigm(a1[2]); o1[3] = bfhi(y.w) * sigm(a1[3]);
                    *(u32x4*)zp = pack8(o0, o1);
                }
            }
    }
};
template <int MODE> struct EpiMix {
    bf16_t* z; int goff;
    __device__ __forceinline__ void operator()(const f32x4 (&acc)[2][2][4][2], const Unit& u, int wr, int wc, int fr, int fq) const {
        const int row0 = u.pm * BM + wr * 64 + fr, col0 = u.pn * BM + wc * 32 + 8 * fq;
#pragma unroll
        for (int ai = 0; ai < 2; ++ai)
#pragma unroll
            for (int m = 0; m < 4; ++m) {
                const int row = row0 + ai * HALF + m * 16;
#pragma unroll
                for (int bj = 0; bj < 2; ++bj) {
                    bf16_t* zr = z + (size_t)row * ZSTR + col0 + bj * HALF;
                    const u32x4 gq = *(const u32x4*)(zr + goff);
                    const f32x4 a0 = acc[ai][bj][m][0], a1 = acc[ai][bj][m][1];
                    f32x4 o0, o1;
                    o0[0] = sigm(bflo(gq.x)) * a0[0]; o0[1] = sigm(bfhi(gq.x)) * a0[1]; o0[2] = sigm(bflo(gq.y)) * a0[2]; o0[3] = sigm(bfhi(gq.y)) * a0[3];
                    o1[0] = sigm(bflo(gq.z)) * a1[0]; o1[1] = sigm(bfhi(gq.z)) * a1[1]; o1[2] = sigm(bflo(gq.w)) * a1[2]; o1[3] = sigm(bfhi(gq.w)) * a1[3];
                    if (MODE == 1) { const u32x4 p = *(const u32x4*)(zr + 1024);
                        o0[0] += bflo(p.x); o0[1] += bfhi(p.x); o0[2] += bflo(p.y); o0[3] += bfhi(p.y); o1[0] += bflo(p.z); o1[1] += bfhi(p.z); o1[2] += bflo(p.w); o1[3] += bfhi(p.w); }
                    *(u32x4*)(zr + 1024) = pack8(o0, o1);
                }
            }
    }
};
struct EpiRes {
    float* h; bf16_t* hb; float* ssq; LAS float* red;
    __device__ __forceinline__ void operator()(const f32x4 (&acc)[2][2][4][2], const Unit& u, int wr, int wc, int fr, int fq) const {
        const int row0 = u.pm * BM + wr * 64 + fr, col0 = u.pn * BM + wc * 32 + 8 * fq;
#pragma unroll
        for (int ai = 0; ai < 2; ++ai)
#pragma unroll
            for (int m = 0; m < 4; ++m) {
                const int row = row0 + ai * HALF + m * 16; float part = 0.f;
#pragma unroll
                for (int bj = 0; bj < 2; ++bj) {
                    float* hp = h + (size_t)row * 1024 + col0 + bj * HALF;
                    f32x4 h0 = *(const f32x4*)hp, h1 = *(const f32x4*)(hp + 4);
                    h0 = h0 + acc[ai][bj][m][0]; h1 = h1 + acc[ai][bj][m][1];
                    *(f32x4*)hp = h0; *(f32x4*)(hp + 4) = h1;
                    part += (h0[0] * h0[0] + h0[1] * h0[1]) + (h0[2] * h0[2] + h0[3] * h0[3]) + (h1[0] * h1[0] + h1[1] * h1[1]) + (h1[2] * h1[2] + h1[3] * h1[3]);
                    *(u32x4*)(hb + (size_t)row * 1024 + col0 + bj * HALF) = pack8(h0, h1);
                }
                part += __shfl_xor(part, 16); part += __shfl_xor(part, 32);
                if (fq == 0) red[(ai * HALF + wr * 64 + m * 16 + fr) * 4 + wc] = part;
            }
        asm volatile("s_waitcnt lgkmcnt(0)" ::: "memory");
        __builtin_amdgcn_s_barrier();
        asm volatile("" ::: "memory");
        { const int t_ = opaque_tid(); if (t_ < 256) { const f32x4 r4 = *(const LAS f32x4*)(red + t_ * 4); ssq[(size_t)(u.pm * BM + t_) * 4 + u.pn] = (r4[0] + r4[1]) + (r4[2] + r4[3]); } }
    }
};
struct EpiAct {
    bf16_t* act; const float* ssq;
    __device__ __forceinline__ void operator()(const f32x4 (&acc)[2][2][4][2], const Unit& u, int wr, int wc, int fr, int fq) const {
        const int row0 = u.pm * BM + wr * 64 + fr, col0 = u.pn * HALF + wc * 32 + 8 * fq;
#pragma unroll
        for (int ai = 0; ai < 2; ++ai)
#pragma unroll
            for (int m = 0; m < 4; ++m) {
                const int row = row0 + ai * HALF + m * 16; const float rs = row_rstd(ssq, row);
                f32x4 o[2];
#pragma unroll
                for (int n = 0; n < 2; ++n)
#pragma unroll
                    for (int i = 0; i < 4; ++i) { const float gg = acc[ai][0][m][n][i] * rs, uu = acc[ai][1][m][n][i] * rs; o[n][i] = gg * sigm(gg) * uu; }
                *(u32x4*)(act + (size_t)row * 2816 + col0) = pack8(o[0], o[1]);
            }
    }
};
struct UberEpi { int mode, i0; unsigned char *p0, *p1, *p2; };
__device__ __forceinline__ void run_epi(const UberEpi& E, LAS unsigned char* lds, const f32x4 (&acc)[2][2][4][2], const Unit& u, int wr, int wc, int fr, int fq) {
    switch (E.mode) {
        case 0: { EpiZ e{(bf16_t*)E.p0, (const float*)E.p1, (bf16_t*)E.p2, E.i0}; e(acc, u, wr, wc, fr, fq); break; }
        case 1: { EpiGlu e{(bf16_t*)E.p0}; e(acc, u, wr, wc, fr, fq); break; }
        case 2: { EpiMix<0> e{(bf16_t*)E.p0, E.i0}; e(acc, u, wr, wc, fr, fq); break; }
        case 3: { EpiMix<1> e{(bf16_t*)E.p0, E.i0}; e(acc, u, wr, wc, fr, fq); break; }
        case 4: { EpiRes e{(float*)E.p0, (bf16_t*)E.p1, (float*)E.p2, (LAS float*)(lds + 131072)}; e(acc, u, wr, wc, fr, fq); break; }
        default: { EpiAct e{(bf16_t*)E.p0, (const float*)E.p1}; e(acc, u, wr, wc, fr, fq); break; }
    }
}
}

constexpr int NLAYER = 4, DM = 1024, ZN = 6144, ZW = 6208  , FFH = 2816, RG = 16384, RMAIN = 65536, VTLD = RG + 64  ;
constexpr size_t al256(size_t x) { return (x + 255) & ~(size_t)255; }
constexpr size_t WS_HB = 0;
constexpr size_t WS_SSQ = WS_HB + (size_t)RMAIN * DM * 2;
constexpr size_t WS_Z = WS_SSQ + (size_t)RMAIN * 4 * 4;
constexpr size_t WS_YB = WS_Z + (size_t)RG * ZW * 2;
constexpr size_t WS_VT = WS_YB + (size_t)RG * 512 * 2;
constexpr size_t WS_HGU = WS_VT + (size_t)512 * VTLD * 2;
constexpr size_t WS_HGP = WS_HGU + (size_t)260 * 8 * 4096 * 4;
constexpr size_t WS_S5S = WS_HGP + (size_t)260 * 8 * 64 * 4;
constexpr size_t WS_W = WS_S5S + (size_t)260 * 2048 * 8;
constexpr size_t W_IN = 0, W_UPA = W_IN + (size_t)6144 * 1024 * 2, W_UPB = W_UPA + (size_t)1024 * 256 * 2, W_UPC = W_UPB + (size_t)1024 * 512 * 2,
                 W_O = W_UPC + (size_t)1024 * 256 * 2, W_GU = W_O + (size_t)1024 * 1024 * 2, W_DN = W_GU + (size_t)5632 * 1024 * 2, W_GLU = W_DN + (size_t)1024 * 2816 * 2,
                 W_END = W_GLU + (size_t)256 * 256 * 2;
constexpr size_t WS_TAB = WS_W + W_END;
constexpr size_t T_LBAR = 0, T_L16 = T_LBAR + 2048 * 8, T_L64 = T_L16 + 2048 * 8, T_BFRAG = T_L64 + 2048 * 8, T_CFRAG = T_BFRAG + (size_t)32 * 8 * 64 * 16,
                 T_LB = T_CFRAG + (size_t)32 * 4 * 64 * 16, T_END = T_LB + 256 * 4;
constexpr size_t WS_META = al256(WS_TAB + T_END);
constexpr size_t M_H = 0, M_HB = M_H + (size_t)256 * 1024 * 4, M_SSQ = M_HB + (size_t)256 * 1024 * 2, M_Z = M_SSQ + (size_t)256 * 4 * 4, M_YB = M_Z + (size_t)256 * ZW * 2,
                 M_VT = M_YB + (size_t)256 * 512 * 2, M_ACT = M_VT + (size_t)512 * 256 * 2, M_END = M_ACT + (size_t)256 * FFH * 2;
constexpr size_t WS_CTL = al256(WS_META + M_END);
constexpr size_t CTL_BYTES = 16384;
constexpr size_t WS_TOTAL = WS_CTL + CTL_BYTES;
constexpr int LDS_ST_OFF = 135168;
constexpr int LDS_BYTES = 147456;

struct Args {
    const float *x_prompt, *x_sample, *meta_tokens, *norm1_g, *w_in, *a_re, *a_im, *log_dt, *b_re, *b_im, *c_re, *c_im, *s5_d, *w_glu, *rpb, *lb_logits, *onorm_g,
        *w_up_a, *w_up_b, *w_up_c, *w_o, *norm2_g, *w_gate, *w_up, *w_down, *final_g;
    float* out; unsigned char* ws;
};

__device__ __forceinline__ unsigned long long ufl(unsigned long long v) { const unsigned lo = __builtin_amdgcn_readfirstlane((unsigned)v), hi = __builtin_amdgcn_readfirstlane((unsigned)(v >> 32)); return ((unsigned long long)hi << 32) | lo; }
#define GAS __attribute__((address_space(1)))
#define KA(f) ((decltype(Args::f))(GAS char*)ufl((unsigned long long)(((const volatile Args*)__builtin_amdgcn_kernarg_segment_ptr())->f)))
#define KAF(f) ((const float*)KA(f))
struct Ctx {
    bf16_t *hb, *z, *yb, *vt; float *ssq, *hgu, *hgp, *s5s;
    bf16_t *w; const float *lbar, *l16, *l64; const bf16_t *bfrag, *cfrag; const float* lb;
    float* mh; bf16_t *mhb, *mz, *myb, *mvt, *mact; float* mssq;
};

__device__ __forceinline__ void tr_item(const float* W, int K, int N, bf16_t* WT, const float* kscale, int mode, LAS float* scr, int item, int lane, bool valid) {
    const int nblk = N / 32, kb = item / nblk, nb = item % nblk, k0 = 64 * kb, n0 = 32 * nb;
    if (valid) {
#pragma unroll 8
    for (int i = 0; i < 32; ++i) { const int kk = 2 * i + (lane >> 5); float v = W[(size_t)(k0 + kk) * N + n0 + (lane & 31)]; if (kscale) v *= kscale[k0 + kk]; scr[kk * 33 + (lane & 31)] = v; }
    }
    __syncthreads();
    const int c = lane & 7;
    int drow0 = n0; if (mode) drow0 = (n0 >> 7) * 256 + (n0 & 127) + (mode == 2 ? 128 : 0);
    if (valid) {
#pragma unroll
    for (int j = 0; j < 4; ++j) { const int n = (lane >> 3) + 8 * j; const LAS float* s = scr + (8 * c) * 33 + n;
        u32x4 o; o.x = pk2(s[0 * 33], s[1 * 33]); o.y = pk2(s[2 * 33], s[3 * 33]); o.z = pk2(s[4 * 33], s[5 * 33]); o.w = pk2(s[6 * 33], s[7 * 33]);
        *(u32x4*)(WT + (size_t)(drow0 + n) * K + k0 + 8 * c) = o; }
    }
    __syncthreads();
}

__device__ __forceinline__ void prep_layer(const Ctx& X, int l, LAS unsigned char* lds, int G) {
    const int tid_ = opaque_tid(); const int wave = __builtin_amdgcn_readfirstlane(tid_ >> 6), lane = tid_ & 63;
    LAS float* scr = (LAS float*)(lds + wave * 16384);
    const int gw = blockIdx.x * 8 + wave, NGW = G * 8;
    constexpr int I0 = 16 * 192, I1 = 4 * 32, I2 = 8 * 32, I3 = 4 * 32, I4 = 16 * 32, I5 = 16 * 88, I6 = 16 * 88, I7 = 44 * 32, I8 = 4 * 8;
    constexpr int NIT = I0 + I1 + I2 + I3 + I4 + I5 + I6 + I7 + I8;
    unsigned char* wb = (unsigned char*)X.w;
    for (int it0 = 0; it0 < NIT; it0 += NGW) {
        const int it = it0 + gw; const bool valid = it < NIT;
        int r = valid ? it : 0;
        if (r < I0) { tr_item(KAF(w_in) + (size_t)l * 1024 * 6144, 1024, 6144, (bf16_t*)(wb + W_IN), KAF(norm1_g) + l * 1024, 0, scr, r, lane, valid); continue; } r -= I0;
        if (r < I1) { tr_item(KAF(w_up_a) + (size_t)l * 256 * 1024, 256, 1024, (bf16_t*)(wb + W_UPA), nullptr, 0, scr, r, lane, valid); continue; } r -= I1;
        if (r < I2) { tr_item(KAF(w_up_b) + (size_t)l * 512 * 1024, 512, 1024, (bf16_t*)(wb + W_UPB), nullptr, 0, scr, r, lane, valid); continue; } r -= I2;
        if (r < I3) { tr_item(KAF(w_up_c) + (size_t)l * 256 * 1024, 256, 1024, (bf16_t*)(wb + W_UPC), nullptr, 0, scr, r, lane, valid); continue; } r -= I3;
        if (r < I4) { tr_item(KAF(w_o) + (size_t)l * 1024 * 1024, 1024, 1024, (bf16_t*)(wb + W_O), nullptr, 0, scr, r, lane, valid); continue; } r -= I4;
        if (r < I5) { tr_item(KAF(w_gate) + (size_t)l * 1024 * 2816, 1024, 2816, (bf16_t*)(wb + W_GU), KAF(norm2_g) + l * 1024, 1, scr, r, lane, valid); continue; } r -= I5;
        if (r < I6) { tr_item(KAF(w_up) + (size_t)l * 1024 * 2816, 1024, 2816, (bf16_t*)(wb + W_GU), KAF(norm2_g) + l * 1024, 2, scr, r, lane, valid); continue; } r -= I6;
        if (r < I7) { tr_item(KAF(w_down) + (size_t)l * 2816 * 1024, 2816, 1024, (bf16_t*)(wb + W_DN), nullptr, 0, scr, r, lane, valid); continue; } r -= I7;
        tr_item(KAF(w_glu) + (size_t)l * 256 * 256, 256, 256, (bf16_t*)(wb + W_GLU), nullptr, 0, scr, r, lane, valid);
    }
    const int gt = blockIdx.x * 512 + tid_;
    if (gt < 2048) {
        const int dg = gt >> 6, p = gt & 63;
        const size_t pb = ((size_t)l * 32 + dg);
        const float are = KAF(a_re)[pb * 64 + p], aim = KAF(a_im)[pb * 64 + p], dt = expf(KAF(log_dt)[pb]);
        const float mag = expf(are * dt); float sn, cs; sincosf(aim * dt, &sn, &cs);
        const float lr = mag * cs, li = mag * sn;
        const float den = are * are + aim * aim, nr = lr - 1.0f, ni = li;
        const float zr = (nr * are + ni * aim) / den, zi = (ni * are - nr * aim) / den;
        float* lbar = (float*)X.lbar; float* l16 = (float*)X.l16; float* l64 = (float*)X.l64;
        lbar[gt * 2] = lr; lbar[gt * 2 + 1] = li;
        float pr = lr, pi = li;
#pragma unroll
        for (int s = 0; s < 4; ++s) { const float t = pr * pr - pi * pi; pi = 2.f * pr * pi; pr = t; }
        l16[gt * 2] = pr; l16[gt * 2 + 1] = pi;
#pragma unroll
        for (int s = 0; s < 2; ++s) { const float t = pr * pr - pi * pi; pi = 2.f * pr * pi; pr = t; }
        l64[gt * 2] = pr; l64[gt * 2 + 1] = pi;
        bf16_t* bfr = (bf16_t*)X.bfrag; bf16_t* cfr = (bf16_t*)X.cfrag;
        const int ntr = p >> 4, col = p & 15;
        for (int c = 0; c < 16; ++c) {
            const float br = KAF(b_re)[(pb * 64 + p) * 16 + c], bi = KAF(b_im)[(pb * 64 + p) * 16 + c];
            const float bbr = zr * br - zi * bi, bbi = zr * bi + zi * br;
            const int q = c >> 3, j = c & 7;
            bfr[(((size_t)dg * 8 + ntr) * 64 + col + 16 * q) * 8 + j] = (bf16_t)f2bf(bbr);
            bfr[(((size_t)dg * 8 + 4 + ntr) * 64 + col + 16 * q) * 8 + j] = (bf16_t)f2bf(bbi);
            bfr[(((size_t)dg * 8 + ntr) * 64 + col + 16 * (q + 2)) * 8 + j] = 0;
            bfr[(((size_t)dg * 8 + 4 + ntr) * 64 + col + 16 * (q + 2)) * 8 + j] = 0;
            const float cr = KAF(c_re)[(pb * 16 + c) * 64 + p], ci = KAF(c_im)[(pb * 16 + c) * 64 + p];
            { const int k = p;      cfr[(((size_t)dg * 4 + (k >> 5)) * 64 + c + 16 * ((k >> 3) & 3)) * 8 + (k & 7)] = (bf16_t)f2bf(cr); }
            { const int k = 64 + p; cfr[(((size_t)dg * 4 + (k >> 5)) * 64 + c + 16 * ((k >> 3) & 3)) * 8 + (k & 7)] = (bf16_t)f2bf(-ci); }
        }
    }
    if (gt >= 2048 && gt < 2048 + 256) {
        const int c = gt - 2048;
        const float l0 = KAF(lb_logits)[c], l1 = KAF(lb_logits)[256 + c], l2 = KAF(lb_logits)[512 + c], l3 = KAF(lb_logits)[768 + c];
        const float mx = fmaxf(fmaxf(l0, l1), fmaxf(l2, l3));
        const float e0 = expf(l0 - mx), e1 = expf(l1 - mx), e2 = expf(l2 - mx), e3 = expf(l3 - mx), inv = 1.f / (e0 + e1 + e2 + e3);
        float v = 0.f; if (l >= 1) v += e1 * inv; if (l >= 2) v += e2 * inv; if (l >= 3) v += e3 * inv;
        ((float*)X.lb)[c] = v;
    }
}

struct Grp { int g, nseq, Lr, nch, s0; };
__device__ __forceinline__ Grp make_grp(int g) { Grp r; r.g = g; r.nseq = g < 2 ? 4 : 1; r.Lr = g < 2 ? 4096 : 16384; r.nch = r.Lr / 64 + 1; r.s0 = g < 2 ? g * 4 : 8 + (g - 2); return r; }

template <bool OUT>
__device__ __forceinline__ void s5_chunk(const Ctx& X, const float* s5d, LAS float* buf, bf16_t* zc, int T, int ci, int wave, int lane) {
    const int p = lane, fr = lane & 15, fq = lane >> 4;
    for (int gi = 0; gi < 2; ++gi) {
        const int g = wave * 2 + gi;
        f32x4 yacc[2][2];
#pragma unroll
        for (int i = 0; i < 2; ++i)
#pragma unroll
            for (int j = 0; j < 2; ++j) yacc[i][j] = (f32x4){0.f, 0.f, 0.f, 0.f};
#pragma unroll
        for (int dir = 0; dir < 2; ++dir) {
            const int dg = dir * 16 + g;
            const float lr = X.lbar[(dg * 64 + p) * 2], li = X.lbar[(dg * 64 + p) * 2 + 1];
            float xr = 0.f, xi = 0.f;
            float* st = X.s5s + ((size_t)ci * 2048 + dg * 64 + p) * 2;
            if (OUT) { xr = st[0]; xi = st[1]; }
#pragma unroll
            for (int sti = 0; sti < 2; ++sti) {
                const int stt = dir ? 1 - sti : sti; const int t0 = stt * 32;
                if (t0 < T) {
                    const int tn = (T - t0) < 32 ? (T - t0) : 32;
#pragma unroll
                    for (int mt = 0; mt < 2; ++mt) {
                        if (mt * 16 < tn) {
                            bf16x8 av = (bf16x8){0, 0, 0, 0, 0, 0, 0, 0};
                            if (fq < 2) av = *(const bf16x8*)(zc + (size_t)(t0 + mt * 16 + fr) * ZW + g * 16 + fq * 8);
#pragma unroll
                            for (int nt = 0; nt < 8; ++nt) {
                                const bf16x8 bv = *(const bf16x8*)(X.bfrag + (((size_t)dg * 8 + nt) * 64 + lane) * 8);
                                const f32x4 c = __builtin_amdgcn_mfma_f32_16x16x32_bf16(av, bv, (f32x4){0.f, 0.f, 0.f, 0.f}, 0, 0, 0);
#pragma unroll
                                for (int r = 0; r < 4; ++r) buf[(mt * 16 + fq * 4 + r) * 132 + nt * 16 + fr] = c[r];
                            }
                        }
                    }
                    __syncthreads();
                    for (int k = 0; k < tn; ++k) {
                        const int t = dir ? (tn - 1 - k) : k;
                        const float br = buf[t * 132 + p], bi = buf[t * 132 + 64 + p];
                        const float nr = lr * xr - li * xi + br, ni = lr * xi + li * xr + bi;
                        xr = nr; xi = ni;
                        if (OUT) { buf[t * 132 + p] = xr; buf[t * 132 + 64 + p] = xi; }
                    }
                    if (OUT) {
                        __syncthreads();
#pragma unroll
                        for (int mt = 0; mt < 2; ++mt) {
                            if (mt * 16 < tn) {
#pragma unroll
                                for (int ks = 0; ks < 4; ++ks) {
                                    const LAS float* ap = buf + (mt * 16 + fr) * 132 + ks * 32 + fq * 8;
                                    const f32x4 a0 = *(const LAS f32x4*)ap, a1 = *(const LAS f32x4*)(ap + 4);
                                    const u32x4 aw = pack8(a0, a1);
                                    const bf16x8 av = __builtin_bit_cast(bf16x8, aw);
                                    const bf16x8 bv = *(const bf16x8*)(X.cfrag + (((size_t)dg * 4 + ks) * 64 + lane) * 8);
                                    yacc[stt][mt] = __builtin_amdgcn_mfma_f32_16x16x32_bf16(av, bv, yacc[stt][mt], 0, 0, 0);
                                }
                            }
                        }
                    }
                    __syncthreads();
                }
            }
            if (!OUT) { st[0] = xr; st[1] = xi; }
        }
        if (OUT) {
            const float dsk = s5d[g * 16 + fr];
#pragma unroll
            for (int stt = 0; stt < 2; ++stt)
#pragma unroll
                for (int mt = 0; mt < 2; ++mt) {
                    if (stt * 32 + mt * 16 < T) {
#pragma unroll
                        for (int r = 0; r < 4; ++r) {
                            const int t = stt * 32 + mt * 16 + fq * 4 + r;
                            bf16_t* zr = zc + (size_t)t * ZW;
                            const float u = bf2f(zr[g * 16 + fr]);
                            const float y = gelu_tanh(yacc[stt][mt][r] + dsk * u);
                            zr[512 + g * 16 + fr] = (bf16_t)f2bf(y);
                        }
                    }
                }
        }
    }
}

__device__ __forceinline__ void s5_passB(const Ctx& X, const Grp& gp, int gtid, int GT) {
    const int n = gp.nseq * 2048;
    for (int e = gtid; e < n; e += GT) {
        const int sl = e >> 11, r = e & 2047, dir = r >> 10;
        const float l16r = X.l16[r * 2], l16i = X.l16[r * 2 + 1], l64r = X.l64[r * 2], l64i = X.l64[r * 2 + 1];
        float sr = 0.f, si = 0.f;
        for (int k0 = 0; k0 < gp.nch; k0 += 8) {
            float er[8], ei[8];
#pragma unroll
            for (int j = 0; j < 8; ++j) { const int k = k0 + j; if (k < gp.nch) { const int c = dir ? gp.nch - 1 - k : k; const float* pp = X.s5s + ((size_t)(sl * gp.nch + c) * 2048 + r) * 2; er[j] = pp[0]; ei[j] = pp[1]; } else { er[j] = 0.f; ei[j] = 0.f; } }
#pragma unroll
            for (int j = 0; j < 8; ++j) { const int k = k0 + j; if (k < gp.nch) { const int c = dir ? gp.nch - 1 - k : k; float* pp = X.s5s + ((size_t)(sl * gp.nch + c) * 2048 + r) * 2; pp[0] = sr; pp[1] = si;
                    const float pr = c == 0 ? l16r : l64r, pi = c == 0 ? l16i : l64i;
                    const float nr = pr * sr - pi * si + er[j], ni = pr * si + pi * sr + ei[j]; sr = nr; si = ni; } }
        }
    }
}

template <bool OUT>
__device__ __forceinline__ void hg_chunk(const Ctx& X, LAS float* gt, LAS bf16_t* ot, const bf16_t* zc, int T, int ci, int wave, int lane) {
    const int h = wave >> 1, dir = wave & 1;
    float S[64];
    float* U = X.hgu + ((size_t)ci * 8 + wave) * 4096;
    if (OUT) {
#pragma unroll
        for (int d = 0; d < 64; ++d) S[d] = U[d * 64 + lane];
    } else {
#pragma unroll
        for (int d = 0; d < 64; ++d) S[d] = 0.f;
    }
    const float lbv = X.lb[h * 64 + lane], oml = 1.f - lbv; float P = 1.f;
    const int fcol = (dir ? 2304 : 2048) + h * 64 + lane, qcol = 1792 + h * 64 + lane, vcol = 2560 + h * 64 + lane;
    const int ns8 = T >> 3;
    bf16_t rq[8], rf[8], rv[8];
    {
        const int sb0 = dir ? (ns8 - 1) : 0;
#pragma unroll
        for (int j = 0; j < 8; ++j) { const bf16_t* zr = zc + (size_t)(sb0 * 8 + j) * ZW; rq[j] = zr[qcol]; rf[j] = zr[fcol]; rv[j] = zr[vcol]; }
    }
#pragma unroll 1
    for (int s8 = 0; s8 < ns8; ++s8) {
        const int sb = dir ? (ns8 - 1 - s8) : s8;
#pragma unroll
        for (int j = 0; j < 8; ++j) {
            const float q = bf2f(rq[j]), ff = bf2f(rf[j]);
            const float sg = sigm(ff), fg = lbv + oml * sg, kk = oml * (1.f - sg);
            gt[j * 256 + lane] = fg; gt[j * 256 + 64 + lane] = kk; gt[j * 256 + 128 + lane] = q * sigm(q); gt[j * 256 + 192 + lane] = bf2f(rv[j]);
            P *= fg;
        }
        __syncthreads();
        if (s8 + 1 < ns8) {
            const int sbn = dir ? (ns8 - 2 - s8) : s8 + 1;
#pragma unroll
            for (int j = 0; j < 8; ++j) { const bf16_t* zr = zc + (size_t)(sbn * 8 + j) * ZW; rq[j] = zr[qcol]; rf[j] = zr[fcol]; rv[j] = zr[vcol]; }
        }
#pragma unroll 1
        for (int jj = 0; jj < 8; ++jj) {
            const int j = dir ? 7 - jj : jj;
            const LAS float* gj = gt + j * 256;
            const float v = gj[192 + lane];
            float o = 0.f;
#pragma unroll
            for (int d4 = 0; d4 < 16; ++d4) {
                const f32x4 f4 = *(const LAS f32x4*)(gj + d4 * 4), k4 = *(const LAS f32x4*)(gj + 64 + d4 * 4);
#pragma unroll
                for (int i = 0; i < 4; ++i) S[d4 * 4 + i] = f4[i] * S[d4 * 4 + i] + k4[i] * v;
                if (OUT) { const f32x4 q4 = *(const LAS f32x4*)(gj + 128 + d4 * 4);
#pragma unroll
                    for (int i = 0; i < 4; ++i) o += S[d4 * 4 + i] * q4[i]; }
                if ((d4 & 3) == 3) __builtin_amdgcn_sched_barrier(0);
            }
            if (OUT) ot[(sb * 8 + j) * 64 + lane] = (bf16_t)f2bf(o);
        }
        __syncthreads();
    }
    if (!OUT) {
#pragma unroll
        for (int d = 0; d < 64; ++d) U[d * 64 + lane] = S[d];
        X.hgp[((size_t)ci * 8 + wave) * 64 + lane] = P;
    }
}

__device__ __forceinline__ void hg_passB(const Ctx& X, const Grp& gp, int gtid, int GT) {
    const int n = gp.nseq * 32768;
    for (int e = gtid; e < n; e += GT) {
        const int sl = e >> 15, r = e & 32767, hd = r >> 12, de = r & 4095, d = de >> 6, dir = hd & 1;
        float s = 0.f;
        for (int k0 = 0; k0 < gp.nch; k0 += 8) {
            float u[8], pv[8];
#pragma unroll
            for (int j = 0; j < 8; ++j) { const int k = k0 + j; if (k < gp.nch) { const int c = dir ? gp.nch - 1 - k : k; const size_t cb = (size_t)(sl * gp.nch + c) * 8 + hd; u[j] = X.hgu[cb * 4096 + de]; pv[j] = X.hgp[cb * 64 + d]; } else { u[j] = 0.f; pv[j] = 0.f; } }
#pragma unroll
            for (int j = 0; j < 8; ++j) { const int k = k0 + j; if (k < gp.nch) { const int c = dir ? gp.nch - 1 - k : k; const size_t cb = (size_t)(sl * gp.nch + c) * 8 + hd; X.hgu[cb * 4096 + de] = s; s = pv[j] * s + u[j]; } }
        }
    }
}

typedef short v4i16_t __attribute__((ext_vector_type(4)));
__device__ __forceinline__ v4i16_t vtr16(const LAS unsigned char* p) { return __builtin_amdgcn_ds_read_tr16_b64_v4i16((LAS v4i16_t*)p); }
__device__ __forceinline__ void na_task(const Ctx& X, const float* rpb, const Grp& gp, int sl, int task, bool metaq, int wave, int lane, LAS unsigned char* vl) {
    const int h = wave, fr = lane & 15, fq = lane >> 4;
    const int s = gp.s0 + sl, rows = gp.Lr >> 6;
    int r = 0, n = 0, rs = 0, ks = 0;
    const bf16_t* qptr; bf16_t* optr; size_t ostride = 512;
    if (metaq) { qptr = X.mz + (size_t)(s * 16 + fr) * ZW; optr = X.myb + (size_t)(s * 16) * 512; }
    else {
        r = task >> 2; n = task & 3;
        rs = r - 4; rs = rs < 0 ? 0 : (rs > rows - 8 ? rows - 8 : rs);
        ks = 16 * n - 8; ks = ks < 0 ? 0 : (ks > 32 ? 32 : ks);
        const size_t qrow0 = (size_t)sl * gp.Lr + r * 64 + 16 * n;
        qptr = X.z + (qrow0 + fr) * ZW; optr = X.yb + qrow0 * 512;
    }
    bf16x8 qf[2];
#pragma unroll
    for (int kk = 0; kk < 2; ++kk) qf[kk] = *(const bf16x8*)(qptr + 256 + h * 64 + 32 * kk + 8 * fq);
    f32x4 sc[17];
    {
        const bf16_t* kp = X.mz + (size_t)(s * 16 + fr) * ZW + 768 + h * 64 + 8 * fq;
        f32x4 c = (f32x4){0.f, 0.f, 0.f, 0.f};
#pragma unroll
        for (int kk = 0; kk < 2; ++kk) c = __builtin_amdgcn_mfma_f32_16x16x32_bf16(*(const bf16x8*)(kp + 32 * kk), qf[kk], c, 0, 0, 0);
        sc[0] = c * 0.125f;
    }
    const int qc = 16 * n + fr;
    int wstart = qc - 8; wstart = wstart < 0 ? 0 : (wstart > 48 ? 48 : wstart);
    const size_t krow_base = (size_t)sl * gp.Lr + (size_t)rs * 64 + ks;
    if (!metaq) {
#pragma unroll
        for (int tb = 0; tb < 2; ++tb) {
            bf16x8 kf[8][2]; float bz[8][4];
#pragma unroll
            for (int t4 = 0; t4 < 8; ++t4) {
                const int tt = tb * 8 + t4, kj = tt >> 1, half = tt & 1;
                const bf16_t* kp = X.z + (krow_base + kj * 64 + 16 * half + fr) * ZW + 768 + h * 64 + 8 * fq;
                kf[t4][0] = *(const bf16x8*)kp; kf[t4][1] = *(const bf16x8*)(kp + 32);
            }
#pragma unroll
            for (int t4 = 0; t4 < 8; ++t4) {
                const int tt = tb * 8 + t4, kj = tt >> 1, half = tt & 1;
                const float* rp = rpb + (h * 15 + (rs + kj - r + 7)) * 31;
#pragma unroll
                for (int i = 0; i < 4; ++i) { int dc = ks + 16 * half + 4 * fq + i - qc; dc = dc < -15 ? -15 : (dc > 15 ? 15 : dc); bz[t4][i] = rp[dc + 15]; }
            }
            __builtin_amdgcn_sched_barrier(0);
#pragma unroll
            for (int t4 = 0; t4 < 8; ++t4) {
                const int tt = tb * 8 + t4, half = tt & 1;
                f32x4 c = (f32x4){0.f, 0.f, 0.f, 0.f};
                c = __builtin_amdgcn_mfma_f32_16x16x32_bf16(kf[t4][0], qf[0], c, 0, 0, 0);
                c = __builtin_amdgcn_mfma_f32_16x16x32_bf16(kf[t4][1], qf[1], c, 0, 0, 0);
#pragma unroll
                for (int i = 0; i < 4; ++i) {
                    const int kc = ks + 16 * half + 4 * fq + i;
                    const bool valid = (kc >= wstart) && (kc < wstart + 16);
                    c[i] = valid ? c[i] * 0.125f + bz[t4][i] : -1e30f;
                }
                sc[1 + tt] = c;
            }
            __builtin_amdgcn_sched_barrier(0);
        }
    } else {
#pragma unroll
        for (int tt = 0; tt < 16; ++tt) sc[1 + tt] = (f32x4){-1e30f, -1e30f, -1e30f, -1e30f};
    }
    float mx = -1e30f;
#pragma unroll
    for (int t = 0; t < 17; ++t)
#pragma unroll
        for (int i = 0; i < 4; ++i) mx = fmaxf(mx, sc[t][i]);
    mx = fmaxf(mx, __shfl_xor(mx, 16)); mx = fmaxf(mx, __shfl_xor(mx, 32));
    float sum = 0.f;
#pragma unroll
    for (int t = 0; t < 17; ++t)
#pragma unroll
        for (int i = 0; i < 4; ++i) { const float e = __expf(sc[t][i] - mx); sc[t][i] = e; sum += e; }
    sum += __shfl_xor(sum, 16); sum += __shfl_xor(sum, 32);
    const float inv = 1.f / sum;
    f32x4 oacc[4];
#pragma unroll
    for (int et = 0; et < 4; ++et) oacc[et] = (f32x4){0.f, 0.f, 0.f, 0.f};
    {
        const int r8 = lane >> 3, pc = lane & 7, l16 = lane & 15;
        const int vcol = 1280 + h * 64 + pc * 8;
        u32x4 vreg[8];
#pragma unroll
        for (int i = 0; i < 2; ++i) vreg[i] = *(const u32x4*)(X.mz + (size_t)(s * 16 + i * 8 + r8) * ZW + vcol);
#pragma unroll
        for (int cc = 0; cc < 5; ++cc) {
            if (cc > 0 && metaq) break;
            __syncthreads();
#pragma unroll
            for (int i = 0; i < 8; ++i) if (cc > 0 || i < 2) *(LAS u32x4*)(vl + (i * 8 + r8) * 144 + pc * 16) = vreg[i];
            __syncthreads();
            if (cc < 4 && !metaq) {
#pragma unroll
                for (int i = 0; i < 8; ++i) { const int rr = i * 8 + r8;
                    vreg[i] = *(const u32x4*)(X.z + (krow_base + (size_t)(2 * cc + (rr >> 5)) * 64 + (rr & 31)) * ZW + vcol); }
            }
#pragma unroll
            for (int ksl = 0; ksl < 2; ++ksl) {
                if (cc == 0 && ksl == 1) break;
                const int tt = 4 * (cc - 1) + 2 * ksl;
                f32x4 pa, pb;
                if (cc == 0) { pa = sc[0] * inv; pb = (f32x4){0.f, 0.f, 0.f, 0.f}; } else { pa = sc[1 + tt] * inv; pb = sc[2 + tt] * inv; }
                const bf16x8 pf = __builtin_bit_cast(bf16x8, pack8(pa, pb));
                const LAS unsigned char* rowp = vl + (32 * ksl + 4 * fq + (l16 >> 2)) * 144 + (4 * (l16 & 3)) * 2;
#pragma unroll
                for (int et = 0; et < 4; ++et) {
                    const v4i16_t ta = vtr16(rowp + et * 32);
                    v4i16_t tb = (v4i16_t){0, 0, 0, 0};
                    if (cc > 0) tb = vtr16(rowp + 16 * 144 + et * 32);
                    const bf16x8 vw = (bf16x8){ta[0], ta[1], ta[2], ta[3], tb[0], tb[1], tb[2], tb[3]};
                    oacc[et] = __builtin_amdgcn_mfma_f32_16x16x32_bf16(pf, vw, oacc[et], 0, 0, 0);
                }
            }
        }
    }
#pragma unroll
    for (int et = 0; et < 4; ++et)
#pragma unroll
        for (int i = 0; i < 4; ++i) optr[(size_t)(4 * fq + i) * ostride + h * 64 + et * 16 + fr] = (bf16_t)f2bf(oacc[et][i]);
}

#define XB_TMO      128
#define XB_XCNT(j)  (256  + 64 * (j))
#define XB_XSUB(j)  (1280 + 64 * (j))
#define XB_XGEN(j)  (2304 + 64 * (j))
#define XB_TOP      3328
#define XB_TOPGEN   3392
#define XCD_BAR_WORDS 3456
#define XB_SPIN_CAP (1u << 22)
__device__ __forceinline__ unsigned xb_ld(unsigned* p)              { return __hip_atomic_load(p, __ATOMIC_RELAXED, __HIP_MEMORY_SCOPE_AGENT); }
__device__ __forceinline__ unsigned xb_add(unsigned* p, unsigned v) { return __hip_atomic_fetch_add(p, v, __ATOMIC_RELAXED, __HIP_MEMORY_SCOPE_AGENT); }
__device__ __forceinline__ unsigned xb_xcc_id() { return (unsigned)__builtin_amdgcn_s_getreg((3 << 11) | 20) & 0xFu; }
#define XB_SPIN(cond, bar) do { unsigned _sp = 0; while (cond) { __builtin_amdgcn_s_sleep(1); \
    if ((++_sp & 255u) == 0u) { if (xb_ld(&(bar)[XB_TMO])) break; if (_sp > XB_SPIN_CAP) { atomicAdd(&(bar)[XB_TMO], 1u); break; } } } } while (0)
__device__ __forceinline__ void xcd_barrier_complete(unsigned* bar, unsigned x, unsigned& nloc, unsigned& nx) {
    const unsigned G = gridDim.x * gridDim.y * gridDim.z;
    unsigned sum, cnt, mine, sp = 0u;
    for (;;) {
        sum = 0u; cnt = 0u; mine = 0u;
#pragma unroll
        for (unsigned j = 0; j < 16; ++j) { const unsigned c = xb_ld(&bar[XB_XCNT(j)]); sum += c; cnt += (c > 0u) ? 1u : 0u; mine = (j == x) ? c : mine; }
        if (sum == G) break;
        __builtin_amdgcn_s_sleep(1);
        if ((++sp & 255u) == 0u) { if (xb_ld(&bar[XB_TMO])) break; if (sp > XB_SPIN_CAP) { atomicAdd(&bar[XB_TMO], 1u); break; } }
    }
    nloc = mine > 0u ? mine : 1u; nx = cnt > 0u ? cnt : 1u;
}
__device__ __forceinline__ void xcd_barrier(unsigned* bar, volatile LAS unsigned* st) {
    asm volatile("s_waitcnt vmcnt(0)" ::: "memory");
    __syncthreads();
    if (threadIdx.x == 0) {
        const unsigned x = xb_xcc_id();
        __builtin_amdgcn_s_waitcnt(0);
        unsigned nloc = st[0], nx = st[1];
        if (nloc == 0u) { xcd_barrier_complete(bar, x, nloc, nx); st[0] = nloc; st[1] = nx; }
        const unsigned old = xb_add(&bar[XB_XSUB(x)], 1u);
        const unsigned gen = old / nloc;
        if (old + 1u == (gen + 1u) * nloc) {
            __builtin_amdgcn_fence(__ATOMIC_RELEASE, "agent");
            asm volatile("s_waitcnt vmcnt(0)" ::: "memory");
            const unsigned og = xb_add(&bar[XB_TOP], 1u);
            const unsigned tg = og / nx;
            if (og + 1u == (tg + 1u) * nx) xb_add(&bar[XB_TOPGEN], 1u);
            else XB_SPIN(xb_ld(&bar[XB_TOPGEN]) == tg, bar);
            __builtin_amdgcn_fence(__ATOMIC_ACQUIRE, "agent");
            xb_add(&bar[XB_XGEN(x)], 1u);
            asm volatile("s_waitcnt vmcnt(0)" ::: "memory");
        } else {
            XB_SPIN(xb_ld(&bar[XB_XGEN(x)]) == gen, bar);
            __builtin_amdgcn_fence(__ATOMIC_ACQUIRE, "agent");
            asm volatile("s_waitcnt vmcnt(0)" ::: "memory");
        }
    }
    __syncthreads();
}
#define GRID_SYNC() xcd_barrier((unsigned*)(KA(ws) + WS_CTL), (volatile LAS unsigned*)(lds + LDS_ST_OFF))
__device__ __forceinline__ Ctx make_ctx(unsigned char* ws) {
    Ctx X;
    X.hb = (bf16_t*)(ws + WS_HB); X.ssq = (float*)(ws + WS_SSQ); X.z = (bf16_t*)(ws + WS_Z); X.yb = (bf16_t*)(ws + WS_YB); X.vt = (bf16_t*)(ws + WS_VT);
    X.hgu = (float*)(ws + WS_HGU); X.hgp = (float*)(ws + WS_HGP); X.s5s = (float*)(ws + WS_S5S); X.w = (bf16_t*)(ws + WS_W);
    X.lbar = (const float*)(ws + WS_TAB + T_LBAR); X.l16 = (const float*)(ws + WS_TAB + T_L16); X.l64 = (const float*)(ws + WS_TAB + T_L64);
    X.bfrag = (const bf16_t*)(ws + WS_TAB + T_BFRAG); X.cfrag = (const bf16_t*)(ws + WS_TAB + T_CFRAG); X.lb = (const float*)(ws + WS_TAB + T_LB);
    X.mh = (float*)(ws + WS_META + M_H); X.mhb = (bf16_t*)(ws + WS_META + M_HB); X.mssq = (float*)(ws + WS_META + M_SSQ); X.mz = (bf16_t*)(ws + WS_META + M_Z);
    X.myb = (bf16_t*)(ws + WS_META + M_YB); X.mvt = (bf16_t*)(ws + WS_META + M_VT); X.mact = (bf16_t*)(ws + WS_META + M_ACT);
    return X;
}

__device__ __forceinline__ bool make_job(unsigned char* ws, float* out, int l, int g, int ph, int j, pg8::Gemm& gm, pg8::UberEpi& ep) {
    const bool mchain = (g == 3) && (l < NLAYER - 1);
    int njobs = 1; bool meta = false; int sub = j;
    if (ph == 0) { njobs = (g == 0) ? 2 : 1; meta = (j == 1); }
    else if (ph == 4) { njobs = (g == 3) ? 2 : 1; meta = (j == 1); }
    else if (ph == 5) { njobs = mchain ? 6 : 3; meta = (j >= 3); sub = j % 3; }
    else { njobs = mchain ? 2 : 1; meta = (j == 1); }
    if (j >= njobs) return false;
    unsigned char* wb = ws + WS_W;
    const size_t r0 = (size_t)g * RG;
    unsigned char* mb = ws + WS_META;
    bf16_t* z = meta ? (bf16_t*)(mb + M_Z) : (bf16_t*)(ws + WS_Z);
    bf16_t* hb = meta ? (bf16_t*)(mb + M_HB) : (bf16_t*)(ws + WS_HB) + r0 * DM;
    float* ssq = meta ? (float*)(mb + M_SSQ) : (float*)(ws + WS_SSQ) + r0 * 4;
    float* h = meta ? (float*)(mb + M_H) : out + r0 * DM;
    bf16_t* yb = meta ? (bf16_t*)(mb + M_YB) : (bf16_t*)(ws + WS_YB);
    bf16_t* vt = meta ? (bf16_t*)(mb + M_VT) : (bf16_t*)(ws + WS_VT);
    bf16_t* act = meta ? (bf16_t*)(mb + M_ACT) : (bf16_t*)(ws + WS_Z);
    gm.M = meta ? 256 : RG;
    ep.i0 = 0; ep.p0 = nullptr; ep.p1 = nullptr; ep.p2 = nullptr;
    if (ph == 0) { gm.A = hb; gm.lda = DM; gm.Bt = (const bf16_t*)(wb + W_IN); gm.N = ZN; gm.K = DM; ep.mode = 0; ep.p0 = (unsigned char*)z; ep.p1 = (unsigned char*)ssq; ep.p2 = (unsigned char*)vt; ep.i0 = meta ? 256 : VTLD; }
    else if (ph == 4) { gm.A = z + 512; gm.lda = ZW; gm.Bt = (const bf16_t*)(wb + W_GLU); gm.N = 256; gm.K = 256; ep.mode = 1; ep.p0 = (unsigned char*)z; }
    else if (ph == 5) {
        gm.N = DM; ep.p0 = (unsigned char*)z;
        if (sub == 0) { gm.A = yb; gm.lda = 512; gm.Bt = (const bf16_t*)(wb + W_UPB); gm.K = 512; ep.mode = 2; ep.i0 = 4096; }
        else if (sub == 1) { gm.A = z + 256; gm.lda = ZW; gm.Bt = (const bf16_t*)(wb + W_UPC); gm.K = 256; ep.mode = 3; ep.i0 = 5120; }
        else { gm.A = z; gm.lda = ZW; gm.Bt = (const bf16_t*)(wb + W_UPA); gm.K = 256; ep.mode = 3; ep.i0 = 3072; }
    }
    else if (ph == 6) { gm.A = z + 1024; gm.lda = ZW; gm.Bt = (const bf16_t*)(wb + W_O); gm.N = DM; gm.K = DM; ep.mode = 4; ep.p0 = (unsigned char*)h; ep.p1 = (unsigned char*)hb; ep.p2 = (unsigned char*)ssq; }
    else if (ph == 7) { gm.A = hb; gm.lda = DM; gm.Bt = (const bf16_t*)(wb + W_GU); gm.N = 2 * FFH; gm.K = DM; ep.mode = 5; ep.p0 = (unsigned char*)act; ep.p1 = (unsigned char*)ssq; }
    else { gm.A = act; gm.lda = FFH; gm.Bt = (const bf16_t*)(wb + W_DN); gm.N = DM; gm.K = FFH; ep.mode = 4; ep.p0 = (unsigned char*)h; ep.p1 = (unsigned char*)hb; ep.p2 = (unsigned char*)ssq; }
    return true;
}

__device__ __forceinline__ void prologue(int G) {
    const int tid_ = opaque_tid(); const int lane = tid_ & 63, gw = blockIdx.x * 8 + __builtin_amdgcn_readfirstlane(tid_ >> 6), NGW = G * 8;
    const Ctx X = make_ctx(((unsigned char*)KA(ws)));
    for (int row = gw; row < RMAIN + 256; row += NGW) {
        const bool ismeta = row >= RMAIN; const int mr = row - RMAIN;
        const float* src = ismeta ? (mr < 160 ? KAF(meta_tokens) + (size_t)(mr & 15) * DM : nullptr) : (row < 32768 ? KAF(x_prompt) + (size_t)row * DM : KAF(x_sample) + (size_t)(row - 32768) * DM);
        float* hd = ismeta ? X.mh + (size_t)mr * DM : ((float*)KA(out)) + (size_t)row * DM;
        bf16_t* hbd = ismeta ? X.mhb + (size_t)mr * DM : X.hb + (size_t)row * DM;
        float* sq = ismeta ? X.mssq + (size_t)mr * 4 : X.ssq + (size_t)row * 4;
        float ss = 0.f;
#pragma unroll
        for (int j = 0; j < 4; ++j) {
            f32x4 v = (f32x4){0.f, 0.f, 0.f, 0.f}; if (src) v = *(const f32x4*)(src + j * 256 + lane * 4);
            *(f32x4*)(hd + j * 256 + lane * 4) = v;
            *(u32x2*)(hbd + j * 256 + lane * 4) = (u32x2){pk2(v[0], v[1]), pk2(v[2], v[3])};
            ss += (v[0] * v[0] + v[1] * v[1]) + (v[2] * v[2] + v[3] * v[3]);
        }
        ss = wave_sum(ss);
        if (lane < 4) sq[lane] = lane == 0 ? ss : 0.f;
    }
}

__device__ __forceinline__ void mixer_phase_A(int l, int g, LAS unsigned char* lds, int G, int bid) {
    const int tid_ = opaque_tid(); const int lane = tid_ & 63, wave = __builtin_amdgcn_readfirstlane(tid_ >> 6);
    const Ctx X = make_ctx(((unsigned char*)KA(ws))); const Grp gp = make_grp(g);
    const float* rpb = KAF(rpb) + (size_t)l * 8 * 15 * 31; const float* s5d = KAF(s5_d) + l * 256;
    const int nna = gp.nseq * (gp.Lr / 16), nmq = gp.nseq, nct = gp.nseq * (gp.nch - 1);
    const int ntask = nna + nmq + 2 * nct;
    const bool xmap = (nna % 256 == 0) && ((volatile LAS unsigned*)(lds + LDS_ST_OFF))[4] != 0u;
    if (xmap) {
        const int xcc = (int)((volatile LAS unsigned*)(lds + LDS_ST_OFF))[2], xrk = (int)((volatile LAS unsigned*)(lds + LDS_ST_OFF))[3];
        const int per = gp.Lr / 16, nx = nna / 8, rounds = nna / 256;
        for (int i = 0; i < rounds; ++i) { const int t = xcc * nx + xrk + 32 * i; na_task(X, rpb, gp, t / per, t % per, false, wave, lane, lds + wave * 9216); }
    }
    for (int t = bid + (xmap ? nna : 0); t < ntask; t += G) {
        __syncthreads();
        if (t < nna) { const int per = gp.Lr / 16; na_task(X, rpb, gp, t / per, t % per, false, wave, lane, lds + wave * 9216); }
        else if (t < nna + nmq) { na_task(X, rpb, gp, t - nna, 0, true, wave, lane, lds + wave * 9216); }
        else {
            const int u = t - nna - nmq; const bool isS5 = u < nct; const int v = isS5 ? u : u - nct;
            const int sl = v / (gp.nch - 1), c1 = v % (gp.nch - 1) + 1;
            for (int c = (c1 == 1 ? 0 : c1); c <= c1; ++c) {
                __syncthreads();
                const int ci = sl * gp.nch + c; const int T = c == 0 ? 16 : 64;
                bf16_t* zc = c == 0 ? X.mz + (size_t)((gp.s0 + sl) * 16) * ZW : X.z + ((size_t)sl * gp.Lr + 64 * (c - 1)) * ZW;
                if (isS5) s5_chunk<false>(X, s5d, (LAS float*)(lds + wave * 16896), zc, T, ci, wave, lane);
                else hg_chunk<false>(X, (LAS float*)(lds + wave * 8192), (LAS bf16_t*)(lds + 65536 + wave * 8192), zc, T, ci, wave, lane);
            }
        }
    }
}

__device__ __forceinline__ void mixer_phase_C(int l, int g, LAS unsigned char* lds, int G, int bid) {
    const int tid_ = opaque_tid(); const int lane = tid_ & 63, wave = __builtin_amdgcn_readfirstlane(tid_ >> 6);
    const Ctx X = make_ctx(((unsigned char*)KA(ws))); const Grp gp = make_grp(g);
    const float* s5d = KAF(s5_d) + l * 256; const float* ong = KAF(onorm_g) + l * 64;
    const int nct = gp.nseq * (gp.nch - 1);
    for (int t = bid; t < 2 * nct; t += G) {
        const bool isS5 = t < nct; const int v = isS5 ? t : t - nct;
        const int sl = v / (gp.nch - 1), c1 = v % (gp.nch - 1) + 1;
        for (int c = (c1 == 1 ? 0 : c1); c <= c1; ++c) {
            __syncthreads();
            const int ci = sl * gp.nch + c; const int T = c == 0 ? 16 : 64;
            bf16_t* zc = c == 0 ? X.mz + (size_t)((gp.s0 + sl) * 16) * ZW : X.z + ((size_t)sl * gp.Lr + 64 * (c - 1)) * ZW;
            if (isS5) s5_chunk<true>(X, s5d, (LAS float*)(lds + wave * 16896), zc, T, ci, wave, lane);
            else {
                hg_chunk<true>(X, (LAS float*)(lds + wave * 8192), (LAS bf16_t*)(lds + 65536 + wave * 8192), zc, T, ci, wave, lane);
                __syncthreads();
                const int h = wave >> 1, half = wave & 1;
                const LAS bf16_t* of = (const LAS bf16_t*)(lds + 65536 + (2 * h) * 8192); const LAS bf16_t* ob = (const LAS bf16_t*)(lds + 65536 + (2 * h + 1) * 8192);
                const float gn = ong[lane];
                for (int tt = half * (T / 2); tt < (half + 1) * (T / 2); ++tt) {
                    const float o = bf2f(of[tt * 64 + lane]) + bf2f(ob[tt * 64 + lane]);
                    const float ms = wave_sum(o * o) * (1.0f / 64.0f);
                    bf16_t* zr = zc + (size_t)tt * ZW;
                    const float go = bf2f(zr[2816 + h * 64 + lane]);
                    zr[256 + h * 64 + lane] = (bf16_t)f2bf(o * rsqrtf(ms + 1e-6f) * gn * (go * sigm(go)));
                }
            }
        }
    }
}

__global__ void __launch_bounds__(512, 2) fwd_kernel(Args a) {
    extern __shared__ __attribute__((aligned(16))) unsigned char lds_raw[];
    LAS unsigned char* lds = (LAS unsigned char*)lds_raw;
    const int G = gridDim.x, bid = blockIdx.x;

    if (threadIdx.x < 2) ((volatile LAS unsigned*)(lds + LDS_ST_OFF))[threadIdx.x] = 0u;
    if (threadIdx.x == 0) { const unsigned xc = xb_xcc_id(); const unsigned rk = xb_add((unsigned*)(KA(ws) + WS_CTL) + XB_XCNT(xc), 1u);
        ((volatile LAS unsigned*)(lds + LDS_ST_OFF))[2] = xc; ((volatile LAS unsigned*)(lds + LDS_ST_OFF))[3] = rk; }
    __syncthreads();
    prologue(G);

    for (int l = 0; l < NLAYER; ++l) {
        __syncthreads();
        { const Ctx X = make_ctx(((unsigned char*)KA(ws))); prep_layer(X, l, lds, G); }
        if (l == 0) { asm volatile("s_waitcnt vmcnt(0)" ::: "memory"); __syncthreads(); cg::this_grid().sync(); }
        GRID_SYNC();
        if (l == 0) {
            if (threadIdx.x == 0) { unsigned* bar = (unsigned*)(KA(ws) + WS_CTL); bool ok = (G == 256);
                for (int j = 0; j < 16; ++j) { const unsigned c = xb_ld(&bar[XB_XCNT(j)]); ok = ok && (c == (j < 8 ? 32u : 0u)); }
                ((volatile LAS unsigned*)(lds + LDS_ST_OFF))[4] = ok ? 1u : 0u; }
            __syncthreads();
        }
        for (int g = 0; g < 4; ++g) {
            for (int ph = 0; ph < 9; ++ph) {
                if (ph == 1) mixer_phase_A(l, g, lds, G, bid);
                else if (ph == 2) { const Ctx X = make_ctx(((unsigned char*)KA(ws))); const Grp gp = make_grp(g); const int gtid = bid * 512 + opaque_tid(), GT = G * 512; s5_passB(X, gp, gtid, GT); hg_passB(X, gp, GT - 1 - gtid, GT); }
                else if (ph == 3) mixer_phase_C(l, g, lds, G, bid);
                else {
                    for (int j = 0; j < 6; ++j) {
                        pg8::Gemm gm; pg8::UberEpi ep;
                        if (!make_job(((unsigned char*)KA(ws)), ((float*)KA(out)), l, g, ph, j, gm, ep)) break;
                        pg8::StaticOrder SO; SO.init(gm.M, gm.N, G, bid);
                        pg8::gemm_phase(lds, gm, SO, ep);
                    }
                }
                GRID_SYNC();
            }
        }
    }
    {
        const float* ssq = (const float*)(((unsigned char*)KA(ws)) + WS_SSQ);
        const int tid_ = opaque_tid(); const int lane = tid_ & 63, wave = __builtin_amdgcn_readfirstlane(tid_ >> 6);
        for (int row = bid * 8 + wave; row < RMAIN; row += G * 8) {
            const float rs = pg8::row_rstd(ssq, row);
            float* hp = ((float*)KA(out)) + (size_t)row * DM;
#pragma unroll
            for (int j = 0; j < 4; ++j) {
                f32x4 v = *(const f32x4*)(hp + j * 256 + lane * 4); const f32x4 gv = *(const f32x4*)(KAF(final_g) + j * 256 + lane * 4);
                v = v * rs * gv; *(f32x4*)(hp + j * 256 + lane * 4) = v;
            }
        }
    }
}

extern "C" void kernel_launch(void* const* d_in, const int* in_sizes, int n_in, void* d_out, int out_size, void* d_ws, size_t ws_size, hipStream_t stream) {
    static int grid = 0;
    if (grid == 0) {
        int dev = 0, cus = 0, per_cu = 0;
        (void)hipGetDevice(&dev);
        (void)hipDeviceGetAttribute(&cus, hipDeviceAttributeMultiprocessorCount, dev);
        (void)hipFuncSetAttribute((const void*)fwd_kernel, hipFuncAttributeMaxDynamicSharedMemorySize, LDS_BYTES);
        (void)hipOccupancyMaxActiveBlocksPerMultiprocessor(&per_cu, (const void*)fwd_kernel, 512, LDS_BYTES);
        (void)hipGetLastError();
        if (ws_size < WS_TOTAL) fprintf(stderr, "kernel_launch: workspace too small: %zu < %zu\n", ws_size, (size_t)WS_TOTAL);
        grid = cus > 0 ? cus : 256;
    }
    (void)hipMemsetAsync((char*)d_ws + WS_CTL, 0, CTL_BYTES, stream);
    Args a{};
    const float** pp = (const float**)&a;
    for (int i = 0; i < 26; ++i) pp[i] = (const float*)d_in[i];
    a.out = (float*)d_out; a.ws = (unsigned char*)d_ws;
    void* args[] = {&a};
    hipError_t e = hipLaunchCooperativeKernel((const void*)fwd_kernel, dim3(grid), dim3(512), args, LDS_BYTES, stream);
    if (e != hipSuccess) fprintf(stderr, "cooperative launch failed: %s\n", hipGetErrorString(e));
}
```

```cpp
#include <hip/hip_runtime.h>
#include <hip/hip_cooperative_groups.h>
#include <cstdio>
#include <cstdint>
namespace cg = cooperative_groups;

#define LAS __attribute__((address_space(3)))
typedef unsigned short bf16_t;
typedef short bf16x8 __attribute__((ext_vector_type(8)));
typedef float f32x4 __attribute__((ext_vector_type(4)));
typedef unsigned u32x4 __attribute__((ext_vector_type(4)));
typedef unsigned u32x2 __attribute__((ext_vector_type(2)));

#define WAVE_SYNC() asm volatile("s_waitcnt lgkmcnt(0)" ::: "memory")
__device__ __forceinline__ int opaque_tid() { int t = threadIdx.x; asm volatile("" : "+v"(t)); return t; }

__device__ __forceinline__ unsigned f2bf(float f) { unsigned u = __builtin_bit_cast(unsigned, f); return (u + 0x7fffu + ((u >> 16) & 1u)) >> 16; }
__device__ __forceinline__ unsigned pk2(float lo, float hi) { return f2bf(lo) | (f2bf(hi) << 16); }
__device__ __forceinline__ float bf2f(bf16_t b) { return __builtin_bit_cast(float, (unsigned)b << 16); }
__device__ __forceinline__ float bflo(unsigned w) { return __builtin_bit_cast(float, w << 16); }
__device__ __forceinline__ float bfhi(unsigned w) { return __builtin_bit_cast(float, w & 0xffff0000u); }
__device__ __forceinline__ float sigm(float x) { return 1.f / (1.f + __expf(-x)); }
__device__ __forceinline__ float gelu_tanh(float y) { const float a = 0.7978845608028654f * (y + 0.044715f * y * y * y); const float th = 1.f - 2.f / (__expf(2.f * a) + 1.f); return 0.5f * y * (1.f + th); }
__device__ __forceinline__ u32x4 pack8(f32x4 a, f32x4 b) { u32x4 w; w.x = pk2(a[0], a[1]); w.y = pk2(a[2], a[3]); w.z = pk2(b[0], b[1]); w.w = pk2(b[2], b[3]); return w; }
__device__ __forceinline__ float wave_sum(float v) {
#pragma unroll
    for (int o = 1; o < 64; o <<= 1) v += __shfl_xor(v, o);
    return v;
}

namespace pg8 {
constexpr int ZSTR = 6208;
constexpr int BM = 256, BK = 64, HALF = 128, HTB = HALF * BK * 2, STAGE_BYTES = 8 * HTB, NXCD = 8, WGM = 8;
__host__ __device__ __forceinline__ int lds_byte(int r, int c) { const int st = (r >> 4) * 2 + (c >> 5), rr = r & 15, cc = c & 31, ob = rr * 64 + cc * 2; return st * 1024 + (ob ^ (((ob >> 9) & 1) << 5)); }
__host__ __device__ __forceinline__ void stage_rc(int b, int& R, int& C) { const int st = b / 1024, sb = b % 1024, swz = sb ^ (((sb >> 9) & 1) << 5); R = (st >> 1) * 16 + swz / 64; C = (st & 1) * 32 + (swz % 64) / 2; }
__host__ __device__ __forceinline__ int perm32(int rho) { const int n = rho >> 4, i = rho & 15; return 8 * (i >> 2) + 4 * n + (i & 3); }
struct Unit { int pm, pn; };
struct Gemm { const bf16_t* A; int lda; const bf16_t* Bt; int M, N, K; };
struct StaticOrder {
    int nM, nN, nwg, G, c;
    __device__ void init(int M, int N, int G_, int c_) { nM = M / BM; nN = N / BM; nwg = nM * nN; G = G_; c = c_; }
    __device__ bool next(int i, Unit& u) const {
        const long L = (long)i * G + c; if (L >= nwg) return false;
        int wgid = (int)L; { const int q = nwg / NXCD, r = nwg % NXCD, xcd = wgid % NXCD, off = wgid / NXCD; wgid = (xcd < r ? xcd * (q + 1) : r * (q + 1) + (xcd - r) * q) + off; }
        const int nig = WGM * nN, gid = wgid / nig, fm = gid * WGM, gsz = (nM - fm) < WGM ? (nM - fm) : WGM;
        u.pm = fm + ((wgid % nig) % gsz); u.pn = (wgid % nig) / gsz; return true;
    }
};

struct UberEpi;
__device__ __forceinline__ void run_epi(const UberEpi& E, LAS unsigned char* lds, const f32x4 (&acc)[2][2][4][2], const Unit& u, int wr, int wc, int fr, int fq);
__device__ __forceinline__ void gemm_phase(LAS unsigned char* lds, const Gemm g, const StaticOrder& S, const UberEpi& E) {
    const int tid = opaque_tid(), wid = __builtin_amdgcn_readfirstlane(tid >> 6), lane = tid & 63, wr = wid >> 2, wc = wid & 3, fr = lane & 15, fq = lane >> 4;
    const int K = g.K, nt = K / BK, lda = g.lda;
    unsigned voffA[2], voffB[2];
#pragma unroll
    for (int i = 0; i < 2; ++i) { int R, C; stage_rc(tid * 16 + i * 8192, R, C); const int Rb = (R & ~31) + perm32(R & 31);
        voffA[i] = (unsigned)(R * lda + C) * 2u; voffB[i] = (unsigned)(Rb * K + C) * 2u; }
    const size_t kstep = (size_t)(BK * 2);
    const size_t hstepA = (size_t)HALF * lda * 2, hstepB = (size_t)HALF * K * 2;
    const size_t tstepA = 2 * hstepA, tstepB = 2 * hstepB;
    const unsigned ldsw = (unsigned)wid * 1024u;
    const int aoff = lds_byte(wr * 64 + fr, fq * 8), boff = lds_byte(wc * 32 + fr, fq * 8);
#define PG8_SA(b, h) (((b) * 2 + (h)) * HTB)
#define PG8_SB(b, h) ((4 + (b) * 2 + (h)) * HTB)
#define PG8_STAGE(bufoff, gbase, voff) do { _Pragma("unroll") for (int _i = 0; _i < 2; ++_i) \
        __builtin_amdgcn_global_load_lds((const unsigned*)((const char*)(gbase) + (voff)[_i]), (LAS unsigned*)(lds + (bufoff) + ldsw + _i * 8192), 16, 0, 0); } while (0)
#define PG8_LDA(dst, b, h) do { _Pragma("unroll") for (int m = 0; m < 4; ++m) _Pragma("unroll") for (int k = 0; k < 2; ++k) dst[m][k] = *(const LAS bf16x8*)(lds + PG8_SA(b, h) + aoff + m * 2048 + k * 1024); } while (0)
#define PG8_LDB(dst, b, h) do { _Pragma("unroll") for (int n = 0; n < 2; ++n) _Pragma("unroll") for (int k = 0; k < 2; ++k) dst[n][k] = *(const LAS bf16x8*)(lds + PG8_SB(b, h) + boff + n * 2048 + k * 1024); } while (0)
#define PG8_MMA(ai, bj, At, Bt) do { __builtin_amdgcn_s_setprio(1); _Pragma("unroll") for (int m = 0; m < 4; ++m) _Pragma("unroll") for (int n = 0; n < 2; ++n) _Pragma("unroll") for (int k = 0; k < 2; ++k) \
        acc[ai][bj][m][n] = __builtin_amdgcn_mfma_f32_16x16x32_bf16(Bt[n][k], At[m][k], acc[ai][bj][m][n], 0, 0, 0); __builtin_amdgcn_s_setprio(0); } while (0)
#define PG8_WAIT_V(n) asm volatile("s_waitcnt vmcnt(" #n ")" ::: "memory")
#define PG8_WAIT_L(n) asm volatile("s_waitcnt lgkmcnt(" #n ")" ::: "memory")
#define PG8_BAR __builtin_amdgcn_s_barrier()
#define PG8_SCHED __builtin_amdgcn_sched_barrier(0)
    Unit cur, nxt; int ui = 0;
    if (!S.next(0, cur)) return;
    f32x4 acc[2][2][4][2];
#pragma unroll
    for (int a = 0; a < 2; ++a)
#pragma unroll
        for (int b = 0; b < 2; ++b)
#pragma unroll
            for (int m = 0; m < 4; ++m)
#pragma unroll
                for (int n = 0; n < 2; ++n) acc[a][b][m][n] = (f32x4){0.f, 0.f, 0.f, 0.f};
    bf16x8 At[4][2], B0[2][2], B1[2][2];
    const char* cA = (const char*)g.A + (size_t)cur.pm * tstepA; const char* cB = (const char*)g.Bt + (size_t)cur.pn * tstepB;
    PG8_STAGE(PG8_SB(0, 0), cB, voffB); PG8_STAGE(PG8_SB(0, 1), cB + hstepB, voffB); PG8_STAGE(PG8_SA(0, 0), cA, voffA); PG8_STAGE(PG8_SA(0, 1), cA + hstepA, voffA);
    if (wr == 1) PG8_BAR;
    PG8_WAIT_V(2); PG8_BAR;
    PG8_STAGE(PG8_SB(1, 0), cB + kstep, voffB); PG8_STAGE(PG8_SA(1, 0), cA + kstep, voffA); PG8_STAGE(PG8_SB(1, 1), cB + hstepB + kstep, voffB);
    PG8_WAIT_V(6); PG8_BAR;
    for (;;) {
        const bool has_next = S.next(ui + 1, nxt);
        const char* nA = has_next ? (const char*)g.A + (size_t)nxt.pm * tstepA : cA; const char* nB = has_next ? (const char*)g.Bt + (size_t)nxt.pn * tstepB : cB;
        for (int t = 0; t < nt; t += 2) {
            const bool last = (t == nt - 2);
            const char* a1 = cA + (size_t)(t + 1) * kstep;
            const char* a2 = last ? nA : cA + (size_t)(t + 2) * kstep; const char* b2 = last ? nB : cB + (size_t)(t + 2) * kstep;
            const char* a3 = a2 + kstep; const char* b3 = b2 + kstep;
            PG8_LDB(B0, 0, 0); PG8_LDB(B1, 0, 1); PG8_SCHED; PG8_LDA(At, 0, 0); PG8_STAGE(PG8_SA(1, 1), a1 + hstepA, voffA);
            PG8_WAIT_V(8); PG8_WAIT_L(0); PG8_BAR; PG8_MMA(0, 0, At, B0); PG8_MMA(0, 1, At, B1); PG8_BAR; PG8_SCHED;
            PG8_LDA(At, 0, 1); PG8_STAGE(PG8_SB(0, 0), b2, voffB); PG8_STAGE(PG8_SB(0, 1), b2 + hstepB, voffB); PG8_STAGE(PG8_SA(0, 0), a2, voffA);
            PG8_WAIT_V(8); PG8_WAIT_L(0); PG8_BAR; PG8_MMA(1, 0, At, B0); PG8_MMA(1, 1, At, B1); PG8_BAR; PG8_SCHED;
            PG8_LDB(B0, 1, 0); PG8_LDB(B1, 1, 1); PG8_SCHED; PG8_LDA(At, 1, 0); PG8_STAGE(PG8_SA(0, 1), a2 + hstepA, voffA);
            PG8_WAIT_V(8); PG8_WAIT_L(0); PG8_BAR; PG8_MMA(0, 0, At, B0); PG8_MMA(0, 1, At, B1); PG8_BAR; PG8_SCHED;
            PG8_LDA(At, 1, 1); PG8_STAGE(PG8_SB(1, 0), b3, voffB); PG8_STAGE(PG8_SB(1, 1), b3 + hstepB, voffB); PG8_STAGE(PG8_SA(1, 0), a3, voffA);
            PG8_WAIT_V(8); PG8_WAIT_L(0); PG8_BAR; PG8_MMA(1, 0, At, B0); PG8_MMA(1, 1, At, B1); PG8_BAR; PG8_SCHED;
        }
        if (wr == 0) PG8_BAR;
        run_epi(E, lds, acc, cur, wr, wc, fr, fq);
        if (!has_next) break;
#pragma unroll
        for (int a = 0; a < 2; ++a)
#pragma unroll
            for (int b = 0; b < 2; ++b)
#pragma unroll
                for (int m = 0; m < 4; ++m)
#pragma unroll
                    for (int n = 0; n < 2; ++n) acc[a][b][m][n] = (f32x4){0.f, 0.f, 0.f, 0.f};
        cur = nxt; cA = nA; cB = nB; ++ui;
        if (wr == 1) PG8_BAR;
    }
    PG8_WAIT_V(0);
    PG8_BAR;
#undef PG8_SA
#undef PG8_SB
#undef PG8_STAGE
#undef PG8_LDA
#undef PG8_LDB
#undef PG8_MMA
#undef PG8_WAIT_V
#undef PG8_WAIT_L
#undef PG8_BAR
#undef PG8_SCHED
}

__device__ __forceinline__ float row_rstd(const float* ssq, int row) {
    const f32x4 s0 = *(const f32x4*)(ssq + (size_t)row * 4);
    const float ss = (s0[0] + s0[1]) + (s0[2] + s0[3]);
    return rsqrtf(ss * (1.0f / 1024.0f) + 1e-6f);
}
struct EpiZ {
    bf16_t* z; const float* ssq; bf16_t* vt; int vt_ld;
    __device__ __forceinline__ void operator()(const f32x4 (&acc)[2][2][4][2], const Unit& u, int wr, int wc, int fr, int fq) const {
        const int row0 = u.pm * BM + wr * 64 + fr, col0 = u.pn * BM + wc * 32 + 8 * fq;
#pragma unroll
        for (int ai = 0; ai < 2; ++ai)
#pragma unroll
            for (int m = 0; m < 4; ++m) {
                const int row = row0 + ai * HALF + m * 16; const float rs = row_rstd(ssq, row);
#pragma unroll
                for (int bj = 0; bj < 2; ++bj) {
                    const u32x4 w = pack8(acc[ai][bj][m][0] * rs, acc[ai][bj][m][1] * rs);
                    *(u32x4*)(z + (size_t)row * ZSTR + col0 + bj * HALF) = w;
                }
            }
    }
};
struct EpiGlu {
    bf16_t* z;
    __device__ __forceinline__ void operator()(const f32x4 (&acc)[2][2][4][2], const Unit& u, int wr, int wc, int fr, int fq) const {
        const int row0 = u.pm * BM + wr * 64 + fr, col0 = wc * 32 + 8 * fq;
#pragma unroll
        for (int ai = 0; ai < 2; ++ai)
#pragma unroll
            for (int m = 0; m < 4; ++m) {
                const int row = row0 + ai * HALF + m * 16;
#pragma unroll
                for (int bj = 0; bj < 2; ++bj) {
                    bf16_t* zp = z + (size_t)row * ZSTR + col0 + bj * HALF;
                    const u32x4 y = *(const u32x4*)(zp + 512);
                    const f32x4 a0 = acc[ai][bj][m][0], a1 = acc[ai][bj][m][1];
                    f32x4 o0, o1;
                    o0[0] = bflo(y.x) * sigm(a0[0]); o0[1] = bfhi(y.x) * sigm(a0[1]); o0[2] = bflo(y.y) * sigm(a0[2]); o0[3] = bfhi(y.y) * sigm(a0[3]);
                    o1[0] = bflo(y.z) * sigm(a1[0]); o1[1] = bfhi(y.z) * sigm(a1[1]); o1[2] = bflo(y.w) * sigm(a1[2]); o1[3] = bfhi(y.w) * sigm(a1[3]);
                    *(u32x4*)zp = pack8(o0, o1);
                }
            }
    }
};
template <int MODE> struct EpiMix {
    bf16_t* z; int goff;
    __device__ __forceinline__ void operator()(const f32x4 (&acc)[2][2][4][2], const Unit& u, int wr, int wc, int fr, int fq) const {
        const int row0 = u.pm * BM + wr * 64 + fr, col0 = u.pn * BM + wc * 32 + 8 * fq;
#pragma unroll
        for (int ai = 0; ai < 2; ++ai)
#pragma unroll
            for (int mp = 0; mp < 2; ++mp) {
                u32x4 gv[2][2], pv[2][2];
#pragma unroll
                for (int mm = 0; mm < 2; ++mm)
#pragma unroll
                    for (int bj = 0; bj < 2; ++bj) { const bf16_t* zr = z + (size_t)(row0 + ai * HALF + (mp * 2 + mm) * 16) * ZSTR + col0 + bj * HALF;
                        gv[mm][bj] = *(const u32x4*)(zr + goff); if (MODE == 1) pv[mm][bj] = *(const u32x4*)(zr + 1024); }
#pragma unroll
                for (int mm = 0; mm < 2; ++mm) {
                    const int m = mp * 2 + mm; const int row = row0 + ai * HALF + m * 16;
#pragma unroll
                    for (int bj = 0; bj < 2; ++bj) {
                        bf16_t* zr = z + (size_t)row * ZSTR + col0 + bj * HALF;
                        const u32x4 gq = gv[mm][bj];
                        const f32x4 a0 = acc[ai][bj][m][0], a1 = acc[ai][bj][m][1];
                        f32x4 o0, o1;
                        o0[0] = sigm(bflo(gq.x)) * a0[0]; o0[1] = sigm(bfhi(gq.x)) * a0[1]; o0[2] = sigm(bflo(gq.y)) * a0[2]; o0[3] = sigm(bfhi(gq.y)) * a0[3];
                        o1[0] = sigm(bflo(gq.z)) * a1[0]; o1[1] = sigm(bfhi(gq.z)) * a1[1]; o1[2] = sigm(bflo(gq.w)) * a1[2]; o1[3] = sigm(bfhi(gq.w)) * a1[3];
                        if (MODE == 1) { const u32x4 p = pv[mm][bj];
                            o0[0] += bflo(p.x); o0[1] += bfhi(p.x); o0[2] += bflo(p.y); o0[3] += bfhi(p.y); o1[0] += bflo(p.z); o1[1] += bfhi(p.z); o1[2] += bflo(p.w); o1[3] += bfhi(p.w); }
                        *(u32x4*)(zr + 1024) = pack8(o0, o1);
                    }
                }
            }
    }
};
struct EpiRes {
    float* h; bf16_t* hb; float* ssq; LAS float* red;
    __device__ __forceinline__ void operator()(const f32x4 (&acc)[2][2][4][2], const Unit& u, int wr, int wc, int fr, int fq) const {
        const int row0 = u.pm * BM + wr * 64 + fr, col0 = u.pn * BM + wc * 32 + 8 * fq;
#pragma unroll
        for (int ai = 0; ai < 2; ++ai)
#pragma unroll
            for (int mp = 0; mp < 2; ++mp) {
                f32x4 hv[2][2][2];
#pragma unroll
                for (int mm = 0; mm < 2; ++mm)
#pragma unroll
                    for (int bj = 0; bj < 2; ++bj) { const float* hp = h + (size_t)(row0 + ai * HALF + (mp * 2 + mm) * 16) * 1024 + col0 + bj * HALF; hv[mm][bj][0] = *(const f32x4*)hp; hv[mm][bj][1] = *(const f32x4*)(hp + 4); }
#pragma unroll
                for (int mm = 0; mm < 2; ++mm) {
                    const int m = mp * 2 + mm; const int row = row0 + ai * HALF + m * 16; float part = 0.f;
#pragma unroll
                    for (int bj = 0; bj < 2; ++bj) {
                        float* hp = h + (size_t)row * 1024 + col0 + bj * HALF;
                        const f32x4 h0 = hv[mm][bj][0] + acc[ai][bj][m][0], h1 = hv[mm][bj][1] + acc[ai][bj][m][1];
                        *(f32x4*)hp = h0; *(f32x4*)(hp + 4) = h1;
                        part += (h0[0] * h0[0] + h0[1] * h0[1]) + (h0[2] * h0[2] + h0[3] * h0[3]) + (h1[0] * h1[0] + h1[1] * h1[1]) + (h1[2] * h1[2] + h1[3] * h1[3]);
                        *(u32x4*)(hb + (size_t)row * 1024 + col0 + bj * HALF) = pack8(h0, h1);
                    }
                    part += __shfl_xor(part, 16); part += __shfl_xor(part, 32);
                    if (fq == 0) red[(ai * HALF + wr * 64 + m * 16 + fr) * 4 + wc] = part;
                }
            }
        asm volatile("s_waitcnt lgkmcnt(0)" ::: "memory");
        __builtin_amdgcn_s_barrier();
        asm volatile("" ::: "memory");
        { const int t_ = opaque_tid(); if (t_ < 256) { const f32x4 r4 = *(const LAS f32x4*)(red + t_ * 4); ssq[(size_t)(u.pm * BM + t_) * 4 + u.pn] = (r4[0] + r4[1]) + (r4[2] + r4[3]); } }
    }
};
struct EpiAct {
    bf16_t* act; const float* ssq;
    __device__ __forceinline__ void operator()(const f32x4 (&acc)[2][2][4][2], const Unit& u, int wr, int wc, int fr, int fq) const {
        const int row0 = u.pm * BM + wr * 64 + fr, col0 = u.pn * HALF + wc * 32 + 8 * fq;
#pragma unroll
        for (int ai = 0; ai < 2; ++ai)
#pragma unroll
            for (int m = 0; m < 4; ++m) {
                const int row = row0 + ai * HALF + m * 16; const float rs = row_rstd(ssq, row);
                f32x4 o[2];
#pragma unroll
                for (int n = 0; n < 2; ++n)
#pragma unroll
                    for (int i = 0; i < 4; ++i) { const float gg = acc[ai][0][m][n][i] * rs, uu = acc[ai][1][m][n][i] * rs; o[n][i] = gg * sigm(gg) * uu; }
                *(u32x4*)(act + (size_t)row * 2816 + col0) = pack8(o[0], o[1]);
            }
    }
};
struct UberEpi { int mode, i0; unsigned char *p0, *p1, *p2; };
__device__ __forceinline__ void run_epi(const UberEpi& E, LAS unsigned char* lds, const f32x4 (&acc)[2][2][4][2], const Unit& u, int wr, int wc, int fr, int fq) {
    switch (E.mode) {
        case 0: { EpiZ e{(bf16_t*)E.p0, (const float*)E.p1, (bf16_t*)E.p2, E.i0}; e(acc, u, wr, wc, fr, fq); break; }
        case 1: { EpiGlu e{(bf16_t*)E.p0}; e(acc, u, wr, wc, fr, fq); break; }
        case 2: { EpiMix<0> e{(bf16_t*)E.p0, E.i0}; e(acc, u, wr, wc, fr, fq); break; }
        case 3: { EpiMix<1> e{(bf16_t*)E.p0, E.i0}; e(acc, u, wr, wc, fr, fq); break; }
        case 4: { EpiRes e{(float*)E.p0, (bf16_t*)E.p1, (float*)E.p2, (LAS float*)(lds + 131072)}; e(acc, u, wr, wc, fr, fq); break; }
        default: { EpiAct e{(bf16_t*)E.p0, (const float*)E.p1}; e(acc, u, wr, wc, fr, fq); break; }
    }
}
}

constexpr int NLAYER = 4, DM = 1024, ZN = 6144, ZW = 6208  , FFH = 2816, RG = 16384, RMAIN = 65536, VTLD = RG + 64  ;
constexpr size_t al256(size_t x) { return (x + 255) & ~(size_t)255; }
constexpr size_t WS_HB = 0;
constexpr size_t WS_SSQ = WS_HB + (size_t)RMAIN * DM * 2;
constexpr size_t WS_Z = WS_SSQ + (size_t)RMAIN * 4 * 4;
constexpr size_t WS_YB = WS_Z + (size_t)RG * ZW * 2;
constexpr size_t WS_VT = WS_YB + (size_t)RG * 512 * 2;
constexpr size_t WS_HGU = WS_VT + (size_t)512 * VTLD * 2;
constexpr size_t WS_HGP = WS_HGU + (size_t)260 * 8 * 4096 * 4;
constexpr size_t WS_S5S = WS_HGP + (size_t)260 * 8 * 64 * 4;
constexpr size_t WS_W = WS_S5S + (size_t)260 * 2048 * 8;
constexpr size_t W_IN = 0, W_UPA = W_IN + (size_t)6144 * 1024 * 2, W_UPB = W_UPA + (size_t)1024 * 256 * 2, W_UPC = W_UPB + (size_t)1024 * 512 * 2,
                 W_O = W_UPC + (size_t)1024 * 256 * 2, W_GU = W_O + (size_t)1024 * 1024 * 2, W_DN = W_GU + (size_t)5632 * 1024 * 2, W_GLU = W_DN + (size_t)1024 * 2816 * 2,
                 W_END = W_GLU + (size_t)256 * 256 * 2;
constexpr size_t WS_TAB = WS_W + W_END;
constexpr size_t T_LBAR = 0, T_L16 = T_LBAR + 2048 * 8, T_L64 = T_L16 + 2048 * 8, T_BFRAG = T_L64 + 2048 * 8, T_CFRAG = T_BFRAG + (size_t)32 * 8 * 64 * 16,
                 T_LB = T_CFRAG + (size_t)32 * 4 * 64 * 16, T_END = T_LB + 256 * 4;
constexpr size_t WS_META = al256(WS_TAB + T_END);
constexpr size_t M_H = 0, M_HB = M_H + (size_t)256 * 1024 * 4, M_SSQ = M_HB + (size_t)256 * 1024 * 2, M_Z = M_SSQ + (size_t)256 * 4 * 4, M_YB = M_Z + (size_t)256 * ZW * 2,
                 M_VT = M_YB + (size_t)256 * 512 * 2, M_ACT = M_VT + (size_t)512 * 256 * 2, M_END = M_ACT + (size_t)256 * FFH * 2;
constexpr size_t WS_CTL = al256(WS_META + M_END);
constexpr size_t CTL_BYTES = 16384;
constexpr size_t WS_TOTAL = WS_CTL + CTL_BYTES;
constexpr int LDS_ST_OFF = 135168;
constexpr int LDS_BYTES = 147456;

struct Args {
    const float *x_prompt, *x_sample, *meta_tokens, *norm1_g, *w_in, *a_re, *a_im, *log_dt, *b_re, *b_im, *c_re, *c_im, *s5_d, *w_glu, *rpb, *lb_logits, *onorm_g,
        *w_up_a, *w_up_b, *w_up_c, *w_o, *norm2_g, *w_gate, *w_up, *w_down, *final_g;
    float* out; unsigned char* ws;
};

__device__ __forceinline__ unsigned long long ufl(unsigned long long v) { const unsigned lo = __builtin_amdgcn_readfirstlane((unsigned)v), hi = __builtin_amdgcn_readfirstlane((unsigned)(v >> 32)); return ((unsigned long long)hi << 32) | lo; }
#define GAS __attribute__((address_space(1)))
#define KA(f) ((decltype(Args::f))(GAS char*)ufl((unsigned long long)(((const volatile Args*)__builtin_amdgcn_kernarg_segment_ptr())->f)))
#define KAF(f) ((const float*)KA(f))
struct Ctx {
    bf16_t *hb, *z, *yb, *vt; float *ssq, *hgu, *hgp, *s5s;
    bf16_t *w; const float *lbar, *l16, *l64; const bf16_t *bfrag, *cfrag; const float* lb;
    float* mh; bf16_t *mhb, *mz, *myb, *mvt, *mact; float* mssq;
};

__device__ __forceinline__ void tr_item(const float* W, int K, int N, bf16_t* WT, const float* kscale, int mode, LAS float* scr, int item, int lane, bool valid) {
    const int nblk = N / 32, kb = item / nblk, nb = item % nblk, k0 = 64 * kb, n0 = 32 * nb;
    if (valid) {
#pragma unroll 8
    for (int i = 0; i < 32; ++i) { const int kk = 2 * i + (lane >> 5); float v = W[(size_t)(k0 + kk) * N + n0 + (lane & 31)]; if (kscale) v *= kscale[k0 + kk]; scr[kk * 33 + (lane & 31)] = v; }
    }
    __syncthreads();
    const int c = lane & 7;
    int drow0 = n0; if (mode) drow0 = (n0 >> 7) * 256 + (n0 & 127) + (mode == 2 ? 128 : 0);
    if (valid) {
#pragma unroll
    for (int j = 0; j < 4; ++j) { const int n = (lane >> 3) + 8 * j; const LAS float* s = scr + (8 * c) * 33 + n;
        u32x4 o; o.x = pk2(s[0 * 33], s[1 * 33]); o.y = pk2(s[2 * 33], s[3 * 33]); o.z = pk2(s[4 * 33], s[5 * 33]); o.w = pk2(s[6 * 33], s[7 * 33]);
        *(u32x4*)(WT + (size_t)(drow0 + n) * K + k0 + 8 * c) = o; }
    }
    __syncthreads();
}

__device__ __forceinline__ void prep_layer(const Ctx& X, int l, LAS unsigned char* lds, int G) {
    const int tid_ = opaque_tid(); const int wave = __builtin_amdgcn_readfirstlane(tid_ >> 6), lane = tid_ & 63;
    LAS float* scr = (LAS float*)(lds + wave * 16384);
    const int gw = blockIdx.x * 8 + wave, NGW = G * 8;
    constexpr int I0 = 16 * 192, I1 = 4 * 32, I2 = 8 * 32, I3 = 4 * 32, I4 = 16 * 32, I5 = 16 * 88, I6 = 16 * 88, I7 = 44 * 32, I8 = 4 * 8;
    constexpr int NIT = I0 + I1 + I2 + I3 + I4 + I5 + I6 + I7 + I8;
    unsigned char* wb = (unsigned char*)X.w;
    for (int it0 = 0; it0 < NIT; it0 += NGW) {
        const int it = it0 + gw; const bool valid = it < NIT;
        int r = valid ? it : 0;
        if (r < I0) { tr_item(KAF(w_in) + (size_t)l * 1024 * 6144, 1024, 6144, (bf16_t*)(wb + W_IN), KAF(norm1_g) + l * 1024, 0, scr, r, lane, valid); continue; } r -= I0;
        if (r < I1) { tr_item(KAF(w_up_a) + (size_t)l * 256 * 1024, 256, 1024, (bf16_t*)(wb + W_UPA), nullptr, 0, scr, r, lane, valid); continue; } r -= I1;
        if (r < I2) { tr_item(KAF(w_up_b) + (size_t)l * 512 * 1024, 512, 1024, (bf16_t*)(wb + W_UPB), nullptr, 0, scr, r, lane, valid); continue; } r -= I2;
        if (r < I3) { tr_item(KAF(w_up_c) + (size_t)l * 256 * 1024, 256, 1024, (bf16_t*)(wb + W_UPC), nullptr, 0, scr, r, lane, valid); continue; } r -= I3;
        if (r < I4) { tr_item(KAF(w_o) + (size_t)l * 1024 * 1024, 1024, 1024, (bf16_t*)(wb + W_O), nullptr, 0, scr, r, lane, valid); continue; } r -= I4;
        if (r < I5) { tr_item(KAF(w_gate) + (size_t)l * 1024 * 2816, 1024, 2816, (bf16_t*)(wb + W_GU), KAF(norm2_g) + l * 1024, 1, scr, r, lane, valid); continue; } r -= I5;
        if (r < I6) { tr_item(KAF(w_up) + (size_t)l * 1024 * 2816, 1024, 2816, (bf16_t*)(wb + W_GU), KAF(norm2_g) + l * 1024, 2, scr, r, lane, valid); continue; } r -= I6;
        if (r < I7) { tr_item(KAF(w_down) + (size_t)l * 2816 * 1024, 2816, 1024, (bf16_t*)(wb + W_DN), nullptr, 0, scr, r, lane, valid); continue; } r -= I7;
        tr_item(KAF(w_glu) + (size_t)l * 256 * 256, 256, 256, (bf16_t*)(wb + W_GLU), nullptr, 0, scr, r, lane, valid);
    }
    const int gt = blockIdx.x * 512 + tid_;
    if (gt < 2048) {
        const int dg = gt >> 6, p = gt & 63;
        const size_t pb = ((size_t)l * 32 + dg);
        const float are = KAF(a_re)[pb * 64 + p], aim = KAF(a_im)[pb * 64 + p], dt = expf(KAF(log_dt)[pb]);
        const float mag = expf(are * dt); float sn, cs; sincosf(aim * dt, &sn, &cs);
        const float lr = mag * cs, li = mag * sn;
        const float den = are * are + aim * aim, nr = lr - 1.0f, ni = li;
        const float zr = (nr * are + ni * aim) / den, zi = (ni * are - nr * aim) / den;
        float* lbar = (float*)X.lbar; float* l16 = (float*)X.l16; float* l64 = (float*)X.l64;
        lbar[gt * 2] = lr; lbar[gt * 2 + 1] = li;
        float pr = lr, pi = li;
#pragma unroll
        for (int s = 0; s < 4; ++s) { const float t = pr * pr - pi * pi; pi = 2.f * pr * pi; pr = t; }
        l16[gt * 2] = pr; l16[gt * 2 + 1] = pi;
#pragma unroll
        for (int s = 0; s < 2; ++s) { const float t = pr * pr - pi * pi; pi = 2.f * pr * pi; pr = t; }
        l64[gt * 2] = pr; l64[gt * 2 + 1] = pi;
        bf16_t* bfr = (bf16_t*)X.bfrag; bf16_t* cfr = (bf16_t*)X.cfrag;
        const int ntr = p >> 4, col = p & 15;
        for (int c = 0; c < 16; ++c) {
            const float br = KAF(b_re)[(pb * 64 + p) * 16 + c], bi = KAF(b_im)[(pb * 64 + p) * 16 + c];
            const float bbr = zr * br - zi * bi, bbi = zr * bi + zi * br;
            const int q = c >> 3, j = c & 7;
            bfr[(((size_t)dg * 8 + ntr) * 64 + col + 16 * q) * 8 + j] = (bf16_t)f2bf(bbr);
            bfr[(((size_t)dg * 8 + 4 + ntr) * 64 + col + 16 * q) * 8 + j] = (bf16_t)f2bf(bbi);
            bfr[(((size_t)dg * 8 + ntr) * 64 + col + 16 * (q + 2)) * 8 + j] = 0;
            bfr[(((size_t)dg * 8 + 4 + ntr) * 64 + col + 16 * (q + 2)) * 8 + j] = 0;
            const float cr = KAF(c_re)[(pb * 16 + c) * 64 + p], ci = KAF(c_im)[(pb * 16 + c) * 64 + p];
            { const int k = p;      cfr[(((size_t)dg * 4 + (k >> 5)) * 64 + c + 16 * ((k >> 3) & 3)) * 8 + (k & 7)] = (bf16_t)f2bf(cr); }
            { const int k = 64 + p; cfr[(((size_t)dg * 4 + (k >> 5)) * 64 + c + 16 * ((k >> 3) & 3)) * 8 + (k & 7)] = (bf16_t)f2bf(-ci); }
        }
    }
    if (gt >= 2048 && gt < 2048 + 256) {
        const int c = gt - 2048;
        const float l0 = KAF(lb_logits)[c], l1 = KAF(lb_logits)[256 + c], l2 = KAF(lb_logits)[512 + c], l3 = KAF(lb_logits)[768 + c];
        const float mx = fmaxf(fmaxf(l0, l1), fmaxf(l2, l3));
        const float e0 = expf(l0 - mx), e1 = expf(l1 - mx), e2 = expf(l2 - mx), e3 = expf(l3 - mx), inv = 1.f / (e0 + e1 + e2 + e3);
        float v = 0.f; if (l >= 1) v += e1 * inv; if (l >= 2) v += e2 * inv; if (l >= 3) v += e3 * inv;
        ((float*)X.lb)[c] = v;
    }
}

struct Grp { int g, nseq, Lr, nch, s0; };
__device__ __forceinline__ Grp make_grp(int g) { Grp r; r.g = g; r.nseq = g < 2 ? 4 : 1; r.Lr = g < 2 ? 4096 : 16384; r.nch = r.Lr / 64 + 1; r.s0 = g < 2 ? g * 4 : 8 + (g - 2); return r; }

template <bool OUT>
__device__ __forceinline__ void s5_chunk(const Ctx& X, const float* s5d, LAS float* buf, bf16_t* zc, int T, int ci, int wave, int lane) {
    const int p = lane, fr = lane & 15, fq = lane >> 4;
    for (int gi = 0; gi < 2; ++gi) {
        const int g = wave * 2 + gi;
        f32x4 yacc[2][2];
#pragma unroll
        for (int i = 0; i < 2; ++i)
#pragma unroll
            for (int j = 0; j < 2; ++j) yacc[i][j] = (f32x4){0.f, 0.f, 0.f, 0.f};
        bf16x8 ua[4];
#pragma unroll
        for (int m4 = 0; m4 < 4; ++m4) { ua[m4] = (bf16x8){0, 0, 0, 0, 0, 0, 0, 0}; if (fq < 2 && m4 * 16 < T) ua[m4] = *(const bf16x8*)(zc + (size_t)(m4 * 16 + fr) * ZW + g * 16 + fq * 8); }
#pragma unroll
        for (int dir = 0; dir < 2; ++dir) {
            const int dg = dir * 16 + g;
            bf16x8 bfr[8], cfr[4];
#pragma unroll
            for (int nt = 0; nt < 8; ++nt) bfr[nt] = *(const bf16x8*)(X.bfrag + (((size_t)dg * 8 + nt) * 64 + lane) * 8);
            if (OUT) {
#pragma unroll
                for (int ks = 0; ks < 4; ++ks) cfr[ks] = *(const bf16x8*)(X.cfrag + (((size_t)dg * 4 + ks) * 64 + lane) * 8);
            }
            const float lr = X.lbar[(dg * 64 + p) * 2], li = X.lbar[(dg * 64 + p) * 2 + 1];
            float xr = 0.f, xi = 0.f;
            float* st = X.s5s + ((size_t)ci * 2048 + dg * 64 + p) * 2;
            if (OUT) { xr = st[0]; xi = st[1]; }
#pragma unroll
            for (int sti = 0; sti < 2; ++sti) {
                const int stt = dir ? 1 - sti : sti; const int t0 = stt * 32;
                if (t0 < T) {
                    const int tn = (T - t0) < 32 ? (T - t0) : 32;
#pragma unroll
                    for (int mt = 0; mt < 2; ++mt) {
                        if (mt * 16 < tn) {
#pragma unroll
                            for (int nt = 0; nt < 8; ++nt) {
                                const f32x4 c = __builtin_amdgcn_mfma_f32_16x16x32_bf16(ua[stt * 2 + mt], bfr[nt], (f32x4){0.f, 0.f, 0.f, 0.f}, 0, 0, 0);
#pragma unroll
                                for (int r = 0; r < 4; ++r) buf[(mt * 16 + fq * 4 + r) * 132 + nt * 16 + fr] = c[r];
                            }
                        }
                    }
                    __syncthreads();
                    for (int k = 0; k < tn; ++k) {
                        const int t = dir ? (tn - 1 - k) : k;
                        const float br = buf[t * 132 + p], bi = buf[t * 132 + 64 + p];
                        const float nr = lr * xr - li * xi + br, ni = lr * xi + li * xr + bi;
                        xr = nr; xi = ni;
                        if (OUT) { buf[t * 132 + p] = xr; buf[t * 132 + 64 + p] = xi; }
                    }
                    if (OUT) {
                        __syncthreads();
#pragma unroll
                        for (int mt = 0; mt < 2; ++mt) {
                            if (mt * 16 < tn) {
#pragma unroll
                                for (int ks = 0; ks < 4; ++ks) {
                                    const LAS float* ap = buf + (mt * 16 + fr) * 132 + ks * 32 + fq * 8;
                                    const f32x4 a0 = *(const LAS f32x4*)ap, a1 = *(const LAS f32x4*)(ap + 4);
                                    const u32x4 aw = pack8(a0, a1);
                                    const bf16x8 av = __builtin_bit_cast(bf16x8, aw);
                                    yacc[stt][mt] = __builtin_amdgcn_mfma_f32_16x16x32_bf16(av, cfr[ks], yacc[stt][mt], 0, 0, 0);
                                }
                            }
                        }
                    }
                    __syncthreads();
                }
            }
            if (!OUT) { st[0] = xr; st[1] = xi; }
        }
        if (OUT) {
            const float dsk = s5d[g * 16 + fr];
            float uv[16];
#pragma unroll
            for (int q4 = 0; q4 < 4; ++q4)
#pragma unroll
                for (int r = 0; r < 4; ++r) { uv[q4 * 4 + r] = 0.f; if (q4 * 16 < T) uv[q4 * 4 + r] = bf2f(zc[(size_t)(q4 * 16 + fq * 4 + r) * ZW + g * 16 + fr]); }
#pragma unroll
            for (int stt = 0; stt < 2; ++stt)
#pragma unroll
                for (int mt = 0; mt < 2; ++mt) {
                    if (stt * 32 + mt * 16 < T) {
#pragma unroll
                        for (int r = 0; r < 4; ++r) {
                            const int t = stt * 32 + mt * 16 + fq * 4 + r;
                            const float y = gelu_tanh(yacc[stt][mt][r] + dsk * uv[(stt * 2 + mt) * 4 + r]);
                            zc[(size_t)t * ZW + 512 + g * 16 + fr] = (bf16_t)f2bf(y);
                        }
                    }
                }
        }
    }
}

__device__ __forceinline__ void s5_passB(const Ctx& X, const Grp& gp, int gtid, int GT) {
    const int n = gp.nseq * 2048;
    for (int e = gtid; e < n; e += GT) {
        const int sl = e >> 11, r = e & 2047, dir = r >> 10;
        const float l16r = X.l16[r * 2], l16i = X.l16[r * 2 + 1], l64r = X.l64[r * 2], l64i = X.l64[r * 2 + 1];
        float sr = 0.f, si = 0.f;
        for (int k0 = 0; k0 < gp.nch; k0 += 8) {
            float er[8], ei[8];
#pragma unroll
            for (int j = 0; j < 8; ++j) { const int k = k0 + j; if (k < gp.nch) { const int c = dir ? gp.nch - 1 - k : k; const float* pp = X.s5s + ((size_t)(sl * gp.nch + c) * 2048 + r) * 2; er[j] = pp[0]; ei[j] = pp[1]; } else { er[j] = 0.f; ei[j] = 0.f; } }
#pragma unroll
            for (int j = 0; j < 8; ++j) { const int k = k0 + j; if (k < gp.nch) { const int c = dir ? gp.nch - 1 - k : k; float* pp = X.s5s + ((size_t)(sl * gp.nch + c) * 2048 + r) * 2; pp[0] = sr; pp[1] = si;
                    const float pr = c == 0 ? l16r : l64r, pi = c == 0 ? l16i : l64i;
                    const float nr = pr * sr - pi * si + er[j], ni = pr * si + pi * sr + ei[j]; sr = nr; si = ni; } }
        }
    }
}

template <bool OUT>
__device__ __forceinline__ void hg_chunk(const Ctx& X, LAS float* gt, LAS bf16_t* ot, const bf16_t* zc, int T, int ci, int wave, int lane) {
    const int h = wave >> 1, dir = wave & 1;
    float S[64];
    float* U = X.hgu + ((size_t)ci * 8 + wave) * 4096;
    if (OUT) {
#pragma unroll
        for (int d = 0; d < 64; ++d) S[d] = U[d * 64 + lane];
    } else {
#pragma unroll
        for (int d = 0; d < 64; ++d) S[d] = 0.f;
    }
    const float lbv = X.lb[h * 64 + lane], oml = 1.f - lbv; float P = 1.f;
    const int fcol = (dir ? 2304 : 2048) + h * 64 + lane, qcol = 1792 + h * 64 + lane, vcol = 2560 + h * 64 + lane;
    const int ns8 = T >> 3;
    bf16_t rq[8], rf[8], rv[8];
    {
        const int sb0 = dir ? (ns8 - 1) : 0;
#pragma unroll
        for (int j = 0; j < 8; ++j) { const bf16_t* zr = zc + (size_t)(sb0 * 8 + j) * ZW; rq[j] = zr[qcol]; rf[j] = zr[fcol]; rv[j] = zr[vcol]; }
    }
#pragma unroll 1
    for (int s8 = 0; s8 < ns8; ++s8) {
        const int sb = dir ? (ns8 - 1 - s8) : s8;
#pragma unroll
        for (int j = 0; j < 8; ++j) {
            const float q = bf2f(rq[j]), ff = bf2f(rf[j]);
            const float sg = sigm(ff), fg = lbv + oml * sg, kk = oml * (1.f - sg);
            gt[j * 256 + lane] = fg; gt[j * 256 + 64 + lane] = kk; gt[j * 256 + 128 + lane] = q * sigm(q); gt[j * 256 + 192 + lane] = bf2f(rv[j]);
            P *= fg;
        }
        __syncthreads();
        if (s8 + 1 < ns8) {
            const int sbn = dir ? (ns8 - 2 - s8) : s8 + 1;
#pragma unroll
            for (int j = 0; j < 8; ++j) { const bf16_t* zr = zc + (size_t)(sbn * 8 + j) * ZW; rq[j] = zr[qcol]; rf[j] = zr[fcol]; rv[j] = zr[vcol]; }
        }
#pragma unroll 1
        for (int jj = 0; jj < 8; ++jj) {
            const int j = dir ? 7 - jj : jj;
            const LAS float* gj = gt + j * 256;
            const float v = gj[192 + lane];
            float o = 0.f;
#pragma unroll
            for (int d4 = 0; d4 < 16; ++d4) {
                const f32x4 f4 = *(const LAS f32x4*)(gj + d4 * 4), k4 = *(const LAS f32x4*)(gj + 64 + d4 * 4);
#pragma unroll
                for (int i = 0; i < 4; ++i) S[d4 * 4 + i] = f4[i] * S[d4 * 4 + i] + k4[i] * v;
                if (OUT) { const f32x4 q4 = *(const LAS f32x4*)(gj + 128 + d4 * 4);
#pragma unroll
                    for (int i = 0; i < 4; ++i) o += S[d4 * 4 + i] * q4[i]; }
                if ((d4 & 3) == 3) __builtin_amdgcn_sched_barrier(0);
            }
            if (OUT) ot[(sb * 8 + j) * 64 + lane] = (bf16_t)f2bf(o);
        }
        __syncthreads();
    }
    if (!OUT) {
#pragma unroll
        for (int d = 0; d < 64; ++d) U[d * 64 + lane] = S[d];
        X.hgp[((size_t)ci * 8 + wave) * 64 + lane] = P;
    }
}

__device__ __forceinline__ void hg_passB(const Ctx& X, const Grp& gp, int gtid, int GT) {
    const int n = gp.nseq * 32768;
    for (int e = gtid; e < n; e += GT) {
        const int sl = e >> 15, r = e & 32767, hd = r >> 12, de = r & 4095, d = de >> 6, dir = hd & 1;
        float s = 0.f;
        for (int k0 = 0; k0 < gp.nch; k0 += 8) {
            float u[8], pv[8];
#pragma unroll
            for (int j = 0; j < 8; ++j) { const int k = k0 + j; if (k < gp.nch) { const int c = dir ? gp.nch - 1 - k : k; const size_t cb = (size_t)(sl * gp.nch + c) * 8 + hd; u[j] = X.hgu[cb * 4096 + de]; pv[j] = X.hgp[cb * 64 + d]; } else { u[j] = 0.f; pv[j] = 0.f; } }
#pragma unroll
            for (int j = 0; j < 8; ++j) { const int k = k0 + j; if (k < gp.nch) { const int c = dir ? gp.nch - 1 - k : k; const size_t cb = (size_t)(sl * gp.nch + c) * 8 + hd; X.hgu[cb * 4096 + de] = s; s = pv[j] * s + u[j]; } }
        }
    }
}

typedef short v4i16_t __attribute__((ext_vector_type(4)));
__device__ __forceinline__ v4i16_t vtr16(const LAS unsigned char* p) { return __builtin_amdgcn_ds_read_tr16_b64_v4i16((LAS v4i16_t*)p); }
__device__ __forceinline__ void na_task(const Ctx& X, const float* rpb, const Grp& gp, int sl, int task, bool metaq, int wave, int lane, LAS unsigned char* vl) {
    const int h = wave, fr = lane & 15, fq = lane >> 4;
    const int s = gp.s0 + sl, rows = gp.Lr >> 6;
    int r = 0, n = 0, rs = 0, ks = 0;
    const bf16_t* qptr; bf16_t* optr; size_t ostride = 512;
    if (metaq) { qptr = X.mz + (size_t)(s * 16 + fr) * ZW; optr = X.myb + (size_t)(s * 16) * 512; }
    else {
        r = task >> 2; n = task & 3;
        rs = r - 4; rs = rs < 0 ? 0 : (rs > rows - 8 ? rows - 8 : rs);
        ks = 16 * n - 8; ks = ks < 0 ? 0 : (ks > 32 ? 32 : ks);
        const size_t qrow0 = (size_t)sl * gp.Lr + r * 64 + 16 * n;
        qptr = X.z + (qrow0 + fr) * ZW; optr = X.yb + qrow0 * 512;
    }
    bf16x8 qf[2];
#pragma unroll
    for (int kk = 0; kk < 2; ++kk) qf[kk] = *(const bf16x8*)(qptr + 256 + h * 64 + 32 * kk + 8 * fq);
    f32x4 sc[17];
    {
        const bf16_t* kp = X.mz + (size_t)(s * 16 + fr) * ZW + 768 + h * 64 + 8 * fq;
        f32x4 c = (f32x4){0.f, 0.f, 0.f, 0.f};
#pragma unroll
        for (int kk = 0; kk < 2; ++kk) c = __builtin_amdgcn_mfma_f32_16x16x32_bf16(*(const bf16x8*)(kp + 32 * kk), qf[kk], c, 0, 0, 0);
        sc[0] = c * 0.125f;
    }
    const int qc = 16 * n + fr;
    int wstart = qc - 8; wstart = wstart < 0 ? 0 : (wstart > 48 ? 48 : wstart);
    const size_t krow_base = (size_t)sl * gp.Lr + (size_t)rs * 64 + ks;
    if (!metaq) {
#pragma unroll
        for (int tb = 0; tb < 2; ++tb) {
            bf16x8 kf[8][2]; float bz[8][4];
#pragma unroll
            for (int t4 = 0; t4 < 8; ++t4) {
                const int tt = tb * 8 + t4, kj = tt >> 1, half = tt & 1;
                const bf16_t* kp = X.z + (krow_base + kj * 64 + 16 * half + fr) * ZW + 768 + h * 64 + 8 * fq;
                kf[t4][0] = *(const bf16x8*)kp; kf[t4][1] = *(const bf16x8*)(kp + 32);
            }
#pragma unroll
            for (int t4 = 0; t4 < 8; ++t4) {
                const int tt = tb * 8 + t4, kj = tt >> 1, half = tt & 1;
                const float* rp = rpb + (h * 15 + (rs + kj - r + 7)) * 31;
#pragma unroll
                for (int i = 0; i < 4; ++i) { int dc = ks + 16 * half + 4 * fq + i - qc; dc = dc < -15 ? -15 : (dc > 15 ? 15 : dc); bz[t4][i] = rp[dc + 15]; }
            }
            __builtin_amdgcn_sched_barrier(0);
#pragma unroll
            for (int t4 = 0; t4 < 8; ++t4) {
                const int tt = tb * 8 + t4, half = tt & 1;
                f32x4 c = (f32x4){0.f, 0.f, 0.f, 0.f};
                c = __builtin_amdgcn_mfma_f32_16x16x32_bf16(kf[t4][0], qf[0], c, 0, 0, 0);
                c = __builtin_amdgcn_mfma_f32_16x16x32_bf16(kf[t4][1], qf[1], c, 0, 0, 0);
#pragma unroll
                for (int i = 0; i < 4; ++i) {
                    const int kc = ks + 16 * half + 4 * fq + i;
                    const bool valid = (kc >= wstart) && (kc < wstart + 16);
                    c[i] = valid ? c[i] * 0.125f + bz[t4][i] : -1e30f;
                }
                sc[1 + tt] = c;
            }
            __builtin_amdgcn_sched_barrier(0);
        }
    } else {
#pragma unroll
        for (int tt = 0; tt < 16; ++tt) sc[1 + tt] = (f32x4){-1e30f, -1e30f, -1e30f, -1e30f};
    }
    float mx = -1e30f;
#pragma unroll
    for (int t = 0; t < 17; ++t)
#pragma unroll
        for (int i = 0; i < 4; ++i) mx = fmaxf(mx, sc[t][i]);
    mx = fmaxf(mx, __shfl_xor(mx, 16)); mx = fmaxf(mx, __shfl_xor(mx, 32));
    float sum = 0.f;
#pragma unroll
    for (int t = 0; t < 17; ++t)
#pragma unroll
        for (int i = 0; i < 4; ++i) { const float e = __expf(sc[t][i] - mx); sc[t][i] = e; sum += e; }
    sum += __shfl_xor(sum, 16); sum += __shfl_xor(sum, 32);
    const float inv = 1.f / sum;
    f32x4 oacc[4];
#pragma unroll
    for (int et = 0; et < 4; ++et) oacc[et] = (f32x4){0.f, 0.f, 0.f, 0.f};
    {
        const int r8 = lane >> 3, pc = lane & 7, l16 = lane & 15;
        const int vcol = 1280 + h * 64 + pc * 8;
        u32x4 vreg[8];
#pragma unroll
        for (int i = 0; i < 2; ++i) vreg[i] = *(const u32x4*)(X.mz + (size_t)(s * 16 + i * 8 + r8) * ZW + vcol);
#pragma unroll
        for (int cc = 0; cc < 5; ++cc) {
            if (cc > 0 && metaq) break;
            __syncthreads();
#pragma unroll
            for (int i = 0; i < 8; ++i) if (cc > 0 || i < 2) *(LAS u32x4*)(vl + (i * 8 + r8) * 144 + pc * 16) = vreg[i];
            __syncthreads();
            if (cc < 4 && !metaq) {
#pragma unroll
                for (int i = 0; i < 8; ++i) { const int rr = i * 8 + r8;
                    vreg[i] = *(const u32x4*)(X.z + (krow_base + (size_t)(2 * cc + (rr >> 5)) * 64 + (rr & 31)) * ZW + vcol); }
            }
#pragma unroll
            for (int ksl = 0; ksl < 2; ++ksl) {
                if (cc == 0 && ksl == 1) break;
                const int tt = 4 * (cc - 1) + 2 * ksl;
                f32x4 pa, pb;
                if (cc == 0) { pa = sc[0] * inv; pb = (f32x4){0.f, 0.f, 0.f, 0.f}; } else { pa = sc[1 + tt] * inv; pb = sc[2 + tt] * inv; }
                const bf16x8 pf = __builtin_bit_cast(bf16x8, pack8(pa, pb));
                const LAS unsigned char* rowp = vl + (32 * ksl + 4 * fq + (l16 >> 2)) * 144 + (4 * (l16 & 3)) * 2;
#pragma unroll
                for (int et = 0; et < 4; ++et) {
                    const v4i16_t ta = vtr16(rowp + et * 32);
                    v4i16_t tb = (v4i16_t){0, 0, 0, 0};
                    if (cc > 0) tb = vtr16(rowp + 16 * 144 + et * 32);
                    const bf16x8 vw = (bf16x8){ta[0], ta[1], ta[2], ta[3], tb[0], tb[1], tb[2], tb[3]};
                    oacc[et] = __builtin_amdgcn_mfma_f32_16x16x32_bf16(pf, vw, oacc[et], 0, 0, 0);
                }
            }
        }
    }
#pragma unroll
    for (int et = 0; et < 4; ++et)
#pragma unroll
        for (int i = 0; i < 4; ++i) optr[(size_t)(4 * fq + i) * ostride + h * 64 + et * 16 + fr] = (bf16_t)f2bf(oacc[et][i]);
}

#define XB_TMO      128
#define XB_XCNT(j)  (256  + 64 * (j))
#define XB_XSUB(j)  (1280 + 64 * (j))
#define XB_XGEN(j)  (2304 + 64 * (j))
#define XB_TOP      3328
#define XB_TOPGEN   3392
#define XCD_BAR_WORDS 3456
#define XB_SPIN_CAP (1u << 22)
__device__ __forceinline__ unsigned xb_ld(unsigned* p)              { return __hip_atomic_load(p, __ATOMIC_RELAXED, __HIP_MEMORY_SCOPE_AGENT); }
__device__ __forceinline__ unsigned xb_add(unsigned* p, unsigned v) { return __hip_atomic_fetch_add(p, v, __ATOMIC_RELAXED, __HIP_MEMORY_SCOPE_AGENT); }
__device__ __forceinline__ unsigned xb_xcc_id() { return (unsigned)__builtin_amdgcn_s_getreg((3 << 11) | 20) & 0xFu; }
#define XB_SPIN(cond, bar) do { unsigned _sp = 0; while (cond) { __builtin_amdgcn_s_sleep(1); \
    if ((++_sp & 255u) == 0u) { if (xb_ld(&(bar)[XB_TMO])) break; if (_sp > XB_SPIN_CAP) { atomicAdd(&(bar)[XB_TMO], 1u); break; } } } } while (0)
__device__ __forceinline__ void xcd_barrier_complete(unsigned* bar, unsigned x, unsigned& nloc, unsigned& nx) {
    const unsigned G = gridDim.x * gridDim.y * gridDim.z;
    unsigned sum, cnt, mine, sp = 0u;
    for (;;) {
        sum = 0u; cnt = 0u; mine = 0u;
#pragma unroll
        for (unsigned j = 0; j < 16; ++j) { const unsigned c = xb_ld(&bar[XB_XCNT(j)]); sum += c; cnt += (c > 0u) ? 1u : 0u; mine = (j == x) ? c : mine; }
        if (sum == G) break;
        __builtin_amdgcn_s_sleep(1);
        if ((++sp & 255u) == 0u) { if (xb_ld(&bar[XB_TMO])) break; if (sp > XB_SPIN_CAP) { atomicAdd(&bar[XB_TMO], 1u); break; } }
    }
    nloc = mine > 0u ? mine : 1u; nx = cnt > 0u ? cnt : 1u;
}
__device__ __forceinline__ void xcd_barrier(unsigned* bar, volatile LAS unsigned* st) {
    asm volatile("s_waitcnt vmcnt(0)" ::: "memory");
    __syncthreads();
    if (threadIdx.x == 0) {
        const unsigned x = xb_xcc_id();
        __builtin_amdgcn_s_waitcnt(0);
        unsigned nloc = st[0], nx = st[1];
        if (nloc == 0u) { xcd_barrier_complete(bar, x, nloc, nx); st[0] = nloc; st[1] = nx; }
        const unsigned old = xb_add(&bar[XB_XSUB(x)], 1u);
        const unsigned gen = old / nloc;
        if (old + 1u == (gen + 1u) * nloc) {
            __builtin_amdgcn_fence(__ATOMIC_RELEASE, "agent");
            asm volatile("s_waitcnt vmcnt(0)" ::: "memory");
            const unsigned og = xb_add(&bar[XB_TOP], 1u);
            const unsigned tg = og / nx;
            if (og + 1u == (tg + 1u) * nx) xb_add(&bar[XB_TOPGEN], 1u);
            else XB_SPIN(xb_ld(&bar[XB_TOPGEN]) == tg, bar);
            __builtin_amdgcn_fence(__ATOMIC_ACQUIRE, "agent");
            xb_add(&bar[XB_XGEN(x)], 1u);
            asm volatile("s_waitcnt vmcnt(0)" ::: "memory");
        } else {
            XB_SPIN(xb_ld(&bar[XB_XGEN(x)]) == gen, bar);
            __builtin_amdgcn_fence(__ATOMIC_ACQUIRE, "agent");
            asm volatile("s_waitcnt vmcnt(0)" ::: "memory");
        }
    }
    __syncthreads();
}
#define GRID_SYNC() xcd_barrier((unsigned*)(KA(ws) + WS_CTL), (volatile LAS unsigned*)(lds + LDS_ST_OFF))
__device__ __forceinline__ Ctx make_ctx(unsigned char* ws) {
    Ctx X;
    X.hb = (bf16_t*)(ws + WS_HB); X.ssq = (float*)(ws + WS_SSQ); X.z = (bf16_t*)(ws + WS_Z); X.yb = (bf16_t*)(ws + WS_YB); X.vt = (bf16_t*)(ws + WS_VT);
    X.hgu = (float*)(ws + WS_HGU); X.hgp = (float*)(ws + WS_HGP); X.s5s = (float*)(ws + WS_S5S); X.w = (bf16_t*)(ws + WS_W);
    X.lbar = (const float*)(ws + WS_TAB + T_LBAR); X.l16 = (const float*)(ws + WS_TAB + T_L16); X.l64 = (const float*)(ws + WS_TAB + T_L64);
    X.bfrag = (const bf16_t*)(ws + WS_TAB + T_BFRAG); X.cfrag = (const bf16_t*)(ws + WS_TAB + T_CFRAG); X.lb = (const float*)(ws + WS_TAB + T_LB);
    X.mh = (float*)(ws + WS_META + M_H); X.mhb = (bf16_t*)(ws + WS_META + M_HB); X.mssq = (float*)(ws + WS_META + M_SSQ); X.mz = (bf16_t*)(ws + WS_META + M_Z);
    X.myb = (bf16_t*)(ws + WS_META + M_YB); X.mvt = (bf16_t*)(ws + WS_META + M_VT); X.mact = (bf16_t*)(ws + WS_META + M_ACT);
    return X;
}

__device__ __forceinline__ bool make_job(unsigned char* ws, float* out, int l, int g, int ph, int j, pg8::Gemm& gm, pg8::UberEpi& ep) {
    const bool mchain = (g == 3) && (l < NLAYER - 1);
    int njobs = 1; bool meta = false; int sub = j;
    if (ph == 0) { njobs = (g == 0) ? 2 : 1; meta = (j == 1); }
    else if (ph == 4) { njobs = (g == 3) ? 2 : 1; meta = (j == 1); }
    else if (ph == 5) { njobs = mchain ? 6 : 3; meta = (j >= 3); sub = j % 3; }
    else { njobs = mchain ? 2 : 1; meta = (j == 1); }
    if (j >= njobs) return false;
    unsigned char* wb = ws + WS_W;
    const size_t r0 = (size_t)g * RG;
    unsigned char* mb = ws + WS_META;
    bf16_t* z = meta ? (bf16_t*)(mb + M_Z) : (bf16_t*)(ws + WS_Z);
    bf16_t* hb = meta ? (bf16_t*)(mb + M_HB) : (bf16_t*)(ws + WS_HB) + r0 * DM;
    float* ssq = meta ? (float*)(mb + M_SSQ) : (float*)(ws + WS_SSQ) + r0 * 4;
    float* h = meta ? (float*)(mb + M_H) : out + r0 * DM;
    bf16_t* yb = meta ? (bf16_t*)(mb + M_YB) : (bf16_t*)(ws + WS_YB);
    bf16_t* vt = meta ? (bf16_t*)(mb + M_VT) : (bf16_t*)(ws + WS_VT);
    bf16_t* act = meta ? (bf16_t*)(mb + M_ACT) : (bf16_t*)(ws + WS_Z);
    gm.M = meta ? 256 : RG;
    ep.i0 = 0; ep.p0 = nullptr; ep.p1 = nullptr; ep.p2 = nullptr;
    if (ph == 0) { gm.A = hb; gm.lda = DM; gm.Bt = (const bf16_t*)(wb + W_IN); gm.N = ZN; gm.K = DM; ep.mode = 0; ep.p0 = (unsigned char*)z; ep.p1 = (unsigned char*)ssq; ep.p2 = (unsigned char*)vt; ep.i0 = meta ? 256 : VTLD; }
    else if (ph == 4) { gm.A = z + 512; gm.lda = ZW; gm.Bt = (const bf16_t*)(wb + W_GLU); gm.N = 256; gm.K = 256; ep.mode = 1; ep.p0 = (unsigned char*)z; }
    else if (ph == 5) {
        gm.N = DM; ep.p0 = (unsigned char*)z;
        if (sub == 0) { gm.A = yb; gm.lda = 512; gm.Bt = (const bf16_t*)(wb + W_UPB); gm.K = 512; ep.mode = 2; ep.i0 = 4096; }
        else if (sub == 1) { gm.A = z + 256; gm.lda = ZW; gm.Bt = (const bf16_t*)(wb + W_UPC); gm.K = 256; ep.mode = 3; ep.i0 = 5120; }
        else { gm.A = z; gm.lda = ZW; gm.Bt = (const bf16_t*)(wb + W_UPA); gm.K = 256; ep.mode = 3; ep.i0 = 3072; }
    }
    else if (ph == 6) { gm.A = z + 1024; gm.lda = ZW; gm.Bt = (const bf16_t*)(wb + W_O); gm.N = DM; gm.K = DM; ep.mode = 4; ep.p0 = (unsigned char*)h; ep.p1 = (unsigned char*)hb; ep.p2 = (unsigned char*)ssq; }
    else if (ph == 7) { gm.A = hb; gm.lda = DM; gm.Bt = (const bf16_t*)(wb + W_GU); gm.N = 2 * FFH; gm.K = DM; ep.mode = 5; ep.p0 = (unsigned char*)act; ep.p1 = (unsigned char*)ssq; }
    else { gm.A = act; gm.lda = FFH; gm.Bt = (const bf16_t*)(wb + W_DN); gm.N = DM; gm.K = FFH; ep.mode = 4; ep.p0 = (unsigned char*)h; ep.p1 = (unsigned char*)hb; ep.p2 = (unsigned char*)ssq; }
    return true;
}

__device__ __forceinline__ void prologue(int G) {
    const int tid_ = opaque_tid(); const int lane = tid_ & 63, gw = blockIdx.x * 8 + __builtin_amdgcn_readfirstlane(tid_ >> 6), NGW = G * 8;
    const Ctx X = make_ctx(((unsigned char*)KA(ws)));
    for (int row = gw; row < RMAIN + 256; row += NGW) {
        const bool ismeta = row >= RMAIN; const int mr = row - RMAIN;
        const float* src = ismeta ? (mr < 160 ? KAF(meta_tokens) + (size_t)(mr & 15) * DM : nullptr) : (row < 32768 ? KAF(x_prompt) + (size_t)row * DM : KAF(x_sample) + (size_t)(row - 32768) * DM);
        float* hd = ismeta ? X.mh + (size_t)mr * DM : ((float*)KA(out)) + (size_t)row * DM;
        bf16_t* hbd = ismeta ? X.mhb + (size_t)mr * DM : X.hb + (size_t)row * DM;
        float* sq = ismeta ? X.mssq + (size_t)mr * 4 : X.ssq + (size_t)row * 4;
        float ss = 0.f;
#pragma unroll
        for (int j = 0; j < 4; ++j) {
            f32x4 v = (f32x4){0.f, 0.f, 0.f, 0.f}; if (src) v = *(const f32x4*)(src + j * 256 + lane * 4);
            *(f32x4*)(hd + j * 256 + lane * 4) = v;
            *(u32x2*)(hbd + j * 256 + lane * 4) = (u32x2){pk2(v[0], v[1]), pk2(v[2], v[3])};
            ss += (v[0] * v[0] + v[1] * v[1]) + (v[2] * v[2] + v[3] * v[3]);
        }
        ss = wave_sum(ss);
        if (lane < 4) sq[lane] = lane == 0 ? ss : 0.f;
    }
}

__device__ __forceinline__ void mixer_phase_A(int l, int g, LAS unsigned char* lds, int G, int bid) {
    const int tid_ = opaque_tid(); const int lane = tid_ & 63, wave = __builtin_amdgcn_readfirstlane(tid_ >> 6);
    const Ctx X = make_ctx(((unsigned char*)KA(ws))); const Grp gp = make_grp(g);
    const float* rpb = KAF(rpb) + (size_t)l * 8 * 15 * 31; const float* s5d = KAF(s5_d) + l * 256;
    const int nna = gp.nseq * (gp.Lr / 16), nmq = gp.nseq, nct = gp.nseq * (gp.nch - 1);
    const int ntask = nna + nmq + 2 * nct;
    const bool xmap = (nna % 256 == 0) && ((volatile LAS unsigned*)(lds + LDS_ST_OFF))[4] != 0u;
    if (xmap) {
        const int xcc = (int)((volatile LAS unsigned*)(lds + LDS_ST_OFF))[2], xrk = (int)((volatile LAS unsigned*)(lds + LDS_ST_OFF))[3];
        const int per = gp.Lr / 16, nx = nna / 8, rounds = nna / 256;
        for (int i = 0; i < rounds; ++i) { const int t = xcc * nx + xrk + 32 * i; na_task(X, rpb, gp, t / per, t % per, false, wave, lane, lds + wave * 9216); }
    }
    for (int t = bid + (xmap ? nna : 0); t < ntask; t += G) {
        __syncthreads();
        if (t < nna) { const int per = gp.Lr / 16; na_task(X, rpb, gp, t / per, t % per, false, wave, lane, lds + wave * 9216); }
        else if (t < nna + nmq) { na_task(X, rpb, gp, t - nna, 0, true, wave, lane, lds + wave * 9216); }
        else {
            const int u = t - nna - nmq; const bool isS5 = u < nct; const int v = isS5 ? u : u - nct;
            const int sl = v / (gp.nch - 1), c1 = v % (gp.nch - 1) + 1;
            for (int c = (c1 == 1 ? 0 : c1); c <= c1; ++c) {
                __syncthreads();
                const int ci = sl * gp.nch + c; const int T = c == 0 ? 16 : 64;
                bf16_t* zc = c == 0 ? X.mz + (size_t)((gp.s0 + sl) * 16) * ZW : X.z + ((size_t)sl * gp.Lr + 64 * (c - 1)) * ZW;
                if (isS5) s5_chunk<false>(X, s5d, (LAS float*)(lds + wave * 16896), zc, T, ci, wave, lane);
                else hg_chunk<false>(X, (LAS float*)(lds + wave * 8192), (LAS bf16_t*)(lds + 65536 + wave * 8192), zc, T, ci, wave, lane);
            }
        }
    }
}

__device__ __forceinline__ void mixer_phase_C(int l, int g, LAS unsigned char* lds, int G, int bid) {
    const int tid_ = opaque_tid(); const int lane = tid_ & 63, wave = __builtin_amdgcn_readfirstlane(tid_ >> 6);
    const Ctx X = make_ctx(((unsigned char*)KA(ws))); const Grp gp = make_grp(g);
    const float* s5d = KAF(s5_d) + l * 256; const float* ong = KAF(onorm_g) + l * 64;
    const int nct = gp.nseq * (gp.nch - 1);
    for (int t = bid; t < 2 * nct; t += G) {
        const bool isS5 = t < nct; const int v = isS5 ? t : t - nct;
        const int sl = v / (gp.nch - 1), c1 = v % (gp.nch - 1) + 1;
        for (int c = (c1 == 1 ? 0 : c1); c <= c1; ++c) {
            __syncthreads();
            const int ci = sl * gp.nch + c; const int T = c == 0 ? 16 : 64;
            bf16_t* zc = c == 0 ? X.mz + (size_t)((gp.s0 + sl) * 16) * ZW : X.z + ((size_t)sl * gp.Lr + 64 * (c - 1)) * ZW;
            if (isS5) s5_chunk<true>(X, s5d, (LAS float*)(lds + wave * 16896), zc, T, ci, wave, lane);
            else {
                hg_chunk<true>(X, (LAS float*)(lds + wave * 8192), (LAS bf16_t*)(lds + 65536 + wave * 8192), zc, T, ci, wave, lane);
                __syncthreads();
                const int h = wave >> 1, half = wave & 1;
                const LAS bf16_t* of = (const LAS bf16_t*)(lds + 65536 + (2 * h) * 8192); const LAS bf16_t* ob = (const LAS bf16_t*)(lds + 65536 + (2 * h + 1) * 8192);
                const float gn = ong[lane];
                const int tt0 = half * (T / 2);
                float gov[32];
#pragma unroll
                for (int i = 0; i < 32; ++i) { gov[i] = 0.f; if (i < T / 2) gov[i] = bf2f(zc[(size_t)(tt0 + i) * ZW + 2816 + h * 64 + lane]); }
#pragma unroll
                for (int i = 0; i < 32; ++i) {
                    if (i < T / 2) {
                        const int tt = tt0 + i;
                        const float o = bf2f(of[tt * 64 + lane]) + bf2f(ob[tt * 64 + lane]);
                        const float ms = wave_sum(o * o) * (1.0f / 64.0f);
                        const float go = gov[i];
                        zc[(size_t)tt * ZW + 256 + h * 64 + lane] = (bf16_t)f2bf(o * rsqrtf(ms + 1e-6f) * gn * (go * sigm(go)));
                    }
                }
            }
        }
    }
}

__global__ void __launch_bounds__(512, 2) fwd_kernel(Args a) {
    extern __shared__ __attribute__((aligned(16))) unsigned char lds_raw[];
    LAS unsigned char* lds = (LAS unsigned char*)lds_raw;
    const int G = gridDim.x, bid = blockIdx.x;

    if (threadIdx.x < 2) ((volatile LAS unsigned*)(lds + LDS_ST_OFF))[threadIdx.x] = 0u;
    if (threadIdx.x == 0) { const unsigned xc = xb_xcc_id(); const unsigned rk = xb_add((unsigned*)(KA(ws) + WS_CTL) + XB_XCNT(xc), 1u);
        ((volatile LAS unsigned*)(lds + LDS_ST_OFF))[2] = xc; ((volatile LAS unsigned*)(lds + LDS_ST_OFF))[3] = rk; }
    __syncthreads();
    prologue(G);

    for (int l = 0; l < NLAYER; ++l) {
        __syncthreads();
        { const Ctx X = make_ctx(((unsigned char*)KA(ws))); prep_layer(X, l, lds, G); }
        if (l == 0) { asm volatile("s_waitcnt vmcnt(0)" ::: "memory"); __syncthreads(); cg::this_grid().sync(); }
        GRID_SYNC();
        if (l == 0) {
            if (threadIdx.x == 0) { unsigned* bar = (unsigned*)(KA(ws) + WS_CTL); bool ok = (G == 256);
                for (int j = 0; j < 16; ++j) { const unsigned c = xb_ld(&bar[XB_XCNT(j)]); ok = ok && (c == (j < 8 ? 32u : 0u)); }
                ((volatile LAS unsigned*)(lds + LDS_ST_OFF))[4] = ok ? 1u : 0u; }
            __syncthreads();
        }
        for (int g = 0; g < 4; ++g) {
            for (int ph = 0; ph < 9; ++ph) {
                if (ph == 1) mixer_phase_A(l, g, lds, G, bid);
                else if (ph == 2) { const Ctx X = make_ctx(((unsigned char*)KA(ws))); const Grp gp = make_grp(g); const int gtid = bid * 512 + opaque_tid(), GT = G * 512; s5_passB(X, gp, gtid, GT); hg_passB(X, gp, GT - 1 - gtid, GT); }
                else if (ph == 3) mixer_phase_C(l, g, lds, G, bid);
                else {
                    for (int j = 0; j < 6; ++j) {
                        pg8::Gemm gm; pg8::UberEpi ep;
                        if (!make_job(((unsigned char*)KA(ws)), ((float*)KA(out)), l, g, ph, j, gm, ep)) break;
                        pg8::StaticOrder SO; SO.init(gm.M, gm.N, G, bid);
                        pg8::gemm_phase(lds, gm, SO, ep);
                    }
                }
                GRID_SYNC();
            }
        }
    }
    {
        const float* ssq = (const float*)(((unsigned char*)KA(ws)) + WS_SSQ);
        const int tid_ = opaque_tid(); const int lane = tid_ & 63, wave = __builtin_amdgcn_readfirstlane(tid_ >> 6);
        for (int row = bid * 8 + wave; row < RMAIN; row += G * 8) {
            const float rs = pg8::row_rstd(ssq, row);
            float* hp = ((float*)KA(out)) + (size_t)row * DM;
#pragma unroll
            for (int j = 0; j < 4; ++j) {
                f32x4 v = *(const f32x4*)(hp + j * 256 + lane * 4); const f32x4 gv = *(const f32x4*)(KAF(final_g) + j * 256 + lane * 4);
                v = v * rs * gv; *(f32x4*)(hp + j * 256 + lane * 4) = v;
            }
        }
    }
}

extern "C" void kernel_launch(void* const* d_in, const int* in_sizes, int n_in, void* d_out, int out_size, void* d_ws, size_t ws_size, hipStream_t stream) {
    static int grid = 0;
    if (grid == 0) {
        int dev = 0, cus = 0, per_cu = 0;
        (void)hipGetDevice(&dev);
        (void)hipDeviceGetAttribute(&cus, hipDeviceAttributeMultiprocessorCount, dev);
        (void)hipFuncSetAttribute((const void*)fwd_kernel, hipFuncAttributeMaxDynamicSharedMemorySize, LDS_BYTES);
        (void)hipOccupancyMaxActiveBlocksPerMultiprocessor(&per_cu, (const void*)fwd_kernel, 512, LDS_BYTES);
        (void)hipGetLastError();
        if (ws_size < WS_TOTAL) fprintf(stderr, "kernel_launch: workspace too small: %zu < %zu\n", ws_size, (size_t)WS_TOTAL);
        grid = cus > 0 ? cus : 256;
    }
    (void)hipMemsetAsync((char*)d_ws + WS_CTL, 0, CTL_BYTES, stream);
    Args a{};
    const float** pp = (const float**)&a;
    for (int i = 0; i < 26; ++i) pp[i] = (const float*)d_in[i];
    a.out = (float*)d_out; a.ws = (unsigned char*)d_ws;
    void* args[] = {&a};
    hipError_t e = hipLaunchCooperativeKernel((const void*)fwd_kernel, dim3(grid), dim3(512), args, LDS_BYTES, stream);
    if (e != hipSuccess) fprintf(stderr, "cooperative launch failed: %s\n", hipGetErrorString(e));
}
```

```cpp
#include <hip/hip_runtime.h>
#include <hip/hip_cooperative_groups.h>
#include <cstdio>
#include <cstdint>
namespace cg = cooperative_groups;

#define LAS __attribute__((address_space(3)))
typedef unsigned short bf16_t;
typedef short bf16x8 __attribute__((ext_vector_type(8)));
typedef float f32x4 __attribute__((ext_vector_type(4)));
typedef unsigned u32x4 __attribute__((ext_vector_type(4)));
typedef unsigned u32x2 __attribute__((ext_vector_type(2)));

#define WAVE_SYNC() asm volatile("s_waitcnt lgkmcnt(0)" ::: "memory")
__device__ __forceinline__ int opaque_tid() { int t = threadIdx.x; asm volatile("" : "+v"(t)); return t; }

__device__ __forceinline__ unsigned f2bf(float f) { unsigned u = __builtin_bit_cast(unsigned, f); return (u + 0x7fffu + ((u >> 16) & 1u)) >> 16; }
__device__ __forceinline__ unsigned pk2(float lo, float hi) { return f2bf(lo) | (f2bf(hi) << 16); }
__device__ __forceinline__ float bf2f(bf16_t b) { return __builtin_bit_cast(float, (unsigned)b << 16); }
__device__ __forceinline__ float bflo(unsigned w) { return __builtin_bit_cast(float, w << 16); }
__device__ __forceinline__ float bfhi(unsigned w) { return __builtin_bit_cast(float, w & 0xffff0000u); }
__device__ __forceinline__ float sigm(float x) { return 1.f / (1.f + __expf(-x)); }
__device__ __forceinline__ float gelu_tanh(float y) { const float a = 0.7978845608028654f * (y + 0.044715f * y * y * y); const float th = 1.f - 2.f / (__expf(2.f * a) + 1.f); return 0.5f * y * (1.f + th); }
__device__ __forceinline__ u32x4 pack8(f32x4 a, f32x4 b) { u32x4 w; w.x = pk2(a[0], a[1]); w.y = pk2(a[2], a[3]); w.z = pk2(b[0], b[1]); w.w = pk2(b[2], b[3]); return w; }
__device__ __forceinline__ float wave_sum(float v) {
#pragma unroll
    for (int o = 1; o < 64; o <<= 1) v += __shfl_xor(v, o);
    return v;
}

namespace pg8 {
constexpr int ZSTR = 6208;
constexpr int BM = 256, BK = 64, HALF = 128, HTB = HALF * BK * 2, STAGE_BYTES = 8 * HTB, NXCD = 8, WGM = 8;
__host__ __device__ __forceinline__ int lds_byte(int r, int c) { const int st = (r >> 4) * 2 + (c >> 5), rr = r & 15, cc = c & 31, ob = rr * 64 + cc * 2; return st * 1024 + (ob ^ (((ob >> 9) & 1) << 5)); }
__host__ __device__ __forceinline__ void stage_rc(int b, int& R, int& C) { const int st = b / 1024, sb = b % 1024, swz = sb ^ (((sb >> 9) & 1) << 5); R = (st >> 1) * 16 + swz / 64; C = (st & 1) * 32 + (swz % 64) / 2; }
__host__ __device__ __forceinline__ int perm32(int rho) { const int n = rho >> 4, i = rho & 15; return 8 * (i >> 2) + 4 * n + (i & 3); }
struct Unit { int pm, pn; };
struct Gemm { const bf16_t* A; int lda; const bf16_t* Bt; int M, N, K; };
struct StaticOrder {
    int nM, nN, nwg, G, c;
    __device__ void init(int M, int N, int G_, int c_) { nM = M / BM; nN = N / BM; nwg = nM * nN; G = G_; c = c_; }
    __device__ bool next(int i, Unit& u) const {
        const long L = (long)i * G + c; if (L >= nwg) return false;
        int wgid = (int)L; { const int q = nwg / NXCD, r = nwg % NXCD, xcd = wgid % NXCD, off = wgid / NXCD; wgid = (xcd < r ? xcd * (q + 1) : r * (q + 1) + (xcd - r) * q) + off; }
        const int nig = WGM * nN, gid = wgid / nig, fm = gid * WGM, gsz = (nM - fm) < WGM ? (nM - fm) : WGM;
        u.pm = fm + ((wgid % nig) % gsz); u.pn = (wgid % nig) / gsz; return true;
    }
};

struct UberEpi;
__device__ __forceinline__ void run_epi(const UberEpi& E, LAS unsigned char* lds, const f32x4 (&acc)[2][2][4][2], const Unit& u, int wr, int wc, int fr, int fq);
__device__ __forceinline__ void gemm_phase(LAS unsigned char* lds, const Gemm g, const StaticOrder& S, const UberEpi& E) {
    const int tid = opaque_tid(), wid = __builtin_amdgcn_readfirstlane(tid >> 6), lane = tid & 63, wr = wid >> 2, wc = wid & 3, fr = lane & 15, fq = lane >> 4;
    const int K = g.K, nt = K / BK, lda = g.lda;
    unsigned voffA[2], voffB[2];
#pragma unroll
    for (int i = 0; i < 2; ++i) { int R, C; stage_rc(tid * 16 + i * 8192, R, C); const int Rb = (R & ~31) + perm32(R & 31);
        voffA[i] = (unsigned)(R * lda + C) * 2u; voffB[i] = (unsigned)(Rb * K + C) * 2u; }
    const size_t kstep = (size_t)(BK * 2);
    const size_t hstepA = (size_t)HALF * lda * 2, hstepB = (size_t)HALF * K * 2;
    const size_t tstepA = 2 * hstepA, tstepB = 2 * hstepB;
    const unsigned ldsw = (unsigned)wid * 1024u;
    const int aoff = lds_byte(wr * 64 + fr, fq * 8), boff = lds_byte(wc * 32 + fr, fq * 8);
#define PG8_SA(b, h) (((b) * 2 + (h)) * HTB)
#define PG8_SB(b, h) ((4 + (b) * 2 + (h)) * HTB)
#define PG8_STAGE(bufoff, gbase, voff) do { _Pragma("unroll") for (int _i = 0; _i < 2; ++_i) \
        __builtin_amdgcn_global_load_lds((const unsigned*)((const char*)(gbase) + (voff)[_i]), (LAS unsigned*)(lds + (bufoff) + ldsw + _i * 8192), 16, 0, 0); } while (0)
#define PG8_LDA(dst, b, h) do { _Pragma("unroll") for (int m = 0; m < 4; ++m) _Pragma("unroll") for (int k = 0; k < 2; ++k) dst[m][k] = *(const LAS bf16x8*)(lds + PG8_SA(b, h) + aoff + m * 2048 + k * 1024); } while (0)
#define PG8_LDB(dst, b, h) do { _Pragma("unroll") for (int n = 0; n < 2; ++n) _Pragma("unroll") for (int k = 0; k < 2; ++k) dst[n][k] = *(const LAS bf16x8*)(lds + PG8_SB(b, h) + boff + n * 2048 + k * 1024); } while (0)
#define PG8_MMA(ai, bj, At, Bt) do { __builtin_amdgcn_s_setprio(1); _Pragma("unroll") for (int m = 0; m < 4; ++m) _Pragma("unroll") for (int n = 0; n < 2; ++n) _Pragma("unroll") for (int k = 0; k < 2; ++k) \
        acc[ai][bj][m][n] = __builtin_amdgcn_mfma_f32_16x16x32_bf16(Bt[n][k], At[m][k], acc[ai][bj][m][n], 0, 0, 0); __builtin_amdgcn_s_setprio(0); } while (0)
#define PG8_WAIT_V(n) asm volatile("s_waitcnt vmcnt(" #n ")" ::: "memory")
#define PG8_WAIT_L(n) asm volatile("s_waitcnt lgkmcnt(" #n ")" ::: "memory")
#define PG8_BAR __builtin_amdgcn_s_barrier()
#define PG8_SCHED __builtin_amdgcn_sched_barrier(0)
    Unit cur, nxt; int ui = 0;
    if (!S.next(0, cur)) return;
    f32x4 acc[2][2][4][2];
#pragma unroll
    for (int a = 0; a < 2; ++a)
#pragma unroll
        for (int b = 0; b < 2; ++b)
#pragma unroll
            for (int m = 0; m < 4; ++m)
#pragma unroll
                for (int n = 0; n < 2; ++n) acc[a][b][m][n] = (f32x4){0.f, 0.f, 0.f, 0.f};
    bf16x8 At[4][2], B0[2][2], B1[2][2];
    const char* cA = (const char*)g.A + (size_t)cur.pm * tstepA; const char* cB = (const char*)g.Bt + (size_t)cur.pn * tstepB;
    PG8_STAGE(PG8_SB(0, 0), cB, voffB); PG8_STAGE(PG8_SB(0, 1), cB + hstepB, voffB); PG8_STAGE(PG8_SA(0, 0), cA, voffA); PG8_STAGE(PG8_SA(0, 1), cA + hstepA, voffA);
    if (wr == 1) PG8_BAR;
    PG8_WAIT_V(2); PG8_BAR;
    PG8_STAGE(PG8_SB(1, 0), cB + kstep, voffB); PG8_STAGE(PG8_SA(1, 0), cA + kstep, voffA); PG8_STAGE(PG8_SB(1, 1), cB + hstepB + kstep, voffB);
    PG8_WAIT_V(6); PG8_BAR;
    for (;;) {
        const bool has_next = S.next(ui + 1, nxt);
        const char* nA = has_next ? (const char*)g.A + (size_t)nxt.pm * tstepA : cA; const char* nB = has_next ? (const char*)g.Bt + (size_t)nxt.pn * tstepB : cB;
        for (int t = 0; t < nt; t += 2) {
            const bool last = (t == nt - 2);
            const char* a1 = cA + (size_t)(t + 1) * kstep;
            const char* a2 = last ? nA : cA + (size_t)(t + 2) * kstep; const char* b2 = last ? nB : cB + (size_t)(t + 2) * kstep;
            const char* a3 = a2 + kstep; const char* b3 = b2 + kstep;
            PG8_LDB(B0, 0, 0); PG8_LDB(B1, 0, 1); PG8_SCHED; PG8_LDA(At, 0, 0); PG8_STAGE(PG8_SA(1, 1), a1 + hstepA, voffA);
            PG8_WAIT_V(8); PG8_WAIT_L(0); PG8_BAR; PG8_MMA(0, 0, At, B0); PG8_MMA(0, 1, At, B1); PG8_BAR; PG8_SCHED;
            PG8_LDA(At, 0, 1); PG8_STAGE(PG8_SB(0, 0), b2, voffB); PG8_STAGE(PG8_SB(0, 1), b2 + hstepB, voffB); PG8_STAGE(PG8_SA(0, 0), a2, voffA);
            PG8_WAIT_V(8); PG8_WAIT_L(0); PG8_BAR; PG8_MMA(1, 0, At, B0); PG8_MMA(1, 1, At, B1); PG8_BAR; PG8_SCHED;
            PG8_LDB(B0, 1, 0); PG8_LDB(B1, 1, 1); PG8_SCHED; PG8_LDA(At, 1, 0); PG8_STAGE(PG8_SA(0, 1), a2 + hstepA, voffA);
            PG8_WAIT_V(8); PG8_WAIT_L(0); PG8_BAR; PG8_MMA(0, 0, At, B0); PG8_MMA(0, 1, At, B1); PG8_BAR; PG8_SCHED;
            PG8_LDA(At, 1, 1); PG8_STAGE(PG8_SB(1, 0), b3, voffB); PG8_STAGE(PG8_SB(1, 1), b3 + hstepB, voffB); PG8_STAGE(PG8_SA(1, 0), a3, voffA);
            PG8_WAIT_V(8); PG8_WAIT_L(0); PG8_BAR; PG8_MMA(1, 0, At, B0); PG8_MMA(1, 1, At, B1); PG8_BAR; PG8_SCHED;
        }
        if (wr == 0) PG8_BAR;
        run_epi(E, lds, acc, cur, wr, wc, fr, fq);
        if (!has_next) break;
#pragma unroll
        for (int a = 0; a < 2; ++a)
#pragma unroll
            for (int b = 0; b < 2; ++b)
#pragma unroll
                for (int m = 0; m < 4; ++m)
#pragma unroll
                    for (int n = 0; n < 2; ++n) acc[a][b][m][n] = (f32x4){0.f, 0.f, 0.f, 0.f};
        cur = nxt; cA = nA; cB = nB; ++ui;
        if (wr == 1) PG8_BAR;
    }
    PG8_WAIT_V(0);
    PG8_BAR;
#undef PG8_SA
#undef PG8_SB
#undef PG8_STAGE
#undef PG8_LDA
#undef PG8_LDB
#undef PG8_MMA
#undef PG8_WAIT_V
#undef PG8_WAIT_L
#undef PG8_BAR
#undef PG8_SCHED
}

__device__ __forceinline__ float row_rstd(const float* ssq, int row) {
    const f32x4 s0 = *(const f32x4*)(ssq + (size_t)row * 4);
    const float ss = (s0[0] + s0[1]) + (s0[2] + s0[3]);
    return rsqrtf(ss * (1.0f / 1024.0f) + 1e-6f);
}
struct EpiZ {
    bf16_t* z; const float* ssq; bf16_t* vt; int vt_ld;
    __device__ __forceinline__ void operator()(const f32x4 (&acc)[2][2][4][2], const Unit& u, int wr, int wc, int fr, int fq) const {
        const int row0 = u.pm * BM + wr * 64 + fr, col0 = u.pn * BM + wc * 32 + 8 * fq;
#pragma unroll
        for (int ai = 0; ai < 2; ++ai)
#pragma unroll
            for (int m = 0; m < 4; ++m) {
                const int row = row0 + ai * HALF + m * 16; const float rs = row_rstd(ssq, row);
#pragma unroll
                for (int bj = 0; bj < 2; ++bj) {
                    const u32x4 w = pack8(acc[ai][bj][m][0] * rs, acc[ai][bj][m][1] * rs);
                    *(u32x4*)(z + (size_t)row * ZSTR + col0 + bj * HALF) = w;
                }
            }
    }
};
struct EpiGlu {
    bf16_t* z;
    __device__ __forceinline__ void operator()(const f32x4 (&acc)[2][2][4][2], const Unit& u, int wr, int wc, int fr, int fq) const {
        const int row0 = u.pm * BM + wr * 64 + fr, col0 = wc * 32 + 8 * fq;
#pragma unroll
        for (int ai = 0; ai < 2; ++ai) {
            u32x4 yv[4][2];
#pragma unroll
            for (int m = 0; m < 4; ++m)
#pragma unroll
                for (int bj = 0; bj < 2; ++bj) yv[m][bj] = *(const u32x4*)(z + (size_t)(row0 + ai * HALF + m * 16) * ZSTR + col0 + bj * HALF + 512);
#pragma unroll
            for (int m = 0; m < 4; ++m) {
                const int row = row0 + ai * HALF + m * 16;
#pragma unroll
                for (int bj = 0; bj < 2; ++bj) {
                    bf16_t* zp = z + (size_t)row * ZSTR + col0 + bj * HALF;
                    const u32x4 y = yv[m][bj];
                    const f32x4 a0 = acc[ai][bj][m][0], a1 = acc[ai][bj][m][1];
                    f32x4 o0, o1;
                    o0[0] = bflo(y.x) * sigm(a0[0]); o0[1] = bfhi(y.x) * sigm(a0[1]); o0[2] = bflo(y.y) * sigm(a0[2]); o0[3] = bfhi(y.y) * sigm(a0[3]);
                    o1[0] = bflo(y.z) * sigm(a1[0]); o1[1] = bfhi(y.z) * sigm(a1[1]); o1[2] = bflo(y.w) * sigm(a1[2]); o1[3] = bfhi(y.w) * sigm(a1[3]);
                    *(u32x4*)zp = pack8(o0, o1);
                }
            }
        }
    }
};
template <int MODE> struct EpiMix {
    bf16_t* z; int goff;
    __device__ __forceinline__ void operator()(const f32x4 (&acc)[2][2][4][2], const Unit& u, int wr, int wc, int fr, int fq) const {
        const int row0 = u.pm * BM + wr * 64 + fr, col0 = u.pn * BM + wc * 32 + 8 * fq;
#pragma unroll
        for (int ai = 0; ai < 2; ++ai)
#pragma unroll
            for (int mp = 0; mp < 2; ++mp) {
                u32x4 gv[2][2], pv[2][2];
#pragma unroll
                for (int mm = 0; mm < 2; ++mm)
#pragma unroll
                    for (int bj = 0; bj < 2; ++bj) { const bf16_t* zr = z + (size_t)(row0 + ai * HALF + (mp * 2 + mm) * 16) * ZSTR + col0 + bj * HALF;
                        gv[mm][bj] = *(const u32x4*)(zr + goff); if (MODE == 1) pv[mm][bj] = *(const u32x4*)(zr + 1024); }
#pragma unroll
                for (int mm = 0; mm < 2; ++mm) {
                    const int m = mp * 2 + mm; const int row = row0 + ai * HALF + m * 16;
#pragma unroll
                    for (int bj = 0; bj < 2; ++bj) {
                        bf16_t* zr = z + (size_t)row * ZSTR + col0 + bj * HALF;
                        const u32x4 gq = gv[mm][bj];
                        const f32x4 a0 = acc[ai][bj][m][0], a1 = acc[ai][bj][m][1];
                        f32x4 o0, o1;
                        o0[0] = sigm(bflo(gq.x)) * a0[0]; o0[1] = sigm(bfhi(gq.x)) * a0[1]; o0[2] = sigm(bflo(gq.y)) * a0[2]; o0[3] = sigm(bfhi(gq.y)) * a0[3];
                        o1[0] = sigm(bflo(gq.z)) * a1[0]; o1[1] = sigm(bfhi(gq.z)) * a1[1]; o1[2] = sigm(bflo(gq.w)) * a1[2]; o1[3] = sigm(bfhi(gq.w)) * a1[3];
                        if (MODE == 1) { const u32x4 p = pv[mm][bj];
                            o0[0] += bflo(p.x); o0[1] += bfhi(p.x); o0[2] += bflo(p.y); o0[3] += bfhi(p.y); o1[0] += bflo(p.z); o1[1] += bfhi(p.z); o1[2] += bflo(p.w); o1[3] += bfhi(p.w); }
                        *(u32x4*)(zr + 1024) = pack8(o0, o1);
                    }
                }
            }
    }
};
struct EpiRes {
    float* h; bf16_t* hb; float* ssq; LAS float* red;
    __device__ __forceinline__ void operator()(const f32x4 (&acc)[2][2][4][2], const Unit& u, int wr, int wc, int fr, int fq) const {
        const int row0 = u.pm * BM + wr * 64 + fr, col0 = u.pn * BM + wc * 32 + 8 * fq;
#pragma unroll
        for (int ai = 0; ai < 2; ++ai)
#pragma unroll
            for (int mp = 0; mp < 2; ++mp) {
                f32x4 hv[2][2][2];
#pragma unroll
                for (int mm = 0; mm < 2; ++mm)
#pragma unroll
                    for (int bj = 0; bj < 2; ++bj) { const float* hp = h + (size_t)(row0 + ai * HALF + (mp * 2 + mm) * 16) * 1024 + col0 + bj * HALF; hv[mm][bj][0] = *(const f32x4*)hp; hv[mm][bj][1] = *(const f32x4*)(hp + 4); }
#pragma unroll
                for (int mm = 0; mm < 2; ++mm) {
                    const int m = mp * 2 + mm; const int row = row0 + ai * HALF + m * 16; float part = 0.f;
#pragma unroll
                    for (int bj = 0; bj < 2; ++bj) {
                        float* hp = h + (size_t)row * 1024 + col0 + bj * HALF;
                        const f32x4 h0 = hv[mm][bj][0] + acc[ai][bj][m][0], h1 = hv[mm][bj][1] + acc[ai][bj][m][1];
                        *(f32x4*)hp = h0; *(f32x4*)(hp + 4) = h1;
                        part += (h0[0] * h0[0] + h0[1] * h0[1]) + (h0[2] * h0[2] + h0[3] * h0[3]) + (h1[0] * h1[0] + h1[1] * h1[1]) + (h1[2] * h1[2] + h1[3] * h1[3]);
                        *(u32x4*)(hb + (size_t)row * 1024 + col0 + bj * HALF) = pack8(h0, h1);
                    }
                    part += __shfl_xor(part, 16); part += __shfl_xor(part, 32);
                    if (fq == 0) red[(ai * HALF + wr * 64 + m * 16 + fr) * 4 + wc] = part;
                }
            }
        asm volatile("s_waitcnt lgkmcnt(0)" ::: "memory");
        __builtin_amdgcn_s_barrier();
        asm volatile("" ::: "memory");
        { const int t_ = opaque_tid(); if (t_ < 256) { const f32x4 r4 = *(const LAS f32x4*)(red + t_ * 4); ssq[(size_t)(u.pm * BM + t_) * 4 + u.pn] = (r4[0] + r4[1]) + (r4[2] + r4[3]); } }
    }
};
struct EpiAct {
    bf16_t* act; const float* ssq;
    __device__ __forceinline__ void operator()(const f32x4 (&acc)[2][2][4][2], const Unit& u, int wr, int wc, int fr, int fq) const {
        const int row0 = u.pm * BM + wr * 64 + fr, col0 = u.pn * HALF + wc * 32 + 8 * fq;
#pragma unroll
        for (int ai = 0; ai < 2; ++ai)
#pragma unroll
            for (int m = 0; m < 4; ++m) {
                const int row = row0 + ai * HALF + m * 16; const float rs = row_rstd(ssq, row);
                f32x4 o[2];
#pragma unroll
                for (int n = 0; n < 2; ++n)
#pragma unroll
                    for (int i = 0; i < 4; ++i) { const float gg = acc[ai][0][m][n][i] * rs, uu = acc[ai][1][m][n][i] * rs; o[n][i] = gg * sigm(gg) * uu; }
                *(u32x4*)(act + (size_t)row * 2816 + col0) = pack8(o[0], o[1]);
            }
    }
};
struct UberEpi { int mode, i0; unsigned char *p0, *p1, *p2; };
__device__ __forceinline__ void run_epi(const UberEpi& E, LAS unsigned char* lds, const f32x4 (&acc)[2][2][4][2], const Unit& u, int wr, int wc, int fr, int fq) {
    switch (E.mode) {
        case 0: { EpiZ e{(bf16_t*)E.p0, (const float*)E.p1, (bf16_t*)E.p2, E.i0}; e(acc, u, wr, wc, fr, fq); break; }
        case 1: { EpiGlu e{(bf16_t*)E.p0}; e(acc, u, wr, wc, fr, fq); break; }
        case 2: { EpiMix<0> e{(bf16_t*)E.p0, E.i0}; e(acc, u, wr, wc, fr, fq); break; }
        case 3: { EpiMix<1> e{(bf16_t*)E.p0, E.i0}; e(acc, u, wr, wc, fr, fq); break; }
        case 4: { EpiRes e{(float*)E.p0, (bf16_t*)E.p1, (float*)E.p2, (LAS float*)(lds + 131072)}; e(acc, u, wr, wc, fr, fq); break; }
        default: { EpiAct e{(bf16_t*)E.p0, (const float*)E.p1}; e(acc, u, wr, wc, fr, fq); break; }
    }
}
}

constexpr int NLAYER = 4, DM = 1024, ZN = 6144, ZW = 6208  , FFH = 2816, RG = 16384, RMAIN = 65536, VTLD = RG + 64  ;
constexpr size_t al256(size_t x) { return (x + 255) & ~(size_t)255; }
constexpr size_t WS_HB = 0;
constexpr size_t WS_SSQ = WS_HB + (size_t)RMAIN * DM * 2;
constexpr size_t WS_Z = WS_SSQ + (size_t)RMAIN * 4 * 4;
constexpr size_t WS_YB = WS_Z + (size_t)RG * ZW * 2;
constexpr size_t WS_VT = WS_YB + (size_t)RG * 512 * 2;
constexpr size_t WS_HGU = WS_VT + (size_t)512 * VTLD * 2;
constexpr size_t WS_HGP = WS_HGU + (size_t)260 * 8 * 4096 * 4;
constexpr size_t WS_S5S = WS_HGP + (size_t)260 * 8 * 64 * 4;
constexpr size_t WS_W = WS_S5S + (size_t)260 * 2048 * 8;
constexpr size_t W_IN = 0, W_UPA = W_IN + (size_t)6144 * 1024 * 2, W_UPB = W_UPA + (size_t)1024 * 256 * 2, W_UPC = W_UPB + (size_t)1024 * 512 * 2,
                 W_O = W_UPC + (size_t)1024 * 256 * 2, W_GU = W_O + (size_t)1024 * 1024 * 2, W_DN = W_GU + (size_t)5632 * 1024 * 2, W_GLU = W_DN + (size_t)1024 * 2816 * 2,
                 W_END = W_GLU + (size_t)256 * 256 * 2;
constexpr size_t WS_TAB = WS_W + W_END;
constexpr size_t T_LBAR = 0, T_L16 = T_LBAR + 2048 * 8, T_L64 = T_L16 + 2048 * 8, T_BFRAG = T_L64 + 2048 * 8, T_CFRAG = T_BFRAG + (size_t)32 * 8 * 64 * 16,
                 T_LB = T_CFRAG + (size_t)32 * 4 * 64 * 16, T_END = T_LB + 256 * 4;
constexpr size_t WS_META = al256(WS_TAB + T_END);
constexpr size_t M_H = 0, M_HB = M_H + (size_t)256 * 1024 * 4, M_SSQ = M_HB + (size_t)256 * 1024 * 2, M_Z = M_SSQ + (size_t)256 * 4 * 4, M_YB = M_Z + (size_t)256 * ZW * 2,
                 M_VT = M_YB + (size_t)256 * 512 * 2, M_ACT = M_VT + (size_t)512 * 256 * 2, M_END = M_ACT + (size_t)256 * FFH * 2;
constexpr size_t WS_CTL = al256(WS_META + M_END);
constexpr size_t CTL_BYTES = 16384;
constexpr size_t WS_TOTAL = WS_CTL + CTL_BYTES;
constexpr int LDS_ST_OFF = 135168;
constexpr int LDS_BYTES = 147456;

struct Args {
    const float *x_prompt, *x_sample, *meta_tokens, *norm1_g, *w_in, *a_re, *a_im, *log_dt, *b_re, *b_im, *c_re, *c_im, *s5_d, *w_glu, *rpb, *lb_logits, *onorm_g,
        *w_up_a, *w_up_b, *w_up_c, *w_o, *norm2_g, *w_gate, *w_up, *w_down, *final_g;
    float* out; unsigned char* ws;
};

__device__ __forceinline__ unsigned long long ufl(unsigned long long v) { const unsigned lo = __builtin_amdgcn_readfirstlane((unsigned)v), hi = __builtin_amdgcn_readfirstlane((unsigned)(v >> 32)); return ((unsigned long long)hi << 32) | lo; }
#define GAS __attribute__((address_space(1)))
template <int OFF> __device__ __forceinline__ unsigned long long ka_load() {
    unsigned long long v; const unsigned long long kp = ufl((unsigned long long)__builtin_amdgcn_kernarg_segment_ptr());
    asm volatile("s_load_dwordx2 %0, %1, %2\n\ts_waitcnt lgkmcnt(0)" : "=s"(v) : "s"(kp), "n"(OFF));
    return v;
}
#define KA(f) ((decltype(Args::f))(GAS char*)ka_load<(int)__builtin_offsetof(Args, f)>())
#define KAF(f) ((const float*)KA(f))
struct Ctx {
    bf16_t *hb, *z, *yb, *vt; float *ssq, *hgu, *hgp, *s5s;
    bf16_t *w; const float *lbar, *l16, *l64; const bf16_t *bfrag, *cfrag; const float* lb;
    float* mh; bf16_t *mhb, *mz, *myb, *mvt, *mact; float* mssq;
};

__device__ __forceinline__ void tr_item(const float* W, int K, int N, bf16_t* WT, const float* kscale, int mode, LAS float* scr, int item, int lane, bool valid) {
    const int nblk = N / 32, kb = item / nblk, nb = item % nblk, k0 = 64 * kb, n0 = 32 * nb;
    if (valid) {
#pragma unroll 8
    for (int i = 0; i < 32; ++i) { const int kk = 2 * i + (lane >> 5); float v = W[(size_t)(k0 + kk) * N + n0 + (lane & 31)]; if (kscale) v *= kscale[k0 + kk]; scr[kk * 33 + (lane & 31)] = v; }
    }
    __syncthreads();
    const int c = lane & 7;
    int drow0 = n0; if (mode) drow0 = (n0 >> 7) * 256 + (n0 & 127) + (mode == 2 ? 128 : 0);
    if (valid) {
#pragma unroll
    for (int j = 0; j < 4; ++j) { const int n = (lane >> 3) + 8 * j; const LAS float* s = scr + (8 * c) * 33 + n;
        u32x4 o; o.x = pk2(s[0 * 33], s[1 * 33]); o.y = pk2(s[2 * 33], s[3 * 33]); o.z = pk2(s[4 * 33], s[5 * 33]); o.w = pk2(s[6 * 33], s[7 * 33]);
        *(u32x4*)(WT + (size_t)(drow0 + n) * K + k0 + 8 * c) = o; }
    }
    __syncthreads();
}

__device__ __forceinline__ void prep_layer(const Ctx& X, int l, LAS unsigned char* lds, int G) {
    const int tid_ = opaque_tid(); const int wave = __builtin_amdgcn_readfirstlane(tid_ >> 6), lane = tid_ & 63;
    LAS float* scr = (LAS float*)(lds + wave * 16384);
    const int gw = blockIdx.x * 8 + wave, NGW = G * 8;
    constexpr int I0 = 16 * 192, I1 = 4 * 32, I2 = 8 * 32, I3 = 4 * 32, I4 = 16 * 32, I5 = 16 * 88, I6 = 16 * 88, I7 = 44 * 32, I8 = 4 * 8;
    constexpr int NIT = I0 + I1 + I2 + I3 + I4 + I5 + I6 + I7 + I8;
    unsigned char* wb = (unsigned char*)X.w;
    for (int it0 = 0; it0 < NIT; it0 += NGW) {
        const int it = it0 + gw; const bool valid = it < NIT;
        int r = valid ? it : 0;
        if (r < I0) { tr_item(KAF(w_in) + (size_t)l * 1024 * 6144, 1024, 6144, (bf16_t*)(wb + W_IN), KAF(norm1_g) + l * 1024, 0, scr, r, lane, valid); continue; } r -= I0;
        if (r < I1) { tr_item(KAF(w_up_a) + (size_t)l * 256 * 1024, 256, 1024, (bf16_t*)(wb + W_UPA), nullptr, 0, scr, r, lane, valid); continue; } r -= I1;
        if (r < I2) { tr_item(KAF(w_up_b) + (size_t)l * 512 * 1024, 512, 1024, (bf16_t*)(wb + W_UPB), nullptr, 0, scr, r, lane, valid); continue; } r -= I2;
        if (r < I3) { tr_item(KAF(w_up_c) + (size_t)l * 256 * 1024, 256, 1024, (bf16_t*)(wb + W_UPC), nullptr, 0, scr, r, lane, valid); continue; } r -= I3;
        if (r < I4) { tr_item(KAF(w_o) + (size_t)l * 1024 * 1024, 1024, 1024, (bf16_t*)(wb + W_O), nullptr, 0, scr, r, lane, valid); continue; } r -= I4;
        if (r < I5) { tr_item(KAF(w_gate) + (size_t)l * 1024 * 2816, 1024, 2816, (bf16_t*)(wb + W_GU), KAF(norm2_g) + l * 1024, 1, scr, r, lane, valid); continue; } r -= I5;
        if (r < I6) { tr_item(KAF(w_up) + (size_t)l * 1024 * 2816, 1024, 2816, (bf16_t*)(wb + W_GU), KAF(norm2_g) + l * 1024, 2, scr, r, lane, valid); continue; } r -= I6;
        if (r < I7) { tr_item(KAF(w_down) + (size_t)l * 2816 * 1024, 2816, 1024, (bf16_t*)(wb + W_DN), nullptr, 0, scr, r, lane, valid); continue; } r -= I7;
        tr_item(KAF(w_glu) + (size_t)l * 256 * 256, 256, 256, (bf16_t*)(wb + W_GLU), nullptr, 0, scr, r, lane, valid);
    }
    const int gt = blockIdx.x * 512 + tid_;
    if (gt < 2048) {
        const int dg = gt >> 6, p = gt & 63;
        const size_t pb = ((size_t)l * 32 + dg);
        const float are = KAF(a_re)[pb * 64 + p], aim = KAF(a_im)[pb * 64 + p], dt = expf(KAF(log_dt)[pb]);
        const float mag = expf(are * dt); float sn, cs; sincosf(aim * dt, &sn, &cs);
        const float lr = mag * cs, li = mag * sn;
        const float den = are * are + aim * aim, nr = lr - 1.0f, ni = li;
        const float zr = (nr * are + ni * aim) / den, zi = (ni * are - nr * aim) / den;
        float* lbar = (float*)X.lbar; float* l16 = (float*)X.l16; float* l64 = (float*)X.l64;
        lbar[gt * 2] = lr; lbar[gt * 2 + 1] = li;
        float pr = lr, pi = li;
#pragma unroll
        for (int s = 0; s < 4; ++s) { const float t = pr * pr - pi * pi; pi = 2.f * pr * pi; pr = t; }
        l16[gt * 2] = pr; l16[gt * 2 + 1] = pi;
#pragma unroll
        for (int s = 0; s < 2; ++s) { const float t = pr * pr - pi * pi; pi = 2.f * pr * pi; pr = t; }
        l64[gt * 2] = pr; l64[gt * 2 + 1] = pi;
        bf16_t* bfr = (bf16_t*)X.bfrag; bf16_t* cfr = (bf16_t*)X.cfrag;
        const int ntr = p >> 4, col = p & 15;
        for (int c = 0; c < 16; ++c) {
            const float br = KAF(b_re)[(pb * 64 + p) * 16 + c], bi = KAF(b_im)[(pb * 64 + p) * 16 + c];
            const float bbr = zr * br - zi * bi, bbi = zr * bi + zi * br;
            const int q = c >> 3, j = c & 7;
            bfr[(((size_t)dg * 8 + ntr) * 64 + col + 16 * q) * 8 + j] = (bf16_t)f2bf(bbr);
            bfr[(((size_t)dg * 8 + 4 + ntr) * 64 + col + 16 * q) * 8 + j] = (bf16_t)f2bf(bbi);
            bfr[(((size_t)dg * 8 + ntr) * 64 + col + 16 * (q + 2)) * 8 + j] = 0;
            bfr[(((size_t)dg * 8 + 4 + ntr) * 64 + col + 16 * (q + 2)) * 8 + j] = 0;
            const float cr = KAF(c_re)[(pb * 16 + c) * 64 + p], ci = KAF(c_im)[(pb * 16 + c) * 64 + p];
            { const int k = p;      cfr[(((size_t)dg * 4 + (k >> 5)) * 64 + c + 16 * ((k >> 3) & 3)) * 8 + (k & 7)] = (bf16_t)f2bf(cr); }
            { const int k = 64 + p; cfr[(((size_t)dg * 4 + (k >> 5)) * 64 + c + 16 * ((k >> 3) & 3)) * 8 + (k & 7)] = (bf16_t)f2bf(-ci); }
        }
    }
    if (gt >= 2048 && gt < 2048 + 256) {
        const int c = gt - 2048;
        const float l0 = KAF(lb_logits)[c], l1 = KAF(lb_logits)[256 + c], l2 = KAF(lb_logits)[512 + c], l3 = KAF(lb_logits)[768 + c];
        const float mx = fmaxf(fmaxf(l0, l1), fmaxf(l2, l3));
        const float e0 = expf(l0 - mx), e1 = expf(l1 - mx), e2 = expf(l2 - mx), e3 = expf(l3 - mx), inv = 1.f / (e0 + e1 + e2 + e3);
        float v = 0.f; if (l >= 1) v += e1 * inv; if (l >= 2) v += e2 * inv; if (l >= 3) v += e3 * inv;
        ((float*)X.lb)[c] = v;
    }
}

struct Grp { int g, nseq, Lr, nch, s0; };
__device__ __forceinline__ Grp make_grp(int g) { Grp r; r.g = g; r.nseq = g < 2 ? 4 : 1; r.Lr = g < 2 ? 4096 : 16384; r.nch = r.Lr / 64 + 1; r.s0 = g < 2 ? g * 4 : 8 + (g - 2); return r; }

template <bool OUT>
__device__ __forceinline__ void s5_chunk(const Ctx& X, const float* s5d, LAS float* buf, bf16_t* zc, int T, int ci, int wave, int lane) {
    const int p = lane, fr = lane & 15, fq = lane >> 4;
    for (int gi = 0; gi < 2; ++gi) {
        const int g = wave * 2 + gi;
        f32x4 yacc[2][2];
#pragma unroll
        for (int i = 0; i < 2; ++i)
#pragma unroll
            for (int j = 0; j < 2; ++j) yacc[i][j] = (f32x4){0.f, 0.f, 0.f, 0.f};
        bf16x8 ua[4];
#pragma unroll
        for (int m4 = 0; m4 < 4; ++m4) { ua[m4] = (bf16x8){0, 0, 0, 0, 0, 0, 0, 0}; if (fq < 2 && m4 * 16 < T) ua[m4] = *(const bf16x8*)(zc + (size_t)(m4 * 16 + fr) * ZW + g * 16 + fq * 8); }
#pragma unroll
        for (int dir = 0; dir < 2; ++dir) {
            const int dg = dir * 16 + g;
            bf16x8 bfr[8], cfr[4];
#pragma unroll
            for (int nt = 0; nt < 8; ++nt) bfr[nt] = *(const bf16x8*)(X.bfrag + (((size_t)dg * 8 + nt) * 64 + lane) * 8);
            if (OUT) {
#pragma unroll
                for (int ks = 0; ks < 4; ++ks) cfr[ks] = *(const bf16x8*)(X.cfrag + (((size_t)dg * 4 + ks) * 64 + lane) * 8);
            }
            const float lr = X.lbar[(dg * 64 + p) * 2], li = X.lbar[(dg * 64 + p) * 2 + 1];
            float xr = 0.f, xi = 0.f;
            float* st = X.s5s + ((size_t)ci * 2048 + dg * 64 + p) * 2;
            if (OUT) { xr = st[0]; xi = st[1]; }
#pragma unroll
            for (int sti = 0; sti < 2; ++sti) {
                const int stt = dir ? 1 - sti : sti; const int t0 = stt * 32;
                if (t0 < T) {
                    const int tn = (T - t0) < 32 ? (T - t0) : 32;
#pragma unroll
                    for (int mt = 0; mt < 2; ++mt) {
                        if (mt * 16 < tn) {
#pragma unroll
                            for (int nt = 0; nt < 8; ++nt) {
                                const f32x4 c = __builtin_amdgcn_mfma_f32_16x16x32_bf16(ua[stt * 2 + mt], bfr[nt], (f32x4){0.f, 0.f, 0.f, 0.f}, 0, 0, 0);
#pragma unroll
                                for (int r = 0; r < 4; ++r) buf[(mt * 16 + fq * 4 + r) * 132 + nt * 16 + fr] = c[r];
                            }
                        }
                    }
                    __syncthreads();
                    for (int k = 0; k < tn; ++k) {
                        const int t = dir ? (tn - 1 - k) : k;
                        const float br = buf[t * 132 + p], bi = buf[t * 132 + 64 + p];
                        const float nr = lr * xr - li * xi + br, ni = lr * xi + li * xr + bi;
                        xr = nr; xi = ni;
                        if (OUT) { buf[t * 132 + p] = xr; buf[t * 132 + 64 + p] = xi; }
                    }
                    if (OUT) {
                        __syncthreads();
#pragma unroll
                        for (int mt = 0; mt < 2; ++mt) {
                            if (mt * 16 < tn) {
#pragma unroll
                                for (int ks = 0; ks < 4; ++ks) {
                                    const LAS float* ap = buf + (mt * 16 + fr) * 132 + ks * 32 + fq * 8;
                                    const f32x4 a0 = *(const LAS f32x4*)ap, a1 = *(const LAS f32x4*)(ap + 4);
                                    const u32x4 aw = pack8(a0, a1);
                                    const bf16x8 av = __builtin_bit_cast(bf16x8, aw);
                                    yacc[stt][mt] = __builtin_amdgcn_mfma_f32_16x16x32_bf16(av, cfr[ks], yacc[stt][mt], 0, 0, 0);
                                }
                            }
                        }
                    }
                    __syncthreads();
                }
            }
            if (!OUT) { st[0] = xr; st[1] = xi; }
        }
        if (OUT) {
            const float dsk = s5d[g * 16 + fr];
            float uv[16];
#pragma unroll
            for (int q4 = 0; q4 < 4; ++q4)
#pragma unroll
                for (int r = 0; r < 4; ++r) { uv[q4 * 4 + r] = 0.f; if (q4 * 16 < T) uv[q4 * 4 + r] = bf2f(zc[(size_t)(q4 * 16 + fq * 4 + r) * ZW + g * 16 + fr]); }
#pragma unroll
            for (int stt = 0; stt < 2; ++stt)
#pragma unroll
                for (int mt = 0; mt < 2; ++mt) {
                    if (stt * 32 + mt * 16 < T) {
#pragma unroll
                        for (int r = 0; r < 4; ++r) {
                            const int t = stt * 32 + mt * 16 + fq * 4 + r;
                            const float y = gelu_tanh(yacc[stt][mt][r] + dsk * uv[(stt * 2 + mt) * 4 + r]);
                            zc[(size_t)t * ZW + 512 + g * 16 + fr] = (bf16_t)f2bf(y);
                        }
                    }
                }
        }
    }
}

__device__ __forceinline__ void s5_passB(const Ctx& X, const Grp& gp, int gtid, int GT) {
    const int n = gp.nseq * 2048;
    for (int e = gtid; e < n; e += GT) {
        const int sl = e >> 11, r = e & 2047, dir = r >> 10;
        const float l16r = X.l16[r * 2], l16i = X.l16[r * 2 + 1], l64r = X.l64[r * 2], l64i = X.l64[r * 2 + 1];
        float sr = 0.f, si = 0.f;
        for (int k0 = 0; k0 < gp.nch; k0 += 8) {
            float er[8], ei[8];
#pragma unroll
            for (int j = 0; j < 8; ++j) { const int k = k0 + j; if (k < gp.nch) { const int c = dir ? gp.nch - 1 - k : k; const float* pp = X.s5s + ((size_t)(sl * gp.nch + c) * 2048 + r) * 2; er[j] = pp[0]; ei[j] = pp[1]; } else { er[j] = 0.f; ei[j] = 0.f; } }
#pragma unroll
            for (int j = 0; j < 8; ++j) { const int k = k0 + j; if (k < gp.nch) { const int c = dir ? gp.nch - 1 - k : k; float* pp = X.s5s + ((size_t)(sl * gp.nch + c) * 2048 + r) * 2; pp[0] = sr; pp[1] = si;
                    const float pr = c == 0 ? l16r : l64r, pi = c == 0 ? l16i : l64i;
                    const float nr = pr * sr - pi * si + er[j], ni = pr * si + pi * sr + ei[j]; sr = nr; si = ni; } }
        }
    }
}

typedef short v4i16_t __attribute__((ext_vector_type(4)));
__device__ __forceinline__ v4i16_t vtr16(const LAS unsigned char* p) { return __builtin_amdgcn_ds_read_tr16_b64_v4i16((LAS v4i16_t*)p); }
template <bool OUT>
__device__ __forceinline__ void hg_chunk(const Ctx& X, LAS float* gt, LAS bf16_t* ot, const bf16_t* zc, int T, int ci, int wave, int lane) {
    const int h = wave >> 1, dir = wave & 1;
    float S[64];
    float* U = X.hgu + ((size_t)ci * 8 + wave) * 4096;
    if (OUT) {
#pragma unroll
        for (int d = 0; d < 64; ++d) S[d] = U[d * 64 + lane];
    } else {
#pragma unroll
        for (int d = 0; d < 64; ++d) S[d] = 0.f;
    }
    const float lbv = X.lb[h * 64 + lane], oml = 1.f - lbv; float P = 1.f;
    const int fcol = (dir ? 2304 : 2048) + h * 64 + lane, qcol = 1792 + h * 64 + lane, vcol = 2560 + h * 64 + lane;
    const int ns8 = T >> 3;
    bf16_t rq[8], rf[8], rv[8];
    {
        const int sb0 = dir ? (ns8 - 1) : 0;
#pragma unroll
        for (int j = 0; j < 8; ++j) { const bf16_t* zr = zc + (size_t)(sb0 * 8 + j) * ZW; rq[j] = zr[qcol]; rf[j] = zr[fcol]; rv[j] = zr[vcol]; }
    }
#pragma unroll 1
    for (int s8 = 0; s8 < ns8; ++s8) {
        const int sb = dir ? (ns8 - 1 - s8) : s8;
#pragma unroll
        for (int j = 0; j < 8; ++j) {
            const float q = bf2f(rq[j]), ff = bf2f(rf[j]);
            const float sg = sigm(ff), fg = lbv + oml * sg, kk = oml * (1.f - sg);
            gt[j * 256 + lane] = fg; gt[j * 256 + 64 + lane] = kk; gt[j * 256 + 128 + lane] = q * sigm(q); gt[j * 256 + 192 + lane] = bf2f(rv[j]);
            P *= fg;
        }
        __syncthreads();
        if (s8 + 1 < ns8) {
            const int sbn = dir ? (ns8 - 2 - s8) : s8 + 1;
#pragma unroll
            for (int j = 0; j < 8; ++j) { const bf16_t* zr = zc + (size_t)(sbn * 8 + j) * ZW; rq[j] = zr[qcol]; rf[j] = zr[fcol]; rv[j] = zr[vcol]; }
        }
#pragma unroll 1
        for (int jj = 0; jj < 8; ++jj) {
            const int j = dir ? 7 - jj : jj;
            const LAS float* gj = gt + j * 256;
            const float v = gj[192 + lane];
            float o = 0.f;
#pragma unroll
            for (int d4 = 0; d4 < 16; ++d4) {
                const f32x4 f4 = *(const LAS f32x4*)(gj + d4 * 4), k4 = *(const LAS f32x4*)(gj + 64 + d4 * 4);
#pragma unroll
                for (int i = 0; i < 4; ++i) S[d4 * 4 + i] = f4[i] * S[d4 * 4 + i] + k4[i] * v;
                if (OUT) { const f32x4 q4 = *(const LAS f32x4*)(gj + 128 + d4 * 4);
#pragma unroll
                    for (int i = 0; i < 4; ++i) o += S[d4 * 4 + i] * q4[i]; }
                if ((d4 & 3) == 3) __builtin_amdgcn_sched_barrier(0);
            }
            if (OUT) ot[(sb * 8 + j) * 64 + lane] = (bf16_t)f2bf(o);
        }
        __syncthreads();
    }
    if (!OUT) {
#pragma unroll
        for (int d = 0; d < 64; ++d) U[d * 64 + lane] = S[d];
        X.hgp[((size_t)ci * 8 + wave) * 64 + lane] = P;
    }
}

__device__ __forceinline__ void hg_passA_mfma(const Ctx& X, LAS unsigned char* wl, const bf16_t* zc, int T, int ci, int wave, int lane) {
    const int h = wave >> 1, dir = wave & 1, fq = lane >> 4, l16 = lane & 15, r8 = lane >> 3, pc = lane & 7;
    LAS unsigned char* kl = wl; LAS unsigned char* vl = wl + 4608;
    const float lbv = X.lb[h * 64 + lane], oml = 1.f - lbv;
    const int fcol = (dir ? 2304 : 2048) + h * 64 + lane, vcolb = 2560 + h * 64 + pc * 8;
    f32x4 acc[4][4];
#pragma unroll
    for (int a = 0; a < 4; ++a)
#pragma unroll
        for (int b = 0; b < 4; ++b) acc[a][b] = (f32x4){0.f, 0.f, 0.f, 0.f};
    float run = 1.f;
    const int nh = (T + 31) >> 5;
#pragma unroll 1
    for (int hh = 0; hh < nh; ++hh) {
        const int hb = dir ? hh : (nh - 1 - hh); const int t0 = hb * 32; const int tn = (T - t0) < 32 ? (T - t0) : 32;
        u32x4 vr[4];
#pragma unroll
        for (int i = 0; i < 4; ++i) { const int rr = i * 8 + r8; vr[i] = (u32x4){0u, 0u, 0u, 0u}; if (rr < tn) vr[i] = *(const u32x4*)(zc + (size_t)(t0 + rr) * ZW + vcolb); }
        __syncthreads();
#pragma unroll 1
        for (int bt = 0; bt < 2; ++bt) {
            const int j0 = (dir ? bt : 1 - bt) * 16;
            bf16_t rf[16];
#pragma unroll
            for (int j = 0; j < 16; ++j) { rf[j] = 0; if (j0 + j < tn) rf[j] = zc[(size_t)(t0 + j0 + j) * ZW + fcol]; }
#pragma unroll
            for (int jj = 0; jj < 16; ++jj) {
                const int jl = dir ? jj : 15 - jj; const int j = j0 + jl;
                float kh = 0.f;
                if (j < tn) { const float sg = sigm(bf2f(dir ? rf[jj] : rf[15 - jj])); kh = oml * (1.f - sg) * run; run *= lbv + oml * sg; }
                *(LAS bf16_t*)(kl + j * 144 + lane * 2) = (bf16_t)f2bf(kh);
            }
        }
#pragma unroll
        for (int i = 0; i < 4; ++i) *(LAS u32x4*)(vl + (i * 8 + r8) * 144 + pc * 16) = vr[i];
        __syncthreads();
        const int roff = (4 * fq + (l16 >> 2)) * 144 + (4 * (l16 & 3)) * 2;
        bf16x8 af[4];
#pragma unroll
        for (int mt = 0; mt < 4; ++mt) { const v4i16_t ta = vtr16(kl + roff + mt * 32), tb = vtr16(kl + roff + 16 * 144 + mt * 32); af[mt] = (bf16x8){ta[0], ta[1], ta[2], ta[3], tb[0], tb[1], tb[2], tb[3]}; }
#pragma unroll
        for (int nt = 0; nt < 4; ++nt) {
            const v4i16_t ta = vtr16(vl + roff + nt * 32), tb = vtr16(vl + roff + 16 * 144 + nt * 32);
            const bf16x8 bfv = (bf16x8){ta[0], ta[1], ta[2], ta[3], tb[0], tb[1], tb[2], tb[3]};
#pragma unroll
            for (int mt = 0; mt < 4; ++mt) acc[mt][nt] = __builtin_amdgcn_mfma_f32_16x16x32_bf16(af[mt], bfv, acc[mt][nt], 0, 0, 0);
        }
    }
    float* U = X.hgu + ((size_t)ci * 8 + wave) * 4096 + (4 * fq) * 64 + l16;
#pragma unroll
    for (int mt = 0; mt < 4; ++mt) {
#pragma unroll
        for (int r = 0; r < 4; ++r)
#pragma unroll
            for (int nt = 0; nt < 4; ++nt) U[(16 * mt + r) * 64 + 16 * nt] = acc[mt][nt][r];
        __builtin_amdgcn_sched_barrier(0);
    }
    X.hgp[((size_t)ci * 8 + wave) * 64 + lane] = run;
}

__device__ __forceinline__ void hg_passB(const Ctx& X, const Grp& gp, int gtid, int GT) {
    const int n = gp.nseq * 32768;
    for (int e = gtid; e < n; e += GT) {
        const int sl = e >> 15, r = e & 32767, hd = r >> 12, de = r & 4095, d = de >> 6, dir = hd & 1;
        const size_t cb0 = (size_t)(sl * gp.nch) * 8 + hd; const int cstep = dir ? -8 : 8; const size_t cfirst = dir ? cb0 + (size_t)(gp.nch - 1) * 8 : cb0;
        float s = 0.f;
        float u[2][8], pv[2][8];
#pragma unroll
        for (int j = 0; j < 8; ++j) { u[0][j] = 0.f; pv[0][j] = 0.f; if (j < gp.nch) { const size_t cb = cfirst + (long)j * cstep; u[0][j] = X.hgu[cb * 4096 + de]; pv[0][j] = X.hgp[cb * 64 + d]; } }
        for (int k0 = 0; k0 < gp.nch; k0 += 16) {
#pragma unroll
            for (int hb = 0; hb < 2; ++hb) {
                const int kb = k0 + hb * 8;
                if (kb < gp.nch) {
#pragma unroll
                    for (int j = 0; j < 8; ++j) { const int k = kb + 8 + j; u[1 - hb][j] = 0.f; pv[1 - hb][j] = 0.f; if (k < gp.nch) { const size_t cb = cfirst + (long)k * cstep; u[1 - hb][j] = X.hgu[cb * 4096 + de]; pv[1 - hb][j] = X.hgp[cb * 64 + d]; } }
#pragma unroll
                    for (int j = 0; j < 8; ++j) { const int k = kb + j; if (k < gp.nch) { const size_t cb = cfirst + (long)k * cstep; X.hgu[cb * 4096 + de] = s; s = pv[hb][j] * s + u[hb][j]; } }
                }
            }
        }
    }
}

__device__ __forceinline__ void na_task(const Ctx& X, const float* rpb, const Grp& gp, int sl, int task, bool metaq, int wave, int lane, LAS unsigned char* vl) {
    const int h = wave, fr = lane & 15, fq = lane >> 4;
    const int s = gp.s0 + sl, rows = gp.Lr >> 6;
    int r = 0, n = 0, rs = 0, ks = 0;
    const bf16_t* qptr; bf16_t* optr; size_t ostride = 512;
    if (metaq) { qptr = X.mz + (size_t)(s * 16 + fr) * ZW; optr = X.myb + (size_t)(s * 16) * 512; }
    else {
        r = task >> 2; n = task & 3;
        rs = r - 4; rs = rs < 0 ? 0 : (rs > rows - 8 ? rows - 8 : rs);
        ks = 16 * n - 8; ks = ks < 0 ? 0 : (ks > 32 ? 32 : ks);
        const size_t qrow0 = (size_t)sl * gp.Lr + r * 64 + 16 * n;
        qptr = X.z + (qrow0 + fr) * ZW; optr = X.yb + qrow0 * 512;
    }
    bf16x8 qf[2];
#pragma unroll
    for (int kk = 0; kk < 2; ++kk) qf[kk] = *(const bf16x8*)(qptr + 256 + h * 64 + 32 * kk + 8 * fq);
    f32x4 sc[17];
    {
        const bf16_t* kp = X.mz + (size_t)(s * 16 + fr) * ZW + 768 + h * 64 + 8 * fq;
        f32x4 c = (f32x4){0.f, 0.f, 0.f, 0.f};
#pragma unroll
        for (int kk = 0; kk < 2; ++kk) c = __builtin_amdgcn_mfma_f32_16x16x32_bf16(*(const bf16x8*)(kp + 32 * kk), qf[kk], c, 0, 0, 0);
        sc[0] = c * 0.125f;
    }
    const int qc = 16 * n + fr;
    int wstart = qc - 8; wstart = wstart < 0 ? 0 : (wstart > 48 ? 48 : wstart);
    const size_t krow_base = (size_t)sl * gp.Lr + (size_t)rs * 64 + ks;
    if (!metaq) {
#pragma unroll
        for (int tb = 0; tb < 2; ++tb) {
            bf16x8 kf[8][2]; float bz[8][4];
#pragma unroll
            for (int t4 = 0; t4 < 8; ++t4) {
                const int tt = tb * 8 + t4, kj = tt >> 1, half = tt & 1;
                const bf16_t* kp = X.z + (krow_base + kj * 64 + 16 * half + fr) * ZW + 768 + h * 64 + 8 * fq;
                kf[t4][0] = *(const bf16x8*)kp; kf[t4][1] = *(const bf16x8*)(kp + 32);
            }
#pragma unroll
            for (int t4 = 0; t4 < 8; ++t4) {
                const int tt = tb * 8 + t4, kj = tt >> 1, half = tt & 1;
                const float* rp = rpb + (h * 15 + (rs + kj - r + 7)) * 31;
#pragma unroll
                for (int i = 0; i < 4; ++i) { int dc = ks + 16 * half + 4 * fq + i - qc; dc = dc < -15 ? -15 : (dc > 15 ? 15 : dc); bz[t4][i] = rp[dc + 15]; }
            }
            __builtin_amdgcn_sched_barrier(0);
#pragma unroll
            for (int t4 = 0; t4 < 8; ++t4) {
                const int tt = tb * 8 + t4, half = tt & 1;
                f32x4 c = (f32x4){0.f, 0.f, 0.f, 0.f};
                c = __builtin_amdgcn_mfma_f32_16x16x32_bf16(kf[t4][0], qf[0], c, 0, 0, 0);
                c = __builtin_amdgcn_mfma_f32_16x16x32_bf16(kf[t4][1], qf[1], c, 0, 0, 0);
#pragma unroll
                for (int i = 0; i < 4; ++i) {
                    const int kc = ks + 16 * half + 4 * fq + i;
                    const bool valid = (kc >= wstart) && (kc < wstart + 16);
                    c[i] = valid ? c[i] * 0.125f + bz[t4][i] : -1e30f;
                }
                sc[1 + tt] = c;
            }
            __builtin_amdgcn_sched_barrier(0);
        }
    } else {
#pragma unroll
        for (int tt = 0; tt < 16; ++tt) sc[1 + tt] = (f32x4){-1e30f, -1e30f, -1e30f, -1e30f};
    }
    float mx = -1e30f;
#pragma unroll
    for (int t = 0; t < 17; ++t)
#pragma unroll
        for (int i = 0; i < 4; ++i) mx = fmaxf(mx, sc[t][i]);
    mx = fmaxf(mx, __shfl_xor(mx, 16)); mx = fmaxf(mx, __shfl_xor(mx, 32));
    float sum = 0.f;
#pragma unroll
    for (int t = 0; t < 17; ++t)
#pragma unroll
        for (int i = 0; i < 4; ++i) { const float e = __expf(sc[t][i] - mx); sc[t][i] = e; sum += e; }
    sum += __shfl_xor(sum, 16); sum += __shfl_xor(sum, 32);
    const float inv = 1.f / sum;
    f32x4 oacc[4];
#pragma unroll
    for (int et = 0; et < 4; ++et) oacc[et] = (f32x4){0.f, 0.f, 0.f, 0.f};
    {
        const int r8 = lane >> 3, pc = lane & 7, l16 = lane & 15;
        const int vcol = 1280 + h * 64 + pc * 8;
        u32x4 vreg[8];
#pragma unroll
        for (int i = 0; i < 2; ++i) vreg[i] = *(const u32x4*)(X.mz + (size_t)(s * 16 + i * 8 + r8) * ZW + vcol);
#pragma unroll
        for (int cc = 0; cc < 5; ++cc) {
            if (cc > 0 && metaq) break;
            __syncthreads();
#pragma unroll
            for (int i = 0; i < 8; ++i) if (cc > 0 || i < 2) *(LAS u32x4*)(vl + (i * 8 + r8) * 144 + pc * 16) = vreg[i];
            __syncthreads();
            if (cc < 4 && !metaq) {
#pragma unroll
                for (int i = 0; i < 8; ++i) { const int rr = i * 8 + r8;
                    vreg[i] = *(const u32x4*)(X.z + (krow_base + (size_t)(2 * cc + (rr >> 5)) * 64 + (rr & 31)) * ZW + vcol); }
            }
#pragma unroll
            for (int ksl = 0; ksl < 2; ++ksl) {
                if (cc == 0 && ksl == 1) break;
                const int tt = 4 * (cc - 1) + 2 * ksl;
                f32x4 pa, pb;
                if (cc == 0) { pa = sc[0] * inv; pb = (f32x4){0.f, 0.f, 0.f, 0.f}; } else { pa = sc[1 + tt] * inv; pb = sc[2 + tt] * inv; }
                const bf16x8 pf = __builtin_bit_cast(bf16x8, pack8(pa, pb));
                const LAS unsigned char* rowp = vl + (32 * ksl + 4 * fq + (l16 >> 2)) * 144 + (4 * (l16 & 3)) * 2;
#pragma unroll
                for (int et = 0; et < 4; ++et) {
                    const v4i16_t ta = vtr16(rowp + et * 32);
                    v4i16_t tb = (v4i16_t){0, 0, 0, 0};
                    if (cc > 0) tb = vtr16(rowp + 16 * 144 + et * 32);
                    const bf16x8 vw = (bf16x8){ta[0], ta[1], ta[2], ta[3], tb[0], tb[1], tb[2], tb[3]};
                    oacc[et] = __builtin_amdgcn_mfma_f32_16x16x32_bf16(pf, vw, oacc[et], 0, 0, 0);
                }
            }
        }
    }
#pragma unroll
    for (int et = 0; et < 4; ++et)
#pragma unroll
        for (int i = 0; i < 4; ++i) optr[(size_t)(4 * fq + i) * ostride + h * 64 + et * 16 + fr] = (bf16_t)f2bf(oacc[et][i]);
}

#define XB_TMO      128
#define XB_XCNT(j)  (256  + 64 * (j))
#define XB_XSUB(j)  (1280 + 64 * (j))
#define XB_XGEN(j)  (2304 + 64 * (j))
#define XB_TOP      3328
#define XB_TOPGEN   3392
#define XCD_BAR_WORDS 3456
#define XB_SPIN_CAP (1u << 22)
__device__ __forceinline__ unsigned xb_ld(unsigned* p)              { return __hip_atomic_load(p, __ATOMIC_RELAXED, __HIP_MEMORY_SCOPE_AGENT); }
__device__ __forceinline__ unsigned xb_add(unsigned* p, unsigned v) { return __hip_atomic_fetch_add(p, v, __ATOMIC_RELAXED, __HIP_MEMORY_SCOPE_AGENT); }
__device__ __forceinline__ unsigned xb_xcc_id() { return (unsigned)__builtin_amdgcn_s_getreg((3 << 11) | 20) & 0xFu; }
#define XB_SPIN(cond, bar) do { unsigned _sp = 0; while (cond) { __builtin_amdgcn_s_sleep(1); \
    if ((++_sp & 255u) == 0u) { if (xb_ld(&(bar)[XB_TMO])) break; if (_sp > XB_SPIN_CAP) { atomicAdd(&(bar)[XB_TMO], 1u); break; } } } } while (0)
__device__ __forceinline__ void xcd_barrier_complete(unsigned* bar, unsigned x, unsigned& nloc, unsigned& nx) {
    const unsigned G = gridDim.x * gridDim.y * gridDim.z;
    unsigned sum, cnt, mine, sp = 0u;
    for (;;) {
        sum = 0u; cnt = 0u; mine = 0u;
#pragma unroll
        for (unsigned j = 0; j < 16; ++j) { const unsigned c = xb_ld(&bar[XB_XCNT(j)]); sum += c; cnt += (c > 0u) ? 1u : 0u; mine = (j == x) ? c : mine; }
        if (sum == G) break;
        __builtin_amdgcn_s_sleep(1);
        if ((++sp & 255u) == 0u) { if (xb_ld(&bar[XB_TMO])) break; if (sp > XB_SPIN_CAP) { atomicAdd(&bar[XB_TMO], 1u); break; } }
    }
    nloc = mine > 0u ? mine : 1u; nx = cnt > 0u ? cnt : 1u;
}
__device__ __forceinline__ void xcd_barrier(unsigned* bar, volatile LAS unsigned* st) {
    asm volatile("s_waitcnt vmcnt(0)" ::: "memory");
    __syncthreads();
    if (threadIdx.x == 0) {
        const unsigned x = xb_xcc_id();
        __builtin_amdgcn_s_waitcnt(0);
        unsigned nloc = st[0], nx = st[1];
        if (nloc == 0u) { xcd_barrier_complete(bar, x, nloc, nx); st[0] = nloc; st[1] = nx; }
        const unsigned old = xb_add(&bar[XB_XSUB(x)], 1u);
        const unsigned gen = old / nloc;
        if (old + 1u == (gen + 1u) * nloc) {
            __builtin_amdgcn_fence(__ATOMIC_RELEASE, "agent");
            asm volatile("s_waitcnt vmcnt(0)" ::: "memory");
            const unsigned og = xb_add(&bar[XB_TOP], 1u);
            const unsigned tg = og / nx;
            if (og + 1u == (tg + 1u) * nx) xb_add(&bar[XB_TOPGEN], 1u);
            else XB_SPIN(xb_ld(&bar[XB_TOPGEN]) == tg, bar);
            __builtin_amdgcn_fence(__ATOMIC_ACQUIRE, "agent");
            xb_add(&bar[XB_XGEN(x)], 1u);
            asm volatile("s_waitcnt vmcnt(0)" ::: "memory");
        } else {
            XB_SPIN(xb_ld(&bar[XB_XGEN(x)]) == gen, bar);
            __builtin_amdgcn_fence(__ATOMIC_ACQUIRE, "agent");
            asm volatile("s_waitcnt vmcnt(0)" ::: "memory");
        }
    }
    __syncthreads();
}
#define GRID_SYNC() xcd_barrier((unsigned*)(KA(ws) + WS_CTL), (volatile LAS unsigned*)(lds + LDS_ST_OFF))
__device__ __forceinline__ Ctx make_ctx(unsigned char* ws) {
    Ctx X;
    X.hb = (bf16_t*)(ws + WS_HB); X.ssq = (float*)(ws + WS_SSQ); X.z = (bf16_t*)(ws + WS_Z); X.yb = (bf16_t*)(ws + WS_YB); X.vt = (bf16_t*)(ws + WS_VT);
    X.hgu = (float*)(ws + WS_HGU); X.hgp = (float*)(ws + WS_HGP); X.s5s = (float*)(ws + WS_S5S); X.w = (bf16_t*)(ws + WS_W);
    X.lbar = (const float*)(ws + WS_TAB + T_LBAR); X.l16 = (const float*)(ws + WS_TAB + T_L16); X.l64 = (const float*)(ws + WS_TAB + T_L64);
    X.bfrag = (const bf16_t*)(ws + WS_TAB + T_BFRAG); X.cfrag = (const bf16_t*)(ws + WS_TAB + T_CFRAG); X.lb = (const float*)(ws + WS_TAB + T_LB);
    X.mh = (float*)(ws + WS_META + M_H); X.mhb = (bf16_t*)(ws + WS_META + M_HB); X.mssq = (float*)(ws + WS_META + M_SSQ); X.mz = (bf16_t*)(ws + WS_META + M_Z);
    X.myb = (bf16_t*)(ws + WS_META + M_YB); X.mvt = (bf16_t*)(ws + WS_META + M_VT); X.mact = (bf16_t*)(ws + WS_META + M_ACT);
    return X;
}

__device__ __forceinline__ bool make_job(unsigned char* ws, float* out, int l, int g, int ph, int j, pg8::Gemm& gm, pg8::UberEpi& ep) {
    const bool mchain = (g == 3) && (l < NLAYER - 1);
    int njobs = 1; bool meta = false; int sub = j;
    if (ph == 0) { njobs = (g == 0) ? 2 : 1; meta = (j == 1); }
    else if (ph == 4) { njobs = (g == 3) ? 2 : 1; meta = (j == 1); }
    else if (ph == 5) { njobs = mchain ? 6 : 3; meta = (j >= 3); sub = j % 3; }
    else { njobs = mchain ? 2 : 1; meta = (j == 1); }
    if (j >= njobs) return false;
    unsigned char* wb = ws + WS_W;
    const size_t r0 = (size_t)g * RG;
    unsigned char* mb = ws + WS_META;
    bf16_t* z = meta ? (bf16_t*)(mb + M_Z) : (bf16_t*)(ws + WS_Z);
    bf16_t* hb = meta ? (bf16_t*)(mb + M_HB) : (bf16_t*)(ws + WS_HB) + r0 * DM;
    float* ssq = meta ? (float*)(mb + M_SSQ) : (float*)(ws + WS_SSQ) + r0 * 4;
    float* h = meta ? (float*)(mb + M_H) : out + r0 * DM;
    bf16_t* yb = meta ? (bf16_t*)(mb + M_YB) : (bf16_t*)(ws + WS_YB);
    bf16_t* vt = meta ? (bf16_t*)(mb + M_VT) : (bf16_t*)(ws + WS_VT);
    bf16_t* act = meta ? (bf16_t*)(mb + M_ACT) : (bf16_t*)(ws + WS_Z);
    gm.M = meta ? 256 : RG;
    ep.i0 = 0; ep.p0 = nullptr; ep.p1 = nullptr; ep.p2 = nullptr;
    if (ph == 0) { gm.A = hb; gm.lda = DM; gm.Bt = (const bf16_t*)(wb + W_IN); gm.N = ZN; gm.K = DM; ep.mode = 0; ep.p0 = (unsigned char*)z; ep.p1 = (unsigned char*)ssq; ep.p2 = (unsigned char*)vt; ep.i0 = meta ? 256 : VTLD; }
    else if (ph == 4) { gm.A = z + 512; gm.lda = ZW; gm.Bt = (const bf16_t*)(wb + W_GLU); gm.N = 256; gm.K = 256; ep.mode = 1; ep.p0 = (unsigned char*)z; }
    else if (ph == 5) {
        gm.N = DM; ep.p0 = (unsigned char*)z;
        if (sub == 0) { gm.A = yb; gm.lda = 512; gm.Bt = (const bf16_t*)(wb + W_UPB); gm.K = 512; ep.mode = 2; ep.i0 = 4096; }
        else if (sub == 1) { gm.A = z + 256; gm.lda = ZW; gm.Bt = (const bf16_t*)(wb + W_UPC); gm.K = 256; ep.mode = 3; ep.i0 = 5120; }
        else { gm.A = z; gm.lda = ZW; gm.Bt = (const bf16_t*)(wb + W_UPA); gm.K = 256; ep.mode = 3; ep.i0 = 3072; }
    }
    else if (ph == 6) { gm.A = z + 1024; gm.lda = ZW; gm.Bt = (const bf16_t*)(wb + W_O); gm.N = DM; gm.K = DM; ep.mode = 4; ep.p0 = (unsigned char*)h; ep.p1 = (unsigned char*)hb; ep.p2 = (unsigned char*)ssq; }
    else if (ph == 7) { gm.A = hb; gm.lda = DM; gm.Bt = (const bf16_t*)(wb + W_GU); gm.N = 2 * FFH; gm.K = DM; ep.mode = 5; ep.p0 = (unsigned char*)act; ep.p1 = (unsigned char*)ssq; }
    else { gm.A = act; gm.lda = FFH; gm.Bt = (const bf16_t*)(wb + W_DN); gm.N = DM; gm.K = FFH; ep.mode = 4; ep.p0 = (unsigned char*)h; ep.p1 = (unsigned char*)hb; ep.p2 = (unsigned char*)ssq; }
    return true;
}

__device__ __forceinline__ void prologue(int G) {
    const int tid_ = opaque_tid(); const int lane = tid_ & 63, gw = blockIdx.x * 8 + __builtin_amdgcn_readfirstlane(tid_ >> 6), NGW = G * 8;
    const Ctx X = make_ctx(((unsigned char*)KA(ws)));
    for (int row = gw; row < RMAIN + 256; row += NGW) {
        const bool ismeta = row >= RMAIN; const int mr = row - RMAIN;
        const float* src = ismeta ? (mr < 160 ? KAF(meta_tokens) + (size_t)(mr & 15) * DM : nullptr) : (row < 32768 ? KAF(x_prompt) + (size_t)row * DM : KAF(x_sample) + (size_t)(row - 32768) * DM);
        float* hd = ismeta ? X.mh + (size_t)mr * DM : ((float*)KA(out)) + (size_t)row * DM;
        bf16_t* hbd = ismeta ? X.mhb + (size_t)mr * DM : X.hb + (size_t)row * DM;
        float* sq = ismeta ? X.mssq + (size_t)mr * 4 : X.ssq + (size_t)row * 4;
        float ss = 0.f;
#pragma unroll
        for (int j = 0; j < 4; ++j) {
            f32x4 v = (f32x4){0.f, 0.f, 0.f, 0.f}; if (src) v = *(const f32x4*)(src + j * 256 + lane * 4);
            *(f32x4*)(hd + j * 256 + lane * 4) = v;
            *(u32x2*)(hbd + j * 256 + lane * 4) = (u32x2){pk2(v[0], v[1]), pk2(v[2], v[3])};
            ss += (v[0] * v[0] + v[1] * v[1]) + (v[2] * v[2] + v[3] * v[3]);
        }
        ss = wave_sum(ss);
        if (lane < 4) sq[lane] = lane == 0 ? ss : 0.f;
    }
}

__device__ __forceinline__ void mixer_phase_A(int l, int g, LAS unsigned char* lds, int G, int bid) {
    const int tid_ = opaque_tid(); const int lane = tid_ & 63, wave = __builtin_amdgcn_readfirstlane(tid_ >> 6);
    const Ctx X = make_ctx(((unsigned char*)KA(ws))); const Grp gp = make_grp(g);
    const float* rpb = KAF(rpb) + (size_t)l * 8 * 15 * 31; const float* s5d = KAF(s5_d) + l * 256;
    const int nna = gp.nseq * (gp.Lr / 16), nmq = gp.nseq, nct = gp.nseq * (gp.nch - 1);
    const int ntask = nna + nmq + 2 * nct;
    const bool xmap = (nna % 256 == 0) && ((volatile LAS unsigned*)(lds + LDS_ST_OFF))[4] != 0u;
    if (xmap) {
        const int xcc = (int)((volatile LAS unsigned*)(lds + LDS_ST_OFF))[2], xrk = (int)((volatile LAS unsigned*)(lds + LDS_ST_OFF))[3];
        const int per = gp.Lr / 16, nx = nna / 8, rounds = nna / 256;
        for (int i = 0; i < rounds; ++i) { const int t = xcc * nx + xrk + 32 * i; na_task(X, rpb, gp, t / per, t % per, false, wave, lane, lds + wave * 9216); }
    }
    for (int t = bid + (xmap ? nna : 0); t < ntask; t += G) {
        __syncthreads();
        if (t < nna) { const int per = gp.Lr / 16; na_task(X, rpb, gp, t / per, t % per, false, wave, lane, lds + wave * 9216); }
        else if (t < nna + nmq) { na_task(X, rpb, gp, t - nna, 0, true, wave, lane, lds + wave * 9216); }
        else {
            const int u = t - nna - nmq; const bool isS5 = u < nct; const int v = isS5 ? u : u - nct;
            const int sl = v / (gp.nch - 1), c1 = v % (gp.nch - 1) + 1;
            for (int c = (c1 == 1 ? 0 : c1); c <= c1; ++c) {
                __syncthreads();
                const int ci = sl * gp.nch + c; const int T = c == 0 ? 16 : 64;
                bf16_t* zc = c == 0 ? X.mz + (size_t)((gp.s0 + sl) * 16) * ZW : X.z + ((size_t)sl * gp.Lr + 64 * (c - 1)) * ZW;
                if (isS5) s5_chunk<false>(X, s5d, (LAS float*)(lds + wave * 16896), zc, T, ci, wave, lane);
                else hg_passA_mfma(X, lds + wave * 9216, zc, T, ci, wave, lane);
            }
        }
    }
}

__device__ __forceinline__ void mixer_phase_C(int l, int g, LAS unsigned char* lds, int G, int bid) {
    const int tid_ = opaque_tid(); const int lane = tid_ & 63, wave = __builtin_amdgcn_readfirstlane(tid_ >> 6);
    const Ctx X = make_ctx(((unsigned char*)KA(ws))); const Grp gp = make_grp(g);
    const float* s5d = KAF(s5_d) + l * 256; const float* ong = KAF(onorm_g) + l * 64;
    const int nct = gp.nseq * (gp.nch - 1);
    for (int t = bid; t < 2 * nct; t += G) {
        const bool isS5 = t < nct; const int v = isS5 ? t : t - nct;
        const int sl = v / (gp.nch - 1), c1 = v % (gp.nch - 1) + 1;
        for (int c = (c1 == 1 ? 0 : c1); c <= c1; ++c) {
            __syncthreads();
            const int ci = sl * gp.nch + c; const int T = c == 0 ? 16 : 64;
            bf16_t* zc = c == 0 ? X.mz + (size_t)((gp.s0 + sl) * 16) * ZW : X.z + ((size_t)sl * gp.Lr + 64 * (c - 1)) * ZW;
            if (isS5) s5_chunk<true>(X, s5d, (LAS float*)(lds + wave * 16896), zc, T, ci, wave, lane);
            else {
                hg_chunk<true>(X, (LAS float*)(lds + wave * 8192), (LAS bf16_t*)(lds + 65536 + wave * 8192), zc, T, ci, wave, lane);
                __syncthreads();
                const int h = wave >> 1, half = wave & 1;
                const LAS bf16_t* of = (const LAS bf16_t*)(lds + 65536 + (2 * h) * 8192); const LAS bf16_t* ob = (const LAS bf16_t*)(lds + 65536 + (2 * h + 1) * 8192);
                const float gn = ong[lane];
                const int tt0 = half * (T / 2);
                float gov[32];
#pragma unroll
                for (int i = 0; i < 32; ++i) { gov[i] = 0.f; if (i < T / 2) gov[i] = bf2f(zc[(size_t)(tt0 + i) * ZW + 2816 + h * 64 + lane]); }
#pragma unroll
                for (int i = 0; i < 32; ++i) {
                    if (i < T / 2) {
                        const int tt = tt0 + i;
                        const float o = bf2f(of[tt * 64 + lane]) + bf2f(ob[tt * 64 + lane]);
                        const float ms = wave_sum(o * o) * (1.0f / 64.0f);
                        const float go = gov[i];
                        zc[(size_t)tt * ZW + 256 + h * 64 + lane] = (bf16_t)f2bf(o * rsqrtf(ms + 1e-6f) * gn * (go * sigm(go)));
                    }
                }
            }
        }
    }
}

__global__ void __launch_bounds__(512, 2) fwd_kernel(Args a) {
    extern __shared__ __attribute__((aligned(16))) unsigned char lds_raw[];
    LAS unsigned char* lds = (LAS unsigned char*)lds_raw;
    const int G = gridDim.x, bid = blockIdx.x;

    if (threadIdx.x < 2) ((volatile LAS unsigned*)(lds + LDS_ST_OFF))[threadIdx.x] = 0u;
    if (threadIdx.x == 0) { const unsigned xc = xb_xcc_id(); const unsigned rk = xb_add((unsigned*)(KA(ws) + WS_CTL) + XB_XCNT(xc), 1u);
        ((volatile LAS unsigned*)(lds + LDS_ST_OFF))[2] = xc; ((volatile LAS unsigned*)(lds + LDS_ST_OFF))[3] = rk; }
    __syncthreads();
    prologue(G);

    for (int l = 0; l < NLAYER; ++l) {
        __syncthreads();
        { const Ctx X = make_ctx(((unsigned char*)KA(ws))); prep_layer(X, l, lds, G); }
        if (l == 0) { asm volatile("s_waitcnt vmcnt(0)" ::: "memory"); __syncthreads(); cg::this_grid().sync(); }
        GRID_SYNC();
        if (l == 0) {
            if (threadIdx.x == 0) { unsigned* bar = (unsigned*)(KA(ws) + WS_CTL); bool ok = (G == 256);
                for (int j = 0; j < 16; ++j) { const unsigned c = xb_ld(&bar[XB_XCNT(j)]); ok = ok && (c == (j < 8 ? 32u : 0u)); }
                ((volatile LAS unsigned*)(lds + LDS_ST_OFF))[4] = ok ? 1u : 0u; }
            __syncthreads();
        }
        for (int g = 0; g < 4; ++g) {
            for (int ph = 0; ph < 9; ++ph) {
                if (ph == 1) mixer_phase_A(l, g, lds, G, bid);
                else if (ph == 2) { const Ctx X = make_ctx(((unsigned char*)KA(ws))); const Grp gp = make_grp(g); const int gtid = bid * 512 + opaque_tid(), GT = G * 512; s5_passB(X, gp, gtid, GT); hg_passB(X, gp, GT - 1 - gtid, GT); }
                else if (ph == 3) mixer_phase_C(l, g, lds, G, bid);
                else {
                    for (int j = 0; j < 6; ++j) {
                        pg8::Gemm gm; pg8::UberEpi ep;
                        if (!make_job(((unsigned char*)KA(ws)), ((float*)KA(out)), l, g, ph, j, gm, ep)) break;
                        pg8::StaticOrder SO; SO.init(gm.M, gm.N, G, bid);
                        pg8::gemm_phase(lds, gm, SO, ep);
                    }
                }
                GRID_SYNC();
            }
        }
    }
    {
        const float* ssq = (const float*)(((unsigned char*)KA(ws)) + WS_SSQ);
        const int tid_ = opaque_tid(); const int lane = tid_ & 63, wave = __builtin_amdgcn_readfirstlane(tid_ >> 6);
        for (int row = bid * 8 + wave; row < RMAIN; row += G * 8) {
            const float rs = pg8::row_rstd(ssq, row);
            float* hp = ((float*)KA(out)) + (size_t)row * DM;
#pragma unroll
            for (int j = 0; j < 4; ++j) {
                f32x4 v = *(const f32x4*)(hp + j * 256 + lane * 4); const f32x4 gv = *(const f32x4*)(KAF(final_g) + j * 256 + lane * 4);
                v = v * rs * gv; *(f32x4*)(hp + j * 256 + lane * 4) = v;
            }
        }
    }
}

extern "C" void kernel_launch(void* const* d_in, const int* in_sizes, int n_in, void* d_out, int out_size, void* d_ws, size_t ws_size, hipStream_t stream) {
    static int grid = 0;
    if (grid == 0) {
        int dev = 0, cus = 0, per_cu = 0;
        (void)hipGetDevice(&dev);
        (void)hipDeviceGetAttribute(&cus, hipDeviceAttributeMultiprocessorCount, dev);
        (void)hipFuncSetAttribute((const void*)fwd_kernel, hipFuncAttributeMaxDynamicSharedMemorySize, LDS_BYTES);
        (void)hipOccupancyMaxActiveBlocksPerMultiprocessor(&per_cu, (const void*)fwd_kernel, 512, LDS_BYTES);
        (void)hipGetLastError();
        if (ws_size < WS_TOTAL) fprintf(stderr, "kernel_launch: workspace too small: %zu < %zu\n", ws_size, (size_t)WS_TOTAL);
        grid = cus > 0 ? cus : 256;
    }
    (void)hipMemsetAsync((char*)d_ws + WS_CTL, 0, CTL_BYTES, stream);
    Args a{};
    const float** pp = (const float**)&a;
    for (int i = 0; i < 26; ++i) pp[i] = (const float*)d_in[i];
    a.out = (float*)d_out; a.ws = (unsigned char*)d_ws;
    void* args[] = {&a};
    hipError_t e = hipLaunchCooperativeKernel((const void*)fwd_kernel, dim3(grid), dim3(512), args, LDS_BYTES, stream);
    if (e != hipSuccess) fprintf(stderr, "cooperative launch failed: %s\n", hipGetErrorString(e));
}
```

```cpp
#include <hip/hip_runtime.h>
#include <hip/hip_cooperative_groups.h>
#include <cstdio>
#include <cstdint>
namespace cg = cooperative_groups;

#define LAS __attribute__((address_space(3)))
typedef unsigned short bf16_t;
typedef short bf16x8 __attribute__((ext_vector_type(8)));
typedef float f32x4 __attribute__((ext_vector_type(4)));
typedef unsigned u32x4 __attribute__((ext_vector_type(4)));
typedef unsigned u32x2 __attribute__((ext_vector_type(2)));

#define WAVE_SYNC() asm volatile("s_waitcnt lgkmcnt(0)" ::: "memory")
__device__ __forceinline__ int opaque_tid() { int t = threadIdx.x; asm volatile("" : "+v"(t)); return t; }

__device__ __forceinline__ unsigned f2bf(float f) { unsigned u = __builtin_bit_cast(unsigned, f); return (u + 0x7fffu + ((u >> 16) & 1u)) >> 16; }
__device__ __forceinline__ unsigned pk2(float lo, float hi) { return f2bf(lo) | (f2bf(hi) << 16); }
__device__ __forceinline__ float bf2f(bf16_t b) { return __builtin_bit_cast(float, (unsigned)b << 16); }
__device__ __forceinline__ float bflo(unsigned w) { return __builtin_bit_cast(float, w << 16); }
__device__ __forceinline__ float bfhi(unsigned w) { return __builtin_bit_cast(float, w & 0xffff0000u); }
__device__ __forceinline__ float sigm(float x) { return 1.f / (1.f + __expf(-x)); }
__device__ __forceinline__ float gelu_tanh(float y) { const float a = 0.7978845608028654f * (y + 0.044715f * y * y * y); const float th = 1.f - 2.f / (__expf(2.f * a) + 1.f); return 0.5f * y * (1.f + th); }
__device__ __forceinline__ u32x4 pack8(f32x4 a, f32x4 b) { u32x4 w; w.x = pk2(a[0], a[1]); w.y = pk2(a[2], a[3]); w.z = pk2(b[0], b[1]); w.w = pk2(b[2], b[3]); return w; }
__device__ __forceinline__ float wave_sum(float v) {
#pragma unroll
    for (int o = 1; o < 64; o <<= 1) v += __shfl_xor(v, o);
    return v;
}

namespace pg8 {
constexpr int ZSTR = 6208;
constexpr int BM = 256, BK = 64, HALF = 128, HTB = HALF * BK * 2, STAGE_BYTES = 8 * HTB, NXCD = 8, WGM = 8;
__host__ __device__ __forceinline__ int lds_byte(int r, int c) { const int st = (r >> 4) * 2 + (c >> 5), rr = r & 15, cc = c & 31, ob = rr * 64 + cc * 2; return st * 1024 + (ob ^ (((ob >> 9) & 1) << 5)); }
__host__ __device__ __forceinline__ void stage_rc(int b, int& R, int& C) { const int st = b / 1024, sb = b % 1024, swz = sb ^ (((sb >> 9) & 1) << 5); R = (st >> 1) * 16 + swz / 64; C = (st & 1) * 32 + (swz % 64) / 2; }
__host__ __device__ __forceinline__ int perm32(int rho) { const int n = rho >> 4, i = rho & 15; return 8 * (i >> 2) + 4 * n + (i & 3); }
struct Unit { int pm, pn; };
struct Gemm { const bf16_t* A; int lda; const bf16_t* Bt; int M, N, K; };
struct StaticOrder {
    int nM, nN, nwg, G, c;
    __device__ void init(int M, int N, int G_, int c_) { nM = M / BM; nN = N / BM; nwg = nM * nN; G = G_; c = c_; }
    __device__ bool next(int i, Unit& u) const {
        const long L = (long)i * G + c; if (L >= nwg) return false;
        int wgid = (int)L; { const int q = nwg / NXCD, r = nwg % NXCD, xcd = wgid % NXCD, off = wgid / NXCD; wgid = (xcd < r ? xcd * (q + 1) : r * (q + 1) + (xcd - r) * q) + off; }
        const int nig = WGM * nN, gid = wgid / nig, fm = gid * WGM, gsz = (nM - fm) < WGM ? (nM - fm) : WGM;
        u.pm = fm + ((wgid % nig) % gsz); u.pn = (wgid % nig) / gsz; return true;
    }
};

struct UberEpi;
__device__ __forceinline__ void run_epi(const UberEpi& E, LAS unsigned char* lds, const f32x4 (&acc)[2][2][4][2], const Unit& u, int wr, int wc, int fr, int fq);
__device__ __forceinline__ void gemm_phase(LAS unsigned char* lds, const Gemm g, const StaticOrder& S, const UberEpi& E) {
    const int tid = opaque_tid(), wid = __builtin_amdgcn_readfirstlane(tid >> 6), lane = tid & 63, wr = wid >> 2, wc = wid & 3, fr = lane & 15, fq = lane >> 4;
    const int K = g.K, nt = K / BK, lda = g.lda;
    unsigned voffA[2], voffB[2];
#pragma unroll
    for (int i = 0; i < 2; ++i) { int R, C; stage_rc(tid * 16 + i * 8192, R, C); const int Rb = (R & ~31) + perm32(R & 31);
        voffA[i] = (unsigned)(R * lda + C) * 2u; voffB[i] = (unsigned)(Rb * K + C) * 2u; }
    const size_t kstep = (size_t)(BK * 2);
    const size_t hstepA = (size_t)HALF * lda * 2, hstepB = (size_t)HALF * K * 2;
    const size_t tstepA = 2 * hstepA, tstepB = 2 * hstepB;
    const unsigned ldsw = (unsigned)wid * 1024u;
    const int aoff = lds_byte(wr * 64 + fr, fq * 8), boff = lds_byte(wc * 32 + fr, fq * 8);
#define PG8_SA(b, h) (((b) * 2 + (h)) * HTB)
#define PG8_SB(b, h) ((4 + (b) * 2 + (h)) * HTB)
#define PG8_STAGE(bufoff, gbase, voff) do { _Pragma("unroll") for (int _i = 0; _i < 2; ++_i) \
        __builtin_amdgcn_global_load_lds((const unsigned*)((const char*)(gbase) + (voff)[_i]), (LAS unsigned*)(lds + (bufoff) + ldsw + _i * 8192), 16, 0, 0); } while (0)
#define PG8_LDA(dst, b, h) do { _Pragma("unroll") for (int m = 0; m < 4; ++m) _Pragma("unroll") for (int k = 0; k < 2; ++k) dst[m][k] = *(const LAS bf16x8*)(lds + PG8_SA(b, h) + aoff + m * 2048 + k * 1024); } while (0)
#define PG8_LDB(dst, b, h) do { _Pragma("unroll") for (int n = 0; n < 2; ++n) _Pragma("unroll") for (int k = 0; k < 2; ++k) dst[n][k] = *(const LAS bf16x8*)(lds + PG8_SB(b, h) + boff + n * 2048 + k * 1024); } while (0)
#define PG8_MMA(ai, bj, At, Bt) do { __builtin_amdgcn_s_setprio(1); _Pragma("unroll") for (int m = 0; m < 4; ++m) _Pragma("unroll") for (int n = 0; n < 2; ++n) _Pragma("unroll") for (int k = 0; k < 2; ++k) \
        acc[ai][bj][m][n] = __builtin_amdgcn_mfma_f32_16x16x32_bf16(Bt[n][k], At[m][k], acc[ai][bj][m][n], 0, 0, 0); __builtin_amdgcn_s_setprio(0); } while (0)
#define PG8_WAIT_V(n) asm volatile("s_waitcnt vmcnt(" #n ")" ::: "memory")
#define PG8_WAIT_L(n) asm volatile("s_waitcnt lgkmcnt(" #n ")" ::: "memory")
#define PG8_BAR __builtin_amdgcn_s_barrier()
#define PG8_SCHED __builtin_amdgcn_sched_barrier(0)
    Unit cur, nxt; int ui = 0;
    if (!S.next(0, cur)) return;
    f32x4 acc[2][2][4][2];
#pragma unroll
    for (int a = 0; a < 2; ++a)
#pragma unroll
        for (int b = 0; b < 2; ++b)
#pragma unroll
            for (int m = 0; m < 4; ++m)
#pragma unroll
                for (int n = 0; n < 2; ++n) acc[a][b][m][n] = (f32x4){0.f, 0.f, 0.f, 0.f};
    bf16x8 At[4][2], B0[2][2], B1[2][2];
    const char* cA = (const char*)g.A + (size_t)cur.pm * tstepA; const char* cB = (const char*)g.Bt + (size_t)cur.pn * tstepB;
    PG8_STAGE(PG8_SB(0, 0), cB, voffB); PG8_STAGE(PG8_SB(0, 1), cB + hstepB, voffB); PG8_STAGE(PG8_SA(0, 0), cA, voffA); PG8_STAGE(PG8_SA(0, 1), cA + hstepA, voffA);
    if (wr == 1) PG8_BAR;
    PG8_WAIT_V(2); PG8_BAR;
    PG8_STAGE(PG8_SB(1, 0), cB + kstep, voffB); PG8_STAGE(PG8_SA(1, 0), cA + kstep, voffA); PG8_STAGE(PG8_SB(1, 1), cB + hstepB + kstep, voffB);
    PG8_WAIT_V(6); PG8_BAR;
    for (;;) {
        const bool has_next = S.next(ui + 1, nxt);
        const char* nA = has_next ? (const char*)g.A + (size_t)nxt.pm * tstepA : cA; const char* nB = has_next ? (const char*)g.Bt + (size_t)nxt.pn * tstepB : cB;
        for (int t = 0; t < nt; t += 2) {
            const bool last = (t == nt - 2);
            const char* a1 = cA + (size_t)(t + 1) * kstep;
            const char* a2 = last ? nA : cA + (size_t)(t + 2) * kstep; const char* b2 = last ? nB : cB + (size_t)(t + 2) * kstep;
            const char* a3 = a2 + kstep; const char* b3 = b2 + kstep;
            PG8_LDB(B0, 0, 0); PG8_LDB(B1, 0, 1); PG8_SCHED; PG8_LDA(At, 0, 0); PG8_STAGE(PG8_SA(1, 1), a1 + hstepA, voffA);
            PG8_WAIT_V(8); PG8_WAIT_L(0); PG8_BAR; PG8_MMA(0, 0, At, B0); PG8_MMA(0, 1, At, B1); PG8_BAR; PG8_SCHED;
            PG8_LDA(At, 0, 1); PG8_STAGE(PG8_SB(0, 0), b2, voffB); PG8_STAGE(PG8_SB(0, 1), b2 + hstepB, voffB); PG8_STAGE(PG8_SA(0, 0), a2, voffA);
            PG8_WAIT_V(8); PG8_WAIT_L(0); PG8_BAR; PG8_MMA(1, 0, At, B0); PG8_MMA(1, 1, At, B1); PG8_BAR; PG8_SCHED;
            PG8_LDB(B0, 1, 0); PG8_LDB(B1, 1, 1); PG8_SCHED; PG8_LDA(At, 1, 0); PG8_STAGE(PG8_SA(0, 1), a2 + hstepA, voffA);
            PG8_WAIT_V(8); PG8_WAIT_L(0); PG8_BAR; PG8_MMA(0, 0, At, B0); PG8_MMA(0, 1, At, B1); PG8_BAR; PG8_SCHED;
            PG8_LDA(At, 1, 1); PG8_STAGE(PG8_SB(1, 0), b3, voffB); PG8_STAGE(PG8_SB(1, 1), b3 + hstepB, voffB); PG8_STAGE(PG8_SA(1, 0), a3, voffA);
            PG8_WAIT_V(8); PG8_WAIT_L(0); PG8_BAR; PG8_MMA(1, 0, At, B0); PG8_MMA(1, 1, At, B1); PG8_BAR; PG8_SCHED;
        }
        if (wr == 0) PG8_BAR;
        run_epi(E, lds, acc, cur, wr, wc, fr, fq);
        if (!has_next) break;
#pragma unroll
        for (int a = 0; a < 2; ++a)
#pragma unroll
            for (int b = 0; b < 2; ++b)
#pragma unroll
                for (int m = 0; m < 4; ++m)
#pragma unroll
                    for (int n = 0; n < 2; ++n) acc[a][b][m][n] = (f32x4){0.f, 0.f, 0.f, 0.f};
        cur = nxt; cA = nA; cB = nB; ++ui;
        if (wr == 1) PG8_BAR;
    }
    PG8_WAIT_V(0);
    PG8_BAR;
#undef PG8_SA
#undef PG8_SB
#undef PG8_STAGE
#undef PG8_LDA
#undef PG8_LDB
#undef PG8_MMA
#undef PG8_WAIT_V
#undef PG8_WAIT_L
#undef PG8_BAR
#undef PG8_SCHED
}

__device__ __forceinline__ float row_rstd(const float* ssq, int row) {
    const f32x4 s0 = *(const f32x4*)(ssq + (size_t)row * 4);
    const float ss = (s0[0] + s0[1]) + (s0[2] + s0[3]);
    return rsqrtf(ss * (1.0f / 1024.0f) + 1e-6f);
}
struct EpiZ {
    bf16_t* z; const float* ssq; bf16_t* vt; int vt_ld;
    __device__ __forceinline__ void operator()(const f32x4 (&acc)[2][2][4][2], const Unit& u, int wr, int wc, int fr, int fq) const {
        const int row0 = u.pm * BM + wr * 64 + fr, col0 = u.pn * BM + wc * 32 + 8 * fq;
#pragma unroll
        for (int ai = 0; ai < 2; ++ai)
#pragma unroll
            for (int m = 0; m < 4; ++m) {
                const int row = row0 + ai * HALF + m * 16; const float rs = row_rstd(ssq, row);
#pragma unroll
                for (int bj = 0; bj < 2; ++bj) {
                    const u32x4 w = pack8(acc[ai][bj][m][0] * rs, acc[ai][bj][m][1] * rs);
                    *(u32x4*)(z + (size_t)row * ZSTR + col0 + bj * HALF) = w;
                }
            }
    }
};
struct EpiGlu {
    bf16_t* z;
    __device__ __forceinline__ void operator()(const f32x4 (&acc)[2][2][4][2], const Unit& u, int wr, int wc, int fr, int fq) const {
        const int row0 = u.pm * BM + wr * 64 + fr, col0 = wc * 32 + 8 * fq;
#pragma unroll
        for (int ai = 0; ai < 2; ++ai) {
            u32x4 yv[4][2];
#pragma unroll
            for (int m = 0; m < 4; ++m)
#pragma unroll
                for (int bj = 0; bj < 2; ++bj) yv[m][bj] = *(const u32x4*)(z + (size_t)(row0 + ai * HALF + m * 16) * ZSTR + col0 + bj * HALF + 512);
#pragma unroll
            for (int m = 0; m < 4; ++m) {
                const int row = row0 + ai * HALF + m * 16;
#pragma unroll
                for (int bj = 0; bj < 2; ++bj) {
                    bf16_t* zp = z + (size_t)row * ZSTR + col0 + bj * HALF;
                    const u32x4 y = yv[m][bj];
                    const f32x4 a0 = acc[ai][bj][m][0], a1 = acc[ai][bj][m][1];
                    f32x4 o0, o1;
                    o0[0] = bflo(y.x) * sigm(a0[0]); o0[1] = bfhi(y.x) * sigm(a0[1]); o0[2] = bflo(y.y) * sigm(a0[2]); o0[3] = bfhi(y.y) * sigm(a0[3]);
                    o1[0] = bflo(y.z) * sigm(a1[0]); o1[1] = bfhi(y.z) * sigm(a1[1]); o1[2] = bflo(y.w) * sigm(a1[2]); o1[3] = bfhi(y.w) * sigm(a1[3]);
                    *(u32x4*)zp = pack8(o0, o1);
                }
            }
        }
    }
};
template <int MODE> struct EpiMix {
    bf16_t* z; int goff;
    __device__ __forceinline__ void operator()(const f32x4 (&acc)[2][2][4][2], const Unit& u, int wr, int wc, int fr, int fq) const {
        const int row0 = u.pm * BM + wr * 64 + fr, col0 = u.pn * BM + wc * 32 + 8 * fq;
#pragma unroll
        for (int ai = 0; ai < 2; ++ai)
#pragma unroll
            for (int mp = 0; mp < 2; ++mp) {
                u32x4 gv[2][2], pv[2][2];
#pragma unroll
                for (int mm = 0; mm < 2; ++mm)
#pragma unroll
                    for (int bj = 0; bj < 2; ++bj) { const bf16_t* zr = z + (size_t)(row0 + ai * HALF + (mp * 2 + mm) * 16) * ZSTR + col0 + bj * HALF;
                        gv[mm][bj] = *(const u32x4*)(zr + goff); if (MODE == 1) pv[mm][bj] = *(const u32x4*)(zr + 1024); }
#pragma unroll
                for (int mm = 0; mm < 2; ++mm) {
                    const int m = mp * 2 + mm; const int row = row0 + ai * HALF + m * 16;
#pragma unroll
                    for (int bj = 0; bj < 2; ++bj) {
                        bf16_t* zr = z + (size_t)row * ZSTR + col0 + bj * HALF;
                        const u32x4 gq = gv[mm][bj];
                        const f32x4 a0 = acc[ai][bj][m][0], a1 = acc[ai][bj][m][1];
                        f32x4 o0, o1;
                        o0[0] = sigm(bflo(gq.x)) * a0[0]; o0[1] = sigm(bfhi(gq.x)) * a0[1]; o0[2] = sigm(bflo(gq.y)) * a0[2]; o0[3] = sigm(bfhi(gq.y)) * a0[3];
                        o1[0] = sigm(bflo(gq.z)) * a1[0]; o1[1] = sigm(bfhi(gq.z)) * a1[1]; o1[2] = sigm(bflo(gq.w)) * a1[2]; o1[3] = sigm(bfhi(gq.w)) * a1[3];
                        if (MODE == 1) { const u32x4 p = pv[mm][bj];
                            o0[0] += bflo(p.x); o0[1] += bfhi(p.x); o0[2] += bflo(p.y); o0[3] += bfhi(p.y); o1[0] += bflo(p.z); o1[1] += bfhi(p.z); o1[2] += bflo(p.w); o1[3] += bfhi(p.w); }
                        *(u32x4*)(zr + 1024) = pack8(o0, o1);
                    }
                }
            }
    }
};
struct EpiRes {
    float* h; bf16_t* hb; float* ssq; LAS float* red;
    __device__ __forceinline__ void operator()(const f32x4 (&acc)[2][2][4][2], const Unit& u, int wr, int wc, int fr, int fq) const {
        const int row0 = u.pm * BM + wr * 64 + fr, col0 = u.pn * BM + wc * 32 + 8 * fq;
#pragma unroll
        for (int ai = 0; ai < 2; ++ai)
#pragma unroll
            for (int mp = 0; mp < 2; ++mp) {
                f32x4 hv[2][2][2];
#pragma unroll
                for (int mm = 0; mm < 2; ++mm)
#pragma unroll
                    for (int bj = 0; bj < 2; ++bj) { const float* hp = h + (size_t)(row0 + ai * HALF + (mp * 2 + mm) * 16) * 1024 + col0 + bj * HALF; hv[mm][bj][0] = *(const f32x4*)hp; hv[mm][bj][1] = *(const f32x4*)(hp + 4); }
#pragma unroll
                for (int mm = 0; mm < 2; ++mm) {
                    const int m = mp * 2 + mm; const int row = row0 + ai * HALF + m * 16; float part = 0.f;
#pragma unroll
                    for (int bj = 0; bj < 2; ++bj) {
                        float* hp = h + (size_t)row * 1024 + col0 + bj * HALF;
                        const f32x4 h0 = hv[mm][bj][0] + acc[ai][bj][m][0], h1 = hv[mm][bj][1] + acc[ai][bj][m][1];
                        *(f32x4*)hp = h0; *(f32x4*)(hp + 4) = h1;
                        part += (h0[0] * h0[0] + h0[1] * h0[1]) + (h0[2] * h0[2] + h0[3] * h0[3]) + (h1[0] * h1[0] + h1[1] * h1[1]) + (h1[2] * h1[2] + h1[3] * h1[3]);
                        *(u32x4*)(hb + (size_t)row * 1024 + col0 + bj * HALF) = pack8(h0, h1);
                    }
                    part += __shfl_xor(part, 16); part += __shfl_xor(part, 32);
                    if (fq == 0) red[(ai * HALF + wr * 64 + m * 16 + fr) * 4 + wc] = part;
                }
            }
        asm volatile("s_waitcnt lgkmcnt(0)" ::: "memory");
        __builtin_amdgcn_s_barrier();
        asm volatile("" ::: "memory");
        { const int t_ = opaque_tid(); if (t_ < 256) { const f32x4 r4 = *(const LAS f32x4*)(red + t_ * 4); ssq[(size_t)(u.pm * BM + t_) * 4 + u.pn] = (r4[0] + r4[1]) + (r4[2] + r4[3]); } }
    }
};
struct EpiAct {
    bf16_t* act; const float* ssq;
    __device__ __forceinline__ void operator()(const f32x4 (&acc)[2][2][4][2], const Unit& u, int wr, int wc, int fr, int fq) const {
        const int row0 = u.pm * BM + wr * 64 + fr, col0 = u.pn * HALF + wc * 32 + 8 * fq;
#pragma unroll
        for (int ai = 0; ai < 2; ++ai)
#pragma unroll
            for (int m = 0; m < 4; ++m) {
                const int row = row0 + ai * HALF + m * 16; const float rs = row_rstd(ssq, row);
                f32x4 o[2];
#pragma unroll
                for (int n = 0; n < 2; ++n)
#pragma unroll
                    for (int i = 0; i < 4; ++i) { const float gg = acc[ai][0][m][n][i] * rs, uu = acc[ai][1][m][n][i] * rs; o[n][i] = gg * sigm(gg) * uu; }
                *(u32x4*)(act + (size_t)row * 2816 + col0) = pack8(o[0], o[1]);
            }
    }
};
struct UberEpi { int mode, i0; unsigned char *p0, *p1, *p2; };
__device__ __forceinline__ void run_epi(const UberEpi& E, LAS unsigned char* lds, const f32x4 (&acc)[2][2][4][2], const Unit& u, int wr, int wc, int fr, int fq) {
    switch (E.mode) {
        case 0: { EpiZ e{(bf16_t*)E.p0, (const float*)E.p1, (bf16_t*)E.p2, E.i0}; e(acc, u, wr, wc, fr, fq); break; }
        case 1: { EpiGlu e{(bf16_t*)E.p0}; e(acc, u, wr, wc, fr, fq); break; }
        case 2: { EpiMix<0> e{(bf16_t*)E.p0, E.i0}; e(acc, u, wr, wc, fr, fq); break; }
        case 3: { EpiMix<1> e{(bf16_t*)E.p0, E.i0}; e(acc, u, wr, wc, fr, fq); break; }
        case 4: { EpiRes e{(float*)E.p0, (bf16_t*)E.p1, (float*)E.p2, (LAS float*)(lds + 131072)}; e(acc, u, wr, wc, fr, fq); break; }
        default: { EpiAct e{(bf16_t*)E.p0, (const float*)E.p1}; e(acc, u, wr, wc, fr, fq); break; }
    }
}
}

constexpr int NLAYER = 4, DM = 1024, ZN = 6144, ZW = 6208  , FFH = 2816, RG = 16384, RMAIN = 65536, VTLD = RG + 64  ;
constexpr size_t al256(size_t x) { return (x + 255) & ~(size_t)255; }
constexpr size_t WS_HB = 0;
constexpr size_t WS_SSQ = WS_HB + (size_t)RMAIN * DM * 2;
constexpr size_t WS_Z = WS_SSQ + (size_t)RMAIN * 4 * 4;
constexpr size_t WS_YB = WS_Z + (size_t)RG * ZW * 2;
constexpr size_t WS_VT = WS_YB + (size_t)RG * 512 * 2;
constexpr size_t WS_HGU = WS_VT + (size_t)512 * VTLD * 2;
constexpr size_t WS_HGP = WS_HGU + (size_t)260 * 8 * 4096 * 4;
constexpr size_t WS_S5S = WS_HGP + (size_t)260 * 8 * 64 * 4;
constexpr size_t WS_W = WS_S5S + (size_t)260 * 2048 * 8;
constexpr size_t W_IN = 0, W_UPA = W_IN + (size_t)6144 * 1024 * 2, W_UPB = W_UPA + (size_t)1024 * 256 * 2, W_UPC = W_UPB + (size_t)1024 * 512 * 2,
                 W_O = W_UPC + (size_t)1024 * 256 * 2, W_GU = W_O + (size_t)1024 * 1024 * 2, W_DN = W_GU + (size_t)5632 * 1024 * 2, W_GLU = W_DN + (size_t)1024 * 2816 * 2,
                 W_END = W_GLU + (size_t)256 * 256 * 2;
constexpr size_t WS_TAB = WS_W + W_END;
constexpr size_t T_LBAR = 0, T_L16 = T_LBAR + 2048 * 8, T_L64 = T_L16 + 2048 * 8, T_BFRAG = T_L64 + 2048 * 8, T_CFRAG = T_BFRAG + (size_t)32 * 8 * 64 * 16,
                 T_LB = T_CFRAG + (size_t)32 * 4 * 64 * 16, T_END = T_LB + 256 * 4;
constexpr size_t WS_META = al256(WS_TAB + T_END);
constexpr size_t M_H = 0, M_HB = M_H + (size_t)256 * 1024 * 4, M_SSQ = M_HB + (size_t)256 * 1024 * 2, M_Z = M_SSQ + (size_t)256 * 4 * 4, M_YB = M_Z + (size_t)256 * ZW * 2,
                 M_VT = M_YB + (size_t)256 * 512 * 2, M_ACT = M_VT + (size_t)512 * 256 * 2, M_END = M_ACT + (size_t)256 * FFH * 2;
constexpr size_t WS_CTL = al256(WS_META + M_END);
constexpr size_t CTL_BYTES = 16384;
constexpr size_t WS_TOTAL = WS_CTL + CTL_BYTES;
constexpr int LDS_ST_OFF = 135168;
constexpr int LDS_BYTES = 147456;

struct Args {
    const float *x_prompt, *x_sample, *meta_tokens, *norm1_g, *w_in, *a_re, *a_im, *log_dt, *b_re, *b_im, *c_re, *c_im, *s5_d, *w_glu, *rpb, *lb_logits, *onorm_g,
        *w_up_a, *w_up_b, *w_up_c, *w_o, *norm2_g, *w_gate, *w_up, *w_down, *final_g;
    float* out; unsigned char* ws;
};

__device__ __forceinline__ unsigned long long ufl(unsigned long long v) { const unsigned lo = __builtin_amdgcn_readfirstlane((unsigned)v), hi = __builtin_amdgcn_readfirstlane((unsigned)(v >> 32)); return ((unsigned long long)hi << 32) | lo; }
#define GAS __attribute__((address_space(1)))
template <int OFF> __device__ __forceinline__ unsigned long long ka_load() {
    unsigned long long v; const unsigned long long kp = ufl((unsigned long long)__builtin_amdgcn_kernarg_segment_ptr());
    asm volatile("s_load_dwordx2 %0, %1, %2\n\ts_waitcnt lgkmcnt(0)" : "=s"(v) : "s"(kp), "n"(OFF));
    return v;
}
#define KA(f) ((decltype(Args::f))(GAS char*)ka_load<(int)__builtin_offsetof(Args, f)>())
#define KAF(f) ((const float*)KA(f))
struct Ctx {
    bf16_t *hb, *z, *yb, *vt; float *ssq, *hgu, *hgp, *s5s;
    bf16_t *w; const float *lbar, *l16, *l64; const bf16_t *bfrag, *cfrag; const float* lb;
    float* mh; bf16_t *mhb, *mz, *myb, *mvt, *mact; float* mssq;
};

__device__ __forceinline__ void tr_item(const float* W, int K, int N, bf16_t* WT, const float* kscale, int mode, LAS float* scr, int item, int lane, bool valid) {
    const int nblk = N / 32, kb = item / nblk, nb = item % nblk, k0 = 64 * kb, n0 = 32 * nb;
    if (valid) {
#pragma unroll 8
    for (int i = 0; i < 32; ++i) { const int kk = 2 * i + (lane >> 5); float v = W[(size_t)(k0 + kk) * N + n0 + (lane & 31)]; if (kscale) v *= kscale[k0 + kk]; scr[kk * 33 + (lane & 31)] = v; }
    }
    __syncthreads();
    const int c = lane & 7;
    int drow0 = n0; if (mode) drow0 = (n0 >> 7) * 256 + (n0 & 127) + (mode == 2 ? 128 : 0);
    if (valid) {
#pragma unroll
    for (int j = 0; j < 4; ++j) { const int n = (lane >> 3) + 8 * j; const LAS float* s = scr + (8 * c) * 33 + n;
        u32x4 o; o.x = pk2(s[0 * 33], s[1 * 33]); o.y = pk2(s[2 * 33], s[3 * 33]); o.z = pk2(s[4 * 33], s[5 * 33]); o.w = pk2(s[6 * 33], s[7 * 33]);
        *(u32x4*)(WT + (size_t)(drow0 + n) * K + k0 + 8 * c) = o; }
    }
    __syncthreads();
}

__device__ __forceinline__ void prep_layer(const Ctx& X, int l, LAS unsigned char* lds, int G) {
    const int tid_ = opaque_tid(); const int wave = __builtin_amdgcn_readfirstlane(tid_ >> 6), lane = tid_ & 63;
    LAS float* scr = (LAS float*)(lds + wave * 16384);
    const int gw = blockIdx.x * 8 + wave, NGW = G * 8;
    constexpr int I0 = 16 * 192, I1 = 4 * 32, I2 = 8 * 32, I3 = 4 * 32, I4 = 16 * 32, I5 = 16 * 88, I6 = 16 * 88, I7 = 44 * 32, I8 = 4 * 8;
    constexpr int NIT = I0 + I1 + I2 + I3 + I4 + I5 + I6 + I7 + I8;
    unsigned char* wb = (unsigned char*)X.w;
    for (int it0 = 0; it0 < NIT; it0 += NGW) {
        const int it = it0 + gw; const bool valid = it < NIT;
        int r = valid ? it : 0;
        if (r < I0) { tr_item(KAF(w_in) + (size_t)l * 1024 * 6144, 1024, 6144, (bf16_t*)(wb + W_IN), KAF(norm1_g) + l * 1024, 0, scr, r, lane, valid); continue; } r -= I0;
        if (r < I1) { tr_item(KAF(w_up_a) + (size_t)l * 256 * 1024, 256, 1024, (bf16_t*)(wb + W_UPA), nullptr, 0, scr, r, lane, valid); continue; } r -= I1;
        if (r < I2) { tr_item(KAF(w_up_b) + (size_t)l * 512 * 1024, 512, 1024, (bf16_t*)(wb + W_UPB), nullptr, 0, scr, r, lane, valid); continue; } r -= I2;
        if (r < I3) { tr_item(KAF(w_up_c) + (size_t)l * 256 * 1024, 256, 1024, (bf16_t*)(wb + W_UPC), nullptr, 0, scr, r, lane, valid); continue; } r -= I3;
        if (r < I4) { tr_item(KAF(w_o) + (size_t)l * 1024 * 1024, 1024, 1024, (bf16_t*)(wb + W_O), nullptr, 0, scr, r, lane, valid); continue; } r -= I4;
        if (r < I5) { tr_item(KAF(w_gate) + (size_t)l * 1024 * 2816, 1024, 2816, (bf16_t*)(wb + W_GU), KAF(norm2_g) + l * 1024, 1, scr, r, lane, valid); continue; } r -= I5;
        if (r < I6) { tr_item(KAF(w_up) + (size_t)l * 1024 * 2816, 1024, 2816, (bf16_t*)(wb + W_GU), KAF(norm2_g) + l * 1024, 2, scr, r, lane, valid); continue; } r -= I6;
        if (r < I7) { tr_item(KAF(w_down) + (size_t)l * 2816 * 1024, 2816, 1024, (bf16_t*)(wb + W_DN), nullptr, 0, scr, r, lane, valid); continue; } r -= I7;
        tr_item(KAF(w_glu) + (size_t)l * 256 * 256, 256, 256, (bf16_t*)(wb + W_GLU), nullptr, 0, scr, r, lane, valid);
    }
    const int gt = blockIdx.x * 512 + tid_;
    if (gt < 2048) {
        const int dg = gt >> 6, p = gt & 63;
        const size_t pb = ((size_t)l * 32 + dg);
        const float are = KAF(a_re)[pb * 64 + p], aim = KAF(a_im)[pb * 64 + p], dt = expf(KAF(log_dt)[pb]);
        const float mag = expf(are * dt); float sn, cs; sincosf(aim * dt, &sn, &cs);
        const float lr = mag * cs, li = mag * sn;
        const float den = are * are + aim * aim, nr = lr - 1.0f, ni = li;
        const float zr = (nr * are + ni * aim) / den, zi = (ni * are - nr * aim) / den;
        float* lbar = (float*)X.lbar; float* l16 = (float*)X.l16; float* l64 = (float*)X.l64;
        lbar[gt * 2] = lr; lbar[gt * 2 + 1] = li;
        float pr = lr, pi = li;
#pragma unroll
        for (int s = 0; s < 4; ++s) { const float t = pr * pr - pi * pi; pi = 2.f * pr * pi; pr = t; }
        l16[gt * 2] = pr; l16[gt * 2 + 1] = pi;
#pragma unroll
        for (int s = 0; s < 2; ++s) { const float t = pr * pr - pi * pi; pi = 2.f * pr * pi; pr = t; }
        l64[gt * 2] = pr; l64[gt * 2 + 1] = pi;
        bf16_t* bfr = (bf16_t*)X.bfrag; bf16_t* cfr = (bf16_t*)X.cfrag;
        const int ntr = p >> 4, col = p & 15;
        for (int c = 0; c < 16; ++c) {
            const float br = KAF(b_re)[(pb * 64 + p) * 16 + c], bi = KAF(b_im)[(pb * 64 + p) * 16 + c];
            const float bbr = zr * br - zi * bi, bbi = zr * bi + zi * br;
            const int q = c >> 3, j = c & 7;
            bfr[(((size_t)dg * 8 + ntr) * 64 + col + 16 * q) * 8 + j] = (bf16_t)f2bf(bbr);
            bfr[(((size_t)dg * 8 + 4 + ntr) * 64 + col + 16 * q) * 8 + j] = (bf16_t)f2bf(bbi);
            bfr[(((size_t)dg * 8 + ntr) * 64 + col + 16 * (q + 2)) * 8 + j] = 0;
            bfr[(((size_t)dg * 8 + 4 + ntr) * 64 + col + 16 * (q + 2)) * 8 + j] = 0;
            const float cr = KAF(c_re)[(pb * 16 + c) * 64 + p], ci = KAF(c_im)[(pb * 16 + c) * 64 + p];
            { const int k = p;      cfr[(((size_t)dg * 4 + (k >> 5)) * 64 + c + 16 * ((k >> 3) & 3)) * 8 + (k & 7)] = (bf16_t)f2bf(cr); }
            { const int k = 64 + p; cfr[(((size_t)dg * 4 + (k >> 5)) * 64 + c + 16 * ((k >> 3) & 3)) * 8 + (k & 7)] = (bf16_t)f2bf(-ci); }
        }
    }
    if (gt >= 2048 && gt < 2048 + 256) {
        const int c = gt - 2048;
        const float l0 = KAF(lb_logits)[c], l1 = KAF(lb_logits)[256 + c], l2 = KAF(lb_logits)[512 + c], l3 = KAF(lb_logits)[768 + c];
        const float mx = fmaxf(fmaxf(l0, l1), fmaxf(l2, l3));
        const float e0 = expf(l0 - mx), e1 = expf(l1 - mx), e2 = expf(l2 - mx), e3 = expf(l3 - mx), inv = 1.f / (e0 + e1 + e2 + e3);
        float v = 0.f; if (l >= 1) v += e1 * inv; if (l >= 2) v += e2 * inv; if (l >= 3) v += e3 * inv;
        ((float*)X.lb)[c] = v;
    }
}

struct Grp { int g, nseq, Lr, nch, s0; };
__device__ __forceinline__ Grp make_grp(int g) { Grp r; r.g = g; r.nseq = g < 2 ? 4 : 1; r.Lr = g < 2 ? 4096 : 16384; r.nch = r.Lr / 64 + 1; r.s0 = g < 2 ? g * 4 : 8 + (g - 2); return r; }

template <bool OUT>
__device__ __forceinline__ void s5_chunk(const Ctx& X, const float* s5d, LAS float* buf, bf16_t* zc, int T, int ci, int wave, int lane) {
    const int p = lane, fr = lane & 15, fq = lane >> 4;
    for (int gi = 0; gi < 2; ++gi) {
        const int g = wave * 2 + gi;
        f32x4 yacc[2][2];
#pragma unroll
        for (int i = 0; i < 2; ++i)
#pragma unroll
            for (int j = 0; j < 2; ++j) yacc[i][j] = (f32x4){0.f, 0.f, 0.f, 0.f};
        bf16x8 ua[4];
#pragma unroll
        for (int m4 = 0; m4 < 4; ++m4) { ua[m4] = (bf16x8){0, 0, 0, 0, 0, 0, 0, 0}; if (fq < 2 && m4 * 16 < T) ua[m4] = *(const bf16x8*)(zc + (size_t)(m4 * 16 + fr) * ZW + g * 16 + fq * 8); }
#pragma unroll
        for (int dir = 0; dir < 2; ++dir) {
            const int dg = dir * 16 + g;
            bf16x8 bfr[8], cfr[4];
#pragma unroll
            for (int nt = 0; nt < 8; ++nt) bfr[nt] = *(const bf16x8*)(X.bfrag + (((size_t)dg * 8 + nt) * 64 + lane) * 8);
            if (OUT) {
#pragma unroll
                for (int ks = 0; ks < 4; ++ks) cfr[ks] = *(const bf16x8*)(X.cfrag + (((size_t)dg * 4 + ks) * 64 + lane) * 8);
            }
            const float lr = X.lbar[(dg * 64 + p) * 2], li = X.lbar[(dg * 64 + p) * 2 + 1];
            float xr = 0.f, xi = 0.f;
            float* st = X.s5s + ((size_t)ci * 2048 + dg * 64 + p) * 2;
            if (OUT) { xr = st[0]; xi = st[1]; }
#pragma unroll
            for (int sti = 0; sti < 2; ++sti) {
                const int stt = dir ? 1 - sti : sti; const int t0 = stt * 32;
                if (t0 < T) {
                    const int tn = (T - t0) < 32 ? (T - t0) : 32;
#pragma unroll
                    for (int mt = 0; mt < 2; ++mt) {
                        if (mt * 16 < tn) {
#pragma unroll
                            for (int nt = 0; nt < 8; ++nt) {
                                const f32x4 c = __builtin_amdgcn_mfma_f32_16x16x32_bf16(ua[stt * 2 + mt], bfr[nt], (f32x4){0.f, 0.f, 0.f, 0.f}, 0, 0, 0);
#pragma unroll
                                for (int r = 0; r < 4; ++r) buf[(mt * 16 + fq * 4 + r) * 132 + nt * 16 + fr] = c[r];
                            }
                        }
                    }
                    __syncthreads();
                    for (int k = 0; k < tn; ++k) {
                        const int t = dir ? (tn - 1 - k) : k;
                        const float br = buf[t * 132 + p], bi = buf[t * 132 + 64 + p];
                        const float nr = lr * xr - li * xi + br, ni = lr * xi + li * xr + bi;
                        xr = nr; xi = ni;
                        if (OUT) { buf[t * 132 + p] = xr; buf[t * 132 + 64 + p] = xi; }
                    }
                    if (OUT) {
                        __syncthreads();
#pragma unroll
                        for (int mt = 0; mt < 2; ++mt) {
                            if (mt * 16 < tn) {
#pragma unroll
                                for (int ks = 0; ks < 4; ++ks) {
                                    const LAS float* ap = buf + (mt * 16 + fr) * 132 + ks * 32 + fq * 8;
                                    const f32x4 a0 = *(const LAS f32x4*)ap, a1 = *(const LAS f32x4*)(ap + 4);
                                    const u32x4 aw = pack8(a0, a1);
                                    const bf16x8 av = __builtin_bit_cast(bf16x8, aw);
                                    yacc[stt][mt] = __builtin_amdgcn_mfma_f32_16x16x32_bf16(av, cfr[ks], yacc[stt][mt], 0, 0, 0);
                                }
                            }
                        }
                    }
                    __syncthreads();
                }
            }
            if (!OUT) { st[0] = xr; st[1] = xi; }
        }
        if (OUT) {
            const float dsk = s5d[g * 16 + fr];
            float uv[16];
#pragma unroll
            for (int q4 = 0; q4 < 4; ++q4)
#pragma unroll
                for (int r = 0; r < 4; ++r) { uv[q4 * 4 + r] = 0.f; if (q4 * 16 < T) uv[q4 * 4 + r] = bf2f(zc[(size_t)(q4 * 16 + fq * 4 + r) * ZW + g * 16 + fr]); }
#pragma unroll
            for (int stt = 0; stt < 2; ++stt)
#pragma unroll
                for (int mt = 0; mt < 2; ++mt) {
                    if (stt * 32 + mt * 16 < T) {
#pragma unroll
                        for (int r = 0; r < 4; ++r) {
                            const int t = stt * 32 + mt * 16 + fq * 4 + r;
                            const float y = gelu_tanh(yacc[stt][mt][r] + dsk * uv[(stt * 2 + mt) * 4 + r]);
                            zc[(size_t)t * ZW + 512 + g * 16 + fr] = (bf16_t)f2bf(y);
                        }
                    }
                }
        }
    }
}

__device__ __forceinline__ void s5_passB(const Ctx& X, const Grp& gp, int gtid, int GT) {
    const int n = gp.nseq * 2048;
    for (int e = gtid; e < n; e += GT) {
        const int sl = e >> 11, r = e & 2047, dir = r >> 10;
        const float l16r = X.l16[r * 2], l16i = X.l16[r * 2 + 1], l64r = X.l64[r * 2], l64i = X.l64[r * 2 + 1];
        float sr = 0.f, si = 0.f;
        for (int k0 = 0; k0 < gp.nch; k0 += 8) {
            float er[8], ei[8];
#pragma unroll
            for (int j = 0; j < 8; ++j) { const int k = k0 + j; if (k < gp.nch) { const int c = dir ? gp.nch - 1 - k : k; const float* pp = X.s5s + ((size_t)(sl * gp.nch + c) * 2048 + r) * 2; er[j] = pp[0]; ei[j] = pp[1]; } else { er[j] = 0.f; ei[j] = 0.f; } }
#pragma unroll
            for (int j = 0; j < 8; ++j) { const int k = k0 + j; if (k < gp.nch) { const int c = dir ? gp.nch - 1 - k : k; float* pp = X.s5s + ((size_t)(sl * gp.nch + c) * 2048 + r) * 2; pp[0] = sr; pp[1] = si;
                    const float pr = c == 0 ? l16r : l64r, pi = c == 0 ? l16i : l64i;
                    const float nr = pr * sr - pi * si + er[j], ni = pr * si + pi * sr + ei[j]; sr = nr; si = ni; } }
        }
    }
}

typedef short v4i16_t __attribute__((ext_vector_type(4)));
__device__ __forceinline__ v4i16_t vtr16(const LAS unsigned char* p) { return __builtin_amdgcn_ds_read_tr16_b64_v4i16((LAS v4i16_t*)p); }
template <bool OUT>
__device__ __forceinline__ void hg_chunk(const Ctx& X, LAS float* gt, LAS bf16_t* ot, const bf16_t* zc, int T, int ci, int wave, int lane) {
    const int h = wave >> 1, dir = wave & 1;
    float S[64];
    float* U = X.hgu + ((size_t)ci * 8 + wave) * 4096;
    if (OUT) {
#pragma unroll
        for (int d = 0; d < 64; ++d) S[d] = U[d * 64 + lane];
    } else {
#pragma unroll
        for (int d = 0; d < 64; ++d) S[d] = 0.f;
    }
    const float lbv = X.lb[h * 64 + lane], oml = 1.f - lbv; float P = 1.f;
    const int fcol = (dir ? 2304 : 2048) + h * 64 + lane, qcol = 1792 + h * 64 + lane, vcol = 2560 + h * 64 + lane;
    const int ns8 = T >> 3;
    bf16_t rq[8], rf[8], rv[8];
    {
        const int sb0 = dir ? (ns8 - 1) : 0;
#pragma unroll
        for (int j = 0; j < 8; ++j) { const bf16_t* zr = zc + (size_t)(sb0 * 8 + j) * ZW; rq[j] = zr[qcol]; rf[j] = zr[fcol]; rv[j] = zr[vcol]; }
    }
#pragma unroll 1
    for (int s8 = 0; s8 < ns8; ++s8) {
        const int sb = dir ? (ns8 - 1 - s8) : s8;
#pragma unroll
        for (int j = 0; j < 8; ++j) {
            const float q = bf2f(rq[j]), ff = bf2f(rf[j]);
            const float sg = sigm(ff), fg = lbv + oml * sg, kk = oml * (1.f - sg);
            gt[j * 256 + lane] = fg; gt[j * 256 + 64 + lane] = kk; gt[j * 256 + 128 + lane] = q * sigm(q); gt[j * 256 + 192 + lane] = bf2f(rv[j]);
            P *= fg;
        }
        __syncthreads();
        if (s8 + 1 < ns8) {
            const int sbn = dir ? (ns8 - 2 - s8) : s8 + 1;
#pragma unroll
            for (int j = 0; j < 8; ++j) { const bf16_t* zr = zc + (size_t)(sbn * 8 + j) * ZW; rq[j] = zr[qcol]; rf[j] = zr[fcol]; rv[j] = zr[vcol]; }
        }
#pragma unroll 1
        for (int jj = 0; jj < 8; ++jj) {
            const int j = dir ? 7 - jj : jj;
            const LAS float* gj = gt + j * 256;
            const float v = gj[192 + lane];
            float o = 0.f;
#pragma unroll
            for (int d4 = 0; d4 < 16; ++d4) {
                const f32x4 f4 = *(const LAS f32x4*)(gj + d4 * 4), k4 = *(const LAS f32x4*)(gj + 64 + d4 * 4);
#pragma unroll
                for (int i = 0; i < 4; ++i) S[d4 * 4 + i] = f4[i] * S[d4 * 4 + i] + k4[i] * v;
                if (OUT) { const f32x4 q4 = *(const LAS f32x4*)(gj + 128 + d4 * 4);
#pragma unroll
                    for (int i = 0; i < 4; ++i) o += S[d4 * 4 + i] * q4[i]; }
                if ((d4 & 3) == 3) __builtin_amdgcn_sched_barrier(0);
            }
            if (OUT) ot[(sb * 8 + j) * 64 + lane] = (bf16_t)f2bf(o);
        }
        __syncthreads();
    }
    if (!OUT) {
#pragma unroll
        for (int d = 0; d < 64; ++d) U[d * 64 + lane] = S[d];
        X.hgp[((size_t)ci * 8 + wave) * 64 + lane] = P;
    }
}

__device__ __forceinline__ void hg_passA_mfma(const Ctx& X, LAS unsigned char* wl, const bf16_t* zc, int T, int ci, int wave, int lane) {
    const int h = wave >> 1, dir = wave & 1, fq = lane >> 4, l16 = lane & 15, r8 = lane >> 3, pc = lane & 7;
    LAS unsigned char* kl = wl; LAS unsigned char* vl = wl + 4608;
    const float lbv = X.lb[h * 64 + lane], oml = 1.f - lbv;
    const int fcol = (dir ? 2304 : 2048) + h * 64 + lane, vcolb = 2560 + h * 64 + pc * 8;
    f32x4 acc[4][4];
#pragma unroll
    for (int a = 0; a < 4; ++a)
#pragma unroll
        for (int b = 0; b < 4; ++b) acc[a][b] = (f32x4){0.f, 0.f, 0.f, 0.f};
    float run = 1.f;
    const int nh = (T + 31) >> 5;
#pragma unroll 1
    for (int hh = 0; hh < nh; ++hh) {
        const int hb = dir ? hh : (nh - 1 - hh); const int t0 = hb * 32; const int tn = (T - t0) < 32 ? (T - t0) : 32;
        u32x4 vr[4];
#pragma unroll
        for (int i = 0; i < 4; ++i) { const int rr = i * 8 + r8; vr[i] = (u32x4){0u, 0u, 0u, 0u}; if (rr < tn) vr[i] = *(const u32x4*)(zc + (size_t)(t0 + rr) * ZW + vcolb); }
        __syncthreads();
#pragma unroll 1
        for (int bt = 0; bt < 2; ++bt) {
            const int j0 = (dir ? bt : 1 - bt) * 16;
            bf16_t rf[16];
#pragma unroll
            for (int j = 0; j < 16; ++j) { rf[j] = 0; if (j0 + j < tn) rf[j] = zc[(size_t)(t0 + j0 + j) * ZW + fcol]; }
#pragma unroll
            for (int jj = 0; jj < 16; ++jj) {
                const int jl = dir ? jj : 15 - jj; const int j = j0 + jl;
                float kh = 0.f;
                if (j < tn) { const float sg = sigm(bf2f(dir ? rf[jj] : rf[15 - jj])); kh = oml * (1.f - sg) * run; run *= lbv + oml * sg; }
                *(LAS bf16_t*)(kl + j * 144 + lane * 2) = (bf16_t)f2bf(kh);
            }
        }
#pragma unroll
        for (int i = 0; i < 4; ++i) *(LAS u32x4*)(vl + (i * 8 + r8) * 144 + pc * 16) = vr[i];
        __syncthreads();
        const int roff = (4 * fq + (l16 >> 2)) * 144 + (4 * (l16 & 3)) * 2;
        bf16x8 af[4];
#pragma unroll
        for (int mt = 0; mt < 4; ++mt) { const v4i16_t ta = vtr16(kl + roff + mt * 32), tb = vtr16(kl + roff + 16 * 144 + mt * 32); af[mt] = (bf16x8){ta[0], ta[1], ta[2], ta[3], tb[0], tb[1], tb[2], tb[3]}; }
#pragma unroll
        for (int nt = 0; nt < 4; ++nt) {
            const v4i16_t ta = vtr16(vl + roff + nt * 32), tb = vtr16(vl + roff + 16 * 144 + nt * 32);
            const bf16x8 bfv = (bf16x8){ta[0], ta[1], ta[2], ta[3], tb[0], tb[1], tb[2], tb[3]};
#pragma unroll
            for (int mt = 0; mt < 4; ++mt) acc[mt][nt] = __builtin_amdgcn_mfma_f32_16x16x32_bf16(af[mt], bfv, acc[mt][nt], 0, 0, 0);
        }
    }
    float* U = X.hgu + ((size_t)ci * 8 + wave) * 4096 + (4 * fq) * 64 + l16;
#pragma unroll
    for (int mt = 0; mt < 4; ++mt) {
#pragma unroll
        for (int r = 0; r < 4; ++r)
#pragma unroll
            for (int nt = 0; nt < 4; ++nt) U[(16 * mt + r) * 64 + 16 * nt] = acc[mt][nt][r];
        __builtin_amdgcn_sched_barrier(0);
    }
    X.hgp[((size_t)ci * 8 + wave) * 64 + lane] = run;
}

__device__ __forceinline__ void hg_passC_mfma(const Ctx& X, LAS unsigned char* wl, LAS bf16_t* ot, const bf16_t* zc, int T, int ci, int wave, int lane) {
    const int h = wave >> 1, dir = wave & 1, fq = lane >> 4, l16 = lane & 15, r8 = lane >> 3, pc = lane & 7;
    LAS unsigned char* ql = wl; LAS unsigned char* kl = wl + 2304; LAS unsigned char* vl = wl + 4608; LAS float* pl = (LAS float*)(wl + 6912);
    const float lbv = X.lb[h * 64 + lane], oml = 1.f - lbv;
    const int fcol = (dir ? 2304 : 2048) + h * 64 + lane, qcol = 1792 + h * 64 + lane, vcolb = 2560 + h * 64 + pc * 8;
    f32x4 sa[4][4];
    {
        const float* U = X.hgu + ((size_t)ci * 8 + wave) * 4096 + (4 * fq) * 64 + l16;
#pragma unroll
        for (int mt = 0; mt < 4; ++mt) {
#pragma unroll
            for (int r = 0; r < 4; ++r)
#pragma unroll
                for (int nt = 0; nt < 4; ++nt) sa[mt][nt][r] = U[(16 * mt + r) * 64 + 16 * nt];
            __builtin_amdgcn_sched_barrier(0);
        }
    }
    const int nsc = T >> 4;
#pragma unroll 1
    for (int sc = 0; sc < nsc; ++sc) {
        const int I = dir ? (nsc - 1 - sc) : sc;
        bf16_t rq[16], rf[16];
#pragma unroll
        for (int i = 0; i < 16; ++i) { const int tok = 16 * I + (dir ? 15 - i : i); rq[i] = zc[(size_t)tok * ZW + qcol]; rf[i] = zc[(size_t)tok * ZW + fcol]; }
        u32x4 vr[2];
#pragma unroll
        for (int i8 = 0; i8 < 2; ++i8) { const int i = i8 * 8 + r8; const int tok = 16 * I + (dir ? 15 - i : i); vr[i8] = *(const u32x4*)(zc + (size_t)tok * ZW + vcolb); }
        __syncthreads();
        float c = 1.f;
#pragma unroll
        for (int i = 0; i < 16; ++i) {
            const float q = bf2f(rq[i]), sg = sigm(bf2f(rf[i]));
            c *= lbv + oml * sg;
            *(LAS bf16_t*)(ql + i * 144 + lane * 2) = (bf16_t)f2bf(q * sigm(q) * c);
            *(LAS bf16_t*)(kl + i * 144 + lane * 2) = (bf16_t)f2bf(oml * (1.f - sg) / c);
        }
        pl[lane] = c;
#pragma unroll
        for (int i8 = 0; i8 < 2; ++i8) *(LAS u32x4*)(vl + (i8 * 8 + r8) * 144 + pc * 16) = vr[i8];
        __syncthreads();
        f32x4 at = (f32x4){0.f, 0.f, 0.f, 0.f};
#pragma unroll
        for (int ks = 0; ks < 2; ++ks) at = __builtin_amdgcn_mfma_f32_16x16x32_bf16(*(const LAS bf16x8*)(kl + l16 * 144 + (32 * ks + 8 * fq) * 2), *(const LAS bf16x8*)(ql + l16 * 144 + (32 * ks + 8 * fq) * 2), at, 0, 0, 0);
#pragma unroll
        for (int r = 0; r < 4; ++r) if (4 * fq + r > l16) at[r] = 0.f;
        const bf16x8 atf = __builtin_bit_cast(bf16x8, pack8(at, (f32x4){0.f, 0.f, 0.f, 0.f}));
        const int roff = (4 * fq + (l16 >> 2)) * 144 + (4 * (l16 & 3)) * 2;
        f32x4 oT[4];
#pragma unroll
        for (int et = 0; et < 4; ++et) {
            const v4i16_t tv = vtr16(vl + roff + et * 32);
            const bf16x8 vf = (bf16x8){tv[0], tv[1], tv[2], tv[3], 0, 0, 0, 0};
            oT[et] = __builtin_amdgcn_mfma_f32_16x16x32_bf16(vf, atf, (f32x4){0.f, 0.f, 0.f, 0.f}, 0, 0, 0);
        }
#pragma unroll
        for (int kp = 0; kp < 2; ++kp) {
            const u32x2 q0 = *(const LAS u32x2*)(ql + l16 * 144 + (32 * kp + 4 * fq) * 2), q1 = *(const LAS u32x2*)(ql + l16 * 144 + (32 * kp + 16 + 4 * fq) * 2);
            const bf16x8 qfr = __builtin_bit_cast(bf16x8, (u32x4){q0.x, q0.y, q1.x, q1.y});
#pragma unroll
            for (int nt = 0; nt < 4; ++nt) {
                const bf16x8 sf = __builtin_bit_cast(bf16x8, pack8(sa[2 * kp][nt], sa[2 * kp + 1][nt]));
                oT[nt] = __builtin_amdgcn_mfma_f32_16x16x32_bf16(sf, qfr, oT[nt], 0, 0, 0);
            }
        }
        {
            const int tok = 16 * I + (dir ? 15 - l16 : l16);
#pragma unroll
            for (int et = 0; et < 4; ++et)
#pragma unroll
                for (int r = 0; r < 4; ++r) ot[tok * 64 + 16 * et + 4 * fq + r] = (bf16_t)f2bf(oT[et][r]);
        }
        bf16x8 kf[4];
#pragma unroll
        for (int mt = 0; mt < 4; ++mt) { const v4i16_t tk = vtr16(kl + roff + mt * 32); kf[mt] = (bf16x8){tk[0], tk[1], tk[2], tk[3], 0, 0, 0, 0}; }
#pragma unroll
        for (int nt = 0; nt < 4; ++nt) {
            const v4i16_t tv = vtr16(vl + roff + nt * 32);
            const bf16x8 vf = (bf16x8){tv[0], tv[1], tv[2], tv[3], 0, 0, 0, 0};
#pragma unroll
            for (int mt = 0; mt < 4; ++mt) sa[mt][nt] = __builtin_amdgcn_mfma_f32_16x16x32_bf16(kf[mt], vf, sa[mt][nt], 0, 0, 0);
        }
#pragma unroll
        for (int mt = 0; mt < 4; ++mt) {
            const f32x4 p4 = *(const LAS f32x4*)(pl + 16 * mt + 4 * fq);
#pragma unroll
            for (int nt = 0; nt < 4; ++nt) sa[mt][nt] = sa[mt][nt] * p4;
        }
    }
}

__device__ __forceinline__ void hg_passB(const Ctx& X, const Grp& gp, int gtid, int GT) {
    const int n = gp.nseq * 32768;
    for (int e = gtid; e < n; e += GT) {
        const int sl = e >> 15, r = e & 32767, hd = r >> 12, de = r & 4095, d = de >> 6, dir = hd & 1;
        const size_t cb0 = (size_t)(sl * gp.nch) * 8 + hd; const int cstep = dir ? -8 : 8; const size_t cfirst = dir ? cb0 + (size_t)(gp.nch - 1) * 8 : cb0;
        float s = 0.f;
        float u[2][8], pv[2][8];
#pragma unroll
        for (int j = 0; j < 8; ++j) { u[0][j] = 0.f; pv[0][j] = 0.f; if (j < gp.nch) { const size_t cb = cfirst + (long)j * cstep; u[0][j] = X.hgu[cb * 4096 + de]; pv[0][j] = X.hgp[cb * 64 + d]; } }
        for (int k0 = 0; k0 < gp.nch; k0 += 16) {
#pragma unroll
            for (int hb = 0; hb < 2; ++hb) {
                const int kb = k0 + hb * 8;
                if (kb < gp.nch) {
#pragma unroll
                    for (int j = 0; j < 8; ++j) { const int k = kb + 8 + j; u[1 - hb][j] = 0.f; pv[1 - hb][j] = 0.f; if (k < gp.nch) { const size_t cb = cfirst + (long)k * cstep; u[1 - hb][j] = X.hgu[cb * 4096 + de]; pv[1 - hb][j] = X.hgp[cb * 64 + d]; } }
#pragma unroll
                    for (int j = 0; j < 8; ++j) { const int k = kb + j; if (k < gp.nch) { const size_t cb = cfirst + (long)k * cstep; X.hgu[cb * 4096 + de] = s; s = pv[hb][j] * s + u[hb][j]; } }
                }
            }
        }
    }
}

__device__ __forceinline__ void na_task(const Ctx& X, const float* rpb, const Grp& gp, int sl, int task, bool metaq, int wave, int lane, LAS unsigned char* vl) {
    const int h = wave, fr = lane & 15, fq = lane >> 4;
    const int s = gp.s0 + sl, rows = gp.Lr >> 6;
    int r = 0, n = 0, rs = 0, ks = 0;
    const bf16_t* qptr; bf16_t* optr; size_t ostride = 512;
    if (metaq) { qptr = X.mz + (size_t)(s * 16 + fr) * ZW; optr = X.myb + (size_t)(s * 16) * 512; }
    else {
        r = task >> 2; n = task & 3;
        rs = r - 4; rs = rs < 0 ? 0 : (rs > rows - 8 ? rows - 8 : rs);
        ks = 16 * n - 8; ks = ks < 0 ? 0 : (ks > 32 ? 32 : ks);
        const size_t qrow0 = (size_t)sl * gp.Lr + r * 64 + 16 * n;
        qptr = X.z + (qrow0 + fr) * ZW; optr = X.yb + qrow0 * 512;
    }
    bf16x8 qf[2];
#pragma unroll
    for (int kk = 0; kk < 2; ++kk) qf[kk] = *(const bf16x8*)(qptr + 256 + h * 64 + 32 * kk + 8 * fq);
    f32x4 sc[17];
    {
        const bf16_t* kp = X.mz + (size_t)(s * 16 + fr) * ZW + 768 + h * 64 + 8 * fq;
        f32x4 c = (f32x4){0.f, 0.f, 0.f, 0.f};
#pragma unroll
        for (int kk = 0; kk < 2; ++kk) c = __builtin_amdgcn_mfma_f32_16x16x32_bf16(*(const bf16x8*)(kp + 32 * kk), qf[kk], c, 0, 0, 0);
        sc[0] = c * 0.125f;
    }
    const int qc = 16 * n + fr;
    int wstart = qc - 8; wstart = wstart < 0 ? 0 : (wstart > 48 ? 48 : wstart);
    const size_t krow_base = (size_t)sl * gp.Lr + (size_t)rs * 64 + ks;
    if (!metaq) {
#pragma unroll
        for (int tb = 0; tb < 2; ++tb) {
            bf16x8 kf[8][2]; float bz[8][4];
#pragma unroll
            for (int t4 = 0; t4 < 8; ++t4) {
                const int tt = tb * 8 + t4, kj = tt >> 1, half = tt & 1;
                const bf16_t* kp = X.z + (krow_base + kj * 64 + 16 * half + fr) * ZW + 768 + h * 64 + 8 * fq;
                kf[t4][0] = *(const bf16x8*)kp; kf[t4][1] = *(const bf16x8*)(kp + 32);
            }
#pragma unroll
            for (int t4 = 0; t4 < 8; ++t4) {
                const int tt = tb * 8 + t4, kj = tt >> 1, half = tt & 1;
                const float* rp = rpb + (h * 15 + (rs + kj - r + 7)) * 31;
#pragma unroll
                for (int i = 0; i < 4; ++i) { int dc = ks + 16 * half + 4 * fq + i - qc; dc = dc < -15 ? -15 : (dc > 15 ? 15 : dc); bz[t4][i] = rp[dc + 15]; }
            }
            __builtin_amdgcn_sched_barrier(0);
#pragma unroll
            for (int t4 = 0; t4 < 8; ++t4) {
                const int tt = tb * 8 + t4, half = tt & 1;
                f32x4 c = (f32x4){0.f, 0.f, 0.f, 0.f};
                c = __builtin_amdgcn_mfma_f32_16x16x32_bf16(kf[t4][0], qf[0], c, 0, 0, 0);
                c = __builtin_amdgcn_mfma_f32_16x16x32_bf16(kf[t4][1], qf[1], c, 0, 0, 0);
#pragma unroll
                for (int i = 0; i < 4; ++i) {
                    const int kc = ks + 16 * half + 4 * fq + i;
                    const bool valid = (kc >= wstart) && (kc < wstart + 16);
                    c[i] = valid ? c[i] * 0.125f + bz[t4][i] : -1e30f;
                }
                sc[1 + tt] = c;
            }
            __builtin_amdgcn_sched_barrier(0);
        }
    } else {
#pragma unroll
        for (int tt = 0; tt < 16; ++tt) sc[1 + tt] = (f32x4){-1e30f, -1e30f, -1e30f, -1e30f};
    }
    float mx = -1e30f;
#pragma unroll
    for (int t = 0; t < 17; ++t)
#pragma unroll
        for (int i = 0; i < 4; ++i) mx = fmaxf(mx, sc[t][i]);
    mx = fmaxf(mx, __shfl_xor(mx, 16)); mx = fmaxf(mx, __shfl_xor(mx, 32));
    float sum = 0.f;
#pragma unroll
    for (int t = 0; t < 17; ++t)
#pragma unroll
        for (int i = 0; i < 4; ++i) { const float e = __expf(sc[t][i] - mx); sc[t][i] = e; sum += e; }
    sum += __shfl_xor(sum, 16); sum += __shfl_xor(sum, 32);
    const float inv = 1.f / sum;
    f32x4 oacc[4];
#pragma unroll
    for (int et = 0; et < 4; ++et) oacc[et] = (f32x4){0.f, 0.f, 0.f, 0.f};
    {
        const int r8 = lane >> 3, pc = lane & 7, l16 = lane & 15;
        const int vcol = 1280 + h * 64 + pc * 8;
        u32x4 vreg[8];
#pragma unroll
        for (int i = 0; i < 2; ++i) vreg[i] = *(const u32x4*)(X.mz + (size_t)(s * 16 + i * 8 + r8) * ZW + vcol);
#pragma unroll
        for (int cc = 0; cc < 5; ++cc) {
            if (cc > 0 && metaq) break;
            __syncthreads();
#pragma unroll
            for (int i = 0; i < 8; ++i) if (cc > 0 || i < 2) *(LAS u32x4*)(vl + (i * 8 + r8) * 144 + pc * 16) = vreg[i];
            __syncthreads();
            if (cc < 4 && !metaq) {
#pragma unroll
                for (int i = 0; i < 8; ++i) { const int rr = i * 8 + r8;
                    vreg[i] = *(const u32x4*)(X.z + (krow_base + (size_t)(2 * cc + (rr >> 5)) * 64 + (rr & 31)) * ZW + vcol); }
            }
#pragma unroll
            for (int ksl = 0; ksl < 2; ++ksl) {
                if (cc == 0 && ksl == 1) break;
                const int tt = 4 * (cc - 1) + 2 * ksl;
                f32x4 pa, pb;
                if (cc == 0) { pa = sc[0] * inv; pb = (f32x4){0.f, 0.f, 0.f, 0.f}; } else { pa = sc[1 + tt] * inv; pb = sc[2 + tt] * inv; }
                const bf16x8 pf = __builtin_bit_cast(bf16x8, pack8(pa, pb));
                const LAS unsigned char* rowp = vl + (32 * ksl + 4 * fq + (l16 >> 2)) * 144 + (4 * (l16 & 3)) * 2;
#pragma unroll
                for (int et = 0; et < 4; ++et) {
                    const v4i16_t ta = vtr16(rowp + et * 32);
                    v4i16_t tb = (v4i16_t){0, 0, 0, 0};
                    if (cc > 0) tb = vtr16(rowp + 16 * 144 + et * 32);
                    const bf16x8 vw = (bf16x8){ta[0], ta[1], ta[2], ta[3], tb[0], tb[1], tb[2], tb[3]};
                    oacc[et] = __builtin_amdgcn_mfma_f32_16x16x32_bf16(pf, vw, oacc[et], 0, 0, 0);
                }
            }
        }
    }
#pragma unroll
    for (int et = 0; et < 4; ++et)
#pragma unroll
        for (int i = 0; i < 4; ++i) optr[(size_t)(4 * fq + i) * ostride + h * 64 + et * 16 + fr] = (bf16_t)f2bf(oacc[et][i]);
}

#define XB_TMO      128
#define XB_XCNT(j)  (256  + 64 * (j))
#define XB_XSUB(j)  (1280 + 64 * (j))
#define XB_XGEN(j)  (2304 + 64 * (j))
#define XB_TOP      3328
#define XB_TOPGEN   3392
#define XCD_BAR_WORDS 3456
#define XB_SPIN_CAP (1u << 22)
__device__ __forceinline__ unsigned xb_ld(unsigned* p)              { return __hip_atomic_load(p, __ATOMIC_RELAXED, __HIP_MEMORY_SCOPE_AGENT); }
__device__ __forceinline__ unsigned xb_add(unsigned* p, unsigned v) { return __hip_atomic_fetch_add(p, v, __ATOMIC_RELAXED, __HIP_MEMORY_SCOPE_AGENT); }
__device__ __forceinline__ unsigned xb_xcc_id() { return (unsigned)__builtin_amdgcn_s_getreg((3 << 11) | 20) & 0xFu; }
#define XB_SPIN(cond, bar) do { unsigned _sp = 0; while (cond) { __builtin_amdgcn_s_sleep(1); \
    if ((++_sp & 255u) == 0u) { if (xb_ld(&(bar)[XB_TMO])) break; if (_sp > XB_SPIN_CAP) { atomicAdd(&(bar)[XB_TMO], 1u); break; } } } } while (0)
__device__ __forceinline__ void xcd_barrier_complete(unsigned* bar, unsigned x, unsigned& nloc, unsigned& nx) {
    const unsigned G = gridDim.x * gridDim.y * gridDim.z;
    unsigned sum, cnt, mine, sp = 0u;
    for (;;) {
        sum = 0u; cnt = 0u; mine = 0u;
#pragma unroll
        for (unsigned j = 0; j < 16; ++j) { const unsigned c = xb_ld(&bar[XB_XCNT(j)]); sum += c; cnt += (c > 0u) ? 1u : 0u; mine = (j == x) ? c : mine; }
        if (sum == G) break;
        __builtin_amdgcn_s_sleep(1);
        if ((++sp & 255u) == 0u) { if (xb_ld(&bar[XB_TMO])) break; if (sp > XB_SPIN_CAP) { atomicAdd(&bar[XB_TMO], 1u); break; } }
    }
    nloc = mine > 0u ? mine : 1u; nx = cnt > 0u ? cnt : 1u;
}
__device__ __forceinline__ void xcd_barrier(unsigned* bar, volatile LAS unsigned* st) {
    asm volatile("s_waitcnt vmcnt(0)" ::: "memory");
    __syncthreads();
    if (threadIdx.x == 0) {
        const unsigned x = xb_xcc_id();
        __builtin_amdgcn_s_waitcnt(0);
        unsigned nloc = st[0], nx = st[1];
        if (nloc == 0u) { xcd_barrier_complete(bar, x, nloc, nx); st[0] = nloc; st[1] = nx; }
        const unsigned old = xb_add(&bar[XB_XSUB(x)], 1u);
        const unsigned gen = old / nloc;
        if (old + 1u == (gen + 1u) * nloc) {
            __builtin_amdgcn_fence(__ATOMIC_RELEASE, "agent");
            asm volatile("s_waitcnt vmcnt(0)" ::: "memory");
            const unsigned og = xb_add(&bar[XB_TOP], 1u);
            const unsigned tg = og / nx;
            if (og + 1u == (tg + 1u) * nx) xb_add(&bar[XB_TOPGEN], 1u);
            else XB_SPIN(xb_ld(&bar[XB_TOPGEN]) == tg, bar);
            __builtin_amdgcn_fence(__ATOMIC_ACQUIRE, "agent");
            xb_add(&bar[XB_XGEN(x)], 1u);
            asm volatile("s_waitcnt vmcnt(0)" ::: "memory");
        } else {
            XB_SPIN(xb_ld(&bar[XB_XGEN(x)]) == gen, bar);
            __builtin_amdgcn_fence(__ATOMIC_ACQUIRE, "agent");
            asm volatile("s_waitcnt vmcnt(0)" ::: "memory");
        }
    }
    __syncthreads();
}
#define GRID_SYNC() xcd_barrier((unsigned*)(KA(ws) + WS_CTL), (volatile LAS unsigned*)(lds + LDS_ST_OFF))
__device__ __forceinline__ Ctx make_ctx(unsigned char* ws) {
    Ctx X;
    X.hb = (bf16_t*)(ws + WS_HB); X.ssq = (float*)(ws + WS_SSQ); X.z = (bf16_t*)(ws + WS_Z); X.yb = (bf16_t*)(ws + WS_YB); X.vt = (bf16_t*)(ws + WS_VT);
    X.hgu = (float*)(ws + WS_HGU); X.hgp = (float*)(ws + WS_HGP); X.s5s = (float*)(ws + WS_S5S); X.w = (bf16_t*)(ws + WS_W);
    X.lbar = (const float*)(ws + WS_TAB + T_LBAR); X.l16 = (const float*)(ws + WS_TAB + T_L16); X.l64 = (const float*)(ws + WS_TAB + T_L64);
    X.bfrag = (const bf16_t*)(ws + WS_TAB + T_BFRAG); X.cfrag = (const bf16_t*)(ws + WS_TAB + T_CFRAG); X.lb = (const float*)(ws + WS_TAB + T_LB);
    X.mh = (float*)(ws + WS_META + M_H); X.mhb = (bf16_t*)(ws + WS_META + M_HB); X.mssq = (float*)(ws + WS_META + M_SSQ); X.mz = (bf16_t*)(ws + WS_META + M_Z);
    X.myb = (bf16_t*)(ws + WS_META + M_YB); X.mvt = (bf16_t*)(ws + WS_META + M_VT); X.mact = (bf16_t*)(ws + WS_META + M_ACT);
    return X;
}

__device__ __forceinline__ bool make_job(unsigned char* ws, float* out, int l, int g, int ph, int j, pg8::Gemm& gm, pg8::UberEpi& ep) {
    const bool mchain = (g == 3) && (l < NLAYER - 1);
    int njobs = 1; bool meta = false; int sub = j;
    if (ph == 0) { njobs = (g == 0) ? 2 : 1; meta = (j == 1); }
    else if (ph == 4) { njobs = (g == 3) ? 2 : 1; meta = (j == 1); }
    else if (ph == 5) { njobs = mchain ? 6 : 3; meta = (j >= 3); sub = j % 3; }
    else { njobs = mchain ? 2 : 1; meta = (j == 1); }
    if (j >= njobs) return false;
    unsigned char* wb = ws + WS_W;
    const size_t r0 = (size_t)g * RG;
    unsigned char* mb = ws + WS_META;
    bf16_t* z = meta ? (bf16_t*)(mb + M_Z) : (bf16_t*)(ws + WS_Z);
    bf16_t* hb = meta ? (bf16_t*)(mb + M_HB) : (bf16_t*)(ws + WS_HB) + r0 * DM;
    float* ssq = meta ? (float*)(mb + M_SSQ) : (float*)(ws + WS_SSQ) + r0 * 4;
    float* h = meta ? (float*)(mb + M_H) : out + r0 * DM;
    bf16_t* yb = meta ? (bf16_t*)(mb + M_YB) : (bf16_t*)(ws + WS_YB);
    bf16_t* vt = meta ? (bf16_t*)(mb + M_VT) : (bf16_t*)(ws + WS_VT);
    bf16_t* act = meta ? (bf16_t*)(mb + M_ACT) : (bf16_t*)(ws + WS_Z);
    gm.M = meta ? 256 : RG;
    ep.i0 = 0; ep.p0 = nullptr; ep.p1 = nullptr; ep.p2 = nullptr;
    if (ph == 0) { gm.A = hb; gm.lda = DM; gm.Bt = (const bf16_t*)(wb + W_IN); gm.N = ZN; gm.K = DM; ep.mode = 0; ep.p0 = (unsigned char*)z; ep.p1 = (unsigned char*)ssq; ep.p2 = (unsigned char*)vt; ep.i0 = meta ? 256 : VTLD; }
    else if (ph == 4) { gm.A = z + 512; gm.lda = ZW; gm.Bt = (const bf16_t*)(wb + W_GLU); gm.N = 256; gm.K = 256; ep.mode = 1; ep.p0 = (unsigned char*)z; }
    else if (ph == 5) {
        gm.N = DM; ep.p0 = (unsigned char*)z;
        if (sub == 0) { gm.A = yb; gm.lda = 512; gm.Bt = (const bf16_t*)(wb + W_UPB); gm.K = 512; ep.mode = 2; ep.i0 = 4096; }
        else if (sub == 1) { gm.A = z + 256; gm.lda = ZW; gm.Bt = (const bf16_t*)(wb + W_UPC); gm.K = 256; ep.mode = 3; ep.i0 = 5120; }
        else { gm.A = z; gm.lda = ZW; gm.Bt = (const bf16_t*)(wb + W_UPA); gm.K = 256; ep.mode = 3; ep.i0 = 3072; }
    }
    else if (ph == 6) { gm.A = z + 1024; gm.lda = ZW; gm.Bt = (const bf16_t*)(wb + W_O); gm.N = DM; gm.K = DM; ep.mode = 4; ep.p0 = (unsigned char*)h; ep.p1 = (unsigned char*)hb; ep.p2 = (unsigned char*)ssq; }
    else if (ph == 7) { gm.A = hb; gm.lda = DM; gm.Bt = (const bf16_t*)(wb + W_GU); gm.N = 2 * FFH; gm.K = DM; ep.mode = 5; ep.p0 = (unsigned char*)act; ep.p1 = (unsigned char*)ssq; }
    else { gm.A = act; gm.lda = FFH; gm.Bt = (const bf16_t*)(wb + W_DN); gm.N = DM; gm.K = FFH; ep.mode = 4; ep.p0 = (unsigned char*)h; ep.p1 = (unsigned char*)hb; ep.p2 = (unsigned char*)ssq; }
    return true;
}

__device__ __forceinline__ void prologue(int G) {
    const int tid_ = opaque_tid(); const int lane = tid_ & 63, gw = blockIdx.x * 8 + __builtin_amdgcn_readfirstlane(tid_ >> 6), NGW = G * 8;
    const Ctx X = make_ctx(((unsigned char*)KA(ws)));
    for (int row = gw; row < RMAIN + 256; row += NGW) {
        const bool ismeta = row >= RMAIN; const int mr = row - RMAIN;
        const float* src = ismeta ? (mr < 160 ? KAF(meta_tokens) + (size_t)(mr & 15) * DM : nullptr) : (row < 32768 ? KAF(x_prompt) + (size_t)row * DM : KAF(x_sample) + (size_t)(row - 32768) * DM);
        float* hd = ismeta ? X.mh + (size_t)mr * DM : ((float*)KA(out)) + (size_t)row * DM;
        bf16_t* hbd = ismeta ? X.mhb + (size_t)mr * DM : X.hb + (size_t)row * DM;
        float* sq = ismeta ? X.mssq + (size_t)mr * 4 : X.ssq + (size_t)row * 4;
        float ss = 0.f;
#pragma unroll
        for (int j = 0; j < 4; ++j) {
            f32x4 v = (f32x4){0.f, 0.f, 0.f, 0.f}; if (src) v = *(const f32x4*)(src + j * 256 + lane * 4);
            *(f32x4*)(hd + j * 256 + lane * 4) = v;
            *(u32x2*)(hbd + j * 256 + lane * 4) = (u32x2){pk2(v[0], v[1]), pk2(v[2], v[3])};
            ss += (v[0] * v[0] + v[1] * v[1]) + (v[2] * v[2] + v[3] * v[3]);
        }
        ss = wave_sum(ss);
        if (lane < 4) sq[lane] = lane == 0 ? ss : 0.f;
    }
}

__device__ __forceinline__ void mixer_phase_A(int l, int g, LAS unsigned char* lds, int G, int bid) {
    const int tid_ = opaque_tid(); const int lane = tid_ & 63, wave = __builtin_amdgcn_readfirstlane(tid_ >> 6);
    const Ctx X = make_ctx(((unsigned char*)KA(ws))); const Grp gp = make_grp(g);
    const float* rpb = KAF(rpb) + (size_t)l * 8 * 15 * 31; const float* s5d = KAF(s5_d) + l * 256;
    const int nna = gp.nseq * (gp.Lr / 16), nmq = gp.nseq, nct = gp.nseq * (gp.nch - 1);
    const int ntask = nna + nmq + 2 * nct;
    const bool xmap = (nna % 256 == 0) && ((volatile LAS unsigned*)(lds + LDS_ST_OFF))[4] != 0u;
    if (xmap) {
        const int xcc = (int)((volatile LAS unsigned*)(lds + LDS_ST_OFF))[2], xrk = (int)((volatile LAS unsigned*)(lds + LDS_ST_OFF))[3];
        const int per = gp.Lr / 16, nx = nna / 8, rounds = nna / 256;
        for (int i = 0; i < rounds; ++i) { const int t = xcc * nx + xrk + 32 * i; na_task(X, rpb, gp, t / per, t % per, false, wave, lane, lds + wave * 9216); }
    }
    for (int t = bid + (xmap ? nna : 0); t < ntask; t += G) {
        __syncthreads();
        if (t < nna) { const int per = gp.Lr / 16; na_task(X, rpb, gp, t / per, t % per, false, wave, lane, lds + wave * 9216); }
        else if (t < nna + nmq) { na_task(X, rpb, gp, t - nna, 0, true, wave, lane, lds + wave * 9216); }
        else {
            const int u = t - nna - nmq; const bool isS5 = u < nct; const int v = isS5 ? u : u - nct;
            const int sl = v / (gp.nch - 1), c1 = v % (gp.nch - 1) + 1;
            for (int c = (c1 == 1 ? 0 : c1); c <= c1; ++c) {
                __syncthreads();
                const int ci = sl * gp.nch + c; const int T = c == 0 ? 16 : 64;
                bf16_t* zc = c == 0 ? X.mz + (size_t)((gp.s0 + sl) * 16) * ZW : X.z + ((size_t)sl * gp.Lr + 64 * (c - 1)) * ZW;
                if (isS5) s5_chunk<false>(X, s5d, (LAS float*)(lds + wave * 16896), zc, T, ci, wave, lane);
                else hg_passA_mfma(X, lds + wave * 9216, zc, T, ci, wave, lane);
            }
        }
    }
}

__device__ __forceinline__ void mixer_phase_C(int l, int g, LAS unsigned char* lds, int G, int bid) {
    const int tid_ = opaque_tid(); const int lane = tid_ & 63, wave = __builtin_amdgcn_readfirstlane(tid_ >> 6);
    const Ctx X = make_ctx(((unsigned char*)KA(ws))); const Grp gp = make_grp(g);
    const float* s5d = KAF(s5_d) + l * 256; const float* ong = KAF(onorm_g) + l * 64;
    const int nct = gp.nseq * (gp.nch - 1);
    for (int t = bid; t < 2 * nct; t += G) {
        const bool isS5 = t < nct; const int v = isS5 ? t : t - nct;
        const int sl = v / (gp.nch - 1), c1 = v % (gp.nch - 1) + 1;
        for (int c = (c1 == 1 ? 0 : c1); c <= c1; ++c) {
            __syncthreads();
            const int ci = sl * gp.nch + c; const int T = c == 0 ? 16 : 64;
            bf16_t* zc = c == 0 ? X.mz + (size_t)((gp.s0 + sl) * 16) * ZW : X.z + ((size_t)sl * gp.Lr + 64 * (c - 1)) * ZW;
            if (isS5) s5_chunk<true>(X, s5d, (LAS float*)(lds + wave * 16896), zc, T, ci, wave, lane);
            else {
                hg_passC_mfma(X, lds + wave * 7168, (LAS bf16_t*)(lds + 65536 + wave * 8192), zc, T, ci, wave, lane);
                __syncthreads();
                const int h = wave >> 1, half = wave & 1;
                const LAS bf16_t* of = (const LAS bf16_t*)(lds + 65536 + (2 * h) * 8192); const LAS bf16_t* ob = (const LAS bf16_t*)(lds + 65536 + (2 * h + 1) * 8192);
                const float gn = ong[lane];
                const int tt0 = half * (T / 2);
                float gov[32];
#pragma unroll
                for (int i = 0; i < 32; ++i) { gov[i] = 0.f; if (i < T / 2) gov[i] = bf2f(zc[(size_t)(tt0 + i) * ZW + 2816 + h * 64 + lane]); }
#pragma unroll
                for (int i = 0; i < 32; ++i) {
                    if (i < T / 2) {
                        const int tt = tt0 + i;
                        const float o = bf2f(of[tt * 64 + lane]) + bf2f(ob[tt * 64 + lane]);
                        const float ms = wave_sum(o * o) * (1.0f / 64.0f);
                        const float go = gov[i];
                        zc[(size_t)tt * ZW + 256 + h * 64 + lane] = (bf16_t)f2bf(o * rsqrtf(ms + 1e-6f) * gn * (go * sigm(go)));
                    }
                }
            }
        }
    }
}

__global__ void __launch_bounds__(512, 2) fwd_kernel(Args a) {
    extern __shared__ __attribute__((aligned(16))) unsigned char lds_raw[];
    LAS unsigned char* lds = (LAS unsigned char*)lds_raw;
    const int G = gridDim.x, bid = blockIdx.x;

    if (threadIdx.x < 2) ((volatile LAS unsigned*)(lds + LDS_ST_OFF))[threadIdx.x] = 0u;
    if (threadIdx.x == 0) { const unsigned xc = xb_xcc_id(); const unsigned rk = xb_add((unsigned*)(KA(ws) + WS_CTL) + XB_XCNT(xc), 1u);
        ((volatile LAS unsigned*)(lds + LDS_ST_OFF))[2] = xc; ((volatile LAS unsigned*)(lds + LDS_ST_OFF))[3] = rk; }
    __syncthreads();
    prologue(G);

    for (int l = 0; l < NLAYER; ++l) {
        __syncthreads();
        { const Ctx X = make_ctx(((unsigned char*)KA(ws))); prep_layer(X, l, lds, G); }
        if (l == 0) { asm volatile("s_waitcnt vmcnt(0)" ::: "memory"); __syncthreads(); cg::this_grid().sync(); }
        GRID_SYNC();
        if (l == 0) {
            if (threadIdx.x == 0) { unsigned* bar = (unsigned*)(KA(ws) + WS_CTL); bool ok = (G == 256);
                for (int j = 0; j < 16; ++j) { const unsigned c = xb_ld(&bar[XB_XCNT(j)]); ok = ok && (c == (j < 8 ? 32u : 0u)); }
                ((volatile LAS unsigned*)(lds + LDS_ST_OFF))[4] = ok ? 1u : 0u; }
            __syncthreads();
        }
        for (int g = 0; g < 4; ++g) {
            for (int ph = 0; ph < 9; ++ph) {
                if (ph == 1) mixer_phase_A(l, g, lds, G, bid);
                else if (ph == 2) { const Ctx X = make_ctx(((unsigned char*)KA(ws))); const Grp gp = make_grp(g); const int gtid = bid * 512 + opaque_tid(), GT = G * 512; s5_passB(X, gp, gtid, GT); hg_passB(X, gp, GT - 1 - gtid, GT); }
                else if (ph == 3) mixer_phase_C(l, g, lds, G, bid);
                else {
                    for (int j = 0; j < 6; ++j) {
                        pg8::Gemm gm; pg8::UberEpi ep;
                        if (!make_job(((unsigned char*)KA(ws)), ((float*)KA(out)), l, g, ph, j, gm, ep)) break;
                        pg8::StaticOrder SO; SO.init(gm.M, gm.N, G, bid);
                        pg8::gemm_phase(lds, gm, SO, ep);
                    }
                }
                GRID_SYNC();
            }
        }
    }
    {
        const float* ssq = (const float*)(((unsigned char*)KA(ws)) + WS_SSQ);
        const int tid_ = opaque_tid(); const int lane = tid_ & 63, wave = __builtin_amdgcn_readfirstlane(tid_ >> 6);
        for (int row = bid * 8 + wave; row < RMAIN; row += G * 8) {
            const float rs = pg8::row_rstd(ssq, row);
            float* hp = ((float*)KA(out)) + (size_t)row * DM;
#pragma unroll
            for (int j = 0; j < 4; ++j) {
                f32x4 v = *(const f32x4*)(hp + j * 256 + lane * 4); const f32x4 gv = *(const f32x4*)(KAF(final_g) + j * 256 + lane * 4);
                v = v * rs * gv; *(f32x4*)(hp + j * 256 + lane * 4) = v;
            }
        }
    }
}

extern "C" void kernel_launch(void* const* d_in, const int* in_sizes, int n_in, void* d_out, int out_size, void* d_ws, size_t ws_size, hipStream_t stream) {
    static int grid = 0;
    if (grid == 0) {
        int dev = 0, cus = 0, per_cu = 0;
        (void)hipGetDevice(&dev);
        (void)hipDeviceGetAttribute(&cus, hipDeviceAttributeMultiprocessorCount, dev);
        (void)hipFuncSetAttribute((const void*)fwd_kernel, hipFuncAttributeMaxDynamicSharedMemorySize, LDS_BYTES);
        (void)hipOccupancyMaxActiveBlocksPerMultiprocessor(&per_cu, (const void*)fwd_kernel, 512, LDS_BYTES);
        (void)hipGetLastError();
        if (ws_size < WS_TOTAL) fprintf(stderr, "kernel_launch: workspace too small: %zu < %zu\n", ws_size, (size_t)WS_TOTAL);
        grid = cus > 0 ? cus : 256;
    }
    (void)hipMemsetAsync((char*)d_ws + WS_CTL, 0, CTL_BYTES, stream);
    Args a{};
    const float** pp = (const float**)&a;
    for (int i = 0; i < 26; ++i) pp[i] = (const float*)d_in[i];
    a.out = (float*)d_out; a.ws = (unsigned char*)d_ws;
    void* args[] = {&a};
    hipError_t e = hipLaunchCooperativeKernel((const void*)fwd_kernel, dim3(grid), dim3(512), args, LDS_BYTES, stream);
    if (e != hipSuccess) fprintf(stderr, "cooperative launch failed: %s\n", hipGetErrorString(e));
}
```

```cpp
#include <hip/hip_runtime.h>
#include <hip/hip_cooperative_groups.h>
#include <cstdio>
#include <cstdint>
namespace cg = cooperative_groups;

#define LAS __attribute__((address_space(3)))
typedef unsigned short bf16_t;
typedef short bf16x8 __attribute__((ext_vector_type(8)));
typedef float f32x4 __attribute__((ext_vector_type(4)));
typedef unsigned u32x4 __attribute__((ext_vector_type(4)));
typedef unsigned u32x2 __attribute__((ext_vector_type(2)));

#define WAVE_SYNC() asm volatile("s_waitcnt lgkmcnt(0)" ::: "memory")
__device__ __forceinline__ int opaque_tid() { int t = threadIdx.x; asm volatile("" : "+v"(t)); return t; }

__device__ __forceinline__ unsigned f2bf(float f) { unsigned u = __builtin_bit_cast(unsigned, f); return (u + 0x7fffu + ((u >> 16) & 1u)) >> 16; }
__device__ __forceinline__ unsigned pk2(float lo, float hi) { return f2bf(lo) | (f2bf(hi) << 16); }
__device__ __forceinline__ float bf2f(bf16_t b) { return __builtin_bit_cast(float, (unsigned)b << 16); }
__device__ __forceinline__ float bflo(unsigned w) { return __builtin_bit_cast(float, w << 16); }
__device__ __forceinline__ float bfhi(unsigned w) { return __builtin_bit_cast(float, w & 0xffff0000u); }
__device__ __forceinline__ float sigm(float x) { return 1.f / (1.f + __expf(-x)); }
__device__ __forceinline__ float gelu_tanh(float y) { const float a = 0.7978845608028654f * (y + 0.044715f * y * y * y); const float th = 1.f - 2.f / (__expf(2.f * a) + 1.f); return 0.5f * y * (1.f + th); }
__device__ __forceinline__ u32x4 pack8(f32x4 a, f32x4 b) { u32x4 w; w.x = pk2(a[0], a[1]); w.y = pk2(a[2], a[3]); w.z = pk2(b[0], b[1]); w.w = pk2(b[2], b[3]); return w; }
__device__ __forceinline__ float wave_sum(float v) {
#pragma unroll
    for (int o = 1; o < 64; o <<= 1) v += __shfl_xor(v, o);
    return v;
}

namespace pg8 {
constexpr int ZSTR = 6208;
constexpr int BM = 256, BK = 64, HALF = 128, HTB = HALF * BK * 2, STAGE_BYTES = 8 * HTB, NXCD = 8, WGM = 8;
__host__ __device__ __forceinline__ int lds_byte(int r, int c) { const int st = (r >> 4) * 2 + (c >> 5), rr = r & 15, cc = c & 31, ob = rr * 64 + cc * 2; return st * 1024 + (ob ^ (((ob >> 9) & 1) << 5)); }
__host__ __device__ __forceinline__ void stage_rc(int b, int& R, int& C) { const int st = b / 1024, sb = b % 1024, swz = sb ^ (((sb >> 9) & 1) << 5); R = (st >> 1) * 16 + swz / 64; C = (st & 1) * 32 + (swz % 64) / 2; }
__host__ __device__ __forceinline__ int perm32(int rho) { const int n = rho >> 4, i = rho & 15; return 8 * (i >> 2) + 4 * n + (i & 3); }
struct Unit { int pm, pn; };
struct Gemm { const bf16_t* A; int lda; const bf16_t* Bt; int M, N, K; };
struct StaticOrder {
    int nM, nN, nwg, G, c;
    __device__ void init(int M, int N, int G_, int c_) { nM = M / BM; nN = N / BM; nwg = nM * nN; G = G_; c = c_; }
    __device__ bool next(int i, Unit& u) const {
        const long L = (long)i * G + c; if (L >= nwg) return false;
        int wgid = (int)L; { const int q = nwg / NXCD, r = nwg % NXCD, xcd = wgid % NXCD, off = wgid / NXCD; wgid = (xcd < r ? xcd * (q + 1) : r * (q + 1) + (xcd - r) * q) + off; }
        const int nig = WGM * nN, gid = wgid / nig, fm = gid * WGM, gsz = (nM - fm) < WGM ? (nM - fm) : WGM;
        u.pm = fm + ((wgid % nig) % gsz); u.pn = (wgid % nig) / gsz; return true;
    }
};

struct UberEpi;
__device__ __forceinline__ void run_epi(const UberEpi& E, LAS unsigned char* lds, const f32x4 (&acc)[2][2][4][2], const Unit& u, int wr, int wc, int fr, int fq);
__device__ __forceinline__ void gemm_phase(LAS unsigned char* lds, const Gemm g, const StaticOrder& S, const UberEpi& E) {
    const int tid = opaque_tid(), wid = __builtin_amdgcn_readfirstlane(tid >> 6), lane = tid & 63, wr = wid >> 2, wc = wid & 3, fr = lane & 15, fq = lane >> 4;
    const int K = g.K, nt = K / BK, lda = g.lda;
    unsigned voffA[2], voffB[2];
#pragma unroll
    for (int i = 0; i < 2; ++i) { int R, C; stage_rc(tid * 16 + i * 8192, R, C); const int Rb = (R & ~31) + perm32(R & 31);
        voffA[i] = (unsigned)(R * lda + C) * 2u; voffB[i] = (unsigned)(Rb * K + C) * 2u; }
    const size_t kstep = (size_t)(BK * 2);
    const size_t hstepA = (size_t)HALF * lda * 2, hstepB = (size_t)HALF * K * 2;
    const size_t tstepA = 2 * hstepA, tstepB = 2 * hstepB;
    const unsigned ldsw = (unsigned)wid * 1024u;
    const int aoff = lds_byte(wr * 64 + fr, fq * 8), boff = lds_byte(wc * 32 + fr, fq * 8);
#define PG8_SA(b, h) (((b) * 2 + (h)) * HTB)
#define PG8_SB(b, h) ((4 + (b) * 2 + (h)) * HTB)
#define PG8_STAGE(bufoff, gbase, voff) do { _Pragma("unroll") for (int _i = 0; _i < 2; ++_i) \
        __builtin_amdgcn_global_load_lds((const unsigned*)((const char*)(gbase) + (voff)[_i]), (LAS unsigned*)(lds + (bufoff) + ldsw + _i * 8192), 16, 0, 0); } while (0)
#define PG8_LDA(dst, b, h) do { _Pragma("unroll") for (int m = 0; m < 4; ++m) _Pragma("unroll") for (int k = 0; k < 2; ++k) dst[m][k] = *(const LAS bf16x8*)(lds + PG8_SA(b, h) + aoff + m * 2048 + k * 1024); } while (0)
#define PG8_LDB(dst, b, h) do { _Pragma("unroll") for (int n = 0; n < 2; ++n) _Pragma("unroll") for (int k = 0; k < 2; ++k) dst[n][k] = *(const LAS bf16x8*)(lds + PG8_SB(b, h) + boff + n * 2048 + k * 1024); } while (0)
#define PG8_MMA(ai, bj, At, Bt) do { __builtin_amdgcn_s_setprio(1); _Pragma("unroll") for (int m = 0; m < 4; ++m) _Pragma("unroll") for (int n = 0; n < 2; ++n) _Pragma("unroll") for (int k = 0; k < 2; ++k) \
        acc[ai][bj][m][n] = __builtin_amdgcn_mfma_f32_16x16x32_bf16(Bt[n][k], At[m][k], acc[ai][bj][m][n], 0, 0, 0); __builtin_amdgcn_s_setprio(0); } while (0)
#define PG8_WAIT_V(n) asm volatile("s_waitcnt vmcnt(" #n ")" ::: "memory")
#define PG8_WAIT_L(n) asm volatile("s_waitcnt lgkmcnt(" #n ")" ::: "memory")
#define PG8_BAR __builtin_amdgcn_s_barrier()
#define PG8_SCHED __builtin_amdgcn_sched_barrier(0)
    Unit cur, nxt; int ui = 0;
    if (!S.next(0, cur)) return;
    f32x4 acc[2][2][4][2];
#pragma unroll
    for (int a = 0; a < 2; ++a)
#pragma unroll
        for (int b = 0; b < 2; ++b)
#pragma unroll
            for (int m = 0; m < 4; ++m)
#pragma unroll
                for (int n = 0; n < 2; ++n) acc[a][b][m][n] = (f32x4){0.f, 0.f, 0.f, 0.f};
    bf16x8 At[4][2], B0[2][2], B1[2][2];
    const char* cA = (const char*)g.A + (size_t)cur.pm * tstepA; const char* cB = (const char*)g.Bt + (size_t)cur.pn * tstepB;
    PG8_STAGE(PG8_SB(0, 0), cB, voffB); PG8_STAGE(PG8_SB(0, 1), cB + hstepB, voffB); PG8_STAGE(PG8_SA(0, 0), cA, voffA); PG8_STAGE(PG8_SA(0, 1), cA + hstepA, voffA);
    if (wr == 1) PG8_BAR;
    PG8_WAIT_V(2); PG8_BAR;
    PG8_STAGE(PG8_SB(1, 0), cB + kstep, voffB); PG8_STAGE(PG8_SA(1, 0), cA + kstep, voffA); PG8_STAGE(PG8_SB(1, 1), cB + hstepB + kstep, voffB);
    PG8_WAIT_V(6); PG8_BAR;
    for (;;) {
        const bool has_next = S.next(ui + 1, nxt);
        const char* nA = has_next ? (const char*)g.A + (size_t)nxt.pm * tstepA : cA; const char* nB = has_next ? (const char*)g.Bt + (size_t)nxt.pn * tstepB : cB;
        for (int t = 0; t < nt; t += 2) {
            const bool last = (t == nt - 2);
            const char* a1 = cA + (size_t)(t + 1) * kstep;
            const char* a2 = last ? nA : cA + (size_t)(t + 2) * kstep; const char* b2 = last ? nB : cB + (size_t)(t + 2) * kstep;
            const char* a3 = a2 + kstep; const char* b3 = b2 + kstep;
            PG8_LDB(B0, 0, 0); PG8_LDB(B1, 0, 1); PG8_SCHED; PG8_LDA(At, 0, 0); PG8_STAGE(PG8_SA(1, 1), a1 + hstepA, voffA);
            PG8_WAIT_V(8); PG8_WAIT_L(0); PG8_BAR; PG8_MMA(0, 0, At, B0); PG8_MMA(0, 1, At, B1); PG8_BAR; PG8_SCHED;
            PG8_LDA(At, 0, 1); PG8_STAGE(PG8_SB(0, 0), b2, voffB); PG8_STAGE(PG8_SB(0, 1), b2 + hstepB, voffB); PG8_STAGE(PG8_SA(0, 0), a2, voffA);
            PG8_WAIT_V(8); PG8_WAIT_L(0); PG8_BAR; PG8_MMA(1, 0, At, B0); PG8_MMA(1, 1, At, B1); PG8_BAR; PG8_SCHED;
            PG8_LDB(B0, 1, 0); PG8_LDB(B1, 1, 1); PG8_SCHED; PG8_LDA(At, 1, 0); PG8_STAGE(PG8_SA(0, 1), a2 + hstepA, voffA);
            PG8_WAIT_V(8); PG8_WAIT_L(0); PG8_BAR; PG8_MMA(0, 0, At, B0); PG8_MMA(0, 1, At, B1); PG8_BAR; PG8_SCHED;
            PG8_LDA(At, 1, 1); PG8_STAGE(PG8_SB(1, 0), b3, voffB); PG8_STAGE(PG8_SB(1, 1), b3 + hstepB, voffB); PG8_STAGE(PG8_SA(1, 0), a3, voffA);
            PG8_WAIT_V(8); PG8_WAIT_L(0); PG8_BAR; PG8_MMA(1, 0, At, B0); PG8_MMA(1, 1, At, B1); PG8_BAR; PG8_SCHED;
        }
        if (wr == 0) PG8_BAR;
        run_epi(E, lds, acc, cur, wr, wc, fr, fq);
        if (!has_next) break;
#pragma unroll
        for (int a = 0; a < 2; ++a)
#pragma unroll
            for (int b = 0; b < 2; ++b)
#pragma unroll
                for (int m = 0; m < 4; ++m)
#pragma unroll
                    for (int n = 0; n < 2; ++n) acc[a][b][m][n] = (f32x4){0.f, 0.f, 0.f, 0.f};
        cur = nxt; cA = nA; cB = nB; ++ui;
        if (wr == 1) PG8_BAR;
    }
    PG8_WAIT_V(0);
    PG8_BAR;
#undef PG8_SA
#undef PG8_SB
#undef PG8_STAGE
#undef PG8_LDA
#undef PG8_LDB
#undef PG8_MMA
#undef PG8_WAIT_V
#undef PG8_WAIT_L
#undef PG8_BAR
#undef PG8_SCHED
}

__device__ __forceinline__ float row_rstd(const float* ssq, int row) {
    const f32x4 s0 = *(const f32x4*)(ssq + (size_t)row * 4);
    const float ss = (s0[0] + s0[1]) + (s0[2] + s0[3]);
    return rsqrtf(ss * (1.0f / 1024.0f) + 1e-6f);
}
struct EpiZ {
    bf16_t* z; const float* ssq; bf16_t* vt; int vt_ld;
    __device__ __forceinline__ void operator()(const f32x4 (&acc)[2][2][4][2], const Unit& u, int wr, int wc, int fr, int fq) const {
        const int row0 = u.pm * BM + wr * 64 + fr, col0 = u.pn * BM + wc * 32 + 8 * fq;
#pragma unroll
        for (int ai = 0; ai < 2; ++ai)
#pragma unroll
            for (int m = 0; m < 4; ++m) {
                const int row = row0 + ai * HALF + m * 16; const float rs = row_rstd(ssq, row);
#pragma unroll
                for (int bj = 0; bj < 2; ++bj) {
                    const u32x4 w = pack8(acc[ai][bj][m][0] * rs, acc[ai][bj][m][1] * rs);
                    *(u32x4*)(z + (size_t)row * ZSTR + col0 + bj * HALF) = w;
                }
            }
    }
};
struct EpiGlu {
    bf16_t* z;
    __device__ __forceinline__ void operator()(const f32x4 (&acc)[2][2][4][2], const Unit& u, int wr, int wc, int fr, int fq) const {
        const int row0 = u.pm * BM + wr * 64 + fr, col0 = wc * 32 + 8 * fq;
#pragma unroll
        for (int ai = 0; ai < 2; ++ai) {
            u32x4 yv[4][2];
#pragma unroll
            for (int m = 0; m < 4; ++m)
#pragma unroll
                for (int bj = 0; bj < 2; ++bj) yv[m][bj] = *(const u32x4*)(z + (size_t)(row0 + ai * HALF + m * 16) * ZSTR + col0 + bj * HALF + 512);
#pragma unroll
            for (int m = 0; m < 4; ++m) {
                const int row = row0 + ai * HALF + m * 16;
#pragma unroll
                for (int bj = 0; bj < 2; ++bj) {
                    bf16_t* zp = z + (size_t)row * ZSTR + col0 + bj * HALF;
                    const u32x4 y = yv[m][bj];
                    const f32x4 a0 = acc[ai][bj][m][0], a1 = acc[ai][bj][m][1];
                    f32x4 o0, o1;
                    o0[0] = bflo(y.x) * sigm(a0[0]); o0[1] = bfhi(y.x) * sigm(a0[1]); o0[2] = bflo(y.y) * sigm(a0[2]); o0[3] = bfhi(y.y) * sigm(a0[3]);
                    o1[0] = bflo(y.z) * sigm(a1[0]); o1[1] = bfhi(y.z) * sigm(a1[1]); o1[2] = bflo(y.w) * sigm(a1[2]); o1[3] = bfhi(y.w) * sigm(a1[3]);
                    *(u32x4*)zp = pack8(o0, o1);
                }
            }
        }
    }
};
template <int MODE> struct EpiMix {
    bf16_t* z; int goff;
    __device__ __forceinline__ void operator()(const f32x4 (&acc)[2][2][4][2], const Unit& u, int wr, int wc, int fr, int fq) const {
        const int row0 = u.pm * BM + wr * 64 + fr, col0 = u.pn * BM + wc * 32 + 8 * fq;
#pragma unroll
        for (int ai = 0; ai < 2; ++ai)
#pragma unroll
            for (int mp = 0; mp < 2; ++mp) {
                u32x4 gv[2][2], pv[2][2];
#pragma unroll
                for (int mm = 0; mm < 2; ++mm)
#pragma unroll
                    for (int bj = 0; bj < 2; ++bj) { const bf16_t* zr = z + (size_t)(row0 + ai * HALF + (mp * 2 + mm) * 16) * ZSTR + col0 + bj * HALF;
                        gv[mm][bj] = *(const u32x4*)(zr + goff); if (MODE == 1) pv[mm][bj] = *(const u32x4*)(zr + 1024); }
#pragma unroll
                for (int mm = 0; mm < 2; ++mm) {
                    const int m = mp * 2 + mm; const int row = row0 + ai * HALF + m * 16;
#pragma unroll
                    for (int bj = 0; bj < 2; ++bj) {
                        bf16_t* zr = z + (size_t)row * ZSTR + col0 + bj * HALF;
                        const u32x4 gq = gv[mm][bj];
                        const f32x4 a0 = acc[ai][bj][m][0], a1 = acc[ai][bj][m][1];
                        f32x4 o0, o1;
                        o0[0] = sigm(bflo(gq.x)) * a0[0]; o0[1] = sigm(bfhi(gq.x)) * a0[1]; o0[2] = sigm(bflo(gq.y)) * a0[2]; o0[3] = sigm(bfhi(gq.y)) * a0[3];
                        o1[0] = sigm(bflo(gq.z)) * a1[0]; o1[1] = sigm(bfhi(gq.z)) * a1[1]; o1[2] = sigm(bflo(gq.w)) * a1[2]; o1[3] = sigm(bfhi(gq.w)) * a1[3];
                        if (MODE == 1) { const u32x4 p = pv[mm][bj];
                            o0[0] += bflo(p.x); o0[1] += bfhi(p.x); o0[2] += bflo(p.y); o0[3] += bfhi(p.y); o1[0] += bflo(p.z); o1[1] += bfhi(p.z); o1[2] += bflo(p.w); o1[3] += bfhi(p.w); }
                        *(u32x4*)(zr + 1024) = pack8(o0, o1);
                    }
                }
            }
    }
};
struct EpiRes {
    float* h; bf16_t* hb; float* ssq; LAS float* red;
    __device__ __forceinline__ void operator()(const f32x4 (&acc)[2][2][4][2], const Unit& u, int wr, int wc, int fr, int fq) const {
        const int row0 = u.pm * BM + wr * 64 + fr, col0 = u.pn * BM + wc * 32 + 8 * fq;
#pragma unroll
        for (int ai = 0; ai < 2; ++ai)
#pragma unroll
            for (int mp = 0; mp < 2; ++mp) {
                f32x4 hv[2][2][2];
#pragma unroll
                for (int mm = 0; mm < 2; ++mm)
#pragma unroll
                    for (int bj = 0; bj < 2; ++bj) { const float* hp = h + (size_t)(row0 + ai * HALF + (mp * 2 + mm) * 16) * 1024 + col0 + bj * HALF; hv[mm][bj][0] = *(const f32x4*)hp; hv[mm][bj][1] = *(const f32x4*)(hp + 4); }
#pragma unroll
                for (int mm = 0; mm < 2; ++mm) {
                    const int m = mp * 2 + mm; const int row = row0 + ai * HALF + m * 16; float part = 0.f;
#pragma unroll
                    for (int bj = 0; bj < 2; ++bj) {
                        float* hp = h + (size_t)row * 1024 + col0 + bj * HALF;
                        const f32x4 h0 = hv[mm][bj][0] + acc[ai][bj][m][0], h1 = hv[mm][bj][1] + acc[ai][bj][m][1];
                        *(f32x4*)hp = h0; *(f32x4*)(hp + 4) = h1;
                        part += (h0[0] * h0[0] + h0[1] * h0[1]) + (h0[2] * h0[2] + h0[3] * h0[3]) + (h1[0] * h1[0] + h1[1] * h1[1]) + (h1[2] * h1[2] + h1[3] * h1[3]);
                        *(u32x4*)(hb + (size_t)row * 1024 + col0 + bj * HALF) = pack8(h0, h1);
                    }
                    part += __shfl_xor(part, 16); part += __shfl_xor(part, 32);
                    if (fq == 0) red[(ai * HALF + wr * 64 + m * 16 + fr) * 4 + wc] = part;
                }
            }
        asm volatile("s_waitcnt lgkmcnt(0)" ::: "memory");
        __builtin_amdgcn_s_barrier();
        asm volatile("" ::: "memory");
        { const int t_ = opaque_tid(); if (t_ < 256) { const f32x4 r4 = *(const LAS f32x4*)(red + t_ * 4); ssq[(size_t)(u.pm * BM + t_) * 4 + u.pn] = (r4[0] + r4[1]) + (r4[2] + r4[3]); } }
    }
};
struct EpiAct {
    bf16_t* act; const float* ssq;
    __device__ __forceinline__ void operator()(const f32x4 (&acc)[2][2][4][2], const Unit& u, int wr, int wc, int fr, int fq) const {
        const int row0 = u.pm * BM + wr * 64 + fr, col0 = u.pn * HALF + wc * 32 + 8 * fq;
#pragma unroll
        for (int ai = 0; ai < 2; ++ai)
#pragma unroll
            for (int m = 0; m < 4; ++m) {
                const int row = row0 + ai * HALF + m * 16; const float rs = row_rstd(ssq, row);
                f32x4 o[2];
#pragma unroll
                for (int n = 0; n < 2; ++n)
#pragma unroll
                    for (int i = 0; i < 4; ++i) { const float gg = acc[ai][0][m][n][i] * rs, uu = acc[ai][1][m][n][i] * rs; o[n][i] = gg * sigm(gg) * uu; }
                *(u32x4*)(act + (size_t)row * 2816 + col0) = pack8(o[0], o[1]);
            }
    }
};
struct UberEpi { int mode, i0; unsigned char *p0, *p1, *p2; };
__device__ __forceinline__ void run_epi(const UberEpi& E, LAS unsigned char* lds, const f32x4 (&acc)[2][2][4][2], const Unit& u, int wr, int wc, int fr, int fq) {
    switch (E.mode) {
        case 0: { EpiZ e{(bf16_t*)E.p0, (const float*)E.p1, (bf16_t*)E.p2, E.i0}; e(acc, u, wr, wc, fr, fq); break; }
        case 1: { EpiGlu e{(bf16_t*)E.p0}; e(acc, u, wr, wc, fr, fq); break; }
        case 2: { EpiMix<0> e{(bf16_t*)E.p0, E.i0}; e(acc, u, wr, wc, fr, fq); break; }
        case 3: { EpiMix<1> e{(bf16_t*)E.p0, E.i0}; e(acc, u, wr, wc, fr, fq); break; }
        case 4: { EpiRes e{(float*)E.p0, (bf16_t*)E.p1, (float*)E.p2, (LAS float*)(lds + 131072)}; e(acc, u, wr, wc, fr, fq); break; }
        default: { EpiAct e{(bf16_t*)E.p0, (const float*)E.p1}; e(acc, u, wr, wc, fr, fq); break; }
    }
}
}

constexpr int NLAYER = 4, DM = 1024, ZN = 6144, ZW = 6208  , FFH = 2816, RG = 16384, RMAIN = 65536, VTLD = RG + 64  ;
constexpr size_t al256(size_t x) { return (x + 255) & ~(size_t)255; }
constexpr size_t WS_HB = 0;
constexpr size_t WS_SSQ = WS_HB + (size_t)RMAIN * DM * 2;
constexpr size_t WS_Z = WS_SSQ + (size_t)RMAIN * 4 * 4;
constexpr size_t WS_YB = WS_Z + (size_t)RG * ZW * 2;
constexpr size_t WS_VT = WS_YB + (size_t)RG * 512 * 2;
constexpr size_t WS_HGU = WS_VT + (size_t)512 * VTLD * 2;
constexpr size_t WS_HGP = WS_HGU + (size_t)260 * 8 * 4096 * 4;
constexpr size_t WS_S5S = WS_HGP + (size_t)260 * 8 * 64 * 4;
constexpr size_t WS_W = WS_S5S + (size_t)260 * 2048 * 8;
constexpr size_t W_IN = 0, W_UPA = W_IN + (size_t)6144 * 1024 * 2, W_UPB = W_UPA + (size_t)1024 * 256 * 2, W_UPC = W_UPB + (size_t)1024 * 512 * 2,
                 W_O = W_UPC + (size_t)1024 * 256 * 2, W_GU = W_O + (size_t)1024 * 1024 * 2, W_DN = W_GU + (size_t)5632 * 1024 * 2, W_GLU = W_DN + (size_t)1024 * 2816 * 2,
                 W_END = W_GLU + (size_t)256 * 256 * 2;
constexpr size_t WS_TAB = WS_W + W_END;
constexpr size_t T_LBAR = 0, T_L16 = T_LBAR + 2048 * 8, T_L64 = T_L16 + 2048 * 8, T_BFRAG = T_L64 + 2048 * 8, T_CFRAG = T_BFRAG + (size_t)32 * 8 * 64 * 16,
                 T_LB = T_CFRAG + (size_t)32 * 4 * 64 * 16, T_END = T_LB + 256 * 4;
constexpr size_t WS_META = al256(WS_TAB + T_END);
constexpr size_t M_H = 0, M_HB = M_H + (size_t)256 * 1024 * 4, M_SSQ = M_HB + (size_t)256 * 1024 * 2, M_Z = M_SSQ + (size_t)256 * 4 * 4, M_YB = M_Z + (size_t)256 * ZW * 2,
                 M_VT = M_YB + (size_t)256 * 512 * 2, M_ACT = M_VT + (size_t)512 * 256 * 2, M_END = M_ACT + (size_t)256 * FFH * 2;
constexpr size_t WS_CTL = al256(WS_META + M_END);
constexpr size_t CTL_BYTES = 16384;
constexpr size_t WS_TOTAL = WS_CTL + CTL_BYTES;
constexpr int LDS_ST_OFF = 135168;
constexpr int LDS_BYTES = 147456;

struct Args {
    const float *x_prompt, *x_sample, *meta_tokens, *norm1_g, *w_in, *a_re, *a_im, *log_dt, *b_re, *b_im, *c_re, *c_im, *s5_d, *w_glu, *rpb, *lb_logits, *onorm_g,
        *w_up_a, *w_up_b, *w_up_c, *w_o, *norm2_g, *w_gate, *w_up, *w_down, *final_g;
    float* out; unsigned char* ws;
};

__device__ __forceinline__ unsigned long long ufl(unsigned long long v) { const unsigned lo = __builtin_amdgcn_readfirstlane((unsigned)v), hi = __builtin_amdgcn_readfirstlane((unsigned)(v >> 32)); return ((unsigned long long)hi << 32) | lo; }
#define GAS __attribute__((address_space(1)))
template <int OFF> __device__ __forceinline__ unsigned long long ka_load() {
    unsigned long long v; const unsigned long long kp = ufl((unsigned long long)__builtin_amdgcn_kernarg_segment_ptr());
    asm volatile("s_load_dwordx2 %0, %1, %2\n\ts_waitcnt lgkmcnt(0)" : "=s"(v) : "s"(kp), "n"(OFF));
    return v;
}
#define KA(f) ((decltype(Args::f))(GAS char*)ka_load<(int)__builtin_offsetof(Args, f)>())
#define KAF(f) ((const float*)KA(f))
struct Ctx {
    bf16_t *hb, *z, *yb, *vt; float *ssq, *hgu, *hgp, *s5s;
    bf16_t *w; const float *lbar, *l16, *l64; const bf16_t *bfrag, *cfrag; const float* lb;
    float* mh; bf16_t *mhb, *mz, *myb, *mvt, *mact; float* mssq;
};

__device__ __forceinline__ void tr_item(const float* W, int K, int N, bf16_t* WT, const float* kscale, int mode, LAS float* scr, int item, int lane, bool valid) {
    const int nblk = N / 32, kb = item / nblk, nb = item % nblk, k0 = 64 * kb, n0 = 32 * nb;
    if (valid) {
#pragma unroll 8
    for (int i = 0; i < 32; ++i) { const int kk = 2 * i + (lane >> 5); float v = W[(size_t)(k0 + kk) * N + n0 + (lane & 31)]; if (kscale) v *= kscale[k0 + kk]; scr[kk * 33 + (lane & 31)] = v; }
    }
    __syncthreads();
    const int c = lane & 7;
    int drow0 = n0; if (mode) drow0 = (n0 >> 7) * 256 + (n0 & 127) + (mode == 2 ? 128 : 0);
    if (valid) {
#pragma unroll
    for (int j = 0; j < 4; ++j) { const int n = (lane >> 3) + 8 * j; const LAS float* s = scr + (8 * c) * 33 + n;
        u32x4 o; o.x = pk2(s[0 * 33], s[1 * 33]); o.y = pk2(s[2 * 33], s[3 * 33]); o.z = pk2(s[4 * 33], s[5 * 33]); o.w = pk2(s[6 * 33], s[7 * 33]);
        *(u32x4*)(WT + (size_t)(drow0 + n) * K + k0 + 8 * c) = o; }
    }
    __syncthreads();
}

__device__ __forceinline__ void prep_layer(const Ctx& X, int l, LAS unsigned char* lds, int G) {
    const int tid_ = opaque_tid(); const int wave = __builtin_amdgcn_readfirstlane(tid_ >> 6), lane = tid_ & 63;
    LAS float* scr = (LAS float*)(lds + wave * 16384);
    const int gw = blockIdx.x * 8 + wave, NGW = G * 8;
    constexpr int I0 = 16 * 192, I1 = 4 * 32, I2 = 8 * 32, I3 = 4 * 32, I4 = 16 * 32, I5 = 16 * 88, I6 = 16 * 88, I7 = 44 * 32, I8 = 4 * 8;
    constexpr int NIT = I0 + I1 + I2 + I3 + I4 + I5 + I6 + I7 + I8;
    unsigned char* wb = (unsigned char*)X.w;
    for (int it0 = 0; it0 < NIT; it0 += NGW) {
        const int it = it0 + gw; const bool valid = it < NIT;
        int r = valid ? it : 0;
        if (r < I0) { tr_item(KAF(w_in) + (size_t)l * 1024 * 6144, 1024, 6144, (bf16_t*)(wb + W_IN), KAF(norm1_g) + l * 1024, 0, scr, r, lane, valid); continue; } r -= I0;
        if (r < I1) { tr_item(KAF(w_up_a) + (size_t)l * 256 * 1024, 256, 1024, (bf16_t*)(wb + W_UPA), nullptr, 0, scr, r, lane, valid); continue; } r -= I1;
        if (r < I2) { tr_item(KAF(w_up_b) + (size_t)l * 512 * 1024, 512, 1024, (bf16_t*)(wb + W_UPB), nullptr, 0, scr, r, lane, valid); continue; } r -= I2;
        if (r < I3) { tr_item(KAF(w_up_c) + (size_t)l * 256 * 1024, 256, 1024, (bf16_t*)(wb + W_UPC), nullptr, 0, scr, r, lane, valid); continue; } r -= I3;
        if (r < I4) { tr_item(KAF(w_o) + (size_t)l * 1024 * 1024, 1024, 1024, (bf16_t*)(wb + W_O), nullptr, 0, scr, r, lane, valid); continue; } r -= I4;
        if (r < I5) { tr_item(KAF(w_gate) + (size_t)l * 1024 * 2816, 1024, 2816, (bf16_t*)(wb + W_GU), KAF(norm2_g) + l * 1024, 1, scr, r, lane, valid); continue; } r -= I5;
        if (r < I6) { tr_item(KAF(w_up) + (size_t)l * 1024 * 2816, 1024, 2816, (bf16_t*)(wb + W_GU), KAF(norm2_g) + l * 1024, 2, scr, r, lane, valid); continue; } r -= I6;
        if (r < I7) { tr_item(KAF(w_down) + (size_t)l * 2816 * 1024, 2816, 1024, (bf16_t*)(wb + W_DN), nullptr, 0, scr, r, lane, valid); continue; } r -= I7;
        tr_item(KAF(w_glu) + (size_t)l * 256 * 256, 256, 256, (bf16_t*)(wb + W_GLU), nullptr, 0, scr, r, lane, valid);
    }
    const int gt = blockIdx.x * 512 + tid_;
    if (gt < 2048) {
        const int dg = gt >> 6, p = gt & 63;
        const size_t pb = ((size_t)l * 32 + dg);
        const float are = KAF(a_re)[pb * 64 + p], aim = KAF(a_im)[pb * 64 + p], dt = expf(KAF(log_dt)[pb]);
        const float mag = expf(are * dt); float sn, cs; sincosf(aim * dt, &sn, &cs);
        const float lr = mag * cs, li = mag * sn;
        const float den = are * are + aim * aim, nr = lr - 1.0f, ni = li;
        const float zr = (nr * are + ni * aim) / den, zi = (ni * are - nr * aim) / den;
        float* lbar = (float*)X.lbar; float* l16 = (float*)X.l16; float* l64 = (float*)X.l64;
        lbar[gt * 2] = lr; lbar[gt * 2 + 1] = li;
        float pr = lr, pi = li;
#pragma unroll
        for (int s = 0; s < 4; ++s) { const float t = pr * pr - pi * pi; pi = 2.f * pr * pi; pr = t; }
        l16[gt * 2] = pr; l16[gt * 2 + 1] = pi;
#pragma unroll
        for (int s = 0; s < 2; ++s) { const float t = pr * pr - pi * pi; pi = 2.f * pr * pi; pr = t; }
        l64[gt * 2] = pr; l64[gt * 2 + 1] = pi;
        bf16_t* bfr = (bf16_t*)X.bfrag; bf16_t* cfr = (bf16_t*)X.cfrag;
        const int ntr = p >> 4, col = p & 15;
        for (int c = 0; c < 16; ++c) {
            const float br = KAF(b_re)[(pb * 64 + p) * 16 + c], bi = KAF(b_im)[(pb * 64 + p) * 16 + c];
            const float bbr = zr * br - zi * bi, bbi = zr * bi + zi * br;
            const int q = c >> 3, j = c & 7;
            bfr[(((size_t)dg * 8 + ntr) * 64 + col + 16 * q) * 8 + j] = (bf16_t)f2bf(bbr);
            bfr[(((size_t)dg * 8 + 4 + ntr) * 64 + col + 16 * q) * 8 + j] = (bf16_t)f2bf(bbi);
            bfr[(((size_t)dg * 8 + ntr) * 64 + col + 16 * (q + 2)) * 8 + j] = 0;
            bfr[(((size_t)dg * 8 + 4 + ntr) * 64 + col + 16 * (q + 2)) * 8 + j] = 0;
            const float cr = KAF(c_re)[(pb * 16 + c) * 64 + p], ci = KAF(c_im)[(pb * 16 + c) * 64 + p];
            { const int k = p;      cfr[(((size_t)dg * 4 + (k >> 5)) * 64 + c + 16 * ((k >> 3) & 3)) * 8 + (k & 7)] = (bf16_t)f2bf(cr); }
            { const int k = 64 + p; cfr[(((size_t)dg * 4 + (k >> 5)) * 64 + c + 16 * ((k >> 3) & 3)) * 8 + (k & 7)] = (bf16_t)f2bf(-ci); }
        }
    }
    if (gt >= 2048 && gt < 2048 + 256) {
        const int c = gt - 2048;
        const float l0 = KAF(lb_logits)[c], l1 = KAF(lb_logits)[256 + c], l2 = KAF(lb_logits)[512 + c], l3 = KAF(lb_logits)[768 + c];
        const float mx = fmaxf(fmaxf(l0, l1), fmaxf(l2, l3));
        const float e0 = expf(l0 - mx), e1 = expf(l1 - mx), e2 = expf(l2 - mx), e3 = expf(l3 - mx), inv = 1.f / (e0 + e1 + e2 + e3);
        float v = 0.f; if (l >= 1) v += e1 * inv; if (l >= 2) v += e2 * inv; if (l >= 3) v += e3 * inv;
        ((float*)X.lb)[c] = v;
    }
}

struct Grp { int g, nseq, Lr, nch, s0; };
__device__ __forceinline__ Grp make_grp(int g) { Grp r; r.g = g; r.nseq = g < 2 ? 4 : 1; r.Lr = g < 2 ? 4096 : 16384; r.nch = r.Lr / 64 + 1; r.s0 = g < 2 ? g * 4 : 8 + (g - 2); return r; }

template <bool OUT>
__device__ __forceinline__ void s5_chunk(const Ctx& X, const float* s5d, LAS float* buf, bf16_t* zc, int T, int ci, int wave, int lane) {
    const int p = lane, fr = lane & 15, fq = lane >> 4;
    for (int gi = 0; gi < 2; ++gi) {
        const int g = wave * 2 + gi;
        f32x4 yacc[2][2];
#pragma unroll
        for (int i = 0; i < 2; ++i)
#pragma unroll
            for (int j = 0; j < 2; ++j) yacc[i][j] = (f32x4){0.f, 0.f, 0.f, 0.f};
        bf16x8 ua[4];
#pragma unroll
        for (int m4 = 0; m4 < 4; ++m4) { ua[m4] = (bf16x8){0, 0, 0, 0, 0, 0, 0, 0}; if (fq < 2 && m4 * 16 < T) ua[m4] = *(const bf16x8*)(zc + (size_t)(m4 * 16 + fr) * ZW + g * 16 + fq * 8); }
#pragma unroll
        for (int dir = 0; dir < 2; ++dir) {
            const int dg = dir * 16 + g;
            bf16x8 bfr[8], cfr[4];
#pragma unroll
            for (int nt = 0; nt < 8; ++nt) bfr[nt] = *(const bf16x8*)(X.bfrag + (((size_t)dg * 8 + nt) * 64 + lane) * 8);
            if (OUT) {
#pragma unroll
                for (int ks = 0; ks < 4; ++ks) cfr[ks] = *(const bf16x8*)(X.cfrag + (((size_t)dg * 4 + ks) * 64 + lane) * 8);
            }
            const float lr = X.lbar[(dg * 64 + p) * 2], li = X.lbar[(dg * 64 + p) * 2 + 1];
            float xr = 0.f, xi = 0.f;
            float* st = X.s5s + ((size_t)ci * 2048 + dg * 64 + p) * 2;
            if (OUT) { xr = st[0]; xi = st[1]; }
#pragma unroll
            for (int sti = 0; sti < 2; ++sti) {
                const int stt = dir ? 1 - sti : sti; const int t0 = stt * 32;
                if (t0 < T) {
                    const int tn = (T - t0) < 32 ? (T - t0) : 32;
#pragma unroll
                    for (int mt = 0; mt < 2; ++mt) {
                        if (mt * 16 < tn) {
#pragma unroll
                            for (int nt = 0; nt < 8; ++nt) {
                                const f32x4 c = __builtin_amdgcn_mfma_f32_16x16x32_bf16(ua[stt * 2 + mt], bfr[nt], (f32x4){0.f, 0.f, 0.f, 0.f}, 0, 0, 0);
#pragma unroll
                                for (int r = 0; r < 4; ++r) buf[(mt * 16 + fq * 4 + r) * 132 + nt * 16 + fr] = c[r];
                            }
                        }
                    }
                    __syncthreads();
                    for (int k = 0; k < tn; ++k) {
                        const int t = dir ? (tn - 1 - k) : k;
                        const float br = buf[t * 132 + p], bi = buf[t * 132 + 64 + p];
                        const float nr = lr * xr - li * xi + br, ni = lr * xi + li * xr + bi;
                        xr = nr; xi = ni;
                        if (OUT) { buf[t * 132 + p] = xr; buf[t * 132 + 64 + p] = xi; }
                    }
                    if (OUT) {
                        __syncthreads();
#pragma unroll
                        for (int mt = 0; mt < 2; ++mt) {
                            if (mt * 16 < tn) {
#pragma unroll
                                for (int ks = 0; ks < 4; ++ks) {
                                    const LAS float* ap = buf + (mt * 16 + fr) * 132 + ks * 32 + fq * 8;
                                    const f32x4 a0 = *(const LAS f32x4*)ap, a1 = *(const LAS f32x4*)(ap + 4);
                                    const u32x4 aw = pack8(a0, a1);
                                    const bf16x8 av = __builtin_bit_cast(bf16x8, aw);
                                    yacc[stt][mt] = __builtin_amdgcn_mfma_f32_16x16x32_bf16(av, cfr[ks], yacc[stt][mt], 0, 0, 0);
                                }
                            }
                        }
                    }
                    __syncthreads();
                }
            }
            if (!OUT) { st[0] = xr; st[1] = xi; }
        }
        if (OUT) {
            const float dsk = s5d[g * 16 + fr];
            float uv[16];
#pragma unroll
            for (int q4 = 0; q4 < 4; ++q4)
#pragma unroll
                for (int r = 0; r < 4; ++r) { uv[q4 * 4 + r] = 0.f; if (q4 * 16 < T) uv[q4 * 4 + r] = bf2f(zc[(size_t)(q4 * 16 + fq * 4 + r) * ZW + g * 16 + fr]); }
#pragma unroll
            for (int stt = 0; stt < 2; ++stt)
#pragma unroll
                for (int mt = 0; mt < 2; ++mt) {
                    if (stt * 32 + mt * 16 < T) {
#pragma unroll
                        for (int r = 0; r < 4; ++r) {
                            const int t = stt * 32 + mt * 16 + fq * 4 + r;
                            const float y = gelu_tanh(yacc[stt][mt][r] + dsk * uv[(stt * 2 + mt) * 4 + r]);
                            zc[(size_t)t * ZW + 512 + g * 16 + fr] = (bf16_t)f2bf(y);
                        }
                    }
                }
        }
    }
}

__device__ __forceinline__ void s5_passB(const Ctx& X, const Grp& gp, int gtid, int GT) {
    const int n = gp.nseq * 2048;
    for (int e = gtid; e < n; e += GT) {
        const int sl = e >> 11, r = e & 2047, dir = r >> 10;
        const float l16r = X.l16[r * 2], l16i = X.l16[r * 2 + 1], l64r = X.l64[r * 2], l64i = X.l64[r * 2 + 1];
        float* base = X.s5s + ((size_t)(sl * gp.nch) * 2048 + r) * 2; const long cstep = dir ? -4096 : 4096; float* first = dir ? base + (size_t)(gp.nch - 1) * 4096 : base;
        float sr = 0.f, si = 0.f;
        float er[2][8], ei[2][8];
#pragma unroll
        for (int j = 0; j < 8; ++j) { er[0][j] = 0.f; ei[0][j] = 0.f; if (j < gp.nch) { const float* pp = first + (long)j * cstep; er[0][j] = pp[0]; ei[0][j] = pp[1]; } }
        for (int k0 = 0; k0 < gp.nch; k0 += 16) {
#pragma unroll
            for (int hb = 0; hb < 2; ++hb) {
                const int kb = k0 + hb * 8;
                if (kb < gp.nch) {
#pragma unroll
                    for (int j = 0; j < 8; ++j) { const int k = kb + 8 + j; er[1 - hb][j] = 0.f; ei[1 - hb][j] = 0.f; if (k < gp.nch) { const float* pp = first + (long)k * cstep; er[1 - hb][j] = pp[0]; ei[1 - hb][j] = pp[1]; } }
#pragma unroll
                    for (int j = 0; j < 8; ++j) { const int k = kb + j; if (k < gp.nch) { float* pp = first + (long)k * cstep; pp[0] = sr; pp[1] = si;
                            const int c = dir ? gp.nch - 1 - k : k;
                            const float pr = c == 0 ? l16r : l64r, pi = c == 0 ? l16i : l64i;
                            const float nr = pr * sr - pi * si + er[hb][j], ni = pr * si + pi * sr + ei[hb][j]; sr = nr; si = ni; } }
                }
            }
        }
    }
}

typedef short v4i16_t __attribute__((ext_vector_type(4)));
__device__ __forceinline__ v4i16_t vtr16(const LAS unsigned char* p) { return __builtin_amdgcn_ds_read_tr16_b64_v4i16((LAS v4i16_t*)p); }
template <bool OUT>
__device__ __forceinline__ void hg_chunk(const Ctx& X, LAS float* gt, LAS bf16_t* ot, const bf16_t* zc, int T, int ci, int wave, int lane) {
    const int h = wave >> 1, dir = wave & 1;
    float S[64];
    float* U = X.hgu + ((size_t)ci * 8 + wave) * 4096;
    if (OUT) {
#pragma unroll
        for (int d = 0; d < 64; ++d) S[d] = U[d * 64 + lane];
    } else {
#pragma unroll
        for (int d = 0; d < 64; ++d) S[d] = 0.f;
    }
    const float lbv = X.lb[h * 64 + lane], oml = 1.f - lbv; float P = 1.f;
    const int fcol = (dir ? 2304 : 2048) + h * 64 + lane, qcol = 1792 + h * 64 + lane, vcol = 2560 + h * 64 + lane;
    const int ns8 = T >> 3;
    bf16_t rq[8], rf[8], rv[8];
    {
        const int sb0 = dir ? (ns8 - 1) : 0;
#pragma unroll
        for (int j = 0; j < 8; ++j) { const bf16_t* zr = zc + (size_t)(sb0 * 8 + j) * ZW; rq[j] = zr[qcol]; rf[j] = zr[fcol]; rv[j] = zr[vcol]; }
    }
#pragma unroll 1
    for (int s8 = 0; s8 < ns8; ++s8) {
        const int sb = dir ? (ns8 - 1 - s8) : s8;
#pragma unroll
        for (int j = 0; j < 8; ++j) {
            const float q = bf2f(rq[j]), ff = bf2f(rf[j]);
            const float sg = sigm(ff), fg = lbv + oml * sg, kk = oml * (1.f - sg);
            gt[j * 256 + lane] = fg; gt[j * 256 + 64 + lane] = kk; gt[j * 256 + 128 + lane] = q * sigm(q); gt[j * 256 + 192 + lane] = bf2f(rv[j]);
            P *= fg;
        }
        __syncthreads();
        if (s8 + 1 < ns8) {
            const int sbn = dir ? (ns8 - 2 - s8) : s8 + 1;
#pragma unroll
            for (int j = 0; j < 8; ++j) { const bf16_t* zr = zc + (size_t)(sbn * 8 + j) * ZW; rq[j] = zr[qcol]; rf[j] = zr[fcol]; rv[j] = zr[vcol]; }
        }
#pragma unroll 1
        for (int jj = 0; jj < 8; ++jj) {
            const int j = dir ? 7 - jj : jj;
            const LAS float* gj = gt + j * 256;
            const float v = gj[192 + lane];
            float o = 0.f;
#pragma unroll
            for (int d4 = 0; d4 < 16; ++d4) {
                const f32x4 f4 = *(const LAS f32x4*)(gj + d4 * 4), k4 = *(const LAS f32x4*)(gj + 64 + d4 * 4);
#pragma unroll
                for (int i = 0; i < 4; ++i) S[d4 * 4 + i] = f4[i] * S[d4 * 4 + i] + k4[i] * v;
                if (OUT) { const f32x4 q4 = *(const LAS f32x4*)(gj + 128 + d4 * 4);
#pragma unroll
                    for (int i = 0; i < 4; ++i) o += S[d4 * 4 + i] * q4[i]; }
                if ((d4 & 3) == 3) __builtin_amdgcn_sched_barrier(0);
            }
            if (OUT) ot[(sb * 8 + j) * 64 + lane] = (bf16_t)f2bf(o);
        }
        __syncthreads();
    }
    if (!OUT) {
#pragma unroll
        for (int d = 0; d < 64; ++d) U[d * 64 + lane] = S[d];
        X.hgp[((size_t)ci * 8 + wave) * 64 + lane] = P;
    }
}

__device__ __forceinline__ void hg_passA_mfma(const Ctx& X, LAS unsigned char* wl, const bf16_t* zc, int T, int ci, int wave, int lane) {
    const int h = wave >> 1, dir = wave & 1, fq = lane >> 4, l16 = lane & 15, r8 = lane >> 3, pc = lane & 7;
    LAS unsigned char* kl = wl; LAS unsigned char* vl = wl + 4608;
    const float lbv = X.lb[h * 64 + lane], oml = 1.f - lbv;
    const int fcol = (dir ? 2304 : 2048) + h * 64 + lane, vcolb = 2560 + h * 64 + pc * 8;
    f32x4 acc[4][4];
#pragma unroll
    for (int a = 0; a < 4; ++a)
#pragma unroll
        for (int b = 0; b < 4; ++b) acc[a][b] = (f32x4){0.f, 0.f, 0.f, 0.f};
    float run = 1.f;
    const int nh = (T + 31) >> 5;
#pragma unroll 1
    for (int hh = 0; hh < nh; ++hh) {
        const int hb = dir ? hh : (nh - 1 - hh); const int t0 = hb * 32; const int tn = (T - t0) < 32 ? (T - t0) : 32;
        u32x4 vr[4];
#pragma unroll
        for (int i = 0; i < 4; ++i) { const int rr = i * 8 + r8; vr[i] = (u32x4){0u, 0u, 0u, 0u}; if (rr < tn) vr[i] = *(const u32x4*)(zc + (size_t)(t0 + rr) * ZW + vcolb); }
        __syncthreads();
#pragma unroll 1
        for (int bt = 0; bt < 2; ++bt) {
            const int j0 = (dir ? bt : 1 - bt) * 16;
            bf16_t rf[16];
#pragma unroll
            for (int j = 0; j < 16; ++j) { rf[j] = 0; if (j0 + j < tn) rf[j] = zc[(size_t)(t0 + j0 + j) * ZW + fcol]; }
#pragma unroll
            for (int jj = 0; jj < 16; ++jj) {
                const int jl = dir ? jj : 15 - jj; const int j = j0 + jl;
                float kh = 0.f;
                if (j < tn) { const float sg = sigm(bf2f(dir ? rf[jj] : rf[15 - jj])); kh = oml * (1.f - sg) * run; run *= lbv + oml * sg; }
                *(LAS bf16_t*)(kl + j * 144 + lane * 2) = (bf16_t)f2bf(kh);
            }
        }
#pragma unroll
        for (int i = 0; i < 4; ++i) *(LAS u32x4*)(vl + (i * 8 + r8) * 144 + pc * 16) = vr[i];
        __syncthreads();
        const int roff = (4 * fq + (l16 >> 2)) * 144 + (4 * (l16 & 3)) * 2;
        bf16x8 af[4];
#pragma unroll
        for (int mt = 0; mt < 4; ++mt) { const v4i16_t ta = vtr16(kl + roff + mt * 32), tb = vtr16(kl + roff + 16 * 144 + mt * 32); af[mt] = (bf16x8){ta[0], ta[1], ta[2], ta[3], tb[0], tb[1], tb[2], tb[3]}; }
#pragma unroll
        for (int nt = 0; nt < 4; ++nt) {
            const v4i16_t ta = vtr16(vl + roff + nt * 32), tb = vtr16(vl + roff + 16 * 144 + nt * 32);
            const bf16x8 bfv = (bf16x8){ta[0], ta[1], ta[2], ta[3], tb[0], tb[1], tb[2], tb[3]};
#pragma unroll
            for (int mt = 0; mt < 4; ++mt) acc[mt][nt] = __builtin_amdgcn_mfma_f32_16x16x32_bf16(af[mt], bfv, acc[mt][nt], 0, 0, 0);
        }
    }
    float* U = X.hgu + ((size_t)ci * 8 + wave) * 4096 + (4 * fq) * 64 + l16;
#pragma unroll
    for (int mt = 0; mt < 4; ++mt) {
#pragma unroll
        for (int r = 0; r < 4; ++r)
#pragma unroll
            for (int nt = 0; nt < 4; ++nt) U[(16 * mt + r) * 64 + 16 * nt] = acc[mt][nt][r];
        __builtin_amdgcn_sched_barrier(0);
    }
    X.hgp[((size_t)ci * 8 + wave) * 64 + lane] = run;
}

__device__ __forceinline__ void hg_passC_mfma(const Ctx& X, LAS unsigned char* wl, LAS bf16_t* ot, const bf16_t* zc, int T, int ci, int wave, int lane) {
    const int h = wave >> 1, dir = wave & 1, fq = lane >> 4, l16 = lane & 15, r8 = lane >> 3, pc = lane & 7;
    LAS unsigned char* ql = wl; LAS unsigned char* kl = wl + 2304; LAS unsigned char* vl = wl + 4608; LAS float* pl = (LAS float*)(wl + 6912);
    const float lbv = X.lb[h * 64 + lane], oml = 1.f - lbv;
    const int fcol = (dir ? 2304 : 2048) + h * 64 + lane, qcol = 1792 + h * 64 + lane, vcolb = 2560 + h * 64 + pc * 8;
    f32x4 sa[4][4];
    {
        const float* U = X.hgu + ((size_t)ci * 8 + wave) * 4096 + (4 * fq) * 64 + l16;
#pragma unroll
        for (int mt = 0; mt < 4; ++mt) {
#pragma unroll
            for (int r = 0; r < 4; ++r)
#pragma unroll
                for (int nt = 0; nt < 4; ++nt) sa[mt][nt][r] = U[(16 * mt + r) * 64 + 16 * nt];
            __builtin_amdgcn_sched_barrier(0);
        }
    }
    const int nsc = T >> 4;
#pragma unroll 1
    for (int sc = 0; sc < nsc; ++sc) {
        const int I = dir ? (nsc - 1 - sc) : sc;
        bf16_t rq[16], rf[16];
#pragma unroll
        for (int i = 0; i < 16; ++i) { const int tok = 16 * I + (dir ? 15 - i : i); rq[i] = zc[(size_t)tok * ZW + qcol]; rf[i] = zc[(size_t)tok * ZW + fcol]; }
        u32x4 vr[2];
#pragma unroll
        for (int i8 = 0; i8 < 2; ++i8) { const int i = i8 * 8 + r8; const int tok = 16 * I + (dir ? 15 - i : i); vr[i8] = *(const u32x4*)(zc + (size_t)tok * ZW + vcolb); }
        __syncthreads();
        float c = 1.f;
#pragma unroll
        for (int i = 0; i < 16; ++i) {
            const float q = bf2f(rq[i]), sg = sigm(bf2f(rf[i]));
            c *= lbv + oml * sg;
            *(LAS bf16_t*)(ql + i * 144 + lane * 2) = (bf16_t)f2bf(q * sigm(q) * c);
            *(LAS bf16_t*)(kl + i * 144 + lane * 2) = (bf16_t)f2bf(oml * (1.f - sg) / c);
        }
        pl[lane] = c;
#pragma unroll
        for (int i8 = 0; i8 < 2; ++i8) *(LAS u32x4*)(vl + (i8 * 8 + r8) * 144 + pc * 16) = vr[i8];
        __syncthreads();
        f32x4 at = (f32x4){0.f, 0.f, 0.f, 0.f};
#pragma unroll
        for (int ks = 0; ks < 2; ++ks) at = __builtin_amdgcn_mfma_f32_16x16x32_bf16(*(const LAS bf16x8*)(kl + l16 * 144 + (32 * ks + 8 * fq) * 2), *(const LAS bf16x8*)(ql + l16 * 144 + (32 * ks + 8 * fq) * 2), at, 0, 0, 0);
#pragma unroll
        for (int r = 0; r < 4; ++r) if (4 * fq + r > l16) at[r] = 0.f;
        const bf16x8 atf = __builtin_bit_cast(bf16x8, pack8(at, (f32x4){0.f, 0.f, 0.f, 0.f}));
        const int roff = (4 * fq + (l16 >> 2)) * 144 + (4 * (l16 & 3)) * 2;
        f32x4 oT[4];
#pragma unroll
        for (int et = 0; et < 4; ++et) {
            const v4i16_t tv = vtr16(vl + roff + et * 32);
            const bf16x8 vf = (bf16x8){tv[0], tv[1], tv[2], tv[3], 0, 0, 0, 0};
            oT[et] = __builtin_amdgcn_mfma_f32_16x16x32_bf16(vf, atf, (f32x4){0.f, 0.f, 0.f, 0.f}, 0, 0, 0);
        }
#pragma unroll
        for (int kp = 0; kp < 2; ++kp) {
            const u32x2 q0 = *(const LAS u32x2*)(ql + l16 * 144 + (32 * kp + 4 * fq) * 2), q1 = *(const LAS u32x2*)(ql + l16 * 144 + (32 * kp + 16 + 4 * fq) * 2);
            const bf16x8 qfr = __builtin_bit_cast(bf16x8, (u32x4){q0.x, q0.y, q1.x, q1.y});
#pragma unroll
            for (int nt = 0; nt < 4; ++nt) {
                const bf16x8 sf = __builtin_bit_cast(bf16x8, pack8(sa[2 * kp][nt], sa[2 * kp + 1][nt]));
                oT[nt] = __builtin_amdgcn_mfma_f32_16x16x32_bf16(sf, qfr, oT[nt], 0, 0, 0);
            }
        }
        {
            const int tok = 16 * I + (dir ? 15 - l16 : l16);
#pragma unroll
            for (int et = 0; et < 4; ++et)
#pragma unroll
                for (int r = 0; r < 4; ++r) ot[tok * 64 + 16 * et + 4 * fq + r] = (bf16_t)f2bf(oT[et][r]);
        }
        bf16x8 kf[4];
#pragma unroll
        for (int mt = 0; mt < 4; ++mt) { const v4i16_t tk = vtr16(kl + roff + mt * 32); kf[mt] = (bf16x8){tk[0], tk[1], tk[2], tk[3], 0, 0, 0, 0}; }
#pragma unroll
        for (int nt = 0; nt < 4; ++nt) {
            const v4i16_t tv = vtr16(vl + roff + nt * 32);
            const bf16x8 vf = (bf16x8){tv[0], tv[1], tv[2], tv[3], 0, 0, 0, 0};
#pragma unroll
            for (int mt = 0; mt < 4; ++mt) sa[mt][nt] = __builtin_amdgcn_mfma_f32_16x16x32_bf16(kf[mt], vf, sa[mt][nt], 0, 0, 0);
        }
#pragma unroll
        for (int mt = 0; mt < 4; ++mt) {
            const f32x4 p4 = *(const LAS f32x4*)(pl + 16 * mt + 4 * fq);
#pragma unroll
            for (int nt = 0; nt < 4; ++nt) sa[mt][nt] = sa[mt][nt] * p4;
        }
    }
}

__device__ __forceinline__ void hg_passB(const Ctx& X, const Grp& gp, int gtid, int GT) {
    const int n = gp.nseq * 32768;
    for (int e = gtid; e < n; e += GT) {
        const int sl = e >> 15, r = e & 32767, hd = r >> 12, de = r & 4095, d = de >> 6, dir = hd & 1;
        const size_t cb0 = (size_t)(sl * gp.nch) * 8 + hd; const int cstep = dir ? -8 : 8; const size_t cfirst = dir ? cb0 + (size_t)(gp.nch - 1) * 8 : cb0;
        float s = 0.f;
        float u[2][8], pv[2][8];
#pragma unroll
        for (int j = 0; j < 8; ++j) { u[0][j] = 0.f; pv[0][j] = 0.f; if (j < gp.nch) { const size_t cb = cfirst + (long)j * cstep; u[0][j] = X.hgu[cb * 4096 + de]; pv[0][j] = X.hgp[cb * 64 + d]; } }
        for (int k0 = 0; k0 < gp.nch; k0 += 16) {
#pragma unroll
            for (int hb = 0; hb < 2; ++hb) {
                const int kb = k0 + hb * 8;
                if (kb < gp.nch) {
#pragma unroll
                    for (int j = 0; j < 8; ++j) { const int k = kb + 8 + j; u[1 - hb][j] = 0.f; pv[1 - hb][j] = 0.f; if (k < gp.nch) { const size_t cb = cfirst + (long)k * cstep; u[1 - hb][j] = X.hgu[cb * 4096 + de]; pv[1 - hb][j] = X.hgp[cb * 64 + d]; } }
#pragma unroll
                    for (int j = 0; j < 8; ++j) { const int k = kb + j; if (k < gp.nch) { const size_t cb = cfirst + (long)k * cstep; X.hgu[cb * 4096 + de] = s; s = pv[hb][j] * s + u[hb][j]; } }
                }
            }
        }
    }
}

__device__ __forceinline__ void na_task(const Ctx& X, const float* rpb, const Grp& gp, int sl, int task, bool metaq, int wave, int lane, LAS unsigned char* vl) {
    const int h = wave, fr = lane & 15, fq = lane >> 4;
    const int s = gp.s0 + sl, rows = gp.Lr >> 6;
    int r = 0, n = 0, rs = 0, ks = 0;
    const bf16_t* qptr; bf16_t* optr; size_t ostride = 512;
    if (metaq) { qptr = X.mz + (size_t)(s * 16 + fr) * ZW; optr = X.myb + (size_t)(s * 16) * 512; }
    else {
        r = task >> 2; n = task & 3;
        rs = r - 4; rs = rs < 0 ? 0 : (rs > rows - 8 ? rows - 8 : rs);
        ks = 16 * n - 8; ks = ks < 0 ? 0 : (ks > 32 ? 32 : ks);
        const size_t qrow0 = (size_t)sl * gp.Lr + r * 64 + 16 * n;
        qptr = X.z + (qrow0 + fr) * ZW; optr = X.yb + qrow0 * 512;
    }
    bf16x8 qf[2];
#pragma unroll
    for (int kk = 0; kk < 2; ++kk) qf[kk] = *(const bf16x8*)(qptr + 256 + h * 64 + 32 * kk + 8 * fq);
    f32x4 sc[17];
    {
        const bf16_t* kp = X.mz + (size_t)(s * 16 + fr) * ZW + 768 + h * 64 + 8 * fq;
        f32x4 c = (f32x4){0.f, 0.f, 0.f, 0.f};
#pragma unroll
        for (int kk = 0; kk < 2; ++kk) c = __builtin_amdgcn_mfma_f32_16x16x32_bf16(*(const bf16x8*)(kp + 32 * kk), qf[kk], c, 0, 0, 0);
        sc[0] = c * 0.125f;
    }
    const int qc = 16 * n + fr;
    int wstart = qc - 8; wstart = wstart < 0 ? 0 : (wstart > 48 ? 48 : wstart);
    const size_t krow_base = (size_t)sl * gp.Lr + (size_t)rs * 64 + ks;
    if (!metaq) {
#pragma unroll
        for (int tb = 0; tb < 2; ++tb) {
            bf16x8 kf[8][2]; float bz[8][4];
#pragma unroll
            for (int t4 = 0; t4 < 8; ++t4) {
                const int tt = tb * 8 + t4, kj = tt >> 1, half = tt & 1;
                const bf16_t* kp = X.z + (krow_base + kj * 64 + 16 * half + fr) * ZW + 768 + h * 64 + 8 * fq;
                kf[t4][0] = *(const bf16x8*)kp; kf[t4][1] = *(const bf16x8*)(kp + 32);
            }
#pragma unroll
            for (int t4 = 0; t4 < 8; ++t4) {
                const int tt = tb * 8 + t4, kj = tt >> 1, half = tt & 1;
                const float* rp = rpb + (h * 15 + (rs + kj - r + 7)) * 31;
#pragma unroll
                for (int i = 0; i < 4; ++i) { int dc = ks + 16 * half + 4 * fq + i - qc; dc = dc < -15 ? -15 : (dc > 15 ? 15 : dc); bz[t4][i] = rp[dc + 15]; }
            }
            __builtin_amdgcn_sched_barrier(0);
#pragma unroll
            for (int t4 = 0; t4 < 8; ++t4) {
                const int tt = tb * 8 + t4, half = tt & 1;
                f32x4 c = (f32x4){0.f, 0.f, 0.f, 0.f};
                c = __builtin_amdgcn_mfma_f32_16x16x32_bf16(kf[t4][0], qf[0], c, 0, 0, 0);
                c = __builtin_amdgcn_mfma_f32_16x16x32_bf16(kf[t4][1], qf[1], c, 0, 0, 0);
#pragma unroll
                for (int i = 0; i < 4; ++i) {
                    const int kc = ks + 16 * half + 4 * fq + i;
                    const bool valid = (kc >= wstart) && (kc < wstart + 16);
                    c[i] = valid ? c[i] * 0.125f + bz[t4][i] : -1e30f;
                }
                sc[1 + tt] = c;
            }
            __builtin_amdgcn_sched_barrier(0);
        }
    } else {
#pragma unroll
        for (int tt = 0; tt < 16; ++tt) sc[1 + tt] = (f32x4){-1e30f, -1e30f, -1e30f, -1e30f};
    }
    float mx = -1e30f;
#pragma unroll
    for (int t = 0; t < 17; ++t)
#pragma unroll
        for (int i = 0; i < 4; ++i) mx = fmaxf(mx, sc[t][i]);
    mx = fmaxf(mx, __shfl_xor(mx, 16)); mx = fmaxf(mx, __shfl_xor(mx, 32));
    float sum = 0.f;
#pragma unroll
    for (int t = 0; t < 17; ++t)
#pragma unroll
        for (int i = 0; i < 4; ++i) { const float e = __expf(sc[t][i] - mx); sc[t][i] = e; sum += e; }
    sum += __shfl_xor(sum, 16); sum += __shfl_xor(sum, 32);
    const float inv = 1.f / sum;
    f32x4 oacc[4];
#pragma unroll
    for (int et = 0; et < 4; ++et) oacc[et] = (f32x4){0.f, 0.f, 0.f, 0.f};
    {
        const int r8 = lane >> 3, pc = lane & 7, l16 = lane & 15;
        const int vcol = 1280 + h * 64 + pc * 8;
        u32x4 vreg[8];
#pragma unroll
        for (int i = 0; i < 2; ++i) vreg[i] = *(const u32x4*)(X.mz + (size_t)(s * 16 + i * 8 + r8) * ZW + vcol);
#pragma unroll
        for (int cc = 0; cc < 5; ++cc) {
            if (cc > 0 && metaq) break;
            __syncthreads();
#pragma unroll
            for (int i = 0; i < 8; ++i) if (cc > 0 || i < 2) *(LAS u32x4*)(vl + (i * 8 + r8) * 144 + pc * 16) = vreg[i];
            __syncthreads();
            if (cc < 4 && !metaq) {
#pragma unroll
                for (int i = 0; i < 8; ++i) { const int rr = i * 8 + r8;
                    vreg[i] = *(const u32x4*)(X.z + (krow_base + (size_t)(2 * cc + (rr >> 5)) * 64 + (rr & 31)) * ZW + vcol); }
            }
#pragma unroll
            for (int ksl = 0; ksl < 2; ++ksl) {
                if (cc == 0 && ksl == 1) break;
                const int tt = 4 * (cc - 1) + 2 * ksl;
                f32x4 pa, pb;
                if (cc == 0) { pa = sc[0] * inv; pb = (f32x4){0.f, 0.f, 0.f, 0.f}; } else { pa = sc[1 + tt] * inv; pb = sc[2 + tt] * inv; }
                const bf16x8 pf = __builtin_bit_cast(bf16x8, pack8(pa, pb));
                const LAS unsigned char* rowp = vl + (32 * ksl + 4 * fq + (l16 >> 2)) * 144 + (4 * (l16 & 3)) * 2;
#pragma unroll
                for (int et = 0; et < 4; ++et) {
                    const v4i16_t ta = vtr16(rowp + et * 32);
                    v4i16_t tb = (v4i16_t){0, 0, 0, 0};
                    if (cc > 0) tb = vtr16(rowp + 16 * 144 + et * 32);
                    const bf16x8 vw = (bf16x8){ta[0], ta[1], ta[2], ta[3], tb[0], tb[1], tb[2], tb[3]};
                    oacc[et] = __builtin_amdgcn_mfma_f32_16x16x32_bf16(pf, vw, oacc[et], 0, 0, 0);
                }
            }
        }
    }
#pragma unroll
    for (int et = 0; et < 4; ++et)
#pragma unroll
        for (int i = 0; i < 4; ++i) optr[(size_t)(4 * fq + i) * ostride + h * 64 + et * 16 + fr] = (bf16_t)f2bf(oacc[et][i]);
}

#define XB_TMO      128
#define XB_XCNT(j)  (256  + 64 * (j))
#define XB_XSUB(j)  (1280 + 64 * (j))
#define XB_XGEN(j)  (2304 + 64 * (j))
#define XB_TOP      3328
#define XB_TOPGEN   3392
#define XCD_BAR_WORDS 3456
#define XB_SPIN_CAP (1u << 22)
__device__ __forceinline__ unsigned xb_ld(unsigned* p)              { return __hip_atomic_load(p, __ATOMIC_RELAXED, __HIP_MEMORY_SCOPE_AGENT); }
__device__ __forceinline__ unsigned xb_add(unsigned* p, unsigned v) { return __hip_atomic_fetch_add(p, v, __ATOMIC_RELAXED, __HIP_MEMORY_SCOPE_AGENT); }
__device__ __forceinline__ unsigned xb_xcc_id() { return (unsigned)__builtin_amdgcn_s_getreg((3 << 11) | 20) & 0xFu; }
#define XB_SPIN(cond, bar) do { unsigned _sp = 0; while (cond) { __builtin_amdgcn_s_sleep(1); \
    if ((++_sp & 255u) == 0u) { if (xb_ld(&(bar)[XB_TMO])) break; if (_sp > XB_SPIN_CAP) { atomicAdd(&(bar)[XB_TMO], 1u); break; } } } } while (0)
__device__ __forceinline__ void xcd_barrier_complete(unsigned* bar, unsigned x, unsigned& nloc, unsigned& nx) {
    const unsigned G = gridDim.x * gridDim.y * gridDim.z;
    unsigned sum, cnt, mine, sp = 0u;
    for (;;) {
        sum = 0u; cnt = 0u; mine = 0u;
#pragma unroll
        for (unsigned j = 0; j < 16; ++j) { const unsigned c = xb_ld(&bar[XB_XCNT(j)]); sum += c; cnt += (c > 0u) ? 1u : 0u; mine = (j == x) ? c : mine; }
        if (sum == G) break;
        __builtin_amdgcn_s_sleep(1);
        if ((++sp & 255u) == 0u) { if (xb_ld(&bar[XB_TMO])) break; if (sp > XB_SPIN_CAP) { atomicAdd(&bar[XB_TMO], 1u); break; } }
    }
    nloc = mine > 0u ? mine : 1u; nx = cnt > 0u ? cnt : 1u;
}
__device__ __forceinline__ void xcd_barrier(unsigned* bar, volatile LAS unsigned* st) {
    asm volatile("s_waitcnt vmcnt(0)" ::: "memory");
    __syncthreads();
    if (threadIdx.x == 0) {
        const unsigned x = xb_xcc_id();
        __builtin_amdgcn_s_waitcnt(0);
        unsigned nloc = st[0], nx = st[1];
        if (nloc == 0u) { xcd_barrier_complete(bar, x, nloc, nx); st[0] = nloc; st[1] = nx; }
        const unsigned old = xb_add(&bar[XB_XSUB(x)], 1u);
        const unsigned gen = old / nloc;
        if (old + 1u == (gen + 1u) * nloc) {
            __builtin_amdgcn_fence(__ATOMIC_RELEASE, "agent");
            asm volatile("s_waitcnt vmcnt(0)" ::: "memory");
            const unsigned og = xb_add(&bar[XB_TOP], 1u);
            const unsigned tg = og / nx;
            if (og + 1u == (tg + 1u) * nx) xb_add(&bar[XB_TOPGEN], 1u);
            else XB_SPIN(xb_ld(&bar[XB_TOPGEN]) == tg, bar);
            __builtin_amdgcn_fence(__ATOMIC_ACQUIRE, "agent");
            xb_add(&bar[XB_XGEN(x)], 1u);
            asm volatile("s_waitcnt vmcnt(0)" ::: "memory");
        } else {
            XB_SPIN(xb_ld(&bar[XB_XGEN(x)]) == gen, bar);
            __builtin_amdgcn_fence(__ATOMIC_ACQUIRE, "agent");
            asm volatile("s_waitcnt vmcnt(0)" ::: "memory");
        }
    }
    __syncthreads();
}
#define GRID_SYNC() xcd_barrier((unsigned*)(KA(ws) + WS_CTL), (volatile LAS unsigned*)(lds + LDS_ST_OFF))
__device__ __forceinline__ Ctx make_ctx(unsigned char* ws) {
    Ctx X;
    X.hb = (bf16_t*)(ws + WS_HB); X.ssq = (float*)(ws + WS_SSQ); X.z = (bf16_t*)(ws + WS_Z); X.yb = (bf16_t*)(ws + WS_YB); X.vt = (bf16_t*)(ws + WS_VT);
    X.hgu = (float*)(ws + WS_HGU); X.hgp = (float*)(ws + WS_HGP); X.s5s = (float*)(ws + WS_S5S); X.w = (bf16_t*)(ws + WS_W);
    X.lbar = (const float*)(ws + WS_TAB + T_LBAR); X.l16 = (const float*)(ws + WS_TAB + T_L16); X.l64 = (const float*)(ws + WS_TAB + T_L64);
    X.bfrag = (const bf16_t*)(ws + WS_TAB + T_BFRAG); X.cfrag = (const bf16_t*)(ws + WS_TAB + T_CFRAG); X.lb = (const float*)(ws + WS_TAB + T_LB);
    X.mh = (float*)(ws + WS_META + M_H); X.mhb = (bf16_t*)(ws + WS_META + M_HB); X.mssq = (float*)(ws + WS_META + M_SSQ); X.mz = (bf16_t*)(ws + WS_META + M_Z);
    X.myb = (bf16_t*)(ws + WS_META + M_YB); X.mvt = (bf16_t*)(ws + WS_META + M_VT); X.mact = (bf16_t*)(ws + WS_META + M_ACT);
    return X;
}

__device__ __forceinline__ bool make_job(unsigned char* ws, float* out, int l, int g, int ph, int j, pg8::Gemm& gm, pg8::UberEpi& ep) {
    const bool mchain = (g == 3) && (l < NLAYER - 1);
    int njobs = 1; bool meta = false; int sub = j;
    if (ph == 0) { njobs = (g == 0) ? 2 : 1; meta = (j == 1); }
    else if (ph == 4) { njobs = (g == 3) ? 2 : 1; meta = (j == 1); }
    else if (ph == 5) { njobs = mchain ? 6 : 3; meta = (j >= 3); sub = j % 3; }
    else { njobs = mchain ? 2 : 1; meta = (j == 1); }
    if (j >= njobs) return false;
    unsigned char* wb = ws + WS_W;
    const size_t r0 = (size_t)g * RG;
    unsigned char* mb = ws + WS_META;
    bf16_t* z = meta ? (bf16_t*)(mb + M_Z) : (bf16_t*)(ws + WS_Z);
    bf16_t* hb = meta ? (bf16_t*)(mb + M_HB) : (bf16_t*)(ws + WS_HB) + r0 * DM;
    float* ssq = meta ? (float*)(mb + M_SSQ) : (float*)(ws + WS_SSQ) + r0 * 4;
    float* h = meta ? (float*)(mb + M_H) : out + r0 * DM;
    bf16_t* yb = meta ? (bf16_t*)(mb + M_YB) : (bf16_t*)(ws + WS_YB);
    bf16_t* vt = meta ? (bf16_t*)(mb + M_VT) : (bf16_t*)(ws + WS_VT);
    bf16_t* act = meta ? (bf16_t*)(mb + M_ACT) : (bf16_t*)(ws + WS_Z);
    gm.M = meta ? 256 : RG;
    ep.i0 = 0; ep.p0 = nullptr; ep.p1 = nullptr; ep.p2 = nullptr;
    if (ph == 0) { gm.A = hb; gm.lda = DM; gm.Bt = (const bf16_t*)(wb + W_IN); gm.N = ZN; gm.K = DM; ep.mode = 0; ep.p0 = (unsigned char*)z; ep.p1 = (unsigned char*)ssq; ep.p2 = (unsigned char*)vt; ep.i0 = meta ? 256 : VTLD; }
    else if (ph == 4) { gm.A = z + 512; gm.lda = ZW; gm.Bt = (const bf16_t*)(wb + W_GLU); gm.N = 256; gm.K = 256; ep.mode = 1; ep.p0 = (unsigned char*)z; }
    else if (ph == 5) {
        gm.N = DM; ep.p0 = (unsigned char*)z;
        if (sub == 0) { gm.A = yb; gm.lda = 512; gm.Bt = (const bf16_t*)(wb + W_UPB); gm.K = 512; ep.mode = 2; ep.i0 = 4096; }
        else if (sub == 1) { gm.A = z + 256; gm.lda = ZW; gm.Bt = (const bf16_t*)(wb + W_UPC); gm.K = 256; ep.mode = 3; ep.i0 = 5120; }
        else { gm.A = z; gm.lda = ZW; gm.Bt = (const bf16_t*)(wb + W_UPA); gm.K = 256; ep.mode = 3; ep.i0 = 3072; }
    }
    else if (ph == 6) { gm.A = z + 1024; gm.lda = ZW; gm.Bt = (const bf16_t*)(wb + W_O); gm.N = DM; gm.K = DM; ep.mode = 4; ep.p0 = (unsigned char*)h; ep.p1 = (unsigned char*)hb; ep.p2 = (unsigned char*)ssq; }
    else if (ph == 7) { gm.A = hb; gm.lda = DM; gm.Bt = (const bf16_t*)(wb + W_GU); gm.N = 2 * FFH; gm.K = DM; ep.mode = 5; ep.p0 = (unsigned char*)act; ep.p1 = (unsigned char*)ssq; }
    else { gm.A = act; gm.lda = FFH; gm.Bt = (const bf16_t*)(wb + W_DN); gm.N = DM; gm.K = FFH; ep.mode = 4; ep.p0 = (unsigned char*)h; ep.p1 = (unsigned char*)hb; ep.p2 = (unsigned char*)ssq; }
    return true;
}

__device__ __forceinline__ void prologue(int G) {
    const int tid_ = opaque_tid(); const int lane = tid_ & 63, gw = blockIdx.x * 8 + __builtin_amdgcn_readfirstlane(tid_ >> 6), NGW = G * 8;
    const Ctx X = make_ctx(((unsigned char*)KA(ws)));
    for (int row = gw; row < RMAIN + 256; row += NGW) {
        const bool ismeta = row >= RMAIN; const int mr = row - RMAIN;
        const float* src = ismeta ? (mr < 160 ? KAF(meta_tokens) + (size_t)(mr & 15) * DM : nullptr) : (row < 32768 ? KAF(x_prompt) + (size_t)row * DM : KAF(x_sample) + (size_t)(row - 32768) * DM);
        float* hd = ismeta ? X.mh + (size_t)mr * DM : ((float*)KA(out)) + (size_t)row * DM;
        bf16_t* hbd = ismeta ? X.mhb + (size_t)mr * DM : X.hb + (size_t)row * DM;
        float* sq = ismeta ? X.mssq + (size_t)mr * 4 : X.ssq + (size_t)row * 4;
        float ss = 0.f;
#pragma unroll
        for (int j = 0; j < 4; ++j) {
            f32x4 v = (f32x4){0.f, 0.f, 0.f, 0.f}; if (src) v = *(const f32x4*)(src + j * 256 + lane * 4);
            *(f32x4*)(hd + j * 256 + lane * 4) = v;
            *(u32x2*)(hbd + j * 256 + lane * 4) = (u32x2){pk2(v[0], v[1]), pk2(v[2], v[3])};
            ss += (v[0] * v[0] + v[1] * v[1]) + (v[2] * v[2] + v[3] * v[3]);
        }
        ss = wave_sum(ss);
        if (lane < 4) sq[lane] = lane == 0 ? ss : 0.f;
    }
}

__device__ __forceinline__ void mixer_phase_A(int l, int g, LAS unsigned char* lds, int G, int bid) {
    const int tid_ = opaque_tid(); const int lane = tid_ & 63, wave = __builtin_amdgcn_readfirstlane(tid_ >> 6);
    const Ctx X = make_ctx(((unsigned char*)KA(ws))); const Grp gp = make_grp(g);
    const float* rpb = KAF(rpb) + (size_t)l * 8 * 15 * 31; const float* s5d = KAF(s5_d) + l * 256;
    const int nna = gp.nseq * (gp.Lr / 16), nmq = gp.nseq, nct = gp.nseq * (gp.nch - 1);
    const int ntask = nna + nmq + 2 * nct;
    const bool xmap = (nna % 256 == 0) && ((volatile LAS unsigned*)(lds + LDS_ST_OFF))[4] != 0u;
    if (xmap) {
        const int xcc = (int)((volatile LAS unsigned*)(lds + LDS_ST_OFF))[2], xrk = (int)((volatile LAS unsigned*)(lds + LDS_ST_OFF))[3];
        const int per = gp.Lr / 16, nx = nna / 8, rounds = nna / 256;
        for (int i = 0; i < rounds; ++i) { const int t = xcc * nx + xrk + 32 * i; na_task(X, rpb, gp, t / per, t % per, false, wave, lane, lds + wave * 9216); }
    }
    for (int t = bid + (xmap ? nna : 0); t < ntask; t += G) {
        __syncthreads();
        if (t < nna) { const int per = gp.Lr / 16; na_task(X, rpb, gp, t / per, t % per, false, wave, lane, lds + wave * 9216); }
        else if (t < nna + nmq) { na_task(X, rpb, gp, t - nna, 0, true, wave, lane, lds + wave * 9216); }
        else {
            const int u = t - nna - nmq; const bool isS5 = u < nct; const int v = isS5 ? u : u - nct;
            const int sl = v / (gp.nch - 1), c1 = v % (gp.nch - 1) + 1;
            for (int c = (c1 == 1 ? 0 : c1); c <= c1; ++c) {
                __syncthreads();
                const int ci = sl * gp.nch + c; const int T = c == 0 ? 16 : 64;
                bf16_t* zc = c == 0 ? X.mz + (size_t)((gp.s0 + sl) * 16) * ZW : X.z + ((size_t)sl * gp.Lr + 64 * (c - 1)) * ZW;
                if (isS5) s5_chunk<false>(X, s5d, (LAS float*)(lds + wave * 16896), zc, T, ci, wave, lane);
                else hg_passA_mfma(X, lds + wave * 9216, zc, T, ci, wave, lane);
            }
        }
    }
}

__device__ __forceinline__ void mixer_phase_C(int l, int g, LAS unsigned char* lds, int G, int bid) {
    const int tid_ = opaque_tid(); const int lane = tid_ & 63, wave = __builtin_amdgcn_readfirstlane(tid_ >> 6);
    const Ctx X = make_ctx(((unsigned char*)KA(ws))); const Grp gp = make_grp(g);
    const float* s5d = KAF(s5_d) + l * 256; const float* ong = KAF(onorm_g) + l * 64;
    const int nct = gp.nseq * (gp.nch - 1);
    for (int t = bid; t < 2 * nct; t += G) {
        const bool isS5 = t < nct; const int v = isS5 ? t : t - nct;
        const int sl = v / (gp.nch - 1), c1 = v % (gp.nch - 1) + 1;
        for (int c = (c1 == 1 ? 0 : c1); c <= c1; ++c) {
            __syncthreads();
            const int ci = sl * gp.nch + c; const int T = c == 0 ? 16 : 64;
            bf16_t* zc = c == 0 ? X.mz + (size_t)((gp.s0 + sl) * 16) * ZW : X.z + ((size_t)sl * gp.Lr + 64 * (c - 1)) * ZW;
            if (isS5) {
                s5_chunk<true>(X, s5d, (LAS float*)(lds + wave * 16896), zc, T, ci, wave, lane);
                asm volatile("s_waitcnt vmcnt(0)" ::: "memory");
                __syncthreads();
                const int fr = lane & 15, fq = lane >> 4;
                const bf16_t* wg = (const bf16_t*)((const unsigned char*)X.w + W_GLU);
                const int n0 = wave * 32;
                f32x4 ga[4][2];
#pragma unroll
                for (int a = 0; a < 4; ++a)
#pragma unroll
                    for (int b = 0; b < 2; ++b) ga[a][b] = (f32x4){0.f, 0.f, 0.f, 0.f};
#pragma unroll 2
                for (int ks = 0; ks < 8; ++ks) {
                    bf16x8 bw[2];
#pragma unroll
                    for (int n2 = 0; n2 < 2; ++n2) bw[n2] = *(const bf16x8*)(wg + (size_t)(n0 + n2 * 16 + fr) * 256 + ks * 32 + fq * 8);
#pragma unroll
                    for (int mt = 0; mt < 4; ++mt) {
                        if (mt * 16 < T) {
                            const bf16x8 af = *(const bf16x8*)(zc + (size_t)(mt * 16 + fr) * ZW + 512 + ks * 32 + fq * 8);
#pragma unroll
                            for (int n2 = 0; n2 < 2; ++n2) ga[mt][n2] = __builtin_amdgcn_mfma_f32_16x16x32_bf16(af, bw[n2], ga[mt][n2], 0, 0, 0);
                        }
                    }
                }
#pragma unroll
                for (int mt = 0; mt < 4; ++mt) {
                    if (mt * 16 < T) {
                        float yy[2][4];
#pragma unroll
                        for (int n2 = 0; n2 < 2; ++n2)
#pragma unroll
                            for (int r = 0; r < 4; ++r) yy[n2][r] = bf2f(zc[(size_t)(mt * 16 + 4 * fq + r) * ZW + 512 + n0 + n2 * 16 + fr]);
#pragma unroll
                        for (int n2 = 0; n2 < 2; ++n2)
#pragma unroll
                            for (int r = 0; r < 4; ++r) zc[(size_t)(mt * 16 + 4 * fq + r) * ZW + n0 + n2 * 16 + fr] = (bf16_t)f2bf(yy[n2][r] * sigm(ga[mt][n2][r]));
                    }
                }
            }
            else {
                hg_passC_mfma(X, lds + wave * 7168, (LAS bf16_t*)(lds + 65536 + wave * 8192), zc, T, ci, wave, lane);
                __syncthreads();
                const int h = wave >> 1, half = wave & 1;
                const LAS bf16_t* of = (const LAS bf16_t*)(lds + 65536 + (2 * h) * 8192); const LAS bf16_t* ob = (const LAS bf16_t*)(lds + 65536 + (2 * h + 1) * 8192);
                const float gn = ong[lane];
                const int tt0 = half * (T / 2);
                float gov[32];
#pragma unroll
                for (int i = 0; i < 32; ++i) { gov[i] = 0.f; if (i < T / 2) gov[i] = bf2f(zc[(size_t)(tt0 + i) * ZW + 2816 + h * 64 + lane]); }
#pragma unroll
                for (int i = 0; i < 32; ++i) {
                    if (i < T / 2) {
                        const int tt = tt0 + i;
                        const float o = bf2f(of[tt * 64 + lane]) + bf2f(ob[tt * 64 + lane]);
                        const float ms = wave_sum(o * o) * (1.0f / 64.0f);
                        const float go = gov[i];
                        zc[(size_t)tt * ZW + 256 + h * 64 + lane] = (bf16_t)f2bf(o * rsqrtf(ms + 1e-6f) * gn * (go * sigm(go)));
                    }
                }
            }
        }
    }
}

__global__ void __launch_bounds__(512, 2) fwd_kernel(Args a) {
    extern __shared__ __attribute__((aligned(16))) unsigned char lds_raw[];
    LAS unsigned char* lds = (LAS unsigned char*)lds_raw;
    const int G = gridDim.x, bid = blockIdx.x;

    if (threadIdx.x < 2) ((volatile LAS unsigned*)(lds + LDS_ST_OFF))[threadIdx.x] = 0u;
    if (threadIdx.x == 0) { const unsigned xc = xb_xcc_id(); const unsigned rk = xb_add((unsigned*)(KA(ws) + WS_CTL) + XB_XCNT(xc), 1u);
        ((volatile LAS unsigned*)(lds + LDS_ST_OFF))[2] = xc; ((volatile LAS unsigned*)(lds + LDS_ST_OFF))[3] = rk; }
    __syncthreads();
    prologue(G);

    for (int l = 0; l < NLAYER; ++l) {
        __syncthreads();
        { const Ctx X = make_ctx(((unsigned char*)KA(ws))); prep_layer(X, l, lds, G); }
        if (l == 0) { asm volatile("s_waitcnt vmcnt(0)" ::: "memory"); __syncthreads(); cg::this_grid().sync(); }
        GRID_SYNC();
        if (l == 0) {
            if (threadIdx.x == 0) { unsigned* bar = (unsigned*)(KA(ws) + WS_CTL); bool ok = (G == 256);
                for (int j = 0; j < 16; ++j) { const unsigned c = xb_ld(&bar[XB_XCNT(j)]); ok = ok && (c == (j < 8 ? 32u : 0u)); }
                ((volatile LAS unsigned*)(lds + LDS_ST_OFF))[4] = ok ? 1u : 0u; }
            __syncthreads();
        }
        for (int g = 0; g < 4; ++g) {
            for (int ph = 0; ph < 9; ++ph) {
                if (ph == 4) continue;
                if (ph == 1) mixer_phase_A(l, g, lds, G, bid);
                else if (ph == 2) { const Ctx X = make_ctx(((unsigned char*)KA(ws))); const Grp gp = make_grp(g); const int gtid = bid * 512 + opaque_tid(), GT = G * 512; s5_passB(X, gp, gtid, GT); hg_passB(X, gp, GT - 1 - gtid, GT); }
                else if (ph == 3) mixer_phase_C(l, g, lds, G, bid);
                else {
                    for (int j = 0; j < 6; ++j) {
                        pg8::Gemm gm; pg8::UberEpi ep;
                        if (!make_job(((unsigned char*)KA(ws)), ((float*)KA(out)), l, g, ph, j, gm, ep)) break;
                        pg8::StaticOrder SO; SO.init(gm.M, gm.N, G, bid);
                        pg8::gemm_phase(lds, gm, SO, ep);
                    }
                }
                GRID_SYNC();
            }
        }
    }
    {
        const float* ssq = (const float*)(((unsigned char*)KA(ws)) + WS_SSQ);
        const int tid_ = opaque_tid(); const int lane = tid_ & 63, wave = __builtin_amdgcn_readfirstlane(tid_ >> 6);
        for (int row = bid * 8 + wave; row < RMAIN; row += G * 8) {
            const float rs = pg8::row_rstd(ssq, row);
            float* hp = ((float*)KA(out)) + (size_t)row * DM;
#pragma unroll
            for (int j = 0; j < 4; ++j) {
                f32x4 v = *(const f32x4*)(hp + j * 256 + lane * 4); const f32x4 gv = *(const f32x4*)(KAF(final_g) + j * 256 + lane * 4);
                v = v * rs * gv; *(f32x4*)(hp + j * 256 + lane * 4) = v;
            }
        }
    }
}

extern "C" void kernel_launch(void* const* d_in, const int* in_sizes, int n_in, void* d_out, int out_size, void* d_ws, size_t ws_size, hipStream_t stream) {
    static int grid = 0;
    if (grid == 0) {
        int dev = 0, cus = 0, per_cu = 0;
        (void)hipGetDevice(&dev);
        (void)hipDeviceGetAttribute(&cus, hipDeviceAttributeMultiprocessorCount, dev);
        (void)hipFuncSetAttribute((const void*)fwd_kernel, hipFuncAttributeMaxDynamicSharedMemorySize, LDS_BYTES);
        (void)hipOccupancyMaxActiveBlocksPerMultiprocessor(&per_cu, (const void*)fwd_kernel, 512, LDS_BYTES);
        (void)hipGetLastError();
        if (ws_size < WS_TOTAL) fprintf(stderr, "kernel_launch: workspace too small: %zu < %zu\n", ws_size, (size_t)WS_TOTAL);
        grid = cus > 0 ? cus : 256;
    }
    (void)hipMemsetAsync((char*)d_ws + WS_CTL, 0, CTL_BYTES, stream);
    Args a{};
    const float** pp = (const float**)&a;
    for (int i = 0; i < 26; ++i) pp[i] = (const float*)d_in[i];
    a.out = (float*)d_out; a.ws = (unsigned char*)d_ws;
    void* args[] = {&a};
    hipError_t e = hipLaunchCooperativeKernel((const void*)fwd_kernel, dim3(grid), dim3(512), args, LDS_BYTES, stream);
    if (e != hipSuccess) fprintf(stderr, "cooperative launch failed: %s\n", hipGetErrorString(e));
}
```

```cpp
#include <hip/hip_runtime.h>
#include <hip/hip_cooperative_groups.h>
#include <cstdio>
#include <cstdint>
namespace cg = cooperative_groups;

#define LAS __attribute__((address_space(3)))
typedef unsigned short bf16_t;
typedef short bf16x8 __attribute__((ext_vector_type(8)));
typedef float f32x4 __attribute__((ext_vector_type(4)));
typedef unsigned u32x4 __attribute__((ext_vector_type(4)));
typedef unsigned u32x2 __attribute__((ext_vector_type(2)));

#define WAVE_SYNC() asm volatile("s_waitcnt lgkmcnt(0)" ::: "memory")
__device__ __forceinline__ int opaque_tid() { int t = threadIdx.x; asm volatile("" : "+v"(t)); return t; }

__device__ __forceinline__ unsigned f2bf(float f) { unsigned u = __builtin_bit_cast(unsigned, f); return (u + 0x7fffu + ((u >> 16) & 1u)) >> 16; }
__device__ __forceinline__ unsigned pk2(float lo, float hi) { return f2bf(lo) | (f2bf(hi) << 16); }
__device__ __forceinline__ float bf2f(bf16_t b) { return __builtin_bit_cast(float, (unsigned)b << 16); }
__device__ __forceinline__ float bflo(unsigned w) { return __builtin_bit_cast(float, w << 16); }
__device__ __forceinline__ float bfhi(unsigned w) { return __builtin_bit_cast(float, w & 0xffff0000u); }
__device__ __forceinline__ float sigm(float x) { return 1.f / (1.f + __expf(-x)); }
__device__ __forceinline__ float gelu_tanh(float y) { const float a = 0.7978845608028654f * (y + 0.044715f * y * y * y); const float th = 1.f - 2.f / (__expf(2.f * a) + 1.f); return 0.5f * y * (1.f + th); }
__device__ __forceinline__ u32x4 pack8(f32x4 a, f32x4 b) { u32x4 w; w.x = pk2(a[0], a[1]); w.y = pk2(a[2], a[3]); w.z = pk2(b[0], b[1]); w.w = pk2(b[2], b[3]); return w; }
__device__ __forceinline__ float wave_sum(float v) {
#pragma unroll
    for (int o = 1; o < 64; o <<= 1) v += __shfl_xor(v, o);
    return v;
}

namespace pg8 {
constexpr int ZSTR = 6208;
constexpr int BM = 256, BK = 64, HALF = 128, HTB = HALF * BK * 2, STAGE_BYTES = 8 * HTB, NXCD = 8, WGM = 8;
__host__ __device__ __forceinline__ int lds_byte(int r, int c) { const int st = (r >> 4) * 2 + (c >> 5), rr = r & 15, cc = c & 31, ob = rr * 64 + cc * 2; return st * 1024 + (ob ^ (((ob >> 9) & 1) << 5)); }
__host__ __device__ __forceinline__ void stage_rc(int b, int& R, int& C) { const int st = b / 1024, sb = b % 1024, swz = sb ^ (((sb >> 9) & 1) << 5); R = (st >> 1) * 16 + swz / 64; C = (st & 1) * 32 + (swz % 64) / 2; }
__host__ __device__ __forceinline__ int perm32(int rho) { const int n = rho >> 4, i = rho & 15; return 8 * (i >> 2) + 4 * n + (i & 3); }
struct Unit { int pm, pn; };
struct Gemm { const bf16_t* A; int lda; const bf16_t* Bt; int M, N, K; };
struct StaticOrder {
    int nM, nN, nwg, G, c;
    __device__ void init(int M, int N, int G_, int c_) { nM = M / BM; nN = N / BM; nwg = nM * nN; G = G_; c = c_; }
    __device__ bool next(int i, Unit& u) const {
        const long L = (long)i * G + c; if (L >= nwg) return false;
        int wgid = (int)L; { const int q = nwg / NXCD, r = nwg % NXCD, xcd = wgid % NXCD, off = wgid / NXCD; wgid = (xcd < r ? xcd * (q + 1) : r * (q + 1) + (xcd - r) * q) + off; }
        const int nig = WGM * nN, gid = wgid / nig, fm = gid * WGM, gsz = (nM - fm) < WGM ? (nM - fm) : WGM;
        u.pm = fm + ((wgid % nig) % gsz); u.pn = (wgid % nig) / gsz; return true;
    }
};

struct UberEpi;
__device__ __forceinline__ void run_epi(const UberEpi& E, LAS unsigned char* lds, const f32x4 (&acc)[2][2][4][2], const Unit& u, int wr, int wc, int fr, int fq);
__device__ __forceinline__ void gemm_phase(LAS unsigned char* lds, const Gemm g, const StaticOrder& S, const UberEpi& E) {
    const int tid = opaque_tid(), wid = __builtin_amdgcn_readfirstlane(tid >> 6), lane = tid & 63, wr = wid >> 2, wc = wid & 3, fr = lane & 15, fq = lane >> 4;
    const int K = g.K, nt = K / BK, lda = g.lda;
    unsigned voffA[2], voffB[2];
#pragma unroll
    for (int i = 0; i < 2; ++i) { int R, C; stage_rc(tid * 16 + i * 8192, R, C); const int Rb = (R & ~31) + perm32(R & 31);
        voffA[i] = (unsigned)(R * lda + C) * 2u; voffB[i] = (unsigned)(Rb * K + C) * 2u; }
    const size_t kstep = (size_t)(BK * 2);
    const size_t hstepA = (size_t)HALF * lda * 2, hstepB = (size_t)HALF * K * 2;
    const size_t tstepA = 2 * hstepA, tstepB = 2 * hstepB;
    const unsigned ldsw = (unsigned)wid * 1024u;
    const int aoff = lds_byte(wr * 64 + fr, fq * 8), boff = lds_byte(wc * 32 + fr, fq * 8);
#define PG8_SA(b, h) (((b) * 2 + (h)) * HTB)
#define PG8_SB(b, h) ((4 + (b) * 2 + (h)) * HTB)
#define PG8_STAGE(bufoff, gbase, voff) do { _Pragma("unroll") for (int _i = 0; _i < 2; ++_i) \
        __builtin_amdgcn_global_load_lds((const unsigned*)((const char*)(gbase) + (voff)[_i]), (LAS unsigned*)(lds + (bufoff) + ldsw + _i * 8192), 16, 0, 0); } while (0)
#define PG8_LDA(dst, b, h) do { _Pragma("unroll") for (int m = 0; m < 4; ++m) _Pragma("unroll") for (int k = 0; k < 2; ++k) dst[m][k] = *(const LAS bf16x8*)(lds + PG8_SA(b, h) + aoff + m * 2048 + k * 1024); } while (0)
#define PG8_LDB(dst, b, h) do { _Pragma("unroll") for (int n = 0; n < 2; ++n) _Pragma("unroll") for (int k = 0; k < 2; ++k) dst[n][k] = *(const LAS bf16x8*)(lds + PG8_SB(b, h) + boff + n * 2048 + k * 1024); } while (0)
#define PG8_MMA(ai, bj, At, Bt) do { __builtin_amdgcn_s_setprio(1); _Pragma("unroll") for (int m = 0; m < 4; ++m) _Pragma("unroll") for (int n = 0; n < 2; ++n) _Pragma("unroll") for (int k = 0; k < 2; ++k) \
        acc[ai][bj][m][n] = __builtin_amdgcn_mfma_f32_16x16x32_bf16(Bt[n][k], At[m][k], acc[ai][bj][m][n], 0, 0, 0); __builtin_amdgcn_s_setprio(0); } while (0)
#define PG8_WAIT_V(n) asm volatile("s_waitcnt vmcnt(" #n ")" ::: "memory")
#define PG8_WAIT_L(n) asm volatile("s_waitcnt lgkmcnt(" #n ")" ::: "memory")
#define PG8_BAR __builtin_amdgcn_s_barrier()
#define PG8_SCHED __builtin_amdgcn_sched_barrier(0)
    Unit cur, nxt; int ui = 0;
    if (!S.next(0, cur)) return;
    f32x4 acc[2][2][4][2];
#pragma unroll
    for (int a = 0; a < 2; ++a)
#pragma unroll
        for (int b = 0; b < 2; ++b)
#pragma unroll
            for (int m = 0; m < 4; ++m)
#pragma unroll
                for (int n = 0; n < 2; ++n) acc[a][b][m][n] = (f32x4){0.f, 0.f, 0.f, 0.f};
    bf16x8 At[4][2], B0[2][2], B1[2][2];
    const char* cA = (const char*)g.A + (size_t)cur.pm * tstepA; const char* cB = (const char*)g.Bt + (size_t)cur.pn * tstepB;
    PG8_STAGE(PG8_SB(0, 0), cB, voffB); PG8_STAGE(PG8_SB(0, 1), cB + hstepB, voffB); PG8_STAGE(PG8_SA(0, 0), cA, voffA); PG8_STAGE(PG8_SA(0, 1), cA + hstepA, voffA);
    if (wr == 1) PG8_BAR;
    PG8_WAIT_V(2); PG8_BAR;
    PG8_STAGE(PG8_SB(1, 0), cB + kstep, voffB); PG8_STAGE(PG8_SA(1, 0), cA + kstep, voffA); PG8_STAGE(PG8_SB(1, 1), cB + hstepB + kstep, voffB);
    PG8_WAIT_V(6); PG8_BAR;
    for (;;) {
        const bool has_next = S.next(ui + 1, nxt);
        const char* nA = has_next ? (const char*)g.A + (size_t)nxt.pm * tstepA : cA; const char* nB = has_next ? (const char*)g.Bt + (size_t)nxt.pn * tstepB : cB;
        for (int t = 0; t < nt; t += 2) {
            const bool last = (t == nt - 2);
            const char* a1 = cA + (size_t)(t + 1) * kstep;
            const char* a2 = last ? nA : cA + (size_t)(t + 2) * kstep; const char* b2 = last ? nB : cB + (size_t)(t + 2) * kstep;
            const char* a3 = a2 + kstep; const char* b3 = b2 + kstep;
            PG8_LDB(B0, 0, 0); PG8_LDB(B1, 0, 1); PG8_SCHED; PG8_LDA(At, 0, 0); PG8_STAGE(PG8_SA(1, 1), a1 + hstepA, voffA);
            PG8_WAIT_V(8); PG8_WAIT_L(0); PG8_BAR; PG8_MMA(0, 0, At, B0); PG8_MMA(0, 1, At, B1); PG8_BAR; PG8_SCHED;
            PG8_LDA(At, 0, 1); PG8_STAGE(PG8_SB(0, 0), b2, voffB); PG8_STAGE(PG8_SB(0, 1), b2 + hstepB, voffB); PG8_STAGE(PG8_SA(0, 0), a2, voffA);
            PG8_WAIT_V(8); PG8_WAIT_L(0); PG8_BAR; PG8_MMA(1, 0, At, B0); PG8_MMA(1, 1, At, B1); PG8_BAR; PG8_SCHED;
            PG8_LDB(B0, 1, 0); PG8_LDB(B1, 1, 1); PG8_SCHED; PG8_LDA(At, 1, 0); PG8_STAGE(PG8_SA(0, 1), a2 + hstepA, voffA);
            PG8_WAIT_V(8); PG8_WAIT_L(0); PG8_BAR; PG8_MMA(0, 0, At, B0); PG8_MMA(0, 1, At, B1); PG8_BAR; PG8_SCHED;
            PG8_LDA(At, 1, 1); PG8_STAGE(PG8_SB(1, 0), b3, voffB); PG8_STAGE(PG8_SB(1, 1), b3 + hstepB, voffB); PG8_STAGE(PG8_SA(1, 0), a3, voffA);
            PG8_WAIT_V(8); PG8_WAIT_L(0); PG8_BAR; PG8_MMA(1, 0, At, B0); PG8_MMA(1, 1, At, B1); PG8_BAR; PG8_SCHED;
        }
        if (wr == 0) PG8_BAR;
        run_epi(E, lds, acc, cur, wr, wc, fr, fq);
        if (!has_next) break;
#pragma unroll
        for (int a = 0; a < 2; ++a)
#pragma unroll
            for (int b = 0; b < 2; ++b)
#pragma unroll
                for (int m = 0; m < 4; ++m)
#pragma unroll
                    for (int n = 0; n < 2; ++n) acc[a][b][m][n] = (f32x4){0.f, 0.f, 0.f, 0.f};
        cur = nxt; cA = nA; cB = nB; ++ui;
        if (wr == 1) PG8_BAR;
    }
    PG8_WAIT_V(0);
    PG8_BAR;
#undef PG8_SA
#undef PG8_SB
#undef PG8_STAGE
#undef PG8_LDA
#undef PG8_LDB
#undef PG8_MMA
#undef PG8_WAIT_V
#undef PG8_WAIT_L
#undef PG8_BAR
#undef PG8_SCHED
}

__device__ __forceinline__ float row_rstd(const float* ssq, int row) {
    const f32x4 s0 = *(const f32x4*)(ssq + (size_t)row * 4);
    const float ss = (s0[0] + s0[1]) + (s0[2] + s0[3]);
    return rsqrtf(ss * (1.0f / 1024.0f) + 1e-6f);
}
struct EpiZ {
    bf16_t* z; const float* ssq; bf16_t* vt; int vt_ld;
    __device__ __forceinline__ void operator()(const f32x4 (&acc)[2][2][4][2], const Unit& u, int wr, int wc, int fr, int fq) const {
        const int row0 = u.pm * BM + wr * 64 + fr, col0 = u.pn * BM + wc * 32 + 8 * fq;
#pragma unroll
        for (int ai = 0; ai < 2; ++ai)
#pragma unroll
            for (int m = 0; m < 4; ++m) {
                const int row = row0 + ai * HALF + m * 16; const float rs = row_rstd(ssq, row);
#pragma unroll
                for (int bj = 0; bj < 2; ++bj) {
                    const u32x4 w = pack8(acc[ai][bj][m][0] * rs, acc[ai][bj][m][1] * rs);
                    *(u32x4*)(z + (size_t)row * ZSTR + col0 + bj * HALF) = w;
                }
            }
    }
};
struct EpiGlu {
    bf16_t* z;
    __device__ __forceinline__ void operator()(const f32x4 (&acc)[2][2][4][2], const Unit& u, int wr, int wc, int fr, int fq) const {
        const int row0 = u.pm * BM + wr * 64 + fr, col0 = wc * 32 + 8 * fq;
#pragma unroll
        for (int ai = 0; ai < 2; ++ai) {
            u32x4 yv[4][2];
#pragma unroll
            for (int m = 0; m < 4; ++m)
#pragma unroll
                for (int bj = 0; bj < 2; ++bj) yv[m][bj] = *(const u32x4*)(z + (size_t)(row0 + ai * HALF + m * 16) * ZSTR + col0 + bj * HALF + 512);
#pragma unroll
            for (int m = 0; m < 4; ++m) {
                const int row = row0 + ai * HALF + m * 16;
#pragma unroll
                for (int bj = 0; bj < 2; ++bj) {
                    bf16_t* zp = z + (size_t)row * ZSTR + col0 + bj * HALF;
                    const u32x4 y = yv[m][bj];
                    const f32x4 a0 = acc[ai][bj][m][0], a1 = acc[ai][bj][m][1];
                    f32x4 o0, o1;
                    o0[0] = bflo(y.x) * sigm(a0[0]); o0[1] = bfhi(y.x) * sigm(a0[1]); o0[2] = bflo(y.y) * sigm(a0[2]); o0[3] = bfhi(y.y) * sigm(a0[3]);
                    o1[0] = bflo(y.z) * sigm(a1[0]); o1[1] = bfhi(y.z) * sigm(a1[1]); o1[2] = bflo(y.w) * sigm(a1[2]); o1[3] = bfhi(y.w) * sigm(a1[3]);
                    *(u32x4*)zp = pack8(o0, o1);
                }
            }
        }
    }
};
template <int MODE> struct EpiMix {
    bf16_t* z; int goff;
    __device__ __forceinline__ void operator()(const f32x4 (&acc)[2][2][4][2], const Unit& u, int wr, int wc, int fr, int fq) const {
        const int row0 = u.pm * BM + wr * 64 + fr, col0 = u.pn * BM + wc * 32 + 8 * fq;
#pragma unroll
        for (int ai = 0; ai < 2; ++ai)
#pragma unroll
            for (int mp = 0; mp < 2; ++mp) {
                u32x4 gv[2][2], pv[2][2];
#pragma unroll
                for (int mm = 0; mm < 2; ++mm)
#pragma unroll
                    for (int bj = 0; bj < 2; ++bj) { const bf16_t* zr = z + (size_t)(row0 + ai * HALF + (mp * 2 + mm) * 16) * ZSTR + col0 + bj * HALF;
                        gv[mm][bj] = *(const u32x4*)(zr + goff); if (MODE == 1) pv[mm][bj] = *(const u32x4*)(zr + 1024); }
#pragma unroll
                for (int mm = 0; mm < 2; ++mm) {
                    const int m = mp * 2 + mm; const int row = row0 + ai * HALF + m * 16;
#pragma unroll
                    for (int bj = 0; bj < 2; ++bj) {
                        bf16_t* zr = z + (size_t)row * ZSTR + col0 + bj * HALF;
                        const u32x4 gq = gv[mm][bj];
                        const f32x4 a0 = acc[ai][bj][m][0], a1 = acc[ai][bj][m][1];
                        f32x4 o0, o1;
                        o0[0] = sigm(bflo(gq.x)) * a0[0]; o0[1] = sigm(bfhi(gq.x)) * a0[1]; o0[2] = sigm(bflo(gq.y)) * a0[2]; o0[3] = sigm(bfhi(gq.y)) * a0[3];
                        o1[0] = sigm(bflo(gq.z)) * a1[0]; o1[1] = sigm(bfhi(gq.z)) * a1[1]; o1[2] = sigm(bflo(gq.w)) * a1[2]; o1[3] = sigm(bfhi(gq.w)) * a1[3];
                        if (MODE == 1) { const u32x4 p = pv[mm][bj];
                            o0[0] += bflo(p.x); o0[1] += bfhi(p.x); o0[2] += bflo(p.y); o0[3] += bfhi(p.y); o1[0] += bflo(p.z); o1[1] += bfhi(p.z); o1[2] += bflo(p.w); o1[3] += bfhi(p.w); }
                        *(u32x4*)(zr + 1024) = pack8(o0, o1);
                    }
                }
            }
    }
};
struct EpiRes {
    float* h; bf16_t* hb; float* ssq; LAS float* red;
    __device__ __forceinline__ void operator()(const f32x4 (&acc)[2][2][4][2], const Unit& u, int wr, int wc, int fr, int fq) const {
        const int row0 = u.pm * BM + wr * 64 + fr, col0 = u.pn * BM + wc * 32 + 8 * fq;
#pragma unroll
        for (int ai = 0; ai < 2; ++ai)
#pragma unroll
            for (int mp = 0; mp < 2; ++mp) {
                f32x4 hv[2][2][2];
#pragma unroll
                for (int mm = 0; mm < 2; ++mm)
#pragma unroll
                    for (int bj = 0; bj < 2; ++bj) { const float* hp = h + (size_t)(row0 + ai * HALF + (mp * 2 + mm) * 16) * 1024 + col0 + bj * HALF; hv[mm][bj][0] = *(const f32x4*)hp; hv[mm][bj][1] = *(const f32x4*)(hp + 4); }
#pragma unroll
                for (int mm = 0; mm < 2; ++mm) {
                    const int m = mp * 2 + mm; const int row = row0 + ai * HALF + m * 16; float part = 0.f;
#pragma unroll
                    for (int bj = 0; bj < 2; ++bj) {
                        float* hp = h + (size_t)row * 1024 + col0 + bj * HALF;
                        const f32x4 h0 = hv[mm][bj][0] + acc[ai][bj][m][0], h1 = hv[mm][bj][1] + acc[ai][bj][m][1];
                        *(f32x4*)hp = h0; *(f32x4*)(hp + 4) = h1;
                        part += (h0[0] * h0[0] + h0[1] * h0[1]) + (h0[2] * h0[2] + h0[3] * h0[3]) + (h1[0] * h1[0] + h1[1] * h1[1]) + (h1[2] * h1[2] + h1[3] * h1[3]);
                        *(u32x4*)(hb + (size_t)row * 1024 + col0 + bj * HALF) = pack8(h0, h1);
                    }
                    part += __shfl_xor(part, 16); part += __shfl_xor(part, 32);
                    if (fq == 0) red[(ai * HALF + wr * 64 + m * 16 + fr) * 4 + wc] = part;
                }
            }
        asm volatile("s_waitcnt lgkmcnt(0)" ::: "memory");
        __builtin_amdgcn_s_barrier();
        asm volatile("" ::: "memory");
        { const int t_ = opaque_tid(); if (t_ < 256) { const f32x4 r4 = *(const LAS f32x4*)(red + t_ * 4); ssq[(size_t)(u.pm * BM + t_) * 4 + u.pn] = (r4[0] + r4[1]) + (r4[2] + r4[3]); } }
    }
};
struct EpiAct {
    bf16_t* act; const float* ssq;
    __device__ __forceinline__ void operator()(const f32x4 (&acc)[2][2][4][2], const Unit& u, int wr, int wc, int fr, int fq) const {
        const int row0 = u.pm * BM + wr * 64 + fr, col0 = u.pn * HALF + wc * 32 + 8 * fq;
#pragma unroll
        for (int ai = 0; ai < 2; ++ai)
#pragma unroll
            for (int m = 0; m < 4; ++m) {
                const int row = row0 + ai * HALF + m * 16; const float rs = row_rstd(ssq, row);
                f32x4 o[2];
#pragma unroll
                for (int n = 0; n < 2; ++n)
#pragma unroll
                    for (int i = 0; i < 4; ++i) { const float gg = acc[ai][0][m][n][i] * rs, uu = acc[ai][1][m][n][i] * rs; o[n][i] = gg * sigm(gg) * uu; }
                *(u32x4*)(act + (size_t)row * 2816 + col0) = pack8(o[0], o[1]);
            }
    }
};
struct UberEpi { int mode, i0; unsigned char *p0, *p1, *p2; };
__device__ __forceinline__ void run_epi(const UberEpi& E, LAS unsigned char* lds, const f32x4 (&acc)[2][2][4][2], const Unit& u, int wr, int wc, int fr, int fq) {
    switch (E.mode) {
        case 0: { EpiZ e{(bf16_t*)E.p0, (const float*)E.p1, (bf16_t*)E.p2, E.i0}; e(acc, u, wr, wc, fr, fq); break; }
        case 1: { EpiGlu e{(bf16_t*)E.p0}; e(acc, u, wr, wc, fr, fq); break; }
        case 2: { EpiMix<0> e{(bf16_t*)E.p0, E.i0}; e(acc, u, wr, wc, fr, fq); break; }
        case 3: { EpiMix<1> e{(bf16_t*)E.p0, E.i0}; e(acc, u, wr, wc, fr, fq); break; }
        case 4: { EpiRes e{(float*)E.p0, (bf16_t*)E.p1, (float*)E.p2, (LAS float*)(lds + 131072)}; e(acc, u, wr, wc, fr, fq); break; }
        default: { EpiAct e{(bf16_t*)E.p0, (const float*)E.p1}; e(acc, u, wr, wc, fr, fq); break; }
    }
}
}

constexpr int NLAYER = 4, DM = 1024, ZN = 6144, ZW = 6208  , FFH = 2816, RG = 16384, RMAIN = 65536, VTLD = RG + 64  ;
constexpr size_t al256(size_t x) { return (x + 255) & ~(size_t)255; }
constexpr size_t WS_HB = 0;
constexpr size_t WS_SSQ = WS_HB + (size_t)RMAIN * DM * 2;
constexpr size_t WS_Z = WS_SSQ + (size_t)RMAIN * 4 * 4;
constexpr size_t WS_YB = WS_Z + (size_t)RG * ZW * 2;
constexpr size_t WS_VT = WS_YB + (size_t)RG * 512 * 2;
constexpr size_t WS_HGU = WS_VT + (size_t)512 * VTLD * 2;
constexpr size_t WS_HGP = WS_HGU + (size_t)260 * 8 * 4096 * 4;
constexpr size_t WS_S5S = WS_HGP + (size_t)260 * 8 * 64 * 4;
constexpr size_t WS_W = WS_S5S + (size_t)260 * 2048 * 8;
constexpr size_t W_IN = 0, W_UPA = W_IN + (size_t)6144 * 1024 * 2, W_UPB = W_UPA + (size_t)1024 * 256 * 2, W_UPC = W_UPB + (size_t)1024 * 512 * 2,
                 W_O = W_UPC + (size_t)1024 * 256 * 2, W_GU = W_O + (size_t)1024 * 1024 * 2, W_DN = W_GU + (size_t)5632 * 1024 * 2, W_GLU = W_DN + (size_t)1024 * 2816 * 2,
                 W_END = W_GLU + (size_t)256 * 256 * 2;
constexpr size_t WS_TAB = WS_W + W_END;
constexpr size_t T_LBAR = 0, T_L16 = T_LBAR + 2048 * 8, T_L64 = T_L16 + 2048 * 8, T_BFRAG = T_L64 + 2048 * 8, T_CFRAG = T_BFRAG + (size_t)32 * 8 * 64 * 16,
                 T_LB = T_CFRAG + (size_t)32 * 4 * 64 * 16, T_END = T_LB + 256 * 4;
constexpr size_t WS_META = al256(WS_TAB + T_END);
constexpr size_t M_H = 0, M_HB = M_H + (size_t)256 * 1024 * 4, M_SSQ = M_HB + (size_t)256 * 1024 * 2, M_Z = M_SSQ + (size_t)256 * 4 * 4, M_YB = M_Z + (size_t)256 * ZW * 2,
                 M_VT = M_YB + (size_t)256 * 512 * 2, M_ACT = M_VT + (size_t)512 * 256 * 2, M_END = M_ACT + (size_t)256 * FFH * 2;
constexpr size_t WS_CTL = al256(WS_META + M_END);
constexpr size_t CTL_BYTES = 16384;
constexpr size_t WS_TOTAL = WS_CTL + CTL_BYTES;
constexpr int LDS_ST_OFF = 135168;
constexpr int LDS_BYTES = 147456;

struct Args {
    const float *x_prompt, *x_sample, *meta_tokens, *norm1_g, *w_in, *a_re, *a_im, *log_dt, *b_re, *b_im, *c_re, *c_im, *s5_d, *w_glu, *rpb, *lb_logits, *onorm_g,
        *w_up_a, *w_up_b, *w_up_c, *w_o, *norm2_g, *w_gate, *w_up, *w_down, *final_g;
    float* out; unsigned char* ws;
};

__device__ __forceinline__ unsigned long long ufl(unsigned long long v) { const unsigned lo = __builtin_amdgcn_readfirstlane((unsigned)v), hi = __builtin_amdgcn_readfirstlane((unsigned)(v >> 32)); return ((unsigned long long)hi << 32) | lo; }
#define GAS __attribute__((address_space(1)))
template <int OFF> __device__ __forceinline__ unsigned long long ka_load() {
    unsigned long long v; const unsigned long long kp = ufl((unsigned long long)__builtin_amdgcn_kernarg_segment_ptr());
    asm volatile("s_load_dwordx2 %0, %1, %2\n\ts_waitcnt lgkmcnt(0)" : "=s"(v) : "s"(kp), "n"(OFF));
    return v;
}
#define KA(f) ((decltype(Args::f))(GAS char*)ka_load<(int)__builtin_offsetof(Args, f)>())
#define KAF(f) ((const float*)KA(f))
struct Ctx {
    bf16_t *hb, *z, *yb, *vt; float *ssq, *hgu, *hgp, *s5s;
    bf16_t *w; const float *lbar, *l16, *l64; const bf16_t *bfrag, *cfrag; const float* lb;
    float* mh; bf16_t *mhb, *mz, *myb, *mvt, *mact; float* mssq;
};

__device__ __forceinline__ void tr_item(const float* W, int K, int N, bf16_t* WT, const float* kscale, int mode, LAS float* scr, int item, int lane, bool valid) {
    const int nblk = N / 32, kb = item / nblk, nb = item % nblk, k0 = 64 * kb, n0 = 32 * nb;
    if (valid) {
#pragma unroll 8
    for (int i = 0; i < 32; ++i) { const int kk = 2 * i + (lane >> 5); float v = W[(size_t)(k0 + kk) * N + n0 + (lane & 31)]; if (kscale) v *= kscale[k0 + kk]; scr[kk * 33 + (lane & 31)] = v; }
    }
    __syncthreads();
    const int c = lane & 7;
    int drow0 = n0; if (mode) drow0 = (n0 >> 7) * 256 + (n0 & 127) + (mode == 2 ? 128 : 0);
    if (valid) {
#pragma unroll
    for (int j = 0; j < 4; ++j) { const int n = (lane >> 3) + 8 * j; const LAS float* s = scr + (8 * c) * 33 + n;
        u32x4 o; o.x = pk2(s[0 * 33], s[1 * 33]); o.y = pk2(s[2 * 33], s[3 * 33]); o.z = pk2(s[4 * 33], s[5 * 33]); o.w = pk2(s[6 * 33], s[7 * 33]);
        *(u32x4*)(WT + (size_t)(drow0 + n) * K + k0 + 8 * c) = o; }
    }
    __syncthreads();
}

__device__ __forceinline__ void prep_layer(const Ctx& X, int l, LAS unsigned char* lds, int G) {
    const int tid_ = opaque_tid(); const int wave = __builtin_amdgcn_readfirstlane(tid_ >> 6), lane = tid_ & 63;
    LAS float* scr = (LAS float*)(lds + wave * 16384);
    const int gw = blockIdx.x * 8 + wave, NGW = G * 8;
    constexpr int I0 = 16 * 192, I1 = 4 * 32, I2 = 8 * 32, I3 = 4 * 32, I4 = 16 * 32, I5 = 16 * 88, I6 = 16 * 88, I7 = 44 * 32, I8 = 4 * 8;
    constexpr int NIT = I0 + I1 + I2 + I3 + I4 + I5 + I6 + I7 + I8;
    unsigned char* wb = (unsigned char*)X.w;
    for (int it0 = 0; it0 < NIT; it0 += NGW) {
        const int it = it0 + gw; const bool valid = it < NIT;
        int r = valid ? it : 0;
        if (r < I0) { tr_item(KAF(w_in) + (size_t)l * 1024 * 6144, 1024, 6144, (bf16_t*)(wb + W_IN), KAF(norm1_g) + l * 1024, 0, scr, r, lane, valid); continue; } r -= I0;
        if (r < I1) { tr_item(KAF(w_up_a) + (size_t)l * 256 * 1024, 256, 1024, (bf16_t*)(wb + W_UPA), nullptr, 0, scr, r, lane, valid); continue; } r -= I1;
        if (r < I2) { tr_item(KAF(w_up_b) + (size_t)l * 512 * 1024, 512, 1024, (bf16_t*)(wb + W_UPB), nullptr, 0, scr, r, lane, valid); continue; } r -= I2;
        if (r < I3) { tr_item(KAF(w_up_c) + (size_t)l * 256 * 1024, 256, 1024, (bf16_t*)(wb + W_UPC), nullptr, 0, scr, r, lane, valid); continue; } r -= I3;
        if (r < I4) { tr_item(KAF(w_o) + (size_t)l * 1024 * 1024, 1024, 1024, (bf16_t*)(wb + W_O), nullptr, 0, scr, r, lane, valid); continue; } r -= I4;
        if (r < I5) { tr_item(KAF(w_gate) + (size_t)l * 1024 * 2816, 1024, 2816, (bf16_t*)(wb + W_GU), KAF(norm2_g) + l * 1024, 1, scr, r, lane, valid); continue; } r -= I5;
        if (r < I6) { tr_item(KAF(w_up) + (size_t)l * 1024 * 2816, 1024, 2816, (bf16_t*)(wb + W_GU), KAF(norm2_g) + l * 1024, 2, scr, r, lane, valid); continue; } r -= I6;
        if (r < I7) { tr_item(KAF(w_down) + (size_t)l * 2816 * 1024, 2816, 1024, (bf16_t*)(wb + W_DN), nullptr, 0, scr, r, lane, valid); continue; } r -= I7;
        tr_item(KAF(w_glu) + (size_t)l * 256 * 256, 256, 256, (bf16_t*)(wb + W_GLU), nullptr, 0, scr, r, lane, valid);
    }
    const int gt = blockIdx.x * 512 + tid_;
    if (gt < 2048) {
        const int dg = gt >> 6, p = gt & 63;
        const size_t pb = ((size_t)l * 32 + dg);
        const float are = KAF(a_re)[pb * 64 + p], aim = KAF(a_im)[pb * 64 + p], dt = expf(KAF(log_dt)[pb]);
        const float mag = expf(are * dt); float sn, cs; sincosf(aim * dt, &sn, &cs);
        const float lr = mag * cs, li = mag * sn;
        const float den = are * are + aim * aim, nr = lr - 1.0f, ni = li;
        const float zr = (nr * are + ni * aim) / den, zi = (ni * are - nr * aim) / den;
        float* lbar = (float*)X.lbar; float* l16 = (float*)X.l16; float* l64 = (float*)X.l64;
        lbar[gt * 2] = lr; lbar[gt * 2 + 1] = li;
        float pr = lr, pi = li;
#pragma unroll
        for (int s = 0; s < 4; ++s) { const float t = pr * pr - pi * pi; pi = 2.f * pr * pi; pr = t; }
        l16[gt * 2] = pr; l16[gt * 2 + 1] = pi;
#pragma unroll
        for (int s = 0; s < 2; ++s) { const float t = pr * pr - pi * pi; pi = 2.f * pr * pi; pr = t; }
        l64[gt * 2] = pr; l64[gt * 2 + 1] = pi;
        bf16_t* bfr = (bf16_t*)X.bfrag; bf16_t* cfr = (bf16_t*)X.cfrag;
        const int ntr = p >> 4, col = p & 15;
        for (int c = 0; c < 16; ++c) {
            const float br = KAF(b_re)[(pb * 64 + p) * 16 + c], bi = KAF(b_im)[(pb * 64 + p) * 16 + c];
            const float bbr = zr * br - zi * bi, bbi = zr * bi + zi * br;
            const int q = c >> 3, j = c & 7;
            bfr[(((size_t)dg * 8 + ntr) * 64 + col + 16 * q) * 8 + j] = (bf16_t)f2bf(bbr);
            bfr[(((size_t)dg * 8 + 4 + ntr) * 64 + col + 16 * q) * 8 + j] = (bf16_t)f2bf(bbi);
            bfr[(((size_t)dg * 8 + ntr) * 64 + col + 16 * (q + 2)) * 8 + j] = 0;
            bfr[(((size_t)dg * 8 + 4 + ntr) * 64 + col + 16 * (q + 2)) * 8 + j] = 0;
            const float cr = KAF(c_re)[(pb * 16 + c) * 64 + p], ci = KAF(c_im)[(pb * 16 + c) * 64 + p];
            { const int k = p;      cfr[(((size_t)dg * 4 + (k >> 5)) * 64 + c + 16 * ((k >> 3) & 3)) * 8 + (k & 7)] = (bf16_t)f2bf(cr); }
            { const int k = 64 + p; cfr[(((size_t)dg * 4 + (k >> 5)) * 64 + c + 16 * ((k >> 3) & 3)) * 8 + (k & 7)] = (bf16_t)f2bf(-ci); }
        }
    }
    if (gt >= 2048 && gt < 2048 + 256) {
        const int c = gt - 2048;
        const float l0 = KAF(lb_logits)[c], l1 = KAF(lb_logits)[256 + c], l2 = KAF(lb_logits)[512 + c], l3 = KAF(lb_logits)[768 + c];
        const float mx = fmaxf(fmaxf(l0, l1), fmaxf(l2, l3));
        const float e0 = expf(l0 - mx), e1 = expf(l1 - mx), e2 = expf(l2 - mx), e3 = expf(l3 - mx), inv = 1.f / (e0 + e1 + e2 + e3);
        float v = 0.f; if (l >= 1) v += e1 * inv; if (l >= 2) v += e2 * inv; if (l >= 3) v += e3 * inv;
        ((float*)X.lb)[c] = v;
    }
}

struct Grp { int g, nseq, Lr, nch, s0; };
__device__ __forceinline__ Grp make_grp(int g) { Grp r; r.g = g; r.nseq = g < 2 ? 4 : 1; r.Lr = g < 2 ? 4096 : 16384; r.nch = r.Lr / 64 + 1; r.s0 = g < 2 ? g * 4 : 8 + (g - 2); return r; }

template <bool OUT>
__device__ __forceinline__ void s5_chunk(const Ctx& X, const float* s5d, LAS float* buf, bf16_t* zc, int T, int ci, int wave, int lane) {
    const int p = lane, fr = lane & 15, fq = lane >> 4;
    for (int gi = 0; gi < 2; ++gi) {
        const int g = wave * 2 + gi;
        f32x4 yacc[2][2];
#pragma unroll
        for (int i = 0; i < 2; ++i)
#pragma unroll
            for (int j = 0; j < 2; ++j) yacc[i][j] = (f32x4){0.f, 0.f, 0.f, 0.f};
        bf16x8 ua[4];
#pragma unroll
        for (int m4 = 0; m4 < 4; ++m4) { ua[m4] = (bf16x8){0, 0, 0, 0, 0, 0, 0, 0}; if (fq < 2 && m4 * 16 < T) ua[m4] = *(const bf16x8*)(zc + (size_t)(m4 * 16 + fr) * ZW + g * 16 + fq * 8); }
#pragma unroll
        for (int dir = 0; dir < 2; ++dir) {
            const int dg = dir * 16 + g;
            bf16x8 bfr[8], cfr[4];
#pragma unroll
            for (int nt = 0; nt < 8; ++nt) bfr[nt] = *(const bf16x8*)(X.bfrag + (((size_t)dg * 8 + nt) * 64 + lane) * 8);
            if (OUT) {
#pragma unroll
                for (int ks = 0; ks < 4; ++ks) cfr[ks] = *(const bf16x8*)(X.cfrag + (((size_t)dg * 4 + ks) * 64 + lane) * 8);
            }
            const float lr = X.lbar[(dg * 64 + p) * 2], li = X.lbar[(dg * 64 + p) * 2 + 1];
            float xr = 0.f, xi = 0.f;
            float* st = X.s5s + ((size_t)ci * 2048 + dg * 64 + p) * 2;
            if (OUT) { xr = st[0]; xi = st[1]; }
#pragma unroll
            for (int sti = 0; sti < 2; ++sti) {
                const int stt = dir ? 1 - sti : sti; const int t0 = stt * 32;
                if (t0 < T) {
                    const int tn = (T - t0) < 32 ? (T - t0) : 32;
#pragma unroll
                    for (int mt = 0; mt < 2; ++mt) {
                        if (mt * 16 < tn) {
#pragma unroll
                            for (int nt = 0; nt < 8; ++nt) {
                                const f32x4 c = __builtin_amdgcn_mfma_f32_16x16x32_bf16(ua[stt * 2 + mt], bfr[nt], (f32x4){0.f, 0.f, 0.f, 0.f}, 0, 0, 0);
#pragma unroll
                                for (int r = 0; r < 4; ++r) buf[(mt * 16 + fq * 4 + r) * 132 + nt * 16 + fr] = c[r];
                            }
                        }
                    }
                    __syncthreads();
                    for (int k0 = 0; k0 < tn; k0 += 8) {
                        float br[8], bi[8];
#pragma unroll
                        for (int j = 0; j < 8; ++j) { const int t = dir ? (tn - 1 - k0 - j) : k0 + j; br[j] = buf[t * 132 + p]; bi[j] = buf[t * 132 + 64 + p]; }
#pragma unroll
                        for (int j = 0; j < 8; ++j) {
                            const int t = dir ? (tn - 1 - k0 - j) : k0 + j;
                            const float nr = lr * xr - li * xi + br[j], ni = lr * xi + li * xr + bi[j];
                            xr = nr; xi = ni;
                            if (OUT) { buf[t * 132 + p] = xr; buf[t * 132 + 64 + p] = xi; }
                        }
                    }
                    if (OUT) {
                        __syncthreads();
#pragma unroll
                        for (int mt = 0; mt < 2; ++mt) {
                            if (mt * 16 < tn) {
#pragma unroll
                                for (int ks = 0; ks < 4; ++ks) {
                                    const LAS float* ap = buf + (mt * 16 + fr) * 132 + ks * 32 + fq * 8;
                                    const f32x4 a0 = *(const LAS f32x4*)ap, a1 = *(const LAS f32x4*)(ap + 4);
                                    const u32x4 aw = pack8(a0, a1);
                                    const bf16x8 av = __builtin_bit_cast(bf16x8, aw);
                                    yacc[stt][mt] = __builtin_amdgcn_mfma_f32_16x16x32_bf16(av, cfr[ks], yacc[stt][mt], 0, 0, 0);
                                }
                            }
                        }
                    }
                    __syncthreads();
                }
            }
            if (!OUT) { st[0] = xr; st[1] = xi; }
        }
        if (OUT) {
            const float dsk = s5d[g * 16 + fr];
            float uv[16];
#pragma unroll
            for (int q4 = 0; q4 < 4; ++q4)
#pragma unroll
                for (int r = 0; r < 4; ++r) { uv[q4 * 4 + r] = 0.f; if (q4 * 16 < T) uv[q4 * 4 + r] = bf2f(zc[(size_t)(q4 * 16 + fq * 4 + r) * ZW + g * 16 + fr]); }
#pragma unroll
            for (int stt = 0; stt < 2; ++stt)
#pragma unroll
                for (int mt = 0; mt < 2; ++mt) {
                    if (stt * 32 + mt * 16 < T) {
#pragma unroll
                        for (int r = 0; r < 4; ++r) {
                            const int t = stt * 32 + mt * 16 + fq * 4 + r;
                            const float y = gelu_tanh(yacc[stt][mt][r] + dsk * uv[(stt * 2 + mt) * 4 + r]);
                            zc[(size_t)t * ZW + 512 + g * 16 + fr] = (bf16_t)f2bf(y);
                        }
                    }
                }
        }
    }
}

__device__ __forceinline__ void s5_passB(const Ctx& X, const Grp& gp, int gtid, int GT) {
    const int n = gp.nseq * 2048;
    for (int e = gtid; e < n; e += GT) {
        const int sl = e >> 11, r = e & 2047, dir = r >> 10;
        const float l16r = X.l16[r * 2], l16i = X.l16[r * 2 + 1], l64r = X.l64[r * 2], l64i = X.l64[r * 2 + 1];
        float* base = X.s5s + ((size_t)(sl * gp.nch) * 2048 + r) * 2; const long cstep = dir ? -4096 : 4096; float* first = dir ? base + (size_t)(gp.nch - 1) * 4096 : base;
        float sr = 0.f, si = 0.f;
        float er[2][8], ei[2][8];
#pragma unroll
        for (int j = 0; j < 8; ++j) { er[0][j] = 0.f; ei[0][j] = 0.f; if (j < gp.nch) { const float* pp = first + (long)j * cstep; er[0][j] = pp[0]; ei[0][j] = pp[1]; } }
        for (int k0 = 0; k0 < gp.nch; k0 += 16) {
#pragma unroll
            for (int hb = 0; hb < 2; ++hb) {
                const int kb = k0 + hb * 8;
                if (kb < gp.nch) {
#pragma unroll
                    for (int j = 0; j < 8; ++j) { const int k = kb + 8 + j; er[1 - hb][j] = 0.f; ei[1 - hb][j] = 0.f; if (k < gp.nch) { const float* pp = first + (long)k * cstep; er[1 - hb][j] = pp[0]; ei[1 - hb][j] = pp[1]; } }
#pragma unroll
                    for (int j = 0; j < 8; ++j) { const int k = kb + j; if (k < gp.nch) { float* pp = first + (long)k * cstep; pp[0] = sr; pp[1] = si;
                            const int c = dir ? gp.nch - 1 - k : k;
                            const float pr = c == 0 ? l16r : l64r, pi = c == 0 ? l16i : l64i;
                            const float nr = pr * sr - pi * si + er[hb][j], ni = pr * si + pi * sr + ei[hb][j]; sr = nr; si = ni; } }
                }
            }
        }
    }
}

typedef short v4i16_t __attribute__((ext_vector_type(4)));
__device__ __forceinline__ v4i16_t vtr16(const LAS unsigned char* p) { return __builtin_amdgcn_ds_read_tr16_b64_v4i16((LAS v4i16_t*)p); }
template <bool OUT>
__device__ __forceinline__ void hg_chunk(const Ctx& X, LAS float* gt, LAS bf16_t* ot, const bf16_t* zc, int T, int ci, int wave, int lane) {
    const int h = wave >> 1, dir = wave & 1;
    float S[64];
    float* U = X.hgu + ((size_t)ci * 8 + wave) * 4096;
    if (OUT) {
#pragma unroll
        for (int d = 0; d < 64; ++d) S[d] = U[d * 64 + lane];
    } else {
#pragma unroll
        for (int d = 0; d < 64; ++d) S[d] = 0.f;
    }
    const float lbv = X.lb[h * 64 + lane], oml = 1.f - lbv; float P = 1.f;
    const int fcol = (dir ? 2304 : 2048) + h * 64 + lane, qcol = 1792 + h * 64 + lane, vcol = 2560 + h * 64 + lane;
    const int ns8 = T >> 3;
    bf16_t rq[8], rf[8], rv[8];
    {
        const int sb0 = dir ? (ns8 - 1) : 0;
#pragma unroll
        for (int j = 0; j < 8; ++j) { const bf16_t* zr = zc + (size_t)(sb0 * 8 + j) * ZW; rq[j] = zr[qcol]; rf[j] = zr[fcol]; rv[j] = zr[vcol]; }
    }
#pragma unroll 1
    for (int s8 = 0; s8 < ns8; ++s8) {
        const int sb = dir ? (ns8 - 1 - s8) : s8;
#pragma unroll
        for (int j = 0; j < 8; ++j) {
            const float q = bf2f(rq[j]), ff = bf2f(rf[j]);
            const float sg = sigm(ff), fg = lbv + oml * sg, kk = oml * (1.f - sg);
            gt[j * 256 + lane] = fg; gt[j * 256 + 64 + lane] = kk; gt[j * 256 + 128 + lane] = q * sigm(q); gt[j * 256 + 192 + lane] = bf2f(rv[j]);
            P *= fg;
        }
        __syncthreads();
        if (s8 + 1 < ns8) {
            const int sbn = dir ? (ns8 - 2 - s8) : s8 + 1;
#pragma unroll
            for (int j = 0; j < 8; ++j) { const bf16_t* zr = zc + (size_t)(sbn * 8 + j) * ZW; rq[j] = zr[qcol]; rf[j] = zr[fcol]; rv[j] = zr[vcol]; }
        }
#pragma unroll 1
        for (int jj = 0; jj < 8; ++jj) {
            const int j = dir ? 7 - jj : jj;
            const LAS float* gj = gt + j * 256;
            const float v = gj[192 + lane];
            float o = 0.f;
#pragma unroll
            for (int d4 = 0; d4 < 16; ++d4) {
                const f32x4 f4 = *(const LAS f32x4*)(gj + d4 * 4), k4 = *(const LAS f32x4*)(gj + 64 + d4 * 4);
#pragma unroll
                for (int i = 0; i < 4; ++i) S[d4 * 4 + i] = f4[i] * S[d4 * 4 + i] + k4[i] * v;
                if (OUT) { const f32x4 q4 = *(const LAS f32x4*)(gj + 128 + d4 * 4);
#pragma unroll
                    for (int i = 0; i < 4; ++i) o += S[d4 * 4 + i] * q4[i]; }
                if ((d4 & 3) == 3) __builtin_amdgcn_sched_barrier(0);
            }
            if (OUT) ot[(sb * 8 + j) * 64 + lane] = (bf16_t)f2bf(o);
        }
        __syncthreads();
    }
    if (!OUT) {
#pragma unroll
        for (int d = 0; d < 64; ++d) U[d * 64 + lane] = S[d];
        X.hgp[((size_t)ci * 8 + wave) * 64 + lane] = P;
    }
}

__device__ __forceinline__ void hg_passA_mfma(const Ctx& X, LAS unsigned char* wl, const bf16_t* zc, int T, int ci, int wave, int lane) {
    const int h = wave >> 1, dir = wave & 1, fq = lane >> 4, l16 = lane & 15, r8 = lane >> 3, pc = lane & 7;
    LAS unsigned char* kl = wl; LAS unsigned char* vl = wl + 4608;
    const float lbv = X.lb[h * 64 + lane], oml = 1.f - lbv;
    const int fcol = (dir ? 2304 : 2048) + h * 64 + lane, vcolb = 2560 + h * 64 + pc * 8;
    f32x4 acc[4][4];
#pragma unroll
    for (int a = 0; a < 4; ++a)
#pragma unroll
        for (int b = 0; b < 4; ++b) acc[a][b] = (f32x4){0.f, 0.f, 0.f, 0.f};
    float run = 1.f;
    const int nh = (T + 31) >> 5;
#pragma unroll 1
    for (int hh = 0; hh < nh; ++hh) {
        const int hb = dir ? hh : (nh - 1 - hh); const int t0 = hb * 32; const int tn = (T - t0) < 32 ? (T - t0) : 32;
        u32x4 vr[4];
#pragma unroll
        for (int i = 0; i < 4; ++i) { const int rr = i * 8 + r8; vr[i] = (u32x4){0u, 0u, 0u, 0u}; if (rr < tn) vr[i] = *(const u32x4*)(zc + (size_t)(t0 + rr) * ZW + vcolb); }
        __syncthreads();
#pragma unroll 1
        for (int bt = 0; bt < 2; ++bt) {
            const int j0 = (dir ? bt : 1 - bt) * 16;
            bf16_t rf[16];
#pragma unroll
            for (int j = 0; j < 16; ++j) { rf[j] = 0; if (j0 + j < tn) rf[j] = zc[(size_t)(t0 + j0 + j) * ZW + fcol]; }
#pragma unroll
            for (int jj = 0; jj < 16; ++jj) {
                const int jl = dir ? jj : 15 - jj; const int j = j0 + jl;
                float kh = 0.f;
                if (j < tn) { const float sg = sigm(bf2f(dir ? rf[jj] : rf[15 - jj])); kh = oml * (1.f - sg) * run; run *= lbv + oml * sg; }
                *(LAS bf16_t*)(kl + j * 144 + lane * 2) = (bf16_t)f2bf(kh);
            }
        }
#pragma unroll
        for (int i = 0; i < 4; ++i) *(LAS u32x4*)(vl + (i * 8 + r8) * 144 + pc * 16) = vr[i];
        __syncthreads();
        const int roff = (4 * fq + (l16 >> 2)) * 144 + (4 * (l16 & 3)) * 2;
        bf16x8 af[4];
#pragma unroll
        for (int mt = 0; mt < 4; ++mt) { const v4i16_t ta = vtr16(kl + roff + mt * 32), tb = vtr16(kl + roff + 16 * 144 + mt * 32); af[mt] = (bf16x8){ta[0], ta[1], ta[2], ta[3], tb[0], tb[1], tb[2], tb[3]}; }
#pragma unroll
        for (int nt = 0; nt < 4; ++nt) {
            const v4i16_t ta = vtr16(vl + roff + nt * 32), tb = vtr16(vl + roff + 16 * 144 + nt * 32);
            const bf16x8 bfv = (bf16x8){ta[0], ta[1], ta[2], ta[3], tb[0], tb[1], tb[2], tb[3]};
#pragma unroll
            for (int mt = 0; mt < 4; ++mt) acc[mt][nt] = __builtin_amdgcn_mfma_f32_16x16x32_bf16(af[mt], bfv, acc[mt][nt], 0, 0, 0);
        }
    }
    float* U = X.hgu + ((size_t)ci * 8 + wave) * 4096 + (4 * fq) * 64 + l16;
#pragma unroll
    for (int mt = 0; mt < 4; ++mt) {
#pragma unroll
        for (int r = 0; r < 4; ++r)
#pragma unroll
            for (int nt = 0; nt < 4; ++nt) U[(16 * mt + r) * 64 + 16 * nt] = acc[mt][nt][r];
        __builtin_amdgcn_sched_barrier(0);
    }
    X.hgp[((size_t)ci * 8 + wave) * 64 + lane] = run;
}

__device__ __forceinline__ void hg_passC_mfma(const Ctx& X, LAS unsigned char* wl, LAS bf16_t* ot, const bf16_t* zc, int T, int ci, int wave, int lane) {
    const int h = wave >> 1, dir = wave & 1, fq = lane >> 4, l16 = lane & 15, r8 = lane >> 3, pc = lane & 7;
    LAS unsigned char* ql = wl; LAS unsigned char* kl = wl + 2304; LAS unsigned char* vl = wl + 4608; LAS float* pl = (LAS float*)(wl + 6912);
    const float lbv = X.lb[h * 64 + lane], oml = 1.f - lbv;
    const int fcol = (dir ? 2304 : 2048) + h * 64 + lane, qcol = 1792 + h * 64 + lane, vcolb = 2560 + h * 64 + pc * 8;
    f32x4 sa[4][4];
    {
        const float* U = X.hgu + ((size_t)ci * 8 + wave) * 4096 + (4 * fq) * 64 + l16;
#pragma unroll
        for (int mt = 0; mt < 4; ++mt) {
#pragma unroll
            for (int r = 0; r < 4; ++r)
#pragma unroll
                for (int nt = 0; nt < 4; ++nt) sa[mt][nt][r] = U[(16 * mt + r) * 64 + 16 * nt];
            __builtin_amdgcn_sched_barrier(0);
        }
    }
    const int nsc = T >> 4;
    bf16_t rq[16], rf[16]; u32x4 vr[2];
    {
        const int I0 = dir ? (nsc - 1) : 0;
#pragma unroll
        for (int i = 0; i < 16; ++i) { const int tok = 16 * I0 + (dir ? 15 - i : i); rq[i] = zc[(size_t)tok * ZW + qcol]; rf[i] = zc[(size_t)tok * ZW + fcol]; }
#pragma unroll
        for (int i8 = 0; i8 < 2; ++i8) { const int i = i8 * 8 + r8; const int tok = 16 * I0 + (dir ? 15 - i : i); vr[i8] = *(const u32x4*)(zc + (size_t)tok * ZW + vcolb); }
    }
#pragma unroll 1
    for (int sc = 0; sc < nsc; ++sc) {
        const int I = dir ? (nsc - 1 - sc) : sc;
        __syncthreads();
        float c = 1.f;
#pragma unroll
        for (int i = 0; i < 16; ++i) {
            const float q = bf2f(rq[i]), sg = sigm(bf2f(rf[i]));
            c *= lbv + oml * sg;
            *(LAS bf16_t*)(ql + i * 144 + lane * 2) = (bf16_t)f2bf(q * sigm(q) * c);
            *(LAS bf16_t*)(kl + i * 144 + lane * 2) = (bf16_t)f2bf(oml * (1.f - sg) / c);
        }
        pl[lane] = c;
#pragma unroll
        for (int i8 = 0; i8 < 2; ++i8) *(LAS u32x4*)(vl + (i8 * 8 + r8) * 144 + pc * 16) = vr[i8];
        __syncthreads();
        if (sc + 1 < nsc) {
            const int In = dir ? (nsc - 2 - sc) : sc + 1;
#pragma unroll
            for (int i = 0; i < 16; ++i) { const int tok = 16 * In + (dir ? 15 - i : i); rq[i] = zc[(size_t)tok * ZW + qcol]; rf[i] = zc[(size_t)tok * ZW + fcol]; }
#pragma unroll
            for (int i8 = 0; i8 < 2; ++i8) { const int i = i8 * 8 + r8; const int tok = 16 * In + (dir ? 15 - i : i); vr[i8] = *(const u32x4*)(zc + (size_t)tok * ZW + vcolb); }
        }
        f32x4 at = (f32x4){0.f, 0.f, 0.f, 0.f};
#pragma unroll
        for (int ks = 0; ks < 2; ++ks) at = __builtin_amdgcn_mfma_f32_16x16x32_bf16(*(const LAS bf16x8*)(kl + l16 * 144 + (32 * ks + 8 * fq) * 2), *(const LAS bf16x8*)(ql + l16 * 144 + (32 * ks + 8 * fq) * 2), at, 0, 0, 0);
#pragma unroll
        for (int r = 0; r < 4; ++r) if (4 * fq + r > l16) at[r] = 0.f;
        const bf16x8 atf = __builtin_bit_cast(bf16x8, pack8(at, (f32x4){0.f, 0.f, 0.f, 0.f}));
        const int roff = (4 * fq + (l16 >> 2)) * 144 + (4 * (l16 & 3)) * 2;
        f32x4 oT[4];
#pragma unroll
        for (int et = 0; et < 4; ++et) {
            const v4i16_t tv = vtr16(vl + roff + et * 32);
            const bf16x8 vf = (bf16x8){tv[0], tv[1], tv[2], tv[3], 0, 0, 0, 0};
            oT[et] = __builtin_amdgcn_mfma_f32_16x16x32_bf16(vf, atf, (f32x4){0.f, 0.f, 0.f, 0.f}, 0, 0, 0);
        }
#pragma unroll
        for (int kp = 0; kp < 2; ++kp) {
            const u32x2 q0 = *(const LAS u32x2*)(ql + l16 * 144 + (32 * kp + 4 * fq) * 2), q1 = *(const LAS u32x2*)(ql + l16 * 144 + (32 * kp + 16 + 4 * fq) * 2);
            const bf16x8 qfr = __builtin_bit_cast(bf16x8, (u32x4){q0.x, q0.y, q1.x, q1.y});
#pragma unroll
            for (int nt = 0; nt < 4; ++nt) {
                const bf16x8 sf = __builtin_bit_cast(bf16x8, pack8(sa[2 * kp][nt], sa[2 * kp + 1][nt]));
                oT[nt] = __builtin_amdgcn_mfma_f32_16x16x32_bf16(sf, qfr, oT[nt], 0, 0, 0);
            }
        }
        {
            const int tok = 16 * I + (dir ? 15 - l16 : l16);
#pragma unroll
            for (int et = 0; et < 4; ++et)
#pragma unroll
                for (int r = 0; r < 4; ++r) ot[tok * 64 + 16 * et + 4 * fq + r] = (bf16_t)f2bf(oT[et][r]);
        }
        bf16x8 kf[4];
#pragma unroll
        for (int mt = 0; mt < 4; ++mt) { const v4i16_t tk = vtr16(kl + roff + mt * 32); kf[mt] = (bf16x8){tk[0], tk[1], tk[2], tk[3], 0, 0, 0, 0}; }
#pragma unroll
        for (int nt = 0; nt < 4; ++nt) {
            const v4i16_t tv = vtr16(vl + roff + nt * 32);
            const bf16x8 vf = (bf16x8){tv[0], tv[1], tv[2], tv[3], 0, 0, 0, 0};
#pragma unroll
            for (int mt = 0; mt < 4; ++mt) sa[mt][nt] = __builtin_amdgcn_mfma_f32_16x16x32_bf16(kf[mt], vf, sa[mt][nt], 0, 0, 0);
        }
#pragma unroll
        for (int mt = 0; mt < 4; ++mt) {
            const f32x4 p4 = *(const LAS f32x4*)(pl + 16 * mt + 4 * fq);
#pragma unroll
            for (int nt = 0; nt < 4; ++nt) sa[mt][nt] = sa[mt][nt] * p4;
        }
    }
}

__device__ __forceinline__ void hg_passB(const Ctx& X, const Grp& gp, int gtid, int GT) {
    const int n = gp.nseq * 32768;
    for (int e = gtid; e < n; e += GT) {
        const int sl = e >> 15, r = e & 32767, hd = r >> 12, de = r & 4095, d = de >> 6, dir = hd & 1;
        const size_t cb0 = (size_t)(sl * gp.nch) * 8 + hd; const int cstep = dir ? -8 : 8; const size_t cfirst = dir ? cb0 + (size_t)(gp.nch - 1) * 8 : cb0;
        float s = 0.f;
        float u[2][8], pv[2][8];
#pragma unroll
        for (int j = 0; j < 8; ++j) { u[0][j] = 0.f; pv[0][j] = 0.f; if (j < gp.nch) { const size_t cb = cfirst + (long)j * cstep; u[0][j] = X.hgu[cb * 4096 + de]; pv[0][j] = X.hgp[cb * 64 + d]; } }
        for (int k0 = 0; k0 < gp.nch; k0 += 16) {
#pragma unroll
            for (int hb = 0; hb < 2; ++hb) {
                const int kb = k0 + hb * 8;
                if (kb < gp.nch) {
#pragma unroll
                    for (int j = 0; j < 8; ++j) { const int k = kb + 8 + j; u[1 - hb][j] = 0.f; pv[1 - hb][j] = 0.f; if (k < gp.nch) { const size_t cb = cfirst + (long)k * cstep; u[1 - hb][j] = X.hgu[cb * 4096 + de]; pv[1 - hb][j] = X.hgp[cb * 64 + d]; } }
#pragma unroll
                    for (int j = 0; j < 8; ++j) { const int k = kb + j; if (k < gp.nch) { const size_t cb = cfirst + (long)k * cstep; X.hgu[cb * 4096 + de] = s; s = pv[hb][j] * s + u[hb][j]; } }
                }
            }
        }
    }
}

__device__ __forceinline__ void na_task(const Ctx& X, const float* rpb, const Grp& gp, int sl, int task, bool metaq, int wave, int lane, LAS unsigned char* vl) {
    const int h = wave, fr = lane & 15, fq = lane >> 4;
    const int s = gp.s0 + sl, rows = gp.Lr >> 6;
    int r = 0, n = 0, rs = 0, ks = 0;
    const bf16_t* qptr; bf16_t* optr; size_t ostride = 512;
    if (metaq) { qptr = X.mz + (size_t)(s * 16 + fr) * ZW; optr = X.myb + (size_t)(s * 16) * 512; }
    else {
        r = task >> 2; n = task & 3;
        rs = r - 4; rs = rs < 0 ? 0 : (rs > rows - 8 ? rows - 8 : rs);
        ks = 16 * n - 8; ks = ks < 0 ? 0 : (ks > 32 ? 32 : ks);
        const size_t qrow0 = (size_t)sl * gp.Lr + r * 64 + 16 * n;
        qptr = X.z + (qrow0 + fr) * ZW; optr = X.yb + qrow0 * 512;
    }
    bf16x8 qf[2];
#pragma unroll
    for (int kk = 0; kk < 2; ++kk) qf[kk] = *(const bf16x8*)(qptr + 256 + h * 64 + 32 * kk + 8 * fq);
    f32x4 sc[17];
    {
        const bf16_t* kp = X.mz + (size_t)(s * 16 + fr) * ZW + 768 + h * 64 + 8 * fq;
        f32x4 c = (f32x4){0.f, 0.f, 0.f, 0.f};
#pragma unroll
        for (int kk = 0; kk < 2; ++kk) c = __builtin_amdgcn_mfma_f32_16x16x32_bf16(*(const bf16x8*)(kp + 32 * kk), qf[kk], c, 0, 0, 0);
        sc[0] = c * 0.125f;
    }
    const int qc = 16 * n + fr;
    int wstart = qc - 8; wstart = wstart < 0 ? 0 : (wstart > 48 ? 48 : wstart);
    const size_t krow_base = (size_t)sl * gp.Lr + (size_t)rs * 64 + ks;
    if (!metaq) {
#pragma unroll
        for (int tb = 0; tb < 2; ++tb) {
            bf16x8 kf[8][2]; float bz[8][4];
#pragma unroll
            for (int t4 = 0; t4 < 8; ++t4) {
                const int tt = tb * 8 + t4, kj = tt >> 1, half = tt & 1;
                const bf16_t* kp = X.z + (krow_base + kj * 64 + 16 * half + fr) * ZW + 768 + h * 64 + 8 * fq;
                kf[t4][0] = *(const bf16x8*)kp; kf[t4][1] = *(const bf16x8*)(kp + 32);
            }
#pragma unroll
            for (int t4 = 0; t4 < 8; ++t4) {
                const int tt = tb * 8 + t4, kj = tt >> 1, half = tt & 1;
                const float* rp = rpb + (h * 15 + (rs + kj - r + 7)) * 31;
#pragma unroll
                for (int i = 0; i < 4; ++i) { int dc = ks + 16 * half + 4 * fq + i - qc; dc = dc < -15 ? -15 : (dc > 15 ? 15 : dc); bz[t4][i] = rp[dc + 15]; }
            }
            __builtin_amdgcn_sched_barrier(0);
#pragma unroll
            for (int t4 = 0; t4 < 8; ++t4) {
                const int tt = tb * 8 + t4, half = tt & 1;
                f32x4 c = (f32x4){0.f, 0.f, 0.f, 0.f};
                c = __builtin_amdgcn_mfma_f32_16x16x32_bf16(kf[t4][0], qf[0], c, 0, 0, 0);
                c = __builtin_amdgcn_mfma_f32_16x16x32_bf16(kf[t4][1], qf[1], c, 0, 0, 0);
#pragma unroll
                for (int i = 0; i < 4; ++i) {
                    const int kc = ks + 16 * half + 4 * fq + i;
                    const bool valid = (kc >= wstart) && (kc < wstart + 16);
                    c[i] = valid ? c[i] * 0.125f + bz[t4][i] : -1e30f;
                }
                sc[1 + tt] = c;
            }
            __builtin_amdgcn_sched_barrier(0);
        }
    } else {
#pragma unroll
        for (int tt = 0; tt < 16; ++tt) sc[1 + tt] = (f32x4){-1e30f, -1e30f, -1e30f, -1e30f};
    }
    float mx = -1e30f;
#pragma unroll
    for (int t = 0; t < 17; ++t)
#pragma unroll
        for (int i = 0; i < 4; ++i) mx = fmaxf(mx, sc[t][i]);
    mx = fmaxf(mx, __shfl_xor(mx, 16)); mx = fmaxf(mx, __shfl_xor(mx, 32));
    float sum = 0.f;
#pragma unroll
    for (int t = 0; t < 17; ++t)
#pragma unroll
        for (int i = 0; i < 4; ++i) { const float e = __expf(sc[t][i] - mx); sc[t][i] = e; sum += e; }
    sum += __shfl_xor(sum, 16); sum += __shfl_xor(sum, 32);
    const float inv = 1.f / sum;
    f32x4 oacc[4];
#pragma unroll
    for (int et = 0; et < 4; ++et) oacc[et] = (f32x4){0.f, 0.f, 0.f, 0.f};
    {
        const int r8 = lane >> 3, pc = lane & 7, l16 = lane & 15;
        const int vcol = 1280 + h * 64 + pc * 8;
        u32x4 vreg[8];
#pragma unroll
        for (int i = 0; i < 2; ++i) vreg[i] = *(const u32x4*)(X.mz + (size_t)(s * 16 + i * 8 + r8) * ZW + vcol);
#pragma unroll
        for (int cc = 0; cc < 5; ++cc) {
            if (cc > 0 && metaq) break;
            __syncthreads();
#pragma unroll
            for (int i = 0; i < 8; ++i) if (cc > 0 || i < 2) *(LAS u32x4*)(vl + (i * 8 + r8) * 144 + pc * 16) = vreg[i];
            __syncthreads();
            if (cc < 4 && !metaq) {
#pragma unroll
                for (int i = 0; i < 8; ++i) { const int rr = i * 8 + r8;
                    vreg[i] = *(const u32x4*)(X.z + (krow_base + (size_t)(2 * cc + (rr >> 5)) * 64 + (rr & 31)) * ZW + vcol); }
            }
#pragma unroll
            for (int ksl = 0; ksl < 2; ++ksl) {
                if (cc == 0 && ksl == 1) break;
                const int tt = 4 * (cc - 1) + 2 * ksl;
                f32x4 pa, pb;
                if (cc == 0) { pa = sc[0] * inv; pb = (f32x4){0.f, 0.f, 0.f, 0.f}; } else { pa = sc[1 + tt] * inv; pb = sc[2 + tt] * inv; }
                const bf16x8 pf = __builtin_bit_cast(bf16x8, pack8(pa, pb));
                const LAS unsigned char* rowp = vl + (32 * ksl + 4 * fq + (l16 >> 2)) * 144 + (4 * (l16 & 3)) * 2;
#pragma unroll
                for (int et = 0; et < 4; ++et) {
                    const v4i16_t ta = vtr16(rowp + et * 32);
                    v4i16_t tb = (v4i16_t){0, 0, 0, 0};
                    if (cc > 0) tb = vtr16(rowp + 16 * 144 + et * 32);
                    const bf16x8 vw = (bf16x8){ta[0], ta[1], ta[2], ta[3], tb[0], tb[1], tb[2], tb[3]};
                    oacc[et] = __builtin_amdgcn_mfma_f32_16x16x32_bf16(pf, vw, oacc[et], 0, 0, 0);
                }
            }
        }
    }
#pragma unroll
    for (int et = 0; et < 4; ++et)
#pragma unroll
        for (int i = 0; i < 4; ++i) optr[(size_t)(4 * fq + i) * ostride + h * 64 + et * 16 + fr] = (bf16_t)f2bf(oacc[et][i]);
}

#define XB_TMO      128
#define XB_XCNT(j)  (256  + 64 * (j))
#define XB_XSUB(j)  (1280 + 64 * (j))
#define XB_XGEN(j)  (2304 + 64 * (j))
#define XB_TOP      3328
#define XB_TOPGEN   3392
#define XCD_BAR_WORDS 3456
#define XB_SPIN_CAP (1u << 22)
__device__ __forceinline__ unsigned xb_ld(unsigned* p)              { return __hip_atomic_load(p, __ATOMIC_RELAXED, __HIP_MEMORY_SCOPE_AGENT); }
__device__ __forceinline__ unsigned xb_add(unsigned* p, unsigned v) { return __hip_atomic_fetch_add(p, v, __ATOMIC_RELAXED, __HIP_MEMORY_SCOPE_AGENT); }
__device__ __forceinline__ unsigned xb_xcc_id() { return (unsigned)__builtin_amdgcn_s_getreg((3 << 11) | 20) & 0xFu; }
#define XB_SPIN(cond, bar) do { unsigned _sp = 0; while (cond) { __builtin_amdgcn_s_sleep(1); \
    if ((++_sp & 255u) == 0u) { if (xb_ld(&(bar)[XB_TMO])) break; if (_sp > XB_SPIN_CAP) { atomicAdd(&(bar)[XB_TMO], 1u); break; } } } } while (0)
__device__ __forceinline__ void xcd_barrier_complete(unsigned* bar, unsigned x, unsigned& nloc, unsigned& nx) {
    const unsigned G = gridDim.x * gridDim.y * gridDim.z;
    unsigned sum, cnt, mine, sp = 0u;
    for (;;) {
        sum = 0u; cnt = 0u; mine = 0u;
#pragma unroll
        for (unsigned j = 0; j < 16; ++j) { const unsigned c = xb_ld(&bar[XB_XCNT(j)]); sum += c; cnt += (c > 0u) ? 1u : 0u; mine = (j == x) ? c : mine; }
        if (sum == G) break;
        __builtin_amdgcn_s_sleep(1);
        if ((++sp & 255u) == 0u) { if (xb_ld(&bar[XB_TMO])) break; if (sp > XB_SPIN_CAP) { atomicAdd(&bar[XB_TMO], 1u); break; } }
    }
    nloc = mine > 0u ? mine : 1u; nx = cnt > 0u ? cnt : 1u;
}
__device__ __forceinline__ void xcd_barrier(unsigned* bar, volatile LAS unsigned* st) {
    asm volatile("s_waitcnt vmcnt(0)" ::: "memory");
    __syncthreads();
    if (threadIdx.x == 0) {
        const unsigned x = xb_xcc_id();
        __builtin_amdgcn_s_waitcnt(0);
        unsigned nloc = st[0], nx = st[1];
        if (nloc == 0u) { xcd_barrier_complete(bar, x, nloc, nx); st[0] = nloc; st[1] = nx; }
        const unsigned old = xb_add(&bar[XB_XSUB(x)], 1u);
        const unsigned gen = old / nloc;
        if (old + 1u == (gen + 1u) * nloc) {
            __builtin_amdgcn_fence(__ATOMIC_RELEASE, "agent");
            asm volatile("s_waitcnt vmcnt(0)" ::: "memory");
            const unsigned og = xb_add(&bar[XB_TOP], 1u);
            const unsigned tg = og / nx;
            if (og + 1u == (tg + 1u) * nx) xb_add(&bar[XB_TOPGEN], 1u);
            else XB_SPIN(xb_ld(&bar[XB_TOPGEN]) == tg, bar);
            __builtin_amdgcn_fence(__ATOMIC_ACQUIRE, "agent");
            xb_add(&bar[XB_XGEN(x)], 1u);
            asm volatile("s_waitcnt vmcnt(0)" ::: "memory");
        } else {
            XB_SPIN(xb_ld(&bar[XB_XGEN(x)]) == gen, bar);
            __builtin_amdgcn_fence(__ATOMIC_ACQUIRE, "agent");
            asm volatile("s_waitcnt vmcnt(0)" ::: "memory");
        }
    }
    __syncthreads();
}
#define GRID_SYNC() xcd_barrier((unsigned*)(KA(ws) + WS_CTL), (volatile LAS unsigned*)(lds + LDS_ST_OFF))
__device__ __forceinline__ Ctx make_ctx(unsigned char* ws) {
    Ctx X;
    X.hb = (bf16_t*)(ws + WS_HB); X.ssq = (float*)(ws + WS_SSQ); X.z = (bf16_t*)(ws + WS_Z); X.yb = (bf16_t*)(ws + WS_YB); X.vt = (bf16_t*)(ws + WS_VT);
    X.hgu = (float*)(ws + WS_HGU); X.hgp = (float*)(ws + WS_HGP); X.s5s = (float*)(ws + WS_S5S); X.w = (bf16_t*)(ws + WS_W);
    X.lbar = (const float*)(ws + WS_TAB + T_LBAR); X.l16 = (const float*)(ws + WS_TAB + T_L16); X.l64 = (const float*)(ws + WS_TAB + T_L64);
    X.bfrag = (const bf16_t*)(ws + WS_TAB + T_BFRAG); X.cfrag = (const bf16_t*)(ws + WS_TAB + T_CFRAG); X.lb = (const float*)(ws + WS_TAB + T_LB);
    X.mh = (float*)(ws + WS_META + M_H); X.mhb = (bf16_t*)(ws + WS_META + M_HB); X.mssq = (float*)(ws + WS_META + M_SSQ); X.mz = (bf16_t*)(ws + WS_META + M_Z);
    X.myb = (bf16_t*)(ws + WS_META + M_YB); X.mvt = (bf16_t*)(ws + WS_META + M_VT); X.mact = (bf16_t*)(ws + WS_META + M_ACT);
    return X;
}

__device__ __forceinline__ bool make_job(unsigned char* ws, float* out, int l, int g, int ph, int j, pg8::Gemm& gm, pg8::UberEpi& ep) {
    const bool mchain = (g == 3) && (l < NLAYER - 1);
    int njobs = 1; bool meta = false; int sub = j;
    if (ph == 0) { njobs = (g == 0) ? 2 : 1; meta = (j == 1); }
    else if (ph == 4) { njobs = (g == 3) ? 2 : 1; meta = (j == 1); }
    else if (ph == 5) { njobs = mchain ? 6 : 3; meta = (j >= 3); sub = j % 3; }
    else { njobs = mchain ? 2 : 1; meta = (j == 1); }
    if (j >= njobs) return false;
    unsigned char* wb = ws + WS_W;
    const size_t r0 = (size_t)g * RG;
    unsigned char* mb = ws + WS_META;
    bf16_t* z = meta ? (bf16_t*)(mb + M_Z) : (bf16_t*)(ws + WS_Z);
    bf16_t* hb = meta ? (bf16_t*)(mb + M_HB) : (bf16_t*)(ws + WS_HB) + r0 * DM;
    float* ssq = meta ? (float*)(mb + M_SSQ) : (float*)(ws + WS_SSQ) + r0 * 4;
    float* h = meta ? (float*)(mb + M_H) : out + r0 * DM;
    bf16_t* yb = meta ? (bf16_t*)(mb + M_YB) : (bf16_t*)(ws + WS_YB);
    bf16_t* vt = meta ? (bf16_t*)(mb + M_VT) : (bf16_t*)(ws + WS_VT);
    bf16_t* act = meta ? (bf16_t*)(mb + M_ACT) : (bf16_t*)(ws + WS_Z);
    gm.M = meta ? 256 : RG;
    ep.i0 = 0; ep.p0 = nullptr; ep.p1 = nullptr; ep.p2 = nullptr;
    if (ph == 0) { gm.A = hb; gm.lda = DM; gm.Bt = (const bf16_t*)(wb + W_IN); gm.N = ZN; gm.K = DM; ep.mode = 0; ep.p0 = (unsigned char*)z; ep.p1 = (unsigned char*)ssq; ep.p2 = (unsigned char*)vt; ep.i0 = meta ? 256 : VTLD; }
    else if (ph == 4) { gm.A = z + 512; gm.lda = ZW; gm.Bt = (const bf16_t*)(wb + W_GLU); gm.N = 256; gm.K = 256; ep.mode = 1; ep.p0 = (unsigned char*)z; }
    else if (ph == 5) {
        gm.N = DM; ep.p0 = (unsigned char*)z;
        if (sub == 0) { gm.A = yb; gm.lda = 512; gm.Bt = (const bf16_t*)(wb + W_UPB); gm.K = 512; ep.mode = 2; ep.i0 = 4096; }
        else if (sub == 1) { gm.A = z + 256; gm.lda = ZW; gm.Bt = (const bf16_t*)(wb + W_UPC); gm.K = 256; ep.mode = 3; ep.i0 = 5120; }
        else { gm.A = z; gm.lda = ZW; gm.Bt = (const bf16_t*)(wb + W_UPA); gm.K = 256; ep.mode = 3; ep.i0 = 3072; }
    }
    else if (ph == 6) { gm.A = z + 1024; gm.lda = ZW; gm.Bt = (const bf16_t*)(wb + W_O); gm.N = DM; gm.K = DM; ep.mode = 4; ep.p0 = (unsigned char*)h; ep.p1 = (unsigned char*)hb; ep.p2 = (unsigned char*)ssq; }
    else if (ph == 7) { gm.A = hb; gm.lda = DM; gm.Bt = (const bf16_t*)(wb + W_GU); gm.N = 2 * FFH; gm.K = DM; ep.mode = 5; ep.p0 = (unsigned char*)act; ep.p1 = (unsigned char*)ssq; }
    else { gm.A = act; gm.lda = FFH; gm.Bt = (const bf16_t*)(wb + W_DN); gm.N = DM; gm.K = FFH; ep.mode = 4; ep.p0 = (unsigned char*)h; ep.p1 = (unsigned char*)hb; ep.p2 = (unsigned char*)ssq; }
    return true;
}

__device__ __forceinline__ void prologue(int G) {
    const int tid_ = opaque_tid(); const int lane = tid_ & 63, gw = blockIdx.x * 8 + __builtin_amdgcn_readfirstlane(tid_ >> 6), NGW = G * 8;
    const Ctx X = make_ctx(((unsigned char*)KA(ws)));
    for (int row = gw; row < RMAIN + 256; row += NGW) {
        const bool ismeta = row >= RMAIN; const int mr = row - RMAIN;
        const float* src = ismeta ? (mr < 160 ? KAF(meta_tokens) + (size_t)(mr & 15) * DM : nullptr) : (row < 32768 ? KAF(x_prompt) + (size_t)row * DM : KAF(x_sample) + (size_t)(row - 32768) * DM);
        float* hd = ismeta ? X.mh + (size_t)mr * DM : ((float*)KA(out)) + (size_t)row * DM;
        bf16_t* hbd = ismeta ? X.mhb + (size_t)mr * DM : X.hb + (size_t)row * DM;
        float* sq = ismeta ? X.mssq + (size_t)mr * 4 : X.ssq + (size_t)row * 4;
        float ss = 0.f;
#pragma unroll
        for (int j = 0; j < 4; ++j) {
            f32x4 v = (f32x4){0.f, 0.f, 0.f, 0.f}; if (src) v = *(const f32x4*)(src + j * 256 + lane * 4);
            *(f32x4*)(hd + j * 256 + lane * 4) = v;
            *(u32x2*)(hbd + j * 256 + lane * 4) = (u32x2){pk2(v[0], v[1]), pk2(v[2], v[3])};
            ss += (v[0] * v[0] + v[1] * v[1]) + (v[2] * v[2] + v[3] * v[3]);
        }
        ss = wave_sum(ss);
        if (lane < 4) sq[lane] = lane == 0 ? ss : 0.f;
    }
}

__device__ __forceinline__ void mixer_phase_A(int l, int g, LAS unsigned char* lds, int G, int bid) {
    const int tid_ = opaque_tid(); const int lane = tid_ & 63, wave = __builtin_amdgcn_readfirstlane(tid_ >> 6);
    const Ctx X = make_ctx(((unsigned char*)KA(ws))); const Grp gp = make_grp(g);
    const float* rpb = KAF(rpb) + (size_t)l * 8 * 15 * 31; const float* s5d = KAF(s5_d) + l * 256;
    const int nna = gp.nseq * (gp.Lr / 16), nmq = gp.nseq, nct = gp.nseq * (gp.nch - 1);
    const int ntask = nna + nmq + 2 * nct;
    const bool xmap = (nna % 256 == 0) && ((volatile LAS unsigned*)(lds + LDS_ST_OFF))[4] != 0u;
    if (xmap) {
        const int xcc = (int)((volatile LAS unsigned*)(lds + LDS_ST_OFF))[2], xrk = (int)((volatile LAS unsigned*)(lds + LDS_ST_OFF))[3];
        const int per = gp.Lr / 16, nx = nna / 8, rounds = nna / 256;
        for (int i = 0; i < rounds; ++i) { const int t = xcc * nx + xrk + 32 * i; na_task(X, rpb, gp, t / per, t % per, false, wave, lane, lds + wave * 9216); }
    }
    for (int t = bid + (xmap ? nna : 0); t < ntask; t += G) {
        __syncthreads();
        if (t < nna) { const int per = gp.Lr / 16; na_task(X, rpb, gp, t / per, t % per, false, wave, lane, lds + wave * 9216); }
        else if (t < nna + nmq) { na_task(X, rpb, gp, t - nna, 0, true, wave, lane, lds + wave * 9216); }
        else {
            const int u = t - nna - nmq; const bool isS5 = u < nct; const int v = isS5 ? u : u - nct;
            const int sl = v / (gp.nch - 1), c1 = v % (gp.nch - 1) + 1;
            for (int c = (c1 == 1 ? 0 : c1); c <= c1; ++c) {
                __syncthreads();
                const int ci = sl * gp.nch + c; const int T = c == 0 ? 16 : 64;
                bf16_t* zc = c == 0 ? X.mz + (size_t)((gp.s0 + sl) * 16) * ZW : X.z + ((size_t)sl * gp.Lr + 64 * (c - 1)) * ZW;
                if (isS5) s5_chunk<false>(X, s5d, (LAS float*)(lds + wave * 16896), zc, T, ci, wave, lane);
                else hg_passA_mfma(X, lds + wave * 9216, zc, T, ci, wave, lane);
            }
        }
    }
}

__device__ __forceinline__ void mixer_phase_C(int l, int g, LAS unsigned char* lds, int G, int bid) {
    const int tid_ = opaque_tid(); const int lane = tid_ & 63, wave = __builtin_amdgcn_readfirstlane(tid_ >> 6);
    const Ctx X = make_ctx(((unsigned char*)KA(ws))); const Grp gp = make_grp(g);
    const float* s5d = KAF(s5_d) + l * 256; const float* ong = KAF(onorm_g) + l * 64;
    const int nct = gp.nseq * (gp.nch - 1);
    for (int t = bid; t < 2 * nct; t += G) {
        const bool isS5 = t < nct; const int v = isS5 ? t : t - nct;
        const int sl = v / (gp.nch - 1), c1 = v % (gp.nch - 1) + 1;
        for (int c = (c1 == 1 ? 0 : c1); c <= c1; ++c) {
            __syncthreads();
            const int ci = sl * gp.nch + c; const int T = c == 0 ? 16 : 64;
            bf16_t* zc = c == 0 ? X.mz + (size_t)((gp.s0 + sl) * 16) * ZW : X.z + ((size_t)sl * gp.Lr + 64 * (c - 1)) * ZW;
            if (isS5) {
                s5_chunk<true>(X, s5d, (LAS float*)(lds + wave * 16896), zc, T, ci, wave, lane);
                const int fr = lane & 15, fq = lane >> 4;
                const bf16_t* wg = (const bf16_t*)((const unsigned char*)X.w + W_GLU);
                const int n0 = wave * 32;
                bf16x8 bw[8][2];
#pragma unroll
                for (int ks = 0; ks < 8; ++ks)
#pragma unroll
                    for (int n2 = 0; n2 < 2; ++n2) bw[ks][n2] = *(const bf16x8*)(wg + (size_t)(n0 + n2 * 16 + fr) * 256 + ks * 32 + fq * 8);
                asm volatile("s_waitcnt vmcnt(0)" ::: "memory");
                __syncthreads();
                f32x4 ga[4][2];
#pragma unroll
                for (int a = 0; a < 4; ++a)
#pragma unroll
                    for (int b = 0; b < 2; ++b) ga[a][b] = (f32x4){0.f, 0.f, 0.f, 0.f};
#pragma unroll
                for (int kh = 0; kh < 2; ++kh) {
                    bf16x8 af[4][4];
#pragma unroll
                    for (int k4 = 0; k4 < 4; ++k4)
#pragma unroll
                        for (int mt = 0; mt < 4; ++mt) { af[k4][mt] = (bf16x8){0, 0, 0, 0, 0, 0, 0, 0}; if (mt * 16 < T) af[k4][mt] = *(const bf16x8*)(zc + (size_t)(mt * 16 + fr) * ZW + 512 + (kh * 4 + k4) * 32 + fq * 8); }
                    __builtin_amdgcn_sched_barrier(0);
#pragma unroll
                    for (int k4 = 0; k4 < 4; ++k4)
#pragma unroll
                        for (int mt = 0; mt < 4; ++mt) {
                            if (mt * 16 < T) {
#pragma unroll
                                for (int n2 = 0; n2 < 2; ++n2) ga[mt][n2] = __builtin_amdgcn_mfma_f32_16x16x32_bf16(af[k4][mt], bw[kh * 4 + k4][n2], ga[mt][n2], 0, 0, 0);
                            }
                        }
                    __builtin_amdgcn_sched_barrier(0);
                }
#pragma unroll
                for (int mt = 0; mt < 4; ++mt) {
                    if (mt * 16 < T) {
                        float yy[2][4];
#pragma unroll
                        for (int n2 = 0; n2 < 2; ++n2)
#pragma unroll
                            for (int r = 0; r < 4; ++r) yy[n2][r] = bf2f(zc[(size_t)(mt * 16 + 4 * fq + r) * ZW + 512 + n0 + n2 * 16 + fr]);
#pragma unroll
                        for (int n2 = 0; n2 < 2; ++n2)
#pragma unroll
                            for (int r = 0; r < 4; ++r) zc[(size_t)(mt * 16 + 4 * fq + r) * ZW + n0 + n2 * 16 + fr] = (bf16_t)f2bf(yy[n2][r] * sigm(ga[mt][n2][r]));
                    }
                }
            }
            else {
                hg_passC_mfma(X, lds + wave * 7168, (LAS bf16_t*)(lds + 65536 + wave * 8192), zc, T, ci, wave, lane);
                __syncthreads();
                const int h = wave >> 1, half = wave & 1;
                const LAS bf16_t* of = (const LAS bf16_t*)(lds + 65536 + (2 * h) * 8192); const LAS bf16_t* ob = (const LAS bf16_t*)(lds + 65536 + (2 * h + 1) * 8192);
                const float gn = ong[lane];
                const int tt0 = half * (T / 2);
                float gov[32];
#pragma unroll
                for (int i = 0; i < 32; ++i) { gov[i] = 0.f; if (i < T / 2) gov[i] = bf2f(zc[(size_t)(tt0 + i) * ZW + 2816 + h * 64 + lane]); }
#pragma unroll
                for (int i = 0; i < 32; ++i) {
                    if (i < T / 2) {
                        const int tt = tt0 + i;
                        const float o = bf2f(of[tt * 64 + lane]) + bf2f(ob[tt * 64 + lane]);
                        const float ms = wave_sum(o * o) * (1.0f / 64.0f);
                        const float go = gov[i];
                        zc[(size_t)tt * ZW + 256 + h * 64 + lane] = (bf16_t)f2bf(o * rsqrtf(ms + 1e-6f) * gn * (go * sigm(go)));
                    }
                }
            }
        }
    }
}

__global__ void __launch_bounds__(512, 2) fwd_kernel(Args a) {
    extern __shared__ __attribute__((aligned(16))) unsigned char lds_raw[];
    LAS unsigned char* lds = (LAS unsigned char*)lds_raw;
    const int G = gridDim.x, bid = blockIdx.x;

    if (threadIdx.x < 2) ((volatile LAS unsigned*)(lds + LDS_ST_OFF))[threadIdx.x] = 0u;
    if (threadIdx.x == 0) { const unsigned xc = xb_xcc_id(); const unsigned rk = xb_add((unsigned*)(KA(ws) + WS_CTL) + XB_XCNT(xc), 1u);
        ((volatile LAS unsigned*)(lds + LDS_ST_OFF))[2] = xc; ((volatile LAS unsigned*)(lds + LDS_ST_OFF))[3] = rk; }
    __syncthreads();
    prologue(G);

    for (int l = 0; l < NLAYER; ++l) {
        __syncthreads();
        { const Ctx X = make_ctx(((unsigned char*)KA(ws))); prep_layer(X, l, lds, G); }
        if (l == 0) { asm volatile("s_waitcnt vmcnt(0)" ::: "memory"); __syncthreads(); cg::this_grid().sync(); }
        GRID_SYNC();
        if (l == 0) {
            if (threadIdx.x == 0) { unsigned* bar = (unsigned*)(KA(ws) + WS_CTL); bool ok = (G == 256);
                for (int j = 0; j < 16; ++j) { const unsigned c = xb_ld(&bar[XB_XCNT(j)]); ok = ok && (c == (j < 8 ? 32u : 0u)); }
                ((volatile LAS unsigned*)(lds + LDS_ST_OFF))[4] = ok ? 1u : 0u; }
            __syncthreads();
        }
        for (int g = 0; g < 4; ++g) {
            for (int ph = 0; ph < 9; ++ph) {
                if (ph == 4) continue;
                if (ph == 1) mixer_phase_A(l, g, lds, G, bid);
                else if (ph == 2) { const Ctx X = make_ctx(((unsigned char*)KA(ws))); const Grp gp = make_grp(g); const int gtid = bid * 512 + opaque_tid(), GT = G * 512; s5_passB(X, gp, gtid, GT); hg_passB(X, gp, GT - 1 - gtid, GT); }
                else if (ph == 3) mixer_phase_C(l, g, lds, G, bid);
                else {
                    for (int j = 0; j < 6; ++j) {
                        pg8::Gemm gm; pg8::UberEpi ep;
                        if (!make_job(((unsigned char*)KA(ws)), ((float*)KA(out)), l, g, ph, j, gm, ep)) break;
                        pg8::StaticOrder SO; SO.init(gm.M, gm.N, G, bid);
                        pg8::gemm_phase(lds, gm, SO, ep);
                    }
                }
                GRID_SYNC();
            }
        }
    }
    {
        const float* ssq = (const float*)(((unsigned char*)KA(ws)) + WS_SSQ);
        const int tid_ = opaque_tid(); const int lane = tid_ & 63, wave = __builtin_amdgcn_readfirstlane(tid_ >> 6);
        for (int row = bid * 8 + wave; row < RMAIN; row += G * 8) {
            const float rs = pg8::row_rstd(ssq, row);
            float* hp = ((float*)KA(out)) + (size_t)row * DM;
#pragma unroll
            for (int j = 0; j < 4; ++j) {
                f32x4 v = *(const f32x4*)(hp + j * 256 + lane * 4); const f32x4 gv = *(const f32x4*)(KAF(final_g) + j * 256 + lane * 4);
                v = v * rs * gv; *(f32x4*)(hp + j * 256 + lane * 4) = v;
            }
        }
    }
}

extern "C" void kernel_launch(void* const* d_in, const int* in_sizes, int n_in, void* d_out, int out_size, void* d_ws, size_t ws_size, hipStream_t stream) {
    static int grid = 0;
    if (grid == 0) {
        int dev = 0, cus = 0, per_cu = 0;
        (void)hipGetDevice(&dev);
        (void)hipDeviceGetAttribute(&cus, hipDeviceAttributeMultiprocessorCount, dev);
        (void)hipFuncSetAttribute((const void*)fwd_kernel, hipFuncAttributeMaxDynamicSharedMemorySize, LDS_BYTES);
        (void)hipOccupancyMaxActiveBlocksPerMultiprocessor(&per_cu, (const void*)fwd_kernel, 512, LDS_BYTES);
        (void)hipGetLastError();
        if (ws_size < WS_TOTAL) fprintf(stderr, "kernel_launch: workspace too small: %zu < %zu\n", ws_size, (size_t)WS_TOTAL);
        grid = cus > 0 ? cus : 256;
    }
    (void)hipMemsetAsync((char*)d_ws + WS_CTL, 0, CTL_BYTES, stream);
    Args a{};
    const float** pp = (const float**)&a;
    for (int i = 0; i < 26; ++i) pp[i] = (const float*)d_in[i];
    a.out = (float*)d_out; a.ws = (unsigned char*)d_ws;
    void* args[] = {&a};
    hipError_t e = hipLaunchCooperativeKernel((const void*)fwd_kernel, dim3(grid), dim3(512), args, LDS_BYTES, stream);
    if (e != hipSuccess) fprintf(stderr, "cooperative launch failed: %s\n", hipGetErrorString(e));
}
```

```cpp
#include <hip/hip_runtime.h>
#include <hip/hip_cooperative_groups.h>
#include <cstdio>
#include <cstdint>
namespace cg = cooperative_groups;

#define LAS __attribute__((address_space(3)))
typedef unsigned short bf16_t;
typedef short bf16x8 __attribute__((ext_vector_type(8)));
typedef float f32x4 __attribute__((ext_vector_type(4)));
typedef unsigned u32x4 __attribute__((ext_vector_type(4)));
typedef unsigned u32x2 __attribute__((ext_vector_type(2)));

#define WAVE_SYNC() asm volatile("s_waitcnt lgkmcnt(0)" ::: "memory")
__device__ __forceinline__ int opaque_tid() { int t = threadIdx.x; asm volatile("" : "+v"(t)); return t; }

__device__ __forceinline__ unsigned f2bf(float f) { unsigned u = __builtin_bit_cast(unsigned, f); return (u + 0x7fffu + ((u >> 16) & 1u)) >> 16; }
__device__ __forceinline__ unsigned pk2(float lo, float hi) { return f2bf(lo) | (f2bf(hi) << 16); }
__device__ __forceinline__ float bf2f(bf16_t b) { return __builtin_bit_cast(float, (unsigned)b << 16); }
__device__ __forceinline__ float bflo(unsigned w) { return __builtin_bit_cast(float, w << 16); }
__device__ __forceinline__ float bfhi(unsigned w) { return __builtin_bit_cast(float, w & 0xffff0000u); }
__device__ __forceinline__ float sigm(float x) { return 1.f / (1.f + __expf(-x)); }
__device__ __forceinline__ float gelu_tanh(float y) { const float a = 0.7978845608028654f * (y + 0.044715f * y * y * y); const float th = 1.f - 2.f / (__expf(2.f * a) + 1.f); return 0.5f * y * (1.f + th); }
__device__ __forceinline__ u32x4 pack8(f32x4 a, f32x4 b) { u32x4 w; w.x = pk2(a[0], a[1]); w.y = pk2(a[2], a[3]); w.z = pk2(b[0], b[1]); w.w = pk2(b[2], b[3]); return w; }
__device__ __forceinline__ float wave_sum(float v) {
#pragma unroll
    for (int o = 1; o < 64; o <<= 1) v += __shfl_xor(v, o);
    return v;
}

namespace pg8 {
constexpr int ZSTR = 6208;
constexpr int BM = 256, BK = 64, HALF = 128, HTB = HALF * BK * 2, STAGE_BYTES = 8 * HTB, NXCD = 8, WGM = 8;
__host__ __device__ __forceinline__ int lds_byte(int r, int c) { const int st = (r >> 4) * 2 + (c >> 5), rr = r & 15, cc = c & 31, ob = rr * 64 + cc * 2; return st * 1024 + (ob ^ (((ob >> 9) & 1) << 5)); }
__host__ __device__ __forceinline__ void stage_rc(int b, int& R, int& C) { const int st = b / 1024, sb = b % 1024, swz = sb ^ (((sb >> 9) & 1) << 5); R = (st >> 1) * 16 + swz / 64; C = (st & 1) * 32 + (swz % 64) / 2; }
__host__ __device__ __forceinline__ int perm32(int rho) { const int n = rho >> 4, i = rho & 15; return 8 * (i >> 2) + 4 * n + (i & 3); }
struct Unit { int pm, pn; };
struct Gemm { const bf16_t* A; int lda; const bf16_t* Bt; int M, N, K; };
struct StaticOrder {
    int nM, nN, nwg, G, c;
    __device__ void init(int M, int N, int G_, int c_) { nM = M / BM; nN = N / BM; nwg = nM * nN; G = G_; c = c_; }
    __device__ bool next(int i, Unit& u) const {
        const long L = (long)i * G + c; if (L >= nwg) return false;
        int wgid = (int)L; { const int q = nwg / NXCD, r = nwg % NXCD, xcd = wgid % NXCD, off = wgid / NXCD; wgid = (xcd < r ? xcd * (q + 1) : r * (q + 1) + (xcd - r) * q) + off; }
        const int nig = WGM * nN, gid = wgid / nig, fm = gid * WGM, gsz = (nM - fm) < WGM ? (nM - fm) : WGM;
        u.pm = fm + ((wgid % nig) % gsz); u.pn = (wgid % nig) / gsz; return true;
    }
};

struct UberEpi;
__device__ __forceinline__ void run_epi(const UberEpi& E, LAS unsigned char* lds, const f32x4 (&acc)[2][2][4][2], const Unit& u, int wr, int wc, int fr, int fq);
__device__ __forceinline__ void gemm_phase(LAS unsigned char* lds, const Gemm g, const StaticOrder& S, const UberEpi& E) {
    const int tid = opaque_tid(), wid = __builtin_amdgcn_readfirstlane(tid >> 6), lane = tid & 63, wr = wid >> 2, wc = wid & 3, fr = lane & 15, fq = lane >> 4;
    const int K = g.K, nt = K / BK, lda = g.lda;
    unsigned voffA[2], voffB[2];
#pragma unroll
    for (int i = 0; i < 2; ++i) { int R, C; stage_rc(tid * 16 + i * 8192, R, C); const int Rb = (R & ~31) + perm32(R & 31);
        voffA[i] = (unsigned)(R * lda + C) * 2u; voffB[i] = (unsigned)(Rb * K + C) * 2u; }
    const size_t kstep = (size_t)(BK * 2);
    const size_t hstepA = (size_t)HALF * lda * 2, hstepB = (size_t)HALF * K * 2;
    const size_t tstepA = 2 * hstepA, tstepB = 2 * hstepB;
    const unsigned ldsw = (unsigned)wid * 1024u;
    const int aoff = lds_byte(wr * 64 + fr, fq * 8), boff = lds_byte(wc * 32 + fr, fq * 8);
#define PG8_SA(b, h) (((b) * 2 + (h)) * HTB)
#define PG8_SB(b, h) ((4 + (b) * 2 + (h)) * HTB)
#define PG8_STAGE(bufoff, gbase, voff) do { _Pragma("unroll") for (int _i = 0; _i < 2; ++_i) \
        __builtin_amdgcn_global_load_lds((const unsigned*)((const char*)(gbase) + (voff)[_i]), (LAS unsigned*)(lds + (bufoff) + ldsw + _i * 8192), 16, 0, 0); } while (0)
#define PG8_LDA(dst, b, h) do { _Pragma("unroll") for (int m = 0; m < 4; ++m) _Pragma("unroll") for (int k = 0; k < 2; ++k) dst[m][k] = *(const LAS bf16x8*)(lds + PG8_SA(b, h) + aoff + m * 2048 + k * 1024); } while (0)
#define PG8_LDB(dst, b, h) do { _Pragma("unroll") for (int n = 0; n < 2; ++n) _Pragma("unroll") for (int k = 0; k < 2; ++k) dst[n][k] = *(const LAS bf16x8*)(lds + PG8_SB(b, h) + boff + n * 2048 + k * 1024); } while (0)
#define PG8_MMA(ai, bj, At, Bt) do { __builtin_amdgcn_s_setprio(1); _Pragma("unroll") for (int m = 0; m < 4; ++m) _Pragma("unroll") for (int n = 0; n < 2; ++n) _Pragma("unroll") for (int k = 0; k < 2; ++k) \
        acc[ai][bj][m][n] = __builtin_amdgcn_mfma_f32_16x16x32_bf16(Bt[n][k], At[m][k], acc[ai][bj][m][n], 0, 0, 0); __builtin_amdgcn_s_setprio(0); } while (0)
#define PG8_WAIT_V(n) asm volatile("s_waitcnt vmcnt(" #n ")" ::: "memory")
#define PG8_WAIT_L(n) asm volatile("s_waitcnt lgkmcnt(" #n ")" ::: "memory")
#define PG8_BAR __builtin_amdgcn_s_barrier()
#define PG8_SCHED __builtin_amdgcn_sched_barrier(0)
    Unit cur, nxt; int ui = 0;
    if (!S.next(0, cur)) return;
    f32x4 acc[2][2][4][2];
#pragma unroll
    for (int a = 0; a < 2; ++a)
#pragma unroll
        for (int b = 0; b < 2; ++b)
#pragma unroll
            for (int m = 0; m < 4; ++m)
#pragma unroll
                for (int n = 0; n < 2; ++n) acc[a][b][m][n] = (f32x4){0.f, 0.f, 0.f, 0.f};
    bf16x8 At[4][2], B0[2][2], B1[2][2];
    const char* cA = (const char*)g.A + (size_t)cur.pm * tstepA; const char* cB = (const char*)g.Bt + (size_t)cur.pn * tstepB;
    PG8_STAGE(PG8_SB(0, 0), cB, voffB); PG8_STAGE(PG8_SB(0, 1), cB + hstepB, voffB); PG8_STAGE(PG8_SA(0, 0), cA, voffA); PG8_STAGE(PG8_SA(0, 1), cA + hstepA, voffA);
    if (wr == 1) PG8_BAR;
    PG8_WAIT_V(2); PG8_BAR;
    PG8_STAGE(PG8_SB(1, 0), cB + kstep, voffB); PG8_STAGE(PG8_SA(1, 0), cA + kstep, voffA); PG8_STAGE(PG8_SB(1, 1), cB + hstepB + kstep, voffB);
    PG8_WAIT_V(6); PG8_BAR;
    for (;;) {
        const bool has_next = S.next(ui + 1, nxt);
        const char* nA = has_next ? (const char*)g.A + (size_t)nxt.pm * tstepA : cA; const char* nB = has_next ? (const char*)g.Bt + (size_t)nxt.pn * tstepB : cB;
        for (int t = 0; t < nt; t += 2) {
            const bool last = (t == nt - 2);
            const char* a1 = cA + (size_t)(t + 1) * kstep;
            const char* a2 = last ? nA : cA + (size_t)(t + 2) * kstep; const char* b2 = last ? nB : cB + (size_t)(t + 2) * kstep;
            const char* a3 = a2 + kstep; const char* b3 = b2 + kstep;
            PG8_LDB(B0, 0, 0); PG8_LDB(B1, 0, 1); PG8_SCHED; PG8_LDA(At, 0, 0); PG8_STAGE(PG8_SA(1, 1), a1 + hstepA, voffA);
            PG8_WAIT_V(8); PG8_WAIT_L(0); PG8_BAR; PG8_MMA(0, 0, At, B0); PG8_MMA(0, 1, At, B1); PG8_BAR; PG8_SCHED;
            PG8_LDA(At, 0, 1); PG8_STAGE(PG8_SB(0, 0), b2, voffB); PG8_STAGE(PG8_SB(0, 1), b2 + hstepB, voffB); PG8_STAGE(PG8_SA(0, 0), a2, voffA);
            PG8_WAIT_V(8); PG8_WAIT_L(0); PG8_BAR; PG8_MMA(1, 0, At, B0); PG8_MMA(1, 1, At, B1); PG8_BAR; PG8_SCHED;
            PG8_LDB(B0, 1, 0); PG8_LDB(B1, 1, 1); PG8_SCHED; PG8_LDA(At, 1, 0); PG8_STAGE(PG8_SA(0, 1), a2 + hstepA, voffA);
            PG8_WAIT_V(8); PG8_WAIT_L(0); PG8_BAR; PG8_MMA(0, 0, At, B0); PG8_MMA(0, 1, At, B1); PG8_BAR; PG8_SCHED;
            PG8_LDA(At, 1, 1); PG8_STAGE(PG8_SB(1, 0), b3, voffB); PG8_STAGE(PG8_SB(1, 1), b3 + hstepB, voffB); PG8_STAGE(PG8_SA(1, 0), a3, voffA);
            PG8_WAIT_V(8); PG8_WAIT_L(0); PG8_BAR; PG8_MMA(1, 0, At, B0); PG8_MMA(1, 1, At, B1); PG8_BAR; PG8_SCHED;
        }
        if (wr == 0) PG8_BAR;
        run_epi(E, lds, acc, cur, wr, wc, fr, fq);
        if (!has_next) break;
#pragma unroll
        for (int a = 0; a < 2; ++a)
#pragma unroll
            for (int b = 0; b < 2; ++b)
#pragma unroll
                for (int m = 0; m < 4; ++m)
#pragma unroll
                    for (int n = 0; n < 2; ++n) acc[a][b][m][n] = (f32x4){0.f, 0.f, 0.f, 0.f};
        cur = nxt; cA = nA; cB = nB; ++ui;
        if (wr == 1) PG8_BAR;
    }
    PG8_WAIT_V(0);
    PG8_BAR;
#undef PG8_SA
#undef PG8_SB
#undef PG8_STAGE
#undef PG8_LDA
#undef PG8_LDB
#undef PG8_MMA
#undef PG8_WAIT_V
#undef PG8_WAIT_L
#undef PG8_BAR
#undef PG8_SCHED
}

__device__ __forceinline__ float row_rstd(const float* ssq, int row) {
    const f32x4 s0 = *(const f32x4*)(ssq + (size_t)row * 4);
    const float ss = (s0[0] + s0[1]) + (s0[2] + s0[3]);
    return rsqrtf(ss * (1.0f / 1024.0f) + 1e-6f);
}
struct EpiZ {
    bf16_t* z; const float* ssq; bf16_t* vt; int vt_ld;
    __device__ __forceinline__ void operator()(const f32x4 (&acc)[2][2][4][2], const Unit& u, int wr, int wc, int fr, int fq) const {
        const int row0 = u.pm * BM + wr * 64 + fr, col0 = u.pn * BM + wc * 32 + 8 * fq;
#pragma unroll
        for (int ai = 0; ai < 2; ++ai)
#pragma unroll
            for (int m = 0; m < 4; ++m) {
                const int row = row0 + ai * HALF + m * 16; const float rs = row_rstd(ssq, row);
#pragma unroll
                for (int bj = 0; bj < 2; ++bj) {
                    const u32x4 w = pack8(acc[ai][bj][m][0] * rs, acc[ai][bj][m][1] * rs);
                    *(u32x4*)(z + (size_t)row * ZSTR + col0 + bj * HALF) = w;
                }
            }
    }
};
struct EpiGlu {
    bf16_t* z;
    __device__ __forceinline__ void operator()(const f32x4 (&acc)[2][2][4][2], const Unit& u, int wr, int wc, int fr, int fq) const {
        const int row0 = u.pm * BM + wr * 64 + fr, col0 = wc * 32 + 8 * fq;
#pragma unroll
        for (int ai = 0; ai < 2; ++ai) {
            u32x4 yv[4][2];
#pragma unroll
            for (int m = 0; m < 4; ++m)
#pragma unroll
                for (int bj = 0; bj < 2; ++bj) yv[m][bj] = *(const u32x4*)(z + (size_t)(row0 + ai * HALF + m * 16) * ZSTR + col0 + bj * HALF + 512);
#pragma unroll
            for (int m = 0; m < 4; ++m) {
                const int row = row0 + ai * HALF + m * 16;
#pragma unroll
                for (int bj = 0; bj < 2; ++bj) {
                    bf16_t* zp = z + (size_t)row * ZSTR + col0 + bj * HALF;
                    const u32x4 y = yv[m][bj];
                    const f32x4 a0 = acc[ai][bj][m][0], a1 = acc[ai][bj][m][1];
                    f32x4 o0, o1;
                    o0[0] = bflo(y.x) * sigm(a0[0]); o0[1] = bfhi(y.x) * sigm(a0[1]); o0[2] = bflo(y.y) * sigm(a0[2]); o0[3] = bfhi(y.y) * sigm(a0[3]);
                    o1[0] = bflo(y.z) * sigm(a1[0]); o1[1] = bfhi(y.z) * sigm(a1[1]); o1[2] = bflo(y.w) * sigm(a1[2]); o1[3] = bfhi(y.w) * sigm(a1[3]);
                    *(u32x4*)zp = pack8(o0, o1);
                }
            }
        }
    }
};
template <int MODE> struct EpiMix {
    bf16_t* z; int goff;
    __device__ __forceinline__ void operator()(const f32x4 (&acc)[2][2][4][2], const Unit& u, int wr, int wc, int fr, int fq) const {
        const int row0 = u.pm * BM + wr * 64 + fr, col0 = u.pn * BM + wc * 32 + 8 * fq;
#pragma unroll
        for (int ai = 0; ai < 2; ++ai)
#pragma unroll
            for (int mp = 0; mp < 2; ++mp) {
                u32x4 gv[2][2], pv[2][2];
#pragma unroll
                for (int mm = 0; mm < 2; ++mm)
#pragma unroll
                    for (int bj = 0; bj < 2; ++bj) { const bf16_t* zr = z + (size_t)(row0 + ai * HALF + (mp * 2 + mm) * 16) * ZSTR + col0 + bj * HALF;
                        gv[mm][bj] = *(const u32x4*)(zr + goff); if (MODE == 1) pv[mm][bj] = *(const u32x4*)(zr + 1024); }
#pragma unroll
                for (int mm = 0; mm < 2; ++mm) {
                    const int m = mp * 2 + mm; const int row = row0 + ai * HALF + m * 16;
#pragma unroll
                    for (int bj = 0; bj < 2; ++bj) {
                        bf16_t* zr = z + (size_t)row * ZSTR + col0 + bj * HALF;
                        const u32x4 gq = gv[mm][bj];
                        const f32x4 a0 = acc[ai][bj][m][0], a1 = acc[ai][bj][m][1];
                        f32x4 o0, o1;
                        o0[0] = sigm(bflo(gq.x)) * a0[0]; o0[1] = sigm(bfhi(gq.x)) * a0[1]; o0[2] = sigm(bflo(gq.y)) * a0[2]; o0[3] = sigm(bfhi(gq.y)) * a0[3];
                        o1[0] = sigm(bflo(gq.z)) * a1[0]; o1[1] = sigm(bfhi(gq.z)) * a1[1]; o1[2] = sigm(bflo(gq.w)) * a1[2]; o1[3] = sigm(bfhi(gq.w)) * a1[3];
                        if (MODE == 1) { const u32x4 p = pv[mm][bj];
                            o0[0] += bflo(p.x); o0[1] += bfhi(p.x); o0[2] += bflo(p.y); o0[3] += bfhi(p.y); o1[0] += bflo(p.z); o1[1] += bfhi(p.z); o1[2] += bflo(p.w); o1[3] += bfhi(p.w); }
                        *(u32x4*)(zr + 1024) = pack8(o0, o1);
                    }
                }
            }
    }
};
struct EpiRes {
    float* h; bf16_t* hb; float* ssq; LAS float* red;
    __device__ __forceinline__ void operator()(const f32x4 (&acc)[2][2][4][2], const Unit& u, int wr, int wc, int fr, int fq) const {
        const int row0 = u.pm * BM + wr * 64 + fr, col0 = u.pn * BM + wc * 32 + 8 * fq;
#pragma unroll
        for (int ai = 0; ai < 2; ++ai)
#pragma unroll
            for (int mp = 0; mp < 2; ++mp) {
                f32x4 hv[2][2][2];
#pragma unroll
                for (int mm = 0; mm < 2; ++mm)
#pragma unroll
                    for (int bj = 0; bj < 2; ++bj) { const float* hp = h + (size_t)(row0 + ai * HALF + (mp * 2 + mm) * 16) * 1024 + col0 + bj * HALF; hv[mm][bj][0] = *(const f32x4*)hp; hv[mm][bj][1] = *(const f32x4*)(hp + 4); }
#pragma unroll
                for (int mm = 0; mm < 2; ++mm) {
                    const int m = mp * 2 + mm; const int row = row0 + ai * HALF + m * 16; float part = 0.f;
#pragma unroll
                    for (int bj = 0; bj < 2; ++bj) {
                        float* hp = h + (size_t)row * 1024 + col0 + bj * HALF;
                        const f32x4 h0 = hv[mm][bj][0] + acc[ai][bj][m][0], h1 = hv[mm][bj][1] + acc[ai][bj][m][1];
                        *(f32x4*)hp = h0; *(f32x4*)(hp + 4) = h1;
                        part += (h0[0] * h0[0] + h0[1] * h0[1]) + (h0[2] * h0[2] + h0[3] * h0[3]) + (h1[0] * h1[0] + h1[1] * h1[1]) + (h1[2] * h1[2] + h1[3] * h1[3]);
                        *(u32x4*)(hb + (size_t)row * 1024 + col0 + bj * HALF) = pack8(h0, h1);
                    }
                    part += __shfl_xor(part, 16); part += __shfl_xor(part, 32);
                    if (fq == 0) red[(ai * HALF + wr * 64 + m * 16 + fr) * 4 + wc] = part;
                }
            }
        asm volatile("s_waitcnt lgkmcnt(0)" ::: "memory");
        __builtin_amdgcn_s_barrier();
        asm volatile("" ::: "memory");
        { const int t_ = opaque_tid(); if (t_ < 256) { const f32x4 r4 = *(const LAS f32x4*)(red + t_ * 4); ssq[(size_t)(u.pm * BM + t_) * 4 + u.pn] = (r4[0] + r4[1]) + (r4[2] + r4[3]); } }
    }
};
struct EpiAct {
    bf16_t* act; const float* ssq;
    __device__ __forceinline__ void operator()(const f32x4 (&acc)[2][2][4][2], const Unit& u, int wr, int wc, int fr, int fq) const {
        const int row0 = u.pm * BM + wr * 64 + fr, col0 = u.pn * HALF + wc * 32 + 8 * fq;
#pragma unroll
        for (int ai = 0; ai < 2; ++ai)
#pragma unroll
            for (int m = 0; m < 4; ++m) {
                const int row = row0 + ai * HALF + m * 16; const float rs = row_rstd(ssq, row);
                f32x4 o[2];
#pragma unroll
                for (int n = 0; n < 2; ++n)
#pragma unroll
                    for (int i = 0; i < 4; ++i) { const float gg = acc[ai][0][m][n][i] * rs, uu = acc[ai][1][m][n][i] * rs; o[n][i] = gg * sigm(gg) * uu; }
                *(u32x4*)(act + (size_t)row * 2816 + col0) = pack8(o[0], o[1]);
            }
    }
};
struct UberEpi { int mode, i0; unsigned char *p0, *p1, *p2; };
__device__ __forceinline__ void run_epi(const UberEpi& E, LAS unsigned char* lds, const f32x4 (&acc)[2][2][4][2], const Unit& u, int wr, int wc, int fr, int fq) {
    switch (E.mode) {
        case 0: { EpiZ e{(bf16_t*)E.p0, (const float*)E.p1, (bf16_t*)E.p2, E.i0}; e(acc, u, wr, wc, fr, fq); break; }
        case 1: { EpiGlu e{(bf16_t*)E.p0}; e(acc, u, wr, wc, fr, fq); break; }
        case 2: { EpiMix<0> e{(bf16_t*)E.p0, E.i0}; e(acc, u, wr, wc, fr, fq); break; }
        case 3: { EpiMix<1> e{(bf16_t*)E.p0, E.i0}; e(acc, u, wr, wc, fr, fq); break; }
        case 4: { EpiRes e{(float*)E.p0, (bf16_t*)E.p1, (float*)E.p2, (LAS float*)(lds + 131072)}; e(acc, u, wr, wc, fr, fq); break; }
        default: { EpiAct e{(bf16_t*)E.p0, (const float*)E.p1}; e(acc, u, wr, wc, fr, fq); break; }
    }
}
}

constexpr int NLAYER = 4, DM = 1024, ZN = 6144, ZW = 6208  , FFH = 2816, RG = 16384, RMAIN = 65536, VTLD = RG + 64  ;
constexpr size_t al256(size_t x) { return (x + 255) & ~(size_t)255; }
constexpr size_t WS_HB = 0;
constexpr size_t WS_SSQ = WS_HB + (size_t)RMAIN * DM * 2;
constexpr size_t WS_Z = WS_SSQ + (size_t)RMAIN * 4 * 4;
constexpr size_t WS_YB = WS_Z + (size_t)RG * ZW * 2;
constexpr size_t WS_VT = WS_YB + (size_t)RG * 512 * 2;
constexpr size_t WS_HGU = WS_VT + (size_t)512 * VTLD * 2;
constexpr size_t WS_HGP = WS_HGU + (size_t)260 * 8 * 4096 * 4;
constexpr size_t WS_S5S = WS_HGP + (size_t)260 * 8 * 64 * 4;
constexpr size_t WS_W = WS_S5S + (size_t)260 * 2048 * 8;
constexpr size_t W_IN = 0, W_UPA = W_IN + (size_t)6144 * 1024 * 2, W_UPB = W_UPA + (size_t)1024 * 256 * 2, W_UPC = W_UPB + (size_t)1024 * 512 * 2,
                 W_O = W_UPC + (size_t)1024 * 256 * 2, W_GU = W_O + (size_t)1024 * 1024 * 2, W_DN = W_GU + (size_t)5632 * 1024 * 2, W_GLU = W_DN + (size_t)1024 * 2816 * 2,
                 W_END = W_GLU + (size_t)256 * 256 * 2;
constexpr size_t WS_TAB = WS_W + W_END;
constexpr size_t T_LBAR = 0, T_L16 = T_LBAR + 2048 * 8, T_L64 = T_L16 + 2048 * 8, T_BFRAG = T_L64 + 2048 * 8, T_CFRAG = T_BFRAG + (size_t)32 * 8 * 64 * 16,
                 T_LB = T_CFRAG + (size_t)32 * 4 * 64 * 16, T_END = T_LB + 256 * 4;
constexpr size_t WS_META = al256(WS_TAB + T_END);
constexpr size_t M_H = 0, M_HB = M_H + (size_t)256 * 1024 * 4, M_SSQ = M_HB + (size_t)256 * 1024 * 2, M_Z = M_SSQ + (size_t)256 * 4 * 4, M_YB = M_Z + (size_t)256 * ZW * 2,
                 M_VT = M_YB + (size_t)256 * 512 * 2, M_ACT = M_VT + (size_t)512 * 256 * 2, M_END = M_ACT + (size_t)256 * FFH * 2;
constexpr size_t WS_CTL = al256(WS_META + M_END);
constexpr size_t CTL_BYTES = 16384;
constexpr size_t WS_TOTAL = WS_CTL + CTL_BYTES;
constexpr int LDS_ST_OFF = 135168;
constexpr int LDS_BYTES = 147456;

struct Args {
    const float *x_prompt, *x_sample, *meta_tokens, *norm1_g, *w_in, *a_re, *a_im, *log_dt, *b_re, *b_im, *c_re, *c_im, *s5_d, *w_glu, *rpb, *lb_logits, *onorm_g,
        *w_up_a, *w_up_b, *w_up_c, *w_o, *norm2_g, *w_gate, *w_up, *w_down, *final_g;
    float* out; unsigned char* ws;
};

__device__ __forceinline__ unsigned long long ufl(unsigned long long v) { const unsigned lo = __builtin_amdgcn_readfirstlane((unsigned)v), hi = __builtin_amdgcn_readfirstlane((unsigned)(v >> 32)); return ((unsigned long long)hi << 32) | lo; }
#define GAS __attribute__((address_space(1)))
template <int OFF> __device__ __forceinline__ unsigned long long ka_load() {
    unsigned long long v; const unsigned long long kp = ufl((unsigned long long)__builtin_amdgcn_kernarg_segment_ptr());
    asm volatile("s_load_dwordx2 %0, %1, %2\n\ts_waitcnt lgkmcnt(0)" : "=s"(v) : "s"(kp), "n"(OFF));
    return v;
}
#define KA(f) ((decltype(Args::f))(GAS char*)ka_load<(int)__builtin_offsetof(Args, f)>())
#define KAF(f) ((const float*)KA(f))
struct Ctx {
    bf16_t *hb, *z, *yb, *vt; float *ssq, *hgu, *hgp, *s5s;
    bf16_t *w; const float *lbar, *l16, *l64; const bf16_t *bfrag, *cfrag; const float* lb;
    float* mh; bf16_t *mhb, *mz, *myb, *mvt, *mact; float* mssq;
};

__device__ __forceinline__ void tr_item(const float* W, int K, int N, bf16_t* WT, const float* kscale, int mode, LAS float* scr, int item, int lane, bool valid) {
    const int nblk = N / 32, kb = item / nblk, nb = item % nblk, k0 = 64 * kb, n0 = 32 * nb;
    if (valid) {
#pragma unroll 8
    for (int i = 0; i < 32; ++i) { const int kk = 2 * i + (lane >> 5); float v = W[(size_t)(k0 + kk) * N + n0 + (lane & 31)]; if (kscale) v *= kscale[k0 + kk]; scr[kk * 33 + (lane & 31)] = v; }
    }
    __syncthreads();
    const int c = lane & 7;
    int drow0 = n0; if (mode) drow0 = (n0 >> 7) * 256 + (n0 & 127) + (mode == 2 ? 128 : 0);
    if (valid) {
#pragma unroll
    for (int j = 0; j < 4; ++j) { const int n = (lane >> 3) + 8 * j; const LAS float* s = scr + (8 * c) * 33 + n;
        u32x4 o; o.x = pk2(s[0 * 33], s[1 * 33]); o.y = pk2(s[2 * 33], s[3 * 33]); o.z = pk2(s[4 * 33], s[5 * 33]); o.w = pk2(s[6 * 33], s[7 * 33]);
        *(u32x4*)(WT + (size_t)(drow0 + n) * K + k0 + 8 * c) = o; }
    }
    __syncthreads();
}

__device__ __forceinline__ void prep_layer(const Ctx& X, int l, LAS unsigned char* lds, int G) {
    const int tid_ = opaque_tid(); const int wave = __builtin_amdgcn_readfirstlane(tid_ >> 6), lane = tid_ & 63;
    LAS float* scr = (LAS float*)(lds + wave * 16384);
    const int gw = blockIdx.x * 8 + wave, NGW = G * 8;
    constexpr int I0 = 16 * 192, I1 = 4 * 32, I2 = 8 * 32, I3 = 4 * 32, I4 = 16 * 32, I5 = 16 * 88, I6 = 16 * 88, I7 = 44 * 32, I8 = 4 * 8;
    constexpr int NIT = I0 + I1 + I2 + I3 + I4 + I5 + I6 + I7 + I8;
    unsigned char* wb = (unsigned char*)X.w;
    for (int it0 = 0; it0 < NIT; it0 += NGW) {
        const int it = it0 + gw; const bool valid = it < NIT;
        int r = valid ? it : 0;
        if (r < I0) { tr_item(KAF(w_in) + (size_t)l * 1024 * 6144, 1024, 6144, (bf16_t*)(wb + W_IN), KAF(norm1_g) + l * 1024, 0, scr, r, lane, valid); continue; } r -= I0;
        if (r < I1) { tr_item(KAF(w_up_a) + (size_t)l * 256 * 1024, 256, 1024, (bf16_t*)(wb + W_UPA), nullptr, 0, scr, r, lane, valid); continue; } r -= I1;
        if (r < I2) { tr_item(KAF(w_up_b) + (size_t)l * 512 * 1024, 512, 1024, (bf16_t*)(wb + W_UPB), nullptr, 0, scr, r, lane, valid); continue; } r -= I2;
        if (r < I3) { tr_item(KAF(w_up_c) + (size_t)l * 256 * 1024, 256, 1024, (bf16_t*)(wb + W_UPC), nullptr, 0, scr, r, lane, valid); continue; } r -= I3;
        if (r < I4) { tr_item(KAF(w_o) + (size_t)l * 1024 * 1024, 1024, 1024, (bf16_t*)(wb + W_O), nullptr, 0, scr, r, lane, valid); continue; } r -= I4;
        if (r < I5) { tr_item(KAF(w_gate) + (size_t)l * 1024 * 2816, 1024, 2816, (bf16_t*)(wb + W_GU), KAF(norm2_g) + l * 1024, 1, scr, r, lane, valid); continue; } r -= I5;
        if (r < I6) { tr_item(KAF(w_up) + (size_t)l * 1024 * 2816, 1024, 2816, (bf16_t*)(wb + W_GU), KAF(norm2_g) + l * 1024, 2, scr, r, lane, valid); continue; } r -= I6;
        if (r < I7) { tr_item(KAF(w_down) + (size_t)l * 2816 * 1024, 2816, 1024, (bf16_t*)(wb + W_DN), nullptr, 0, scr, r, lane, valid); continue; } r -= I7;
        tr_item(KAF(w_glu) + (size_t)l * 256 * 256, 256, 256, (bf16_t*)(wb + W_GLU), nullptr, 0, scr, r, lane, valid);
    }
    const int gt = blockIdx.x * 512 + tid_;
    if (gt < 2048) {
        const int dg = gt >> 6, p = gt & 63;
        const size_t pb = ((size_t)l * 32 + dg);
        const float are = KAF(a_re)[pb * 64 + p], aim = KAF(a_im)[pb * 64 + p], dt = expf(KAF(log_dt)[pb]);
        const float mag = expf(are * dt); float sn, cs; sincosf(aim * dt, &sn, &cs);
        const float lr = mag * cs, li = mag * sn;
        const float den = are * are + aim * aim, nr = lr - 1.0f, ni = li;
        const float zr = (nr * are + ni * aim) / den, zi = (ni * are - nr * aim) / den;
        float* lbar = (float*)X.lbar; float* l16 = (float*)X.l16; float* l64 = (float*)X.l64;
        lbar[gt * 2] = lr; lbar[gt * 2 + 1] = li;
        float pr = lr, pi = li;
#pragma unroll
        for (int s = 0; s < 4; ++s) { const float t = pr * pr - pi * pi; pi = 2.f * pr * pi; pr = t; }
        l16[gt * 2] = pr; l16[gt * 2 + 1] = pi;
#pragma unroll
        for (int s = 0; s < 2; ++s) { const float t = pr * pr - pi * pi; pi = 2.f * pr * pi; pr = t; }
        l64[gt * 2] = pr; l64[gt * 2 + 1] = pi;
        bf16_t* bfr = (bf16_t*)X.bfrag; bf16_t* cfr = (bf16_t*)X.cfrag;
        const int ntr = p >> 4, col = p & 15;
        for (int c = 0; c < 16; ++c) {
            const float br = KAF(b_re)[(pb * 64 + p) * 16 + c], bi = KAF(b_im)[(pb * 64 + p) * 16 + c];
            const float bbr = zr * br - zi * bi, bbi = zr * bi + zi * br;
            const int q = c >> 3, j = c & 7;
            bfr[(((size_t)dg * 8 + ntr) * 64 + col + 16 * q) * 8 + j] = (bf16_t)f2bf(bbr);
            bfr[(((size_t)dg * 8 + 4 + ntr) * 64 + col + 16 * q) * 8 + j] = (bf16_t)f2bf(bbi);
            bfr[(((size_t)dg * 8 + ntr) * 64 + col + 16 * (q + 2)) * 8 + j] = 0;
            bfr[(((size_t)dg * 8 + 4 + ntr) * 64 + col + 16 * (q + 2)) * 8 + j] = 0;
            const float cr = KAF(c_re)[(pb * 16 + c) * 64 + p], ci = KAF(c_im)[(pb * 16 + c) * 64 + p];
            { const int k = p;      cfr[(((size_t)dg * 4 + (k >> 5)) * 64 + c + 16 * ((k >> 3) & 3)) * 8 + (k & 7)] = (bf16_t)f2bf(cr); }
            { const int k = 64 + p; cfr[(((size_t)dg * 4 + (k >> 5)) * 64 + c + 16 * ((k >> 3) & 3)) * 8 + (k & 7)] = (bf16_t)f2bf(-ci); }
        }
    }
    if (gt >= 2048 && gt < 2048 + 256) {
        const int c = gt - 2048;
        const float l0 = KAF(lb_logits)[c], l1 = KAF(lb_logits)[256 + c], l2 = KAF(lb_logits)[512 + c], l3 = KAF(lb_logits)[768 + c];
        const float mx = fmaxf(fmaxf(l0, l1), fmaxf(l2, l3));
        const float e0 = expf(l0 - mx), e1 = expf(l1 - mx), e2 = expf(l2 - mx), e3 = expf(l3 - mx), inv = 1.f / (e0 + e1 + e2 + e3);
        float v = 0.f; if (l >= 1) v += e1 * inv; if (l >= 2) v += e2 * inv; if (l >= 3) v += e3 * inv;
        ((float*)X.lb)[c] = v;
    }
}

struct Grp { int g, nseq, Lr, nch, s0; };
__device__ __forceinline__ Grp make_grp(int g) { Grp r; r.g = g; r.nseq = g < 2 ? 4 : 1; r.Lr = g < 2 ? 4096 : 16384; r.nch = r.Lr / 64 + 1; r.s0 = g < 2 ? g * 4 : 8 + (g - 2); return r; }

template <bool OUT>
__device__ __forceinline__ void s5_chunk(const Ctx& X, const float* s5d, LAS float* buf, bf16_t* zc, int T, int ci, int wave, int lane) {
    const int p = lane, fr = lane & 15, fq = lane >> 4;
    for (int gi = 0; gi < 2; ++gi) {
        const int g = wave * 2 + gi;
        f32x4 yacc[2][2];
#pragma unroll
        for (int i = 0; i < 2; ++i)
#pragma unroll
            for (int j = 0; j < 2; ++j) yacc[i][j] = (f32x4){0.f, 0.f, 0.f, 0.f};
        bf16x8 ua[4];
#pragma unroll
        for (int m4 = 0; m4 < 4; ++m4) { ua[m4] = (bf16x8){0, 0, 0, 0, 0, 0, 0, 0}; if (fq < 2 && m4 * 16 < T) ua[m4] = *(const bf16x8*)(zc + (size_t)(m4 * 16 + fr) * ZW + g * 16 + fq * 8); }
#pragma unroll
        for (int dir = 0; dir < 2; ++dir) {
            const int dg = dir * 16 + g;
            bf16x8 bfr[8], cfr[4];
#pragma unroll
            for (int nt = 0; nt < 8; ++nt) bfr[nt] = *(const bf16x8*)(X.bfrag + (((size_t)dg * 8 + nt) * 64 + lane) * 8);
            if (OUT) {
#pragma unroll
                for (int ks = 0; ks < 4; ++ks) cfr[ks] = *(const bf16x8*)(X.cfrag + (((size_t)dg * 4 + ks) * 64 + lane) * 8);
            }
            const float lr = X.lbar[(dg * 64 + p) * 2], li = X.lbar[(dg * 64 + p) * 2 + 1];
            float xr = 0.f, xi = 0.f;
            float* st = X.s5s + ((size_t)ci * 2048 + dg * 64 + p) * 2;
            if (OUT) { xr = st[0]; xi = st[1]; }
#pragma unroll
            for (int sti = 0; sti < 2; ++sti) {
                const int stt = dir ? 1 - sti : sti; const int t0 = stt * 32;
                if (t0 < T) {
                    const int tn = (T - t0) < 32 ? (T - t0) : 32;
#pragma unroll
                    for (int mt = 0; mt < 2; ++mt) {
                        if (mt * 16 < tn) {
#pragma unroll
                            for (int nt = 0; nt < 8; ++nt) {
                                const f32x4 c = __builtin_amdgcn_mfma_f32_16x16x32_bf16(ua[stt * 2 + mt], bfr[nt], (f32x4){0.f, 0.f, 0.f, 0.f}, 0, 0, 0);
#pragma unroll
                                for (int r = 0; r < 4; ++r) buf[(mt * 16 + fq * 4 + r) * 132 + nt * 16 + fr] = c[r];
                            }
                        }
                    }
                    __syncthreads();
                    for (int k0 = 0; k0 < tn; k0 += 8) {
                        float br[8], bi[8];
#pragma unroll
                        for (int j = 0; j < 8; ++j) { const int t = dir ? (tn - 1 - k0 - j) : k0 + j; br[j] = buf[t * 132 + p]; bi[j] = buf[t * 132 + 64 + p]; }
#pragma unroll
                        for (int j = 0; j < 8; ++j) {
                            const int t = dir ? (tn - 1 - k0 - j) : k0 + j;
                            const float nr = lr * xr - li * xi + br[j], ni = lr * xi + li * xr + bi[j];
                            xr = nr; xi = ni;
                            if (OUT) { buf[t * 132 + p] = xr; buf[t * 132 + 64 + p] = xi; }
                        }
                    }
                    if (OUT) {
                        __syncthreads();
#pragma unroll
                        for (int mt = 0; mt < 2; ++mt) {
                            if (mt * 16 < tn) {
#pragma unroll
                                for (int ks = 0; ks < 4; ++ks) {
                                    const LAS float* ap = buf + (mt * 16 + fr) * 132 + ks * 32 + fq * 8;
                                    const f32x4 a0 = *(const LAS f32x4*)ap, a1 = *(const LAS f32x4*)(ap + 4);
                                    const u32x4 aw = pack8(a0, a1);
                                    const bf16x8 av = __builtin_bit_cast(bf16x8, aw);
                                    yacc[stt][mt] = __builtin_amdgcn_mfma_f32_16x16x32_bf16(av, cfr[ks], yacc[stt][mt], 0, 0, 0);
                                }
                            }
                        }
                    }
                    __syncthreads();
                }
            }
            if (!OUT) { st[0] = xr; st[1] = xi; }
        }
        if (OUT) {
            const float dsk = s5d[g * 16 + fr];
            float uv[16];
#pragma unroll
            for (int q4 = 0; q4 < 4; ++q4)
#pragma unroll
                for (int r = 0; r < 4; ++r) { uv[q4 * 4 + r] = 0.f; if (q4 * 16 < T) uv[q4 * 4 + r] = bf2f(zc[(size_t)(q4 * 16 + fq * 4 + r) * ZW + g * 16 + fr]); }
#pragma unroll
            for (int stt = 0; stt < 2; ++stt)
#pragma unroll
                for (int mt = 0; mt < 2; ++mt) {
                    if (stt * 32 + mt * 16 < T) {
#pragma unroll
                        for (int r = 0; r < 4; ++r) {
                            const int t = stt * 32 + mt * 16 + fq * 4 + r;
                            const float y = gelu_tanh(yacc[stt][mt][r] + dsk * uv[(stt * 2 + mt) * 4 + r]);
                            zc[(size_t)t * ZW + 512 + g * 16 + fr] = (bf16_t)f2bf(y);
                        }
                    }
                }
        }
    }
}

__device__ __forceinline__ void s5_passB(const Ctx& X, const Grp& gp, int gtid, int GT) {
    const int n = gp.nseq * 2048;
    for (int e = gtid; e < n; e += GT) {
        const int sl = e >> 11, r = e & 2047, dir = r >> 10;
        const float l16r = X.l16[r * 2], l16i = X.l16[r * 2 + 1], l64r = X.l64[r * 2], l64i = X.l64[r * 2 + 1];
        float* base = X.s5s + ((size_t)(sl * gp.nch) * 2048 + r) * 2; const long cstep = dir ? -4096 : 4096; float* first = dir ? base + (size_t)(gp.nch - 1) * 4096 : base;
        float sr = 0.f, si = 0.f;
        float er[2][8], ei[2][8];
#pragma unroll
        for (int j = 0; j < 8; ++j) { er[0][j] = 0.f; ei[0][j] = 0.f; if (j < gp.nch) { const float* pp = first + (long)j * cstep; er[0][j] = pp[0]; ei[0][j] = pp[1]; } }
        for (int k0 = 0; k0 < gp.nch; k0 += 16) {
#pragma unroll
            for (int hb = 0; hb < 2; ++hb) {
                const int kb = k0 + hb * 8;
                if (kb < gp.nch) {
#pragma unroll
                    for (int j = 0; j < 8; ++j) { const int k = kb + 8 + j; er[1 - hb][j] = 0.f; ei[1 - hb][j] = 0.f; if (k < gp.nch) { const float* pp = first + (long)k * cstep; er[1 - hb][j] = pp[0]; ei[1 - hb][j] = pp[1]; } }
#pragma unroll
                    for (int j = 0; j < 8; ++j) { const int k = kb + j; if (k < gp.nch) { float* pp = first + (long)k * cstep; pp[0] = sr; pp[1] = si;
                            const int c = dir ? gp.nch - 1 - k : k;
                            const float pr = c == 0 ? l16r : l64r, pi = c == 0 ? l16i : l64i;
                            const float nr = pr * sr - pi * si + er[hb][j], ni = pr * si + pi * sr + ei[hb][j]; sr = nr; si = ni; } }
                }
            }
        }
    }
}

typedef short v4i16_t __attribute__((ext_vector_type(4)));
__device__ __forceinline__ v4i16_t vtr16(const LAS unsigned char* p) { return __builtin_amdgcn_ds_read_tr16_b64_v4i16((LAS v4i16_t*)p); }
template <bool OUT>
__device__ __forceinline__ void hg_chunk(const Ctx& X, LAS float* gt, LAS bf16_t* ot, const bf16_t* zc, int T, int ci, int wave, int lane) {
    const int h = wave >> 1, dir = wave & 1;
    float S[64];
    float* U = X.hgu + ((size_t)ci * 8 + wave) * 4096;
    if (OUT) {
#pragma unroll
        for (int d = 0; d < 64; ++d) S[d] = U[d * 64 + lane];
    } else {
#pragma unroll
        for (int d = 0; d < 64; ++d) S[d] = 0.f;
    }
    const float lbv = X.lb[h * 64 + lane], oml = 1.f - lbv; float P = 1.f;
    const int fcol = (dir ? 2304 : 2048) + h * 64 + lane, qcol = 1792 + h * 64 + lane, vcol = 2560 + h * 64 + lane;
    const int ns8 = T >> 3;
    bf16_t rq[8], rf[8], rv[8];
    {
        const int sb0 = dir ? (ns8 - 1) : 0;
#pragma unroll
        for (int j = 0; j < 8; ++j) { const bf16_t* zr = zc + (size_t)(sb0 * 8 + j) * ZW; rq[j] = zr[qcol]; rf[j] = zr[fcol]; rv[j] = zr[vcol]; }
    }
#pragma unroll 1
    for (int s8 = 0; s8 < ns8; ++s8) {
        const int sb = dir ? (ns8 - 1 - s8) : s8;
#pragma unroll
        for (int j = 0; j < 8; ++j) {
            const float q = bf2f(rq[j]), ff = bf2f(rf[j]);
            const float sg = sigm(ff), fg = lbv + oml * sg, kk = oml * (1.f - sg);
            gt[j * 256 + lane] = fg; gt[j * 256 + 64 + lane] = kk; gt[j * 256 + 128 + lane] = q * sigm(q); gt[j * 256 + 192 + lane] = bf2f(rv[j]);
            P *= fg;
        }
        __syncthreads();
        if (s8 + 1 < ns8) {
            const int sbn = dir ? (ns8 - 2 - s8) : s8 + 1;
#pragma unroll
            for (int j = 0; j < 8; ++j) { const bf16_t* zr = zc + (size_t)(sbn * 8 + j) * ZW; rq[j] = zr[qcol]; rf[j] = zr[fcol]; rv[j] = zr[vcol]; }
        }
#pragma unroll 1
        for (int jj = 0; jj < 8; ++jj) {
            const int j = dir ? 7 - jj : jj;
            const LAS float* gj = gt + j * 256;
            const float v = gj[192 + lane];
            float o = 0.f;
#pragma unroll
            for (int d4 = 0; d4 < 16; ++d4) {
                const f32x4 f4 = *(const LAS f32x4*)(gj + d4 * 4), k4 = *(const LAS f32x4*)(gj + 64 + d4 * 4);
#pragma unroll
                for (int i = 0; i < 4; ++i) S[d4 * 4 + i] = f4[i] * S[d4 * 4 + i] + k4[i] * v;
                if (OUT) { const f32x4 q4 = *(const LAS f32x4*)(gj + 128 + d4 * 4);
#pragma unroll
                    for (int i = 0; i < 4; ++i) o += S[d4 * 4 + i] * q4[i]; }
                if ((d4 & 3) == 3) __builtin_amdgcn_sched_barrier(0);
            }
            if (OUT) ot[(sb * 8 + j) * 64 + lane] = (bf16_t)f2bf(o);
        }
        __syncthreads();
    }
    if (!OUT) {
#pragma unroll
        for (int d = 0; d < 64; ++d) U[d * 64 + lane] = S[d];
        X.hgp[((size_t)ci * 8 + wave) * 64 + lane] = P;
    }
}

__device__ __forceinline__ void hg_passA_mfma(const Ctx& X, LAS unsigned char* wl, const bf16_t* zc, int T, int ci, int wave, int lane) {
    const int h = wave >> 1, dir = wave & 1, fq = lane >> 4, l16 = lane & 15, r8 = lane >> 3, pc = lane & 7;
    LAS unsigned char* kl = wl; LAS unsigned char* vl = wl + 4608;
    const float lbv = X.lb[h * 64 + lane], oml = 1.f - lbv;
    const int fcol = (dir ? 2304 : 2048) + h * 64 + lane, vcolb = 2560 + h * 64 + pc * 8;
    f32x4 acc[4][4];
#pragma unroll
    for (int a = 0; a < 4; ++a)
#pragma unroll
        for (int b = 0; b < 4; ++b) acc[a][b] = (f32x4){0.f, 0.f, 0.f, 0.f};
    float run = 1.f;
    const int nh = (T + 31) >> 5;
#pragma unroll 1
    for (int hh = 0; hh < nh; ++hh) {
        const int hb = dir ? hh : (nh - 1 - hh); const int t0 = hb * 32; const int tn = (T - t0) < 32 ? (T - t0) : 32;
        u32x4 vr[4];
#pragma unroll
        for (int i = 0; i < 4; ++i) { const int rr = i * 8 + r8; vr[i] = (u32x4){0u, 0u, 0u, 0u}; if (rr < tn) vr[i] = *(const u32x4*)(zc + (size_t)(t0 + rr) * ZW + vcolb); }
        __syncthreads();
#pragma unroll 1
        for (int bt = 0; bt < 2; ++bt) {
            const int j0 = (dir ? bt : 1 - bt) * 16;
            bf16_t rf[16];
#pragma unroll
            for (int j = 0; j < 16; ++j) { rf[j] = 0; if (j0 + j < tn) rf[j] = zc[(size_t)(t0 + j0 + j) * ZW + fcol]; }
#pragma unroll
            for (int jj = 0; jj < 16; ++jj) {
                const int jl = dir ? jj : 15 - jj; const int j = j0 + jl;
                float kh = 0.f;
                if (j < tn) { const float sg = sigm(bf2f(dir ? rf[jj] : rf[15 - jj])); kh = oml * (1.f - sg) * run; run *= lbv + oml * sg; }
                *(LAS bf16_t*)(kl + j * 144 + lane * 2) = (bf16_t)f2bf(kh);
            }
        }
#pragma unroll
        for (int i = 0; i < 4; ++i) *(LAS u32x4*)(vl + (i * 8 + r8) * 144 + pc * 16) = vr[i];
        __syncthreads();
        const int roff = (4 * fq + (l16 >> 2)) * 144 + (4 * (l16 & 3)) * 2;
        bf16x8 af[4];
#pragma unroll
        for (int mt = 0; mt < 4; ++mt) { const v4i16_t ta = vtr16(kl + roff + mt * 32), tb = vtr16(kl + roff + 16 * 144 + mt * 32); af[mt] = (bf16x8){ta[0], ta[1], ta[2], ta[3], tb[0], tb[1], tb[2], tb[3]}; }
#pragma unroll
        for (int nt = 0; nt < 4; ++nt) {
            const v4i16_t ta = vtr16(vl + roff + nt * 32), tb = vtr16(vl + roff + 16 * 144 + nt * 32);
            const bf16x8 bfv = (bf16x8){ta[0], ta[1], ta[2], ta[3], tb[0], tb[1], tb[2], tb[3]};
#pragma unroll
            for (int mt = 0; mt < 4; ++mt) acc[mt][nt] = __builtin_amdgcn_mfma_f32_16x16x32_bf16(af[mt], bfv, acc[mt][nt], 0, 0, 0);
        }
    }
    float* U = X.hgu + ((size_t)ci * 8 + wave) * 4096 + (4 * fq) * 64 + l16;
#pragma unroll
    for (int mt = 0; mt < 4; ++mt) {
#pragma unroll
        for (int r = 0; r < 4; ++r)
#pragma unroll
            for (int nt = 0; nt < 4; ++nt) U[(16 * mt + r) * 64 + 16 * nt] = acc[mt][nt][r];
        __builtin_amdgcn_sched_barrier(0);
    }
    X.hgp[((size_t)ci * 8 + wave) * 64 + lane] = run;
}

__device__ __forceinline__ void hg_passC_mfma(const Ctx& X, LAS unsigned char* wl, LAS bf16_t* ot, const bf16_t* zc, int T, int ci, int wave, int lane) {
    const int h = wave >> 1, dir = wave & 1, fq = lane >> 4, l16 = lane & 15, r8 = lane >> 3, pc = lane & 7;
    LAS unsigned char* ql = wl; LAS unsigned char* kl = wl + 2304; LAS unsigned char* vl = wl + 4608; LAS float* pl = (LAS float*)(wl + 6912);
    const float lbv = X.lb[h * 64 + lane], oml = 1.f - lbv;
    const int fcol = (dir ? 2304 : 2048) + h * 64 + lane, qcol = 1792 + h * 64 + lane, vcolb = 2560 + h * 64 + pc * 8;
    f32x4 sa[4][4];
    {
        const float* U = X.hgu + ((size_t)ci * 8 + wave) * 4096 + (4 * fq) * 64 + l16;
#pragma unroll
        for (int mt = 0; mt < 4; ++mt) {
#pragma unroll
            for (int r = 0; r < 4; ++r)
#pragma unroll
                for (int nt = 0; nt < 4; ++nt) sa[mt][nt][r] = U[(16 * mt + r) * 64 + 16 * nt];
            __builtin_amdgcn_sched_barrier(0);
        }
    }
    const int nsc = T >> 4;
    bf16_t rq[16], rf[16]; u32x4 vr[2];
    {
        const int I0 = dir ? (nsc - 1) : 0;
#pragma unroll
        for (int i = 0; i < 16; ++i) { const int tok = 16 * I0 + (dir ? 15 - i : i); rq[i] = zc[(size_t)tok * ZW + qcol]; rf[i] = zc[(size_t)tok * ZW + fcol]; }
#pragma unroll
        for (int i8 = 0; i8 < 2; ++i8) { const int i = i8 * 8 + r8; const int tok = 16 * I0 + (dir ? 15 - i : i); vr[i8] = *(const u32x4*)(zc + (size_t)tok * ZW + vcolb); }
    }
#pragma unroll 1
    for (int sc = 0; sc < nsc; ++sc) {
        const int I = dir ? (nsc - 1 - sc) : sc;
        __syncthreads();
        float c = 1.f;
#pragma unroll
        for (int i = 0; i < 16; ++i) {
            const float q = bf2f(rq[i]), sg = sigm(bf2f(rf[i]));
            c *= lbv + oml * sg;
            *(LAS bf16_t*)(ql + i * 144 + lane * 2) = (bf16_t)f2bf(q * sigm(q) * c);
            *(LAS bf16_t*)(kl + i * 144 + lane * 2) = (bf16_t)f2bf(oml * (1.f - sg) / c);
        }
        pl[lane] = c;
#pragma unroll
        for (int i8 = 0; i8 < 2; ++i8) *(LAS u32x4*)(vl + (i8 * 8 + r8) * 144 + pc * 16) = vr[i8];
        __syncthreads();
        if (sc + 1 < nsc) {
            const int In = dir ? (nsc - 2 - sc) : sc + 1;
#pragma unroll
            for (int i = 0; i < 16; ++i) { const int tok = 16 * In + (dir ? 15 - i : i); rq[i] = zc[(size_t)tok * ZW + qcol]; rf[i] = zc[(size_t)tok * ZW + fcol]; }
#pragma unroll
            for (int i8 = 0; i8 < 2; ++i8) { const int i = i8 * 8 + r8; const int tok = 16 * In + (dir ? 15 - i : i); vr[i8] = *(const u32x4*)(zc + (size_t)tok * ZW + vcolb); }
        }
        f32x4 at = (f32x4){0.f, 0.f, 0.f, 0.f};
#pragma unroll
        for (int ks = 0; ks < 2; ++ks) at = __builtin_amdgcn_mfma_f32_16x16x32_bf16(*(const LAS bf16x8*)(kl + l16 * 144 + (32 * ks + 8 * fq) * 2), *(const LAS bf16x8*)(ql + l16 * 144 + (32 * ks + 8 * fq) * 2), at, 0, 0, 0);
#pragma unroll
        for (int r = 0; r < 4; ++r) if (4 * fq + r > l16) at[r] = 0.f;
        const bf16x8 atf = __builtin_bit_cast(bf16x8, pack8(at, (f32x4){0.f, 0.f, 0.f, 0.f}));
        const int roff = (4 * fq + (l16 >> 2)) * 144 + (4 * (l16 & 3)) * 2;
        f32x4 oT[4];
#pragma unroll
        for (int et = 0; et < 4; ++et) {
            const v4i16_t tv = vtr16(vl + roff + et * 32);
            const bf16x8 vf = (bf16x8){tv[0], tv[1], tv[2], tv[3], 0, 0, 0, 0};
            oT[et] = __builtin_amdgcn_mfma_f32_16x16x32_bf16(vf, atf, (f32x4){0.f, 0.f, 0.f, 0.f}, 0, 0, 0);
        }
#pragma unroll
        for (int kp = 0; kp < 2; ++kp) {
            const u32x2 q0 = *(const LAS u32x2*)(ql + l16 * 144 + (32 * kp + 4 * fq) * 2), q1 = *(const LAS u32x2*)(ql + l16 * 144 + (32 * kp + 16 + 4 * fq) * 2);
            const bf16x8 qfr = __builtin_bit_cast(bf16x8, (u32x4){q0.x, q0.y, q1.x, q1.y});
#pragma unroll
            for (int nt = 0; nt < 4; ++nt) {
                const bf16x8 sf = __builtin_bit_cast(bf16x8, pack8(sa[2 * kp][nt], sa[2 * kp + 1][nt]));
                oT[nt] = __builtin_amdgcn_mfma_f32_16x16x32_bf16(sf, qfr, oT[nt], 0, 0, 0);
            }
        }
        {
            const int tok = 16 * I + (dir ? 15 - l16 : l16);
#pragma unroll
            for (int et = 0; et < 4; ++et)
#pragma unroll
                for (int r = 0; r < 4; ++r) ot[tok * 64 + 16 * et + 4 * fq + r] = (bf16_t)f2bf(oT[et][r]);
        }
        bf16x8 kf[4];
#pragma unroll
        for (int mt = 0; mt < 4; ++mt) { const v4i16_t tk = vtr16(kl + roff + mt * 32); kf[mt] = (bf16x8){tk[0], tk[1], tk[2], tk[3], 0, 0, 0, 0}; }
#pragma unroll
        for (int nt = 0; nt < 4; ++nt) {
            const v4i16_t tv = vtr16(vl + roff + nt * 32);
            const bf16x8 vf = (bf16x8){tv[0], tv[1], tv[2], tv[3], 0, 0, 0, 0};
#pragma unroll
            for (int mt = 0; mt < 4; ++mt) sa[mt][nt] = __builtin_amdgcn_mfma_f32_16x16x32_bf16(kf[mt], vf, sa[mt][nt], 0, 0, 0);
        }
#pragma unroll
        for (int mt = 0; mt < 4; ++mt) {
            const f32x4 p4 = *(const LAS f32x4*)(pl + 16 * mt + 4 * fq);
#pragma unroll
            for (int nt = 0; nt < 4; ++nt) sa[mt][nt] = sa[mt][nt] * p4;
        }
    }
}

__device__ __forceinline__ void hg_passB(const Ctx& X, const Grp& gp, int gtid, int GT) {
    const int n = gp.nseq * 32768;
    for (int e = gtid; e < n; e += GT) {
        const int sl = e >> 15, r = e & 32767, hd = r >> 12, de = r & 4095, d = de >> 6, dir = hd & 1;
        const size_t cb0 = (size_t)(sl * gp.nch) * 8 + hd; const int cstep = dir ? -8 : 8; const size_t cfirst = dir ? cb0 + (size_t)(gp.nch - 1) * 8 : cb0;
        float s = 0.f;
        float u[2][8], pv[2][8];
#pragma unroll
        for (int j = 0; j < 8; ++j) { u[0][j] = 0.f; pv[0][j] = 0.f; if (j < gp.nch) { const size_t cb = cfirst + (long)j * cstep; u[0][j] = X.hgu[cb * 4096 + de]; pv[0][j] = X.hgp[cb * 64 + d]; } }
        for (int k0 = 0; k0 < gp.nch; k0 += 16) {
#pragma unroll
            for (int hb = 0; hb < 2; ++hb) {
                const int kb = k0 + hb * 8;
                if (kb < gp.nch) {
#pragma unroll
                    for (int j = 0; j < 8; ++j) { const int k = kb + 8 + j; u[1 - hb][j] = 0.f; pv[1 - hb][j] = 0.f; if (k < gp.nch) { const size_t cb = cfirst + (long)k * cstep; u[1 - hb][j] = X.hgu[cb * 4096 + de]; pv[1 - hb][j] = X.hgp[cb * 64 + d]; } }
#pragma unroll
                    for (int j = 0; j < 8; ++j) { const int k = kb + j; if (k < gp.nch) { const size_t cb = cfirst + (long)k * cstep; X.hgu[cb * 4096 + de] = s; s = pv[hb][j] * s + u[hb][j]; } }
                }
            }
        }
    }
}

__device__ __forceinline__ void na_task(const Ctx& X, const float* rpb, const Grp& gp, int sl, int task, bool metaq, int wave, int lane, LAS unsigned char* vl) {
    const int h = wave, fr = lane & 15, fq = lane >> 4;
    const int s = gp.s0 + sl, rows = gp.Lr >> 6;
    int r = 0, n = 0, rs = 0, ks = 0;
    const bf16_t* qptr; bf16_t* optr; size_t ostride = 512;
    if (metaq) { qptr = X.mz + (size_t)(s * 16 + fr) * ZW; optr = X.myb + (size_t)(s * 16) * 512; }
    else {
        r = task >> 2; n = task & 3;
        rs = r - 4; rs = rs < 0 ? 0 : (rs > rows - 8 ? rows - 8 : rs);
        ks = 16 * n - 8; ks = ks < 0 ? 0 : (ks > 32 ? 32 : ks);
        const size_t qrow0 = (size_t)sl * gp.Lr + r * 64 + 16 * n;
        qptr = X.z + (qrow0 + fr) * ZW; optr = X.yb + qrow0 * 512;
    }
    bf16x8 qf[2];
#pragma unroll
    for (int kk = 0; kk < 2; ++kk) qf[kk] = *(const bf16x8*)(qptr + 256 + h * 64 + 32 * kk + 8 * fq);
    f32x4 sc[17];
    {
        const bf16_t* kp = X.mz + (size_t)(s * 16 + fr) * ZW + 768 + h * 64 + 8 * fq;
        f32x4 c = (f32x4){0.f, 0.f, 0.f, 0.f};
#pragma unroll
        for (int kk = 0; kk < 2; ++kk) c = __builtin_amdgcn_mfma_f32_16x16x32_bf16(*(const bf16x8*)(kp + 32 * kk), qf[kk], c, 0, 0, 0);
        sc[0] = c * 0.125f;
    }
    const int qc = 16 * n + fr;
    int wstart = qc - 8; wstart = wstart < 0 ? 0 : (wstart > 48 ? 48 : wstart);
    const size_t krow_base = (size_t)sl * gp.Lr + (size_t)rs * 64 + ks;
    if (!metaq) {
#pragma unroll
        for (int tb = 0; tb < 2; ++tb) {
            bf16x8 kf[8][2]; float bz[8][4];
#pragma unroll
            for (int t4 = 0; t4 < 8; ++t4) {
                const int tt = tb * 8 + t4, kj = tt >> 1, half = tt & 1;
                const bf16_t* kp = X.z + (krow_base + kj * 64 + 16 * half + fr) * ZW + 768 + h * 64 + 8 * fq;
                kf[t4][0] = *(const bf16x8*)kp; kf[t4][1] = *(const bf16x8*)(kp + 32);
            }
#pragma unroll
            for (int t4 = 0; t4 < 8; ++t4) {
                const int tt = tb * 8 + t4, kj = tt >> 1, half = tt & 1;
                const float* rp = rpb + (h * 15 + (rs + kj - r + 7)) * 31;
#pragma unroll
                for (int i = 0; i < 4; ++i) { int dc = ks + 16 * half + 4 * fq + i - qc; dc = dc < -15 ? -15 : (dc > 15 ? 15 : dc); bz[t4][i] = rp[dc + 15]; }
            }
            __builtin_amdgcn_sched_barrier(0);
#pragma unroll
            for (int t4 = 0; t4 < 8; ++t4) {
                const int tt = tb * 8 + t4, half = tt & 1;
                f32x4 c = (f32x4){0.f, 0.f, 0.f, 0.f};
                c = __builtin_amdgcn_mfma_f32_16x16x32_bf16(kf[t4][0], qf[0], c, 0, 0, 0);
                c = __builtin_amdgcn_mfma_f32_16x16x32_bf16(kf[t4][1], qf[1], c, 0, 0, 0);
#pragma unroll
                for (int i = 0; i < 4; ++i) {
                    const int kc = ks + 16 * half + 4 * fq + i;
                    const bool valid = (kc >= wstart) && (kc < wstart + 16);
                    c[i] = valid ? c[i] * 0.125f + bz[t4][i] : -1e30f;
                }
                sc[1 + tt] = c;
            }
            __builtin_amdgcn_sched_barrier(0);
        }
    } else {
#pragma unroll
        for (int tt = 0; tt < 16; ++tt) sc[1 + tt] = (f32x4){-1e30f, -1e30f, -1e30f, -1e30f};
    }
    float mx = -1e30f;
#pragma unroll
    for (int t = 0; t < 17; ++t)
#pragma unroll
        for (int i = 0; i < 4; ++i) mx = fmaxf(mx, sc[t][i]);
    mx = fmaxf(mx, __shfl_xor(mx, 16)); mx = fmaxf(mx, __shfl_xor(mx, 32));
    float sum = 0.f;
#pragma unroll
    for (int t = 0; t < 17; ++t)
#pragma unroll
        for (int i = 0; i < 4; ++i) { const float e = __expf(sc[t][i] - mx); sc[t][i] = e; sum += e; }
    sum += __shfl_xor(sum, 16); sum += __shfl_xor(sum, 32);
    const float inv = 1.f / sum;
    f32x4 oacc[4];
#pragma unroll
    for (int et = 0; et < 4; ++et) oacc[et] = (f32x4){0.f, 0.f, 0.f, 0.f};
    {
        const int r8 = lane >> 3, pc = lane & 7, l16 = lane & 15;
        const int vcol = 1280 + h * 64 + pc * 8;
        u32x4 vreg[8];
#pragma unroll
        for (int i = 0; i < 2; ++i) vreg[i] = *(const u32x4*)(X.mz + (size_t)(s * 16 + i * 8 + r8) * ZW + vcol);
#pragma unroll
        for (int cc = 0; cc < 5; ++cc) {
            if (cc > 0 && metaq) break;
            __syncthreads();
#pragma unroll
            for (int i = 0; i < 8; ++i) if (cc > 0 || i < 2) *(LAS u32x4*)(vl + (i * 8 + r8) * 144 + pc * 16) = vreg[i];
            __syncthreads();
            if (cc < 4 && !metaq) {
#pragma unroll
                for (int i = 0; i < 8; ++i) { const int rr = i * 8 + r8;
                    vreg[i] = *(const u32x4*)(X.z + (krow_base + (size_t)(2 * cc + (rr >> 5)) * 64 + (rr & 31)) * ZW + vcol); }
            }
#pragma unroll
            for (int ksl = 0; ksl < 2; ++ksl) {
                if (cc == 0 && ksl == 1) break;
                const int tt = 4 * (cc - 1) + 2 * ksl;
                f32x4 pa, pb;
                if (cc == 0) { pa = sc[0] * inv; pb = (f32x4){0.f, 0.f, 0.f, 0.f}; } else { pa = sc[1 + tt] * inv; pb = sc[2 + tt] * inv; }
                const bf16x8 pf = __builtin_bit_cast(bf16x8, pack8(pa, pb));
                const LAS unsigned char* rowp = vl + (32 * ksl + 4 * fq + (l16 >> 2)) * 144 + (4 * (l16 & 3)) * 2;
#pragma unroll
                for (int et = 0; et < 4; ++et) {
                    const v4i16_t ta = vtr16(rowp + et * 32);
                    v4i16_t tb = (v4i16_t){0, 0, 0, 0};
                    if (cc > 0) tb = vtr16(rowp + 16 * 144 + et * 32);
                    const bf16x8 vw = (bf16x8){ta[0], ta[1], ta[2], ta[3], tb[0], tb[1], tb[2], tb[3]};
                    oacc[et] = __builtin_amdgcn_mfma_f32_16x16x32_bf16(pf, vw, oacc[et], 0, 0, 0);
                }
            }
        }
    }
#pragma unroll
    for (int et = 0; et < 4; ++et)
#pragma unroll
        for (int i = 0; i < 4; ++i) optr[(size_t)(4 * fq + i) * ostride + h * 64 + et * 16 + fr] = (bf16_t)f2bf(oacc[et][i]);
}

#define XB_TMO      128
#define XB_XCNT(j)  (256  + 64 * (j))
#define XB_XSUB(j)  (1280 + 64 * (j))
#define XB_XGEN(j)  (2304 + 64 * (j))
#define XB_TOP      3328
#define XB_TOPGEN   3392
#define XCD_BAR_WORDS 3456
#define XB_SPIN_CAP (1u << 22)
__device__ __forceinline__ unsigned xb_ld(unsigned* p)              { return __hip_atomic_load(p, __ATOMIC_RELAXED, __HIP_MEMORY_SCOPE_AGENT); }
__device__ __forceinline__ unsigned xb_add(unsigned* p, unsigned v) { return __hip_atomic_fetch_add(p, v, __ATOMIC_RELAXED, __HIP_MEMORY_SCOPE_AGENT); }
__device__ __forceinline__ unsigned xb_xcc_id() { return (unsigned)__builtin_amdgcn_s_getreg((3 << 11) | 20) & 0xFu; }
#define XB_SPIN(cond, bar) do { unsigned _sp = 0; while (cond) { __builtin_amdgcn_s_sleep(1); \
    if ((++_sp & 255u) == 0u) { if (xb_ld(&(bar)[XB_TMO])) break; if (_sp > XB_SPIN_CAP) { atomicAdd(&(bar)[XB_TMO], 1u); break; } } } } while (0)
__device__ __forceinline__ void xcd_barrier_complete(unsigned* bar, unsigned x, unsigned& nloc, unsigned& nx) {
    const unsigned G = gridDim.x * gridDim.y * gridDim.z;
    unsigned sum, cnt, mine, sp = 0u;
    for (;;) {
        sum = 0u; cnt = 0u; mine = 0u;
#pragma unroll
        for (unsigned j = 0; j < 16; ++j) { const unsigned c = xb_ld(&bar[XB_XCNT(j)]); sum += c; cnt += (c > 0u) ? 1u : 0u; mine = (j == x) ? c : mine; }
        if (sum == G) break;
        __builtin_amdgcn_s_sleep(1);
        if ((++sp & 255u) == 0u) { if (xb_ld(&bar[XB_TMO])) break; if (sp > XB_SPIN_CAP) { atomicAdd(&bar[XB_TMO], 1u); break; } }
    }
    nloc = mine > 0u ? mine : 1u; nx = cnt > 0u ? cnt : 1u;
}
__device__ __forceinline__ void xcd_barrier(unsigned* bar, volatile LAS unsigned* st) {
    asm volatile("s_waitcnt vmcnt(0)" ::: "memory");
    __syncthreads();
    if (threadIdx.x == 0) {
        const unsigned x = xb_xcc_id();
        __builtin_amdgcn_s_waitcnt(0);
        unsigned nloc = st[0], nx = st[1];
        if (nloc == 0u) { xcd_barrier_complete(bar, x, nloc, nx); st[0] = nloc; st[1] = nx; }
        const unsigned old = xb_add(&bar[XB_XSUB(x)], 1u);
        const unsigned gen = old / nloc;
        if (old + 1u == (gen + 1u) * nloc) {
            __builtin_amdgcn_fence(__ATOMIC_RELEASE, "agent");
            asm volatile("s_waitcnt vmcnt(0)" ::: "memory");
            const unsigned og = xb_add(&bar[XB_TOP], 1u);
            const unsigned tg = og / nx;
            if (og + 1u == (tg + 1u) * nx) xb_add(&bar[XB_TOPGEN], 1u);
            else XB_SPIN(xb_ld(&bar[XB_TOPGEN]) == tg, bar);
            __builtin_amdgcn_fence(__ATOMIC_ACQUIRE, "agent");
            xb_add(&bar[XB_XGEN(x)], 1u);
            asm volatile("s_waitcnt vmcnt(0)" ::: "memory");
        } else {
            XB_SPIN(xb_ld(&bar[XB_XGEN(x)]) == gen, bar);
            __builtin_amdgcn_fence(__ATOMIC_ACQUIRE, "agent");
            asm volatile("s_waitcnt vmcnt(0)" ::: "memory");
        }
    }
    __syncthreads();
}
#define GRID_SYNC() xcd_barrier((unsigned*)(KA(ws) + WS_CTL), (volatile LAS unsigned*)(lds + LDS_ST_OFF))
__device__ __forceinline__ Ctx make_ctx(unsigned char* ws) {
    Ctx X;
    X.hb = (bf16_t*)(ws + WS_HB); X.ssq = (float*)(ws + WS_SSQ); X.z = (bf16_t*)(ws + WS_Z); X.yb = (bf16_t*)(ws + WS_YB); X.vt = (bf16_t*)(ws + WS_VT);
    X.hgu = (float*)(ws + WS_HGU); X.hgp = (float*)(ws + WS_HGP); X.s5s = (float*)(ws + WS_S5S); X.w = (bf16_t*)(ws + WS_W);
    X.lbar = (const float*)(ws + WS_TAB + T_LBAR); X.l16 = (const float*)(ws + WS_TAB + T_L16); X.l64 = (const float*)(ws + WS_TAB + T_L64);
    X.bfrag = (const bf16_t*)(ws + WS_TAB + T_BFRAG); X.cfrag = (const bf16_t*)(ws + WS_TAB + T_CFRAG); X.lb = (const float*)(ws + WS_TAB + T_LB);
    X.mh = (float*)(ws + WS_META + M_H); X.mhb = (bf16_t*)(ws + WS_META + M_HB); X.mssq = (float*)(ws + WS_META + M_SSQ); X.mz = (bf16_t*)(ws + WS_META + M_Z);
    X.myb = (bf16_t*)(ws + WS_META + M_YB); X.mvt = (bf16_t*)(ws + WS_META + M_VT); X.mact = (bf16_t*)(ws + WS_META + M_ACT);
    return X;
}

__device__ __forceinline__ bool make_job(unsigned char* ws, float* out, int l, int g, int ph, int j, pg8::Gemm& gm, pg8::UberEpi& ep) {
    const bool mchain = (g == 3) && (l < NLAYER - 1);
    int njobs = 1; bool meta = false; int sub = j;
    if (ph == 0) { njobs = (g == 0) ? 2 : 1; meta = (j == 1); }
    else if (ph == 4) { njobs = (g == 3) ? 2 : 1; meta = (j == 1); }
    else if (ph == 5) { njobs = mchain ? 6 : 3; meta = (j >= 3); sub = j % 3; }
    else { njobs = mchain ? 2 : 1; meta = (j == 1); }
    if (j >= njobs) return false;
    unsigned char* wb = ws + WS_W;
    const size_t r0 = (size_t)g * RG;
    unsigned char* mb = ws + WS_META;
    bf16_t* z = meta ? (bf16_t*)(mb + M_Z) : (bf16_t*)(ws + WS_Z);
    bf16_t* hb = meta ? (bf16_t*)(mb + M_HB) : (bf16_t*)(ws + WS_HB) + r0 * DM;
    float* ssq = meta ? (float*)(mb + M_SSQ) : (float*)(ws + WS_SSQ) + r0 * 4;
    float* h = meta ? (float*)(mb + M_H) : out + r0 * DM;
    bf16_t* yb = meta ? (bf16_t*)(mb + M_YB) : (bf16_t*)(ws + WS_YB);
    bf16_t* vt = meta ? (bf16_t*)(mb + M_VT) : (bf16_t*)(ws + WS_VT);
    bf16_t* act = meta ? (bf16_t*)(mb + M_ACT) : (bf16_t*)(ws + WS_Z);
    gm.M = meta ? 256 : RG;
    ep.i0 = 0; ep.p0 = nullptr; ep.p1 = nullptr; ep.p2 = nullptr;
    if (ph == 0) { gm.A = hb; gm.lda = DM; gm.Bt = (const bf16_t*)(wb + W_IN); gm.N = ZN; gm.K = DM; ep.mode = 0; ep.p0 = (unsigned char*)z; ep.p1 = (unsigned char*)ssq; ep.p2 = (unsigned char*)vt; ep.i0 = meta ? 256 : VTLD; }
    else if (ph == 4) { gm.A = z + 512; gm.lda = ZW; gm.Bt = (const bf16_t*)(wb + W_GLU); gm.N = 256; gm.K = 256; ep.mode = 1; ep.p0 = (unsigned char*)z; }
    else if (ph == 5) {
        gm.N = DM; ep.p0 = (unsigned char*)z;
        if (sub == 0) { gm.A = yb; gm.lda = 512; gm.Bt = (const bf16_t*)(wb + W_UPB); gm.K = 512; ep.mode = 2; ep.i0 = 4096; }
        else if (sub == 1) { gm.A = z + 256; gm.lda = ZW; gm.Bt = (const bf16_t*)(wb + W_UPC); gm.K = 256; ep.mode = 3; ep.i0 = 5120; }
        else { gm.A = z; gm.lda = ZW; gm.Bt = (const bf16_t*)(wb + W_UPA); gm.K = 256; ep.mode = 3; ep.i0 = 3072; }
    }
    else if (ph == 6) { gm.A = z + 1024; gm.lda = ZW; gm.Bt = (const bf16_t*)(wb + W_O); gm.N = DM; gm.K = DM; ep.mode = 4; ep.p0 = (unsigned char*)h; ep.p1 = (unsigned char*)hb; ep.p2 = (unsigned char*)ssq; }
    else if (ph == 7) { gm.A = hb; gm.lda = DM; gm.Bt = (const bf16_t*)(wb + W_GU); gm.N = 2 * FFH; gm.K = DM; ep.mode = 5; ep.p0 = (unsigned char*)act; ep.p1 = (unsigned char*)ssq; }
    else { gm.A = act; gm.lda = FFH; gm.Bt = (const bf16_t*)(wb + W_DN); gm.N = DM; gm.K = FFH; ep.mode = 4; ep.p0 = (unsigned char*)h; ep.p1 = (unsigned char*)hb; ep.p2 = (unsigned char*)ssq; }
    return true;
}

__device__ __forceinline__ void prologue(int G) {
    const int tid_ = opaque_tid(); const int lane = tid_ & 63, gw = blockIdx.x * 8 + __builtin_amdgcn_readfirstlane(tid_ >> 6), NGW = G * 8;
    const Ctx X = make_ctx(((unsigned char*)KA(ws)));
    for (int row = gw; row < RMAIN + 256; row += NGW) {
        const bool ismeta = row >= RMAIN; const int mr = row - RMAIN;
        const float* src = ismeta ? (mr < 160 ? KAF(meta_tokens) + (size_t)(mr & 15) * DM : nullptr) : (row < 32768 ? KAF(x_prompt) + (size_t)row * DM : KAF(x_sample) + (size_t)(row - 32768) * DM);
        float* hd = ismeta ? X.mh + (size_t)mr * DM : ((float*)KA(out)) + (size_t)row * DM;
        bf16_t* hbd = ismeta ? X.mhb + (size_t)mr * DM : X.hb + (size_t)row * DM;
        float* sq = ismeta ? X.mssq + (size_t)mr * 4 : X.ssq + (size_t)row * 4;
        float ss = 0.f;
#pragma unroll
        for (int j = 0; j < 4; ++j) {
            f32x4 v = (f32x4){0.f, 0.f, 0.f, 0.f}; if (src) v = *(const f32x4*)(src + j * 256 + lane * 4);
            *(f32x4*)(hd + j * 256 + lane * 4) = v;
            *(u32x2*)(hbd + j * 256 + lane * 4) = (u32x2){pk2(v[0], v[1]), pk2(v[2], v[3])};
            ss += (v[0] * v[0] + v[1] * v[1]) + (v[2] * v[2] + v[3] * v[3]);
        }
        ss = wave_sum(ss);
        if (lane < 4) sq[lane] = lane == 0 ? ss : 0.f;
    }
}

__device__ __forceinline__ void mixer_phase_A(int l, int g, LAS unsigned char* lds, int G, int bid) {
    const int tid_ = opaque_tid(); const int lane = tid_ & 63, wave = __builtin_amdgcn_readfirstlane(tid_ >> 6);
    const Ctx X = make_ctx(((unsigned char*)KA(ws))); const Grp gp = make_grp(g);
    const float* rpb = KAF(rpb) + (size_t)l * 8 * 15 * 31; const float* s5d = KAF(s5_d) + l * 256;
    const int nna = gp.nseq * (gp.Lr / 16), nmq = gp.nseq, nct = gp.nseq * (gp.nch - 1);
    const int ntask = nna + nmq + 2 * nct;
    const bool xmap = (nna % 256 == 0) && ((volatile LAS unsigned*)(lds + LDS_ST_OFF))[4] != 0u;
    if (xmap) {
        const int xcc = (int)((volatile LAS unsigned*)(lds + LDS_ST_OFF))[2], xrk = (int)((volatile LAS unsigned*)(lds + LDS_ST_OFF))[3];
        const int per = gp.Lr / 16, nx = nna / 8, rounds = nna / 256;
        for (int i = 0; i < rounds; ++i) { const int t = xcc * nx + xrk + 32 * i; na_task(X, rpb, gp, t / per, t % per, false, wave, lane, lds + wave * 9216); }
    }
    for (int t = bid + (xmap ? nna : 0); t < ntask; t += G) {
        __syncthreads();
        if (t < nna) { const int per = gp.Lr / 16; na_task(X, rpb, gp, t / per, t % per, false, wave, lane, lds + wave * 9216); }
        else if (t < nna + nmq) { na_task(X, rpb, gp, t - nna, 0, true, wave, lane, lds + wave * 9216); }
        else {
            const int u = t - nna - nmq; const bool isS5 = u < nct; const int v = isS5 ? u : u - nct;
            const int sl = v / (gp.nch - 1), c1 = v % (gp.nch - 1) + 1;
            for (int c = (c1 == 1 ? 0 : c1); c <= c1; ++c) {
                __syncthreads();
                const int ci = sl * gp.nch + c; const int T = c == 0 ? 16 : 64;
                bf16_t* zc = c == 0 ? X.mz + (size_t)((gp.s0 + sl) * 16) * ZW : X.z + ((size_t)sl * gp.Lr + 64 * (c - 1)) * ZW;
                if (isS5) s5_chunk<false>(X, s5d, (LAS float*)(lds + wave * 16896), zc, T, ci, wave, lane);
                else hg_passA_mfma(X, lds + wave * 9216, zc, T, ci, wave, lane);
            }
        }
    }
}

__device__ __forceinline__ void mixer_phase_C(int l, int g, LAS unsigned char* lds, int G, int bid) {
    const int tid_ = opaque_tid(); const int lane = tid_ & 63, wave = __builtin_amdgcn_readfirstlane(tid_ >> 6);
    const Ctx X = make_ctx(((unsigned char*)KA(ws))); const Grp gp = make_grp(g);
    const float* s5d = KAF(s5_d) + l * 256; const float* ong = KAF(onorm_g) + l * 64;
    const int nct = gp.nseq * (gp.nch - 1);
    for (int t = bid; t < 2 * nct; t += G) {
        const bool isS5 = t < nct; const int v = isS5 ? t : t - nct;
        const int sl = v / (gp.nch - 1), c1 = v % (gp.nch - 1) + 1;
        for (int c = (c1 == 1 ? 0 : c1); c <= c1; ++c) {
            __syncthreads();
            const int ci = sl * gp.nch + c; const int T = c == 0 ? 16 : 64;
            bf16_t* zc = c == 0 ? X.mz + (size_t)((gp.s0 + sl) * 16) * ZW : X.z + ((size_t)sl * gp.Lr + 64 * (c - 1)) * ZW;
            if (isS5) {
                s5_chunk<true>(X, s5d, (LAS float*)(lds + wave * 16896), zc, T, ci, wave, lane);
                const int fr = lane & 15, fq = lane >> 4;
                const bf16_t* wg = (const bf16_t*)((const unsigned char*)X.w + W_GLU);
                const int n0 = wave * 32;
                bf16x8 bw[8][2];
#pragma unroll
                for (int ks = 0; ks < 8; ++ks)
#pragma unroll
                    for (int n2 = 0; n2 < 2; ++n2) bw[ks][n2] = *(const bf16x8*)(wg + (size_t)(n0 + n2 * 16 + fr) * 256 + ks * 32 + fq * 8);
                asm volatile("s_waitcnt vmcnt(0)" ::: "memory");
                __syncthreads();
                f32x4 ga[4][2];
#pragma unroll
                for (int a = 0; a < 4; ++a)
#pragma unroll
                    for (int b = 0; b < 2; ++b) ga[a][b] = (f32x4){0.f, 0.f, 0.f, 0.f};
#pragma unroll
                for (int kh = 0; kh < 2; ++kh) {
                    bf16x8 af[4][4];
#pragma unroll
                    for (int k4 = 0; k4 < 4; ++k4)
#pragma unroll
                        for (int mt = 0; mt < 4; ++mt) { af[k4][mt] = (bf16x8){0, 0, 0, 0, 0, 0, 0, 0}; if (mt * 16 < T) af[k4][mt] = *(const bf16x8*)(zc + (size_t)(mt * 16 + fr) * ZW + 512 + (kh * 4 + k4) * 32 + fq * 8); }
                    __builtin_amdgcn_sched_barrier(0);
#pragma unroll
                    for (int k4 = 0; k4 < 4; ++k4)
#pragma unroll
                        for (int mt = 0; mt < 4; ++mt) {
                            if (mt * 16 < T) {
#pragma unroll
                                for (int n2 = 0; n2 < 2; ++n2) ga[mt][n2] = __builtin_amdgcn_mfma_f32_16x16x32_bf16(af[k4][mt], bw[kh * 4 + k4][n2], ga[mt][n2], 0, 0, 0);
                            }
                        }
                    __builtin_amdgcn_sched_barrier(0);
                }
#pragma unroll
                for (int mt = 0; mt < 4; ++mt) {
                    if (mt * 16 < T) {
                        float yy[2][4];
#pragma unroll
                        for (int n2 = 0; n2 < 2; ++n2)
#pragma unroll
                            for (int r = 0; r < 4; ++r) yy[n2][r] = bf2f(zc[(size_t)(mt * 16 + 4 * fq + r) * ZW + 512 + n0 + n2 * 16 + fr]);
#pragma unroll
                        for (int n2 = 0; n2 < 2; ++n2)
#pragma unroll
                            for (int r = 0; r < 4; ++r) zc[(size_t)(mt * 16 + 4 * fq + r) * ZW + n0 + n2 * 16 + fr] = (bf16_t)f2bf(yy[n2][r] * sigm(ga[mt][n2][r]));
                    }
                }
            }
            else {
                hg_passC_mfma(X, lds + wave * 7168, (LAS bf16_t*)(lds + 65536 + wave * 8192), zc, T, ci, wave, lane);
                __syncthreads();
                const int h = wave >> 1, half = wave & 1;
                const LAS bf16_t* of = (const LAS bf16_t*)(lds + 65536 + (2 * h) * 8192); const LAS bf16_t* ob = (const LAS bf16_t*)(lds + 65536 + (2 * h + 1) * 8192);
                const float gn = ong[lane];
                const int tt0 = half * (T / 2);
                float gov[32];
#pragma unroll
                for (int i = 0; i < 32; ++i) { gov[i] = 0.f; if (i < T / 2) gov[i] = bf2f(zc[(size_t)(tt0 + i) * ZW + 2816 + h * 64 + lane]); }
#pragma unroll
                for (int i = 0; i < 32; ++i) {
                    if (i < T / 2) {
                        const int tt = tt0 + i;
                        const float o = bf2f(of[tt * 64 + lane]) + bf2f(ob[tt * 64 + lane]);
                        const float ms = wave_sum(o * o) * (1.0f / 64.0f);
                        const float go = gov[i];
                        zc[(size_t)tt * ZW + 256 + h * 64 + lane] = (bf16_t)f2bf(o * rsqrtf(ms + 1e-6f) * gn * (go * sigm(go)));
                    }
                }
            }
        }
    }
}

__global__ void __launch_bounds__(512, 2) fwd_kernel(Args a) {
    extern __shared__ __attribute__((aligned(16))) unsigned char lds_raw[];
    LAS unsigned char* lds = (LAS unsigned char*)lds_raw;
    const int G = gridDim.x, bid = blockIdx.x;

    if (threadIdx.x < 2) ((volatile LAS unsigned*)(lds + LDS_ST_OFF))[threadIdx.x] = 0u;
    if (threadIdx.x == 0) { const unsigned xc = xb_xcc_id(); const unsigned rk = xb_add((unsigned*)(KA(ws) + WS_CTL) + XB_XCNT(xc), 1u);
        ((volatile LAS unsigned*)(lds + LDS_ST_OFF))[2] = xc; ((volatile LAS unsigned*)(lds + LDS_ST_OFF))[3] = rk; }
    __syncthreads();
    prologue(G);

    for (int l = 0; l < NLAYER; ++l) {
        __syncthreads();
        { const Ctx X = make_ctx(((unsigned char*)KA(ws))); prep_layer(X, l, lds, G); }
        if (l == 0) { asm volatile("s_waitcnt vmcnt(0)" ::: "memory"); __syncthreads(); cg::this_grid().sync(); }
        GRID_SYNC();
        if (l == 0) {
            if (threadIdx.x == 0) { unsigned* bar = (unsigned*)(KA(ws) + WS_CTL); bool ok = (G == 256);
                for (int j = 0; j < 16; ++j) { const unsigned c = xb_ld(&bar[XB_XCNT(j)]); ok = ok && (c == (j < 8 ? 32u : 0u)); }
                ((volatile LAS unsigned*)(lds + LDS_ST_OFF))[4] = ok ? 1u : 0u; }
            __syncthreads();
        }
        for (int g = 0; g < 4; ++g) {
            for (int ph = 0; ph < 9; ++ph) {
                if (ph == 4) continue;
                if (ph == 1) mixer_phase_A(l, g, lds, G, bid);
                else if (ph == 2) { const Ctx X = make_ctx(((unsigned char*)KA(ws))); const Grp gp = make_grp(g); const int gtid = bid * 512 + opaque_tid(), GT = G * 512; s5_passB(X, gp, gtid, GT); hg_passB(X, gp, GT - 1 - gtid, GT); }
                else if (ph == 3) mixer_phase_C(l, g, lds, G, bid);
                else {
                    for (int j = 0; j < 6; ++j) {
                        pg8::Gemm gm; pg8::UberEpi ep;
                        if (!make_job(((unsigned char*)KA(ws)), ((float*)KA(out)), l, g, ph, j, gm, ep)) break;
                        int cidx = bid;
                        if (ph == 7 && j == 1) { const int busy = ((RG / 256) * (2 * FFH / 256)) % G; cidx = (bid + G - busy) % G; }
                        pg8::StaticOrder SO; SO.init(gm.M, gm.N, G, cidx);
                        pg8::gemm_phase(lds, gm, SO, ep);
                    }
                }
                GRID_SYNC();
            }
        }
    }
    {
        const float* ssq = (const float*)(((unsigned char*)KA(ws)) + WS_SSQ);
        const int tid_ = opaque_tid(); const int lane = tid_ & 63, wave = __builtin_amdgcn_readfirstlane(tid_ >> 6);
        for (int row = bid * 8 + wave; row < RMAIN; row += G * 8) {
            const float rs = pg8::row_rstd(ssq, row);
            float* hp = ((float*)KA(out)) + (size_t)row * DM;
#pragma unroll
            for (int j = 0; j < 4; ++j) {
                f32x4 v = *(const f32x4*)(hp + j * 256 + lane * 4); const f32x4 gv = *(const f32x4*)(KAF(final_g) + j * 256 + lane * 4);
                v = v * rs * gv; *(f32x4*)(hp + j * 256 + lane * 4) = v;
            }
        }
    }
}

extern "C" void kernel_launch(void* const* d_in, const int* in_sizes, int n_in, void* d_out, int out_size, void* d_ws, size_t ws_size, hipStream_t stream) {
    static int grid = 0;
    if (grid == 0) {
        int dev = 0, cus = 0, per_cu = 0;
        (void)hipGetDevice(&dev);
        (void)hipDeviceGetAttribute(&cus, hipDeviceAttributeMultiprocessorCount, dev);
        (void)hipFuncSetAttribute((const void*)fwd_kernel, hipFuncAttributeMaxDynamicSharedMemorySize, LDS_BYTES);
        (void)hipOccupancyMaxActiveBlocksPerMultiprocessor(&per_cu, (const void*)fwd_kernel, 512, LDS_BYTES);
        (void)hipGetLastError();
        if (ws_size < WS_TOTAL) fprintf(stderr, "kernel_launch: workspace too small: %zu < %zu\n", ws_size, (size_t)WS_TOTAL);
        grid = cus > 0 ? cus : 256;
    }
    (void)hipMemsetAsync((char*)d_ws + WS_CTL, 0, CTL_BYTES, stream);
    Args a{};
    const float** pp = (const float**)&a;
    for (int i = 0; i < 26; ++i) pp[i] = (const float*)d_in[i];
    a.out = (float*)d_out; a.ws = (unsigned char*)d_ws;
    void* args[] = {&a};
    hipError_t e = hipLaunchCooperativeKernel((const void*)fwd_kernel, dim3(grid), dim3(512), args, LDS_BYTES, stream);
    if (e != hipSuccess) fprintf(stderr, "cooperative launch failed: %s\n", hipGetErrorString(e));
}
```

```cpp
#include <hip/hip_runtime.h>
#include <hip/hip_cooperative_groups.h>
#include <cstdio>
#include <cstdint>
namespace cg = cooperative_groups;

#define LAS __attribute__((address_space(3)))
typedef unsigned short bf16_t;
typedef short bf16x8 __attribute__((ext_vector_type(8)));
typedef float f32x4 __attribute__((ext_vector_type(4)));
typedef unsigned u32x4 __attribute__((ext_vector_type(4)));
typedef unsigned u32x2 __attribute__((ext_vector_type(2)));

#define WAVE_SYNC() asm volatile("s_waitcnt lgkmcnt(0)" ::: "memory")
__device__ __forceinline__ int opaque_tid() { int t = threadIdx.x; asm volatile("" : "+v"(t)); return t; }

__device__ __forceinline__ unsigned f2bf(float f) { unsigned u = __builtin_bit_cast(unsigned, f); return (u + 0x7fffu + ((u >> 16) & 1u)) >> 16; }
__device__ __forceinline__ unsigned pk2(float lo, float hi) { return f2bf(lo) | (f2bf(hi) << 16); }
__device__ __forceinline__ float bf2f(bf16_t b) { return __builtin_bit_cast(float, (unsigned)b << 16); }
__device__ __forceinline__ float bflo(unsigned w) { return __builtin_bit_cast(float, w << 16); }
__device__ __forceinline__ float bfhi(unsigned w) { return __builtin_bit_cast(float, w & 0xffff0000u); }
__device__ __forceinline__ float sigm(float x) { return 1.f / (1.f + __expf(-x)); }
__device__ __forceinline__ float gelu_tanh(float y) { const float a = 0.7978845608028654f * (y + 0.044715f * y * y * y); const float th = 1.f - 2.f / (__expf(2.f * a) + 1.f); return 0.5f * y * (1.f + th); }
__device__ __forceinline__ u32x4 pack8(f32x4 a, f32x4 b) { u32x4 w; w.x = pk2(a[0], a[1]); w.y = pk2(a[2], a[3]); w.z = pk2(b[0], b[1]); w.w = pk2(b[2], b[3]); return w; }
__device__ __forceinline__ float wave_sum(float v) {
#pragma unroll
    for (int o = 1; o < 64; o <<= 1) v += __shfl_xor(v, o);
    return v;
}

namespace pg8 {
constexpr int ZSTR = 6208;
constexpr int BM = 256, BK = 64, HALF = 128, HTB = HALF * BK * 2, STAGE_BYTES = 8 * HTB, NXCD = 8, WGM = 8;
__host__ __device__ __forceinline__ int lds_byte(int r, int c) { const int st = (r >> 4) * 2 + (c >> 5), rr = r & 15, cc = c & 31, ob = rr * 64 + cc * 2; return st * 1024 + (ob ^ (((ob >> 9) & 1) << 5)); }
__host__ __device__ __forceinline__ void stage_rc(int b, int& R, int& C) { const int st = b / 1024, sb = b % 1024, swz = sb ^ (((sb >> 9) & 1) << 5); R = (st >> 1) * 16 + swz / 64; C = (st & 1) * 32 + (swz % 64) / 2; }
__host__ __device__ __forceinline__ int perm32(int rho) { const int n = rho >> 4, i = rho & 15; return 8 * (i >> 2) + 4 * n + (i & 3); }
struct Unit { int pm, pn; };
struct Gemm { const bf16_t* A; int lda; const bf16_t* Bt; int M, N, K; };
struct StaticOrder {
    int nM, nN, nwg, G, c;
    __device__ void init(int M, int N, int G_, int c_) { nM = M / BM; nN = N / BM; nwg = nM * nN; G = G_; c = c_; }
    __device__ bool next(int i, Unit& u) const {
        const long L = (long)i * G + c; if (L >= nwg) return false;
        int wgid = (int)L; { const int q = nwg / NXCD, r = nwg % NXCD, xcd = wgid % NXCD, off = wgid / NXCD; wgid = (xcd < r ? xcd * (q + 1) : r * (q + 1) + (xcd - r) * q) + off; }
        const int nig = WGM * nN, gid = wgid / nig, fm = gid * WGM, gsz = (nM - fm) < WGM ? (nM - fm) : WGM;
        u.pm = fm + ((wgid % nig) % gsz); u.pn = (wgid % nig) / gsz; return true;
    }
};

struct UberEpi;
__device__ __forceinline__ void run_epi(const UberEpi& E, LAS unsigned char* lds, const f32x4 (&acc)[2][2][4][2], const Unit& u, int wr, int wc, int fr, int fq);
__device__ __forceinline__ void gemm_phase(LAS unsigned char* lds, const Gemm g, const StaticOrder& S, const UberEpi& E) {
    const int tid = opaque_tid(), wid = __builtin_amdgcn_readfirstlane(tid >> 6), lane = tid & 63, wr = wid >> 2, wc = wid & 3, fr = lane & 15, fq = lane >> 4;
    const int K = g.K, nt = K / BK, lda = g.lda;
    unsigned voffA[2], voffB[2];
#pragma unroll
    for (int i = 0; i < 2; ++i) { int R, C; stage_rc(tid * 16 + i * 8192, R, C); const int Rb = (R & ~31) + perm32(R & 31);
        voffA[i] = (unsigned)(R * lda + C) * 2u; voffB[i] = (unsigned)(Rb * K + C) * 2u; }
    const size_t kstep = (size_t)(BK * 2);
    const size_t hstepA = (size_t)HALF * lda * 2, hstepB = (size_t)HALF * K * 2;
    const size_t tstepA = 2 * hstepA, tstepB = 2 * hstepB;
    const unsigned ldsw = (unsigned)wid * 1024u;
    const int aoff = lds_byte(wr * 64 + fr, fq * 8), boff = lds_byte(wc * 32 + fr, fq * 8);
#define PG8_SA(b, h) (((b) * 2 + (h)) * HTB)
#define PG8_SB(b, h) ((4 + (b) * 2 + (h)) * HTB)
#define PG8_STAGE(bufoff, gbase, voff) do { _Pragma("unroll") for (int _i = 0; _i < 2; ++_i) \
        __builtin_amdgcn_global_load_lds((const unsigned*)((const char*)(gbase) + (voff)[_i]), (LAS unsigned*)(lds + (bufoff) + ldsw + _i * 8192), 16, 0, 0); } while (0)
#define PG8_LDA(dst, b, h) do { _Pragma("unroll") for (int m = 0; m < 4; ++m) _Pragma("unroll") for (int k = 0; k < 2; ++k) dst[m][k] = *(const LAS bf16x8*)(lds + PG8_SA(b, h) + aoff + m * 2048 + k * 1024); } while (0)
#define PG8_LDB(dst, b, h) do { _Pragma("unroll") for (int n = 0; n < 2; ++n) _Pragma("unroll") for (int k = 0; k < 2; ++k) dst[n][k] = *(const LAS bf16x8*)(lds + PG8_SB(b, h) + boff + n * 2048 + k * 1024); } while (0)
#define PG8_MMA(ai, bj, At, Bt) do { __builtin_amdgcn_s_setprio(1); _Pragma("unroll") for (int m = 0; m < 4; ++m) _Pragma("unroll") for (int n = 0; n < 2; ++n) _Pragma("unroll") for (int k = 0; k < 2; ++k) \
        acc[ai][bj][m][n] = __builtin_amdgcn_mfma_f32_16x16x32_bf16(Bt[n][k], At[m][k], acc[ai][bj][m][n], 0, 0, 0); __builtin_amdgcn_s_setprio(0); } while (0)
#define PG8_WAIT_V(n) asm volatile("s_waitcnt vmcnt(" #n ")" ::: "memory")
#define PG8_WAIT_L(n) asm volatile("s_waitcnt lgkmcnt(" #n ")" ::: "memory")
#define PG8_BAR __builtin_amdgcn_s_barrier()
#define PG8_SCHED __builtin_amdgcn_sched_barrier(0)
    Unit cur, nxt; int ui = 0;
    if (!S.next(0, cur)) return;
    f32x4 acc[2][2][4][2];
#pragma unroll
    for (int a = 0; a < 2; ++a)
#pragma unroll
        for (int b = 0; b < 2; ++b)
#pragma unroll
            for (int m = 0; m < 4; ++m)
#pragma unroll
                for (int n = 0; n < 2; ++n) acc[a][b][m][n] = (f32x4){0.f, 0.f, 0.f, 0.f};
    bf16x8 At[4][2], B0[2][2], B1[2][2];
    const char* cA = (const char*)g.A + (size_t)cur.pm * tstepA; const char* cB = (const char*)g.Bt + (size_t)cur.pn * tstepB;
    PG8_STAGE(PG8_SB(0, 0), cB, voffB); PG8_STAGE(PG8_SB(0, 1), cB + hstepB, voffB); PG8_STAGE(PG8_SA(0, 0), cA, voffA); PG8_STAGE(PG8_SA(0, 1), cA + hstepA, voffA);
    if (wr == 1) PG8_BAR;
    PG8_WAIT_V(2); PG8_BAR;
    PG8_STAGE(PG8_SB(1, 0), cB + kstep, voffB); PG8_STAGE(PG8_SA(1, 0), cA + kstep, voffA); PG8_STAGE(PG8_SB(1, 1), cB + hstepB + kstep, voffB);
    PG8_WAIT_V(6); PG8_BAR;
    for (;;) {
        const bool has_next = S.next(ui + 1, nxt);
        const char* nA = has_next ? (const char*)g.A + (size_t)nxt.pm * tstepA : cA; const char* nB = has_next ? (const char*)g.Bt + (size_t)nxt.pn * tstepB : cB;
        for (int t = 0; t < nt; t += 2) {
            const bool last = (t == nt - 2);
            const char* a1 = cA + (size_t)(t + 1) * kstep;
            const char* a2 = last ? nA : cA + (size_t)(t + 2) * kstep; const char* b2 = last ? nB : cB + (size_t)(t + 2) * kstep;
            const char* a3 = a2 + kstep; const char* b3 = b2 + kstep;
            PG8_LDB(B0, 0, 0); PG8_LDB(B1, 0, 1); PG8_SCHED; PG8_LDA(At, 0, 0); PG8_STAGE(PG8_SA(1, 1), a1 + hstepA, voffA);
            PG8_WAIT_V(8); PG8_WAIT_L(0); PG8_BAR; PG8_MMA(0, 0, At, B0); PG8_MMA(0, 1, At, B1); PG8_BAR; PG8_SCHED;
            PG8_LDA(At, 0, 1); PG8_STAGE(PG8_SB(0, 0), b2, voffB); PG8_STAGE(PG8_SB(0, 1), b2 + hstepB, voffB); PG8_STAGE(PG8_SA(0, 0), a2, voffA);
            PG8_WAIT_V(8); PG8_WAIT_L(0); PG8_BAR; PG8_MMA(1, 0, At, B0); PG8_MMA(1, 1, At, B1); PG8_BAR; PG8_SCHED;
            PG8_LDB(B0, 1, 0); PG8_LDB(B1, 1, 1); PG8_SCHED; PG8_LDA(At, 1, 0); PG8_STAGE(PG8_SA(0, 1), a2 + hstepA, voffA);
            PG8_WAIT_V(8); PG8_WAIT_L(0); PG8_BAR; PG8_MMA(0, 0, At, B0); PG8_MMA(0, 1, At, B1); PG8_BAR; PG8_SCHED;
            PG8_LDA(At, 1, 1); PG8_STAGE(PG8_SB(1, 0), b3, voffB); PG8_STAGE(PG8_SB(1, 1), b3 + hstepB, voffB); PG8_STAGE(PG8_SA(1, 0), a3, voffA);
            PG8_WAIT_V(8); PG8_WAIT_L(0); PG8_BAR; PG8_MMA(1, 0, At, B0); PG8_MMA(1, 1, At, B1); PG8_BAR; PG8_SCHED;
        }
        if (wr == 0) PG8_BAR;
        run_epi(E, lds, acc, cur, wr, wc, fr, fq);
        if (!has_next) break;
#pragma unroll
        for (int a = 0; a < 2; ++a)
#pragma unroll
            for (int b = 0; b < 2; ++b)
#pragma unroll
                for (int m = 0; m < 4; ++m)
#pragma unroll
                    for (int n = 0; n < 2; ++n) acc[a][b][m][n] = (f32x4){0.f, 0.f, 0.f, 0.f};
        cur = nxt; cA = nA; cB = nB; ++ui;
        if (wr == 1) PG8_BAR;
    }
    PG8_WAIT_V(0);
    PG8_BAR;
#undef PG8_SA
#undef PG8_SB
#undef PG8_STAGE
#undef PG8_LDA
#undef PG8_LDB
#undef PG8_MMA
#undef PG8_WAIT_V
#undef PG8_WAIT_L
#undef PG8_BAR
#undef PG8_SCHED
}

__device__ __forceinline__ float row_rstd(const float* ssq, int row) {
    const f32x4 s0 = *(const f32x4*)(ssq + (size_t)row * 4);
    const float ss = (s0[0] + s0[1]) + (s0[2] + s0[3]);
    return rsqrtf(ss * (1.0f / 1024.0f) + 1e-6f);
}
struct EpiZ {
    bf16_t* z; const float* ssq; bf16_t* vt; int vt_ld;
    __device__ __forceinline__ void operator()(const f32x4 (&acc)[2][2][4][2], const Unit& u, int wr, int wc, int fr, int fq) const {
        const int row0 = u.pm * BM + wr * 64 + fr, col0 = u.pn * BM + wc * 32 + 8 * fq;
#pragma unroll
        for (int ai = 0; ai < 2; ++ai)
#pragma unroll
            for (int m = 0; m < 4; ++m) {
                const int row = row0 + ai * HALF + m * 16; const float rs = row_rstd(ssq, row);
#pragma unroll
                for (int bj = 0; bj < 2; ++bj) {
                    const u32x4 w = pack8(acc[ai][bj][m][0] * rs, acc[ai][bj][m][1] * rs);
                    *(u32x4*)(z + (size_t)row * ZSTR + col0 + bj * HALF) = w;
                }
            }
    }
};
struct EpiGlu {
    bf16_t* z;
    __device__ __forceinline__ void operator()(const f32x4 (&acc)[2][2][4][2], const Unit& u, int wr, int wc, int fr, int fq) const {
        const int row0 = u.pm * BM + wr * 64 + fr, col0 = wc * 32 + 8 * fq;
#pragma unroll
        for (int ai = 0; ai < 2; ++ai) {
            u32x4 yv[4][2];
#pragma unroll
            for (int m = 0; m < 4; ++m)
#pragma unroll
                for (int bj = 0; bj < 2; ++bj) yv[m][bj] = *(const u32x4*)(z + (size_t)(row0 + ai * HALF + m * 16) * ZSTR + col0 + bj * HALF + 512);
#pragma unroll
            for (int m = 0; m < 4; ++m) {
                const int row = row0 + ai * HALF + m * 16;
#pragma unroll
                for (int bj = 0; bj < 2; ++bj) {
                    bf16_t* zp = z + (size_t)row * ZSTR + col0 + bj * HALF;
                    const u32x4 y = yv[m][bj];
                    const f32x4 a0 = acc[ai][bj][m][0], a1 = acc[ai][bj][m][1];
                    f32x4 o0, o1;
                    o0[0] = bflo(y.x) * sigm(a0[0]); o0[1] = bfhi(y.x) * sigm(a0[1]); o0[2] = bflo(y.y) * sigm(a0[2]); o0[3] = bfhi(y.y) * sigm(a0[3]);
                    o1[0] = bflo(y.z) * sigm(a1[0]); o1[1] = bfhi(y.z) * sigm(a1[1]); o1[2] = bflo(y.w) * sigm(a1[2]); o1[3] = bfhi(y.w) * sigm(a1[3]);
                    *(u32x4*)zp = pack8(o0, o1);
                }
            }
        }
    }
};
template <int MODE> struct EpiMix {
    bf16_t* z; int goff;
    __device__ __forceinline__ void operator()(const f32x4 (&acc)[2][2][4][2], const Unit& u, int wr, int wc, int fr, int fq) const {
        const int row0 = u.pm * BM + wr * 64 + fr, col0 = u.pn * BM + wc * 32 + 8 * fq;
#pragma unroll
        for (int ai = 0; ai < 2; ++ai)
#pragma unroll
            for (int mp = 0; mp < 2; ++mp) {
                u32x4 gv[2][2], pv[2][2];
#pragma unroll
                for (int mm = 0; mm < 2; ++mm)
#pragma unroll
                    for (int bj = 0; bj < 2; ++bj) { const bf16_t* zr = z + (size_t)(row0 + ai * HALF + (mp * 2 + mm) * 16) * ZSTR + col0 + bj * HALF;
                        gv[mm][bj] = *(const u32x4*)(zr + goff); if (MODE == 1) pv[mm][bj] = *(const u32x4*)(zr + 1024); }
#pragma unroll
                for (int mm = 0; mm < 2; ++mm) {
                    const int m = mp * 2 + mm; const int row = row0 + ai * HALF + m * 16;
#pragma unroll
                    for (int bj = 0; bj < 2; ++bj) {
                        bf16_t* zr = z + (size_t)row * ZSTR + col0 + bj * HALF;
                        const u32x4 gq = gv[mm][bj];
                        const f32x4 a0 = acc[ai][bj][m][0], a1 = acc[ai][bj][m][1];
                        f32x4 o0, o1;
                        o0[0] = sigm(bflo(gq.x)) * a0[0]; o0[1] = sigm(bfhi(gq.x)) * a0[1]; o0[2] = sigm(bflo(gq.y)) * a0[2]; o0[3] = sigm(bfhi(gq.y)) * a0[3];
                        o1[0] = sigm(bflo(gq.z)) * a1[0]; o1[1] = sigm(bfhi(gq.z)) * a1[1]; o1[2] = sigm(bflo(gq.w)) * a1[2]; o1[3] = sigm(bfhi(gq.w)) * a1[3];
                        if (MODE == 1) { const u32x4 p = pv[mm][bj];
                            o0[0] += bflo(p.x); o0[1] += bfhi(p.x); o0[2] += bflo(p.y); o0[3] += bfhi(p.y); o1[0] += bflo(p.z); o1[1] += bfhi(p.z); o1[2] += bflo(p.w); o1[3] += bfhi(p.w); }
                        *(u32x4*)(zr + 1024) = pack8(o0, o1);
                    }
                }
            }
    }
};
struct EpiRes {
    float* h; bf16_t* hb; float* ssq; LAS float* red;
    __device__ __forceinline__ void operator()(const f32x4 (&acc)[2][2][4][2], const Unit& u, int wr, int wc, int fr, int fq) const {
        const int row0 = u.pm * BM + wr * 64 + fr, col0 = u.pn * BM + wc * 32 + 8 * fq;
#pragma unroll
        for (int ai = 0; ai < 2; ++ai)
#pragma unroll
            for (int mp = 0; mp < 2; ++mp) {
                f32x4 hv[2][2][2];
#pragma unroll
                for (int mm = 0; mm < 2; ++mm)
#pragma unroll
                    for (int bj = 0; bj < 2; ++bj) { const float* hp = h + (size_t)(row0 + ai * HALF + (mp * 2 + mm) * 16) * 1024 + col0 + bj * HALF; hv[mm][bj][0] = *(const f32x4*)hp; hv[mm][bj][1] = *(const f32x4*)(hp + 4); }
#pragma unroll
                for (int mm = 0; mm < 2; ++mm) {
                    const int m = mp * 2 + mm; const int row = row0 + ai * HALF + m * 16; float part = 0.f;
#pragma unroll
                    for (int bj = 0; bj < 2; ++bj) {
                        float* hp = h + (size_t)row * 1024 + col0 + bj * HALF;
                        const f32x4 h0 = hv[mm][bj][0] + acc[ai][bj][m][0], h1 = hv[mm][bj][1] + acc[ai][bj][m][1];
                        *(f32x4*)hp = h0; *(f32x4*)(hp + 4) = h1;
                        part += (h0[0] * h0[0] + h0[1] * h0[1]) + (h0[2] * h0[2] + h0[3] * h0[3]) + (h1[0] * h1[0] + h1[1] * h1[1]) + (h1[2] * h1[2] + h1[3] * h1[3]);
                        *(u32x4*)(hb + (size_t)row * 1024 + col0 + bj * HALF) = pack8(h0, h1);
                    }
                    part += __shfl_xor(part, 16); part += __shfl_xor(part, 32);
                    if (fq == 0) red[(ai * HALF + wr * 64 + m * 16 + fr) * 4 + wc] = part;
                }
            }
        asm volatile("s_waitcnt lgkmcnt(0)" ::: "memory");
        __builtin_amdgcn_s_barrier();
        asm volatile("" ::: "memory");
        { const int t_ = opaque_tid(); if (t_ < 256) { const f32x4 r4 = *(const LAS f32x4*)(red + t_ * 4); ssq[(size_t)(u.pm * BM + t_) * 4 + u.pn] = (r4[0] + r4[1]) + (r4[2] + r4[3]); } }
    }
};
struct EpiAct {
    bf16_t* act; const float* ssq;
    __device__ __forceinline__ void operator()(const f32x4 (&acc)[2][2][4][2], const Unit& u, int wr, int wc, int fr, int fq) const {
        const int row0 = u.pm * BM + wr * 64 + fr, col0 = u.pn * HALF + wc * 32 + 8 * fq;
#pragma unroll
        for (int ai = 0; ai < 2; ++ai)
#pragma unroll
            for (int m = 0; m < 4; ++m) {
                const int row = row0 + ai * HALF + m * 16; const float rs = row_rstd(ssq, row);
                f32x4 o[2];
#pragma unroll
                for (int n = 0; n < 2; ++n)
#pragma unroll
                    for (int i = 0; i < 4; ++i) { const float gg = acc[ai][0][m][n][i] * rs, uu = acc[ai][1][m][n][i] * rs; o[n][i] = gg * sigm(gg) * uu; }
                *(u32x4*)(act + (size_t)row * 2816 + col0) = pack8(o[0], o[1]);
            }
    }
};
struct UberEpi { int mode, i0; unsigned char *p0, *p1, *p2; };
__device__ __forceinline__ void run_epi(const UberEpi& E, LAS unsigned char* lds, const f32x4 (&acc)[2][2][4][2], const Unit& u, int wr, int wc, int fr, int fq) {
    switch (E.mode) {
        case 0: { EpiZ e{(bf16_t*)E.p0, (const float*)E.p1, (bf16_t*)E.p2, E.i0}; e(acc, u, wr, wc, fr, fq); break; }
        case 1: { EpiGlu e{(bf16_t*)E.p0}; e(acc, u, wr, wc, fr, fq); break; }
        case 2: { EpiMix<0> e{(bf16_t*)E.p0, E.i0}; e(acc, u, wr, wc, fr, fq); break; }
        case 3: { EpiMix<1> e{(bf16_t*)E.p0, E.i0}; e(acc, u, wr, wc, fr, fq); break; }
        case 4: { EpiRes e{(float*)E.p0, (bf16_t*)E.p1, (float*)E.p2, (LAS float*)(lds + 131072)}; e(acc, u, wr, wc, fr, fq); break; }
        default: { EpiAct e{(bf16_t*)E.p0, (const float*)E.p1}; e(acc, u, wr, wc, fr, fq); break; }
    }
}
}

constexpr int NLAYER = 4, DM = 1024, ZN = 6144, ZW = 6208  , FFH = 2816, RG = 16384, RMAIN = 65536, VTLD = RG + 64  ;
constexpr size_t al256(size_t x) { return (x + 255) & ~(size_t)255; }
constexpr size_t WS_HB = 0;
constexpr size_t WS_SSQ = WS_HB + (size_t)RMAIN * DM * 2;
constexpr size_t WS_Z = WS_SSQ + (size_t)RMAIN * 4 * 4;
constexpr size_t WS_YB = WS_Z + (size_t)RG * ZW * 2;
constexpr size_t WS_VT = WS_YB + (size_t)RG * 512 * 2;
constexpr size_t WS_HGU = WS_VT + (size_t)512 * VTLD * 2;
constexpr size_t WS_HGP = WS_HGU + (size_t)260 * 8 * 4096 * 4;
constexpr size_t WS_S5S = WS_HGP + (size_t)260 * 8 * 64 * 4;
constexpr size_t WS_W = WS_S5S + (size_t)260 * 2048 * 8;
constexpr size_t W_IN = 0, W_UPA = W_IN + (size_t)6144 * 1024 * 2, W_UPB = W_UPA + (size_t)1024 * 256 * 2, W_UPC = W_UPB + (size_t)1024 * 512 * 2,
                 W_O = W_UPC + (size_t)1024 * 256 * 2, W_GU = W_O + (size_t)1024 * 1024 * 2, W_DN = W_GU + (size_t)5632 * 1024 * 2, W_GLU = W_DN + (size_t)1024 * 2816 * 2,
                 W_END = W_GLU + (size_t)256 * 256 * 2;
constexpr size_t WS_TAB = WS_W + W_END;
constexpr size_t T_LBAR = 0, T_L16 = T_LBAR + 2048 * 8, T_L64 = T_L16 + 2048 * 8, T_BFRAG = T_L64 + 2048 * 8, T_CFRAG = T_BFRAG + (size_t)32 * 8 * 64 * 16,
                 T_LB = T_CFRAG + (size_t)32 * 4 * 64 * 16, T_END = T_LB + 256 * 4;
constexpr size_t WS_META = al256(WS_TAB + T_END);
constexpr size_t M_H = 0, M_HB = M_H + (size_t)256 * 1024 * 4, M_SSQ = M_HB + (size_t)256 * 1024 * 2, M_Z = M_SSQ + (size_t)256 * 4 * 4, M_YB = M_Z + (size_t)256 * ZW * 2,
                 M_VT = M_YB + (size_t)256 * 512 * 2, M_ACT = M_VT + (size_t)512 * 256 * 2, M_END = M_ACT + (size_t)256 * FFH * 2;
constexpr size_t WS_CTL = al256(WS_META + M_END);
constexpr size_t CTL_BYTES = 16384;
constexpr size_t WS_TOTAL = WS_CTL + CTL_BYTES;
constexpr int LDS_ST_OFF = 135168;
constexpr int LDS_BYTES = 147456;

struct Args {
    const float *x_prompt, *x_sample, *meta_tokens, *norm1_g, *w_in, *a_re, *a_im, *log_dt, *b_re, *b_im, *c_re, *c_im, *s5_d, *w_glu, *rpb, *lb_logits, *onorm_g,
        *w_up_a, *w_up_b, *w_up_c, *w_o, *norm2_g, *w_gate, *w_up, *w_down, *final_g;
    float* out; unsigned char* ws;
};

__device__ __forceinline__ unsigned long long ufl(unsigned long long v) { const unsigned lo = __builtin_amdgcn_readfirstlane((unsigned)v), hi = __builtin_amdgcn_readfirstlane((unsigned)(v >> 32)); return ((unsigned long long)hi << 32) | lo; }
#define GAS __attribute__((address_space(1)))
template <int OFF> __device__ __forceinline__ unsigned long long ka_load() {
    unsigned long long v; const unsigned long long kp = ufl((unsigned long long)__builtin_amdgcn_kernarg_segment_ptr());
    asm volatile("s_load_dwordx2 %0, %1, %2\n\ts_waitcnt lgkmcnt(0)" : "=s"(v) : "s"(kp), "n"(OFF));
    return v;
}
#define KA(f) ((decltype(Args::f))(GAS char*)ka_load<(int)__builtin_offsetof(Args, f)>())
#define KAF(f) ((const float*)KA(f))
struct Ctx {
    bf16_t *hb, *z, *yb, *vt; float *ssq, *hgu, *hgp, *s5s;
    bf16_t *w; const float *lbar, *l16, *l64; const bf16_t *bfrag, *cfrag; const float* lb;
    float* mh; bf16_t *mhb, *mz, *myb, *mvt, *mact; float* mssq;
};

__device__ __forceinline__ void tr_item(const float* W, int K, int N, bf16_t* WT, const float* kscale, int mode, LAS float* scr, int item, int lane, bool valid) {
    const int nblk = N / 32, kb = item / nblk, nb = item % nblk, k0 = 64 * kb, n0 = 32 * nb;
    if (valid) {
#pragma unroll 8
    for (int i = 0; i < 32; ++i) { const int kk = 2 * i + (lane >> 5); float v = W[(size_t)(k0 + kk) * N + n0 + (lane & 31)]; if (kscale) v *= kscale[k0 + kk]; scr[kk * 33 + (lane & 31)] = v; }
    }
    __syncthreads();
    const int c = lane & 7;
    int drow0 = n0; if (mode) drow0 = (n0 >> 7) * 256 + (n0 & 127) + (mode == 2 ? 128 : 0);
    if (valid) {
#pragma unroll
    for (int j = 0; j < 4; ++j) { const int n = (lane >> 3) + 8 * j; const LAS float* s = scr + (8 * c) * 33 + n;
        u32x4 o; o.x = pk2(s[0 * 33], s[1 * 33]); o.y = pk2(s[2 * 33], s[3 * 33]); o.z = pk2(s[4 * 33], s[5 * 33]); o.w = pk2(s[6 * 33], s[7 * 33]);
        *(u32x4*)(WT + (size_t)(drow0 + n) * K + k0 + 8 * c) = o; }
    }
    __syncthreads();
}

__device__ __forceinline__ void prep_layer(const Ctx& X, int l, LAS unsigned char* lds, int G) {
    const int tid_ = opaque_tid(); const int wave = __builtin_amdgcn_readfirstlane(tid_ >> 6), lane = tid_ & 63;
    LAS float* scr = (LAS float*)(lds + wave * 16384);
    const int gw = blockIdx.x * 8 + wave, NGW = G * 8;
    constexpr int I0 = 16 * 192, I1 = 4 * 32, I2 = 8 * 32, I3 = 4 * 32, I4 = 16 * 32, I5 = 16 * 88, I6 = 16 * 88, I7 = 44 * 32, I8 = 4 * 8;
    constexpr int NIT = I0 + I1 + I2 + I3 + I4 + I5 + I6 + I7 + I8;
    unsigned char* wb = (unsigned char*)X.w;
    for (int it0 = 0; it0 < NIT; it0 += NGW) {
        const int it = it0 + gw; const bool valid = it < NIT;
        int r = valid ? it : 0;
        if (r < I0) { tr_item(KAF(w_in) + (size_t)l * 1024 * 6144, 1024, 6144, (bf16_t*)(wb + W_IN), KAF(norm1_g) + l * 1024, 0, scr, r, lane, valid); continue; } r -= I0;
        if (r < I1) { tr_item(KAF(w_up_a) + (size_t)l * 256 * 1024, 256, 1024, (bf16_t*)(wb + W_UPA), nullptr, 0, scr, r, lane, valid); continue; } r -= I1;
        if (r < I2) { tr_item(KAF(w_up_b) + (size_t)l * 512 * 1024, 512, 1024, (bf16_t*)(wb + W_UPB), nullptr, 0, scr, r, lane, valid); continue; } r -= I2;
        if (r < I3) { tr_item(KAF(w_up_c) + (size_t)l * 256 * 1024, 256, 1024, (bf16_t*)(wb + W_UPC), nullptr, 0, scr, r, lane, valid); continue; } r -= I3;
        if (r < I4) { tr_item(KAF(w_o) + (size_t)l * 1024 * 1024, 1024, 1024, (bf16_t*)(wb + W_O), nullptr, 0, scr, r, lane, valid); continue; } r -= I4;
        if (r < I5) { tr_item(KAF(w_gate) + (size_t)l * 1024 * 2816, 1024, 2816, (bf16_t*)(wb + W_GU), KAF(norm2_g) + l * 1024, 1, scr, r, lane, valid); continue; } r -= I5;
        if (r < I6) { tr_item(KAF(w_up) + (size_t)l * 1024 * 2816, 1024, 2816, (bf16_t*)(wb + W_GU), KAF(norm2_g) + l * 1024, 2, scr, r, lane, valid); continue; } r -= I6;
        if (r < I7) { tr_item(KAF(w_down) + (size_t)l * 2816 * 1024, 2816, 1024, (bf16_t*)(wb + W_DN), nullptr, 0, scr, r, lane, valid); continue; } r -= I7;
        tr_item(KAF(w_glu) + (size_t)l * 256 * 256, 256, 256, (bf16_t*)(wb + W_GLU), nullptr, 0, scr, r, lane, valid);
    }
    const int gt = blockIdx.x * 512 + tid_;
    if (gt < 2048) {
        const int dg = gt >> 6, p = gt & 63;
        const size_t pb = ((size_t)l * 32 + dg);
        const float are = KAF(a_re)[pb * 64 + p], aim = KAF(a_im)[pb * 64 + p], dt = expf(KAF(log_dt)[pb]);
        const float mag = expf(are * dt); float sn, cs; sincosf(aim * dt, &sn, &cs);
        const float lr = mag * cs, li = mag * sn;
        const float den = are * are + aim * aim, nr = lr - 1.0f, ni = li;
        const float zr = (nr * are + ni * aim) / den, zi = (ni * are - nr * aim) / den;
        float* lbar = (float*)X.lbar; float* l16 = (float*)X.l16; float* l64 = (float*)X.l64;
        lbar[gt * 2] = lr; lbar[gt * 2 + 1] = li;
        float pr = lr, pi = li;
#pragma unroll
        for (int s = 0; s < 4; ++s) { const float t = pr * pr - pi * pi; pi = 2.f * pr * pi; pr = t; }
        l16[gt * 2] = pr; l16[gt * 2 + 1] = pi;
#pragma unroll
        for (int s = 0; s < 2; ++s) { const float t = pr * pr - pi * pi; pi = 2.f * pr * pi; pr = t; }
        l64[gt * 2] = pr; l64[gt * 2 + 1] = pi;
        bf16_t* bfr = (bf16_t*)X.bfrag; bf16_t* cfr = (bf16_t*)X.cfrag;
        const int ntr = p >> 4, col = p & 15;
        for (int c = 0; c < 16; ++c) {
            const float br = KAF(b_re)[(pb * 64 + p) * 16 + c], bi = KAF(b_im)[(pb * 64 + p) * 16 + c];
            const float bbr = zr * br - zi * bi, bbi = zr * bi + zi * br;
            const int q = c >> 3, j = c & 7;
            bfr[(((size_t)dg * 8 + ntr) * 64 + col + 16 * q) * 8 + j] = (bf16_t)f2bf(bbr);
            bfr[(((size_t)dg * 8 + 4 + ntr) * 64 + col + 16 * q) * 8 + j] = (bf16_t)f2bf(bbi);
            bfr[(((size_t)dg * 8 + ntr) * 64 + col + 16 * (q + 2)) * 8 + j] = 0;
            bfr[(((size_t)dg * 8 + 4 + ntr) * 64 + col + 16 * (q + 2)) * 8 + j] = 0;
            const float cr = KAF(c_re)[(pb * 16 + c) * 64 + p], ci = KAF(c_im)[(pb * 16 + c) * 64 + p];
            { const int k = p;      cfr[(((size_t)dg * 4 + (k >> 5)) * 64 + c + 16 * ((k >> 3) & 3)) * 8 + (k & 7)] = (bf16_t)f2bf(cr); }
            { const int k = 64 + p; cfr[(((size_t)dg * 4 + (k >> 5)) * 64 + c + 16 * ((k >> 3) & 3)) * 8 + (k & 7)] = (bf16_t)f2bf(-ci); }
        }
    }
    if (gt >= 2048 && gt < 2048 + 256) {
        const int c = gt - 2048;
        const float l0 = KAF(lb_logits)[c], l1 = KAF(lb_logits)[256 + c], l2 = KAF(lb_logits)[512 + c], l3 = KAF(lb_logits)[768 + c];
        const float mx = fmaxf(fmaxf(l0, l1), fmaxf(l2, l3));
        const float e0 = expf(l0 - mx), e1 = expf(l1 - mx), e2 = expf(l2 - mx), e3 = expf(l3 - mx), inv = 1.f / (e0 + e1 + e2 + e3);
        float v = 0.f; if (l >= 1) v += e1 * inv; if (l >= 2) v += e2 * inv; if (l >= 3) v += e3 * inv;
        ((float*)X.lb)[c] = v;
    }
}

struct Grp { int g, nseq, Lr, nch, s0; };
__device__ __forceinline__ Grp make_grp(int g) { Grp r; r.g = g; r.nseq = g < 2 ? 4 : 1; r.Lr = g < 2 ? 4096 : 16384; r.nch = r.Lr / 64 + 1; r.s0 = g < 2 ? g * 4 : 8 + (g - 2); return r; }

template <bool OUT>
__device__ __forceinline__ void s5_chunk(const Ctx& X, const float* s5d, LAS float* buf, bf16_t* zc, int T, int ci, int wave, int lane) {
    const int p = lane, fr = lane & 15, fq = lane >> 4;
    for (int gi = 0; gi < 2; ++gi) {
        const int g = wave * 2 + gi;
        f32x4 yacc[2][2];
#pragma unroll
        for (int i = 0; i < 2; ++i)
#pragma unroll
            for (int j = 0; j < 2; ++j) yacc[i][j] = (f32x4){0.f, 0.f, 0.f, 0.f};
        bf16x8 ua[4];
#pragma unroll
        for (int m4 = 0; m4 < 4; ++m4) { ua[m4] = (bf16x8){0, 0, 0, 0, 0, 0, 0, 0}; if (fq < 2 && m4 * 16 < T) ua[m4] = *(const bf16x8*)(zc + (size_t)(m4 * 16 + fr) * ZW + g * 16 + fq * 8); }
        bf16x8 bfr2[2][8]; float lr2[2], li2[2], xr2[2], xi2[2];
#pragma unroll
        for (int dir = 0; dir < 2; ++dir) {
            const int dg = dir * 16 + g;
#pragma unroll
            for (int nt = 0; nt < 8; ++nt) bfr2[dir][nt] = *(const bf16x8*)(X.bfrag + (((size_t)dg * 8 + nt) * 64 + lane) * 8);
            lr2[dir] = X.lbar[(dg * 64 + p) * 2]; li2[dir] = X.lbar[(dg * 64 + p) * 2 + 1];
            xr2[dir] = 0.f; xi2[dir] = 0.f;
            if (OUT) { const float* st0 = X.s5s + ((size_t)ci * 2048 + dg * 64 + p) * 2; xr2[dir] = st0[0]; xi2[dir] = st0[1]; }
        }
#pragma unroll
        for (int dir = 0; dir < 2; ++dir) {
            const int dg = dir * 16 + g;
            const bf16x8 (&bfr)[8] = bfr2[dir];
            bf16x8 cfr[4];
            if (OUT) {
#pragma unroll
                for (int ks = 0; ks < 4; ++ks) cfr[ks] = *(const bf16x8*)(X.cfrag + (((size_t)dg * 4 + ks) * 64 + lane) * 8);
            }
            const float lr = lr2[dir], li = li2[dir];
            float xr = xr2[dir], xi = xi2[dir];
            float* st = X.s5s + ((size_t)ci * 2048 + dg * 64 + p) * 2;
#pragma unroll
            for (int sti = 0; sti < 2; ++sti) {
                const int stt = dir ? 1 - sti : sti; const int t0 = stt * 32;
                if (t0 < T) {
                    const int tn = (T - t0) < 32 ? (T - t0) : 32;
#pragma unroll
                    for (int mt = 0; mt < 2; ++mt) {
                        if (mt * 16 < tn) {
#pragma unroll
                            for (int nt = 0; nt < 8; ++nt) {
                                const f32x4 c = __builtin_amdgcn_mfma_f32_16x16x32_bf16(ua[stt * 2 + mt], bfr[nt], (f32x4){0.f, 0.f, 0.f, 0.f}, 0, 0, 0);
#pragma unroll
                                for (int r = 0; r < 4; ++r) buf[(mt * 16 + fq * 4 + r) * 132 + nt * 16 + fr] = c[r];
                            }
                        }
                    }
                    __syncthreads();
                    for (int k0 = 0; k0 < tn; k0 += 8) {
                        float br[8], bi[8];
#pragma unroll
                        for (int j = 0; j < 8; ++j) { const int t = dir ? (tn - 1 - k0 - j) : k0 + j; br[j] = buf[t * 132 + p]; bi[j] = buf[t * 132 + 64 + p]; }
#pragma unroll
                        for (int j = 0; j < 8; ++j) {
                            const int t = dir ? (tn - 1 - k0 - j) : k0 + j;
                            const float nr = lr * xr - li * xi + br[j], ni = lr * xi + li * xr + bi[j];
                            xr = nr; xi = ni;
                            if (OUT) { buf[t * 132 + p] = xr; buf[t * 132 + 64 + p] = xi; }
                        }
                    }
                    if (OUT) {
                        __syncthreads();
#pragma unroll
                        for (int mt = 0; mt < 2; ++mt) {
                            if (mt * 16 < tn) {
#pragma unroll
                                for (int ks = 0; ks < 4; ++ks) {
                                    const LAS float* ap = buf + (mt * 16 + fr) * 132 + ks * 32 + fq * 8;
                                    const f32x4 a0 = *(const LAS f32x4*)ap, a1 = *(const LAS f32x4*)(ap + 4);
                                    const u32x4 aw = pack8(a0, a1);
                                    const bf16x8 av = __builtin_bit_cast(bf16x8, aw);
                                    yacc[stt][mt] = __builtin_amdgcn_mfma_f32_16x16x32_bf16(av, cfr[ks], yacc[stt][mt], 0, 0, 0);
                                }
                            }
                        }
                    }
                    __syncthreads();
                }
            }
            if (!OUT) { st[0] = xr; st[1] = xi; }
        }
        if (OUT) {
            const float dsk = s5d[g * 16 + fr];
            float uv[16];
#pragma unroll
            for (int q4 = 0; q4 < 4; ++q4)
#pragma unroll
                for (int r = 0; r < 4; ++r) { uv[q4 * 4 + r] = 0.f; if (q4 * 16 < T) uv[q4 * 4 + r] = bf2f(zc[(size_t)(q4 * 16 + fq * 4 + r) * ZW + g * 16 + fr]); }
#pragma unroll
            for (int stt = 0; stt < 2; ++stt)
#pragma unroll
                for (int mt = 0; mt < 2; ++mt) {
                    if (stt * 32 + mt * 16 < T) {
#pragma unroll
                        for (int r = 0; r < 4; ++r) {
                            const int t = stt * 32 + mt * 16 + fq * 4 + r;
                            const float y = gelu_tanh(yacc[stt][mt][r] + dsk * uv[(stt * 2 + mt) * 4 + r]);
                            zc[(size_t)t * ZW + 512 + g * 16 + fr] = (bf16_t)f2bf(y);
                        }
                    }
                }
        }
    }
}

__device__ __forceinline__ void s5_passB(const Ctx& X, const Grp& gp, int gtid, int GT) {
    const int n = gp.nseq * 2048;
    for (int e = gtid; e < n; e += GT) {
        const int sl = e >> 11, r = e & 2047, dir = r >> 10;
        const float l16r = X.l16[r * 2], l16i = X.l16[r * 2 + 1], l64r = X.l64[r * 2], l64i = X.l64[r * 2 + 1];
        float* base = X.s5s + ((size_t)(sl * gp.nch) * 2048 + r) * 2; const long cstep = dir ? -4096 : 4096; float* first = dir ? base + (size_t)(gp.nch - 1) * 4096 : base;
        float sr = 0.f, si = 0.f;
        float er[2][8], ei[2][8];
#pragma unroll
        for (int j = 0; j < 8; ++j) { er[0][j] = 0.f; ei[0][j] = 0.f; if (j < gp.nch) { const float* pp = first + (long)j * cstep; er[0][j] = pp[0]; ei[0][j] = pp[1]; } }
        for (int k0 = 0; k0 < gp.nch; k0 += 16) {
#pragma unroll
            for (int hb = 0; hb < 2; ++hb) {
                const int kb = k0 + hb * 8;
                if (kb < gp.nch) {
#pragma unroll
                    for (int j = 0; j < 8; ++j) { const int k = kb + 8 + j; er[1 - hb][j] = 0.f; ei[1 - hb][j] = 0.f; if (k < gp.nch) { const float* pp = first + (long)k * cstep; er[1 - hb][j] = pp[0]; ei[1 - hb][j] = pp[1]; } }
#pragma unroll
                    for (int j = 0; j < 8; ++j) { const int k = kb + j; if (k < gp.nch) { float* pp = first + (long)k * cstep; pp[0] = sr; pp[1] = si;
                            const int c = dir ? gp.nch - 1 - k : k;
                            const float pr = c == 0 ? l16r : l64r, pi = c == 0 ? l16i : l64i;
                            const float nr = pr * sr - pi * si + er[hb][j], ni = pr * si + pi * sr + ei[hb][j]; sr = nr; si = ni; } }
                }
            }
        }
    }
}

typedef short v4i16_t __attribute__((ext_vector_type(4)));
__device__ __forceinline__ v4i16_t vtr16(const LAS unsigned char* p) { return __builtin_amdgcn_ds_read_tr16_b64_v4i16((LAS v4i16_t*)p); }
template <bool OUT>
__device__ __forceinline__ void hg_chunk(const Ctx& X, LAS float* gt, LAS bf16_t* ot, const bf16_t* zc, int T, int ci, int wave, int lane) {
    const int h = wave >> 1, dir = wave & 1;
    float S[64];
    float* U = X.hgu + ((size_t)ci * 8 + wave) * 4096;
    if (OUT) {
#pragma unroll
        for (int d = 0; d < 64; ++d) S[d] = U[d * 64 + lane];
    } else {
#pragma unroll
        for (int d = 0; d < 64; ++d) S[d] = 0.f;
    }
    const float lbv = X.lb[h * 64 + lane], oml = 1.f - lbv; float P = 1.f;
    const int fcol = (dir ? 2304 : 2048) + h * 64 + lane, qcol = 1792 + h * 64 + lane, vcol = 2560 + h * 64 + lane;
    const int ns8 = T >> 3;
    bf16_t rq[8], rf[8], rv[8];
    {
        const int sb0 = dir ? (ns8 - 1) : 0;
#pragma unroll
        for (int j = 0; j < 8; ++j) { const bf16_t* zr = zc + (size_t)(sb0 * 8 + j) * ZW; rq[j] = zr[qcol]; rf[j] = zr[fcol]; rv[j] = zr[vcol]; }
    }
#pragma unroll 1
    for (int s8 = 0; s8 < ns8; ++s8) {
        const int sb = dir ? (ns8 - 1 - s8) : s8;
#pragma unroll
        for (int j = 0; j < 8; ++j) {
            const float q = bf2f(rq[j]), ff = bf2f(rf[j]);
            const float sg = sigm(ff), fg = lbv + oml * sg, kk = oml * (1.f - sg);
            gt[j * 256 + lane] = fg; gt[j * 256 + 64 + lane] = kk; gt[j * 256 + 128 + lane] = q * sigm(q); gt[j * 256 + 192 + lane] = bf2f(rv[j]);
            P *= fg;
        }
        __syncthreads();
        if (s8 + 1 < ns8) {
            const int sbn = dir ? (ns8 - 2 - s8) : s8 + 1;
#pragma unroll
            for (int j = 0; j < 8; ++j) { const bf16_t* zr = zc + (size_t)(sbn * 8 + j) * ZW; rq[j] = zr[qcol]; rf[j] = zr[fcol]; rv[j] = zr[vcol]; }
        }
#pragma unroll 1
        for (int jj = 0; jj < 8; ++jj) {
            const int j = dir ? 7 - jj : jj;
            const LAS float* gj = gt + j * 256;
            const float v = gj[192 + lane];
            float o = 0.f;
#pragma unroll
            for (int d4 = 0; d4 < 16; ++d4) {
                const f32x4 f4 = *(const LAS f32x4*)(gj + d4 * 4), k4 = *(const LAS f32x4*)(gj + 64 + d4 * 4);
#pragma unroll
                for (int i = 0; i < 4; ++i) S[d4 * 4 + i] = f4[i] * S[d4 * 4 + i] + k4[i] * v;
                if (OUT) { const f32x4 q4 = *(const LAS f32x4*)(gj + 128 + d4 * 4);
#pragma unroll
                    for (int i = 0; i < 4; ++i) o += S[d4 * 4 + i] * q4[i]; }
                if ((d4 & 3) == 3) __builtin_amdgcn_sched_barrier(0);
            }
            if (OUT) ot[(sb * 8 + j) * 64 + lane] = (bf16_t)f2bf(o);
        }
        __syncthreads();
    }
    if (!OUT) {
#pragma unroll
        for (int d = 0; d < 64; ++d) U[d * 64 + lane] = S[d];
        X.hgp[((size_t)ci * 8 + wave) * 64 + lane] = P;
    }
}

__device__ __forceinline__ void hg_passA_mfma(const Ctx& X, LAS unsigned char* wl, const bf16_t* zc, int T, int ci, int wave, int lane) {
    const int h = wave >> 1, dir = wave & 1, fq = lane >> 4, l16 = lane & 15, r8 = lane >> 3, pc = lane & 7;
    LAS unsigned char* kl = wl; LAS unsigned char* vl = wl + 4608;
    const float lbv = X.lb[h * 64 + lane], oml = 1.f - lbv;
    const int fcol = (dir ? 2304 : 2048) + h * 64 + lane, vcolb = 2560 + h * 64 + pc * 8;
    f32x4 acc[4][4];
#pragma unroll
    for (int a = 0; a < 4; ++a)
#pragma unroll
        for (int b = 0; b < 4; ++b) acc[a][b] = (f32x4){0.f, 0.f, 0.f, 0.f};
    float run = 1.f;
    const int nh = (T + 31) >> 5;
#pragma unroll 1
    for (int hh = 0; hh < nh; ++hh) {
        const int hb = dir ? hh : (nh - 1 - hh); const int t0 = hb * 32; const int tn = (T - t0) < 32 ? (T - t0) : 32;
        u32x4 vr[4];
#pragma unroll
        for (int i = 0; i < 4; ++i) { const int rr = i * 8 + r8; vr[i] = (u32x4){0u, 0u, 0u, 0u}; if (rr < tn) vr[i] = *(const u32x4*)(zc + (size_t)(t0 + rr) * ZW + vcolb); }
        __syncthreads();
#pragma unroll 1
        for (int bt = 0; bt < 2; ++bt) {
            const int j0 = (dir ? bt : 1 - bt) * 16;
            bf16_t rf[16];
#pragma unroll
            for (int j = 0; j < 16; ++j) { rf[j] = 0; if (j0 + j < tn) rf[j] = zc[(size_t)(t0 + j0 + j) * ZW + fcol]; }
#pragma unroll
            for (int jj = 0; jj < 16; ++jj) {
                const int jl = dir ? jj : 15 - jj; const int j = j0 + jl;
                float kh = 0.f;
                if (j < tn) { const float sg = sigm(bf2f(dir ? rf[jj] : rf[15 - jj])); kh = oml * (1.f - sg) * run; run *= lbv + oml * sg; }
                *(LAS bf16_t*)(kl + j * 144 + lane * 2) = (bf16_t)f2bf(kh);
            }
        }
#pragma unroll
        for (int i = 0; i < 4; ++i) *(LAS u32x4*)(vl + (i * 8 + r8) * 144 + pc * 16) = vr[i];
        __syncthreads();
        const int roff = (4 * fq + (l16 >> 2)) * 144 + (4 * (l16 & 3)) * 2;
        bf16x8 af[4];
#pragma unroll
        for (int mt = 0; mt < 4; ++mt) { const v4i16_t ta = vtr16(kl + roff + mt * 32), tb = vtr16(kl + roff + 16 * 144 + mt * 32); af[mt] = (bf16x8){ta[0], ta[1], ta[2], ta[3], tb[0], tb[1], tb[2], tb[3]}; }
#pragma unroll
        for (int nt = 0; nt < 4; ++nt) {
            const v4i16_t ta = vtr16(vl + roff + nt * 32), tb = vtr16(vl + roff + 16 * 144 + nt * 32);
            const bf16x8 bfv = (bf16x8){ta[0], ta[1], ta[2], ta[3], tb[0], tb[1], tb[2], tb[3]};
#pragma unroll
            for (int mt = 0; mt < 4; ++mt) acc[mt][nt] = __builtin_amdgcn_mfma_f32_16x16x32_bf16(af[mt], bfv, acc[mt][nt], 0, 0, 0);
        }
    }
    float* U = X.hgu + ((size_t)ci * 8 + wave) * 4096 + (4 * fq) * 64 + l16;
#pragma unroll
    for (int mt = 0; mt < 4; ++mt) {
#pragma unroll
        for (int r = 0; r < 4; ++r)
#pragma unroll
            for (int nt = 0; nt < 4; ++nt) U[(16 * mt + r) * 64 + 16 * nt] = acc[mt][nt][r];
        __builtin_amdgcn_sched_barrier(0);
    }
    X.hgp[((size_t)ci * 8 + wave) * 64 + lane] = run;
}

__device__ __forceinline__ void hg_passC_mfma(const Ctx& X, LAS unsigned char* wl, LAS bf16_t* ot, const bf16_t* zc, int T, int ci, int wave, int lane) {
    const int h = wave >> 1, dir = wave & 1, fq = lane >> 4, l16 = lane & 15, r8 = lane >> 3, pc = lane & 7;
    LAS unsigned char* ql = wl; LAS unsigned char* kl = wl + 2304; LAS unsigned char* vl = wl + 4608; LAS float* pl = (LAS float*)(wl + 6912);
    const float lbv = X.lb[h * 64 + lane], oml = 1.f - lbv;
    const int fcol = (dir ? 2304 : 2048) + h * 64 + lane, qcol = 1792 + h * 64 + lane, vcolb = 2560 + h * 64 + pc * 8;
    f32x4 sa[4][4];
    {
        const float* U = X.hgu + ((size_t)ci * 8 + wave) * 4096 + (4 * fq) * 64 + l16;
#pragma unroll
        for (int mt = 0; mt < 4; ++mt) {
#pragma unroll
            for (int r = 0; r < 4; ++r)
#pragma unroll
                for (int nt = 0; nt < 4; ++nt) sa[mt][nt][r] = U[(16 * mt + r) * 64 + 16 * nt];
            __builtin_amdgcn_sched_barrier(0);
        }
    }
    const int nsc = T >> 4;
    bf16_t rq[16], rf[16]; u32x4 vr[2];
    {
        const int I0 = dir ? (nsc - 1) : 0;
#pragma unroll
        for (int i = 0; i < 16; ++i) { const int tok = 16 * I0 + (dir ? 15 - i : i); rq[i] = zc[(size_t)tok * ZW + qcol]; rf[i] = zc[(size_t)tok * ZW + fcol]; }
#pragma unroll
        for (int i8 = 0; i8 < 2; ++i8) { const int i = i8 * 8 + r8; const int tok = 16 * I0 + (dir ? 15 - i : i); vr[i8] = *(const u32x4*)(zc + (size_t)tok * ZW + vcolb); }
    }
#pragma unroll 1
    for (int sc = 0; sc < nsc; ++sc) {
        const int I = dir ? (nsc - 1 - sc) : sc;
        __syncthreads();
        float c = 1.f;
#pragma unroll
        for (int i = 0; i < 16; ++i) {
            const float q = bf2f(rq[i]), sg = sigm(bf2f(rf[i]));
            c *= lbv + oml * sg;
            *(LAS bf16_t*)(ql + i * 144 + lane * 2) = (bf16_t)f2bf(q * sigm(q) * c);
            *(LAS bf16_t*)(kl + i * 144 + lane * 2) = (bf16_t)f2bf(oml * (1.f - sg) / c);
        }
        pl[lane] = c;
#pragma unroll
        for (int i8 = 0; i8 < 2; ++i8) *(LAS u32x4*)(vl + (i8 * 8 + r8) * 144 + pc * 16) = vr[i8];
        __syncthreads();
        if (sc + 1 < nsc) {
            const int In = dir ? (nsc - 2 - sc) : sc + 1;
#pragma unroll
            for (int i = 0; i < 16; ++i) { const int tok = 16 * In + (dir ? 15 - i : i); rq[i] = zc[(size_t)tok * ZW + qcol]; rf[i] = zc[(size_t)tok * ZW + fcol]; }
#pragma unroll
            for (int i8 = 0; i8 < 2; ++i8) { const int i = i8 * 8 + r8; const int tok = 16 * In + (dir ? 15 - i : i); vr[i8] = *(const u32x4*)(zc + (size_t)tok * ZW + vcolb); }
        }
        f32x4 at = (f32x4){0.f, 0.f, 0.f, 0.f};
#pragma unroll
        for (int ks = 0; ks < 2; ++ks) at = __builtin_amdgcn_mfma_f32_16x16x32_bf16(*(const LAS bf16x8*)(kl + l16 * 144 + (32 * ks + 8 * fq) * 2), *(const LAS bf16x8*)(ql + l16 * 144 + (32 * ks + 8 * fq) * 2), at, 0, 0, 0);
#pragma unroll
        for (int r = 0; r < 4; ++r) if (4 * fq + r > l16) at[r] = 0.f;
        const bf16x8 atf = __builtin_bit_cast(bf16x8, pack8(at, (f32x4){0.f, 0.f, 0.f, 0.f}));
        const int roff = (4 * fq + (l16 >> 2)) * 144 + (4 * (l16 & 3)) * 2;
        f32x4 oT[4];
#pragma unroll
        for (int et = 0; et < 4; ++et) {
            const v4i16_t tv = vtr16(vl + roff + et * 32);
            const bf16x8 vf = (bf16x8){tv[0], tv[1], tv[2], tv[3], 0, 0, 0, 0};
            oT[et] = __builtin_amdgcn_mfma_f32_16x16x32_bf16(vf, atf, (f32x4){0.f, 0.f, 0.f, 0.f}, 0, 0, 0);
        }
#pragma unroll
        for (int kp = 0; kp < 2; ++kp) {
            const u32x2 q0 = *(const LAS u32x2*)(ql + l16 * 144 + (32 * kp + 4 * fq) * 2), q1 = *(const LAS u32x2*)(ql + l16 * 144 + (32 * kp + 16 + 4 * fq) * 2);
            const bf16x8 qfr = __builtin_bit_cast(bf16x8, (u32x4){q0.x, q0.y, q1.x, q1.y});
#pragma unroll
            for (int nt = 0; nt < 4; ++nt) {
                const bf16x8 sf = __builtin_bit_cast(bf16x8, pack8(sa[2 * kp][nt], sa[2 * kp + 1][nt]));
                oT[nt] = __builtin_amdgcn_mfma_f32_16x16x32_bf16(sf, qfr, oT[nt], 0, 0, 0);
            }
        }
        {
            const int tok = 16 * I + (dir ? 15 - l16 : l16);
#pragma unroll
            for (int et = 0; et < 4; ++et)
#pragma unroll
                for (int r = 0; r < 4; ++r) ot[tok * 64 + 16 * et + 4 * fq + r] = (bf16_t)f2bf(oT[et][r]);
        }
        bf16x8 kf[4];
#pragma unroll
        for (int mt = 0; mt < 4; ++mt) { const v4i16_t tk = vtr16(kl + roff + mt * 32); kf[mt] = (bf16x8){tk[0], tk[1], tk[2], tk[3], 0, 0, 0, 0}; }
#pragma unroll
        for (int nt = 0; nt < 4; ++nt) {
            const v4i16_t tv = vtr16(vl + roff + nt * 32);
            const bf16x8 vf = (bf16x8){tv[0], tv[1], tv[2], tv[3], 0, 0, 0, 0};
#pragma unroll
            for (int mt = 0; mt < 4; ++mt) sa[mt][nt] = __builtin_amdgcn_mfma_f32_16x16x32_bf16(kf[mt], vf, sa[mt][nt], 0, 0, 0);
        }
#pragma unroll
        for (int mt = 0; mt < 4; ++mt) {
            const f32x4 p4 = *(const LAS f32x4*)(pl + 16 * mt + 4 * fq);
#pragma unroll
            for (int nt = 0; nt < 4; ++nt) sa[mt][nt] = sa[mt][nt] * p4;
        }
    }
}

__device__ __forceinline__ void hg_passB(const Ctx& X, const Grp& gp, int gtid, int GT) {
    const int n = gp.nseq * 32768;
    for (int e = gtid; e < n; e += GT) {
        const int sl = e >> 15, r = e & 32767, hd = r >> 12, de = r & 4095, d = de >> 6, dir = hd & 1;
        const size_t cb0 = (size_t)(sl * gp.nch) * 8 + hd; const int cstep = dir ? -8 : 8; const size_t cfirst = dir ? cb0 + (size_t)(gp.nch - 1) * 8 : cb0;
        float s = 0.f;
        float u[2][8], pv[2][8];
#pragma unroll
        for (int j = 0; j < 8; ++j) { u[0][j] = 0.f; pv[0][j] = 0.f; if (j < gp.nch) { const size_t cb = cfirst + (long)j * cstep; u[0][j] = X.hgu[cb * 4096 + de]; pv[0][j] = X.hgp[cb * 64 + d]; } }
        for (int k0 = 0; k0 < gp.nch; k0 += 16) {
#pragma unroll
            for (int hb = 0; hb < 2; ++hb) {
                const int kb = k0 + hb * 8;
                if (kb < gp.nch) {
#pragma unroll
                    for (int j = 0; j < 8; ++j) { const int k = kb + 8 + j; u[1 - hb][j] = 0.f; pv[1 - hb][j] = 0.f; if (k < gp.nch) { const size_t cb = cfirst + (long)k * cstep; u[1 - hb][j] = X.hgu[cb * 4096 + de]; pv[1 - hb][j] = X.hgp[cb * 64 + d]; } }
#pragma unroll
                    for (int j = 0; j < 8; ++j) { const int k = kb + j; if (k < gp.nch) { const size_t cb = cfirst + (long)k * cstep; X.hgu[cb * 4096 + de] = s; s = pv[hb][j] * s + u[hb][j]; } }
                }
            }
        }
    }
}

__device__ __forceinline__ void na_task(const Ctx& X, const float* rpb, const Grp& gp, int sl, int task, bool metaq, int wave, int lane, LAS unsigned char* vl) {
    const int h = wave, fr = lane & 15, fq = lane >> 4;
    const int s = gp.s0 + sl, rows = gp.Lr >> 6;
    int r = 0, n = 0, rs = 0, ks = 0;
    const bf16_t* qptr; bf16_t* optr; size_t ostride = 512;
    if (metaq) { qptr = X.mz + (size_t)(s * 16 + fr) * ZW; optr = X.myb + (size_t)(s * 16) * 512; }
    else {
        r = task >> 2; n = task & 3;
        rs = r - 4; rs = rs < 0 ? 0 : (rs > rows - 8 ? rows - 8 : rs);
        ks = 16 * n - 8; ks = ks < 0 ? 0 : (ks > 32 ? 32 : ks);
        const size_t qrow0 = (size_t)sl * gp.Lr + r * 64 + 16 * n;
        qptr = X.z + (qrow0 + fr) * ZW; optr = X.yb + qrow0 * 512;
    }
    bf16x8 qf[2];
#pragma unroll
    for (int kk = 0; kk < 2; ++kk) qf[kk] = *(const bf16x8*)(qptr + 256 + h * 64 + 32 * kk + 8 * fq);
    f32x4 sc[17];
    {
        const bf16_t* kp = X.mz + (size_t)(s * 16 + fr) * ZW + 768 + h * 64 + 8 * fq;
        f32x4 c = (f32x4){0.f, 0.f, 0.f, 0.f};
#pragma unroll
        for (int kk = 0; kk < 2; ++kk) c = __builtin_amdgcn_mfma_f32_16x16x32_bf16(*(const bf16x8*)(kp + 32 * kk), qf[kk], c, 0, 0, 0);
        sc[0] = c * 0.125f;
    }
    const int qc = 16 * n + fr;
    int wstart = qc - 8; wstart = wstart < 0 ? 0 : (wstart > 48 ? 48 : wstart);
    const size_t krow_base = (size_t)sl * gp.Lr + (size_t)rs * 64 + ks;
    if (!metaq) {
#pragma unroll
        for (int tb = 0; tb < 2; ++tb) {
            bf16x8 kf[8][2]; float bz[8][4];
#pragma unroll
            for (int t4 = 0; t4 < 8; ++t4) {
                const int tt = tb * 8 + t4, kj = tt >> 1, half = tt & 1;
                const bf16_t* kp = X.z + (krow_base + kj * 64 + 16 * half + fr) * ZW + 768 + h * 64 + 8 * fq;
                kf[t4][0] = *(const bf16x8*)kp; kf[t4][1] = *(const bf16x8*)(kp + 32);
            }
#pragma unroll
            for (int t4 = 0; t4 < 8; ++t4) {
                const int tt = tb * 8 + t4, kj = tt >> 1, half = tt & 1;
                const float* rp = rpb + (h * 15 + (rs + kj - r + 7)) * 31;
#pragma unroll
                for (int i = 0; i < 4; ++i) { int dc = ks + 16 * half + 4 * fq + i - qc; dc = dc < -15 ? -15 : (dc > 15 ? 15 : dc); bz[t4][i] = rp[dc + 15]; }
            }
            __builtin_amdgcn_sched_barrier(0);
#pragma unroll
            for (int t4 = 0; t4 < 8; ++t4) {
                const int tt = tb * 8 + t4, half = tt & 1;
                f32x4 c = (f32x4){0.f, 0.f, 0.f, 0.f};
                c = __builtin_amdgcn_mfma_f32_16x16x32_bf16(kf[t4][0], qf[0], c, 0, 0, 0);
                c = __builtin_amdgcn_mfma_f32_16x16x32_bf16(kf[t4][1], qf[1], c, 0, 0, 0);
#pragma unroll
                for (int i = 0; i < 4; ++i) {
                    const int kc = ks + 16 * half + 4 * fq + i;
                    const bool valid = (kc >= wstart) && (kc < wstart + 16);
                    c[i] = valid ? c[i] * 0.125f + bz[t4][i] : -1e30f;
                }
                sc[1 + tt] = c;
            }
            __builtin_amdgcn_sched_barrier(0);
        }
    } else {
#pragma unroll
        for (int tt = 0; tt < 16; ++tt) sc[1 + tt] = (f32x4){-1e30f, -1e30f, -1e30f, -1e30f};
    }
    float mx = -1e30f;
#pragma unroll
    for (int t = 0; t < 17; ++t)
#pragma unroll
        for (int i = 0; i < 4; ++i) mx = fmaxf(mx, sc[t][i]);
    mx = fmaxf(mx, __shfl_xor(mx, 16)); mx = fmaxf(mx, __shfl_xor(mx, 32));
    float sum = 0.f;
#pragma unroll
    for (int t = 0; t < 17; ++t)
#pragma unroll
        for (int i = 0; i < 4; ++i) { const float e = __expf(sc[t][i] - mx); sc[t][i] = e; sum += e; }
    sum += __shfl_xor(sum, 16); sum += __shfl_xor(sum, 32);
    const float inv = 1.f / sum;
    f32x4 oacc[4];
#pragma unroll
    for (int et = 0; et < 4; ++et) oacc[et] = (f32x4){0.f, 0.f, 0.f, 0.f};
    {
        const int r8 = lane >> 3, pc = lane & 7, l16 = lane & 15;
        const int vcol = 1280 + h * 64 + pc * 8;
        u32x4 vreg[8];
#pragma unroll
        for (int i = 0; i < 2; ++i) vreg[i] = *(const u32x4*)(X.mz + (size_t)(s * 16 + i * 8 + r8) * ZW + vcol);
#pragma unroll
        for (int cc = 0; cc < 5; ++cc) {
            if (cc > 0 && metaq) break;
            __syncthreads();
#pragma unroll
            for (int i = 0; i < 8; ++i) if (cc > 0 || i < 2) *(LAS u32x4*)(vl + (i * 8 + r8) * 144 + pc * 16) = vreg[i];
            __syncthreads();
            if (cc < 4 && !metaq) {
#pragma unroll
                for (int i = 0; i < 8; ++i) { const int rr = i * 8 + r8;
                    vreg[i] = *(const u32x4*)(X.z + (krow_base + (size_t)(2 * cc + (rr >> 5)) * 64 + (rr & 31)) * ZW + vcol); }
            }
#pragma unroll
            for (int ksl = 0; ksl < 2; ++ksl) {
                if (cc == 0 && ksl == 1) break;
                const int tt = 4 * (cc - 1) + 2 * ksl;
                f32x4 pa, pb;
                if (cc == 0) { pa = sc[0] * inv; pb = (f32x4){0.f, 0.f, 0.f, 0.f}; } else { pa = sc[1 + tt] * inv; pb = sc[2 + tt] * inv; }
                const bf16x8 pf = __builtin_bit_cast(bf16x8, pack8(pa, pb));
                const LAS unsigned char* rowp = vl + (32 * ksl + 4 * fq + (l16 >> 2)) * 144 + (4 * (l16 & 3)) * 2;
#pragma unroll
                for (int et = 0; et < 4; ++et) {
                    const v4i16_t ta = vtr16(rowp + et * 32);
                    v4i16_t tb = (v4i16_t){0, 0, 0, 0};
                    if (cc > 0) tb = vtr16(rowp + 16 * 144 + et * 32);
                    const bf16x8 vw = (bf16x8){ta[0], ta[1], ta[2], ta[3], tb[0], tb[1], tb[2], tb[3]};
                    oacc[et] = __builtin_amdgcn_mfma_f32_16x16x32_bf16(pf, vw, oacc[et], 0, 0, 0);
                }
            }
        }
    }
#pragma unroll
    for (int et = 0; et < 4; ++et)
#pragma unroll
        for (int i = 0; i < 4; ++i) optr[(size_t)(4 * fq + i) * ostride + h * 64 + et * 16 + fr] = (bf16_t)f2bf(oacc[et][i]);
}

#define XB_TMO      128
#define XB_XCNT(j)  (256  + 64 * (j))
#define XB_XSUB(j)  (1280 + 64 * (j))
#define XB_XGEN(j)  (2304 + 64 * (j))
#define XB_TOP      3328
#define XB_TOPGEN   3392
#define XCD_BAR_WORDS 3456
#define XB_SPIN_CAP (1u << 22)
__device__ __forceinline__ unsigned xb_ld(unsigned* p)              { return __hip_atomic_load(p, __ATOMIC_RELAXED, __HIP_MEMORY_SCOPE_AGENT); }
__device__ __forceinline__ unsigned xb_add(unsigned* p, unsigned v) { return __hip_atomic_fetch_add(p, v, __ATOMIC_RELAXED, __HIP_MEMORY_SCOPE_AGENT); }
__device__ __forceinline__ unsigned xb_xcc_id() { return (unsigned)__builtin_amdgcn_s_getreg((3 << 11) | 20) & 0xFu; }
#define XB_SPIN(cond, bar) do { unsigned _sp = 0; while (cond) { __builtin_amdgcn_s_sleep(1); \
    if ((++_sp & 255u) == 0u) { if (xb_ld(&(bar)[XB_TMO])) break; if (_sp > XB_SPIN_CAP) { atomicAdd(&(bar)[XB_TMO], 1u); break; } } } } while (0)
__device__ __forceinline__ void xcd_barrier_complete(unsigned* bar, unsigned x, unsigned& nloc, unsigned& nx) {
    const unsigned G = gridDim.x * gridDim.y * gridDim.z;
    unsigned sum, cnt, mine, sp = 0u;
    for (;;) {
        sum = 0u; cnt = 0u; mine = 0u;
#pragma unroll
        for (unsigned j = 0; j < 16; ++j) { const unsigned c = xb_ld(&bar[XB_XCNT(j)]); sum += c; cnt += (c > 0u) ? 1u : 0u; mine = (j == x) ? c : mine; }
        if (sum == G) break;
        __builtin_amdgcn_s_sleep(1);
        if ((++sp & 255u) == 0u) { if (xb_ld(&bar[XB_TMO])) break; if (sp > XB_SPIN_CAP) { atomicAdd(&bar[XB_TMO], 1u); break; } }
    }
    nloc = mine > 0u ? mine : 1u; nx = cnt > 0u ? cnt : 1u;
}
__device__ __forceinline__ void xcd_barrier(unsigned* bar, volatile LAS unsigned* st) {
    asm volatile("s_waitcnt vmcnt(0)" ::: "memory");
    __syncthreads();
    if (threadIdx.x == 0) {
        const unsigned x = xb_xcc_id();
        __builtin_amdgcn_s_waitcnt(0);
        unsigned nloc = st[0], nx = st[1];
        if (nloc == 0u) { xcd_barrier_complete(bar, x, nloc, nx); st[0] = nloc; st[1] = nx; }
        const unsigned old = xb_add(&bar[XB_XSUB(x)], 1u);
        const unsigned gen = old / nloc;
        if (old + 1u == (gen + 1u) * nloc) {
            __builtin_amdgcn_fence(__ATOMIC_RELEASE, "agent");
            asm volatile("s_waitcnt vmcnt(0)" ::: "memory");
            const unsigned og = xb_add(&bar[XB_TOP], 1u);
            const unsigned tg = og / nx;
            if (og + 1u == (tg + 1u) * nx) xb_add(&bar[XB_TOPGEN], 1u);
            else XB_SPIN(xb_ld(&bar[XB_TOPGEN]) == tg, bar);
            __builtin_amdgcn_fence(__ATOMIC_ACQUIRE, "agent");
            xb_add(&bar[XB_XGEN(x)], 1u);
            asm volatile("s_waitcnt vmcnt(0)" ::: "memory");
        } else {
            XB_SPIN(xb_ld(&bar[XB_XGEN(x)]) == gen, bar);
            __builtin_amdgcn_fence(__ATOMIC_ACQUIRE, "agent");
            asm volatile("s_waitcnt vmcnt(0)" ::: "memory");
        }
    }
    __syncthreads();
}
#define GRID_SYNC() xcd_barrier((unsigned*)(KA(ws) + WS_CTL), (volatile LAS unsigned*)(lds + LDS_ST_OFF))
__device__ __forceinline__ Ctx make_ctx(unsigned char* ws) {
    Ctx X;
    X.hb = (bf16_t*)(ws + WS_HB); X.ssq = (float*)(ws + WS_SSQ); X.z = (bf16_t*)(ws + WS_Z); X.yb = (bf16_t*)(ws + WS_YB); X.vt = (bf16_t*)(ws + WS_VT);
    X.hgu = (float*)(ws + WS_HGU); X.hgp = (float*)(ws + WS_HGP); X.s5s = (float*)(ws + WS_S5S); X.w = (bf16_t*)(ws + WS_W);
    X.lbar = (const float*)(ws + WS_TAB + T_LBAR); X.l16 = (const float*)(ws + WS_TAB + T_L16); X.l64 = (const float*)(ws + WS_TAB + T_L64);
    X.bfrag = (const bf16_t*)(ws + WS_TAB + T_BFRAG); X.cfrag = (const bf16_t*)(ws + WS_TAB + T_CFRAG); X.lb = (const float*)(ws + WS_TAB + T_LB);
    X.mh = (float*)(ws + WS_META + M_H); X.mhb = (bf16_t*)(ws + WS_META + M_HB); X.mssq = (float*)(ws + WS_META + M_SSQ); X.mz = (bf16_t*)(ws + WS_META + M_Z);
    X.myb = (bf16_t*)(ws + WS_META + M_YB); X.mvt = (bf16_t*)(ws + WS_META + M_VT); X.mact = (bf16_t*)(ws + WS_META + M_ACT);
    return X;
}

__device__ __forceinline__ bool make_job(unsigned char* ws, float* out, int l, int g, int ph, int j, pg8::Gemm& gm, pg8::UberEpi& ep) {
    const bool mchain = (g == 3) && (l < NLAYER - 1);
    int njobs = 1; bool meta = false; int sub = j;
    if (ph == 0) { njobs = (g == 0) ? 2 : 1; meta = (j == 1); }
    else if (ph == 4) { njobs = (g == 3) ? 2 : 1; meta = (j == 1); }
    else if (ph == 5) { njobs = mchain ? 6 : 3; meta = (j >= 3); sub = j % 3; }
    else { njobs = mchain ? 2 : 1; meta = (j == 1); }
    if (j >= njobs) return false;
    unsigned char* wb = ws + WS_W;
    const size_t r0 = (size_t)g * RG;
    unsigned char* mb = ws + WS_META;
    bf16_t* z = meta ? (bf16_t*)(mb + M_Z) : (bf16_t*)(ws + WS_Z);
    bf16_t* hb = meta ? (bf16_t*)(mb + M_HB) : (bf16_t*)(ws + WS_HB) + r0 * DM;
    float* ssq = meta ? (float*)(mb + M_SSQ) : (float*)(ws + WS_SSQ) + r0 * 4;
    float* h = meta ? (float*)(mb + M_H) : out + r0 * DM;
    bf16_t* yb = meta ? (bf16_t*)(mb + M_YB) : (bf16_t*)(ws + WS_YB);
    bf16_t* vt = meta ? (bf16_t*)(mb + M_VT) : (bf16_t*)(ws + WS_VT);
    bf16_t* act = meta ? (bf16_t*)(mb + M_ACT) : (bf16_t*)(ws + WS_Z);
    gm.M = meta ? 256 : RG;
    ep.i0 = 0; ep.p0 = nullptr; ep.p1 = nullptr; ep.p2 = nullptr;
    if (ph == 0) { gm.A = hb; gm.lda = DM; gm.Bt = (const bf16_t*)(wb + W_IN); gm.N = ZN; gm.K = DM; ep.mode = 0; ep.p0 = (unsigned char*)z; ep.p1 = (unsigned char*)ssq; ep.p2 = (unsigned char*)vt; ep.i0 = meta ? 256 : VTLD; }
    else if (ph == 4) { gm.A = z + 512; gm.lda = ZW; gm.Bt = (const bf16_t*)(wb + W_GLU); gm.N = 256; gm.K = 256; ep.mode = 1; ep.p0 = (unsigned char*)z; }
    else if (ph == 5) {
        gm.N = DM; ep.p0 = (unsigned char*)z;
        if (sub == 0) { gm.A = yb; gm.lda = 512; gm.Bt = (const bf16_t*)(wb + W_UPB); gm.K = 512; ep.mode = 2; ep.i0 = 4096; }
        else if (sub == 1) { gm.A = z + 256; gm.lda = ZW; gm.Bt = (const bf16_t*)(wb + W_UPC); gm.K = 256; ep.mode = 3; ep.i0 = 5120; }
        else { gm.A = z; gm.lda = ZW; gm.Bt = (const bf16_t*)(wb + W_UPA); gm.K = 256; ep.mode = 3; ep.i0 = 3072; }
    }
    else if (ph == 6) { gm.A = z + 1024; gm.lda = ZW; gm.Bt = (const bf16_t*)(wb + W_O); gm.N = DM; gm.K = DM; ep.mode = 4; ep.p0 = (unsigned char*)h; ep.p1 = (unsigned char*)hb; ep.p2 = (unsigned char*)ssq; }
    else if (ph == 7) { gm.A = hb; gm.lda = DM; gm.Bt = (const bf16_t*)(wb + W_GU); gm.N = 2 * FFH; gm.K = DM; ep.mode = 5; ep.p0 = (unsigned char*)act; ep.p1 = (unsigned char*)ssq; }
    else { gm.A = act; gm.lda = FFH; gm.Bt = (const bf16_t*)(wb + W_DN); gm.N = DM; gm.K = FFH; ep.mode = 4; ep.p0 = (unsigned char*)h; ep.p1 = (unsigned char*)hb; ep.p2 = (unsigned char*)ssq; }
    return true;
}

__device__ __forceinline__ void prologue(int G) {
    const int tid_ = opaque_tid(); const int lane = tid_ & 63, gw = blockIdx.x * 8 + __builtin_amdgcn_readfirstlane(tid_ >> 6), NGW = G * 8;
    const Ctx X = make_ctx(((unsigned char*)KA(ws)));
    for (int row = gw; row < RMAIN + 256; row += NGW) {
        const bool ismeta = row >= RMAIN; const int mr = row - RMAIN;
        const float* src = ismeta ? (mr < 160 ? KAF(meta_tokens) + (size_t)(mr & 15) * DM : nullptr) : (row < 32768 ? KAF(x_prompt) + (size_t)row * DM : KAF(x_sample) + (size_t)(row - 32768) * DM);
        float* hd = ismeta ? X.mh + (size_t)mr * DM : ((float*)KA(out)) + (size_t)row * DM;
        bf16_t* hbd = ismeta ? X.mhb + (size_t)mr * DM : X.hb + (size_t)row * DM;
        float* sq = ismeta ? X.mssq + (size_t)mr * 4 : X.ssq + (size_t)row * 4;
        float ss = 0.f;
#pragma unroll
        for (int j = 0; j < 4; ++j) {
            f32x4 v = (f32x4){0.f, 0.f, 0.f, 0.f}; if (src) v = *(const f32x4*)(src + j * 256 + lane * 4);
            *(f32x4*)(hd + j * 256 + lane * 4) = v;
            *(u32x2*)(hbd + j * 256 + lane * 4) = (u32x2){pk2(v[0], v[1]), pk2(v[2], v[3])};
            ss += (v[0] * v[0] + v[1] * v[1]) + (v[2] * v[2] + v[3] * v[3]);
        }
        ss = wave_sum(ss);
        if (lane < 4) sq[lane] = lane == 0 ? ss : 0.f;
    }
}

__device__ __forceinline__ void mixer_phase_A(int l, int g, LAS unsigned char* lds, int G, int bid) {
    const int tid_ = opaque_tid(); const int lane = tid_ & 63, wave = __builtin_amdgcn_readfirstlane(tid_ >> 6);
    const Ctx X = make_ctx(((unsigned char*)KA(ws))); const Grp gp = make_grp(g);
    const float* rpb = KAF(rpb) + (size_t)l * 8 * 15 * 31; const float* s5d = KAF(s5_d) + l * 256;
    const int nna = gp.nseq * (gp.Lr / 16), nmq = gp.nseq, nct = gp.nseq * (gp.nch - 1);
    const int ntask = nna + nmq + 2 * nct;
    const bool xmap = (nna % 256 == 0) && ((volatile LAS unsigned*)(lds + LDS_ST_OFF))[4] != 0u;
    if (xmap) {
        const int xcc = (int)((volatile LAS unsigned*)(lds + LDS_ST_OFF))[2], xrk = (int)((volatile LAS unsigned*)(lds + LDS_ST_OFF))[3];
        const int per = gp.Lr / 16, nx = nna / 8, rounds = nna / 256;
        for (int i = 0; i < rounds; ++i) { const int t = xcc * nx + xrk + 32 * i; na_task(X, rpb, gp, t / per, t % per, false, wave, lane, lds + wave * 9216); }
    }
    for (int t = bid + (xmap ? nna : 0); t < ntask; t += G) {
        __syncthreads();
        if (t < nna) { const int per = gp.Lr / 16; na_task(X, rpb, gp, t / per, t % per, false, wave, lane, lds + wave * 9216); }
        else if (t < nna + nmq) { na_task(X, rpb, gp, t - nna, 0, true, wave, lane, lds + wave * 9216); }
        else {
            const int u = t - nna - nmq; const bool isS5 = u < nct; const int v = isS5 ? u : u - nct;
            const int sl = v / (gp.nch - 1), c1 = v % (gp.nch - 1) + 1;
            for (int c = (c1 == 1 ? 0 : c1); c <= c1; ++c) {
                __syncthreads();
                const int ci = sl * gp.nch + c; const int T = c == 0 ? 16 : 64;
                bf16_t* zc = c == 0 ? X.mz + (size_t)((gp.s0 + sl) * 16) * ZW : X.z + ((size_t)sl * gp.Lr + 64 * (c - 1)) * ZW;
                if (isS5) s5_chunk<false>(X, s5d, (LAS float*)(lds + wave * 16896), zc, T, ci, wave, lane);
                else hg_passA_mfma(X, lds + wave * 9216, zc, T, ci, wave, lane);
            }
        }
    }
}

__device__ __forceinline__ void mixer_phase_C(int l, int g, LAS unsigned char* lds, int G, int bid) {
    const int tid_ = opaque_tid(); const int lane = tid_ & 63, wave = __builtin_amdgcn_readfirstlane(tid_ >> 6);
    const Ctx X = make_ctx(((unsigned char*)KA(ws))); const Grp gp = make_grp(g);
    const float* s5d = KAF(s5_d) + l * 256; const float* ong = KAF(onorm_g) + l * 64;
    const int nct = gp.nseq * (gp.nch - 1);
    for (int t = bid; t < 2 * nct; t += G) {
        const bool isS5 = t < nct; const int v = isS5 ? t : t - nct;
        const int sl = v / (gp.nch - 1), c1 = v % (gp.nch - 1) + 1;
        for (int c = (c1 == 1 ? 0 : c1); c <= c1; ++c) {
            __syncthreads();
            const int ci = sl * gp.nch + c; const int T = c == 0 ? 16 : 64;
            bf16_t* zc = c == 0 ? X.mz + (size_t)((gp.s0 + sl) * 16) * ZW : X.z + ((size_t)sl * gp.Lr + 64 * (c - 1)) * ZW;
            if (isS5) {
                s5_chunk<true>(X, s5d, (LAS float*)(lds + wave * 16896), zc, T, ci, wave, lane);
                const int fr = lane & 15, fq = lane >> 4;
                const bf16_t* wg = (const bf16_t*)((const unsigned char*)X.w + W_GLU);
                const int n0 = wave * 32;
                bf16x8 bw[8][2];
#pragma unroll
                for (int ks = 0; ks < 8; ++ks)
#pragma unroll
                    for (int n2 = 0; n2 < 2; ++n2) bw[ks][n2] = *(const bf16x8*)(wg + (size_t)(n0 + n2 * 16 + fr) * 256 + ks * 32 + fq * 8);
                asm volatile("s_waitcnt vmcnt(0)" ::: "memory");
                __syncthreads();
                f32x4 ga[4][2];
#pragma unroll
                for (int a = 0; a < 4; ++a)
#pragma unroll
                    for (int b = 0; b < 2; ++b) ga[a][b] = (f32x4){0.f, 0.f, 0.f, 0.f};
#pragma unroll
                for (int kh = 0; kh < 2; ++kh) {
                    bf16x8 af[4][4];
#pragma unroll
                    for (int k4 = 0; k4 < 4; ++k4)
#pragma unroll
                        for (int mt = 0; mt < 4; ++mt) { af[k4][mt] = (bf16x8){0, 0, 0, 0, 0, 0, 0, 0}; if (mt * 16 < T) af[k4][mt] = *(const bf16x8*)(zc + (size_t)(mt * 16 + fr) * ZW + 512 + (kh * 4 + k4) * 32 + fq * 8); }
                    __builtin_amdgcn_sched_barrier(0);
#pragma unroll
                    for (int k4 = 0; k4 < 4; ++k4)
#pragma unroll
                        for (int mt = 0; mt < 4; ++mt) {
                            if (mt * 16 < T) {
#pragma unroll
                                for (int n2 = 0; n2 < 2; ++n2) ga[mt][n2] = __builtin_amdgcn_mfma_f32_16x16x32_bf16(af[k4][mt], bw[kh * 4 + k4][n2], ga[mt][n2], 0, 0, 0);
                            }
                        }
                    __builtin_amdgcn_sched_barrier(0);
                }
#pragma unroll
                for (int mt = 0; mt < 4; ++mt) {
                    if (mt * 16 < T) {
                        float yy[2][4];
#pragma unroll
                        for (int n2 = 0; n2 < 2; ++n2)
#pragma unroll
                            for (int r = 0; r < 4; ++r) yy[n2][r] = bf2f(zc[(size_t)(mt * 16 + 4 * fq + r) * ZW + 512 + n0 + n2 * 16 + fr]);
#pragma unroll
                        for (int n2 = 0; n2 < 2; ++n2)
#pragma unroll
                            for (int r = 0; r < 4; ++r) zc[(size_t)(mt * 16 + 4 * fq + r) * ZW + n0 + n2 * 16 + fr] = (bf16_t)f2bf(yy[n2][r] * sigm(ga[mt][n2][r]));
                    }
                }
            }
            else {
                hg_passC_mfma(X, lds + wave * 7168, (LAS bf16_t*)(lds + 65536 + wave * 8192), zc, T, ci, wave, lane);
                __syncthreads();
                const int h = wave >> 1, half = wave & 1;
                const LAS bf16_t* of = (const LAS bf16_t*)(lds + 65536 + (2 * h) * 8192); const LAS bf16_t* ob = (const LAS bf16_t*)(lds + 65536 + (2 * h + 1) * 8192);
                const float gn = ong[lane];
                const int tt0 = half * (T / 2);
                float gov[32];
#pragma unroll
                for (int i = 0; i < 32; ++i) { gov[i] = 0.f; if (i < T / 2) gov[i] = bf2f(zc[(size_t)(tt0 + i) * ZW + 2816 + h * 64 + lane]); }
#pragma unroll
                for (int i = 0; i < 32; ++i) {
                    if (i < T / 2) {
                        const int tt = tt0 + i;
                        const float o = bf2f(of[tt * 64 + lane]) + bf2f(ob[tt * 64 + lane]);
                        const float ms = wave_sum(o * o) * (1.0f / 64.0f);
                        const float go = gov[i];
                        zc[(size_t)tt * ZW + 256 + h * 64 + lane] = (bf16_t)f2bf(o * rsqrtf(ms + 1e-6f) * gn * (go * sigm(go)));
                    }
                }
            }
        }
    }
}

__global__ void __launch_bounds__(512, 2) fwd_kernel(Args a) {
    extern __shared__ __attribute__((aligned(16))) unsigned char lds_raw[];
    LAS unsigned char* lds = (LAS unsigned char*)lds_raw;
    const int G = gridDim.x, bid = blockIdx.x;

    if (threadIdx.x < 2) ((volatile LAS unsigned*)(lds + LDS_ST_OFF))[threadIdx.x] = 0u;
    if (threadIdx.x == 0) { const unsigned xc = xb_xcc_id(); const unsigned rk = xb_add((unsigned*)(KA(ws) + WS_CTL) + XB_XCNT(xc), 1u);
        ((volatile LAS unsigned*)(lds + LDS_ST_OFF))[2] = xc; ((volatile LAS unsigned*)(lds + LDS_ST_OFF))[3] = rk; }
    __syncthreads();
    prologue(G);

    for (int l = 0; l < NLAYER; ++l) {
        __syncthreads();
        { const Ctx X = make_ctx(((unsigned char*)KA(ws))); prep_layer(X, l, lds, G); }
        if (l == 0) { asm volatile("s_waitcnt vmcnt(0)" ::: "memory"); __syncthreads(); cg::this_grid().sync(); }
        GRID_SYNC();
        if (l == 0) {
            if (threadIdx.x == 0) { unsigned* bar = (unsigned*)(KA(ws) + WS_CTL); bool ok = (G == 256);
                for (int j = 0; j < 16; ++j) { const unsigned c = xb_ld(&bar[XB_XCNT(j)]); ok = ok && (c == (j < 8 ? 32u : 0u)); }
                ((volatile LAS unsigned*)(lds + LDS_ST_OFF))[4] = ok ? 1u : 0u; }
            __syncthreads();
        }
        for (int g = 0; g < 4; ++g) {
            for (int ph = 0; ph < 9; ++ph) {
                if (ph == 4) continue;
                if (ph == 1) mixer_phase_A(l, g, lds, G, bid);
                else if (ph == 2) { const Ctx X = make_ctx(((unsigned char*)KA(ws))); const Grp gp = make_grp(g); const int gtid = bid * 512 + opaque_tid(), GT = G * 512; s5_passB(X, gp, gtid, GT); hg_passB(X, gp, GT - 1 - gtid, GT); }
                else if (ph == 3) mixer_phase_C(l, g, lds, G, bid);
                else {
                    for (int j = 0; j < 6; ++j) {
                        pg8::Gemm gm; pg8::UberEpi ep;
                        if (!make_job(((unsigned char*)KA(ws)), ((float*)KA(out)), l, g, ph, j, gm, ep)) break;
                        int cidx = bid;
                        if (ph == 7 && j == 1) { const int busy = ((RG / 256) * (2 * FFH / 256)) % G; cidx = (bid + G - busy) % G; }
                        pg8::StaticOrder SO; SO.init(gm.M, gm.N, G, cidx);
                        pg8::gemm_phase(lds, gm, SO, ep);
                    }
                }
                GRID_SYNC();
            }
        }
    }
    {
        const float* ssq = (const float*)(((unsigned char*)KA(ws)) + WS_SSQ);
        const int tid_ = opaque_tid(); const int lane = tid_ & 63, wave = __builtin_amdgcn_readfirstlane(tid_ >> 6);
        for (int row = bid * 8 + wave; row < RMAIN; row += G * 8) {
            const float rs = pg8::row_rstd(ssq, row);
            float* hp = ((float*)KA(out)) + (size_t)row * DM;
#pragma unroll
            for (int j = 0; j < 4; ++j) {
                f32x4 v = *(const f32x4*)(hp + j * 256 + lane * 4); const f32x4 gv = *(const f32x4*)(KAF(final_g) + j * 256 + lane * 4);
                v = v * rs * gv; *(f32x4*)(hp + j * 256 + lane * 4) = v;
            }
        }
    }
}

extern "C" void kernel_launch(void* const* d_in, const int* in_sizes, int n_in, void* d_out, int out_size, void* d_ws, size_t ws_size, hipStream_t stream) {
    static int grid = 0;
    if (grid == 0) {
        int dev = 0, cus = 0, per_cu = 0;
        (void)hipGetDevice(&dev);
        (void)hipDeviceGetAttribute(&cus, hipDeviceAttributeMultiprocessorCount, dev);
        (void)hipFuncSetAttribute((const void*)fwd_kernel, hipFuncAttributeMaxDynamicSharedMemorySize, LDS_BYTES);
        (void)hipOccupancyMaxActiveBlocksPerMultiprocessor(&per_cu, (const void*)fwd_kernel, 512, LDS_BYTES);
        (void)hipGetLastError();
        if (ws_size < WS_TOTAL) fprintf(stderr, "kernel_launch: workspace too small: %zu < %zu\n", ws_size, (size_t)WS_TOTAL);
        grid = cus > 0 ? cus : 256;
    }
    (void)hipMemsetAsync((char*)d_ws + WS_CTL, 0, CTL_BYTES, stream);
    Args a{};
    const float** pp = (const float**)&a;
    for (int i = 0; i < 26; ++i) pp[i] = (const float*)d_in[i];
    a.out = (float*)d_out; a.ws = (unsigned char*)d_ws;
    void* args[] = {&a};
    hipError_t e = hipLaunchCooperativeKernel((const void*)fwd_kernel, dim3(grid), dim3(512), args, LDS_BYTES, stream);
    if (e != hipSuccess) fprintf(stderr, "cooperative launch failed: %s\n", hipGetErrorString(e));
}
```

```cpp
#include <hip/hip_runtime.h>
#include <hip/hip_cooperative_groups.h>
#include <cstdio>
#include <cstdint>
namespace cg = cooperative_groups;

#define LAS __attribute__((address_space(3)))
typedef unsigned short bf16_t;
typedef short bf16x8 __attribute__((ext_vector_type(8)));
typedef float f32x4 __attribute__((ext_vector_type(4)));
typedef unsigned u32x4 __attribute__((ext_vector_type(4)));
typedef unsigned u32x2 __attribute__((ext_vector_type(2)));

#define WAVE_SYNC() asm volatile("s_waitcnt lgkmcnt(0)" ::: "memory")
__device__ __forceinline__ int opaque_tid() { int t = threadIdx.x; asm volatile("" : "+v"(t)); return t; }

__device__ __forceinline__ unsigned f2bf(float f) { unsigned u = __builtin_bit_cast(unsigned, f); return (u + 0x7fffu + ((u >> 16) & 1u)) >> 16; }
__device__ __forceinline__ unsigned pk2(float lo, float hi) { return f2bf(lo) | (f2bf(hi) << 16); }
__device__ __forceinline__ float bf2f(bf16_t b) { return __builtin_bit_cast(float, (unsigned)b << 16); }
__device__ __forceinline__ float bflo(unsigned w) { return __builtin_bit_cast(float, w << 16); }
__device__ __forceinline__ float bfhi(unsigned w) { return __builtin_bit_cast(float, w & 0xffff0000u); }
__device__ __forceinline__ float sigm(float x) { return 1.f / (1.f + __expf(-x)); }
__device__ __forceinline__ float gelu_tanh(float y) { const float a = 0.7978845608028654f * (y + 0.044715f * y * y * y); const float th = 1.f - 2.f / (__expf(2.f * a) + 1.f); return 0.5f * y * (1.f + th); }
__device__ __forceinline__ u32x4 pack8(f32x4 a, f32x4 b) { u32x4 w; w.x = pk2(a[0], a[1]); w.y = pk2(a[2], a[3]); w.z = pk2(b[0], b[1]); w.w = pk2(b[2], b[3]); return w; }
__device__ __forceinline__ float wave_sum(float v) {
#pragma unroll
    for (int o = 1; o < 64; o <<= 1) v += __shfl_xor(v, o);
    return v;
}

namespace pg8 {
constexpr int ZSTR = 6208;
constexpr int BM = 256, BK = 64, HALF = 128, HTB = HALF * BK * 2, STAGE_BYTES = 8 * HTB, NXCD = 8, WGM = 8;
__host__ __device__ __forceinline__ int lds_byte(int r, int c) { const int st = (r >> 4) * 2 + (c >> 5), rr = r & 15, cc = c & 31, ob = rr * 64 + cc * 2; return st * 1024 + (ob ^ (((ob >> 9) & 1) << 5)); }
__host__ __device__ __forceinline__ void stage_rc(int b, int& R, int& C) { const int st = b / 1024, sb = b % 1024, swz = sb ^ (((sb >> 9) & 1) << 5); R = (st >> 1) * 16 + swz / 64; C = (st & 1) * 32 + (swz % 64) / 2; }
__host__ __device__ __forceinline__ int perm32(int rho) { const int n = rho >> 4, i = rho & 15; return 8 * (i >> 2) + 4 * n + (i & 3); }
struct Unit { int pm, pn; };
struct Gemm { const bf16_t* A; int lda; const bf16_t* Bt; int M, N, K; };
struct StaticOrder {
    int nM, nN, nwg, G, c;
    __device__ void init(int M, int N, int G_, int c_) { nM = M / BM; nN = N / BM; nwg = nM * nN; G = G_; c = c_; }
    __device__ bool next(int i, Unit& u) const {
        const long L = (long)i * G + c; if (L >= nwg) return false;
        int wgid = (int)L; { const int q = nwg / NXCD, r = nwg % NXCD, xcd = wgid % NXCD, off = wgid / NXCD; wgid = (xcd < r ? xcd * (q + 1) : r * (q + 1) + (xcd - r) * q) + off; }
        const int nig = WGM * nN, gid = wgid / nig, fm = gid * WGM, gsz = (nM - fm) < WGM ? (nM - fm) : WGM;
        u.pm = fm + ((wgid % nig) % gsz); u.pn = (wgid % nig) / gsz; return true;
    }
};

struct UberEpi;
__device__ __forceinline__ void run_epi(const UberEpi& E, LAS unsigned char* lds, const f32x4 (&acc)[2][2][4][2], const Unit& u, int wr, int wc, int fr, int fq);
__device__ __forceinline__ void gemm_phase(LAS unsigned char* lds, const Gemm g, const StaticOrder& S, const UberEpi& E) {
    const int tid = opaque_tid(), wid = __builtin_amdgcn_readfirstlane(tid >> 6), lane = tid & 63, wr = wid >> 2, wc = wid & 3, fr = lane & 15, fq = lane >> 4;
    const int K = g.K, nt = K / BK, lda = g.lda;
    unsigned voffA[2], voffB[2];
#pragma unroll
    for (int i = 0; i < 2; ++i) { int R, C; stage_rc(tid * 16 + i * 8192, R, C); const int Rb = (R & ~31) + perm32(R & 31);
        voffA[i] = (unsigned)(R * lda + C) * 2u; voffB[i] = (unsigned)(Rb * K + C) * 2u; }
    const size_t kstep = (size_t)(BK * 2);
    const size_t hstepA = (size_t)HALF * lda * 2, hstepB = (size_t)HALF * K * 2;
    const size_t tstepA = 2 * hstepA, tstepB = 2 * hstepB;
    const unsigned ldsw = (unsigned)wid * 1024u;
    const int aoff = lds_byte(wr * 64 + fr, fq * 8), boff = lds_byte(wc * 32 + fr, fq * 8);
#define PG8_SA(b, h) (((b) * 2 + (h)) * HTB)
#define PG8_SB(b, h) ((4 + (b) * 2 + (h)) * HTB)
#define PG8_STAGE(bufoff, gbase, voff) do { _Pragma("unroll") for (int _i = 0; _i < 2; ++_i) \
        __builtin_amdgcn_global_load_lds((const unsigned*)((const char*)(gbase) + (voff)[_i]), (LAS unsigned*)(lds + (bufoff) + ldsw + _i * 8192), 16, 0, 0); } while (0)
#define PG8_LDA(dst, b, h) do { _Pragma("unroll") for (int m = 0; m < 4; ++m) _Pragma("unroll") for (int k = 0; k < 2; ++k) dst[m][k] = *(const LAS bf16x8*)(lds + PG8_SA(b, h) + aoff + m * 2048 + k * 1024); } while (0)
#define PG8_LDB(dst, b, h) do { _Pragma("unroll") for (int n = 0; n < 2; ++n) _Pragma("unroll") for (int k = 0; k < 2; ++k) dst[n][k] = *(const LAS bf16x8*)(lds + PG8_SB(b, h) + boff + n * 2048 + k * 1024); } while (0)
#define PG8_MMA(ai, bj, At, Bt) do { __builtin_amdgcn_s_setprio(1); _Pragma("unroll") for (int m = 0; m < 4; ++m) _Pragma("unroll") for (int n = 0; n < 2; ++n) _Pragma("unroll") for (int k = 0; k < 2; ++k) \
        acc[ai][bj][m][n] = __builtin_amdgcn_mfma_f32_16x16x32_bf16(Bt[n][k], At[m][k], acc[ai][bj][m][n], 0, 0, 0); __builtin_amdgcn_s_setprio(0); } while (0)
#define PG8_WAIT_V(n) asm volatile("s_waitcnt vmcnt(" #n ")" ::: "memory")
#define PG8_WAIT_L(n) asm volatile("s_waitcnt lgkmcnt(" #n ")" ::: "memory")
#define PG8_BAR __builtin_amdgcn_s_barrier()
#define PG8_SCHED __builtin_amdgcn_sched_barrier(0)
    Unit cur, nxt; int ui = 0;
    if (!S.next(0, cur)) return;
    f32x4 acc[2][2][4][2];
#pragma unroll
    for (int a = 0; a < 2; ++a)
#pragma unroll
        for (int b = 0; b < 2; ++b)
#pragma unroll
            for (int m = 0; m < 4; ++m)
#pragma unroll
                for (int n = 0; n < 2; ++n) acc[a][b][m][n] = (f32x4){0.f, 0.f, 0.f, 0.f};
    bf16x8 At[4][2], B0[2][2], B1[2][2];
    const char* cA = (const char*)g.A + (size_t)cur.pm * tstepA; const char* cB = (const char*)g.Bt + (size_t)cur.pn * tstepB;
    PG8_STAGE(PG8_SB(0, 0), cB, voffB); PG8_STAGE(PG8_SB(0, 1), cB + hstepB, voffB); PG8_STAGE(PG8_SA(0, 0), cA, voffA); PG8_STAGE(PG8_SA(0, 1), cA + hstepA, voffA);
    if (wr == 1) PG8_BAR;
    PG8_WAIT_V(2); PG8_BAR;
    PG8_STAGE(PG8_SB(1, 0), cB + kstep, voffB); PG8_STAGE(PG8_SA(1, 0), cA + kstep, voffA); PG8_STAGE(PG8_SB(1, 1), cB + hstepB + kstep, voffB);
    PG8_WAIT_V(6); PG8_BAR;
    for (;;) {
        const bool has_next = S.next(ui + 1, nxt);
        const char* nA = has_next ? (const char*)g.A + (size_t)nxt.pm * tstepA : cA; const char* nB = has_next ? (const char*)g.Bt + (size_t)nxt.pn * tstepB : cB;
        for (int t = 0; t < nt; t += 2) {
            const bool last = (t == nt - 2);
            const char* a1 = cA + (size_t)(t + 1) * kstep;
            const char* a2 = last ? nA : cA + (size_t)(t + 2) * kstep; const char* b2 = last ? nB : cB + (size_t)(t + 2) * kstep;
            const char* a3 = a2 + kstep; const char* b3 = b2 + kstep;
            PG8_LDB(B0, 0, 0); PG8_LDB(B1, 0, 1); PG8_SCHED; PG8_LDA(At, 0, 0); PG8_STAGE(PG8_SA(1, 1), a1 + hstepA, voffA);
            PG8_WAIT_V(8); PG8_WAIT_L(0); PG8_BAR; PG8_MMA(0, 0, At, B0); PG8_MMA(0, 1, At, B1); PG8_BAR; PG8_SCHED;
            PG8_LDA(At, 0, 1); PG8_STAGE(PG8_SB(0, 0), b2, voffB); PG8_STAGE(PG8_SB(0, 1), b2 + hstepB, voffB); PG8_STAGE(PG8_SA(0, 0), a2, voffA);
            PG8_WAIT_V(8); PG8_WAIT_L(0); PG8_BAR; PG8_MMA(1, 0, At, B0); PG8_MMA(1, 1, At, B1); PG8_BAR; PG8_SCHED;
            PG8_LDB(B0, 1, 0); PG8_LDB(B1, 1, 1); PG8_SCHED; PG8_LDA(At, 1, 0); PG8_STAGE(PG8_SA(0, 1), a2 + hstepA, voffA);
            PG8_WAIT_V(8); PG8_WAIT_L(0); PG8_BAR; PG8_MMA(0, 0, At, B0); PG8_MMA(0, 1, At, B1); PG8_BAR; PG8_SCHED;
            PG8_LDA(At, 1, 1); PG8_STAGE(PG8_SB(1, 0), b3, voffB); PG8_STAGE(PG8_SB(1, 1), b3 + hstepB, voffB); PG8_STAGE(PG8_SA(1, 0), a3, voffA);
            PG8_WAIT_V(8); PG8_WAIT_L(0); PG8_BAR; PG8_MMA(1, 0, At, B0); PG8_MMA(1, 1, At, B1); PG8_BAR; PG8_SCHED;
        }
        if (wr == 0) PG8_BAR;
        run_epi(E, lds, acc, cur, wr, wc, fr, fq);
        if (!has_next) break;
#pragma unroll
        for (int a = 0; a < 2; ++a)
#pragma unroll
            for (int b = 0; b < 2; ++b)
#pragma unroll
                for (int m = 0; m < 4; ++m)
#pragma unroll
                    for (int n = 0; n < 2; ++n) acc[a][b][m][n] = (f32x4){0.f, 0.f, 0.f, 0.f};
        cur = nxt; cA = nA; cB = nB; ++ui;
        if (wr == 1) PG8_BAR;
    }
    PG8_WAIT_V(0);
    PG8_BAR;
#undef PG8_SA
#undef PG8_SB
#undef PG8_STAGE
#undef PG8_LDA
#undef PG8_LDB
#undef PG8_MMA
#undef PG8_WAIT_V
#undef PG8_WAIT_L
#undef PG8_BAR
#undef PG8_SCHED
}

__device__ __forceinline__ float row_rstd(const float* ssq, int row) {
    const f32x4 s0 = *(const f32x4*)(ssq + (size_t)row * 4);
    const float ss = (s0[0] + s0[1]) + (s0[2] + s0[3]);
    return rsqrtf(ss * (1.0f / 1024.0f) + 1e-6f);
}
struct EpiZ {
    bf16_t* z; const float* ssq; bf16_t* vt; int vt_ld;
    __device__ __forceinline__ void operator()(const f32x4 (&acc)[2][2][4][2], const Unit& u, int wr, int wc, int fr, int fq) const {
        const int row0 = u.pm * BM + wr * 64 + fr, col0 = u.pn * BM + wc * 32 + 8 * fq;
#pragma unroll
        for (int ai = 0; ai < 2; ++ai)
#pragma unroll
            for (int m = 0; m < 4; ++m) {
                const int row = row0 + ai * HALF + m * 16; const float rs = row_rstd(ssq, row);
#pragma unroll
                for (int bj = 0; bj < 2; ++bj) {
                    const u32x4 w = pack8(acc[ai][bj][m][0] * rs, acc[ai][bj][m][1] * rs);
                    *(u32x4*)(z + (size_t)row * ZSTR + col0 + bj * HALF) = w;
                }
            }
    }
};
struct EpiGlu {
    bf16_t* z;
    __device__ __forceinline__ void operator()(const f32x4 (&acc)[2][2][4][2], const Unit& u, int wr, int wc, int fr, int fq) const {
        const int row0 = u.pm * BM + wr * 64 + fr, col0 = wc * 32 + 8 * fq;
#pragma unroll
        for (int ai = 0; ai < 2; ++ai) {
            u32x4 yv[4][2];
#pragma unroll
            for (int m = 0; m < 4; ++m)
#pragma unroll
                for (int bj = 0; bj < 2; ++bj) yv[m][bj] = *(const u32x4*)(z + (size_t)(row0 + ai * HALF + m * 16) * ZSTR + col0 + bj * HALF + 512);
#pragma unroll
            for (int m = 0; m < 4; ++m) {
                const int row = row0 + ai * HALF + m * 16;
#pragma unroll
                for (int bj = 0; bj < 2; ++bj) {
                    bf16_t* zp = z + (size_t)row * ZSTR + col0 + bj * HALF;
                    const u32x4 y = yv[m][bj];
                    const f32x4 a0 = acc[ai][bj][m][0], a1 = acc[ai][bj][m][1];
                    f32x4 o0, o1;
                    o0[0] = bflo(y.x) * sigm(a0[0]); o0[1] = bfhi(y.x) * sigm(a0[1]); o0[2] = bflo(y.y) * sigm(a0[2]); o0[3] = bfhi(y.y) * sigm(a0[3]);
                    o1[0] = bflo(y.z) * sigm(a1[0]); o1[1] = bfhi(y.z) * sigm(a1[1]); o1[2] = bflo(y.w) * sigm(a1[2]); o1[3] = bfhi(y.w) * sigm(a1[3]);
                    *(u32x4*)zp = pack8(o0, o1);
                }
            }
        }
    }
};
template <int MODE> struct EpiMix {
    bf16_t* z; int goff;
    __device__ __forceinline__ void operator()(const f32x4 (&acc)[2][2][4][2], const Unit& u, int wr, int wc, int fr, int fq) const {
        const int row0 = u.pm * BM + wr * 64 + fr, col0 = u.pn * BM + wc * 32 + 8 * fq;
#pragma unroll
        for (int ai = 0; ai < 2; ++ai)
#pragma unroll
            for (int mp = 0; mp < 2; ++mp) {
                u32x4 gv[2][2], pv[2][2];
#pragma unroll
                for (int mm = 0; mm < 2; ++mm)
#pragma unroll
                    for (int bj = 0; bj < 2; ++bj) { const bf16_t* zr = z + (size_t)(row0 + ai * HALF + (mp * 2 + mm) * 16) * ZSTR + col0 + bj * HALF;
                        gv[mm][bj] = *(const u32x4*)(zr + goff); if (MODE == 1) pv[mm][bj] = *(const u32x4*)(zr + 1024); }
#pragma unroll
                for (int mm = 0; mm < 2; ++mm) {
                    const int m = mp * 2 + mm; const int row = row0 + ai * HALF + m * 16;
#pragma unroll
                    for (int bj = 0; bj < 2; ++bj) {
                        bf16_t* zr = z + (size_t)row * ZSTR + col0 + bj * HALF;
                        const u32x4 gq = gv[mm][bj];
                        const f32x4 a0 = acc[ai][bj][m][0], a1 = acc[ai][bj][m][1];
                        f32x4 o0, o1;
                        o0[0] = sigm(bflo(gq.x)) * a0[0]; o0[1] = sigm(bfhi(gq.x)) * a0[1]; o0[2] = sigm(bflo(gq.y)) * a0[2]; o0[3] = sigm(bfhi(gq.y)) * a0[3];
                        o1[0] = sigm(bflo(gq.z)) * a1[0]; o1[1] = sigm(bfhi(gq.z)) * a1[1]; o1[2] = sigm(bflo(gq.w)) * a1[2]; o1[3] = sigm(bfhi(gq.w)) * a1[3];
                        if (MODE == 1) { const u32x4 p = pv[mm][bj];
                            o0[0] += bflo(p.x); o0[1] += bfhi(p.x); o0[2] += bflo(p.y); o0[3] += bfhi(p.y); o1[0] += bflo(p.z); o1[1] += bfhi(p.z); o1[2] += bflo(p.w); o1[3] += bfhi(p.w); }
                        *(u32x4*)(zr + 1024) = pack8(o0, o1);
                    }
                }
            }
    }
};
struct EpiRes {
    float* h; bf16_t* hb; float* ssq; LAS float* red;
    __device__ __forceinline__ void operator()(const f32x4 (&acc)[2][2][4][2], const Unit& u, int wr, int wc, int fr, int fq) const {
        const int row0 = u.pm * BM + wr * 64 + fr, col0 = u.pn * BM + wc * 32 + 8 * fq;
#pragma unroll
        for (int ai = 0; ai < 2; ++ai)
#pragma unroll
            for (int mp = 0; mp < 2; ++mp) {
                f32x4 hv[2][2][2];
#pragma unroll
                for (int mm = 0; mm < 2; ++mm)
#pragma unroll
                    for (int bj = 0; bj < 2; ++bj) { const float* hp = h + (size_t)(row0 + ai * HALF + (mp * 2 + mm) * 16) * 1024 + col0 + bj * HALF; hv[mm][bj][0] = *(const f32x4*)hp; hv[mm][bj][1] = *(const f32x4*)(hp + 4); }
#pragma unroll
                for (int mm = 0; mm < 2; ++mm) {
                    const int m = mp * 2 + mm; const int row = row0 + ai * HALF + m * 16; float part = 0.f;
#pragma unroll
                    for (int bj = 0; bj < 2; ++bj) {
                        float* hp = h + (size_t)row * 1024 + col0 + bj * HALF;
                        const f32x4 h0 = hv[mm][bj][0] + acc[ai][bj][m][0], h1 = hv[mm][bj][1] + acc[ai][bj][m][1];
                        *(f32x4*)hp = h0; *(f32x4*)(hp + 4) = h1;
                        part += (h0[0] * h0[0] + h0[1] * h0[1]) + (h0[2] * h0[2] + h0[3] * h0[3]) + (h1[0] * h1[0] + h1[1] * h1[1]) + (h1[2] * h1[2] + h1[3] * h1[3]);
                        *(u32x4*)(hb + (size_t)row * 1024 + col0 + bj * HALF) = pack8(h0, h1);
                    }
                    part += __shfl_xor(part, 16); part += __shfl_xor(part, 32);
                    if (fq == 0) red[(ai * HALF + wr * 64 + m * 16 + fr) * 4 + wc] = part;
                }
            }
        asm volatile("s_waitcnt lgkmcnt(0)" ::: "memory");
        __builtin_amdgcn_s_barrier();
        asm volatile("" ::: "memory");
        { const int t_ = opaque_tid(); if (t_ < 256) { const f32x4 r4 = *(const LAS f32x4*)(red + t_ * 4); ssq[(size_t)(u.pm * BM + t_) * 4 + u.pn] = (r4[0] + r4[1]) + (r4[2] + r4[3]); } }
    }
};
struct EpiAct {
    bf16_t* act; const float* ssq;
    __device__ __forceinline__ void operator()(const f32x4 (&acc)[2][2][4][2], const Unit& u, int wr, int wc, int fr, int fq) const {
        const int row0 = u.pm * BM + wr * 64 + fr, col0 = u.pn * HALF + wc * 32 + 8 * fq;
#pragma unroll
        for (int ai = 0; ai < 2; ++ai)
#pragma unroll
            for (int m = 0; m < 4; ++m) {
                const int row = row0 + ai * HALF + m * 16; const float rs = row_rstd(ssq, row);
                f32x4 o[2];
#pragma unroll
                for (int n = 0; n < 2; ++n)
#pragma unroll
                    for (int i = 0; i < 4; ++i) { const float gg = acc[ai][0][m][n][i] * rs, uu = acc[ai][1][m][n][i] * rs; o[n][i] = gg * sigm(gg) * uu; }
                *(u32x4*)(act + (size_t)row * 2816 + col0) = pack8(o[0], o[1]);
            }
    }
};
struct UberEpi { int mode, i0; unsigned char *p0, *p1, *p2; };
__device__ __forceinline__ void run_epi(const UberEpi& E, LAS unsigned char* lds, const f32x4 (&acc)[2][2][4][2], const Unit& u, int wr, int wc, int fr, int fq) {
    switch (E.mode) {
        case 0: { EpiZ e{(bf16_t*)E.p0, (const float*)E.p1, (bf16_t*)E.p2, E.i0}; e(acc, u, wr, wc, fr, fq); break; }
        case 1: { EpiGlu e{(bf16_t*)E.p0}; e(acc, u, wr, wc, fr, fq); break; }
        case 2: { EpiMix<0> e{(bf16_t*)E.p0, E.i0}; e(acc, u, wr, wc, fr, fq); break; }
        case 3: { EpiMix<1> e{(bf16_t*)E.p0, E.i0}; e(acc, u, wr, wc, fr, fq); break; }
        case 4: { EpiRes e{(float*)E.p0, (bf16_t*)E.p1, (float*)E.p2, (LAS float*)(lds + 131072)}; e(acc, u, wr, wc, fr, fq); break; }
        default: { EpiAct e{(bf16_t*)E.p0, (const float*)E.p1}; e(acc, u, wr, wc, fr, fq); break; }
    }
}
}

constexpr int NLAYER = 4, DM = 1024, ZN = 6144, ZW = 6208  , FFH = 2816, RG = 16384, RMAIN = 65536, VTLD = RG + 64  ;
constexpr size_t al256(size_t x) { return (x + 255) & ~(size_t)255; }
constexpr size_t WS_HB = 0;
constexpr size_t WS_SSQ = WS_HB + (size_t)RMAIN * DM * 2;
constexpr size_t WS_Z = WS_SSQ + (size_t)RMAIN * 4 * 4;
constexpr size_t WS_YB = WS_Z + (size_t)RG * ZW * 2;
constexpr size_t WS_VT = WS_YB + (size_t)RG * 512 * 2;
constexpr size_t WS_HGU = WS_VT + (size_t)512 * VTLD * 2;
constexpr size_t WS_HGP = WS_HGU + (size_t)260 * 8 * 4096 * 4;
constexpr size_t WS_S5S = WS_HGP + (size_t)260 * 8 * 64 * 4;
constexpr size_t WS_W = WS_S5S + (size_t)260 * 2048 * 8;
constexpr size_t W_IN = 0, W_UPA = W_IN + (size_t)6144 * 1024 * 2, W_UPB = W_UPA + (size_t)1024 * 256 * 2, W_UPC = W_UPB + (size_t)1024 * 512 * 2,
                 W_O = W_UPC + (size_t)1024 * 256 * 2, W_GU = W_O + (size_t)1024 * 1024 * 2, W_DN = W_GU + (size_t)5632 * 1024 * 2, W_GLU = W_DN + (size_t)1024 * 2816 * 2,
                 W_END = W_GLU + (size_t)256 * 256 * 2;
constexpr size_t WS_TAB = WS_W + W_END;
constexpr size_t T_LBAR = 0, T_L16 = T_LBAR + 2048 * 8, T_L64 = T_L16 + 2048 * 8, T_BFRAG = T_L64 + 2048 * 8, T_CFRAG = T_BFRAG + (size_t)32 * 8 * 64 * 16,
                 T_LB = T_CFRAG + (size_t)32 * 4 * 64 * 16, T_END = T_LB + 256 * 4;
constexpr size_t WS_META = al256(WS_TAB + T_END);
constexpr size_t M_H = 0, M_HB = M_H + (size_t)256 * 1024 * 4, M_SSQ = M_HB + (size_t)256 * 1024 * 2, M_Z = M_SSQ + (size_t)256 * 4 * 4, M_YB = M_Z + (size_t)256 * ZW * 2,
                 M_VT = M_YB + (size_t)256 * 512 * 2, M_ACT = M_VT + (size_t)512 * 256 * 2, M_END = M_ACT + (size_t)256 * FFH * 2;
constexpr size_t WS_CTL = al256(WS_META + M_END);
constexpr size_t CTL_BYTES = 16384;
constexpr size_t WS_TOTAL = WS_CTL + CTL_BYTES;
constexpr int LDS_ST_OFF = 135168;
constexpr int LDS_BYTES = 147456;

struct Args {
    const float *x_prompt, *x_sample, *meta_tokens, *norm1_g, *w_in, *a_re, *a_im, *log_dt, *b_re, *b_im, *c_re, *c_im, *s5_d, *w_glu, *rpb, *lb_logits, *onorm_g,
        *w_up_a, *w_up_b, *w_up_c, *w_o, *norm2_g, *w_gate, *w_up, *w_down, *final_g;
    float* out; unsigned char* ws;
};

__device__ __forceinline__ unsigned long long ufl(unsigned long long v) { const unsigned lo = __builtin_amdgcn_readfirstlane((unsigned)v), hi = __builtin_amdgcn_readfirstlane((unsigned)(v >> 32)); return ((unsigned long long)hi << 32) | lo; }
#define GAS __attribute__((address_space(1)))
template <int OFF> __device__ __forceinline__ unsigned long long ka_load() {
    unsigned long long v; const unsigned long long kp = ufl((unsigned long long)__builtin_amdgcn_kernarg_segment_ptr());
    asm volatile("s_load_dwordx2 %0, %1, %2\n\ts_waitcnt lgkmcnt(0)" : "=s"(v) : "s"(kp), "n"(OFF));
    return v;
}
#define KA(f) ((decltype(Args::f))(GAS char*)ka_load<(int)__builtin_offsetof(Args, f)>())
#define KAF(f) ((const float*)KA(f))
struct Ctx {
    bf16_t *hb, *z, *yb, *vt; float *ssq, *hgu, *hgp, *s5s;
    bf16_t *w; const float *lbar, *l16, *l64; const bf16_t *bfrag, *cfrag; const float* lb;
    float* mh; bf16_t *mhb, *mz, *myb, *mvt, *mact; float* mssq;
};

__device__ __forceinline__ void tr_item(const float* W, int K, int N, bf16_t* WT, const float* kscale, int mode, LAS float* scr, int item, int lane, bool valid) {
    const int nblk = N / 32, kb = item / nblk, nb = item % nblk, k0 = 64 * kb, n0 = 32 * nb;
    if (valid) {
#pragma unroll 8
    for (int i = 0; i < 32; ++i) { const int kk = 2 * i + (lane >> 5); float v = W[(size_t)(k0 + kk) * N + n0 + (lane & 31)]; if (kscale) v *= kscale[k0 + kk]; scr[kk * 33 + (lane & 31)] = v; }
    }
    __syncthreads();
    const int c = lane & 7;
    int drow0 = n0; if (mode) drow0 = (n0 >> 7) * 256 + (n0 & 127) + (mode == 2 ? 128 : 0);
    if (valid) {
#pragma unroll
    for (int j = 0; j < 4; ++j) { const int n = (lane >> 3) + 8 * j; const LAS float* s = scr + (8 * c) * 33 + n;
        u32x4 o; o.x = pk2(s[0 * 33], s[1 * 33]); o.y = pk2(s[2 * 33], s[3 * 33]); o.z = pk2(s[4 * 33], s[5 * 33]); o.w = pk2(s[6 * 33], s[7 * 33]);
        *(u32x4*)(WT + (size_t)(drow0 + n) * K + k0 + 8 * c) = o; }
    }
    __syncthreads();
}

__device__ __forceinline__ void prep_layer(const Ctx& X, int l, LAS unsigned char* lds, int G) {
    const int tid_ = opaque_tid(); const int wave = __builtin_amdgcn_readfirstlane(tid_ >> 6), lane = tid_ & 63;
    LAS float* scr = (LAS float*)(lds + wave * 16384);
    const int gw = blockIdx.x * 8 + wave, NGW = G * 8;
    constexpr int I0 = 16 * 192, I1 = 4 * 32, I2 = 8 * 32, I3 = 4 * 32, I4 = 16 * 32, I5 = 16 * 88, I6 = 16 * 88, I7 = 44 * 32, I8 = 4 * 8;
    constexpr int NIT = I0 + I1 + I2 + I3 + I4 + I5 + I6 + I7 + I8;
    unsigned char* wb = (unsigned char*)X.w;
    for (int it0 = 0; it0 < NIT; it0 += NGW) {
        const int it = it0 + gw; const bool valid = it < NIT;
        int r = valid ? it : 0;
        if (r < I0) { tr_item(KAF(w_in) + (size_t)l * 1024 * 6144, 1024, 6144, (bf16_t*)(wb + W_IN), KAF(norm1_g) + l * 1024, 0, scr, r, lane, valid); continue; } r -= I0;
        if (r < I1) { tr_item(KAF(w_up_a) + (size_t)l * 256 * 1024, 256, 1024, (bf16_t*)(wb + W_UPA), nullptr, 0, scr, r, lane, valid); continue; } r -= I1;
        if (r < I2) { tr_item(KAF(w_up_b) + (size_t)l * 512 * 1024, 512, 1024, (bf16_t*)(wb + W_UPB), nullptr, 0, scr, r, lane, valid); continue; } r -= I2;
        if (r < I3) { tr_item(KAF(w_up_c) + (size_t)l * 256 * 1024, 256, 1024, (bf16_t*)(wb + W_UPC), nullptr, 0, scr, r, lane, valid); continue; } r -= I3;
        if (r < I4) { tr_item(KAF(w_o) + (size_t)l * 1024 * 1024, 1024, 1024, (bf16_t*)(wb + W_O), nullptr, 0, scr, r, lane, valid); continue; } r -= I4;
        if (r < I5) { tr_item(KAF(w_gate) + (size_t)l * 1024 * 2816, 1024, 2816, (bf16_t*)(wb + W_GU), KAF(norm2_g) + l * 1024, 1, scr, r, lane, valid); continue; } r -= I5;
        if (r < I6) { tr_item(KAF(w_up) + (size_t)l * 1024 * 2816, 1024, 2816, (bf16_t*)(wb + W_GU), KAF(norm2_g) + l * 1024, 2, scr, r, lane, valid); continue; } r -= I6;
        if (r < I7) { tr_item(KAF(w_down) + (size_t)l * 2816 * 1024, 2816, 1024, (bf16_t*)(wb + W_DN), nullptr, 0, scr, r, lane, valid); continue; } r -= I7;
        tr_item(KAF(w_glu) + (size_t)l * 256 * 256, 256, 256, (bf16_t*)(wb + W_GLU), nullptr, 0, scr, r, lane, valid);
    }
    const int gt = blockIdx.x * 512 + tid_;
    if (gt < 2048) {
        const int dg = gt >> 6, p = gt & 63;
        const size_t pb = ((size_t)l * 32 + dg);
        const float are = KAF(a_re)[pb * 64 + p], aim = KAF(a_im)[pb * 64 + p], dt = expf(KAF(log_dt)[pb]);
        const float mag = expf(are * dt); float sn, cs; sincosf(aim * dt, &sn, &cs);
        const float lr = mag * cs, li = mag * sn;
        const float den = are * are + aim * aim, nr = lr - 1.0f, ni = li;
        const float zr = (nr * are + ni * aim) / den, zi = (ni * are - nr * aim) / den;
        float* lbar = (float*)X.lbar; float* l16 = (float*)X.l16; float* l64 = (float*)X.l64;
        lbar[gt * 2] = lr; lbar[gt * 2 + 1] = li;
        float pr = lr, pi = li;
#pragma unroll
        for (int s = 0; s < 4; ++s) { const float t = pr * pr - pi * pi; pi = 2.f * pr * pi; pr = t; }
        l16[gt * 2] = pr; l16[gt * 2 + 1] = pi;
#pragma unroll
        for (int s = 0; s < 2; ++s) { const float t = pr * pr - pi * pi; pi = 2.f * pr * pi; pr = t; }
        l64[gt * 2] = pr; l64[gt * 2 + 1] = pi;
        bf16_t* bfr = (bf16_t*)X.bfrag; bf16_t* cfr = (bf16_t*)X.cfrag;
        const int ntr = p >> 4, col = p & 15;
        for (int c = 0; c < 16; ++c) {
            const float br = KAF(b_re)[(pb * 64 + p) * 16 + c], bi = KAF(b_im)[(pb * 64 + p) * 16 + c];
            const float bbr = zr * br - zi * bi, bbi = zr * bi + zi * br;
            const int q = c >> 3, j = c & 7;
            bfr[(((size_t)dg * 8 + ntr) * 64 + col + 16 * q) * 8 + j] = (bf16_t)f2bf(bbr);
            bfr[(((size_t)dg * 8 + 4 + ntr) * 64 + col + 16 * q) * 8 + j] = (bf16_t)f2bf(bbi);
            bfr[(((size_t)dg * 8 + ntr) * 64 + col + 16 * (q + 2)) * 8 + j] = 0;
            bfr[(((size_t)dg * 8 + 4 + ntr) * 64 + col + 16 * (q + 2)) * 8 + j] = 0;
            const float cr = KAF(c_re)[(pb * 16 + c) * 64 + p], ci = KAF(c_im)[(pb * 16 + c) * 64 + p];
            { const int k = p;      cfr[(((size_t)dg * 4 + (k >> 5)) * 64 + c + 16 * ((k >> 3) & 3)) * 8 + (k & 7)] = (bf16_t)f2bf(cr); }
            { const int k = 64 + p; cfr[(((size_t)dg * 4 + (k >> 5)) * 64 + c + 16 * ((k >> 3) & 3)) * 8 + (k & 7)] = (bf16_t)f2bf(-ci); }
        }
    }
    if (gt >= 2048 && gt < 2048 + 256) {
        const int c = gt - 2048;
        const float l0 = KAF(lb_logits)[c], l1 = KAF(lb_logits)[256 + c], l2 = KAF(lb_logits)[512 + c], l3 = KAF(lb_logits)[768 + c];
        const float mx = fmaxf(fmaxf(l0, l1), fmaxf(l2, l3));
        const float e0 = expf(l0 - mx), e1 = expf(l1 - mx), e2 = expf(l2 - mx), e3 = expf(l3 - mx), inv = 1.f / (e0 + e1 + e2 + e3);
        float v = 0.f; if (l >= 1) v += e1 * inv; if (l >= 2) v += e2 * inv; if (l >= 3) v += e3 * inv;
        ((float*)X.lb)[c] = v;
    }
}

struct Grp { int g, nseq, Lr, nch, s0; };
__device__ __forceinline__ Grp make_grp(int g) { Grp r; r.g = g; r.nseq = g < 2 ? 4 : 1; r.Lr = g < 2 ? 4096 : 16384; r.nch = r.Lr / 64 + 1; r.s0 = g < 2 ? g * 4 : 8 + (g - 2); return r; }

template <bool OUT>
__device__ __forceinline__ void s5_chunk(const Ctx& X, const float* s5d, LAS float* buf, bf16_t* zc, int T, int ci, int wave, int lane) {
    const int p = lane, fr = lane & 15, fq = lane >> 4;
    for (int gi = 0; gi < 2; ++gi) {
        const int g = wave * 2 + gi;
        f32x4 yacc[2][2];
#pragma unroll
        for (int i = 0; i < 2; ++i)
#pragma unroll
            for (int j = 0; j < 2; ++j) yacc[i][j] = (f32x4){0.f, 0.f, 0.f, 0.f};
        bf16x8 ua[4];
#pragma unroll
        for (int m4 = 0; m4 < 4; ++m4) { ua[m4] = (bf16x8){0, 0, 0, 0, 0, 0, 0, 0}; if (fq < 2 && m4 * 16 < T) ua[m4] = *(const bf16x8*)(zc + (size_t)(m4 * 16 + fr) * ZW + g * 16 + fq * 8); }
        bf16x8 bfr2[2][8]; float lr2[2], li2[2], xr2[2], xi2[2];
#pragma unroll
        for (int dir = 0; dir < 2; ++dir) {
            const int dg = dir * 16 + g;
#pragma unroll
            for (int nt = 0; nt < 8; ++nt) bfr2[dir][nt] = *(const bf16x8*)(X.bfrag + (((size_t)dg * 8 + nt) * 64 + lane) * 8);
            lr2[dir] = X.lbar[(dg * 64 + p) * 2]; li2[dir] = X.lbar[(dg * 64 + p) * 2 + 1];
            xr2[dir] = 0.f; xi2[dir] = 0.f;
            if (OUT) { const float* st0 = X.s5s + ((size_t)ci * 2048 + dg * 64 + p) * 2; xr2[dir] = st0[0]; xi2[dir] = st0[1]; }
        }
#pragma unroll
        for (int dir = 0; dir < 2; ++dir) {
            const int dg = dir * 16 + g;
            const bf16x8 (&bfr)[8] = bfr2[dir];
            bf16x8 cfr[4];
            if (OUT) {
#pragma unroll
                for (int ks = 0; ks < 4; ++ks) cfr[ks] = *(const bf16x8*)(X.cfrag + (((size_t)dg * 4 + ks) * 64 + lane) * 8);
            }
            const float lr = lr2[dir], li = li2[dir];
            float xr = xr2[dir], xi = xi2[dir];
            float* st = X.s5s + ((size_t)ci * 2048 + dg * 64 + p) * 2;
#pragma unroll
            for (int sti = 0; sti < 2; ++sti) {
                const int stt = dir ? 1 - sti : sti; const int t0 = stt * 32;
                if (t0 < T) {
                    const int tn = (T - t0) < 32 ? (T - t0) : 32;
#pragma unroll
                    for (int mt = 0; mt < 2; ++mt) {
                        if (mt * 16 < tn) {
#pragma unroll
                            for (int nt = 0; nt < 8; ++nt) {
                                const f32x4 c = __builtin_amdgcn_mfma_f32_16x16x32_bf16(ua[stt * 2 + mt], bfr[nt], (f32x4){0.f, 0.f, 0.f, 0.f}, 0, 0, 0);
#pragma unroll
                                for (int r = 0; r < 4; ++r) buf[(mt * 16 + fq * 4 + r) * 132 + nt * 16 + fr] = c[r];
                            }
                        }
                    }
                    __syncthreads();
                    for (int k0 = 0; k0 < tn; k0 += 8) {
                        float br[8], bi[8];
#pragma unroll
                        for (int j = 0; j < 8; ++j) { const int t = dir ? (tn - 1 - k0 - j) : k0 + j; br[j] = buf[t * 132 + p]; bi[j] = buf[t * 132 + 64 + p]; }
#pragma unroll
                        for (int j = 0; j < 8; ++j) {
                            const int t = dir ? (tn - 1 - k0 - j) : k0 + j;
                            const float nr = lr * xr - li * xi + br[j], ni = lr * xi + li * xr + bi[j];
                            xr = nr; xi = ni;
                            if (OUT) { buf[t * 132 + p] = xr; buf[t * 132 + 64 + p] = xi; }
                        }
                    }
                    if (OUT) {
                        __syncthreads();
#pragma unroll
                        for (int mt = 0; mt < 2; ++mt) {
                            if (mt * 16 < tn) {
#pragma unroll
                                for (int ks = 0; ks < 4; ++ks) {
                                    const LAS float* ap = buf + (mt * 16 + fr) * 132 + ks * 32 + fq * 8;
                                    const f32x4 a0 = *(const LAS f32x4*)ap, a1 = *(const LAS f32x4*)(ap + 4);
                                    const u32x4 aw = pack8(a0, a1);
                                    const bf16x8 av = __builtin_bit_cast(bf16x8, aw);
                                    yacc[stt][mt] = __builtin_amdgcn_mfma_f32_16x16x32_bf16(av, cfr[ks], yacc[stt][mt], 0, 0, 0);
                                }
                            }
                        }
                    }
                    __syncthreads();
                }
            }
            if (!OUT) { st[0] = xr; st[1] = xi; }
        }
        if (OUT) {
            const float dsk = s5d[g * 16 + fr];
            float uv[16];
#pragma unroll
            for (int q4 = 0; q4 < 4; ++q4)
#pragma unroll
                for (int r = 0; r < 4; ++r) { uv[q4 * 4 + r] = 0.f; if (q4 * 16 < T) uv[q4 * 4 + r] = bf2f(zc[(size_t)(q4 * 16 + fq * 4 + r) * ZW + g * 16 + fr]); }
#pragma unroll
            for (int stt = 0; stt < 2; ++stt)
#pragma unroll
                for (int mt = 0; mt < 2; ++mt) {
                    if (stt * 32 + mt * 16 < T) {
#pragma unroll
                        for (int r = 0; r < 4; ++r) {
                            const int t = stt * 32 + mt * 16 + fq * 4 + r;
                            const float y = gelu_tanh(yacc[stt][mt][r] + dsk * uv[(stt * 2 + mt) * 4 + r]);
                            zc[(size_t)t * ZW + 512 + g * 16 + fr] = (bf16_t)f2bf(y);
                        }
                    }
                }
        }
    }
}

__device__ __forceinline__ void s5_passB(const Ctx& X, const Grp& gp, int gtid, int GT) {
    const int n = gp.nseq * 2048;
    for (int e = gtid; e < n; e += GT) {
        const int sl = e >> 11, r = e & 2047, dir = r >> 10;
        const float l16r = X.l16[r * 2], l16i = X.l16[r * 2 + 1], l64r = X.l64[r * 2], l64i = X.l64[r * 2 + 1];
        float* base = X.s5s + ((size_t)(sl * gp.nch) * 2048 + r) * 2; const long cstep = dir ? -4096 : 4096; float* first = dir ? base + (size_t)(gp.nch - 1) * 4096 : base;
        float sr = 0.f, si = 0.f;
        float er[2][8], ei[2][8];
#pragma unroll
        for (int j = 0; j < 8; ++j) { er[0][j] = 0.f; ei[0][j] = 0.f; if (j < gp.nch) { const float* pp = first + (long)j * cstep; er[0][j] = pp[0]; ei[0][j] = pp[1]; } }
        for (int k0 = 0; k0 < gp.nch; k0 += 16) {
#pragma unroll
            for (int hb = 0; hb < 2; ++hb) {
                const int kb = k0 + hb * 8;
                if (kb < gp.nch) {
#pragma unroll
                    for (int j = 0; j < 8; ++j) { const int k = kb + 8 + j; er[1 - hb][j] = 0.f; ei[1 - hb][j] = 0.f; if (k < gp.nch) { const float* pp = first + (long)k * cstep; er[1 - hb][j] = pp[0]; ei[1 - hb][j] = pp[1]; } }
#pragma unroll
                    for (int j = 0; j < 8; ++j) { const int k = kb + j; if (k < gp.nch) { float* pp = first + (long)k * cstep; pp[0] = sr; pp[1] = si;
                            const int c = dir ? gp.nch - 1 - k : k;
                            const float pr = c == 0 ? l16r : l64r, pi = c == 0 ? l16i : l64i;
                            const float nr = pr * sr - pi * si + er[hb][j], ni = pr * si + pi * sr + ei[hb][j]; sr = nr; si = ni; } }
                }
            }
        }
    }
}

typedef short v4i16_t __attribute__((ext_vector_type(4)));
__device__ __forceinline__ v4i16_t vtr16(const LAS unsigned char* p) { return __builtin_amdgcn_ds_read_tr16_b64_v4i16((LAS v4i16_t*)p); }
template <bool OUT>
__device__ __forceinline__ void hg_chunk(const Ctx& X, LAS float* gt, LAS bf16_t* ot, const bf16_t* zc, int T, int ci, int wave, int lane) {
    const int h = wave >> 1, dir = wave & 1;
    float S[64];
    float* U = X.hgu + ((size_t)ci * 8 + wave) * 4096;
    if (OUT) {
#pragma unroll
        for (int d = 0; d < 64; ++d) S[d] = U[d * 64 + lane];
    } else {
#pragma unroll
        for (int d = 0; d < 64; ++d) S[d] = 0.f;
    }
    const float lbv = X.lb[h * 64 + lane], oml = 1.f - lbv; float P = 1.f;
    const int fcol = (dir ? 2304 : 2048) + h * 64 + lane, qcol = 1792 + h * 64 + lane, vcol = 2560 + h * 64 + lane;
    const int ns8 = T >> 3;
    bf16_t rq[8], rf[8], rv[8];
    {
        const int sb0 = dir ? (ns8 - 1) : 0;
#pragma unroll
        for (int j = 0; j < 8; ++j) { const bf16_t* zr = zc + (size_t)(sb0 * 8 + j) * ZW; rq[j] = zr[qcol]; rf[j] = zr[fcol]; rv[j] = zr[vcol]; }
    }
#pragma unroll 1
    for (int s8 = 0; s8 < ns8; ++s8) {
        const int sb = dir ? (ns8 - 1 - s8) : s8;
#pragma unroll
        for (int j = 0; j < 8; ++j) {
            const float q = bf2f(rq[j]), ff = bf2f(rf[j]);
            const float sg = sigm(ff), fg = lbv + oml * sg, kk = oml * (1.f - sg);
            gt[j * 256 + lane] = fg; gt[j * 256 + 64 + lane] = kk; gt[j * 256 + 128 + lane] = q * sigm(q); gt[j * 256 + 192 + lane] = bf2f(rv[j]);
            P *= fg;
        }
        __syncthreads();
        if (s8 + 1 < ns8) {
            const int sbn = dir ? (ns8 - 2 - s8) : s8 + 1;
#pragma unroll
            for (int j = 0; j < 8; ++j) { const bf16_t* zr = zc + (size_t)(sbn * 8 + j) * ZW; rq[j] = zr[qcol]; rf[j] = zr[fcol]; rv[j] = zr[vcol]; }
        }
#pragma unroll 1
        for (int jj = 0; jj < 8; ++jj) {
            const int j = dir ? 7 - jj : jj;
            const LAS float* gj = gt + j * 256;
            const float v = gj[192 + lane];
            float o = 0.f;
#pragma unroll
            for (int d4 = 0; d4 < 16; ++d4) {
                const f32x4 f4 = *(const LAS f32x4*)(gj + d4 * 4), k4 = *(const LAS f32x4*)(gj + 64 + d4 * 4);
#pragma unroll
                for (int i = 0; i < 4; ++i) S[d4 * 4 + i] = f4[i] * S[d4 * 4 + i] + k4[i] * v;
                if (OUT) { const f32x4 q4 = *(const LAS f32x4*)(gj + 128 + d4 * 4);
#pragma unroll
                    for (int i = 0; i < 4; ++i) o += S[d4 * 4 + i] * q4[i]; }
                if ((d4 & 3) == 3) __builtin_amdgcn_sched_barrier(0);
            }
            if (OUT) ot[(sb * 8 + j) * 64 + lane] = (bf16_t)f2bf(o);
        }
        __syncthreads();
    }
    if (!OUT) {
#pragma unroll
        for (int d = 0; d < 64; ++d) U[d * 64 + lane] = S[d];
        X.hgp[((size_t)ci * 8 + wave) * 64 + lane] = P;
    }
}

__device__ __forceinline__ void hg_passA_mfma(const Ctx& X, LAS unsigned char* wl, const bf16_t* zc, int T, int ci, int wave, int lane) {
    const int h = wave >> 1, dir = wave & 1, fq = lane >> 4, l16 = lane & 15, r8 = lane >> 3, pc = lane & 7;
    LAS unsigned char* kl = wl; LAS unsigned char* vl = wl + 4608;
    const float lbv = X.lb[h * 64 + lane], oml = 1.f - lbv;
    const int fcol = (dir ? 2304 : 2048) + h * 64 + lane, vcolb = 2560 + h * 64 + pc * 8;
    f32x4 acc[4][4];
#pragma unroll
    for (int a = 0; a < 4; ++a)
#pragma unroll
        for (int b = 0; b < 4; ++b) acc[a][b] = (f32x4){0.f, 0.f, 0.f, 0.f};
    float run = 1.f;
    const int nh = (T + 31) >> 5;
#pragma unroll 1
    for (int hh = 0; hh < nh; ++hh) {
        const int hb = dir ? hh : (nh - 1 - hh); const int t0 = hb * 32; const int tn = (T - t0) < 32 ? (T - t0) : 32;
        u32x4 vr[4];
#pragma unroll
        for (int i = 0; i < 4; ++i) { const int rr = i * 8 + r8; vr[i] = (u32x4){0u, 0u, 0u, 0u}; if (rr < tn) vr[i] = *(const u32x4*)(zc + (size_t)(t0 + rr) * ZW + vcolb); }
        __syncthreads();
#pragma unroll 1
        for (int bt = 0; bt < 2; ++bt) {
            const int j0 = (dir ? bt : 1 - bt) * 16;
            bf16_t rf[16];
#pragma unroll
            for (int j = 0; j < 16; ++j) { rf[j] = 0; if (j0 + j < tn) rf[j] = zc[(size_t)(t0 + j0 + j) * ZW + fcol]; }
#pragma unroll
            for (int jj = 0; jj < 16; ++jj) {
                const int jl = dir ? jj : 15 - jj; const int j = j0 + jl;
                float kh = 0.f;
                if (j < tn) { const float sg = sigm(bf2f(dir ? rf[jj] : rf[15 - jj])); kh = oml * (1.f - sg) * run; run *= lbv + oml * sg; }
                *(LAS bf16_t*)(kl + j * 144 + lane * 2) = (bf16_t)f2bf(kh);
            }
        }
#pragma unroll
        for (int i = 0; i < 4; ++i) *(LAS u32x4*)(vl + (i * 8 + r8) * 144 + pc * 16) = vr[i];
        __syncthreads();
        const int roff = (4 * fq + (l16 >> 2)) * 144 + (4 * (l16 & 3)) * 2;
        bf16x8 af[4];
#pragma unroll
        for (int mt = 0; mt < 4; ++mt) { const v4i16_t ta = vtr16(kl + roff + mt * 32), tb = vtr16(kl + roff + 16 * 144 + mt * 32); af[mt] = (bf16x8){ta[0], ta[1], ta[2], ta[3], tb[0], tb[1], tb[2], tb[3]}; }
#pragma unroll
        for (int nt = 0; nt < 4; ++nt) {
            const v4i16_t ta = vtr16(vl + roff + nt * 32), tb = vtr16(vl + roff + 16 * 144 + nt * 32);
            const bf16x8 bfv = (bf16x8){ta[0], ta[1], ta[2], ta[3], tb[0], tb[1], tb[2], tb[3]};
#pragma unroll
            for (int mt = 0; mt < 4; ++mt) acc[mt][nt] = __builtin_amdgcn_mfma_f32_16x16x32_bf16(af[mt], bfv, acc[mt][nt], 0, 0, 0);
        }
    }
    float* U = X.hgu + ((size_t)ci * 8 + wave) * 4096 + (4 * fq) * 64 + l16;
#pragma unroll
    for (int mt = 0; mt < 4; ++mt) {
#pragma unroll
        for (int r = 0; r < 4; ++r)
#pragma unroll
            for (int nt = 0; nt < 4; ++nt) U[(16 * mt + r) * 64 + 16 * nt] = acc[mt][nt][r];
        __builtin_amdgcn_sched_barrier(0);
    }
    X.hgp[((size_t)ci * 8 + wave) * 64 + lane] = run;
}

__device__ __forceinline__ void hg_passC_mfma(const Ctx& X, LAS unsigned char* wl, LAS bf16_t* ot, const bf16_t* zc, int T, int ci, int wave, int lane) {
    const int h = wave >> 1, dir = wave & 1, fq = lane >> 4, l16 = lane & 15, r8 = lane >> 3, pc = lane & 7;
    LAS unsigned char* ql = wl; LAS unsigned char* kl = wl + 2304; LAS unsigned char* vl = wl + 4608; LAS float* pl = (LAS float*)(wl + 6912);
    const float lbv = X.lb[h * 64 + lane], oml = 1.f - lbv;
    const int fcol = (dir ? 2304 : 2048) + h * 64 + lane, qcol = 1792 + h * 64 + lane, vcolb = 2560 + h * 64 + pc * 8;
    f32x4 sa[4][4];
    {
        const float* U = X.hgu + ((size_t)ci * 8 + wave) * 4096 + (4 * fq) * 64 + l16;
#pragma unroll
        for (int mt = 0; mt < 4; ++mt) {
#pragma unroll
            for (int r = 0; r < 4; ++r)
#pragma unroll
                for (int nt = 0; nt < 4; ++nt) sa[mt][nt][r] = U[(16 * mt + r) * 64 + 16 * nt];
            __builtin_amdgcn_sched_barrier(0);
        }
    }
    const int nsc = T >> 4;
    bf16_t rq[16], rf[16]; u32x4 vr[2];
    {
        const int I0 = dir ? (nsc - 1) : 0;
#pragma unroll
        for (int i = 0; i < 16; ++i) { const int tok = 16 * I0 + (dir ? 15 - i : i); rq[i] = zc[(size_t)tok * ZW + qcol]; rf[i] = zc[(size_t)tok * ZW + fcol]; }
#pragma unroll
        for (int i8 = 0; i8 < 2; ++i8) { const int i = i8 * 8 + r8; const int tok = 16 * I0 + (dir ? 15 - i : i); vr[i8] = *(const u32x4*)(zc + (size_t)tok * ZW + vcolb); }
    }
#pragma unroll 1
    for (int sc = 0; sc < nsc; ++sc) {
        const int I = dir ? (nsc - 1 - sc) : sc;
        __syncthreads();
        float c = 1.f;
#pragma unroll
        for (int i = 0; i < 16; ++i) {
            const float q = bf2f(rq[i]), sg = sigm(bf2f(rf[i]));
            c *= lbv + oml * sg;
            *(LAS bf16_t*)(ql + i * 144 + lane * 2) = (bf16_t)f2bf(q * sigm(q) * c);
            *(LAS bf16_t*)(kl + i * 144 + lane * 2) = (bf16_t)f2bf(oml * (1.f - sg) / c);
        }
        pl[lane] = c;
#pragma unroll
        for (int i8 = 0; i8 < 2; ++i8) *(LAS u32x4*)(vl + (i8 * 8 + r8) * 144 + pc * 16) = vr[i8];
        __syncthreads();
        if (sc + 1 < nsc) {
            const int In = dir ? (nsc - 2 - sc) : sc + 1;
#pragma unroll
            for (int i = 0; i < 16; ++i) { const int tok = 16 * In + (dir ? 15 - i : i); rq[i] = zc[(size_t)tok * ZW + qcol]; rf[i] = zc[(size_t)tok * ZW + fcol]; }
#pragma unroll
            for (int i8 = 0; i8 < 2; ++i8) { const int i = i8 * 8 + r8; const int tok = 16 * In + (dir ? 15 - i : i); vr[i8] = *(const u32x4*)(zc + (size_t)tok * ZW + vcolb); }
        }
        f32x4 at = (f32x4){0.f, 0.f, 0.f, 0.f};
#pragma unroll
        for (int ks = 0; ks < 2; ++ks) at = __builtin_amdgcn_mfma_f32_16x16x32_bf16(*(const LAS bf16x8*)(kl + l16 * 144 + (32 * ks + 8 * fq) * 2), *(const LAS bf16x8*)(ql + l16 * 144 + (32 * ks + 8 * fq) * 2), at, 0, 0, 0);
#pragma unroll
        for (int r = 0; r < 4; ++r) if (4 * fq + r > l16) at[r] = 0.f;
        const bf16x8 atf = __builtin_bit_cast(bf16x8, pack8(at, (f32x4){0.f, 0.f, 0.f, 0.f}));
        const int roff = (4 * fq + (l16 >> 2)) * 144 + (4 * (l16 & 3)) * 2;
        f32x4 oT[4];
#pragma unroll
        for (int et = 0; et < 4; ++et) {
            const v4i16_t tv = vtr16(vl + roff + et * 32);
            const bf16x8 vf = (bf16x8){tv[0], tv[1], tv[2], tv[3], 0, 0, 0, 0};
            oT[et] = __builtin_amdgcn_mfma_f32_16x16x32_bf16(vf, atf, (f32x4){0.f, 0.f, 0.f, 0.f}, 0, 0, 0);
        }
#pragma unroll
        for (int kp = 0; kp < 2; ++kp) {
            const u32x2 q0 = *(const LAS u32x2*)(ql + l16 * 144 + (32 * kp + 4 * fq) * 2), q1 = *(const LAS u32x2*)(ql + l16 * 144 + (32 * kp + 16 + 4 * fq) * 2);
            const bf16x8 qfr = __builtin_bit_cast(bf16x8, (u32x4){q0.x, q0.y, q1.x, q1.y});
#pragma unroll
            for (int nt = 0; nt < 4; ++nt) {
                const bf16x8 sf = __builtin_bit_cast(bf16x8, pack8(sa[2 * kp][nt], sa[2 * kp + 1][nt]));
                oT[nt] = __builtin_amdgcn_mfma_f32_16x16x32_bf16(sf, qfr, oT[nt], 0, 0, 0);
            }
        }
        {
            const int tok = 16 * I + (dir ? 15 - l16 : l16);
#pragma unroll
            for (int et = 0; et < 4; ++et)
#pragma unroll
                for (int r = 0; r < 4; ++r) ot[tok * 64 + 16 * et + 4 * fq + r] = (bf16_t)f2bf(oT[et][r]);
        }
        bf16x8 kf[4];
#pragma unroll
        for (int mt = 0; mt < 4; ++mt) { const v4i16_t tk = vtr16(kl + roff + mt * 32); kf[mt] = (bf16x8){tk[0], tk[1], tk[2], tk[3], 0, 0, 0, 0}; }
#pragma unroll
        for (int nt = 0; nt < 4; ++nt) {
            const v4i16_t tv = vtr16(vl + roff + nt * 32);
            const bf16x8 vf = (bf16x8){tv[0], tv[1], tv[2], tv[3], 0, 0, 0, 0};
#pragma unroll
            for (int mt = 0; mt < 4; ++mt) sa[mt][nt] = __builtin_amdgcn_mfma_f32_16x16x32_bf16(kf[mt], vf, sa[mt][nt], 0, 0, 0);
        }
#pragma unroll
        for (int mt = 0; mt < 4; ++mt) {
            const f32x4 p4 = *(const LAS f32x4*)(pl + 16 * mt + 4 * fq);
#pragma unroll
            for (int nt = 0; nt < 4; ++nt) sa[mt][nt] = sa[mt][nt] * p4;
        }
    }
}

__device__ __forceinline__ void hg_passB(const Ctx& X, const Grp& gp, int gtid, int GT) {
    const int n = gp.nseq * 32768;
    for (int e = gtid; e < n; e += GT) {
        const int sl = e >> 15, r = e & 32767, hd = r >> 12, de = r & 4095, d = de >> 6, dir = hd & 1;
        const size_t cb0 = (size_t)(sl * gp.nch) * 8 + hd; const int cstep = dir ? -8 : 8; const size_t cfirst = dir ? cb0 + (size_t)(gp.nch - 1) * 8 : cb0;
        float s = 0.f;
        float u[2][8], pv[2][8];
#pragma unroll
        for (int j = 0; j < 8; ++j) { u[0][j] = 0.f; pv[0][j] = 0.f; if (j < gp.nch) { const size_t cb = cfirst + (long)j * cstep; u[0][j] = X.hgu[cb * 4096 + de]; pv[0][j] = X.hgp[cb * 64 + d]; } }
        for (int k0 = 0; k0 < gp.nch; k0 += 16) {
#pragma unroll
            for (int hb = 0; hb < 2; ++hb) {
                const int kb = k0 + hb * 8;
                if (kb < gp.nch) {
#pragma unroll
                    for (int j = 0; j < 8; ++j) { const int k = kb + 8 + j; u[1 - hb][j] = 0.f; pv[1 - hb][j] = 0.f; if (k < gp.nch) { const size_t cb = cfirst + (long)k * cstep; u[1 - hb][j] = X.hgu[cb * 4096 + de]; pv[1 - hb][j] = X.hgp[cb * 64 + d]; } }
#pragma unroll
                    for (int j = 0; j < 8; ++j) { const int k = kb + j; if (k < gp.nch) { const size_t cb = cfirst + (long)k * cstep; X.hgu[cb * 4096 + de] = s; s = pv[hb][j] * s + u[hb][j]; } }
                }
            }
        }
    }
}

__device__ __forceinline__ void na_task(const Ctx& X, const float* rpb, const Grp& gp, int sl, int task, bool metaq, int wave, int lane, LAS unsigned char* vl) {
    const int h = wave, fr = lane & 15, fq = lane >> 4;
    const int s = gp.s0 + sl, rows = gp.Lr >> 6;
    int r = 0, n = 0, rs = 0, ks = 0;
    const bf16_t* qptr; bf16_t* optr; size_t ostride = 512;
    if (metaq) { qptr = X.mz + (size_t)(s * 16 + fr) * ZW; optr = X.myb + (size_t)(s * 16) * 512; }
    else {
        r = task >> 2; n = task & 3;
        rs = r - 4; rs = rs < 0 ? 0 : (rs > rows - 8 ? rows - 8 : rs);
        ks = 16 * n - 8; ks = ks < 0 ? 0 : (ks > 32 ? 32 : ks);
        const size_t qrow0 = (size_t)sl * gp.Lr + r * 64 + 16 * n;
        qptr = X.z + (qrow0 + fr) * ZW; optr = X.yb + qrow0 * 512;
    }
    bf16x8 qf[2];
#pragma unroll
    for (int kk = 0; kk < 2; ++kk) qf[kk] = *(const bf16x8*)(qptr + 256 + h * 64 + 32 * kk + 8 * fq);
    f32x4 sc[17];
    {
        const bf16_t* kp = X.mz + (size_t)(s * 16 + fr) * ZW + 768 + h * 64 + 8 * fq;
        f32x4 c = (f32x4){0.f, 0.f, 0.f, 0.f};
#pragma unroll
        for (int kk = 0; kk < 2; ++kk) c = __builtin_amdgcn_mfma_f32_16x16x32_bf16(*(const bf16x8*)(kp + 32 * kk), qf[kk], c, 0, 0, 0);
        sc[0] = c * 0.125f;
    }
    const int qc = 16 * n + fr;
    int wstart = qc - 8; wstart = wstart < 0 ? 0 : (wstart > 48 ? 48 : wstart);
    const size_t krow_base = (size_t)sl * gp.Lr + (size_t)rs * 64 + ks;
    const int r8v = lane >> 3, pcv = lane & 7; const int vcolv = 1280 + h * 64 + pcv * 8;
    u32x4 vpre0[2], vpre1[8];
#pragma unroll
    for (int i = 0; i < 2; ++i) vpre0[i] = *(const u32x4*)(X.mz + (size_t)(s * 16 + i * 8 + r8v) * ZW + vcolv);
#pragma unroll
    for (int i = 0; i < 8; ++i) { vpre1[i] = (u32x4){0u, 0u, 0u, 0u}; if (!metaq) { const int rr = i * 8 + r8v; vpre1[i] = *(const u32x4*)(X.z + (krow_base + (size_t)(rr >> 5) * 64 + (rr & 31)) * ZW + vcolv); } }
    if (!metaq) {
#pragma unroll
        for (int tb = 0; tb < 2; ++tb) {
            bf16x8 kf[8][2]; float bz[8][4];
#pragma unroll
            for (int t4 = 0; t4 < 8; ++t4) {
                const int tt = tb * 8 + t4, kj = tt >> 1, half = tt & 1;
                const bf16_t* kp = X.z + (krow_base + kj * 64 + 16 * half + fr) * ZW + 768 + h * 64 + 8 * fq;
                kf[t4][0] = *(const bf16x8*)kp; kf[t4][1] = *(const bf16x8*)(kp + 32);
            }
#pragma unroll
            for (int t4 = 0; t4 < 8; ++t4) {
                const int tt = tb * 8 + t4, kj = tt >> 1, half = tt & 1;
                const float* rp = rpb + (h * 15 + (rs + kj - r + 7)) * 31;
#pragma unroll
                for (int i = 0; i < 4; ++i) { int dc = ks + 16 * half + 4 * fq + i - qc; dc = dc < -15 ? -15 : (dc > 15 ? 15 : dc); bz[t4][i] = rp[dc + 15]; }
            }
            __builtin_amdgcn_sched_barrier(0);
#pragma unroll
            for (int t4 = 0; t4 < 8; ++t4) {
                const int tt = tb * 8 + t4, half = tt & 1;
                f32x4 c = (f32x4){0.f, 0.f, 0.f, 0.f};
                c = __builtin_amdgcn_mfma_f32_16x16x32_bf16(kf[t4][0], qf[0], c, 0, 0, 0);
                c = __builtin_amdgcn_mfma_f32_16x16x32_bf16(kf[t4][1], qf[1], c, 0, 0, 0);
#pragma unroll
                for (int i = 0; i < 4; ++i) {
                    const int kc = ks + 16 * half + 4 * fq + i;
                    const bool valid = (kc >= wstart) && (kc < wstart + 16);
                    c[i] = valid ? c[i] * 0.125f + bz[t4][i] : -1e30f;
                }
                sc[1 + tt] = c;
            }
            __builtin_amdgcn_sched_barrier(0);
        }
    } else {
#pragma unroll
        for (int tt = 0; tt < 16; ++tt) sc[1 + tt] = (f32x4){-1e30f, -1e30f, -1e30f, -1e30f};
    }
    float mx = -1e30f;
#pragma unroll
    for (int t = 0; t < 17; ++t)
#pragma unroll
        for (int i = 0; i < 4; ++i) mx = fmaxf(mx, sc[t][i]);
    mx = fmaxf(mx, __shfl_xor(mx, 16)); mx = fmaxf(mx, __shfl_xor(mx, 32));
    float sum = 0.f;
#pragma unroll
    for (int t = 0; t < 17; ++t)
#pragma unroll
        for (int i = 0; i < 4; ++i) { const float e = __expf(sc[t][i] - mx); sc[t][i] = e; sum += e; }
    sum += __shfl_xor(sum, 16); sum += __shfl_xor(sum, 32);
    const float inv = 1.f / sum;
    f32x4 oacc[4];
#pragma unroll
    for (int et = 0; et < 4; ++et) oacc[et] = (f32x4){0.f, 0.f, 0.f, 0.f};
    {
        const int r8 = lane >> 3, pc = lane & 7, l16 = lane & 15;
        const int vcol = 1280 + h * 64 + pc * 8;
        u32x4 vreg[8];
#pragma unroll
        for (int i = 0; i < 2; ++i) vreg[i] = vpre0[i];
#pragma unroll
        for (int cc = 0; cc < 5; ++cc) {
            if (cc > 0 && metaq) break;
            __syncthreads();
#pragma unroll
            for (int i = 0; i < 8; ++i) if (cc > 0 || i < 2) *(LAS u32x4*)(vl + (i * 8 + r8) * 144 + pc * 16) = vreg[i];
            __syncthreads();
            if (cc < 4 && !metaq) {
#pragma unroll
                for (int i = 0; i < 8; ++i) { const int rr = i * 8 + r8;
                    if (cc == 0) vreg[i] = vpre1[i];
                    else vreg[i] = *(const u32x4*)(X.z + (krow_base + (size_t)(2 * cc + (rr >> 5)) * 64 + (rr & 31)) * ZW + vcol); }
            }
#pragma unroll
            for (int ksl = 0; ksl < 2; ++ksl) {
                if (cc == 0 && ksl == 1) break;
                const int tt = 4 * (cc - 1) + 2 * ksl;
                f32x4 pa, pb;
                if (cc == 0) { pa = sc[0] * inv; pb = (f32x4){0.f, 0.f, 0.f, 0.f}; } else { pa = sc[1 + tt] * inv; pb = sc[2 + tt] * inv; }
                const bf16x8 pf = __builtin_bit_cast(bf16x8, pack8(pa, pb));
                const LAS unsigned char* rowp = vl + (32 * ksl + 4 * fq + (l16 >> 2)) * 144 + (4 * (l16 & 3)) * 2;
#pragma unroll
                for (int et = 0; et < 4; ++et) {
                    const v4i16_t ta = vtr16(rowp + et * 32);
                    v4i16_t tb = (v4i16_t){0, 0, 0, 0};
                    if (cc > 0) tb = vtr16(rowp + 16 * 144 + et * 32);
                    const bf16x8 vw = (bf16x8){ta[0], ta[1], ta[2], ta[3], tb[0], tb[1], tb[2], tb[3]};
                    oacc[et] = __builtin_amdgcn_mfma_f32_16x16x32_bf16(pf, vw, oacc[et], 0, 0, 0);
                }
            }
        }
    }
#pragma unroll
    for (int et = 0; et < 4; ++et)
#pragma unroll
        for (int i = 0; i < 4; ++i) optr[(size_t)(4 * fq + i) * ostride + h * 64 + et * 16 + fr] = (bf16_t)f2bf(oacc[et][i]);
}

#define XB_TMO      128
#define XB_XCNT(j)  (256  + 64 * (j))
#define XB_XSUB(j)  (1280 + 64 * (j))
#define XB_XGEN(j)  (2304 + 64 * (j))
#define XB_TOP      3328
#define XB_TOPGEN   3392
#define XCD_BAR_WORDS 3456
#define XB_SPIN_CAP (1u << 22)
__device__ __forceinline__ unsigned xb_ld(unsigned* p)              { return __hip_atomic_load(p, __ATOMIC_RELAXED, __HIP_MEMORY_SCOPE_AGENT); }
__device__ __forceinline__ unsigned xb_add(unsigned* p, unsigned v) { return __hip_atomic_fetch_add(p, v, __ATOMIC_RELAXED, __HIP_MEMORY_SCOPE_AGENT); }
__device__ __forceinline__ unsigned xb_xcc_id() { return (unsigned)__builtin_amdgcn_s_getreg((3 << 11) | 20) & 0xFu; }
#define XB_SPIN(cond, bar) do { unsigned _sp = 0; while (cond) { __builtin_amdgcn_s_sleep(1); \
    if ((++_sp & 255u) == 0u) { if (xb_ld(&(bar)[XB_TMO])) break; if (_sp > XB_SPIN_CAP) { atomicAdd(&(bar)[XB_TMO], 1u); break; } } } } while (0)
__device__ __forceinline__ void xcd_barrier_complete(unsigned* bar, unsigned x, unsigned& nloc, unsigned& nx) {
    const unsigned G = gridDim.x * gridDim.y * gridDim.z;
    unsigned sum, cnt, mine, sp = 0u;
    for (;;) {
        sum = 0u; cnt = 0u; mine = 0u;
#pragma unroll
        for (unsigned j = 0; j < 16; ++j) { const unsigned c = xb_ld(&bar[XB_XCNT(j)]); sum += c; cnt += (c > 0u) ? 1u : 0u; mine = (j == x) ? c : mine; }
        if (sum == G) break;
        __builtin_amdgcn_s_sleep(1);
        if ((++sp & 255u) == 0u) { if (xb_ld(&bar[XB_TMO])) break; if (sp > XB_SPIN_CAP) { atomicAdd(&bar[XB_TMO], 1u); break; } }
    }
    nloc = mine > 0u ? mine : 1u; nx = cnt > 0u ? cnt : 1u;
}
__device__ __forceinline__ void xcd_barrier(unsigned* bar, volatile LAS unsigned* st) {
    asm volatile("s_waitcnt vmcnt(0)" ::: "memory");
    __syncthreads();
    if (threadIdx.x == 0) {
        const unsigned x = xb_xcc_id();
        __builtin_amdgcn_s_waitcnt(0);
        unsigned nloc = st[0], nx = st[1];
        if (nloc == 0u) { xcd_barrier_complete(bar, x, nloc, nx); st[0] = nloc; st[1] = nx; }
        const unsigned old = xb_add(&bar[XB_XSUB(x)], 1u);
        const unsigned gen = old / nloc;
        if (old + 1u == (gen + 1u) * nloc) {
            __builtin_amdgcn_fence(__ATOMIC_RELEASE, "agent");
            asm volatile("s_waitcnt vmcnt(0)" ::: "memory");
            const unsigned og = xb_add(&bar[XB_TOP], 1u);
            const unsigned tg = og / nx;
            if (og + 1u == (tg + 1u) * nx) xb_add(&bar[XB_TOPGEN], 1u);
            else XB_SPIN(xb_ld(&bar[XB_TOPGEN]) == tg, bar);
            __builtin_amdgcn_fence(__ATOMIC_ACQUIRE, "agent");
            xb_add(&bar[XB_XGEN(x)], 1u);
            asm volatile("s_waitcnt vmcnt(0)" ::: "memory");
        } else {
            XB_SPIN(xb_ld(&bar[XB_XGEN(x)]) == gen, bar);
            __builtin_amdgcn_fence(__ATOMIC_ACQUIRE, "agent");
            asm volatile("s_waitcnt vmcnt(0)" ::: "memory");
        }
    }
    __syncthreads();
}
#define GRID_SYNC() xcd_barrier((unsigned*)(KA(ws) + WS_CTL), (volatile LAS unsigned*)(lds + LDS_ST_OFF))
__device__ __forceinline__ Ctx make_ctx(unsigned char* ws) {
    Ctx X;
    X.hb = (bf16_t*)(ws + WS_HB); X.ssq = (float*)(ws + WS_SSQ); X.z = (bf16_t*)(ws + WS_Z); X.yb = (bf16_t*)(ws + WS_YB); X.vt = (bf16_t*)(ws + WS_VT);
    X.hgu = (float*)(ws + WS_HGU); X.hgp = (float*)(ws + WS_HGP); X.s5s = (float*)(ws + WS_S5S); X.w = (bf16_t*)(ws + WS_W);
    X.lbar = (const float*)(ws + WS_TAB + T_LBAR); X.l16 = (const float*)(ws + WS_TAB + T_L16); X.l64 = (const float*)(ws + WS_TAB + T_L64);
    X.bfrag = (const bf16_t*)(ws + WS_TAB + T_BFRAG); X.cfrag = (const bf16_t*)(ws + WS_TAB + T_CFRAG); X.lb = (const float*)(ws + WS_TAB + T_LB);
    X.mh = (float*)(ws + WS_META + M_H); X.mhb = (bf16_t*)(ws + WS_META + M_HB); X.mssq = (float*)(ws + WS_META + M_SSQ); X.mz = (bf16_t*)(ws + WS_META + M_Z);
    X.myb = (bf16_t*)(ws + WS_META + M_YB); X.mvt = (bf16_t*)(ws + WS_META + M_VT); X.mact = (bf16_t*)(ws + WS_META + M_ACT);
    return X;
}

__device__ __forceinline__ bool make_job(unsigned char* ws, float* out, int l, int g, int ph, int j, pg8::Gemm& gm, pg8::UberEpi& ep) {
    const bool mchain = (g == 3) && (l < NLAYER - 1);
    int njobs = 1; bool meta = false; int sub = j;
    if (ph == 0) { njobs = (g == 0) ? 2 : 1; meta = (j == 1); }
    else if (ph == 4) { njobs = (g == 3) ? 2 : 1; meta = (j == 1); }
    else if (ph == 5) { njobs = mchain ? 6 : 3; meta = (j >= 3); sub = j % 3; }
    else { njobs = mchain ? 2 : 1; meta = (j == 1); }
    if (j >= njobs) return false;
    unsigned char* wb = ws + WS_W;
    const size_t r0 = (size_t)g * RG;
    unsigned char* mb = ws + WS_META;
    bf16_t* z = meta ? (bf16_t*)(mb + M_Z) : (bf16_t*)(ws + WS_Z);
    bf16_t* hb = meta ? (bf16_t*)(mb + M_HB) : (bf16_t*)(ws + WS_HB) + r0 * DM;
    float* ssq = meta ? (float*)(mb + M_SSQ) : (float*)(ws + WS_SSQ) + r0 * 4;
    float* h = meta ? (float*)(mb + M_H) : out + r0 * DM;
    bf16_t* yb = meta ? (bf16_t*)(mb + M_YB) : (bf16_t*)(ws + WS_YB);
    bf16_t* vt = meta ? (bf16_t*)(mb + M_VT) : (bf16_t*)(ws + WS_VT);
    bf16_t* act = meta ? (bf16_t*)(mb + M_ACT) : (bf16_t*)(ws + WS_Z);
    gm.M = meta ? 256 : RG;
    ep.i0 = 0; ep.p0 = nullptr; ep.p1 = nullptr; ep.p2 = nullptr;
    if (ph == 0) { gm.A = hb; gm.lda = DM; gm.Bt = (const bf16_t*)(wb + W_IN); gm.N = ZN; gm.K = DM; ep.mode = 0; ep.p0 = (unsigned char*)z; ep.p1 = (unsigned char*)ssq; ep.p2 = (unsigned char*)vt; ep.i0 = meta ? 256 : VTLD; }
    else if (ph == 4) { gm.A = z + 512; gm.lda = ZW; gm.Bt = (const bf16_t*)(wb + W_GLU); gm.N = 256; gm.K = 256; ep.mode = 1; ep.p0 = (unsigned char*)z; }
    else if (ph == 5) {
        gm.N = DM; ep.p0 = (unsigned char*)z;
        if (sub == 0) { gm.A = yb; gm.lda = 512; gm.Bt = (const bf16_t*)(wb + W_UPB); gm.K = 512; ep.mode = 2; ep.i0 = 4096; }
        else if (sub == 1) { gm.A = z + 256; gm.lda = ZW; gm.Bt = (const bf16_t*)(wb + W_UPC); gm.K = 256; ep.mode = 3; ep.i0 = 5120; }
        else { gm.A = z; gm.lda = ZW; gm.Bt = (const bf16_t*)(wb + W_UPA); gm.K = 256; ep.mode = 3; ep.i0 = 3072; }
    }
    else if (ph == 6) { gm.A = z + 1024; gm.lda = ZW; gm.Bt = (const bf16_t*)(wb + W_O); gm.N = DM; gm.K = DM; ep.mode = 4; ep.p0 = (unsigned char*)h; ep.p1 = (unsigned char*)hb; ep.p2 = (unsigned char*)ssq; }
    else if (ph == 7) { gm.A = hb; gm.lda = DM; gm.Bt = (const bf16_t*)(wb + W_GU); gm.N = 2 * FFH; gm.K = DM; ep.mode = 5; ep.p0 = (unsigned char*)act; ep.p1 = (unsigned char*)ssq; }
    else { gm.A = act; gm.lda = FFH; gm.Bt = (const bf16_t*)(wb + W_DN); gm.N = DM; gm.K = FFH; ep.mode = 4; ep.p0 = (unsigned char*)h; ep.p1 = (unsigned char*)hb; ep.p2 = (unsigned char*)ssq; }
    return true;
}

__device__ __forceinline__ void prologue(int G) {
    const int tid_ = opaque_tid(); const int lane = tid_ & 63, gw = blockIdx.x * 8 + __builtin_amdgcn_readfirstlane(tid_ >> 6), NGW = G * 8;
    const Ctx X = make_ctx(((unsigned char*)KA(ws)));
    for (int row = gw; row < RMAIN + 256; row += NGW) {
        const bool ismeta = row >= RMAIN; const int mr = row - RMAIN;
        const float* src = ismeta ? (mr < 160 ? KAF(meta_tokens) + (size_t)(mr & 15) * DM : nullptr) : (row < 32768 ? KAF(x_prompt) + (size_t)row * DM : KAF(x_sample) + (size_t)(row - 32768) * DM);
        float* hd = ismeta ? X.mh + (size_t)mr * DM : ((float*)KA(out)) + (size_t)row * DM;
        bf16_t* hbd = ismeta ? X.mhb + (size_t)mr * DM : X.hb + (size_t)row * DM;
        float* sq = ismeta ? X.mssq + (size_t)mr * 4 : X.ssq + (size_t)row * 4;
        float ss = 0.f;
#pragma unroll
        for (int j = 0; j < 4; ++j) {
            f32x4 v = (f32x4){0.f, 0.f, 0.f, 0.f}; if (src) v = *(const f32x4*)(src + j * 256 + lane * 4);
            *(f32x4*)(hd + j * 256 + lane * 4) = v;
            *(u32x2*)(hbd + j * 256 + lane * 4) = (u32x2){pk2(v[0], v[1]), pk2(v[2], v[3])};
            ss += (v[0] * v[0] + v[1] * v[1]) + (v[2] * v[2] + v[3] * v[3]);
        }
        ss = wave_sum(ss);
        if (lane < 4) sq[lane] = lane == 0 ? ss : 0.f;
    }
}

__device__ __forceinline__ void mixer_phase_A(int l, int g, LAS unsigned char* lds, int G, int bid) {
    const int tid_ = opaque_tid(); const int lane = tid_ & 63, wave = __builtin_amdgcn_readfirstlane(tid_ >> 6);
    const Ctx X = make_ctx(((unsigned char*)KA(ws))); const Grp gp = make_grp(g);
    const float* rpb = KAF(rpb) + (size_t)l * 8 * 15 * 31; const float* s5d = KAF(s5_d) + l * 256;
    const int nna = gp.nseq * (gp.Lr / 16), nmq = gp.nseq, nct = gp.nseq * (gp.nch - 1);
    const int ntask = nna + nmq + 2 * nct;
    const bool xmap = (nna % 256 == 0) && ((volatile LAS unsigned*)(lds + LDS_ST_OFF))[4] != 0u;
    if (xmap) {
        const int xcc = (int)((volatile LAS unsigned*)(lds + LDS_ST_OFF))[2], xrk = (int)((volatile LAS unsigned*)(lds + LDS_ST_OFF))[3];
        const int per = gp.Lr / 16, nx = nna / 8, rounds = nna / 256;
        for (int i = 0; i < rounds; ++i) { const int t = xcc * nx + xrk + 32 * i; na_task(X, rpb, gp, t / per, t % per, false, wave, lane, lds + wave * 9216); }
    }
    for (int t = bid + (xmap ? nna : 0); t < ntask; t += G) {
        __syncthreads();
        if (t < nna) { const int per = gp.Lr / 16; na_task(X, rpb, gp, t / per, t % per, false, wave, lane, lds + wave * 9216); }
        else if (t < nna + nmq) { na_task(X, rpb, gp, t - nna, 0, true, wave, lane, lds + wave * 9216); }
        else {
            const int u = t - nna - nmq; const bool isS5 = u < nct; const int v = isS5 ? u : u - nct;
            const int sl = v / (gp.nch - 1), c1 = v % (gp.nch - 1) + 1;
            for (int c = (c1 == 1 ? 0 : c1); c <= c1; ++c) {
                __syncthreads();
                const int ci = sl * gp.nch + c; const int T = c == 0 ? 16 : 64;
                bf16_t* zc = c == 0 ? X.mz + (size_t)((gp.s0 + sl) * 16) * ZW : X.z + ((size_t)sl * gp.Lr + 64 * (c - 1)) * ZW;
                if (isS5) s5_chunk<false>(X, s5d, (LAS float*)(lds + wave * 16896), zc, T, ci, wave, lane);
                else hg_passA_mfma(X, lds + wave * 9216, zc, T, ci, wave, lane);
            }
        }
    }
}

__device__ __forceinline__ void mixer_phase_C(int l, int g, LAS unsigned char* lds, int G, int bid) {
    const int tid_ = opaque_tid(); const int lane = tid_ & 63, wave = __builtin_amdgcn_readfirstlane(tid_ >> 6);
    const Ctx X = make_ctx(((unsigned char*)KA(ws))); const Grp gp = make_grp(g);
    const float* s5d = KAF(s5_d) + l * 256; const float* ong = KAF(onorm_g) + l * 64;
    const int nct = gp.nseq * (gp.nch - 1);
    for (int t = bid; t < 2 * nct; t += G) {
        const bool isS5 = t < nct; const int v = isS5 ? t : t - nct;
        const int sl = v / (gp.nch - 1), c1 = v % (gp.nch - 1) + 1;
        for (int c = (c1 == 1 ? 0 : c1); c <= c1; ++c) {
            __syncthreads();
            const int ci = sl * gp.nch + c; const int T = c == 0 ? 16 : 64;
            bf16_t* zc = c == 0 ? X.mz + (size_t)((gp.s0 + sl) * 16) * ZW : X.z + ((size_t)sl * gp.Lr + 64 * (c - 1)) * ZW;
            if (isS5) {
                s5_chunk<true>(X, s5d, (LAS float*)(lds + wave * 16896), zc, T, ci, wave, lane);
                const int fr = lane & 15, fq = lane >> 4;
                const bf16_t* wg = (const bf16_t*)((const unsigned char*)X.w + W_GLU);
                const int n0 = wave * 32;
                bf16x8 bw[8][2];
#pragma unroll
                for (int ks = 0; ks < 8; ++ks)
#pragma unroll
                    for (int n2 = 0; n2 < 2; ++n2) bw[ks][n2] = *(const bf16x8*)(wg + (size_t)(n0 + n2 * 16 + fr) * 256 + ks * 32 + fq * 8);
                asm volatile("s_waitcnt vmcnt(0)" ::: "memory");
                __syncthreads();
                f32x4 ga[4][2];
#pragma unroll
                for (int a = 0; a < 4; ++a)
#pragma unroll
                    for (int b = 0; b < 2; ++b) ga[a][b] = (f32x4){0.f, 0.f, 0.f, 0.f};
#pragma unroll
                for (int kh = 0; kh < 2; ++kh) {
                    bf16x8 af[4][4];
#pragma unroll
                    for (int k4 = 0; k4 < 4; ++k4)
#pragma unroll
                        for (int mt = 0; mt < 4; ++mt) { af[k4][mt] = (bf16x8){0, 0, 0, 0, 0, 0, 0, 0}; if (mt * 16 < T) af[k4][mt] = *(const bf16x8*)(zc + (size_t)(mt * 16 + fr) * ZW + 512 + (kh * 4 + k4) * 32 + fq * 8); }
                    __builtin_amdgcn_sched_barrier(0);
#pragma unroll
                    for (int k4 = 0; k4 < 4; ++k4)
#pragma unroll
                        for (int mt = 0; mt < 4; ++mt) {
                            if (mt * 16 < T) {
#pragma unroll
                                for (int n2 = 0; n2 < 2; ++n2) ga[mt][n2] = __builtin_amdgcn_mfma_f32_16x16x32_bf16(af[k4][mt], bw[kh * 4 + k4][n2], ga[mt][n2], 0, 0, 0);
                            }
                        }
                    __builtin_amdgcn_sched_barrier(0);
                }
#pragma unroll
                for (int mt = 0; mt < 4; ++mt) {
                    if (mt * 16 < T) {
                        float yy[2][4];
#pragma unroll
                        for (int n2 = 0; n2 < 2; ++n2)
#pragma unroll
                            for (int r = 0; r < 4; ++r) yy[n2][r] = bf2f(zc[(size_t)(mt * 16 + 4 * fq + r) * ZW + 512 + n0 + n2 * 16 + fr]);
#pragma unroll
                        for (int n2 = 0; n2 < 2; ++n2)
#pragma unroll
                            for (int r = 0; r < 4; ++r) zc[(size_t)(mt * 16 + 4 * fq + r) * ZW + n0 + n2 * 16 + fr] = (bf16_t)f2bf(yy[n2][r] * sigm(ga[mt][n2][r]));
                    }
                }
            }
            else {
                hg_passC_mfma(X, lds + wave * 7168, (LAS bf16_t*)(lds + 65536 + wave * 8192), zc, T, ci, wave, lane);
                __syncthreads();
                const int h = wave >> 1, half = wave & 1;
                const LAS bf16_t* of = (const LAS bf16_t*)(lds + 65536 + (2 * h) * 8192); const LAS bf16_t* ob = (const LAS bf16_t*)(lds + 65536 + (2 * h + 1) * 8192);
                const float gn = ong[lane];
                const int tt0 = half * (T / 2);
                float gov[32];
#pragma unroll
                for (int i = 0; i < 32; ++i) { gov[i] = 0.f; if (i < T / 2) gov[i] = bf2f(zc[(size_t)(tt0 + i) * ZW + 2816 + h * 64 + lane]); }
#pragma unroll
                for (int i = 0; i < 32; ++i) {
                    if (i < T / 2) {
                        const int tt = tt0 + i;
                        const float o = bf2f(of[tt * 64 + lane]) + bf2f(ob[tt * 64 + lane]);
                        const float ms = wave_sum(o * o) * (1.0f / 64.0f);
                        const float go = gov[i];
                        zc[(size_t)tt * ZW + 256 + h * 64 + lane] = (bf16_t)f2bf(o * rsqrtf(ms + 1e-6f) * gn * (go * sigm(go)));
                    }
                }
            }
        }
    }
}

__global__ void __launch_bounds__(512, 2) fwd_kernel(Args a) {
    extern __shared__ __attribute__((aligned(16))) unsigned char lds_raw[];
    LAS unsigned char* lds = (LAS unsigned char*)lds_raw;
    const int G = gridDim.x, bid = blockIdx.x;

    if (threadIdx.x < 2) ((volatile LAS unsigned*)(lds + LDS_ST_OFF))[threadIdx.x] = 0u;
    if (threadIdx.x == 0) { const unsigned xc = xb_xcc_id(); const unsigned rk = xb_add((unsigned*)(KA(ws) + WS_CTL) + XB_XCNT(xc), 1u);
        ((volatile LAS unsigned*)(lds + LDS_ST_OFF))[2] = xc; ((volatile LAS unsigned*)(lds + LDS_ST_OFF))[3] = rk; }
    __syncthreads();
    prologue(G);

    for (int l = 0; l < NLAYER; ++l) {
        __syncthreads();
        { const Ctx X = make_ctx(((unsigned char*)KA(ws))); prep_layer(X, l, lds, G); }
        if (l == 0) { asm volatile("s_waitcnt vmcnt(0)" ::: "memory"); __syncthreads(); cg::this_grid().sync(); }
        GRID_SYNC();
        if (l == 0) {
            if (threadIdx.x == 0) { unsigned* bar = (unsigned*)(KA(ws) + WS_CTL); bool ok = (G == 256);
                for (int j = 0; j < 16; ++j) { const unsigned c = xb_ld(&bar[XB_XCNT(j)]); ok = ok && (c == (j < 8 ? 32u : 0u)); }
                ((volatile LAS unsigned*)(lds + LDS_ST_OFF))[4] = ok ? 1u : 0u; }
            __syncthreads();
        }
        for (int g = 0; g < 4; ++g) {
            for (int ph = 0; ph < 9; ++ph) {
                if (ph == 4) continue;
                if (ph == 1) mixer_phase_A(l, g, lds, G, bid);
                else if (ph == 2) { const Ctx X = make_ctx(((unsigned char*)KA(ws))); const Grp gp = make_grp(g); const int gtid = bid * 512 + opaque_tid(), GT = G * 512; s5_passB(X, gp, gtid, GT); hg_passB(X, gp, GT - 1 - gtid, GT); }
                else if (ph == 3) mixer_phase_C(l, g, lds, G, bid);
                else {
                    for (int j = 0; j < 6; ++j) {
                        pg8::Gemm gm; pg8::UberEpi ep;
                        if (!make_job(((unsigned char*)KA(ws)), ((float*)KA(out)), l, g, ph, j, gm, ep)) break;
                        int cidx = bid;
                        if (ph == 7 && j == 1) { const int busy = ((RG / 256) * (2 * FFH / 256)) % G; cidx = (bid + G - busy) % G; }
                        pg8::StaticOrder SO; SO.init(gm.M, gm.N, G, cidx);
                        pg8::gemm_phase(lds, gm, SO, ep);
                    }
                }
                GRID_SYNC();
            }
        }
    }
    {
        const float* ssq = (const float*)(((unsigned char*)KA(ws)) + WS_SSQ);
        const int tid_ = opaque_tid(); const int lane = tid_ & 63, wave = __builtin_amdgcn_readfirstlane(tid_ >> 6);
        for (int row = bid * 8 + wave; row < RMAIN; row += G * 8) {
            const float rs = pg8::row_rstd(ssq, row);
            float* hp = ((float*)KA(out)) + (size_t)row * DM;
#pragma unroll
            for (int j = 0; j < 4; ++j) {
                f32x4 v = *(const f32x4*)(hp + j * 256 + lane * 4); const f32x4 gv = *(const f32x4*)(KAF(final_g) + j * 256 + lane * 4);
                v = v * rs * gv; *(f32x4*)(hp + j * 256 + lane * 4) = v;
            }
        }
    }
}

extern "C" void kernel_launch(void* const* d_in, const int* in_sizes, int n_in, void* d_out, int out_size, void* d_ws, size_t ws_size, hipStream_t stream) {
    static int grid = 0;
    if (grid == 0) {
        int dev = 0, cus = 0, per_cu = 0;
        (void)hipGetDevice(&dev);
        (void)hipDeviceGetAttribute(&cus, hipDeviceAttributeMultiprocessorCount, dev);
        (void)hipFuncSetAttribute((const void*)fwd_kernel, hipFuncAttributeMaxDynamicSharedMemorySize, LDS_BYTES);
        (void)hipOccupancyMaxActiveBlocksPerMultiprocessor(&per_cu, (const void*)fwd_kernel, 512, LDS_BYTES);
        (void)hipGetLastError();
        if (ws_size < WS_TOTAL) fprintf(stderr, "kernel_launch: workspace too small: %zu < %zu\n", ws_size, (size_t)WS_TOTAL);
        grid = cus > 0 ? cus : 256;
    }
    (void)hipMemsetAsync((char*)d_ws + WS_CTL, 0, CTL_BYTES, stream);
    Args a{};
    const float** pp = (const float**)&a;
    for (int i = 0; i < 26; ++i) pp[i] = (const float*)d_in[i];
    a.out = (float*)d_out; a.ws = (unsigned char*)d_ws;
    void* args[] = {&a};
    hipError_t e = hipLaunchCooperativeKernel((const void*)fwd_kernel, dim3(grid), dim3(512), args, LDS_BYTES, stream);
    if (e != hipSuccess) fprintf(stderr, "cooperative launch failed: %s\n", hipGetErrorString(e));
}
```

```cpp
#include <hip/hip_runtime.h>
#include <hip/hip_cooperative_groups.h>
#include <cstdio>
#include <cstdint>
namespace cg = cooperative_groups;

#define LAS __attribute__((address_space(3)))
typedef unsigned short bf16_t;
typedef short bf16x8 __attribute__((ext_vector_type(8)));
typedef float f32x4 __attribute__((ext_vector_type(4)));
typedef unsigned u32x4 __attribute__((ext_vector_type(4)));
typedef unsigned u32x2 __attribute__((ext_vector_type(2)));

#define WAVE_SYNC() asm volatile("s_waitcnt lgkmcnt(0)" ::: "memory")
__device__ __forceinline__ int opaque_tid() { int t = threadIdx.x; asm volatile("" : "+v"(t)); return t; }

__device__ __forceinline__ unsigned f2bf(float f) { unsigned u = __builtin_bit_cast(unsigned, f); return (u + 0x7fffu + ((u >> 16) & 1u)) >> 16; }
__device__ __forceinline__ unsigned pk2(float lo, float hi) { return f2bf(lo) | (f2bf(hi) << 16); }
__device__ __forceinline__ float bf2f(bf16_t b) { return __builtin_bit_cast(float, (unsigned)b << 16); }
__device__ __forceinline__ float bflo(unsigned w) { return __builtin_bit_cast(float, w << 16); }
__device__ __forceinline__ float bfhi(unsigned w) { return __builtin_bit_cast(float, w & 0xffff0000u); }
__device__ __forceinline__ float sigm(float x) { return 1.f / (1.f + __expf(-x)); }
__device__ __forceinline__ float gelu_tanh(float y) { const float a = 0.7978845608028654f * (y + 0.044715f * y * y * y); const float th = 1.f - 2.f / (__expf(2.f * a) + 1.f); return 0.5f * y * (1.f + th); }
__device__ __forceinline__ u32x4 pack8(f32x4 a, f32x4 b) { u32x4 w; w.x = pk2(a[0], a[1]); w.y = pk2(a[2], a[3]); w.z = pk2(b[0], b[1]); w.w = pk2(b[2], b[3]); return w; }
__device__ __forceinline__ float wave_sum(float v) {
#pragma unroll
    for (int o = 1; o < 64; o <<= 1) v += __shfl_xor(v, o);
    return v;
}

namespace pg8 {
constexpr int ZSTR = 6208;
constexpr int BM = 256, BK = 64, HALF = 128, HTB = HALF * BK * 2, STAGE_BYTES = 8 * HTB, NXCD = 8, WGM = 8;
__host__ __device__ __forceinline__ int lds_byte(int r, int c) { const int st = (r >> 4) * 2 + (c >> 5), rr = r & 15, cc = c & 31, ob = rr * 64 + cc * 2; return st * 1024 + (ob ^ (((ob >> 9) & 1) << 5)); }
__host__ __device__ __forceinline__ void stage_rc(int b, int& R, int& C) { const int st = b / 1024, sb = b % 1024, swz = sb ^ (((sb >> 9) & 1) << 5); R = (st >> 1) * 16 + swz / 64; C = (st & 1) * 32 + (swz % 64) / 2; }
__host__ __device__ __forceinline__ int perm32(int rho) { const int n = rho >> 4, i = rho & 15; return 8 * (i >> 2) + 4 * n + (i & 3); }
struct Unit { int pm, pn; };
struct Gemm { const bf16_t* A; int lda; const bf16_t* Bt; int M, N, K; };
struct StaticOrder {
    int nM, nN, nwg, G, c;
    __device__ void init(int M, int N, int G_, int c_) { nM = M / BM; nN = N / BM; nwg = nM * nN; G = G_; c = c_; }
    __device__ bool next(int i, Unit& u) const {
        const long L = (long)i * G + c; if (L >= nwg) return false;
        int wgid = (int)L; { const int q = nwg / NXCD, r = nwg % NXCD, xcd = wgid % NXCD, off = wgid / NXCD; wgid = (xcd < r ? xcd * (q + 1) : r * (q + 1) + (xcd - r) * q) + off; }
        const int nig = WGM * nN, gid = wgid / nig, fm = gid * WGM, gsz = (nM - fm) < WGM ? (nM - fm) : WGM;
        u.pm = fm + ((wgid % nig) % gsz); u.pn = (wgid % nig) / gsz; return true;
    }
};

struct UberEpi;
__device__ __forceinline__ void run_epi(const UberEpi& E, LAS unsigned char* lds, const f32x4 (&acc)[2][2][4][2], const Unit& u, int wr, int wc, int fr, int fq);
__device__ __forceinline__ void gemm_phase(LAS unsigned char* lds, const Gemm g, const StaticOrder& S, const UberEpi& E) {
    const int tid = opaque_tid(), wid = __builtin_amdgcn_readfirstlane(tid >> 6), lane = tid & 63, wr = wid >> 2, wc = wid & 3, fr = lane & 15, fq = lane >> 4;
    const int K = g.K, nt = K / BK, lda = g.lda;
    unsigned voffA[2], voffB[2];
#pragma unroll
    for (int i = 0; i < 2; ++i) { int R, C; stage_rc(tid * 16 + i * 8192, R, C); const int Rb = (R & ~31) + perm32(R & 31);
        voffA[i] = (unsigned)(R * lda + C) * 2u; voffB[i] = (unsigned)(Rb * K + C) * 2u; }
    const size_t kstep = (size_t)(BK * 2);
    const size_t hstepA = (size_t)HALF * lda * 2, hstepB = (size_t)HALF * K * 2;
    const size_t tstepA = 2 * hstepA, tstepB = 2 * hstepB;
    const unsigned ldsw = (unsigned)wid * 1024u;
    const int aoff = lds_byte(wr * 64 + fr, fq * 8), boff = lds_byte(wc * 32 + fr, fq * 8);
#define PG8_SA(b, h) (((b) * 2 + (h)) * HTB)
#define PG8_SB(b, h) ((4 + (b) * 2 + (h)) * HTB)
#define PG8_STAGE(bufoff, gbase, voff) do { _Pragma("unroll") for (int _i = 0; _i < 2; ++_i) \
        __builtin_amdgcn_global_load_lds((const unsigned*)((const char*)(gbase) + (voff)[_i]), (LAS unsigned*)(lds + (bufoff) + ldsw + _i * 8192), 16, 0, 0); } while (0)
#define PG8_LDA(dst, b, h) do { _Pragma("unroll") for (int m = 0; m < 4; ++m) _Pragma("unroll") for (int k = 0; k < 2; ++k) dst[m][k] = *(const LAS bf16x8*)(lds + PG8_SA(b, h) + aoff + m * 2048 + k * 1024); } while (0)
#define PG8_LDB(dst, b, h) do { _Pragma("unroll") for (int n = 0; n < 2; ++n) _Pragma("unroll") for (int k = 0; k < 2; ++k) dst[n][k] = *(const LAS bf16x8*)(lds + PG8_SB(b, h) + boff + n * 2048 + k * 1024); } while (0)
#define PG8_MMA(ai, bj, At, Bt) do { __builtin_amdgcn_s_setprio(1); _Pragma("unroll") for (int m = 0; m < 4; ++m) _Pragma("unroll") for (int n = 0; n < 2; ++n) _Pragma("unroll") for (int k = 0; k < 2; ++k) \
        acc[ai][bj][m][n] = __builtin_amdgcn_mfma_f32_16x16x32_bf16(Bt[n][k], At[m][k], acc[ai][bj][m][n], 0, 0, 0); __builtin_amdgcn_s_setprio(0); } while (0)
#define PG8_WAIT_V(n) asm volatile("s_waitcnt vmcnt(" #n ")" ::: "memory")
#define PG8_WAIT_L(n) asm volatile("s_waitcnt lgkmcnt(" #n ")" ::: "memory")
#define PG8_BAR __builtin_amdgcn_s_barrier()
#define PG8_SCHED __builtin_amdgcn_sched_barrier(0)
    Unit cur, nxt; int ui = 0;
    if (!S.next(0, cur)) return;
    f32x4 acc[2][2][4][2];
#pragma unroll
    for (int a = 0; a < 2; ++a)
#pragma unroll
        for (int b = 0; b < 2; ++b)
#pragma unroll
            for (int m = 0; m < 4; ++m)
#pragma unroll
                for (int n = 0; n < 2; ++n) acc[a][b][m][n] = (f32x4){0.f, 0.f, 0.f, 0.f};
    bf16x8 At[4][2], B0[2][2], B1[2][2];
    const char* cA = (const char*)g.A + (size_t)cur.pm * tstepA; const char* cB = (const char*)g.Bt + (size_t)cur.pn * tstepB;
    PG8_STAGE(PG8_SB(0, 0), cB, voffB); PG8_STAGE(PG8_SB(0, 1), cB + hstepB, voffB); PG8_STAGE(PG8_SA(0, 0), cA, voffA); PG8_STAGE(PG8_SA(0, 1), cA + hstepA, voffA);
    if (wr == 1) PG8_BAR;
    PG8_WAIT_V(2); PG8_BAR;
    PG8_STAGE(PG8_SB(1, 0), cB + kstep, voffB); PG8_STAGE(PG8_SA(1, 0), cA + kstep, voffA); PG8_STAGE(PG8_SB(1, 1), cB + hstepB + kstep, voffB);
    PG8_WAIT_V(6); PG8_BAR;
    for (;;) {
        const bool has_next = S.next(ui + 1, nxt);
        const char* nA = has_next ? (const char*)g.A + (size_t)nxt.pm * tstepA : cA; const char* nB = has_next ? (const char*)g.Bt + (size_t)nxt.pn * tstepB : cB;
        for (int t = 0; t < nt; t += 2) {
            const bool last = (t == nt - 2);
            const char* a1 = cA + (size_t)(t + 1) * kstep;
            const char* a2 = last ? nA : cA + (size_t)(t + 2) * kstep; const char* b2 = last ? nB : cB + (size_t)(t + 2) * kstep;
            const char* a3 = a2 + kstep; const char* b3 = b2 + kstep;
            PG8_LDB(B0, 0, 0); PG8_LDB(B1, 0, 1); PG8_SCHED; PG8_LDA(At, 0, 0); PG8_STAGE(PG8_SA(1, 1), a1 + hstepA, voffA);
            PG8_WAIT_V(8); PG8_WAIT_L(0); PG8_BAR; PG8_MMA(0, 0, At, B0); PG8_MMA(0, 1, At, B1); PG8_BAR; PG8_SCHED;
            PG8_LDA(At, 0, 1); PG8_STAGE(PG8_SB(0, 0), b2, voffB); PG8_STAGE(PG8_SB(0, 1), b2 + hstepB, voffB); PG8_STAGE(PG8_SA(0, 0), a2, voffA);
            PG8_WAIT_V(8); PG8_WAIT_L(0); PG8_BAR; PG8_MMA(1, 0, At, B0); PG8_MMA(1, 1, At, B1); PG8_BAR; PG8_SCHED;
            PG8_LDB(B0, 1, 0); PG8_LDB(B1, 1, 1); PG8_SCHED; PG8_LDA(At, 1, 0); PG8_STAGE(PG8_SA(0, 1), a2 + hstepA, voffA);
            PG8_WAIT_V(8); PG8_WAIT_L(0); PG8_BAR; PG8_MMA(0, 0, At, B0); PG8_MMA(0, 1, At, B1); PG8_BAR; PG8_SCHED;
            PG8_LDA(At, 1, 1); PG8_STAGE(PG8_SB(1, 0), b3, voffB); PG8_STAGE(PG8_SB(1, 1), b3 + hstepB, voffB); PG8_STAGE(PG8_SA(1, 0), a3, voffA);
            PG8_WAIT_V(8); PG8_WAIT_L(0); PG8_BAR; PG8_MMA(1, 0, At, B0); PG8_MMA(1, 1, At, B1); PG8_BAR; PG8_SCHED;
        }
        if (wr == 0) PG8_BAR;
        run_epi(E, lds, acc, cur, wr, wc, fr, fq);
        if (!has_next) break;
#pragma unroll
        for (int a = 0; a < 2; ++a)
#pragma unroll
            for (int b = 0; b < 2; ++b)
#pragma unroll
                for (int m = 0; m < 4; ++m)
#pragma unroll
                    for (int n = 0; n < 2; ++n) acc[a][b][m][n] = (f32x4){0.f, 0.f, 0.f, 0.f};
        cur = nxt; cA = nA; cB = nB; ++ui;
        if (wr == 1) PG8_BAR;
    }
    PG8_WAIT_V(0);
    PG8_BAR;
#undef PG8_SA
#undef PG8_SB
#undef PG8_STAGE
#undef PG8_LDA
#undef PG8_LDB
#undef PG8_MMA
#undef PG8_WAIT_V
#undef PG8_WAIT_L
#undef PG8_BAR
#undef PG8_SCHED
}

__device__ __forceinline__ float row_rstd(const float* ssq, int row) {
    const f32x4 s0 = *(const f32x4*)(ssq + (size_t)row * 4);
    const float ss = (s0[0] + s0[1]) + (s0[2] + s0[3]);
    return rsqrtf(ss * (1.0f / 1024.0f) + 1e-6f);
}
struct EpiZ {
    bf16_t* z; const float* ssq; bf16_t* vt; int vt_ld;
    __device__ __forceinline__ void operator()(const f32x4 (&acc)[2][2][4][2], const Unit& u, int wr, int wc, int fr, int fq) const {
        const int row0 = u.pm * BM + wr * 64 + fr, col0 = u.pn * BM + wc * 32 + 8 * fq;
#pragma unroll
        for (int ai = 0; ai < 2; ++ai)
#pragma unroll
            for (int m = 0; m < 4; ++m) {
                const int row = row0 + ai * HALF + m * 16; const float rs = row_rstd(ssq, row);
#pragma unroll
                for (int bj = 0; bj < 2; ++bj) {
                    const u32x4 w = pack8(acc[ai][bj][m][0] * rs, acc[ai][bj][m][1] * rs);
                    *(u32x4*)(z + (size_t)row * ZSTR + col0 + bj * HALF) = w;
                }
            }
    }
};
struct EpiGlu {
    bf16_t* z;
    __device__ __forceinline__ void operator()(const f32x4 (&acc)[2][2][4][2], const Unit& u, int wr, int wc, int fr, int fq) const {
        const int row0 = u.pm * BM + wr * 64 + fr, col0 = wc * 32 + 8 * fq;
#pragma unroll
        for (int ai = 0; ai < 2; ++ai) {
            u32x4 yv[4][2];
#pragma unroll
            for (int m = 0; m < 4; ++m)
#pragma unroll
                for (int bj = 0; bj < 2; ++bj) yv[m][bj] = *(const u32x4*)(z + (size_t)(row0 + ai * HALF + m * 16) * ZSTR + col0 + bj * HALF + 512);
#pragma unroll
            for (int m = 0; m < 4; ++m) {
                const int row = row0 + ai * HALF + m * 16;
#pragma unroll
                for (int bj = 0; bj < 2; ++bj) {
                    bf16_t* zp = z + (size_t)row * ZSTR + col0 + bj * HALF;
                    const u32x4 y = yv[m][bj];
                    const f32x4 a0 = acc[ai][bj][m][0], a1 = acc[ai][bj][m][1];
                    f32x4 o0, o1;
                    o0[0] = bflo(y.x) * sigm(a0[0]); o0[1] = bfhi(y.x) * sigm(a0[1]); o0[2] = bflo(y.y) * sigm(a0[2]); o0[3] = bfhi(y.y) * sigm(a0[3]);
                    o1[0] = bflo(y.z) * sigm(a1[0]); o1[1] = bfhi(y.z) * sigm(a1[1]); o1[2] = bflo(y.w) * sigm(a1[2]); o1[3] = bfhi(y.w) * sigm(a1[3]);
                    *(u32x4*)zp = pack8(o0, o1);
                }
            }
        }
    }
};
template <int MODE> struct EpiMix {
    bf16_t* z; int goff;
    __device__ __forceinline__ void operator()(const f32x4 (&acc)[2][2][4][2], const Unit& u, int wr, int wc, int fr, int fq) const {
        const int row0 = u.pm * BM + wr * 64 + fr, col0 = u.pn * BM + wc * 32 + 8 * fq;
#pragma unroll
        for (int ai = 0; ai < 2; ++ai)
#pragma unroll
            for (int mp = 0; mp < 2; ++mp) {
                u32x4 gv[2][2], pv[2][2];
#pragma unroll
                for (int mm = 0; mm < 2; ++mm)
#pragma unroll
                    for (int bj = 0; bj < 2; ++bj) { const bf16_t* zr = z + (size_t)(row0 + ai * HALF + (mp * 2 + mm) * 16) * ZSTR + col0 + bj * HALF;
                        gv[mm][bj] = *(const u32x4*)(zr + goff); if (MODE == 1) pv[mm][bj] = *(const u32x4*)(zr + 1024); }
#pragma unroll
                for (int mm = 0; mm < 2; ++mm) {
                    const int m = mp * 2 + mm; const int row = row0 + ai * HALF + m * 16;
#pragma unroll
                    for (int bj = 0; bj < 2; ++bj) {
                        bf16_t* zr = z + (size_t)row * ZSTR + col0 + bj * HALF;
                        const u32x4 gq = gv[mm][bj];
                        const f32x4 a0 = acc[ai][bj][m][0], a1 = acc[ai][bj][m][1];
                        f32x4 o0, o1;
                        o0[0] = sigm(bflo(gq.x)) * a0[0]; o0[1] = sigm(bfhi(gq.x)) * a0[1]; o0[2] = sigm(bflo(gq.y)) * a0[2]; o0[3] = sigm(bfhi(gq.y)) * a0[3];
                        o1[0] = sigm(bflo(gq.z)) * a1[0]; o1[1] = sigm(bfhi(gq.z)) * a1[1]; o1[2] = sigm(bflo(gq.w)) * a1[2]; o1[3] = sigm(bfhi(gq.w)) * a1[3];
                        if (MODE == 1) { const u32x4 p = pv[mm][bj];
                            o0[0] += bflo(p.x); o0[1] += bfhi(p.x); o0[2] += bflo(p.y); o0[3] += bfhi(p.y); o1[0] += bflo(p.z); o1[1] += bfhi(p.z); o1[2] += bflo(p.w); o1[3] += bfhi(p.w); }
                        *(u32x4*)(zr + 1024) = pack8(o0, o1);
                    }
                }
            }
    }
};
struct EpiRes {
    float* h; bf16_t* hb; float* ssq; LAS float* red;
    __device__ __forceinline__ void operator()(const f32x4 (&acc)[2][2][4][2], const Unit& u, int wr, int wc, int fr, int fq) const {
        const int row0 = u.pm * BM + wr * 64 + fr, col0 = u.pn * BM + wc * 32 + 8 * fq;
#pragma unroll
        for (int ai = 0; ai < 2; ++ai)
#pragma unroll
            for (int mp = 0; mp < 2; ++mp) {
                f32x4 hv[2][2][2];
#pragma unroll
                for (int mm = 0; mm < 2; ++mm)
#pragma unroll
                    for (int bj = 0; bj < 2; ++bj) { const float* hp = h + (size_t)(row0 + ai * HALF + (mp * 2 + mm) * 16) * 1024 + col0 + bj * HALF; hv[mm][bj][0] = *(const f32x4*)hp; hv[mm][bj][1] = *(const f32x4*)(hp + 4); }
#pragma unroll
                for (int mm = 0; mm < 2; ++mm) {
                    const int m = mp * 2 + mm; const int row = row0 + ai * HALF + m * 16; float part = 0.f;
#pragma unroll
                    for (int bj = 0; bj < 2; ++bj) {
                        float* hp = h + (size_t)row * 1024 + col0 + bj * HALF;
                        const f32x4 h0 = hv[mm][bj][0] + acc[ai][bj][m][0], h1 = hv[mm][bj][1] + acc[ai][bj][m][1];
                        *(f32x4*)hp = h0; *(f32x4*)(hp + 4) = h1;
                        part += (h0[0] * h0[0] + h0[1] * h0[1]) + (h0[2] * h0[2] + h0[3] * h0[3]) + (h1[0] * h1[0] + h1[1] * h1[1]) + (h1[2] * h1[2] + h1[3] * h1[3]);
                        *(u32x4*)(hb + (size_t)row * 1024 + col0 + bj * HALF) = pack8(h0, h1);
                    }
                    part += __shfl_xor(part, 16); part += __shfl_xor(part, 32);
                    if (fq == 0) red[(ai * HALF + wr * 64 + m * 16 + fr) * 4 + wc] = part;
                }
            }
        asm volatile("s_waitcnt lgkmcnt(0)" ::: "memory");
        __builtin_amdgcn_s_barrier();
        asm volatile("" ::: "memory");
        { const int t_ = opaque_tid(); if (t_ < 256) { const f32x4 r4 = *(const LAS f32x4*)(red + t_ * 4); ssq[(size_t)(u.pm * BM + t_) * 4 + u.pn] = (r4[0] + r4[1]) + (r4[2] + r4[3]); } }
    }
};
struct EpiAct {
    bf16_t* act; const float* ssq;
    __device__ __forceinline__ void operator()(const f32x4 (&acc)[2][2][4][2], const Unit& u, int wr, int wc, int fr, int fq) const {
        const int row0 = u.pm * BM + wr * 64 + fr, col0 = u.pn * HALF + wc * 32 + 8 * fq;
#pragma unroll
        for (int ai = 0; ai < 2; ++ai)
#pragma unroll
            for (int m = 0; m < 4; ++m) {
                const int row = row0 + ai * HALF + m * 16; const float rs = row_rstd(ssq, row);
                f32x4 o[2];
#pragma unroll
                for (int n = 0; n < 2; ++n)
#pragma unroll
                    for (int i = 0; i < 4; ++i) { const float gg = acc[ai][0][m][n][i] * rs, uu = acc[ai][1][m][n][i] * rs; o[n][i] = gg * sigm(gg) * uu; }
                *(u32x4*)(act + (size_t)row * 2816 + col0) = pack8(o[0], o[1]);
            }
    }
};
struct UberEpi { int mode, i0; unsigned char *p0, *p1, *p2; };
__device__ __forceinline__ void run_epi(const UberEpi& E, LAS unsigned char* lds, const f32x4 (&acc)[2][2][4][2], const Unit& u, int wr, int wc, int fr, int fq) {
    switch (E.mode) {
        case 0: { EpiZ e{(bf16_t*)E.p0, (const float*)E.p1, (bf16_t*)E.p2, E.i0}; e(acc, u, wr, wc, fr, fq); break; }
        case 1: { EpiGlu e{(bf16_t*)E.p0}; e(acc, u, wr, wc, fr, fq); break; }
        case 2: { EpiMix<0> e{(bf16_t*)E.p0, E.i0}; e(acc, u, wr, wc, fr, fq); break; }
        case 3: { EpiMix<1> e{(bf16_t*)E.p0, E.i0}; e(acc, u, wr, wc, fr, fq); break; }
        case 4: { EpiRes e{(float*)E.p0, (bf16_t*)E.p1, (float*)E.p2, (LAS float*)(lds + 131072)}; e(acc, u, wr, wc, fr, fq); break; }
        default: { EpiAct e{(bf16_t*)E.p0, (const float*)E.p1}; e(acc, u, wr, wc, fr, fq); break; }
    }
}
}

constexpr int NLAYER = 4, DM = 1024, ZN = 6144, ZW = 6208  , FFH = 2816, RG = 16384, RMAIN = 65536, VTLD = RG + 64  ;
constexpr size_t al256(size_t x) { return (x + 255) & ~(size_t)255; }
constexpr size_t WS_HB = 0;
constexpr size_t WS_SSQ = WS_HB + (size_t)RMAIN * DM * 2;
constexpr size_t WS_Z = WS_SSQ + (size_t)RMAIN * 4 * 4;
constexpr size_t WS_YB = WS_Z + (size_t)RG * ZW * 2;
constexpr size_t WS_VT = WS_YB + (size_t)RG * 512 * 2;
constexpr size_t WS_HGU = WS_VT + (size_t)512 * VTLD * 2;
constexpr size_t WS_HGP = WS_HGU + (size_t)260 * 8 * 4096 * 4;
constexpr size_t WS_S5S = WS_HGP + (size_t)260 * 8 * 64 * 4;
constexpr size_t WS_W = WS_S5S + (size_t)260 * 2048 * 8;
constexpr size_t W_IN = 0, W_UPA = W_IN + (size_t)6144 * 1024 * 2, W_UPB = W_UPA + (size_t)1024 * 256 * 2, W_UPC = W_UPB + (size_t)1024 * 512 * 2,
                 W_O = W_UPC + (size_t)1024 * 256 * 2, W_GU = W_O + (size_t)1024 * 1024 * 2, W_DN = W_GU + (size_t)5632 * 1024 * 2, W_GLU = W_DN + (size_t)1024 * 2816 * 2,
                 W_END = W_GLU + (size_t)256 * 256 * 2;
constexpr size_t WS_TAB = WS_W + W_END;
constexpr size_t T_LBAR = 0, T_L16 = T_LBAR + 2048 * 8, T_L64 = T_L16 + 2048 * 8, T_BFRAG = T_L64 + 2048 * 8, T_CFRAG = T_BFRAG + (size_t)32 * 8 * 64 * 16,
                 T_LB = T_CFRAG + (size_t)32 * 4 * 64 * 16, T_END = T_LB + 256 * 4;
constexpr size_t WS_META = al256(WS_TAB + T_END);
constexpr size_t M_H = 0, M_HB = M_H + (size_t)256 * 1024 * 4, M_SSQ = M_HB + (size_t)256 * 1024 * 2, M_Z = M_SSQ + (size_t)256 * 4 * 4, M_YB = M_Z + (size_t)256 * ZW * 2,
                 M_VT = M_YB + (size_t)256 * 512 * 2, M_ACT = M_VT + (size_t)512 * 256 * 2, M_END = M_ACT + (size_t)256 * FFH * 2;
constexpr size_t WS_CTL = al256(WS_META + M_END);
constexpr size_t CTL_BYTES = 16384;
constexpr size_t WS_TOTAL = WS_CTL + CTL_BYTES;
constexpr int LDS_ST_OFF = 135168;
constexpr int LDS_BYTES = 147456;

struct Args {
    const float *x_prompt, *x_sample, *meta_tokens, *norm1_g, *w_in, *a_re, *a_im, *log_dt, *b_re, *b_im, *c_re, *c_im, *s5_d, *w_glu, *rpb, *lb_logits, *onorm_g,
        *w_up_a, *w_up_b, *w_up_c, *w_o, *norm2_g, *w_gate, *w_up, *w_down, *final_g;
    float* out; unsigned char* ws;
};

__device__ __forceinline__ unsigned long long ufl(unsigned long long v) { const unsigned lo = __builtin_amdgcn_readfirstlane((unsigned)v), hi = __builtin_amdgcn_readfirstlane((unsigned)(v >> 32)); return ((unsigned long long)hi << 32) | lo; }
#define GAS __attribute__((address_space(1)))
template <int OFF> __device__ __forceinline__ unsigned long long ka_load() {
    unsigned long long v; const unsigned long long kp = ufl((unsigned long long)__builtin_amdgcn_kernarg_segment_ptr());
    asm volatile("s_load_dwordx2 %0, %1, %2\n\ts_waitcnt lgkmcnt(0)" : "=s"(v) : "s"(kp), "n"(OFF));
    return v;
}
#define KA(f) ((decltype(Args::f))(GAS char*)ka_load<(int)__builtin_offsetof(Args, f)>())
#define KAF(f) ((const float*)KA(f))
struct Ctx {
    bf16_t *hb, *z, *yb, *vt; float *ssq, *hgu, *hgp, *s5s;
    bf16_t *w; const float *lbar, *l16, *l64; const bf16_t *bfrag, *cfrag; const float* lb;
    float* mh; bf16_t *mhb, *mz, *myb, *mvt, *mact; float* mssq;
};

__device__ __forceinline__ void tr_item(const float* W, int K, int N, bf16_t* WT, const float* kscale, int mode, LAS float* scr, int item, int lane, bool valid) {
    const int nblk = N / 32, kb = item / nblk, nb = item % nblk, k0 = 64 * kb, n0 = 32 * nb;
    if (valid) {
#pragma unroll 8
    for (int i = 0; i < 32; ++i) { const int kk = 2 * i + (lane >> 5); float v = W[(size_t)(k0 + kk) * N + n0 + (lane & 31)]; if (kscale) v *= kscale[k0 + kk]; scr[kk * 33 + (lane & 31)] = v; }
    }
    __syncthreads();
    const int c = lane & 7;
    int drow0 = n0; if (mode) drow0 = (n0 >> 7) * 256 + (n0 & 127) + (mode == 2 ? 128 : 0);
    if (valid) {
#pragma unroll
    for (int j = 0; j < 4; ++j) { const int n = (lane >> 3) + 8 * j; const LAS float* s = scr + (8 * c) * 33 + n;
        u32x4 o; o.x = pk2(s[0 * 33], s[1 * 33]); o.y = pk2(s[2 * 33], s[3 * 33]); o.z = pk2(s[4 * 33], s[5 * 33]); o.w = pk2(s[6 * 33], s[7 * 33]);
        *(u32x4*)(WT + (size_t)(drow0 + n) * K + k0 + 8 * c) = o; }
    }
    __syncthreads();
}

__device__ __forceinline__ void prep_layer(const Ctx& X, int l, LAS unsigned char* lds, int G) {
    const int tid_ = opaque_tid(); const int wave = __builtin_amdgcn_readfirstlane(tid_ >> 6), lane = tid_ & 63;
    LAS float* scr = (LAS float*)(lds + wave * 16384);
    const int gw = blockIdx.x * 8 + wave, NGW = G * 8;
    constexpr int I0 = 16 * 192, I1 = 4 * 32, I2 = 8 * 32, I3 = 4 * 32, I4 = 16 * 32, I5 = 16 * 88, I6 = 16 * 88, I7 = 44 * 32, I8 = 4 * 8;
    constexpr int NIT = I0 + I1 + I2 + I3 + I4 + I5 + I6 + I7 + I8;
    unsigned char* wb = (unsigned char*)X.w;
    for (int it0 = 0; it0 < NIT; it0 += NGW) {
        const int it = it0 + gw; const bool valid = it < NIT;
        int r = valid ? it : 0;
        if (r < I0) { tr_item(KAF(w_in) + (size_t)l * 1024 * 6144, 1024, 6144, (bf16_t*)(wb + W_IN), KAF(norm1_g) + l * 1024, 0, scr, r, lane, valid); continue; } r -= I0;
        if (r < I1) { tr_item(KAF(w_up_a) + (size_t)l * 256 * 1024, 256, 1024, (bf16_t*)(wb + W_UPA), nullptr, 0, scr, r, lane, valid); continue; } r -= I1;
        if (r < I2) { tr_item(KAF(w_up_b) + (size_t)l * 512 * 1024, 512, 1024, (bf16_t*)(wb + W_UPB), nullptr, 0, scr, r, lane, valid); continue; } r -= I2;
        if (r < I3) { tr_item(KAF(w_up_c) + (size_t)l * 256 * 1024, 256, 1024, (bf16_t*)(wb + W_UPC), nullptr, 0, scr, r, lane, valid); continue; } r -= I3;
        if (r < I4) { tr_item(KAF(w_o) + (size_t)l * 1024 * 1024, 1024, 1024, (bf16_t*)(wb + W_O), nullptr, 0, scr, r, lane, valid); continue; } r -= I4;
        if (r < I5) { tr_item(KAF(w_gate) + (size_t)l * 1024 * 2816, 1024, 2816, (bf16_t*)(wb + W_GU), KAF(norm2_g) + l * 1024, 1, scr, r, lane, valid); continue; } r -= I5;
        if (r < I6) { tr_item(KAF(w_up) + (size_t)l * 1024 * 2816, 1024, 2816, (bf16_t*)(wb + W_GU), KAF(norm2_g) + l * 1024, 2, scr, r, lane, valid); continue; } r -= I6;
        if (r < I7) { tr_item(KAF(w_down) + (size_t)l * 2816 * 1024, 2816, 1024, (bf16_t*)(wb + W_DN), nullptr, 0, scr, r, lane, valid); continue; } r -= I7;
        tr_item(KAF(w_glu) + (size_t)l * 256 * 256, 256, 256, (bf16_t*)(wb + W_GLU), nullptr, 0, scr, r, lane, valid);
    }
    const int gt = blockIdx.x * 512 + tid_;
    if (gt < 2048) {
        const int dg = gt >> 6, p = gt & 63;
        const size_t pb = ((size_t)l * 32 + dg);
        const float are = KAF(a_re)[pb * 64 + p], aim = KAF(a_im)[pb * 64 + p], dt = expf(KAF(log_dt)[pb]);
        const float mag = expf(are * dt); float sn, cs; sincosf(aim * dt, &sn, &cs);
        const float lr = mag * cs, li = mag * sn;
        const float den = are * are + aim * aim, nr = lr - 1.0f, ni = li;
        const float zr = (nr * are + ni * aim) / den, zi = (ni * are - nr * aim) / den;
        float* lbar = (float*)X.lbar; float* l16 = (float*)X.l16; float* l64 = (float*)X.l64;
        lbar[gt * 2] = lr; lbar[gt * 2 + 1] = li;
        float pr = lr, pi = li;
#pragma unroll
        for (int s = 0; s < 4; ++s) { const float t = pr * pr - pi * pi; pi = 2.f * pr * pi; pr = t; }
        l16[gt * 2] = pr; l16[gt * 2 + 1] = pi;
#pragma unroll
        for (int s = 0; s < 2; ++s) { const float t = pr * pr - pi * pi; pi = 2.f * pr * pi; pr = t; }
        l64[gt * 2] = pr; l64[gt * 2 + 1] = pi;
        bf16_t* bfr = (bf16_t*)X.bfrag; bf16_t* cfr = (bf16_t*)X.cfrag;
        const int ntr = p >> 4, col = p & 15;
        for (int c = 0; c < 16; ++c) {
            const float br = KAF(b_re)[(pb * 64 + p) * 16 + c], bi = KAF(b_im)[(pb * 64 + p) * 16 + c];
            const float bbr = zr * br - zi * bi, bbi = zr * bi + zi * br;
            const int q = c >> 3, j = c & 7;
            bfr[(((size_t)dg * 8 + ntr) * 64 + col + 16 * q) * 8 + j] = (bf16_t)f2bf(bbr);
            bfr[(((size_t)dg * 8 + 4 + ntr) * 64 + col + 16 * q) * 8 + j] = (bf16_t)f2bf(bbi);
            bfr[(((size_t)dg * 8 + ntr) * 64 + col + 16 * (q + 2)) * 8 + j] = 0;
            bfr[(((size_t)dg * 8 + 4 + ntr) * 64 + col + 16 * (q + 2)) * 8 + j] = 0;
            const float cr = KAF(c_re)[(pb * 16 + c) * 64 + p], ci = KAF(c_im)[(pb * 16 + c) * 64 + p];
            { const int k = p;      cfr[(((size_t)dg * 4 + (k >> 5)) * 64 + c + 16 * ((k >> 3) & 3)) * 8 + (k & 7)] = (bf16_t)f2bf(cr); }
            { const int k = 64 + p; cfr[(((size_t)dg * 4 + (k >> 5)) * 64 + c + 16 * ((k >> 3) & 3)) * 8 + (k & 7)] = (bf16_t)f2bf(-ci); }
        }
    }
    if (gt >= 2048 && gt < 2048 + 256) {
        const int c = gt - 2048;
        const float l0 = KAF(lb_logits)[c], l1 = KAF(lb_logits)[256 + c], l2 = KAF(lb_logits)[512 + c], l3 = KAF(lb_logits)[768 + c];
        const float mx = fmaxf(fmaxf(l0, l1), fmaxf(l2, l3));
        const float e0 = expf(l0 - mx), e1 = expf(l1 - mx), e2 = expf(l2 - mx), e3 = expf(l3 - mx), inv = 1.f / (e0 + e1 + e2 + e3);
        float v = 0.f; if (l >= 1) v += e1 * inv; if (l >= 2) v += e2 * inv; if (l >= 3) v += e3 * inv;
        ((float*)X.lb)[c] = v;
    }
}

struct Grp { int g, nseq, Lr, nch, s0; };
__device__ __forceinline__ Grp make_grp(int g) { Grp r; r.g = g; r.nseq = g < 2 ? 4 : 1; r.Lr = g < 2 ? 4096 : 16384; r.nch = r.Lr / 64 + 1; r.s0 = g < 2 ? g * 4 : 8 + (g - 2); return r; }

template <bool OUT>
__device__ __forceinline__ void s5_chunk(const Ctx& X, const float* s5d, LAS float* buf, bf16_t* zc, int T, int ci, int wave, int lane) {
    const int p = lane, fr = lane & 15, fq = lane >> 4;
    for (int gi = 0; gi < 2; ++gi) {
        const int g = wave * 2 + gi;
        f32x4 yacc[2][2];
#pragma unroll
        for (int i = 0; i < 2; ++i)
#pragma unroll
            for (int j = 0; j < 2; ++j) yacc[i][j] = (f32x4){0.f, 0.f, 0.f, 0.f};
        bf16x8 ua[4];
#pragma unroll
        for (int m4 = 0; m4 < 4; ++m4) { ua[m4] = (bf16x8){0, 0, 0, 0, 0, 0, 0, 0}; if (fq < 2 && m4 * 16 < T) ua[m4] = *(const bf16x8*)(zc + (size_t)(m4 * 16 + fr) * ZW + g * 16 + fq * 8); }
        bf16x8 bfr2[2][8]; float lr2[2], li2[2], xr2[2], xi2[2];
#pragma unroll
        for (int dir = 0; dir < 2; ++dir) {
            const int dg = dir * 16 + g;
#pragma unroll
            for (int nt = 0; nt < 8; ++nt) bfr2[dir][nt] = *(const bf16x8*)(X.bfrag + (((size_t)dg * 8 + nt) * 64 + lane) * 8);
            lr2[dir] = X.lbar[(dg * 64 + p) * 2]; li2[dir] = X.lbar[(dg * 64 + p) * 2 + 1];
            xr2[dir] = 0.f; xi2[dir] = 0.f;
            if (OUT) { const float* st0 = X.s5s + ((size_t)ci * 2048 + dg * 64 + p) * 2; xr2[dir] = st0[0]; xi2[dir] = st0[1]; }
        }
#pragma unroll
        for (int dir = 0; dir < 2; ++dir) {
            const int dg = dir * 16 + g;
            const bf16x8 (&bfr)[8] = bfr2[dir];
            bf16x8 cfr[4];
            if (OUT) {
#pragma unroll
                for (int ks = 0; ks < 4; ++ks) cfr[ks] = *(const bf16x8*)(X.cfrag + (((size_t)dg * 4 + ks) * 64 + lane) * 8);
            }
            const float lr = lr2[dir], li = li2[dir];
            float xr = xr2[dir], xi = xi2[dir];
            float* st = X.s5s + ((size_t)ci * 2048 + dg * 64 + p) * 2;
#pragma unroll
            for (int sti = 0; sti < 2; ++sti) {
                const int stt = dir ? 1 - sti : sti; const int t0 = stt * 32;
                if (t0 < T) {
                    const int tn = (T - t0) < 32 ? (T - t0) : 32;
#pragma unroll
                    for (int mt = 0; mt < 2; ++mt) {
                        if (mt * 16 < tn) {
#pragma unroll
                            for (int nt = 0; nt < 8; ++nt) {
                                const f32x4 c = __builtin_amdgcn_mfma_f32_16x16x32_bf16(ua[stt * 2 + mt], bfr[nt], (f32x4){0.f, 0.f, 0.f, 0.f}, 0, 0, 0);
#pragma unroll
                                for (int r = 0; r < 4; ++r) buf[(mt * 16 + fq * 4 + r) * 132 + nt * 16 + fr] = c[r];
                            }
                        }
                    }
                    __syncthreads();
                    for (int k0 = 0; k0 < tn; k0 += 8) {
                        float br[8], bi[8];
#pragma unroll
                        for (int j = 0; j < 8; ++j) { const int t = dir ? (tn - 1 - k0 - j) : k0 + j; br[j] = buf[t * 132 + p]; bi[j] = buf[t * 132 + 64 + p]; }
#pragma unroll
                        for (int j = 0; j < 8; ++j) {
                            const int t = dir ? (tn - 1 - k0 - j) : k0 + j;
                            const float nr = lr * xr - li * xi + br[j], ni = lr * xi + li * xr + bi[j];
                            xr = nr; xi = ni;
                            if (OUT) { buf[t * 132 + p] = xr; buf[t * 132 + 64 + p] = xi; }
                        }
                    }
                    if (OUT) {
                        __syncthreads();
#pragma unroll
                        for (int mt = 0; mt < 2; ++mt) {
                            if (mt * 16 < tn) {
#pragma unroll
                                for (int ks = 0; ks < 4; ++ks) {
                                    const LAS float* ap = buf + (mt * 16 + fr) * 132 + ks * 32 + fq * 8;
                                    const f32x4 a0 = *(const LAS f32x4*)ap, a1 = *(const LAS f32x4*)(ap + 4);
                                    const u32x4 aw = pack8(a0, a1);
                                    const bf16x8 av = __builtin_bit_cast(bf16x8, aw);
                                    yacc[stt][mt] = __builtin_amdgcn_mfma_f32_16x16x32_bf16(av, cfr[ks], yacc[stt][mt], 0, 0, 0);
                                }
                            }
                        }
                    }
                    __syncthreads();
                }
            }
            if (!OUT) { st[0] = xr; st[1] = xi; }
        }
        if (OUT) {
            const float dsk = s5d[g * 16 + fr];
            float uv[16];
#pragma unroll
            for (int q4 = 0; q4 < 4; ++q4)
#pragma unroll
                for (int r = 0; r < 4; ++r) { uv[q4 * 4 + r] = 0.f; if (q4 * 16 < T) uv[q4 * 4 + r] = bf2f(zc[(size_t)(q4 * 16 + fq * 4 + r) * ZW + g * 16 + fr]); }
#pragma unroll
            for (int stt = 0; stt < 2; ++stt)
#pragma unroll
                for (int mt = 0; mt < 2; ++mt) {
                    if (stt * 32 + mt * 16 < T) {
#pragma unroll
                        for (int r = 0; r < 4; ++r) {
                            const int t = stt * 32 + mt * 16 + fq * 4 + r;
                            const float y = gelu_tanh(yacc[stt][mt][r] + dsk * uv[(stt * 2 + mt) * 4 + r]);
                            zc[(size_t)t * ZW + 512 + g * 16 + fr] = (bf16_t)f2bf(y);
                        }
                    }
                }
        }
    }
}

__device__ __forceinline__ void s5_passB(const Ctx& X, const Grp& gp, int gtid, int GT) {
    const int n = gp.nseq * 2048;
    for (int e = gtid; e < n; e += GT) {
        const int sl = e >> 11, r = e & 2047, dir = r >> 10;
        const float l16r = X.l16[r * 2], l16i = X.l16[r * 2 + 1], l64r = X.l64[r * 2], l64i = X.l64[r * 2 + 1];
        float* base = X.s5s + ((size_t)(sl * gp.nch) * 2048 + r) * 2; const long cstep = dir ? -4096 : 4096; float* first = dir ? base + (size_t)(gp.nch - 1) * 4096 : base;
        float sr = 0.f, si = 0.f;
        float er[2][8], ei[2][8];
#pragma unroll
        for (int j = 0; j < 8; ++j) { er[0][j] = 0.f; ei[0][j] = 0.f; if (j < gp.nch) { const float* pp = first + (long)j * cstep; er[0][j] = pp[0]; ei[0][j] = pp[1]; } }
        for (int k0 = 0; k0 < gp.nch; k0 += 16) {
#pragma unroll
            for (int hb = 0; hb < 2; ++hb) {
                const int kb = k0 + hb * 8;
                if (kb < gp.nch) {
#pragma unroll
                    for (int j = 0; j < 8; ++j) { const int k = kb + 8 + j; er[1 - hb][j] = 0.f; ei[1 - hb][j] = 0.f; if (k < gp.nch) { const float* pp = first + (long)k * cstep; er[1 - hb][j] = pp[0]; ei[1 - hb][j] = pp[1]; } }
#pragma unroll
                    for (int j = 0; j < 8; ++j) { const int k = kb + j; if (k < gp.nch) { float* pp = first + (long)k * cstep; pp[0] = sr; pp[1] = si;
                            const int c = dir ? gp.nch - 1 - k : k;
                            const float pr = c == 0 ? l16r : l64r, pi = c == 0 ? l16i : l64i;
                            const float nr = pr * sr - pi * si + er[hb][j], ni = pr * si + pi * sr + ei[hb][j]; sr = nr; si = ni; } }
                }
            }
        }
    }
}

typedef short v4i16_t __attribute__((ext_vector_type(4)));
__device__ __forceinline__ v4i16_t vtr16(const LAS unsigned char* p) { return __builtin_amdgcn_ds_read_tr16_b64_v4i16((LAS v4i16_t*)p); }
template <bool OUT>
__device__ __forceinline__ void hg_chunk(const Ctx& X, LAS float* gt, LAS bf16_t* ot, const bf16_t* zc, int T, int ci, int wave, int lane) {
    const int h = wave >> 1, dir = wave & 1;
    float S[64];
    float* U = X.hgu + ((size_t)ci * 8 + wave) * 4096;
    if (OUT) {
#pragma unroll
        for (int d = 0; d < 64; ++d) S[d] = U[d * 64 + lane];
    } else {
#pragma unroll
        for (int d = 0; d < 64; ++d) S[d] = 0.f;
    }
    const float lbv = X.lb[h * 64 + lane], oml = 1.f - lbv; float P = 1.f;
    const int fcol = (dir ? 2304 : 2048) + h * 64 + lane, qcol = 1792 + h * 64 + lane, vcol = 2560 + h * 64 + lane;
    const int ns8 = T >> 3;
    bf16_t rq[8], rf[8], rv[8];
    {
        const int sb0 = dir ? (ns8 - 1) : 0;
#pragma unroll
        for (int j = 0; j < 8; ++j) { const bf16_t* zr = zc + (size_t)(sb0 * 8 + j) * ZW; rq[j] = zr[qcol]; rf[j] = zr[fcol]; rv[j] = zr[vcol]; }
    }
#pragma unroll 1
    for (int s8 = 0; s8 < ns8; ++s8) {
        const int sb = dir ? (ns8 - 1 - s8) : s8;
#pragma unroll
        for (int j = 0; j < 8; ++j) {
            const float q = bf2f(rq[j]), ff = bf2f(rf[j]);
            const float sg = sigm(ff), fg = lbv + oml * sg, kk = oml * (1.f - sg);
            gt[j * 256 + lane] = fg; gt[j * 256 + 64 + lane] = kk; gt[j * 256 + 128 + lane] = q * sigm(q); gt[j * 256 + 192 + lane] = bf2f(rv[j]);
            P *= fg;
        }
        __syncthreads();
        if (s8 + 1 < ns8) {
            const int sbn = dir ? (ns8 - 2 - s8) : s8 + 1;
#pragma unroll
            for (int j = 0; j < 8; ++j) { const bf16_t* zr = zc + (size_t)(sbn * 8 + j) * ZW; rq[j] = zr[qcol]; rf[j] = zr[fcol]; rv[j] = zr[vcol]; }
        }
#pragma unroll 1
        for (int jj = 0; jj < 8; ++jj) {
            const int j = dir ? 7 - jj : jj;
            const LAS float* gj = gt + j * 256;
            const float v = gj[192 + lane];
            float o = 0.f;
#pragma unroll
            for (int d4 = 0; d4 < 16; ++d4) {
                const f32x4 f4 = *(const LAS f32x4*)(gj + d4 * 4), k4 = *(const LAS f32x4*)(gj + 64 + d4 * 4);
#pragma unroll
                for (int i = 0; i < 4; ++i) S[d4 * 4 + i] = f4[i] * S[d4 * 4 + i] + k4[i] * v;
                if (OUT) { const f32x4 q4 = *(const LAS f32x4*)(gj + 128 + d4 * 4);
#pragma unroll
                    for (int i = 0; i < 4; ++i) o += S[d4 * 4 + i] * q4[i]; }
                if ((d4 & 3) == 3) __builtin_amdgcn_sched_barrier(0);
            }
            if (OUT) ot[(sb * 8 + j) * 64 + lane] = (bf16_t)f2bf(o);
        }
        __syncthreads();
    }
    if (!OUT) {
#pragma unroll
        for (int d = 0; d < 64; ++d) U[d * 64 + lane] = S[d];
        X.hgp[((size_t)ci * 8 + wave) * 64 + lane] = P;
    }
}

__device__ __forceinline__ void hg_passA_mfma(const Ctx& X, LAS unsigned char* wl, const bf16_t* zc, int T, int ci, int wave, int lane) {
    const int h = wave >> 1, dir = wave & 1, fq = lane >> 4, l16 = lane & 15, r8 = lane >> 3, pc = lane & 7;
    LAS unsigned char* kl = wl; LAS unsigned char* vl = wl + 4608;
    const float lbv = X.lb[h * 64 + lane], oml = 1.f - lbv;
    const int fcol = (dir ? 2304 : 2048) + h * 64 + lane, vcolb = 2560 + h * 64 + pc * 8;
    f32x4 acc[4][4];
#pragma unroll
    for (int a = 0; a < 4; ++a)
#pragma unroll
        for (int b = 0; b < 4; ++b) acc[a][b] = (f32x4){0.f, 0.f, 0.f, 0.f};
    float run = 1.f;
    const int nh = (T + 31) >> 5;
#pragma unroll 1
    for (int hh = 0; hh < nh; ++hh) {
        const int hb = dir ? hh : (nh - 1 - hh); const int t0 = hb * 32; const int tn = (T - t0) < 32 ? (T - t0) : 32;
        u32x4 vr[4];
#pragma unroll
        for (int i = 0; i < 4; ++i) { const int rr = i * 8 + r8; vr[i] = (u32x4){0u, 0u, 0u, 0u}; if (rr < tn) vr[i] = *(const u32x4*)(zc + (size_t)(t0 + rr) * ZW + vcolb); }
        __syncthreads();
#pragma unroll 1
        for (int bt = 0; bt < 2; ++bt) {
            const int j0 = (dir ? bt : 1 - bt) * 16;
            bf16_t rf[16];
#pragma unroll
            for (int j = 0; j < 16; ++j) { rf[j] = 0; if (j0 + j < tn) rf[j] = zc[(size_t)(t0 + j0 + j) * ZW + fcol]; }
#pragma unroll
            for (int jj = 0; jj < 16; ++jj) {
                const int jl = dir ? jj : 15 - jj; const int j = j0 + jl;
                float kh = 0.f;
                if (j < tn) { const float sg = sigm(bf2f(dir ? rf[jj] : rf[15 - jj])); kh = oml * (1.f - sg) * run; run *= lbv + oml * sg; }
                *(LAS bf16_t*)(kl + j * 144 + lane * 2) = (bf16_t)f2bf(kh);
            }
        }
#pragma unroll
        for (int i = 0; i < 4; ++i) *(LAS u32x4*)(vl + (i * 8 + r8) * 144 + pc * 16) = vr[i];
        __syncthreads();
        const int roff = (4 * fq + (l16 >> 2)) * 144 + (4 * (l16 & 3)) * 2;
        bf16x8 af[4];
#pragma unroll
        for (int mt = 0; mt < 4; ++mt) { const v4i16_t ta = vtr16(kl + roff + mt * 32), tb = vtr16(kl + roff + 16 * 144 + mt * 32); af[mt] = (bf16x8){ta[0], ta[1], ta[2], ta[3], tb[0], tb[1], tb[2], tb[3]}; }
#pragma unroll
        for (int nt = 0; nt < 4; ++nt) {
            const v4i16_t ta = vtr16(vl + roff + nt * 32), tb = vtr16(vl + roff + 16 * 144 + nt * 32);
            const bf16x8 bfv = (bf16x8){ta[0], ta[1], ta[2], ta[3], tb[0], tb[1], tb[2], tb[3]};
#pragma unroll
            for (int mt = 0; mt < 4; ++mt) acc[mt][nt] = __builtin_amdgcn_mfma_f32_16x16x32_bf16(af[mt], bfv, acc[mt][nt], 0, 0, 0);
        }
    }
    float* U = X.hgu + ((size_t)ci * 8 + wave) * 4096 + (4 * fq) * 64 + l16;
#pragma unroll
    for (int mt = 0; mt < 4; ++mt) {
#pragma unroll
        for (int r = 0; r < 4; ++r)
#pragma unroll
            for (int nt = 0; nt < 4; ++nt) U[(16 * mt + r) * 64 + 16 * nt] = acc[mt][nt][r];
        __builtin_amdgcn_sched_barrier(0);
    }
    X.hgp[((size_t)ci * 8 + wave) * 64 + lane] = run;
}

__device__ __forceinline__ void hg_passC_mfma(const Ctx& X, LAS unsigned char* wl, LAS bf16_t* ot, const bf16_t* zc, int T, int ci, int wave, int lane) {
    const int h = wave >> 1, dir = wave & 1, fq = lane >> 4, l16 = lane & 15, r8 = lane >> 3, pc = lane & 7;
    LAS unsigned char* ql = wl; LAS unsigned char* kl = wl + 2304; LAS unsigned char* vl = wl + 4608; LAS float* pl = (LAS float*)(wl + 6912);
    const float lbv = X.lb[h * 64 + lane], oml = 1.f - lbv;
    const int fcol = (dir ? 2304 : 2048) + h * 64 + lane, qcol = 1792 + h * 64 + lane, vcolb = 2560 + h * 64 + pc * 8;
    f32x4 sa[4][4];
    {
        const float* U = X.hgu + ((size_t)ci * 8 + wave) * 4096 + (4 * fq) * 64 + l16;
#pragma unroll
        for (int mt = 0; mt < 4; ++mt) {
#pragma unroll
            for (int r = 0; r < 4; ++r)
#pragma unroll
                for (int nt = 0; nt < 4; ++nt) sa[mt][nt][r] = U[(16 * mt + r) * 64 + 16 * nt];
            __builtin_amdgcn_sched_barrier(0);
        }
    }
    const int nsc = T >> 4;
    bf16_t rq[16], rf[16]; u32x4 vr[2];
    {
        const int I0 = dir ? (nsc - 1) : 0;
#pragma unroll
        for (int i = 0; i < 16; ++i) { const int tok = 16 * I0 + (dir ? 15 - i : i); rq[i] = zc[(size_t)tok * ZW + qcol]; rf[i] = zc[(size_t)tok * ZW + fcol]; }
#pragma unroll
        for (int i8 = 0; i8 < 2; ++i8) { const int i = i8 * 8 + r8; const int tok = 16 * I0 + (dir ? 15 - i : i); vr[i8] = *(const u32x4*)(zc + (size_t)tok * ZW + vcolb); }
    }
#pragma unroll 1
    for (int sc = 0; sc < nsc; ++sc) {
        const int I = dir ? (nsc - 1 - sc) : sc;
        __syncthreads();
        float c = 1.f;
#pragma unroll
        for (int i = 0; i < 16; ++i) {
            const float q = bf2f(rq[i]), sg = sigm(bf2f(rf[i]));
            c *= lbv + oml * sg;
            *(LAS bf16_t*)(ql + i * 144 + lane * 2) = (bf16_t)f2bf(q * sigm(q) * c);
            *(LAS bf16_t*)(kl + i * 144 + lane * 2) = (bf16_t)f2bf(oml * (1.f - sg) / c);
        }
        pl[lane] = c;
#pragma unroll
        for (int i8 = 0; i8 < 2; ++i8) *(LAS u32x4*)(vl + (i8 * 8 + r8) * 144 + pc * 16) = vr[i8];
        __syncthreads();
        if (sc + 1 < nsc) {
            const int In = dir ? (nsc - 2 - sc) : sc + 1;
#pragma unroll
            for (int i = 0; i < 16; ++i) { const int tok = 16 * In + (dir ? 15 - i : i); rq[i] = zc[(size_t)tok * ZW + qcol]; rf[i] = zc[(size_t)tok * ZW + fcol]; }
#pragma unroll
            for (int i8 = 0; i8 < 2; ++i8) { const int i = i8 * 8 + r8; const int tok = 16 * In + (dir ? 15 - i : i); vr[i8] = *(const u32x4*)(zc + (size_t)tok * ZW + vcolb); }
        }
        f32x4 at = (f32x4){0.f, 0.f, 0.f, 0.f};
#pragma unroll
        for (int ks = 0; ks < 2; ++ks) at = __builtin_amdgcn_mfma_f32_16x16x32_bf16(*(const LAS bf16x8*)(kl + l16 * 144 + (32 * ks + 8 * fq) * 2), *(const LAS bf16x8*)(ql + l16 * 144 + (32 * ks + 8 * fq) * 2), at, 0, 0, 0);
#pragma unroll
        for (int r = 0; r < 4; ++r) if (4 * fq + r > l16) at[r] = 0.f;
        const bf16x8 atf = __builtin_bit_cast(bf16x8, pack8(at, (f32x4){0.f, 0.f, 0.f, 0.f}));
        const int roff = (4 * fq + (l16 >> 2)) * 144 + (4 * (l16 & 3)) * 2;
        f32x4 oT[4];
#pragma unroll
        for (int et = 0; et < 4; ++et) {
            const v4i16_t tv = vtr16(vl + roff + et * 32);
            const bf16x8 vf = (bf16x8){tv[0], tv[1], tv[2], tv[3], 0, 0, 0, 0};
            oT[et] = __builtin_amdgcn_mfma_f32_16x16x32_bf16(vf, atf, (f32x4){0.f, 0.f, 0.f, 0.f}, 0, 0, 0);
        }
#pragma unroll
        for (int kp = 0; kp < 2; ++kp) {
            const u32x2 q0 = *(const LAS u32x2*)(ql + l16 * 144 + (32 * kp + 4 * fq) * 2), q1 = *(const LAS u32x2*)(ql + l16 * 144 + (32 * kp + 16 + 4 * fq) * 2);
            const bf16x8 qfr = __builtin_bit_cast(bf16x8, (u32x4){q0.x, q0.y, q1.x, q1.y});
#pragma unroll
            for (int nt = 0; nt < 4; ++nt) {
                const bf16x8 sf = __builtin_bit_cast(bf16x8, pack8(sa[2 * kp][nt], sa[2 * kp + 1][nt]));
                oT[nt] = __builtin_amdgcn_mfma_f32_16x16x32_bf16(sf, qfr, oT[nt], 0, 0, 0);
            }
        }
        {
            const int tok = 16 * I + (dir ? 15 - l16 : l16);
#pragma unroll
            for (int et = 0; et < 4; ++et)
#pragma unroll
                for (int r = 0; r < 4; ++r) ot[tok * 64 + 16 * et + 4 * fq + r] = (bf16_t)f2bf(oT[et][r]);
        }
        bf16x8 kf[4];
#pragma unroll
        for (int mt = 0; mt < 4; ++mt) { const v4i16_t tk = vtr16(kl + roff + mt * 32); kf[mt] = (bf16x8){tk[0], tk[1], tk[2], tk[3], 0, 0, 0, 0}; }
#pragma unroll
        for (int nt = 0; nt < 4; ++nt) {
            const v4i16_t tv = vtr16(vl + roff + nt * 32);
            const bf16x8 vf = (bf16x8){tv[0], tv[1], tv[2], tv[3], 0, 0, 0, 0};
#pragma unroll
            for (int mt = 0; mt < 4; ++mt) sa[mt][nt] = __builtin_amdgcn_mfma_f32_16x16x32_bf16(kf[mt], vf, sa[mt][nt], 0, 0, 0);
        }
#pragma unroll
        for (int mt = 0; mt < 4; ++mt) {
            const f32x4 p4 = *(const LAS f32x4*)(pl + 16 * mt + 4 * fq);
#pragma unroll
            for (int nt = 0; nt < 4; ++nt) sa[mt][nt] = sa[mt][nt] * p4;
        }
    }
}

__device__ __forceinline__ void hg_passB(const Ctx& X, const Grp& gp, int gtid, int GT) {
    const int n = gp.nseq * 32768;
    for (int e = gtid; e < n; e += GT) {
        const int sl = e >> 15, r = e & 32767, hd = r >> 12, de = r & 4095, d = de >> 6, dir = hd & 1;
        const size_t cb0 = (size_t)(sl * gp.nch) * 8 + hd; const int cstep = dir ? -8 : 8; const size_t cfirst = dir ? cb0 + (size_t)(gp.nch - 1) * 8 : cb0;
        float s = 0.f;
        float u[2][8], pv[2][8];
#pragma unroll
        for (int j = 0; j < 8; ++j) { u[0][j] = 0.f; pv[0][j] = 0.f; if (j < gp.nch) { const size_t cb = cfirst + (long)j * cstep; u[0][j] = X.hgu[cb * 4096 + de]; pv[0][j] = X.hgp[cb * 64 + d]; } }
        for (int k0 = 0; k0 < gp.nch; k0 += 16) {
#pragma unroll
            for (int hb = 0; hb < 2; ++hb) {
                const int kb = k0 + hb * 8;
                if (kb < gp.nch) {
#pragma unroll
                    for (int j = 0; j < 8; ++j) { const int k = kb + 8 + j; u[1 - hb][j] = 0.f; pv[1 - hb][j] = 0.f; if (k < gp.nch) { const size_t cb = cfirst + (long)k * cstep; u[1 - hb][j] = X.hgu[cb * 4096 + de]; pv[1 - hb][j] = X.hgp[cb * 64 + d]; } }
#pragma unroll
                    for (int j = 0; j < 8; ++j) { const int k = kb + j; if (k < gp.nch) { const size_t cb = cfirst + (long)k * cstep; X.hgu[cb * 4096 + de] = s; s = pv[hb][j] * s + u[hb][j]; } }
                }
            }
        }
    }
}

__device__ __forceinline__ void na_task(const Ctx& X, const float* rpb, const Grp& gp, int sl, int task, bool metaq, int wave, int lane, LAS unsigned char* vl) {
    const int h = wave, fr = lane & 15, fq = lane >> 4;
    const int s = gp.s0 + sl, rows = gp.Lr >> 6;
    int r = 0, n = 0, rs = 0, ks = 0;
    const bf16_t* qptr; bf16_t* optr; size_t ostride = 512;
    if (metaq) { qptr = X.mz + (size_t)(s * 16 + fr) * ZW; optr = X.myb + (size_t)(s * 16) * 512; }
    else {
        r = task >> 2; n = task & 3;
        rs = r - 4; rs = rs < 0 ? 0 : (rs > rows - 8 ? rows - 8 : rs);
        ks = 16 * n - 8; ks = ks < 0 ? 0 : (ks > 32 ? 32 : ks);
        const size_t qrow0 = (size_t)sl * gp.Lr + r * 64 + 16 * n;
        qptr = X.z + (qrow0 + fr) * ZW; optr = X.yb + qrow0 * 512;
    }
    bf16x8 qf[2];
#pragma unroll
    for (int kk = 0; kk < 2; ++kk) qf[kk] = *(const bf16x8*)(qptr + 256 + h * 64 + 32 * kk + 8 * fq);
    f32x4 sc[17];
    {
        const bf16_t* kp = X.mz + (size_t)(s * 16 + fr) * ZW + 768 + h * 64 + 8 * fq;
        f32x4 c = (f32x4){0.f, 0.f, 0.f, 0.f};
#pragma unroll
        for (int kk = 0; kk < 2; ++kk) c = __builtin_amdgcn_mfma_f32_16x16x32_bf16(*(const bf16x8*)(kp + 32 * kk), qf[kk], c, 0, 0, 0);
        sc[0] = c * 0.125f;
    }
    const int qc = 16 * n + fr;
    int wstart = qc - 8; wstart = wstart < 0 ? 0 : (wstart > 48 ? 48 : wstart);
    const size_t krow_base = (size_t)sl * gp.Lr + (size_t)rs * 64 + ks;
    const int r8v = lane >> 3, pcv = lane & 7; const int vcolv = 1280 + h * 64 + pcv * 8;
    u32x4 vpre0[2], vpre1[8];
#pragma unroll
    for (int i = 0; i < 2; ++i) vpre0[i] = *(const u32x4*)(X.mz + (size_t)(s * 16 + i * 8 + r8v) * ZW + vcolv);
#pragma unroll
    for (int i = 0; i < 8; ++i) { vpre1[i] = (u32x4){0u, 0u, 0u, 0u}; if (!metaq) { const int rr = i * 8 + r8v; vpre1[i] = *(const u32x4*)(X.z + (krow_base + (size_t)(rr >> 5) * 64 + (rr & 31)) * ZW + vcolv); } }
    if (!metaq) {
#pragma unroll
        for (int tb = 0; tb < 2; ++tb) {
            bf16x8 kf[8][2]; float bz[8][4];
#pragma unroll
            for (int t4 = 0; t4 < 8; ++t4) {
                const int tt = tb * 8 + t4, kj = tt >> 1, half = tt & 1;
                const bf16_t* kp = X.z + (krow_base + kj * 64 + 16 * half + fr) * ZW + 768 + h * 64 + 8 * fq;
                kf[t4][0] = *(const bf16x8*)kp; kf[t4][1] = *(const bf16x8*)(kp + 32);
            }
#pragma unroll
            for (int t4 = 0; t4 < 8; ++t4) {
                const int tt = tb * 8 + t4, kj = tt >> 1, half = tt & 1;
                const float* rp = rpb + (h * 15 + (rs + kj - r + 7)) * 31;
#pragma unroll
                for (int i = 0; i < 4; ++i) { int dc = ks + 16 * half + 4 * fq + i - qc; dc = dc < -15 ? -15 : (dc > 15 ? 15 : dc); bz[t4][i] = rp[dc + 15]; }
            }
            __builtin_amdgcn_sched_barrier(0);
#pragma unroll
            for (int t4 = 0; t4 < 8; ++t4) {
                const int tt = tb * 8 + t4, half = tt & 1;
                f32x4 c = (f32x4){0.f, 0.f, 0.f, 0.f};
                c = __builtin_amdgcn_mfma_f32_16x16x32_bf16(kf[t4][0], qf[0], c, 0, 0, 0);
                c = __builtin_amdgcn_mfma_f32_16x16x32_bf16(kf[t4][1], qf[1], c, 0, 0, 0);
#pragma unroll
                for (int i = 0; i < 4; ++i) {
                    const int kc = ks + 16 * half + 4 * fq + i;
                    const bool valid = (kc >= wstart) && (kc < wstart + 16);
                    c[i] = valid ? c[i] * 0.125f + bz[t4][i] : -1e30f;
                }
                sc[1 + tt] = c;
            }
            __builtin_amdgcn_sched_barrier(0);
        }
    } else {
#pragma unroll
        for (int tt = 0; tt < 16; ++tt) sc[1 + tt] = (f32x4){-1e30f, -1e30f, -1e30f, -1e30f};
    }
    float mx = -1e30f;
#pragma unroll
    for (int t = 0; t < 17; ++t)
#pragma unroll
        for (int i = 0; i < 4; ++i) mx = fmaxf(mx, sc[t][i]);
    mx = fmaxf(mx, __shfl_xor(mx, 16)); mx = fmaxf(mx, __shfl_xor(mx, 32));
    float sum = 0.f;
#pragma unroll
    for (int t = 0; t < 17; ++t)
#pragma unroll
        for (int i = 0; i < 4; ++i) { const float e = __expf(sc[t][i] - mx); sc[t][i] = e; sum += e; }
    sum += __shfl_xor(sum, 16); sum += __shfl_xor(sum, 32);
    const float inv = 1.f / sum;
    f32x4 oacc[4];
#pragma unroll
    for (int et = 0; et < 4; ++et) oacc[et] = (f32x4){0.f, 0.f, 0.f, 0.f};
    {
        const int r8 = lane >> 3, pc = lane & 7, l16 = lane & 15;
        const int vcol = 1280 + h * 64 + pc * 8;
        u32x4 vreg[8];
#pragma unroll
        for (int i = 0; i < 2; ++i) vreg[i] = vpre0[i];
#pragma unroll
        for (int cc = 0; cc < 5; ++cc) {
            if (cc > 0 && metaq) break;
            __syncthreads();
#pragma unroll
            for (int i = 0; i < 8; ++i) if (cc > 0 || i < 2) *(LAS u32x4*)(vl + (i * 8 + r8) * 144 + pc * 16) = vreg[i];
            __syncthreads();
            if (cc < 4 && !metaq) {
#pragma unroll
                for (int i = 0; i < 8; ++i) { const int rr = i * 8 + r8;
                    if (cc == 0) vreg[i] = vpre1[i];
                    else vreg[i] = *(const u32x4*)(X.z + (krow_base + (size_t)(2 * cc + (rr >> 5)) * 64 + (rr & 31)) * ZW + vcol); }
            }
#pragma unroll
            for (int ksl = 0; ksl < 2; ++ksl) {
                if (cc == 0 && ksl == 1) break;
                const int tt = 4 * (cc - 1) + 2 * ksl;
                f32x4 pa, pb;
                if (cc == 0) { pa = sc[0] * inv; pb = (f32x4){0.f, 0.f, 0.f, 0.f}; } else { pa = sc[1 + tt] * inv; pb = sc[2 + tt] * inv; }
                const bf16x8 pf = __builtin_bit_cast(bf16x8, pack8(pa, pb));
                const LAS unsigned char* rowp = vl + (32 * ksl + 4 * fq + (l16 >> 2)) * 144 + (4 * (l16 & 3)) * 2;
#pragma unroll
                for (int et = 0; et < 4; ++et) {
                    const v4i16_t ta = vtr16(rowp + et * 32);
                    v4i16_t tb = (v4i16_t){0, 0, 0, 0};
                    if (cc > 0) tb = vtr16(rowp + 16 * 144 + et * 32);
                    const bf16x8 vw = (bf16x8){ta[0], ta[1], ta[2], ta[3], tb[0], tb[1], tb[2], tb[3]};
                    oacc[et] = __builtin_amdgcn_mfma_f32_16x16x32_bf16(pf, vw, oacc[et], 0, 0, 0);
                }
            }
        }
    }
#pragma unroll
    for (int et = 0; et < 4; ++et)
#pragma unroll
        for (int i = 0; i < 4; ++i) optr[(size_t)(4 * fq + i) * ostride + h * 64 + et * 16 + fr] = (bf16_t)f2bf(oacc[et][i]);
}

#define XB_TMO      128
#define XB_XCNT(j)  (256  + 64 * (j))
#define XB_XSUB(j)  (1280 + 64 * (j))
#define XB_XGEN(j)  (2304 + 64 * (j))
#define XB_TOP      3328
#define XB_TOPGEN   3392
#define XCD_BAR_WORDS 3456
#define XB_SPIN_CAP (1u << 22)
__device__ __forceinline__ unsigned xb_ld(unsigned* p)              { return __hip_atomic_load(p, __ATOMIC_RELAXED, __HIP_MEMORY_SCOPE_AGENT); }
__device__ __forceinline__ unsigned xb_add(unsigned* p, unsigned v) { return __hip_atomic_fetch_add(p, v, __ATOMIC_RELAXED, __HIP_MEMORY_SCOPE_AGENT); }
__device__ __forceinline__ unsigned xb_xcc_id() { return (unsigned)__builtin_amdgcn_s_getreg((3 << 11) | 20) & 0xFu; }
#define XB_SPIN(cond, bar) do { unsigned _sp = 0; while (cond) { __builtin_amdgcn_s_sleep(1); \
    if ((++_sp & 255u) == 0u) { if (xb_ld(&(bar)[XB_TMO])) break; if (_sp > XB_SPIN_CAP) { atomicAdd(&(bar)[XB_TMO], 1u); break; } } } } while (0)
__device__ __forceinline__ void xcd_barrier_complete(unsigned* bar, unsigned x, unsigned& nloc, unsigned& nx) {
    const unsigned G = gridDim.x * gridDim.y * gridDim.z;
    unsigned sum, cnt, mine, sp = 0u;
    for (;;) {
        sum = 0u; cnt = 0u; mine = 0u;
#pragma unroll
        for (unsigned j = 0; j < 16; ++j) { const unsigned c = xb_ld(&bar[XB_XCNT(j)]); sum += c; cnt += (c > 0u) ? 1u : 0u; mine = (j == x) ? c : mine; }
        if (sum == G) break;
        __builtin_amdgcn_s_sleep(1);
        if ((++sp & 255u) == 0u) { if (xb_ld(&bar[XB_TMO])) break; if (sp > XB_SPIN_CAP) { atomicAdd(&bar[XB_TMO], 1u); break; } }
    }
    nloc = mine > 0u ? mine : 1u; nx = cnt > 0u ? cnt : 1u;
}
__device__ __forceinline__ void xcd_barrier(unsigned* bar, volatile LAS unsigned* st) {
    asm volatile("s_waitcnt vmcnt(0)" ::: "memory");
    __syncthreads();
    if (threadIdx.x == 0) {
        const unsigned x = xb_xcc_id();
        __builtin_amdgcn_s_waitcnt(0);
        unsigned nloc = st[0], nx = st[1];
        if (nloc == 0u) { xcd_barrier_complete(bar, x, nloc, nx); st[0] = nloc; st[1] = nx; }
        const unsigned old = xb_add(&bar[XB_XSUB(x)], 1u);
        const unsigned gen = old / nloc;
        if (old + 1u == (gen + 1u) * nloc) {
            __builtin_amdgcn_fence(__ATOMIC_RELEASE, "agent");
            asm volatile("s_waitcnt vmcnt(0)" ::: "memory");
            const unsigned og = xb_add(&bar[XB_TOP], 1u);
            const unsigned tg = og / nx;
            if (og + 1u == (tg + 1u) * nx) xb_add(&bar[XB_TOPGEN], 1u);
            else XB_SPIN(xb_ld(&bar[XB_TOPGEN]) == tg, bar);
            __builtin_amdgcn_fence(__ATOMIC_ACQUIRE, "agent");
            xb_add(&bar[XB_XGEN(x)], 1u);
            asm volatile("s_waitcnt vmcnt(0)" ::: "memory");
        } else {
            XB_SPIN(xb_ld(&bar[XB_XGEN(x)]) == gen, bar);
            __builtin_amdgcn_fence(__ATOMIC_ACQUIRE, "agent");
            asm volatile("s_waitcnt vmcnt(0)" ::: "memory");
        }
    }
    __syncthreads();
}
#define GRID_SYNC() xcd_barrier((unsigned*)(KA(ws) + WS_CTL), (volatile LAS unsigned*)(lds + LDS_ST_OFF))
__device__ __forceinline__ Ctx make_ctx(unsigned char* ws) {
    Ctx X;
    X.hb = (bf16_t*)(ws + WS_HB); X.ssq = (float*)(ws + WS_SSQ); X.z = (bf16_t*)(ws + WS_Z); X.yb = (bf16_t*)(ws + WS_YB); X.vt = (bf16_t*)(ws + WS_VT);
    X.hgu = (float*)(ws + WS_HGU); X.hgp = (float*)(ws + WS_HGP); X.s5s = (float*)(ws + WS_S5S); X.w = (bf16_t*)(ws + WS_W);
    X.lbar = (const float*)(ws + WS_TAB + T_LBAR); X.l16 = (const float*)(ws + WS_TAB + T_L16); X.l64 = (const float*)(ws + WS_TAB + T_L64);
    X.bfrag = (const bf16_t*)(ws + WS_TAB + T_BFRAG); X.cfrag = (const bf16_t*)(ws + WS_TAB + T_CFRAG); X.lb = (const float*)(ws + WS_TAB + T_LB);
    X.mh = (float*)(ws + WS_META + M_H); X.mhb = (bf16_t*)(ws + WS_META + M_HB); X.mssq = (float*)(ws + WS_META + M_SSQ); X.mz = (bf16_t*)(ws + WS_META + M_Z);
    X.myb = (bf16_t*)(ws + WS_META + M_YB); X.mvt = (bf16_t*)(ws + WS_META + M_VT); X.mact = (bf16_t*)(ws + WS_META + M_ACT);
    return X;
}

__device__ __forceinline__ bool make_job(unsigned char* ws, float* out, int l, int g, int ph, int j, pg8::Gemm& gm, pg8::UberEpi& ep) {
    const bool mchain = (g == 3) && (l < NLAYER - 1);
    int njobs = 1; bool meta = false; int sub = j;
    if (ph == 0) { njobs = (g == 0) ? 2 : 1; meta = (j == 1); }
    else if (ph == 4) { njobs = (g == 3) ? 2 : 1; meta = (j == 1); }
    else if (ph == 5) { njobs = mchain ? 6 : 3; meta = (j >= 3); sub = j % 3; }
    else { njobs = mchain ? 2 : 1; meta = (j == 1); }
    if (j >= njobs) return false;
    unsigned char* wb = ws + WS_W;
    const size_t r0 = (size_t)g * RG;
    unsigned char* mb = ws + WS_META;
    bf16_t* z = meta ? (bf16_t*)(mb + M_Z) : (bf16_t*)(ws + WS_Z);
    bf16_t* hb = meta ? (bf16_t*)(mb + M_HB) : (bf16_t*)(ws + WS_HB) + r0 * DM;
    float* ssq = meta ? (float*)(mb + M_SSQ) : (float*)(ws + WS_SSQ) + r0 * 4;
    float* h = meta ? (float*)(mb + M_H) : out + r0 * DM;
    bf16_t* yb = meta ? (bf16_t*)(mb + M_YB) : (bf16_t*)(ws + WS_YB);
    bf16_t* vt = meta ? (bf16_t*)(mb + M_VT) : (bf16_t*)(ws + WS_VT);
    bf16_t* act = meta ? (bf16_t*)(mb + M_ACT) : (bf16_t*)(ws + WS_Z);
    gm.M = meta ? 256 : RG;
    ep.i0 = 0; ep.p0 = nullptr; ep.p1 = nullptr; ep.p2 = nullptr;
    if (ph == 0) { gm.A = hb; gm.lda = DM; gm.Bt = (const bf16_t*)(wb + W_IN); gm.N = ZN; gm.K = DM; ep.mode = 0; ep.p0 = (unsigned char*)z; ep.p1 = (unsigned char*)ssq; ep.p2 = (unsigned char*)vt; ep.i0 = meta ? 256 : VTLD; }
    else if (ph == 4) { gm.A = z + 512; gm.lda = ZW; gm.Bt = (const bf16_t*)(wb + W_GLU); gm.N = 256; gm.K = 256; ep.mode = 1; ep.p0 = (unsigned char*)z; }
    else if (ph == 5) {
        gm.N = DM; ep.p0 = (unsigned char*)z;
        if (sub == 0) { gm.A = yb; gm.lda = 512; gm.Bt = (const bf16_t*)(wb + W_UPB); gm.K = 512; ep.mode = 2; ep.i0 = 4096; }
        else if (sub == 1) { gm.A = z + 256; gm.lda = ZW; gm.Bt = (const bf16_t*)(wb + W_UPC); gm.K = 256; ep.mode = 3; ep.i0 = 5120; }
        else { gm.A = z; gm.lda = ZW; gm.Bt = (const bf16_t*)(wb + W_UPA); gm.K = 256; ep.mode = 3; ep.i0 = 3072; }
    }
    else if (ph == 6) { gm.A = z + 1024; gm.lda = ZW; gm.Bt = (const bf16_t*)(wb + W_O); gm.N = DM; gm.K = DM; ep.mode = 4; ep.p0 = (unsigned char*)h; ep.p1 = (unsigned char*)hb; ep.p2 = (unsigned char*)ssq; }
    else if (ph == 7) { gm.A = hb; gm.lda = DM; gm.Bt = (const bf16_t*)(wb + W_GU); gm.N = 2 * FFH; gm.K = DM; ep.mode = 5; ep.p0 = (unsigned char*)act; ep.p1 = (unsigned char*)ssq; }
    else { gm.A = act; gm.lda = FFH; gm.Bt = (const bf16_t*)(wb + W_DN); gm.N = DM; gm.K = FFH; ep.mode = 4; ep.p0 = (unsigned char*)h; ep.p1 = (unsigned char*)hb; ep.p2 = (unsigned char*)ssq; }
    return true;
}

__device__ __forceinline__ void prologue(int G) {
    const int tid_ = opaque_tid(); const int lane = tid_ & 63, gw = blockIdx.x * 8 + __builtin_amdgcn_readfirstlane(tid_ >> 6), NGW = G * 8;
    const Ctx X = make_ctx(((unsigned char*)KA(ws)));
    for (int row = gw; row < RMAIN + 256; row += NGW) {
        const bool ismeta = row >= RMAIN; const int mr = row - RMAIN;
        const float* src = ismeta ? (mr < 160 ? KAF(meta_tokens) + (size_t)(mr & 15) * DM : nullptr) : (row < 32768 ? KAF(x_prompt) + (size_t)row * DM : KAF(x_sample) + (size_t)(row - 32768) * DM);
        float* hd = ismeta ? X.mh + (size_t)mr * DM : ((float*)KA(out)) + (size_t)row * DM;
        bf16_t* hbd = ismeta ? X.mhb + (size_t)mr * DM : X.hb + (size_t)row * DM;
        float* sq = ismeta ? X.mssq + (size_t)mr * 4 : X.ssq + (size_t)row * 4;
        float ss = 0.f;
#pragma unroll
        for (int j = 0; j < 4; ++j) {
            f32x4 v = (f32x4){0.f, 0.f, 0.f, 0.f}; if (src) v = *(const f32x4*)(src + j * 256 + lane * 4);
            *(f32x4*)(hd + j * 256 + lane * 4) = v;
            *(u32x2*)(hbd + j * 256 + lane * 4) = (u32x2){pk2(v[0], v[1]), pk2(v[2], v[3])};
            ss += (v[0] * v[0] + v[1] * v[1]) + (v[2] * v[2] + v[3] * v[3]);
        }
        ss = wave_sum(ss);
        if (lane < 4) sq[lane] = lane == 0 ? ss : 0.f;
    }
}

__device__ __forceinline__ void mixer_phase_A(int l, int g, LAS unsigned char* lds, int G, int bid) {
    const int tid_ = opaque_tid(); const int lane = tid_ & 63, wave = __builtin_amdgcn_readfirstlane(tid_ >> 6);
    const Ctx X = make_ctx(((unsigned char*)KA(ws))); const Grp gp = make_grp(g);
    const float* rpb = KAF(rpb) + (size_t)l * 8 * 15 * 31; const float* s5d = KAF(s5_d) + l * 256;
    const int nna = gp.nseq * (gp.Lr / 16), nmq = (l == NLAYER - 1) ? 0 : gp.nseq  , nct = gp.nseq * (gp.nch - 1);
    const int ntask = nna + nmq + 2 * nct;
    const bool xmap = (nna % 256 == 0) && ((volatile LAS unsigned*)(lds + LDS_ST_OFF))[4] != 0u;
    if (xmap) {
        const int xcc = (int)((volatile LAS unsigned*)(lds + LDS_ST_OFF))[2], xrk = (int)((volatile LAS unsigned*)(lds + LDS_ST_OFF))[3];
        const int per = gp.Lr / 16, nx = nna / 8, rounds = nna / 256;
        for (int i = 0; i < rounds; ++i) { const int t = xcc * nx + xrk + 32 * i; na_task(X, rpb, gp, t / per, t % per, false, wave, lane, lds + wave * 9216); }
    }
    for (int t = bid + (xmap ? nna : 0); t < ntask; t += G) {
        __syncthreads();
        if (t < nna) { const int per = gp.Lr / 16; na_task(X, rpb, gp, t / per, t % per, false, wave, lane, lds + wave * 9216); }
        else if (t < nna + nmq) { na_task(X, rpb, gp, t - nna, 0, true, wave, lane, lds + wave * 9216); }
        else {
            const int u = t - nna - nmq; const bool isS5 = u < nct; const int v = isS5 ? u : u - nct;
            const int sl = v / (gp.nch - 1), c1 = v % (gp.nch - 1) + 1;
            for (int c = (c1 == 1 ? 0 : c1); c <= c1; ++c) {
                __syncthreads();
                const int ci = sl * gp.nch + c; const int T = c == 0 ? 16 : 64;
                bf16_t* zc = c == 0 ? X.mz + (size_t)((gp.s0 + sl) * 16) * ZW : X.z + ((size_t)sl * gp.Lr + 64 * (c - 1)) * ZW;
                if (isS5) s5_chunk<false>(X, s5d, (LAS float*)(lds + wave * 16896), zc, T, ci, wave, lane);
                else hg_passA_mfma(X, lds + wave * 9216, zc, T, ci, wave, lane);
            }
        }
    }
}

__device__ __forceinline__ void mixer_phase_C(int l, int g, LAS unsigned char* lds, int G, int bid) {
    const int tid_ = opaque_tid(); const int lane = tid_ & 63, wave = __builtin_amdgcn_readfirstlane(tid_ >> 6);
    const Ctx X = make_ctx(((unsigned char*)KA(ws))); const Grp gp = make_grp(g);
    const float* s5d = KAF(s5_d) + l * 256; const float* ong = KAF(onorm_g) + l * 64;
    const int nct = gp.nseq * (gp.nch - 1);
    for (int t = bid; t < 2 * nct; t += G) {
        const bool isS5 = t < nct; const int v = isS5 ? t : t - nct;
        const int sl = v / (gp.nch - 1), c1 = v % (gp.nch - 1) + 1;
        for (int c = ((c1 == 1 && l != NLAYER - 1) ? 0 : c1); c <= c1; ++c) {
            __syncthreads();
            const int ci = sl * gp.nch + c; const int T = c == 0 ? 16 : 64;
            bf16_t* zc = c == 0 ? X.mz + (size_t)((gp.s0 + sl) * 16) * ZW : X.z + ((size_t)sl * gp.Lr + 64 * (c - 1)) * ZW;
            if (isS5) {
                s5_chunk<true>(X, s5d, (LAS float*)(lds + wave * 16896), zc, T, ci, wave, lane);
                const int fr = lane & 15, fq = lane >> 4;
                const bf16_t* wg = (const bf16_t*)((const unsigned char*)X.w + W_GLU);
                const int n0 = wave * 32;
                bf16x8 bw[8][2];
#pragma unroll
                for (int ks = 0; ks < 8; ++ks)
#pragma unroll
                    for (int n2 = 0; n2 < 2; ++n2) bw[ks][n2] = *(const bf16x8*)(wg + (size_t)(n0 + n2 * 16 + fr) * 256 + ks * 32 + fq * 8);
                asm volatile("s_waitcnt vmcnt(0)" ::: "memory");
                __syncthreads();
                f32x4 ga[4][2];
#pragma unroll
                for (int a = 0; a < 4; ++a)
#pragma unroll
                    for (int b = 0; b < 2; ++b) ga[a][b] = (f32x4){0.f, 0.f, 0.f, 0.f};
#pragma unroll
                for (int kh = 0; kh < 2; ++kh) {
                    bf16x8 af[4][4];
#pragma unroll
                    for (int k4 = 0; k4 < 4; ++k4)
#pragma unroll
                        for (int mt = 0; mt < 4; ++mt) { af[k4][mt] = (bf16x8){0, 0, 0, 0, 0, 0, 0, 0}; if (mt * 16 < T) af[k4][mt] = *(const bf16x8*)(zc + (size_t)(mt * 16 + fr) * ZW + 512 + (kh * 4 + k4) * 32 + fq * 8); }
                    __builtin_amdgcn_sched_barrier(0);
#pragma unroll
                    for (int k4 = 0; k4 < 4; ++k4)
#pragma unroll
                        for (int mt = 0; mt < 4; ++mt) {
                            if (mt * 16 < T) {
#pragma unroll
                                for (int n2 = 0; n2 < 2; ++n2) ga[mt][n2] = __builtin_amdgcn_mfma_f32_16x16x32_bf16(af[k4][mt], bw[kh * 4 + k4][n2], ga[mt][n2], 0, 0, 0);
                            }
                        }
                    __builtin_amdgcn_sched_barrier(0);
                }
#pragma unroll
                for (int mt = 0; mt < 4; ++mt) {
                    if (mt * 16 < T) {
                        float yy[2][4];
#pragma unroll
                        for (int n2 = 0; n2 < 2; ++n2)
#pragma unroll
                            for (int r = 0; r < 4; ++r) yy[n2][r] = bf2f(zc[(size_t)(mt * 16 + 4 * fq + r) * ZW + 512 + n0 + n2 * 16 + fr]);
#pragma unroll
                        for (int n2 = 0; n2 < 2; ++n2)
#pragma unroll
                            for (int r = 0; r < 4; ++r) zc[(size_t)(mt * 16 + 4 * fq + r) * ZW + n0 + n2 * 16 + fr] = (bf16_t)f2bf(yy[n2][r] * sigm(ga[mt][n2][r]));
                    }
                }
            }
            else {
                hg_passC_mfma(X, lds + wave * 7168, (LAS bf16_t*)(lds + 65536 + wave * 8192), zc, T, ci, wave, lane);
                __syncthreads();
                const int h = wave >> 1, half = wave & 1;
                const LAS bf16_t* of = (const LAS bf16_t*)(lds + 65536 + (2 * h) * 8192); const LAS bf16_t* ob = (const LAS bf16_t*)(lds + 65536 + (2 * h + 1) * 8192);
                const float gn = ong[lane];
                const int tt0 = half * (T / 2);
                float gov[32];
#pragma unroll
                for (int i = 0; i < 32; ++i) { gov[i] = 0.f; if (i < T / 2) gov[i] = bf2f(zc[(size_t)(tt0 + i) * ZW + 2816 + h * 64 + lane]); }
#pragma unroll
                for (int i = 0; i < 32; ++i) {
                    if (i < T / 2) {
                        const int tt = tt0 + i;
                        const float o = bf2f(of[tt * 64 + lane]) + bf2f(ob[tt * 64 + lane]);
                        const float ms = wave_sum(o * o) * (1.0f / 64.0f);
                        const float go = gov[i];
                        zc[(size_t)tt * ZW + 256 + h * 64 + lane] = (bf16_t)f2bf(o * rsqrtf(ms + 1e-6f) * gn * (go * sigm(go)));
                    }
                }
            }
        }
    }
}

__global__ void __launch_bounds__(512, 2) fwd_kernel(Args a) {
    extern __shared__ __attribute__((aligned(16))) unsigned char lds_raw[];
    LAS unsigned char* lds = (LAS unsigned char*)lds_raw;
    const int G = gridDim.x, bid = blockIdx.x;

    if (threadIdx.x < 2) ((volatile LAS unsigned*)(lds + LDS_ST_OFF))[threadIdx.x] = 0u;
    if (threadIdx.x == 0) { const unsigned xc = xb_xcc_id(); const unsigned rk = xb_add((unsigned*)(KA(ws) + WS_CTL) + XB_XCNT(xc), 1u);
        ((volatile LAS unsigned*)(lds + LDS_ST_OFF))[2] = xc; ((volatile LAS unsigned*)(lds + LDS_ST_OFF))[3] = rk; }
    __syncthreads();
    prologue(G);

    for (int l = 0; l < NLAYER; ++l) {
        __syncthreads();
        { const Ctx X = make_ctx(((unsigned char*)KA(ws))); prep_layer(X, l, lds, G); }
        if (l == 0) { asm volatile("s_waitcnt vmcnt(0)" ::: "memory"); __syncthreads(); cg::this_grid().sync(); }
        GRID_SYNC();
        if (l == 0) {
            if (threadIdx.x == 0) { unsigned* bar = (unsigned*)(KA(ws) + WS_CTL); bool ok = (G == 256);
                for (int j = 0; j < 16; ++j) { const unsigned c = xb_ld(&bar[XB_XCNT(j)]); ok = ok && (c == (j < 8 ? 32u : 0u)); }
                ((volatile LAS unsigned*)(lds + LDS_ST_OFF))[4] = ok ? 1u : 0u; }
            __syncthreads();
        }
        for (int g = 0; g < 4; ++g) {
            for (int ph = 0; ph < 9; ++ph) {
                if (ph == 4) continue;
                if (ph == 1) mixer_phase_A(l, g, lds, G, bid);
                else if (ph == 2) { const Ctx X = make_ctx(((unsigned char*)KA(ws))); const Grp gp = make_grp(g); const int gtid = bid * 512 + opaque_tid(), GT = G * 512; s5_passB(X, gp, gtid, GT); hg_passB(X, gp, GT - 1 - gtid, GT); }
                else if (ph == 3) mixer_phase_C(l, g, lds, G, bid);
                else {
                    for (int j = 0; j < 6; ++j) {
                        pg8::Gemm gm; pg8::UberEpi ep;
                        if (!make_job(((unsigned char*)KA(ws)), ((float*)KA(out)), l, g, ph, j, gm, ep)) break;
                        int cidx = bid;
                        if (ph == 7 && j == 1) { const int busy = ((RG / 256) * (2 * FFH / 256)) % G; cidx = (bid + G - busy) % G; }
                        pg8::StaticOrder SO; SO.init(gm.M, gm.N, G, cidx);
                        pg8::gemm_phase(lds, gm, SO, ep);
                    }
                }
                GRID_SYNC();
            }
        }
    }
    {
        const float* ssq = (const float*)(((unsigned char*)KA(ws)) + WS_SSQ);
        const int tid_ = opaque_tid(); const int lane = tid_ & 63, wave = __builtin_amdgcn_readfirstlane(tid_ >> 6);
        for (int row = bid * 8 + wave; row < RMAIN; row += G * 8) {
            const float rs = pg8::row_rstd(ssq, row);
            float* hp = ((float*)KA(out)) + (size_t)row * DM;
#pragma unroll
            for (int j = 0; j < 4; ++j) {
                f32x4 v = *(const f32x4*)(hp + j * 256 + lane * 4); const f32x4 gv = *(const f32x4*)(KAF(final_g) + j * 256 + lane * 4);
                v = v * rs * gv; *(f32x4*)(hp + j * 256 + lane * 4) = v;
            }
        }
    }
}

extern "C" void kernel_launch(void* const* d_in, const int* in_sizes, int n_in, void* d_out, int out_size, void* d_ws, size_t ws_size, hipStream_t stream) {
    static int grid = 0;
    if (grid == 0) {
        int dev = 0, cus = 0, per_cu = 0;
        (void)hipGetDevice(&dev);
        (void)hipDeviceGetAttribute(&cus, hipDeviceAttributeMultiprocessorCount, dev);
        (void)hipFuncSetAttribute((const void*)fwd_kernel, hipFuncAttributeMaxDynamicSharedMemorySize, LDS_BYTES);
        (void)hipOccupancyMaxActiveBlocksPerMultiprocessor(&per_cu, (const void*)fwd_kernel, 512, LDS_BYTES);
        (void)hipGetLastError();
        if (ws_size < WS_TOTAL) fprintf(stderr, "kernel_launch: workspace too small: %zu < %zu\n", ws_size, (size_t)WS_TOTAL);
        grid = cus > 0 ? cus : 256;
    }
    (void)hipMemsetAsync((char*)d_ws + WS_CTL, 0, CTL_BYTES, stream);
    Args a{};
    const float** pp = (const float**)&a;
    for (int i = 0; i < 26; ++i) pp[i] = (const float*)d_in[i];
    a.out = (float*)d_out; a.ws = (unsigned char*)d_ws;
    void* args[] = {&a};
    hipError_t e = hipLaunchCooperativeKernel((const void*)fwd_kernel, dim3(grid), dim3(512), args, LDS_BYTES, stream);
    if (e != hipSuccess) fprintf(stderr, "cooperative launch failed: %s\n", hipGetErrorString(e));
}
```

```cpp
#include <hip/hip_runtime.h>
#include <hip/hip_cooperative_groups.h>
#include <cstdio>
#include <cstdint>
namespace cg = cooperative_groups;

#define LAS __attribute__((address_space(3)))
typedef unsigned short bf16_t;
typedef short bf16x8 __attribute__((ext_vector_type(8)));
typedef float f32x4 __attribute__((ext_vector_type(4)));
typedef unsigned u32x4 __attribute__((ext_vector_type(4)));
typedef unsigned u32x2 __attribute__((ext_vector_type(2)));

#define WAVE_SYNC() asm volatile("s_waitcnt lgkmcnt(0)" ::: "memory")
__device__ __forceinline__ int opaque_tid() { int t = threadIdx.x; asm volatile("" : "+v"(t)); return t; }

__device__ __forceinline__ unsigned f2bf(float f) { unsigned u = __builtin_bit_cast(unsigned, f); return (u + 0x7fffu + ((u >> 16) & 1u)) >> 16; }
__device__ __forceinline__ unsigned pk2(float lo, float hi) { return f2bf(lo) | (f2bf(hi) << 16); }
__device__ __forceinline__ float bf2f(bf16_t b) { return __builtin_bit_cast(float, (unsigned)b << 16); }
__device__ __forceinline__ float bflo(unsigned w) { return __builtin_bit_cast(float, w << 16); }
__device__ __forceinline__ float bfhi(unsigned w) { return __builtin_bit_cast(float, w & 0xffff0000u); }
__device__ __forceinline__ float sigm(float x) { return 1.f / (1.f + __expf(-x)); }
__device__ __forceinline__ float gelu_tanh(float y) { const float a = 0.7978845608028654f * (y + 0.044715f * y * y * y); const float th = 1.f - 2.f / (__expf(2.f * a) + 1.f); return 0.5f * y * (1.f + th); }
__device__ __forceinline__ u32x4 pack8(f32x4 a, f32x4 b) { u32x4 w; w.x = pk2(a[0], a[1]); w.y = pk2(a[2], a[3]); w.z = pk2(b[0], b[1]); w.w = pk2(b[2], b[3]); return w; }
__device__ __forceinline__ float wave_sum(float v) {
#pragma unroll
    for (int o = 1; o < 64; o <<= 1) v += __shfl_xor(v, o);
    return v;
}

namespace pg8 {
constexpr int ZSTR = 6208;
constexpr int BM = 256, BK = 64, HALF = 128, HTB = HALF * BK * 2, STAGE_BYTES = 8 * HTB, NXCD = 8, WGM = 8;
__host__ __device__ __forceinline__ int lds_byte(int r, int c) { const int st = (r >> 4) * 2 + (c >> 5), rr = r & 15, cc = c & 31, ob = rr * 64 + cc * 2; return st * 1024 + (ob ^ (((ob >> 9) & 1) << 5)); }
__host__ __device__ __forceinline__ void stage_rc(int b, int& R, int& C) { const int st = b / 1024, sb = b % 1024, swz = sb ^ (((sb >> 9) & 1) << 5); R = (st >> 1) * 16 + swz / 64; C = (st & 1) * 32 + (swz % 64) / 2; }
__host__ __device__ __forceinline__ int perm32(int rho) { const int n = rho >> 4, i = rho & 15; return 8 * (i >> 2) + 4 * n + (i & 3); }
struct Unit { int pm, pn; };
struct Gemm { const bf16_t* A; int lda; const bf16_t* Bt; int M, N, K; };
struct StaticOrder {
    int nM, nN, nwg, G, c;
    __device__ void init(int M, int N, int G_, int c_) { nM = M / BM; nN = N / BM; nwg = nM * nN; G = G_; c = c_; }
    __device__ bool next(int i, Unit& u) const {
        const long L = (long)i * G + c; if (L >= nwg) return false;
        int wgid = (int)L; { const int q = nwg / NXCD, r = nwg % NXCD, xcd = wgid % NXCD, off = wgid / NXCD; wgid = (xcd < r ? xcd * (q + 1) : r * (q + 1) + (xcd - r) * q) + off; }
        const int nig = WGM * nN, gid = wgid / nig, fm = gid * WGM, gsz = (nM - fm) < WGM ? (nM - fm) : WGM;
        u.pm = fm + ((wgid % nig) % gsz); u.pn = (wgid % nig) / gsz; return true;
    }
};

struct UberEpi;
__device__ __forceinline__ void run_epi(const UberEpi& E, LAS unsigned char* lds, const f32x4 (&acc)[2][2][4][2], const Unit& u, int wr, int wc, int fr, int fq);
__device__ __forceinline__ void gemm_phase(LAS unsigned char* lds, const Gemm g, const StaticOrder& S, const UberEpi& E) {
    const int tid = opaque_tid(), wid = __builtin_amdgcn_readfirstlane(tid >> 6), lane = tid & 63, wr = wid >> 2, wc = wid & 3, fr = lane & 15, fq = lane >> 4;
    const int K = g.K, nt = K / BK, lda = g.lda;
    unsigned voffA[2], voffB[2];
#pragma unroll
    for (int i = 0; i < 2; ++i) { int R, C; stage_rc(tid * 16 + i * 8192, R, C); const int Rb = (R & ~31) + perm32(R & 31);
        voffA[i] = (unsigned)(R * lda + C) * 2u; voffB[i] = (unsigned)(Rb * K + C) * 2u; }
    const size_t kstep = (size_t)(BK * 2);
    const size_t hstepA = (size_t)HALF * lda * 2, hstepB = (size_t)HALF * K * 2;
    const size_t tstepA = 2 * hstepA, tstepB = 2 * hstepB;
    const unsigned ldsw = (unsigned)wid * 1024u;
    const int aoff = lds_byte(wr * 64 + fr, fq * 8), boff = lds_byte(wc * 32 + fr, fq * 8);
#define PG8_SA(b, h) (((b) * 2 + (h)) * HTB)
#define PG8_SB(b, h) ((4 + (b) * 2 + (h)) * HTB)
#define PG8_STAGE(bufoff, gbase, voff) do { _Pragma("unroll") for (int _i = 0; _i < 2; ++_i) \
        __builtin_amdgcn_global_load_lds((const unsigned*)((const char*)(gbase) + (voff)[_i]), (LAS unsigned*)(lds + (bufoff) + ldsw + _i * 8192), 16, 0, 0); } while (0)
#define PG8_LDA(dst, b, h) do { _Pragma("unroll") for (int m = 0; m < 4; ++m) _Pragma("unroll") for (int k = 0; k < 2; ++k) dst[m][k] = *(const LAS bf16x8*)(lds + PG8_SA(b, h) + aoff + m * 2048 + k * 1024); } while (0)
#define PG8_LDB(dst, b, h) do { _Pragma("unroll") for (int n = 0; n < 2; ++n) _Pragma("unroll") for (int k = 0; k < 2; ++k) dst[n][k] = *(const LAS bf16x8*)(lds + PG8_SB(b, h) + boff + n * 2048 + k * 1024); } while (0)
#define PG8_MMA(ai, bj, At, Bt) do { __builtin_amdgcn_s_setprio(1); _Pragma("unroll") for (int m = 0; m < 4; ++m) _Pragma("unroll") for (int n = 0; n < 2; ++n) _Pragma("unroll") for (int k = 0; k < 2; ++k) \
        acc[ai][bj][m][n] = __builtin_amdgcn_mfma_f32_16x16x32_bf16(Bt[n][k], At[m][k], acc[ai][bj][m][n], 0, 0, 0); __builtin_amdgcn_s_setprio(0); } while (0)
#define PG8_WAIT_V(n) asm volatile("s_waitcnt vmcnt(" #n ")" ::: "memory")
#define PG8_WAIT_L(n) asm volatile("s_waitcnt lgkmcnt(" #n ")" ::: "memory")
#define PG8_BAR __builtin_amdgcn_s_barrier()
#define PG8_SCHED __builtin_amdgcn_sched_barrier(0)
    Unit cur, nxt; int ui = 0;
    if (!S.next(0, cur)) return;
    f32x4 acc[2][2][4][2];
#pragma unroll
    for (int a = 0; a < 2; ++a)
#pragma unroll
        for (int b = 0; b < 2; ++b)
#pragma unroll
            for (int m = 0; m < 4; ++m)
#pragma unroll
                for (int n = 0; n < 2; ++n) acc[a][b][m][n] = (f32x4){0.f, 0.f, 0.f, 0.f};
    bf16x8 At[4][2], B0[2][2], B1[2][2];
    const char* cA = (const char*)g.A + (size_t)cur.pm * tstepA; const char* cB = (const char*)g.Bt + (size_t)cur.pn * tstepB;
    PG8_STAGE(PG8_SB(0, 0), cB, voffB); PG8_STAGE(PG8_SB(0, 1), cB + hstepB, voffB); PG8_STAGE(PG8_SA(0, 0), cA, voffA); PG8_STAGE(PG8_SA(0, 1), cA + hstepA, voffA);
    if (wr == 1) PG8_BAR;
    PG8_WAIT_V(2); PG8_BAR;
    PG8_STAGE(PG8_SB(1, 0), cB + kstep, voffB); PG8_STAGE(PG8_SA(1, 0), cA + kstep, voffA); PG8_STAGE(PG8_SB(1, 1), cB + hstepB + kstep, voffB);
    PG8_WAIT_V(6); PG8_BAR;
    for (;;) {
        const bool has_next = S.next(ui + 1, nxt);
        const char* nA = has_next ? (const char*)g.A + (size_t)nxt.pm * tstepA : cA; const char* nB = has_next ? (const char*)g.Bt + (size_t)nxt.pn * tstepB : cB;
        for (int t = 0; t < nt; t += 2) {
            const bool last = (t == nt - 2);
            const char* a1 = cA + (size_t)(t + 1) * kstep;
            const char* a2 = last ? nA : cA + (size_t)(t + 2) * kstep; const char* b2 = last ? nB : cB + (size_t)(t + 2) * kstep;
            const char* a3 = a2 + kstep; const char* b3 = b2 + kstep;
            PG8_LDB(B0, 0, 0); PG8_LDB(B1, 0, 1); PG8_SCHED; PG8_LDA(At, 0, 0); PG8_STAGE(PG8_SA(1, 1), a1 + hstepA, voffA);
            PG8_WAIT_V(8); PG8_WAIT_L(0); PG8_BAR; PG8_MMA(0, 0, At, B0); PG8_MMA(0, 1, At, B1); PG8_BAR; PG8_SCHED;
            PG8_LDA(At, 0, 1); PG8_STAGE(PG8_SB(0, 0), b2, voffB); PG8_STAGE(PG8_SB(0, 1), b2 + hstepB, voffB); PG8_STAGE(PG8_SA(0, 0), a2, voffA);
            PG8_WAIT_V(8); PG8_WAIT_L(0); PG8_BAR; PG8_MMA(1, 0, At, B0); PG8_MMA(1, 1, At, B1); PG8_BAR; PG8_SCHED;
            PG8_LDB(B0, 1, 0); PG8_LDB(B1, 1, 1); PG8_SCHED; PG8_LDA(At, 1, 0); PG8_STAGE(PG8_SA(0, 1), a2 + hstepA, voffA);
            PG8_WAIT_V(8); PG8_WAIT_L(0); PG8_BAR; PG8_MMA(0, 0, At, B0); PG8_MMA(0, 1, At, B1); PG8_BAR; PG8_SCHED;
            PG8_LDA(At, 1, 1); PG8_STAGE(PG8_SB(1, 0), b3, voffB); PG8_STAGE(PG8_SB(1, 1), b3 + hstepB, voffB); PG8_STAGE(PG8_SA(1, 0), a3, voffA);
            PG8_WAIT_V(8); PG8_WAIT_L(0); PG8_BAR; PG8_MMA(1, 0, At, B0); PG8_MMA(1, 1, At, B1); PG8_BAR; PG8_SCHED;
        }
        if (wr == 0) PG8_BAR;
        run_epi(E, lds, acc, cur, wr, wc, fr, fq);
        if (!has_next) break;
#pragma unroll
        for (int a = 0; a < 2; ++a)
#pragma unroll
            for (int b = 0; b < 2; ++b)
#pragma unroll
                for (int m = 0; m < 4; ++m)
#pragma unroll
                    for (int n = 0; n < 2; ++n) acc[a][b][m][n] = (f32x4){0.f, 0.f, 0.f, 0.f};
        cur = nxt; cA = nA; cB = nB; ++ui;
        if (wr == 1) PG8_BAR;
    }
    PG8_WAIT_V(0);
    PG8_BAR;
#undef PG8_SA
#undef PG8_SB
#undef PG8_STAGE
#undef PG8_LDA
#undef PG8_LDB
#undef PG8_MMA
#undef PG8_WAIT_V
#undef PG8_WAIT_L
#undef PG8_BAR
#undef PG8_SCHED
}

__device__ __forceinline__ float row_rstd(const float* ssq, int row) {
    const f32x4 s0 = *(const f32x4*)(ssq + (size_t)row * 4);
    const float ss = (s0[0] + s0[1]) + (s0[2] + s0[3]);
    return rsqrtf(ss * (1.0f / 1024.0f) + 1e-6f);
}
struct EpiZ {
    bf16_t* z; const float* ssq; bf16_t* vt; int vt_ld;
    __device__ __forceinline__ void operator()(const f32x4 (&acc)[2][2][4][2], const Unit& u, int wr, int wc, int fr, int fq) const {
        const int row0 = u.pm * BM + wr * 64 + fr, col0 = u.pn * BM + wc * 32 + 8 * fq;
#pragma unroll
        for (int ai = 0; ai < 2; ++ai)
#pragma unroll
            for (int m = 0; m < 4; ++m) {
                const int row = row0 + ai * HALF + m * 16; const float rs = row_rstd(ssq, row);
#pragma unroll
                for (int bj = 0; bj < 2; ++bj) {
                    const u32x4 w = pack8(acc[ai][bj][m][0] * rs, acc[ai][bj][m][1] * rs);
                    *(u32x4*)(z + (size_t)row * ZSTR + col0 + bj * HALF) = w;
                }
            }
    }
};
struct EpiGlu {
    bf16_t* z;
    __device__ __forceinline__ void operator()(const f32x4 (&acc)[2][2][4][2], const Unit& u, int wr, int wc, int fr, int fq) const {
        const int row0 = u.pm * BM + wr * 64 + fr, col0 = wc * 32 + 8 * fq;
#pragma unroll
        for (int ai = 0; ai < 2; ++ai) {
            u32x4 yv[4][2];
#pragma unroll
            for (int m = 0; m < 4; ++m)
#pragma unroll
                for (int bj = 0; bj < 2; ++bj) yv[m][bj] = *(const u32x4*)(z + (size_t)(row0 + ai * HALF + m * 16) * ZSTR + col0 + bj * HALF + 512);
#pragma unroll
            for (int m = 0; m < 4; ++m) {
                const int row = row0 + ai * HALF + m * 16;
#pragma unroll
                for (int bj = 0; bj < 2; ++bj) {
                    bf16_t* zp = z + (size_t)row * ZSTR + col0 + bj * HALF;
                    const u32x4 y = yv[m][bj];
                    const f32x4 a0 = acc[ai][bj][m][0], a1 = acc[ai][bj][m][1];
                    f32x4 o0, o1;
                    o0[0] = bflo(y.x) * sigm(a0[0]); o0[1] = bfhi(y.x) * sigm(a0[1]); o0[2] = bflo(y.y) * sigm(a0[2]); o0[3] = bfhi(y.y) * sigm(a0[3]);
                    o1[0] = bflo(y.z) * sigm(a1[0]); o1[1] = bfhi(y.z) * sigm(a1[1]); o1[2] = bflo(y.w) * sigm(a1[2]); o1[3] = bfhi(y.w) * sigm(a1[3]);
                    *(u32x4*)zp = pack8(o0, o1);
                }
            }
        }
    }
};
template <int MODE> struct EpiMix {
    bf16_t* z; int goff;
    __device__ __forceinline__ void operator()(const f32x4 (&acc)[2][2][4][2], const Unit& u, int wr, int wc, int fr, int fq) const {
        const int row0 = u.pm * BM + wr * 64 + fr, col0 = u.pn * BM + wc * 32 + 8 * fq;
#pragma unroll
        for (int ai = 0; ai < 2; ++ai)
#pragma unroll
            for (int mp = 0; mp < 2; ++mp) {
                u32x4 gv[2][2], pv[2][2];
#pragma unroll
                for (int mm = 0; mm < 2; ++mm)
#pragma unroll
                    for (int bj = 0; bj < 2; ++bj) { const bf16_t* zr = z + (size_t)(row0 + ai * HALF + (mp * 2 + mm) * 16) * ZSTR + col0 + bj * HALF;
                        gv[mm][bj] = *(const u32x4*)(zr + goff); if (MODE == 1) pv[mm][bj] = *(const u32x4*)(zr + 1024); }
#pragma unroll
                for (int mm = 0; mm < 2; ++mm) {
                    const int m = mp * 2 + mm; const int row = row0 + ai * HALF + m * 16;
#pragma unroll
                    for (int bj = 0; bj < 2; ++bj) {
                        bf16_t* zr = z + (size_t)row * ZSTR + col0 + bj * HALF;
                        const u32x4 gq = gv[mm][bj];
                        const f32x4 a0 = acc[ai][bj][m][0], a1 = acc[ai][bj][m][1];
                        f32x4 o0, o1;
                        o0[0] = sigm(bflo(gq.x)) * a0[0]; o0[1] = sigm(bfhi(gq.x)) * a0[1]; o0[2] = sigm(bflo(gq.y)) * a0[2]; o0[3] = sigm(bfhi(gq.y)) * a0[3];
                        o1[0] = sigm(bflo(gq.z)) * a1[0]; o1[1] = sigm(bfhi(gq.z)) * a1[1]; o1[2] = sigm(bflo(gq.w)) * a1[2]; o1[3] = sigm(bfhi(gq.w)) * a1[3];
                        if (MODE == 1) { const u32x4 p = pv[mm][bj];
                            o0[0] += bflo(p.x); o0[1] += bfhi(p.x); o0[2] += bflo(p.y); o0[3] += bfhi(p.y); o1[0] += bflo(p.z); o1[1] += bfhi(p.z); o1[2] += bflo(p.w); o1[3] += bfhi(p.w); }
                        *(u32x4*)(zr + 1024) = pack8(o0, o1);
                    }
                }
            }
    }
};
struct EpiRes {
    float* h; bf16_t* hb; float* ssq; LAS float* red;
    __device__ __forceinline__ void operator()(const f32x4 (&acc)[2][2][4][2], const Unit& u, int wr, int wc, int fr, int fq) const {
        const int row0 = u.pm * BM + wr * 64 + fr, col0 = u.pn * BM + wc * 32 + 8 * fq;
#pragma unroll
        for (int ai = 0; ai < 2; ++ai)
#pragma unroll
            for (int mp = 0; mp < 2; ++mp) {
                f32x4 hv[2][2][2];
#pragma unroll
                for (int mm = 0; mm < 2; ++mm)
#pragma unroll
                    for (int bj = 0; bj < 2; ++bj) { const float* hp = h + (size_t)(row0 + ai * HALF + (mp * 2 + mm) * 16) * 1024 + col0 + bj * HALF; hv[mm][bj][0] = *(const f32x4*)hp; hv[mm][bj][1] = *(const f32x4*)(hp + 4); }
#pragma unroll
                for (int mm = 0; mm < 2; ++mm) {
                    const int m = mp * 2 + mm; const int row = row0 + ai * HALF + m * 16; float part = 0.f;
#pragma unroll
                    for (int bj = 0; bj < 2; ++bj) {
                        float* hp = h + (size_t)row * 1024 + col0 + bj * HALF;
                        const f32x4 h0 = hv[mm][bj][0] + acc[ai][bj][m][0], h1 = hv[mm][bj][1] + acc[ai][bj][m][1];
                        *(f32x4*)hp = h0; *(f32x4*)(hp + 4) = h1;
                        part += (h0[0] * h0[0] + h0[1] * h0[1]) + (h0[2] * h0[2] + h0[3] * h0[3]) + (h1[0] * h1[0] + h1[1] * h1[1]) + (h1[2] * h1[2] + h1[3] * h1[3]);
                        if (hb) *(u32x4*)(hb + (size_t)row * 1024 + col0 + bj * HALF) = pack8(h0, h1);
                    }
                    part += __shfl_xor(part, 16); part += __shfl_xor(part, 32);
                    if (fq == 0) red[(ai * HALF + wr * 64 + m * 16 + fr) * 4 + wc] = part;
                }
            }
        asm volatile("s_waitcnt lgkmcnt(0)" ::: "memory");
        __builtin_amdgcn_s_barrier();
        asm volatile("" ::: "memory");
        { const int t_ = opaque_tid(); if (t_ < 256) { const f32x4 r4 = *(const LAS f32x4*)(red + t_ * 4); ssq[(size_t)(u.pm * BM + t_) * 4 + u.pn] = (r4[0] + r4[1]) + (r4[2] + r4[3]); } }
    }
};
struct EpiAct {
    bf16_t* act; const float* ssq;
    __device__ __forceinline__ void operator()(const f32x4 (&acc)[2][2][4][2], const Unit& u, int wr, int wc, int fr, int fq) const {
        const int row0 = u.pm * BM + wr * 64 + fr, col0 = u.pn * HALF + wc * 32 + 8 * fq;
#pragma unroll
        for (int ai = 0; ai < 2; ++ai)
#pragma unroll
            for (int m = 0; m < 4; ++m) {
                const int row = row0 + ai * HALF + m * 16; const float rs = row_rstd(ssq, row);
                f32x4 o[2];
#pragma unroll
                for (int n = 0; n < 2; ++n)
#pragma unroll
                    for (int i = 0; i < 4; ++i) { const float gg = acc[ai][0][m][n][i] * rs, uu = acc[ai][1][m][n][i] * rs; o[n][i] = gg * sigm(gg) * uu; }
                *(u32x4*)(act + (size_t)row * 2816 + col0) = pack8(o[0], o[1]);
            }
    }
};
struct UberEpi { int mode, i0; unsigned char *p0, *p1, *p2; };
__device__ __forceinline__ void run_epi(const UberEpi& E, LAS unsigned char* lds, const f32x4 (&acc)[2][2][4][2], const Unit& u, int wr, int wc, int fr, int fq) {
    switch (E.mode) {
        case 0: { EpiZ e{(bf16_t*)E.p0, (const float*)E.p1, (bf16_t*)E.p2, E.i0}; e(acc, u, wr, wc, fr, fq); break; }
        case 1: { EpiGlu e{(bf16_t*)E.p0}; e(acc, u, wr, wc, fr, fq); break; }
        case 2: { EpiMix<0> e{(bf16_t*)E.p0, E.i0}; e(acc, u, wr, wc, fr, fq); break; }
        case 3: { EpiMix<1> e{(bf16_t*)E.p0, E.i0}; e(acc, u, wr, wc, fr, fq); break; }
        case 4: { EpiRes e{(float*)E.p0, (bf16_t*)E.p1, (float*)E.p2, (LAS float*)(lds + 131072)}; e(acc, u, wr, wc, fr, fq); break; }
        default: { EpiAct e{(bf16_t*)E.p0, (const float*)E.p1}; e(acc, u, wr, wc, fr, fq); break; }
    }
}
}

constexpr int NLAYER = 4, DM = 1024, ZN = 6144, ZW = 6208  , FFH = 2816, RG = 16384, RMAIN = 65536, VTLD = RG + 64  ;
constexpr size_t al256(size_t x) { return (x + 255) & ~(size_t)255; }
constexpr size_t WS_HB = 0;
constexpr size_t WS_SSQ = WS_HB + (size_t)RMAIN * DM * 2;
constexpr size_t WS_Z = WS_SSQ + (size_t)RMAIN * 4 * 4;
constexpr size_t WS_YB = WS_Z + (size_t)RG * ZW * 2;
constexpr size_t WS_VT = WS_YB + (size_t)RG * 512 * 2;
constexpr size_t WS_HGU = WS_VT + (size_t)512 * VTLD * 2;
constexpr size_t WS_HGP = WS_HGU + (size_t)260 * 8 * 4096 * 4;
constexpr size_t WS_S5S = WS_HGP + (size_t)260 * 8 * 64 * 4;
constexpr size_t WS_W = WS_S5S + (size_t)260 * 2048 * 8;
constexpr size_t W_IN = 0, W_UPA = W_IN + (size_t)6144 * 1024 * 2, W_UPB = W_UPA + (size_t)1024 * 256 * 2, W_UPC = W_UPB + (size_t)1024 * 512 * 2,
                 W_O = W_UPC + (size_t)1024 * 256 * 2, W_GU = W_O + (size_t)1024 * 1024 * 2, W_DN = W_GU + (size_t)5632 * 1024 * 2, W_GLU = W_DN + (size_t)1024 * 2816 * 2,
                 W_END = W_GLU + (size_t)256 * 256 * 2;
constexpr size_t WS_TAB = WS_W + W_END;
constexpr size_t T_LBAR = 0, T_L16 = T_LBAR + 2048 * 8, T_L64 = T_L16 + 2048 * 8, T_BFRAG = T_L64 + 2048 * 8, T_CFRAG = T_BFRAG + (size_t)32 * 8 * 64 * 16,
                 T_LB = T_CFRAG + (size_t)32 * 4 * 64 * 16, T_END = T_LB + 256 * 4;
constexpr size_t WS_META = al256(WS_TAB + T_END);
constexpr size_t M_H = 0, M_HB = M_H + (size_t)256 * 1024 * 4, M_SSQ = M_HB + (size_t)256 * 1024 * 2, M_Z = M_SSQ + (size_t)256 * 4 * 4, M_YB = M_Z + (size_t)256 * ZW * 2,
                 M_VT = M_YB + (size_t)256 * 512 * 2, M_ACT = M_VT + (size_t)512 * 256 * 2, M_END = M_ACT + (size_t)256 * FFH * 2;
constexpr size_t WS_CTL = al256(WS_META + M_END);
constexpr size_t CTL_BYTES = 16384;
constexpr size_t WS_TOTAL = WS_CTL + CTL_BYTES;
constexpr int LDS_ST_OFF = 135168;
constexpr int LDS_BYTES = 147456;

struct Args {
    const float *x_prompt, *x_sample, *meta_tokens, *norm1_g, *w_in, *a_re, *a_im, *log_dt, *b_re, *b_im, *c_re, *c_im, *s5_d, *w_glu, *rpb, *lb_logits, *onorm_g,
        *w_up_a, *w_up_b, *w_up_c, *w_o, *norm2_g, *w_gate, *w_up, *w_down, *final_g;
    float* out; unsigned char* ws;
};

__device__ __forceinline__ unsigned long long ufl(unsigned long long v) { const unsigned lo = __builtin_amdgcn_readfirstlane((unsigned)v), hi = __builtin_amdgcn_readfirstlane((unsigned)(v >> 32)); return ((unsigned long long)hi << 32) | lo; }
#define GAS __attribute__((address_space(1)))
template <int OFF> __device__ __forceinline__ unsigned long long ka_load() {
    unsigned long long v; const unsigned long long kp = ufl((unsigned long long)__builtin_amdgcn_kernarg_segment_ptr());
    asm volatile("s_load_dwordx2 %0, %1, %2\n\ts_waitcnt lgkmcnt(0)" : "=s"(v) : "s"(kp), "n"(OFF));
    return v;
}
#define KA(f) ((decltype(Args::f))(GAS char*)ka_load<(int)__builtin_offsetof(Args, f)>())
#define KAF(f) ((const float*)KA(f))
struct Ctx {
    bf16_t *hb, *z, *yb, *vt; float *ssq, *hgu, *hgp, *s5s;
    bf16_t *w; const float *lbar, *l16, *l64; const bf16_t *bfrag, *cfrag; const float* lb;
    float* mh; bf16_t *mhb, *mz, *myb, *mvt, *mact; float* mssq;
};

__device__ __forceinline__ void tr_item(const float* W, int K, int N, bf16_t* WT, const float* kscale, int mode, LAS float* scr, int item, int lane, bool valid) {
    const int nblk = N / 32, kb = item / nblk, nb = item % nblk, k0 = 64 * kb, n0 = 32 * nb;
    if (valid) {
#pragma unroll 8
    for (int i = 0; i < 32; ++i) { const int kk = 2 * i + (lane >> 5); float v = W[(size_t)(k0 + kk) * N + n0 + (lane & 31)]; if (kscale) v *= kscale[k0 + kk]; scr[kk * 33 + (lane & 31)] = v; }
    }
    __syncthreads();
    const int c = lane & 7;
    int drow0 = n0; if (mode) drow0 = (n0 >> 7) * 256 + (n0 & 127) + (mode == 2 ? 128 : 0);
    if (valid) {
#pragma unroll
    for (int j = 0; j < 4; ++j) { const int n = (lane >> 3) + 8 * j; const LAS float* s = scr + (8 * c) * 33 + n;
        u32x4 o; o.x = pk2(s[0 * 33], s[1 * 33]); o.y = pk2(s[2 * 33], s[3 * 33]); o.z = pk2(s[4 * 33], s[5 * 33]); o.w = pk2(s[6 * 33], s[7 * 33]);
        *(u32x4*)(WT + (size_t)(drow0 + n) * K + k0 + 8 * c) = o; }
    }
    __syncthreads();
}

__device__ __forceinline__ void prep_layer(const Ctx& X, int l, LAS unsigned char* lds, int G) {
    const int tid_ = opaque_tid(); const int wave = __builtin_amdgcn_readfirstlane(tid_ >> 6), lane = tid_ & 63;
    LAS float* scr = (LAS float*)(lds + wave * 16384);
    const int gw = blockIdx.x * 8 + wave, NGW = G * 8;
    constexpr int I0 = 16 * 192, I1 = 4 * 32, I2 = 8 * 32, I3 = 4 * 32, I4 = 16 * 32, I5 = 16 * 88, I6 = 16 * 88, I7 = 44 * 32, I8 = 4 * 8;
    constexpr int NIT = I0 + I1 + I2 + I3 + I4 + I5 + I6 + I7 + I8;
    unsigned char* wb = (unsigned char*)X.w;
    for (int it0 = 0; it0 < NIT; it0 += NGW) {
        const int it = it0 + gw; const bool valid = it < NIT;
        int r = valid ? it : 0;
        if (r < I0) { tr_item(KAF(w_in) + (size_t)l * 1024 * 6144, 1024, 6144, (bf16_t*)(wb + W_IN), KAF(norm1_g) + l * 1024, 0, scr, r, lane, valid); continue; } r -= I0;
        if (r < I1) { tr_item(KAF(w_up_a) + (size_t)l * 256 * 1024, 256, 1024, (bf16_t*)(wb + W_UPA), nullptr, 0, scr, r, lane, valid); continue; } r -= I1;
        if (r < I2) { tr_item(KAF(w_up_b) + (size_t)l * 512 * 1024, 512, 1024, (bf16_t*)(wb + W_UPB), nullptr, 0, scr, r, lane, valid); continue; } r -= I2;
        if (r < I3) { tr_item(KAF(w_up_c) + (size_t)l * 256 * 1024, 256, 1024, (bf16_t*)(wb + W_UPC), nullptr, 0, scr, r, lane, valid); continue; } r -= I3;
        if (r < I4) { tr_item(KAF(w_o) + (size_t)l * 1024 * 1024, 1024, 1024, (bf16_t*)(wb + W_O), nullptr, 0, scr, r, lane, valid); continue; } r -= I4;
        if (r < I5) { tr_item(KAF(w_gate) + (size_t)l * 1024 * 2816, 1024, 2816, (bf16_t*)(wb + W_GU), KAF(norm2_g) + l * 1024, 1, scr, r, lane, valid); continue; } r -= I5;
        if (r < I6) { tr_item(KAF(w_up) + (size_t)l * 1024 * 2816, 1024, 2816, (bf16_t*)(wb + W_GU), KAF(norm2_g) + l * 1024, 2, scr, r, lane, valid); continue; } r -= I6;
        if (r < I7) { tr_item(KAF(w_down) + (size_t)l * 2816 * 1024, 2816, 1024, (bf16_t*)(wb + W_DN), nullptr, 0, scr, r, lane, valid); continue; } r -= I7;
        tr_item(KAF(w_glu) + (size_t)l * 256 * 256, 256, 256, (bf16_t*)(wb + W_GLU), nullptr, 0, scr, r, lane, valid);
    }
    const int gt = blockIdx.x * 512 + tid_;
    if (gt < 2048) {
        const int dg = gt >> 6, p = gt & 63;
        const size_t pb = ((size_t)l * 32 + dg);
        const float are = KAF(a_re)[pb * 64 + p], aim = KAF(a_im)[pb * 64 + p], dt = expf(KAF(log_dt)[pb]);
        const float mag = expf(are * dt); float sn, cs; sincosf(aim * dt, &sn, &cs);
        const float lr = mag * cs, li = mag * sn;
        const float den = are * are + aim * aim, nr = lr - 1.0f, ni = li;
        const float zr = (nr * are + ni * aim) / den, zi = (ni * are - nr * aim) / den;
        float* lbar = (float*)X.lbar; float* l16 = (float*)X.l16; float* l64 = (float*)X.l64;
        lbar[gt * 2] = lr; lbar[gt * 2 + 1] = li;
        float pr = lr, pi = li;
#pragma unroll
        for (int s = 0; s < 4; ++s) { const float t = pr * pr - pi * pi; pi = 2.f * pr * pi; pr = t; }
        l16[gt * 2] = pr; l16[gt * 2 + 1] = pi;
#pragma unroll
        for (int s = 0; s < 2; ++s) { const float t = pr * pr - pi * pi; pi = 2.f * pr * pi; pr = t; }
        l64[gt * 2] = pr; l64[gt * 2 + 1] = pi;
        bf16_t* bfr = (bf16_t*)X.bfrag; bf16_t* cfr = (bf16_t*)X.cfrag;
        const int ntr = p >> 4, col = p & 15;
        for (int c = 0; c < 16; ++c) {
            const float br = KAF(b_re)[(pb * 64 + p) * 16 + c], bi = KAF(b_im)[(pb * 64 + p) * 16 + c];
            const float bbr = zr * br - zi * bi, bbi = zr * bi + zi * br;
            const int q = c >> 3, j = c & 7;
            bfr[(((size_t)dg * 8 + ntr) * 64 + col + 16 * q) * 8 + j] = (bf16_t)f2bf(bbr);
            bfr[(((size_t)dg * 8 + 4 + ntr) * 64 + col + 16 * q) * 8 + j] = (bf16_t)f2bf(bbi);
            bfr[(((size_t)dg * 8 + ntr) * 64 + col + 16 * (q + 2)) * 8 + j] = 0;
            bfr[(((size_t)dg * 8 + 4 + ntr) * 64 + col + 16 * (q + 2)) * 8 + j] = 0;
            const float cr = KAF(c_re)[(pb * 16 + c) * 64 + p], ci = KAF(c_im)[(pb * 16 + c) * 64 + p];
            { const int k = p;      cfr[(((size_t)dg * 4 + (k >> 5)) * 64 + c + 16 * ((k >> 3) & 3)) * 8 + (k & 7)] = (bf16_t)f2bf(cr); }
            { const int k = 64 + p; cfr[(((size_t)dg * 4 + (k >> 5)) * 64 + c + 16 * ((k >> 3) & 3)) * 8 + (k & 7)] = (bf16_t)f2bf(-ci); }
        }
    }
    if (gt >= 2048 && gt < 2048 + 256) {
        const int c = gt - 2048;
        const float l0 = KAF(lb_logits)[c], l1 = KAF(lb_logits)[256 + c], l2 = KAF(lb_logits)[512 + c], l3 = KAF(lb_logits)[768 + c];
        const float mx = fmaxf(fmaxf(l0, l1), fmaxf(l2, l3));
        const float e0 = expf(l0 - mx), e1 = expf(l1 - mx), e2 = expf(l2 - mx), e3 = expf(l3 - mx), inv = 1.f / (e0 + e1 + e2 + e3);
        float v = 0.f; if (l >= 1) v += e1 * inv; if (l >= 2) v += e2 * inv; if (l >= 3) v += e3 * inv;
        ((float*)X.lb)[c] = v;
    }
}

struct Grp { int g, nseq, Lr, nch, s0; };
__device__ __forceinline__ Grp make_grp(int g) { Grp r; r.g = g; r.nseq = g < 2 ? 4 : 1; r.Lr = g < 2 ? 4096 : 16384; r.nch = r.Lr / 64 + 1; r.s0 = g < 2 ? g * 4 : 8 + (g - 2); return r; }

template <bool OUT>
__device__ __forceinline__ void s5_chunk(const Ctx& X, const float* s5d, LAS float* buf, bf16_t* zc, int T, int ci, int wave, int lane) {
    const int p = lane, fr = lane & 15, fq = lane >> 4;
    for (int gi = 0; gi < 2; ++gi) {
        const int g = wave * 2 + gi;
        f32x4 yacc[2][2];
#pragma unroll
        for (int i = 0; i < 2; ++i)
#pragma unroll
            for (int j = 0; j < 2; ++j) yacc[i][j] = (f32x4){0.f, 0.f, 0.f, 0.f};
        bf16x8 ua[4];
#pragma unroll
        for (int m4 = 0; m4 < 4; ++m4) { ua[m4] = (bf16x8){0, 0, 0, 0, 0, 0, 0, 0}; if (fq < 2 && m4 * 16 < T) ua[m4] = *(const bf16x8*)(zc + (size_t)(m4 * 16 + fr) * ZW + g * 16 + fq * 8); }
        bf16x8 bfr2[2][8]; float lr2[2], li2[2], xr2[2], xi2[2];
#pragma unroll
        for (int dir = 0; dir < 2; ++dir) {
            const int dg = dir * 16 + g;
#pragma unroll
            for (int nt = 0; nt < 8; ++nt) bfr2[dir][nt] = *(const bf16x8*)(X.bfrag + (((size_t)dg * 8 + nt) * 64 + lane) * 8);
            lr2[dir] = X.lbar[(dg * 64 + p) * 2]; li2[dir] = X.lbar[(dg * 64 + p) * 2 + 1];
            xr2[dir] = 0.f; xi2[dir] = 0.f;
            if (OUT) { const float* st0 = X.s5s + ((size_t)ci * 2048 + dg * 64 + p) * 2; xr2[dir] = st0[0]; xi2[dir] = st0[1]; }
        }
#pragma unroll
        for (int dir = 0; dir < 2; ++dir) {
            const int dg = dir * 16 + g;
            const bf16x8 (&bfr)[8] = bfr2[dir];
            bf16x8 cfr[4];
            if (OUT) {
#pragma unroll
                for (int ks = 0; ks < 4; ++ks) cfr[ks] = *(const bf16x8*)(X.cfrag + (((size_t)dg * 4 + ks) * 64 + lane) * 8);
            }
            const float lr = lr2[dir], li = li2[dir];
            float xr = xr2[dir], xi = xi2[dir];
            float* st = X.s5s + ((size_t)ci * 2048 + dg * 64 + p) * 2;
#pragma unroll
            for (int sti = 0; sti < 2; ++sti) {
                const int stt = dir ? 1 - sti : sti; const int t0 = stt * 32;
                if (t0 < T) {
                    const int tn = (T - t0) < 32 ? (T - t0) : 32;
#pragma unroll
                    for (int mt = 0; mt < 2; ++mt) {
                        if (mt * 16 < tn) {
#pragma unroll
                            for (int nt = 0; nt < 8; ++nt) {
                                const f32x4 c = __builtin_amdgcn_mfma_f32_16x16x32_bf16(ua[stt * 2 + mt], bfr[nt], (f32x4){0.f, 0.f, 0.f, 0.f}, 0, 0, 0);
#pragma unroll
                                for (int r = 0; r < 4; ++r) buf[(mt * 16 + fq * 4 + r) * 132 + nt * 16 + fr] = c[r];
                            }
                        }
                    }
                    __syncthreads();
                    for (int k0 = 0; k0 < tn; k0 += 8) {
                        float br[8], bi[8];
#pragma unroll
                        for (int j = 0; j < 8; ++j) { const int t = dir ? (tn - 1 - k0 - j) : k0 + j; br[j] = buf[t * 132 + p]; bi[j] = buf[t * 132 + 64 + p]; }
#pragma unroll
                        for (int j = 0; j < 8; ++j) {
                            const int t = dir ? (tn - 1 - k0 - j) : k0 + j;
                            const float nr = lr * xr - li * xi + br[j], ni = lr * xi + li * xr + bi[j];
                            xr = nr; xi = ni;
                            if (OUT) { buf[t * 132 + p] = xr; buf[t * 132 + 64 + p] = xi; }
                        }
                    }
                    if (OUT) {
                        __syncthreads();
#pragma unroll
                        for (int mt = 0; mt < 2; ++mt) {
                            if (mt * 16 < tn) {
#pragma unroll
                                for (int ks = 0; ks < 4; ++ks) {
                                    const LAS float* ap = buf + (mt * 16 + fr) * 132 + ks * 32 + fq * 8;
                                    const f32x4 a0 = *(const LAS f32x4*)ap, a1 = *(const LAS f32x4*)(ap + 4);
                                    const u32x4 aw = pack8(a0, a1);
                                    const bf16x8 av = __builtin_bit_cast(bf16x8, aw);
                                    yacc[stt][mt] = __builtin_amdgcn_mfma_f32_16x16x32_bf16(av, cfr[ks], yacc[stt][mt], 0, 0, 0);
                                }
                            }
                        }
                    }
                    __syncthreads();
                }
            }
            if (!OUT) { st[0] = xr; st[1] = xi; }
        }
        if (OUT) {
            const float dsk = s5d[g * 16 + fr];
            float uv[16];
#pragma unroll
            for (int q4 = 0; q4 < 4; ++q4)
#pragma unroll
                for (int r = 0; r < 4; ++r) { uv[q4 * 4 + r] = 0.f; if (q4 * 16 < T) uv[q4 * 4 + r] = bf2f(zc[(size_t)(q4 * 16 + fq * 4 + r) * ZW + g * 16 + fr]); }
#pragma unroll
            for (int stt = 0; stt < 2; ++stt)
#pragma unroll
                for (int mt = 0; mt < 2; ++mt) {
                    if (stt * 32 + mt * 16 < T) {
#pragma unroll
                        for (int r = 0; r < 4; ++r) {
                            const int t = stt * 32 + mt * 16 + fq * 4 + r;
                            const float y = gelu_tanh(yacc[stt][mt][r] + dsk * uv[(stt * 2 + mt) * 4 + r]);
                            zc[(size_t)t * ZW + 512 + g * 16 + fr] = (bf16_t)f2bf(y);
                        }
                    }
                }
        }
    }
}

__device__ __forceinline__ void s5_passB(const Ctx& X, const Grp& gp, int gtid, int GT) {
    const int n = gp.nseq * 2048;
    for (int e = gtid; e < n; e += GT) {
        const int sl = e >> 11, r = e & 2047, dir = r >> 10;
        const float l16r = X.l16[r * 2], l16i = X.l16[r * 2 + 1], l64r = X.l64[r * 2], l64i = X.l64[r * 2 + 1];
        float* base = X.s5s + ((size_t)(sl * gp.nch) * 2048 + r) * 2; const long cstep = dir ? -4096 : 4096; float* first = dir ? base + (size_t)(gp.nch - 1) * 4096 : base;
        float sr = 0.f, si = 0.f;
        float er[2][8], ei[2][8];
#pragma unroll
        for (int j = 0; j < 8; ++j) { er[0][j] = 0.f; ei[0][j] = 0.f; if (j < gp.nch) { const float* pp = first + (long)j * cstep; er[0][j] = pp[0]; ei[0][j] = pp[1]; } }
        for (int k0 = 0; k0 < gp.nch; k0 += 16) {
#pragma unroll
            for (int hb = 0; hb < 2; ++hb) {
                const int kb = k0 + hb * 8;
                if (kb < gp.nch) {
#pragma unroll
                    for (int j = 0; j < 8; ++j) { const int k = kb + 8 + j; er[1 - hb][j] = 0.f; ei[1 - hb][j] = 0.f; if (k < gp.nch) { const float* pp = first + (long)k * cstep; er[1 - hb][j] = pp[0]; ei[1 - hb][j] = pp[1]; } }
#pragma unroll
                    for (int j = 0; j < 8; ++j) { const int k = kb + j; if (k < gp.nch) { float* pp = first + (long)k * cstep; pp[0] = sr; pp[1] = si;
                            const int c = dir ? gp.nch - 1 - k : k;
                            const float pr = c == 0 ? l16r : l64r, pi = c == 0 ? l16i : l64i;
                            const float nr = pr * sr - pi * si + er[hb][j], ni = pr * si + pi * sr + ei[hb][j]; sr = nr; si = ni; } }
                }
            }
        }
    }
}

typedef short v4i16_t __attribute__((ext_vector_type(4)));
__device__ __forceinline__ v4i16_t vtr16(const LAS unsigned char* p) { return __builtin_amdgcn_ds_read_tr16_b64_v4i16((LAS v4i16_t*)p); }
template <bool OUT>
__device__ __forceinline__ void hg_chunk(const Ctx& X, LAS float* gt, LAS bf16_t* ot, const bf16_t* zc, int T, int ci, int wave, int lane) {
    const int h = wave >> 1, dir = wave & 1;
    float S[64];
    float* U = X.hgu + ((size_t)ci * 8 + wave) * 4096;
    if (OUT) {
#pragma unroll
        for (int d = 0; d < 64; ++d) S[d] = U[d * 64 + lane];
    } else {
#pragma unroll
        for (int d = 0; d < 64; ++d) S[d] = 0.f;
    }
    const float lbv = X.lb[h * 64 + lane], oml = 1.f - lbv; float P = 1.f;
    const int fcol = (dir ? 2304 : 2048) + h * 64 + lane, qcol = 1792 + h * 64 + lane, vcol = 2560 + h * 64 + lane;
    const int ns8 = T >> 3;
    bf16_t rq[8], rf[8], rv[8];
    {
        const int sb0 = dir ? (ns8 - 1) : 0;
#pragma unroll
        for (int j = 0; j < 8; ++j) { const bf16_t* zr = zc + (size_t)(sb0 * 8 + j) * ZW; rq[j] = zr[qcol]; rf[j] = zr[fcol]; rv[j] = zr[vcol]; }
    }
#pragma unroll 1
    for (int s8 = 0; s8 < ns8; ++s8) {
        const int sb = dir ? (ns8 - 1 - s8) : s8;
#pragma unroll
        for (int j = 0; j < 8; ++j) {
            const float q = bf2f(rq[j]), ff = bf2f(rf[j]);
            const float sg = sigm(ff), fg = lbv + oml * sg, kk = oml * (1.f - sg);
            gt[j * 256 + lane] = fg; gt[j * 256 + 64 + lane] = kk; gt[j * 256 + 128 + lane] = q * sigm(q); gt[j * 256 + 192 + lane] = bf2f(rv[j]);
            P *= fg;
        }
        __syncthreads();
        if (s8 + 1 < ns8) {
            const int sbn = dir ? (ns8 - 2 - s8) : s8 + 1;
#pragma unroll
            for (int j = 0; j < 8; ++j) { const bf16_t* zr = zc + (size_t)(sbn * 8 + j) * ZW; rq[j] = zr[qcol]; rf[j] = zr[fcol]; rv[j] = zr[vcol]; }
        }
#pragma unroll 1
        for (int jj = 0; jj < 8; ++jj) {
            const int j = dir ? 7 - jj : jj;
            const LAS float* gj = gt + j * 256;
            const float v = gj[192 + lane];
            float o = 0.f;
#pragma unroll
            for (int d4 = 0; d4 < 16; ++d4) {
                const f32x4 f4 = *(const LAS f32x4*)(gj + d4 * 4), k4 = *(const LAS f32x4*)(gj + 64 + d4 * 4);
#pragma unroll
                for (int i = 0; i < 4; ++i) S[d4 * 4 + i] = f4[i] * S[d4 * 4 + i] + k4[i] * v;
                if (OUT) { const f32x4 q4 = *(const LAS f32x4*)(gj + 128 + d4 * 4);
#pragma unroll
                    for (int i = 0; i < 4; ++i) o += S[d4 * 4 + i] * q4[i]; }
                if ((d4 & 3) == 3) __builtin_amdgcn_sched_barrier(0);
            }
            if (OUT) ot[(sb * 8 + j) * 64 + lane] = (bf16_t)f2bf(o);
        }
        __syncthreads();
    }
    if (!OUT) {
#pragma unroll
        for (int d = 0; d < 64; ++d) U[d * 64 + lane] = S[d];
        X.hgp[((size_t)ci * 8 + wave) * 64 + lane] = P;
    }
}

__device__ __forceinline__ void hg_passA_mfma(const Ctx& X, LAS unsigned char* wl, const bf16_t* zc, int T, int ci, int wave, int lane) {
    const int h = wave >> 1, dir = wave & 1, fq = lane >> 4, l16 = lane & 15, r8 = lane >> 3, pc = lane & 7;
    LAS unsigned char* kl = wl; LAS unsigned char* vl = wl + 4608;
    const float lbv = X.lb[h * 64 + lane], oml = 1.f - lbv;
    const int fcol = (dir ? 2304 : 2048) + h * 64 + lane, vcolb = 2560 + h * 64 + pc * 8;
    f32x4 acc[4][4];
#pragma unroll
    for (int a = 0; a < 4; ++a)
#pragma unroll
        for (int b = 0; b < 4; ++b) acc[a][b] = (f32x4){0.f, 0.f, 0.f, 0.f};
    float run = 1.f;
    const int nh = (T + 31) >> 5;
#pragma unroll 1
    for (int hh = 0; hh < nh; ++hh) {
        const int hb = dir ? hh : (nh - 1 - hh); const int t0 = hb * 32; const int tn = (T - t0) < 32 ? (T - t0) : 32;
        u32x4 vr[4];
#pragma unroll
        for (int i = 0; i < 4; ++i) { const int rr = i * 8 + r8; vr[i] = (u32x4){0u, 0u, 0u, 0u}; if (rr < tn) vr[i] = *(const u32x4*)(zc + (size_t)(t0 + rr) * ZW + vcolb); }
        __syncthreads();
#pragma unroll 1
        for (int bt = 0; bt < 2; ++bt) {
            const int j0 = (dir ? bt : 1 - bt) * 16;
            bf16_t rf[16];
#pragma unroll
            for (int j = 0; j < 16; ++j) { rf[j] = 0; if (j0 + j < tn) rf[j] = zc[(size_t)(t0 + j0 + j) * ZW + fcol]; }
#pragma unroll
            for (int jj = 0; jj < 16; ++jj) {
                const int jl = dir ? jj : 15 - jj; const int j = j0 + jl;
                float kh = 0.f;
                if (j < tn) { const float sg = sigm(bf2f(dir ? rf[jj] : rf[15 - jj])); kh = oml * (1.f - sg) * run; run *= lbv + oml * sg; }
                *(LAS bf16_t*)(kl + j * 144 + lane * 2) = (bf16_t)f2bf(kh);
            }
        }
#pragma unroll
        for (int i = 0; i < 4; ++i) *(LAS u32x4*)(vl + (i * 8 + r8) * 144 + pc * 16) = vr[i];
        __syncthreads();
        const int roff = (4 * fq + (l16 >> 2)) * 144 + (4 * (l16 & 3)) * 2;
        bf16x8 af[4];
#pragma unroll
        for (int mt = 0; mt < 4; ++mt) { const v4i16_t ta = vtr16(kl + roff + mt * 32), tb = vtr16(kl + roff + 16 * 144 + mt * 32); af[mt] = (bf16x8){ta[0], ta[1], ta[2], ta[3], tb[0], tb[1], tb[2], tb[3]}; }
#pragma unroll
        for (int nt = 0; nt < 4; ++nt) {
            const v4i16_t ta = vtr16(vl + roff + nt * 32), tb = vtr16(vl + roff + 16 * 144 + nt * 32);
            const bf16x8 bfv = (bf16x8){ta[0], ta[1], ta[2], ta[3], tb[0], tb[1], tb[2], tb[3]};
#pragma unroll
            for (int mt = 0; mt < 4; ++mt) acc[mt][nt] = __builtin_amdgcn_mfma_f32_16x16x32_bf16(af[mt], bfv, acc[mt][nt], 0, 0, 0);
        }
    }
    float* U = X.hgu + ((size_t)ci * 8 + wave) * 4096 + (4 * fq) * 64 + l16;
#pragma unroll
    for (int mt = 0; mt < 4; ++mt) {
#pragma unroll
        for (int r = 0; r < 4; ++r)
#pragma unroll
            for (int nt = 0; nt < 4; ++nt) U[(16 * mt + r) * 64 + 16 * nt] = acc[mt][nt][r];
        __builtin_amdgcn_sched_barrier(0);
    }
    X.hgp[((size_t)ci * 8 + wave) * 64 + lane] = run;
}

__device__ __forceinline__ void hg_passC_mfma(const Ctx& X, LAS unsigned char* wl, LAS bf16_t* ot, const bf16_t* zc, int T, int ci, int wave, int lane) {
    const int h = wave >> 1, dir = wave & 1, fq = lane >> 4, l16 = lane & 15, r8 = lane >> 3, pc = lane & 7;
    LAS unsigned char* ql = wl; LAS unsigned char* kl = wl + 2304; LAS unsigned char* vl = wl + 4608; LAS float* pl = (LAS float*)(wl + 6912);
    const float lbv = X.lb[h * 64 + lane], oml = 1.f - lbv;
    const int fcol = (dir ? 2304 : 2048) + h * 64 + lane, qcol = 1792 + h * 64 + lane, vcolb = 2560 + h * 64 + pc * 8;
    f32x4 sa[4][4];
    {
        const float* U = X.hgu + ((size_t)ci * 8 + wave) * 4096 + (4 * fq) * 64 + l16;
#pragma unroll
        for (int mt = 0; mt < 4; ++mt) {
#pragma unroll
            for (int r = 0; r < 4; ++r)
#pragma unroll
                for (int nt = 0; nt < 4; ++nt) sa[mt][nt][r] = U[(16 * mt + r) * 64 + 16 * nt];
            __builtin_amdgcn_sched_barrier(0);
        }
    }
    const int nsc = T >> 4;
    bf16_t rq[16], rf[16]; u32x4 vr[2];
    {
        const int I0 = dir ? (nsc - 1) : 0;
#pragma unroll
        for (int i = 0; i < 16; ++i) { const int tok = 16 * I0 + (dir ? 15 - i : i); rq[i] = zc[(size_t)tok * ZW + qcol]; rf[i] = zc[(size_t)tok * ZW + fcol]; }
#pragma unroll
        for (int i8 = 0; i8 < 2; ++i8) { const int i = i8 * 8 + r8; const int tok = 16 * I0 + (dir ? 15 - i : i); vr[i8] = *(const u32x4*)(zc + (size_t)tok * ZW + vcolb); }
    }
#pragma unroll 1
    for (int sc = 0; sc < nsc; ++sc) {
        const int I = dir ? (nsc - 1 - sc) : sc;
        __syncthreads();
        float c = 1.f;
#pragma unroll
        for (int i = 0; i < 16; ++i) {
            const float q = bf2f(rq[i]), sg = sigm(bf2f(rf[i]));
            c *= lbv + oml * sg;
            *(LAS bf16_t*)(ql + i * 144 + lane * 2) = (bf16_t)f2bf(q * sigm(q) * c);
            *(LAS bf16_t*)(kl + i * 144 + lane * 2) = (bf16_t)f2bf(oml * (1.f - sg) / c);
        }
        pl[lane] = c;
#pragma unroll
        for (int i8 = 0; i8 < 2; ++i8) *(LAS u32x4*)(vl + (i8 * 8 + r8) * 144 + pc * 16) = vr[i8];
        __syncthreads();
        if (sc + 1 < nsc) {
            const int In = dir ? (nsc - 2 - sc) : sc + 1;
#pragma unroll
            for (int i = 0; i < 16; ++i) { const int tok = 16 * In + (dir ? 15 - i : i); rq[i] = zc[(size_t)tok * ZW + qcol]; rf[i] = zc[(size_t)tok * ZW + fcol]; }
#pragma unroll
            for (int i8 = 0; i8 < 2; ++i8) { const int i = i8 * 8 + r8; const int tok = 16 * In + (dir ? 15 - i : i); vr[i8] = *(const u32x4*)(zc + (size_t)tok * ZW + vcolb); }
        }
        f32x4 at = (f32x4){0.f, 0.f, 0.f, 0.f};
#pragma unroll
        for (int ks = 0; ks < 2; ++ks) at = __builtin_amdgcn_mfma_f32_16x16x32_bf16(*(const LAS bf16x8*)(kl + l16 * 144 + (32 * ks + 8 * fq) * 2), *(const LAS bf16x8*)(ql + l16 * 144 + (32 * ks + 8 * fq) * 2), at, 0, 0, 0);
#pragma unroll
        for (int r = 0; r < 4; ++r) if (4 * fq + r > l16) at[r] = 0.f;
        const bf16x8 atf = __builtin_bit_cast(bf16x8, pack8(at, (f32x4){0.f, 0.f, 0.f, 0.f}));
        const int roff = (4 * fq + (l16 >> 2)) * 144 + (4 * (l16 & 3)) * 2;
        f32x4 oT[4];
#pragma unroll
        for (int et = 0; et < 4; ++et) {
            const v4i16_t tv = vtr16(vl + roff + et * 32);
            const bf16x8 vf = (bf16x8){tv[0], tv[1], tv[2], tv[3], 0, 0, 0, 0};
            oT[et] = __builtin_amdgcn_mfma_f32_16x16x32_bf16(vf, atf, (f32x4){0.f, 0.f, 0.f, 0.f}, 0, 0, 0);
        }
#pragma unroll
        for (int kp = 0; kp < 2; ++kp) {
            const u32x2 q0 = *(const LAS u32x2*)(ql + l16 * 144 + (32 * kp + 4 * fq) * 2), q1 = *(const LAS u32x2*)(ql + l16 * 144 + (32 * kp + 16 + 4 * fq) * 2);
            const bf16x8 qfr = __builtin_bit_cast(bf16x8, (u32x4){q0.x, q0.y, q1.x, q1.y});
#pragma unroll
            for (int nt = 0; nt < 4; ++nt) {
                const bf16x8 sf = __builtin_bit_cast(bf16x8, pack8(sa[2 * kp][nt], sa[2 * kp + 1][nt]));
                oT[nt] = __builtin_amdgcn_mfma_f32_16x16x32_bf16(sf, qfr, oT[nt], 0, 0, 0);
            }
        }
        {
            const int tok = 16 * I + (dir ? 15 - l16 : l16);
#pragma unroll
            for (int et = 0; et < 4; ++et)
#pragma unroll
                for (int r = 0; r < 4; ++r) ot[tok * 64 + 16 * et + 4 * fq + r] = (bf16_t)f2bf(oT[et][r]);
        }
        bf16x8 kf[4];
#pragma unroll
        for (int mt = 0; mt < 4; ++mt) { const v4i16_t tk = vtr16(kl + roff + mt * 32); kf[mt] = (bf16x8){tk[0], tk[1], tk[2], tk[3], 0, 0, 0, 0}; }
#pragma unroll
        for (int nt = 0; nt < 4; ++nt) {
            const v4i16_t tv = vtr16(vl + roff + nt * 32);
            const bf16x8 vf = (bf16x8){tv[0], tv[1], tv[2], tv[3], 0, 0, 0, 0};
#pragma unroll
            for (int mt = 0; mt < 4; ++mt) sa[mt][nt] = __builtin_amdgcn_mfma_f32_16x16x32_bf16(kf[mt], vf, sa[mt][nt], 0, 0, 0);
        }
#pragma unroll
        for (int mt = 0; mt < 4; ++mt) {
            const f32x4 p4 = *(const LAS f32x4*)(pl + 16 * mt + 4 * fq);
#pragma unroll
            for (int nt = 0; nt < 4; ++nt) sa[mt][nt] = sa[mt][nt] * p4;
        }
    }
}

__device__ __forceinline__ void hg_passB(const Ctx& X, const Grp& gp, int gtid, int GT) {
    const int n = gp.nseq * 32768;
    for (int e = gtid; e < n; e += GT) {
        const int sl = e >> 15, r = e & 32767, hd = r >> 12, de = r & 4095, d = de >> 6, dir = hd & 1;
        const size_t cb0 = (size_t)(sl * gp.nch) * 8 + hd; const int cstep = dir ? -8 : 8; const size_t cfirst = dir ? cb0 + (size_t)(gp.nch - 1) * 8 : cb0;
        float s = 0.f;
        float u[2][8], pv[2][8];
#pragma unroll
        for (int j = 0; j < 8; ++j) { u[0][j] = 0.f; pv[0][j] = 0.f; if (j < gp.nch) { const size_t cb = cfirst + (long)j * cstep; u[0][j] = X.hgu[cb * 4096 + de]; pv[0][j] = X.hgp[cb * 64 + d]; } }
        for (int k0 = 0; k0 < gp.nch; k0 += 16) {
#pragma unroll
            for (int hb = 0; hb < 2; ++hb) {
                const int kb = k0 + hb * 8;
                if (kb < gp.nch) {
#pragma unroll
                    for (int j = 0; j < 8; ++j) { const int k = kb + 8 + j; u[1 - hb][j] = 0.f; pv[1 - hb][j] = 0.f; if (k < gp.nch) { const size_t cb = cfirst + (long)k * cstep; u[1 - hb][j] = X.hgu[cb * 4096 + de]; pv[1 - hb][j] = X.hgp[cb * 64 + d]; } }
#pragma unroll
                    for (int j = 0; j < 8; ++j) { const int k = kb + j; if (k < gp.nch) { const size_t cb = cfirst + (long)k * cstep; X.hgu[cb * 4096 + de] = s; s = pv[hb][j] * s + u[hb][j]; } }
                }
            }
        }
    }
}

__device__ __forceinline__ void na_task(const Ctx& X, const float* rpb, const Grp& gp, int sl, int task, bool metaq, int wave, int lane, LAS unsigned char* vl) {
    const int h = wave, fr = lane & 15, fq = lane >> 4;
    const int s = gp.s0 + sl, rows = gp.Lr >> 6;
    int r = 0, n = 0, rs = 0, ks = 0;
    const bf16_t* qptr; bf16_t* optr; size_t ostride = 512;
    if (metaq) { qptr = X.mz + (size_t)(s * 16 + fr) * ZW; optr = X.myb + (size_t)(s * 16) * 512; }
    else {
        r = task >> 2; n = task & 3;
        rs = r - 4; rs = rs < 0 ? 0 : (rs > rows - 8 ? rows - 8 : rs);
        ks = 16 * n - 8; ks = ks < 0 ? 0 : (ks > 32 ? 32 : ks);
        const size_t qrow0 = (size_t)sl * gp.Lr + r * 64 + 16 * n;
        qptr = X.z + (qrow0 + fr) * ZW; optr = X.yb + qrow0 * 512;
    }
    bf16x8 qf[2];
#pragma unroll
    for (int kk = 0; kk < 2; ++kk) qf[kk] = *(const bf16x8*)(qptr + 256 + h * 64 + 32 * kk + 8 * fq);
    f32x4 sc[17];
    {
        const bf16_t* kp = X.mz + (size_t)(s * 16 + fr) * ZW + 768 + h * 64 + 8 * fq;
        f32x4 c = (f32x4){0.f, 0.f, 0.f, 0.f};
#pragma unroll
        for (int kk = 0; kk < 2; ++kk) c = __builtin_amdgcn_mfma_f32_16x16x32_bf16(*(const bf16x8*)(kp + 32 * kk), qf[kk], c, 0, 0, 0);
        sc[0] = c * 0.125f;
    }
    const int qc = 16 * n + fr;
    int wstart = qc - 8; wstart = wstart < 0 ? 0 : (wstart > 48 ? 48 : wstart);
    const size_t krow_base = (size_t)sl * gp.Lr + (size_t)rs * 64 + ks;
    const int r8v = lane >> 3, pcv = lane & 7; const int vcolv = 1280 + h * 64 + pcv * 8;
    u32x4 vpre0[2], vpre1[8];
#pragma unroll
    for (int i = 0; i < 2; ++i) vpre0[i] = *(const u32x4*)(X.mz + (size_t)(s * 16 + i * 8 + r8v) * ZW + vcolv);
#pragma unroll
    for (int i = 0; i < 8; ++i) { vpre1[i] = (u32x4){0u, 0u, 0u, 0u}; if (!metaq) { const int rr = i * 8 + r8v; vpre1[i] = *(const u32x4*)(X.z + (krow_base + (size_t)(rr >> 5) * 64 + (rr & 31)) * ZW + vcolv); } }
    if (!metaq) {
#pragma unroll
        for (int tb = 0; tb < 2; ++tb) {
            bf16x8 kf[8][2]; float bz[8][4];
#pragma unroll
            for (int t4 = 0; t4 < 8; ++t4) {
                const int tt = tb * 8 + t4, kj = tt >> 1, half = tt & 1;
                const bf16_t* kp = X.z + (krow_base + kj * 64 + 16 * half + fr) * ZW + 768 + h * 64 + 8 * fq;
                kf[t4][0] = *(const bf16x8*)kp; kf[t4][1] = *(const bf16x8*)(kp + 32);
            }
#pragma unroll
            for (int t4 = 0; t4 < 8; ++t4) {
                const int tt = tb * 8 + t4, kj = tt >> 1, half = tt & 1;
                const float* rp = rpb + (h * 15 + (rs + kj - r + 7)) * 31;
#pragma unroll
                for (int i = 0; i < 4; ++i) { int dc = ks + 16 * half + 4 * fq + i - qc; dc = dc < -15 ? -15 : (dc > 15 ? 15 : dc); bz[t4][i] = rp[dc + 15]; }
            }
            __builtin_amdgcn_sched_barrier(0);
#pragma unroll
            for (int t4 = 0; t4 < 8; ++t4) {
                const int tt = tb * 8 + t4, half = tt & 1;
                f32x4 c = (f32x4){0.f, 0.f, 0.f, 0.f};
                c = __builtin_amdgcn_mfma_f32_16x16x32_bf16(kf[t4][0], qf[0], c, 0, 0, 0);
                c = __builtin_amdgcn_mfma_f32_16x16x32_bf16(kf[t4][1], qf[1], c, 0, 0, 0);
#pragma unroll
                for (int i = 0; i < 4; ++i) {
                    const int kc = ks + 16 * half + 4 * fq + i;
                    const bool valid = (kc >= wstart) && (kc < wstart + 16);
                    c[i] = valid ? c[i] * 0.125f + bz[t4][i] : -1e30f;
                }
                sc[1 + tt] = c;
            }
            __builtin_amdgcn_sched_barrier(0);
        }
    } else {
#pragma unroll
        for (int tt = 0; tt < 16; ++tt) sc[1 + tt] = (f32x4){-1e30f, -1e30f, -1e30f, -1e30f};
    }
    float mx = -1e30f;
#pragma unroll
    for (int t = 0; t < 17; ++t)
#pragma unroll
        for (int i = 0; i < 4; ++i) mx = fmaxf(mx, sc[t][i]);
    mx = fmaxf(mx, __shfl_xor(mx, 16)); mx = fmaxf(mx, __shfl_xor(mx, 32));
    float sum = 0.f;
#pragma unroll
    for (int t = 0; t < 17; ++t)
#pragma unroll
        for (int i = 0; i < 4; ++i) { const float e = __expf(sc[t][i] - mx); sc[t][i] = e; sum += e; }
    sum += __shfl_xor(sum, 16); sum += __shfl_xor(sum, 32);
    const float inv = 1.f / sum;
    f32x4 oacc[4];
#pragma unroll
    for (int et = 0; et < 4; ++et) oacc[et] = (f32x4){0.f, 0.f, 0.f, 0.f};
    {
        const int r8 = lane >> 3, pc = lane & 7, l16 = lane & 15;
        const int vcol = 1280 + h * 64 + pc * 8;
        u32x4 vreg[8];
#pragma unroll
        for (int i = 0; i < 2; ++i) vreg[i] = vpre0[i];
#pragma unroll
        for (int cc = 0; cc < 5; ++cc) {
            if (cc > 0 && metaq) break;
            __syncthreads();
#pragma unroll
            for (int i = 0; i < 8; ++i) if (cc > 0 || i < 2) *(LAS u32x4*)(vl + (i * 8 + r8) * 144 + pc * 16) = vreg[i];
            __syncthreads();
            if (cc < 4 && !metaq) {
#pragma unroll
                for (int i = 0; i < 8; ++i) { const int rr = i * 8 + r8;
                    if (cc == 0) vreg[i] = vpre1[i];
                    else vreg[i] = *(const u32x4*)(X.z + (krow_base + (size_t)(2 * cc + (rr >> 5)) * 64 + (rr & 31)) * ZW + vcol); }
            }
#pragma unroll
            for (int ksl = 0; ksl < 2; ++ksl) {
                if (cc == 0 && ksl == 1) break;
                const int tt = 4 * (cc - 1) + 2 * ksl;
                f32x4 pa, pb;
                if (cc == 0) { pa = sc[0] * inv; pb = (f32x4){0.f, 0.f, 0.f, 0.f}; } else { pa = sc[1 + tt] * inv; pb = sc[2 + tt] * inv; }
                const bf16x8 pf = __builtin_bit_cast(bf16x8, pack8(pa, pb));
                const LAS unsigned char* rowp = vl + (32 * ksl + 4 * fq + (l16 >> 2)) * 144 + (4 * (l16 & 3)) * 2;
#pragma unroll
                for (int et = 0; et < 4; ++et) {
                    const v4i16_t ta = vtr16(rowp + et * 32);
                    v4i16_t tb = (v4i16_t){0, 0, 0, 0};
                    if (cc > 0) tb = vtr16(rowp + 16 * 144 + et * 32);
                    const bf16x8 vw = (bf16x8){ta[0], ta[1], ta[2], ta[3], tb[0], tb[1], tb[2], tb[3]};
                    oacc[et] = __builtin_amdgcn_mfma_f32_16x16x32_bf16(pf, vw, oacc[et], 0, 0, 0);
                }
            }
        }
    }
#pragma unroll
    for (int et = 0; et < 4; ++et)
#pragma unroll
        for (int i = 0; i < 4; ++i) optr[(size_t)(4 * fq + i) * ostride + h * 64 + et * 16 + fr] = (bf16_t)f2bf(oacc[et][i]);
}

#define XB_TMO      128
#define XB_XCNT(j)  (256  + 64 * (j))
#define XB_XSUB(j)  (1280 + 64 * (j))
#define XB_XGEN(j)  (2304 + 64 * (j))
#define XB_TOP      3328
#define XB_TOPGEN   3392
#define XCD_BAR_WORDS 3456
#define XB_SPIN_CAP (1u << 22)
__device__ __forceinline__ unsigned xb_ld(unsigned* p)              { return __hip_atomic_load(p, __ATOMIC_RELAXED, __HIP_MEMORY_SCOPE_AGENT); }
__device__ __forceinline__ unsigned xb_add(unsigned* p, unsigned v) { return __hip_atomic_fetch_add(p, v, __ATOMIC_RELAXED, __HIP_MEMORY_SCOPE_AGENT); }
__device__ __forceinline__ unsigned xb_xcc_id() { return (unsigned)__builtin_amdgcn_s_getreg((3 << 11) | 20) & 0xFu; }
#define XB_SPIN(cond, bar) do { unsigned _sp = 0; while (cond) { __builtin_amdgcn_s_sleep(1); \
    if ((++_sp & 255u) == 0u) { if (xb_ld(&(bar)[XB_TMO])) break; if (_sp > XB_SPIN_CAP) { atomicAdd(&(bar)[XB_TMO], 1u); break; } } } } while (0)
__device__ __forceinline__ void xcd_barrier_complete(unsigned* bar, unsigned x, unsigned& nloc, unsigned& nx) {
    const unsigned G = gridDim.x * gridDim.y * gridDim.z;
    unsigned sum, cnt, mine, sp = 0u;
    for (;;) {
        sum = 0u; cnt = 0u; mine = 0u;
#pragma unroll
        for (unsigned j = 0; j < 16; ++j) { const unsigned c = xb_ld(&bar[XB_XCNT(j)]); sum += c; cnt += (c > 0u) ? 1u : 0u; mine = (j == x) ? c : mine; }
        if (sum == G) break;
        __builtin_amdgcn_s_sleep(1);
        if ((++sp & 255u) == 0u) { if (xb_ld(&bar[XB_TMO])) break; if (sp > XB_SPIN_CAP) { atomicAdd(&bar[XB_TMO], 1u); break; } }
    }
    nloc = mine > 0u ? mine : 1u; nx = cnt > 0u ? cnt : 1u;
}
__device__ __forceinline__ void xcd_barrier(unsigned* bar, volatile LAS unsigned* st) {
    asm volatile("s_waitcnt vmcnt(0)" ::: "memory");
    __syncthreads();
    if (threadIdx.x == 0) {
        const unsigned x = xb_xcc_id();
        __builtin_amdgcn_s_waitcnt(0);
        unsigned nloc = st[0], nx = st[1];
        if (nloc == 0u) { xcd_barrier_complete(bar, x, nloc, nx); st[0] = nloc; st[1] = nx; }
        const unsigned old = xb_add(&bar[XB_XSUB(x)], 1u);
        const unsigned gen = old / nloc;
        if (old + 1u == (gen + 1u) * nloc) {
            __builtin_amdgcn_fence(__ATOMIC_RELEASE, "agent");
            asm volatile("s_waitcnt vmcnt(0)" ::: "memory");
            const unsigned og = xb_add(&bar[XB_TOP], 1u);
            const unsigned tg = og / nx;
            if (og + 1u == (tg + 1u) * nx) xb_add(&bar[XB_TOPGEN], 1u);
            else XB_SPIN(xb_ld(&bar[XB_TOPGEN]) == tg, bar);
            __builtin_amdgcn_fence(__ATOMIC_ACQUIRE, "agent");
            xb_add(&bar[XB_XGEN(x)], 1u);
            asm volatile("s_waitcnt vmcnt(0)" ::: "memory");
        } else {
            XB_SPIN(xb_ld(&bar[XB_XGEN(x)]) == gen, bar);
            __builtin_amdgcn_fence(__ATOMIC_ACQUIRE, "agent");
            asm volatile("s_waitcnt vmcnt(0)" ::: "memory");
        }
    }
    __syncthreads();
}
#define GRID_SYNC() xcd_barrier((unsigned*)(KA(ws) + WS_CTL), (volatile LAS unsigned*)(lds + LDS_ST_OFF))
__device__ __forceinline__ Ctx make_ctx(unsigned char* ws) {
    Ctx X;
    X.hb = (bf16_t*)(ws + WS_HB); X.ssq = (float*)(ws + WS_SSQ); X.z = (bf16_t*)(ws + WS_Z); X.yb = (bf16_t*)(ws + WS_YB); X.vt = (bf16_t*)(ws + WS_VT);
    X.hgu = (float*)(ws + WS_HGU); X.hgp = (float*)(ws + WS_HGP); X.s5s = (float*)(ws + WS_S5S); X.w = (bf16_t*)(ws + WS_W);
    X.lbar = (const float*)(ws + WS_TAB + T_LBAR); X.l16 = (const float*)(ws + WS_TAB + T_L16); X.l64 = (const float*)(ws + WS_TAB + T_L64);
    X.bfrag = (const bf16_t*)(ws + WS_TAB + T_BFRAG); X.cfrag = (const bf16_t*)(ws + WS_TAB + T_CFRAG); X.lb = (const float*)(ws + WS_TAB + T_LB);
    X.mh = (float*)(ws + WS_META + M_H); X.mhb = (bf16_t*)(ws + WS_META + M_HB); X.mssq = (float*)(ws + WS_META + M_SSQ); X.mz = (bf16_t*)(ws + WS_META + M_Z);
    X.myb = (bf16_t*)(ws + WS_META + M_YB); X.mvt = (bf16_t*)(ws + WS_META + M_VT); X.mact = (bf16_t*)(ws + WS_META + M_ACT);
    return X;
}

__device__ __forceinline__ bool make_job(unsigned char* ws, float* out, int l, int g, int ph, int j, pg8::Gemm& gm, pg8::UberEpi& ep) {
    const bool mchain = (g == 3) && (l < NLAYER - 1);
    int njobs = 1; bool meta = false; int sub = j;
    if (ph == 0) { njobs = (g == 0) ? 2 : 1; meta = (j == 1); }
    else if (ph == 4) { njobs = (g == 3) ? 2 : 1; meta = (j == 1); }
    else if (ph == 5) { njobs = mchain ? 6 : 3; meta = (j >= 3); sub = j % 3; }
    else { njobs = mchain ? 2 : 1; meta = (j == 1); }
    if (j >= njobs) return false;
    unsigned char* wb = ws + WS_W;
    const size_t r0 = (size_t)g * RG;
    unsigned char* mb = ws + WS_META;
    bf16_t* z = meta ? (bf16_t*)(mb + M_Z) : (bf16_t*)(ws + WS_Z);
    bf16_t* hb = meta ? (bf16_t*)(mb + M_HB) : (bf16_t*)(ws + WS_HB) + r0 * DM;
    float* ssq = meta ? (float*)(mb + M_SSQ) : (float*)(ws + WS_SSQ) + r0 * 4;
    float* h = meta ? (float*)(mb + M_H) : out + r0 * DM;
    bf16_t* yb = meta ? (bf16_t*)(mb + M_YB) : (bf16_t*)(ws + WS_YB);
    bf16_t* vt = meta ? (bf16_t*)(mb + M_VT) : (bf16_t*)(ws + WS_VT);
    bf16_t* act = meta ? (bf16_t*)(mb + M_ACT) : (bf16_t*)(ws + WS_Z);
    gm.M = meta ? 256 : RG;
    ep.i0 = 0; ep.p0 = nullptr; ep.p1 = nullptr; ep.p2 = nullptr;
    if (ph == 0) { gm.A = hb; gm.lda = DM; gm.Bt = (const bf16_t*)(wb + W_IN); gm.N = ZN; gm.K = DM; ep.mode = 0; ep.p0 = (unsigned char*)z; ep.p1 = (unsigned char*)ssq; ep.p2 = (unsigned char*)vt; ep.i0 = meta ? 256 : VTLD; }
    else if (ph == 4) { gm.A = z + 512; gm.lda = ZW; gm.Bt = (const bf16_t*)(wb + W_GLU); gm.N = 256; gm.K = 256; ep.mode = 1; ep.p0 = (unsigned char*)z; }
    else if (ph == 5) {
        gm.N = DM; ep.p0 = (unsigned char*)z;
        if (sub == 0) { gm.A = yb; gm.lda = 512; gm.Bt = (const bf16_t*)(wb + W_UPB); gm.K = 512; ep.mode = 2; ep.i0 = 4096; }
        else if (sub == 1) { gm.A = z + 256; gm.lda = ZW; gm.Bt = (const bf16_t*)(wb + W_UPC); gm.K = 256; ep.mode = 3; ep.i0 = 5120; }
        else { gm.A = z; gm.lda = ZW; gm.Bt = (const bf16_t*)(wb + W_UPA); gm.K = 256; ep.mode = 3; ep.i0 = 3072; }
    }
    else if (ph == 6) { gm.A = z + 1024; gm.lda = ZW; gm.Bt = (const bf16_t*)(wb + W_O); gm.N = DM; gm.K = DM; ep.mode = 4; ep.p0 = (unsigned char*)h; ep.p1 = (unsigned char*)hb; ep.p2 = (unsigned char*)ssq; }
    else if (ph == 7) { gm.A = hb; gm.lda = DM; gm.Bt = (const bf16_t*)(wb + W_GU); gm.N = 2 * FFH; gm.K = DM; ep.mode = 5; ep.p0 = (unsigned char*)act; ep.p1 = (unsigned char*)ssq; }
    else { gm.A = act; gm.lda = FFH; gm.Bt = (const bf16_t*)(wb + W_DN); gm.N = DM; gm.K = FFH; ep.mode = 4; ep.p0 = (unsigned char*)h; ep.p1 = (l == NLAYER - 1) ? nullptr : (unsigned char*)hb; ep.p2 = (unsigned char*)ssq; }
    return true;
}

__device__ __forceinline__ void prologue(int G) {
    const int tid_ = opaque_tid(); const int lane = tid_ & 63, gw = blockIdx.x * 8 + __builtin_amdgcn_readfirstlane(tid_ >> 6), NGW = G * 8;
    const Ctx X = make_ctx(((unsigned char*)KA(ws)));
    for (int row = gw; row < RMAIN + 256; row += NGW) {
        const bool ismeta = row >= RMAIN; const int mr = row - RMAIN;
        const float* src = ismeta ? (mr < 160 ? KAF(meta_tokens) + (size_t)(mr & 15) * DM : nullptr) : (row < 32768 ? KAF(x_prompt) + (size_t)row * DM : KAF(x_sample) + (size_t)(row - 32768) * DM);
        float* hd = ismeta ? X.mh + (size_t)mr * DM : ((float*)KA(out)) + (size_t)row * DM;
        bf16_t* hbd = ismeta ? X.mhb + (size_t)mr * DM : X.hb + (size_t)row * DM;
        float* sq = ismeta ? X.mssq + (size_t)mr * 4 : X.ssq + (size_t)row * 4;
        float ss = 0.f;
#pragma unroll
        for (int j = 0; j < 4; ++j) {
            f32x4 v = (f32x4){0.f, 0.f, 0.f, 0.f}; if (src) v = *(const f32x4*)(src + j * 256 + lane * 4);
            *(f32x4*)(hd + j * 256 + lane * 4) = v;
            *(u32x2*)(hbd + j * 256 + lane * 4) = (u32x2){pk2(v[0], v[1]), pk2(v[2], v[3])};
            ss += (v[0] * v[0] + v[1] * v[1]) + (v[2] * v[2] + v[3] * v[3]);
        }
        ss = wave_sum(ss);
        if (lane < 4) sq[lane] = lane == 0 ? ss : 0.f;
    }
}

__device__ __forceinline__ void mixer_phase_A(int l, int g, LAS unsigned char* lds, int G, int bid) {
    const int tid_ = opaque_tid(); const int lane = tid_ & 63, wave = __builtin_amdgcn_readfirstlane(tid_ >> 6);
    const Ctx X = make_ctx(((unsigned char*)KA(ws))); const Grp gp = make_grp(g);
    const float* rpb = KAF(rpb) + (size_t)l * 8 * 15 * 31; const float* s5d = KAF(s5_d) + l * 256;
    const int nna = gp.nseq * (gp.Lr / 16), nmq = (l == NLAYER - 1) ? 0 : gp.nseq  , nct = gp.nseq * (gp.nch - 1);
    const int ntask = nna + nmq + 2 * nct;
    const bool xmap = (nna % 256 == 0) && ((volatile LAS unsigned*)(lds + LDS_ST_OFF))[4] != 0u;
    if (xmap) {
        const int xcc = (int)((volatile LAS unsigned*)(lds + LDS_ST_OFF))[2], xrk = (int)((volatile LAS unsigned*)(lds + LDS_ST_OFF))[3];
        const int per = gp.Lr / 16, nx = nna / 8, rounds = nna / 256;
        for (int i = 0; i < rounds; ++i) { const int t = xcc * nx + xrk + 32 * i; na_task(X, rpb, gp, t / per, t % per, false, wave, lane, lds + wave * 9216); }
    }
    for (int t = bid + (xmap ? nna : 0); t < ntask; t += G) {
        __syncthreads();
        if (t < nna) { const int per = gp.Lr / 16; na_task(X, rpb, gp, t / per, t % per, false, wave, lane, lds + wave * 9216); }
        else if (t < nna + nmq) { na_task(X, rpb, gp, t - nna, 0, true, wave, lane, lds + wave * 9216); }
        else {
            const int u = t - nna - nmq; const bool isS5 = u < nct; const int v = isS5 ? u : u - nct;
            const int sl = v / (gp.nch - 1), c1 = v % (gp.nch - 1) + 1;
            for (int c = (c1 == 1 ? 0 : c1); c <= c1; ++c) {
                __syncthreads();
                const int ci = sl * gp.nch + c; const int T = c == 0 ? 16 : 64;
                bf16_t* zc = c == 0 ? X.mz + (size_t)((gp.s0 + sl) * 16) * ZW : X.z + ((size_t)sl * gp.Lr + 64 * (c - 1)) * ZW;
                if (isS5) s5_chunk<false>(X, s5d, (LAS float*)(lds + wave * 16896), zc, T, ci, wave, lane);
                else hg_passA_mfma(X, lds + wave * 9216, zc, T, ci, wave, lane);
            }
        }
    }
}

__device__ __forceinline__ void mixer_phase_C(int l, int g, LAS unsigned char* lds, int G, int bid) {
    const int tid_ = opaque_tid(); const int lane = tid_ & 63, wave = __builtin_amdgcn_readfirstlane(tid_ >> 6);
    const Ctx X = make_ctx(((unsigned char*)KA(ws))); const Grp gp = make_grp(g);
    const float* s5d = KAF(s5_d) + l * 256; const float* ong = KAF(onorm_g) + l * 64;
    const int nct = gp.nseq * (gp.nch - 1);
    for (int t = bid; t < 2 * nct; t += G) {
        const bool isS5 = t < nct; const int v = isS5 ? t : t - nct;
        const int sl = v / (gp.nch - 1), c1 = v % (gp.nch - 1) + 1;
        for (int c = ((c1 == 1 && l != NLAYER - 1) ? 0 : c1); c <= c1; ++c) {
            __syncthreads();
            const int ci = sl * gp.nch + c; const int T = c == 0 ? 16 : 64;
            bf16_t* zc = c == 0 ? X.mz + (size_t)((gp.s0 + sl) * 16) * ZW : X.z + ((size_t)sl * gp.Lr + 64 * (c - 1)) * ZW;
            if (isS5) {
                s5_chunk<true>(X, s5d, (LAS float*)(lds + wave * 16896), zc, T, ci, wave, lane);
                const int fr = lane & 15, fq = lane >> 4;
                const bf16_t* wg = (const bf16_t*)((const unsigned char*)X.w + W_GLU);
                const int n0 = wave * 32;
                bf16x8 bw[8][2];
#pragma unroll
                for (int ks = 0; ks < 8; ++ks)
#pragma unroll
                    for (int n2 = 0; n2 < 2; ++n2) bw[ks][n2] = *(const bf16x8*)(wg + (size_t)(n0 + n2 * 16 + fr) * 256 + ks * 32 + fq * 8);
                asm volatile("s_waitcnt vmcnt(0)" ::: "memory");
                __syncthreads();
                f32x4 ga[4][2];
#pragma unroll
                for (int a = 0; a < 4; ++a)
#pragma unroll
                    for (int b = 0; b < 2; ++b) ga[a][b] = (f32x4){0.f, 0.f, 0.f, 0.f};
#pragma unroll
                for (int kh = 0; kh < 2; ++kh) {
                    bf16x8 af[4][4];
#pragma unroll
                    for (int k4 = 0; k4 < 4; ++k4)
#pragma unroll
                        for (int mt = 0; mt < 4; ++mt) { af[k4][mt] = (bf16x8){0, 0, 0, 0, 0, 0, 0, 0}; if (mt * 16 < T) af[k4][mt] = *(const bf16x8*)(zc + (size_t)(mt * 16 + fr) * ZW + 512 + (kh * 4 + k4) * 32 + fq * 8); }
                    __builtin_amdgcn_sched_barrier(0);
#pragma unroll
                    for (int k4 = 0; k4 < 4; ++k4)
#pragma unroll
                        for (int mt = 0; mt < 4; ++mt) {
                            if (mt * 16 < T) {
#pragma unroll
                                for (int n2 = 0; n2 < 2; ++n2) ga[mt][n2] = __builtin_amdgcn_mfma_f32_16x16x32_bf16(af[k4][mt], bw[kh * 4 + k4][n2], ga[mt][n2], 0, 0, 0);
                            }
                        }
                    __builtin_amdgcn_sched_barrier(0);
                }
#pragma unroll
                for (int mt = 0; mt < 4; ++mt) {
                    if (mt * 16 < T) {
                        float yy[2][4];
#pragma unroll
                        for (int n2 = 0; n2 < 2; ++n2)
#pragma unroll
                            for (int r = 0; r < 4; ++r) yy[n2][r] = bf2f(zc[(size_t)(mt * 16 + 4 * fq + r) * ZW + 512 + n0 + n2 * 16 + fr]);
#pragma unroll
                        for (int n2 = 0; n2 < 2; ++n2)
#pragma unroll
                            for (int r = 0; r < 4; ++r) zc[(size_t)(mt * 16 + 4 * fq + r) * ZW + n0 + n2 * 16 + fr] = (bf16_t)f2bf(yy[n2][r] * sigm(ga[mt][n2][r]));
                    }
                }
            }
            else {
                hg_passC_mfma(X, lds + wave * 7168, (LAS bf16_t*)(lds + 65536 + wave * 8192), zc, T, ci, wave, lane);
                __syncthreads();
                const int h = wave >> 1, half = wave & 1;
                const LAS bf16_t* of = (const LAS bf16_t*)(lds + 65536 + (2 * h) * 8192); const LAS bf16_t* ob = (const LAS bf16_t*)(lds + 65536 + (2 * h + 1) * 8192);
                const float gn = ong[lane];
                const int tt0 = half * (T / 2);
                float gov[32];
#pragma unroll
                for (int i = 0; i < 32; ++i) { gov[i] = 0.f; if (i < T / 2) gov[i] = bf2f(zc[(size_t)(tt0 + i) * ZW + 2816 + h * 64 + lane]); }
#pragma unroll
                for (int i = 0; i < 32; ++i) {
                    if (i < T / 2) {
                        const int tt = tt0 + i;
                        const float o = bf2f(of[tt * 64 + lane]) + bf2f(ob[tt * 64 + lane]);
                        const float ms = wave_sum(o * o) * (1.0f / 64.0f);
                        const float go = gov[i];
                        zc[(size_t)tt * ZW + 256 + h * 64 + lane] = (bf16_t)f2bf(o * rsqrtf(ms + 1e-6f) * gn * (go * sigm(go)));
                    }
                }
            }
        }
    }
}

__global__ void __launch_bounds__(512, 2) fwd_kernel(Args a) {
    extern __shared__ __attribute__((aligned(16))) unsigned char lds_raw[];
    LAS unsigned char* lds = (LAS unsigned char*)lds_raw;
    const int G = gridDim.x, bid = blockIdx.x;

    if (threadIdx.x < 2) ((volatile LAS unsigned*)(lds + LDS_ST_OFF))[threadIdx.x] = 0u;
    if (threadIdx.x == 0) { const unsigned xc = xb_xcc_id(); const unsigned rk = xb_add((unsigned*)(KA(ws) + WS_CTL) + XB_XCNT(xc), 1u);
        ((volatile LAS unsigned*)(lds + LDS_ST_OFF))[2] = xc; ((volatile LAS unsigned*)(lds + LDS_ST_OFF))[3] = rk; }
    __syncthreads();
    prologue(G);

    for (int l = 0; l < NLAYER; ++l) {
        __syncthreads();
        { const Ctx X = make_ctx(((unsigned char*)KA(ws))); prep_layer(X, l, lds, G); }
        if (l == 0) { asm volatile("s_waitcnt vmcnt(0)" ::: "memory"); __syncthreads(); cg::this_grid().sync(); }
        GRID_SYNC();
        if (l == 0) {
            if (threadIdx.x == 0) { unsigned* bar = (unsigned*)(KA(ws) + WS_CTL); bool ok = (G == 256);
                for (int j = 0; j < 16; ++j) { const unsigned c = xb_ld(&bar[XB_XCNT(j)]); ok = ok && (c == (j < 8 ? 32u : 0u)); }
                ((volatile LAS unsigned*)(lds + LDS_ST_OFF))[4] = ok ? 1u : 0u; }
            __syncthreads();
        }
        for (int g = 0; g < 4; ++g) {
            for (int ph = 0; ph < 9; ++ph) {
                if (ph == 4) continue;
                if (ph == 1) mixer_phase_A(l, g, lds, G, bid);
                else if (ph == 2) { const Ctx X = make_ctx(((unsigned char*)KA(ws))); const Grp gp = make_grp(g); const int gtid = bid * 512 + opaque_tid(), GT = G * 512; s5_passB(X, gp, gtid, GT); hg_passB(X, gp, GT - 1 - gtid, GT); }
                else if (ph == 3) mixer_phase_C(l, g, lds, G, bid);
                else {
                    for (int j = 0; j < 6; ++j) {
                        pg8::Gemm gm; pg8::UberEpi ep;
                        if (!make_job(((unsigned char*)KA(ws)), ((float*)KA(out)), l, g, ph, j, gm, ep)) break;
                        int cidx = bid;
                        if (ph == 7 && j == 1) { const int busy = ((RG / 256) * (2 * FFH / 256)) % G; cidx = (bid + G - busy) % G; }
                        pg8::StaticOrder SO; SO.init(gm.M, gm.N, G, cidx);
                        pg8::gemm_phase(lds, gm, SO, ep);
                    }
                }
                GRID_SYNC();
            }
        }
    }
    {
        const float* ssq = (const float*)(((unsigned char*)KA(ws)) + WS_SSQ);
        const int tid_ = opaque_tid(); const int lane = tid_ & 63, wave = __builtin_amdgcn_readfirstlane(tid_ >> 6);
        for (int row = bid * 8 + wave; row < RMAIN; row += G * 8) {
            const float rs = pg8::row_rstd(ssq, row);
            float* hp = ((float*)KA(out)) + (size_t)row * DM;
#pragma unroll
            for (int j = 0; j < 4; ++j) {
                f32x4 v = *(const f32x4*)(hp + j * 256 + lane * 4); const f32x4 gv = *(const f32x4*)(KAF(final_g) + j * 256 + lane * 4);
                v = v * rs * gv; *(f32x4*)(hp + j * 256 + lane * 4) = v;
            }
        }
    }
}

extern "C" void kernel_launch(void* const* d_in, const int* in_sizes, int n_in, void* d_out, int out_size, void* d_ws, size_t ws_size, hipStream_t stream) {
    static int grid = 0;
    if (grid == 0) {
        int dev = 0, cus = 0, per_cu = 0;
        (void)hipGetDevice(&dev);
        (void)hipDeviceGetAttribute(&cus, hipDeviceAttributeMultiprocessorCount, dev);
        (void)hipFuncSetAttribute((const void*)fwd_kernel, hipFuncAttributeMaxDynamicSharedMemorySize, LDS_BYTES);
        (void)hipOccupancyMaxActiveBlocksPerMultiprocessor(&per_cu, (const void*)fwd_kernel, 512, LDS_BYTES);
        (void)hipGetLastError();
        if (ws_size < WS_TOTAL) fprintf(stderr, "kernel_launch: workspace too small: %zu < %zu\n", ws_size, (size_t)WS_TOTAL);
        grid = cus > 0 ? cus : 256;
    }
    (void)hipMemsetAsync((char*)d_ws + WS_CTL, 0, CTL_BYTES, stream);
    Args a{};
    const float** pp = (const float**)&a;
    for (int i = 0; i < 26; ++i) pp[i] = (const float*)d_in[i];
    a.out = (float*)d_out; a.ws = (unsigned char*)d_ws;
    void* args[] = {&a};
    hipError_t e = hipLaunchCooperativeKernel((const void*)fwd_kernel, dim3(grid), dim3(512), args, LDS_BYTES, stream);
    if (e != hipSuccess) fprintf(stderr, "cooperative launch failed: %s\n", hipGetErrorString(e));
}
```
